# Optimizing an MI355X kernel written in HIP

```python
import math
import jax, jax.numpy as jnp
from jax import lax
import numpy as np

D_MODEL = 1024
BATCH = 16
SEQ = 2048
DEPTH = 2

GRID_W = 64
CTX_LEN = 256
ROPE_THETA = 10000.0
NORM_EPS = 1e-6
SUBLN_EPS = 1e-5
LN_EPS = 1e-5
Q_BLOCK = 128

A_GROUPS = 8
A_WIDTH = D_MODEL // 2
A_GROUP_DIM = A_WIDTH // A_GROUPS
A_CHUNK = 128

B_HEADS = 4
B_HEAD_DIM = 64
B_V_DIM = 2 * B_HEAD_DIM
B_WIDTH = B_HEADS * B_V_DIM
B_QK = B_HEADS * 2 * B_HEAD_DIM

EVEN_IN = 3 * A_WIDTH + 2 * B_QK + 2 * B_WIDTH
EVEN_MIX = A_WIDTH + B_WIDTH
EVEN_SPLITS = (A_WIDTH, 2 * A_WIDTH, 3 * A_WIDTH, 3 * A_WIDTH + B_QK,
               3 * A_WIDTH + 2 * B_QK, 3 * A_WIDTH + 2 * B_QK + B_WIDTH)

C_HEADS = 8
C_NOPE = 128
C_ROPE = 64
C_V = 128
C_Q_RANK = 256
C_KV_RANK = 128
C_WIDTH = C_HEADS * C_V
ODD_IN = C_Q_RANK + C_KV_RANK + C_ROPE + C_WIDTH
ODD_SPLITS = (C_Q_RANK, C_Q_RANK + C_KV_RANK, C_Q_RANK + C_KV_RANK + C_ROPE)

N_EVEN = (DEPTH + 1) // 2
N_ODD = DEPTH // 2

kernel_name = 'hybrid_gmlp_diffattn_mla_prefix_dit'

F32 = jnp.float32


def rms_norm(x, w, eps=NORM_EPS):
    xf = x.astype(F32)
    y = xf * lax.rsqrt(jnp.mean(xf * xf, axis=-1, keepdims=True) + eps)
    return (y * w.astype(F32)).astype(x.dtype)


def layer_norm(x, w, b, eps=LN_EPS):
    xf = x.astype(F32)
    mu = jnp.mean(xf, axis=-1, keepdims=True)
    xc = xf - mu
    y = xc * lax.rsqrt(jnp.mean(xc * xc, axis=-1, keepdims=True) + eps)
    return (y * w.astype(F32) + b.astype(F32)).astype(x.dtype)


def adaln_terms(cond, w_ada, b_ada):
    m = jax.nn.silu(cond) @ w_ada + b_ada
    return jnp.split(m, 3, axis=-1)


def axial_rope_tables(seq, dim):
    rows = seq // GRID_W
    row = jnp.repeat(jnp.arange(rows), GRID_W).astype(F32)
    col = jnp.tile(jnp.arange(GRID_W), rows).astype(F32)
    half = dim // 2
    inv = ROPE_THETA ** (-jnp.arange(0, half, 2, dtype=F32) / half)
    ang_r = row[:, None] * inv[None, :]
    ang_c = col[:, None] * inv[None, :]
    ang = jnp.concatenate([ang_r, ang_r, ang_c, ang_c], axis=-1)
    return jnp.cos(ang), jnp.sin(ang)


def apply_rope(x, cos, sin):
    extra = x.ndim - 3
    shp = (1, cos.shape[0]) + (1,) * extra + (cos.shape[1],)
    c = cos.reshape(shp)
    s = sin.reshape(shp)
    seg = x.reshape(x.shape[:-1] + (2, 2, x.shape[-1] // 4))
    rot = jnp.concatenate([-seg[..., 1:, :], seg[..., :1, :]], axis=-2).reshape(x.shape)
    return (x.astype(F32) * c + rot.astype(F32) * s).astype(x.dtype)


def sweep_query_blocks(fn, q):
    b, s = q.shape[0], q.shape[1]
    nb = s // Q_BLOCK
    qb = jnp.moveaxis(q.reshape((b, nb, Q_BLOCK) + q.shape[2:]), 1, 0)
    ob = lax.map(fn, qb)
    return jnp.moveaxis(ob, 0, 1).reshape((b, s) + ob.shape[3:])


def spatial_gating(u, v, w_s, b_s, ln_w, ln_b):
    bsz, length, _ = v.shape
    vn = layer_norm(v, ln_w, ln_b)
    vc = vn.reshape(bsz, length // A_CHUNK, A_CHUNK, A_GROUPS, A_GROUP_DIM)
    mixed = jnp.einsum('gpq,bnqgd->bnpgd', w_s, vc) + b_s.T[None, None, :, :, None]
    return u * mixed.reshape(bsz, length, A_WIDTH)


def diff_attn_core(q, k, v, lam):
    s = jnp.einsum('bqhmd,bkhmd->bhmqk', q, k).astype(F32) * (B_HEAD_DIM ** -0.5)
    p = jax.nn.softmax(s, axis=-1)
    a = p[:, :, 0] - lam * p[:, :, 1]
    return jnp.einsum('bhqk,bkhd->bqhd', a.astype(v.dtype), v)


def mla_core(q, k, v):
    s = jnp.einsum('bqhd,bkhd->bhqk', q, k).astype(F32) * ((C_NOPE + C_ROPE) ** -0.5)
    p = jax.nn.softmax(s, axis=-1)
    return jnp.einsum('bhqk,bkhd->bqhd', p.astype(v.dtype), v)


def even_mixer(xl, xc, need_ctx, li, w_in, w_s, b_s, ln_w, ln_b, lq1, lk1, lq2, lk2, subln_w, w_out):
    bsz, seq, _ = xl.shape
    clen = xc.shape[1]
    cos, sin = axial_rope_tables(seq, B_HEAD_DIM)
    lam_init = 0.8 - 0.6 * math.exp(-0.3 * li)
    lam = (jnp.exp(jnp.sum(lq1.astype(F32) * lk1.astype(F32)))
           - jnp.exp(jnp.sum(lq2.astype(F32) * lk2.astype(F32))) + lam_init)

    au_l, av_l, az_l, bq_l, bk_l, bv_l, bz_l = jnp.split(xl @ w_in, EVEN_SPLITS, axis=-1)
    au_c, av_c, az_c, bq_c, bk_c, bv_c, bz_c = jnp.split(xc @ w_in, EVEN_SPLITS, axis=-1)

    def a_branch(u, v, z):
        return spatial_gating(jax.nn.gelu(u, approximate=False), jax.nn.gelu(v, approximate=False),
                              w_s, b_s, ln_w, ln_b) * jax.nn.silu(z)

    def b_post(o, z, length):
        o = rms_norm(o, subln_w, SUBLN_EPS) * (1.0 - lam_init)
        return o.reshape(bsz, length, B_WIDTH) * jax.nn.silu(z)

    qk_shape_l = (bsz, seq, B_HEADS, 2, B_HEAD_DIM)
    qk_shape_c = (bsz, clen, B_HEADS, 2, B_HEAD_DIM)
    q_l = apply_rope(bq_l.reshape(qk_shape_l), cos, sin)
    k_l = apply_rope(bk_l.reshape(qk_shape_l), cos, sin)
    v_l = bv_l.reshape(bsz, seq, B_HEADS, B_V_DIM)
    k_c = bk_c.reshape(qk_shape_c)
    v_c = bv_c.reshape(bsz, clen, B_HEADS, B_V_DIM)
    k_all = jnp.concatenate([k_c, k_l], axis=1)
    v_all = jnp.concatenate([v_c, v_l], axis=1)

    ob_l = sweep_query_blocks(lambda qb: diff_attn_core(qb, k_all, v_all, lam), q_l)
    out_l = jnp.concatenate([a_branch(au_l, av_l, az_l), b_post(ob_l, bz_l, seq)], axis=-1) @ w_out

    out_c = None
    if need_ctx:
        q_c = bq_c.reshape(qk_shape_c)
        ob_c = diff_attn_core(q_c, k_c, v_c, lam)
        out_c = jnp.concatenate([a_branch(au_c, av_c, az_c), b_post(ob_c, bz_c, clen)], axis=-1) @ w_out
    return out_l, out_c


def odd_mixer(xl, xc, need_ctx, w_in, q_norm_w, wq_b, kv_norm_w, wkv_b, w_out):
    bsz, seq, _ = xl.shape
    clen = xc.shape[1]
    cos, sin = axial_rope_tables(seq, C_ROPE)

    cq_l, ckv_l, kr_l, z_l = jnp.split(xl @ w_in, ODD_SPLITS, axis=-1)
    cq_c, ckv_c, kr_c, z_c = jnp.split(xc @ w_in, ODD_SPLITS, axis=-1)

    def queries(cq, length):
        q = (rms_norm(cq, q_norm_w) @ wq_b).reshape(bsz, length, C_HEADS, C_NOPE + C_ROPE)
        return q[..., :C_NOPE], q[..., C_NOPE:]

    def keys_values(ckv, k_rope, length):
        kv = (rms_norm(ckv, kv_norm_w) @ wkv_b).reshape(bsz, length, C_HEADS, C_NOPE + C_V)
        k_rope_h = jnp.broadcast_to(k_rope[:, :, None, :], (bsz, length, C_HEADS, C_ROPE))
        return jnp.concatenate([kv[..., :C_NOPE], k_rope_h], axis=-1), kv[..., C_NOPE:]

    qn_l, qr_l = queries(cq_l, seq)
    q_l = jnp.concatenate([qn_l, apply_rope(qr_l, cos, sin)], axis=-1)
    kr_l_rot = apply_rope(kr_l[:, :, None, :], cos, sin)[:, :, 0, :]
    k_l, v_l = keys_values(ckv_l, kr_l_rot, seq)
    k_c, v_c = keys_values(ckv_c, kr_c, clen)
    k_all = jnp.concatenate([k_c, k_l], axis=1)
    v_all = jnp.concatenate([v_c, v_l], axis=1)

    o_l = sweep_query_blocks(lambda qb: mla_core(qb, k_all, v_all), q_l)
    out_l = (o_l.reshape(bsz, seq, C_WIDTH) * jax.nn.silu(z_l)) @ w_out

    out_c = None
    if need_ctx:
        qn_c, qr_c = queries(cq_c, clen)
        q_c = jnp.concatenate([qn_c, qr_c], axis=-1)
        o_c = mla_core(q_c, k_c, v_c)
        out_c = (o_c.reshape(bsz, clen, C_WIDTH) * jax.nn.silu(z_c)) @ w_out
    return out_l, out_c


def setup_inputs(seed: int = 0) -> dict:
    key = jax.random.key(seed)
    ks = jax.random.split(key, 32)
    nrm = jax.random.normal
    D = D_MODEL
    return {
        'x': nrm(ks[0], (BATCH, SEQ, D), F32),
        'c': nrm(ks[1], (BATCH, D), F32),
        'ctx': nrm(ks[2], (BATCH, CTX_LEN, D), F32),
        'c_ctx': nrm(ks[3], (D,), F32),
        'norm_w': 1.0 + 0.02 * nrm(ks[4], (DEPTH, D), F32),
        'ada_w': 0.5 * D ** -0.5 * nrm(ks[5], (DEPTH, D, 3 * D), F32),
        'ada_b': 0.01 * nrm(ks[6], (DEPTH, 3 * D), F32),
        'even_w_in': D ** -0.5 * nrm(ks[7], (N_EVEN, D, EVEN_IN), F32),
        'a_ws': A_CHUNK ** -0.5 * nrm(ks[8], (N_EVEN, A_GROUPS, A_CHUNK, A_CHUNK), F32),
        'a_bs': 1.0 + 0.02 * nrm(ks[9], (N_EVEN, A_GROUPS, A_CHUNK), F32),
        'a_ln_w': 1.0 + 0.02 * nrm(ks[10], (N_EVEN, A_WIDTH), F32),
        'a_ln_b': 0.01 * nrm(ks[11], (N_EVEN, A_WIDTH), F32),
        'b_lq1': 0.1 * nrm(ks[12], (N_EVEN, B_HEAD_DIM), F32),
        'b_lk1': 0.1 * nrm(ks[13], (N_EVEN, B_HEAD_DIM), F32),
        'b_lq2': 0.1 * nrm(ks[14], (N_EVEN, B_HEAD_DIM), F32),
        'b_lk2': 0.1 * nrm(ks[15], (N_EVEN, B_HEAD_DIM), F32),
        'b_subln_w': 1.0 + 0.02 * nrm(ks[16], (N_EVEN, B_V_DIM), F32),
        'even_w_out': EVEN_MIX ** -0.5 * nrm(ks[17], (N_EVEN, EVEN_MIX, D), F32),
        'odd_w_in': D ** -0.5 * nrm(ks[18], (N_ODD, D, ODD_IN), F32),
        'c_q_norm_w': 1.0 + 0.02 * nrm(ks[19], (N_ODD, C_Q_RANK), F32),
        'c_wq_b': C_Q_RANK ** -0.5 * nrm(ks[20], (N_ODD, C_Q_RANK, C_HEADS * (C_NOPE + C_ROPE)), F32),
        'c_kv_norm_w': 1.0 + 0.02 * nrm(ks[21], (N_ODD, C_KV_RANK), F32),
        'c_wkv_b': C_KV_RANK ** -0.5 * nrm(ks[22], (N_ODD, C_KV_RANK, C_HEADS * (C_NOPE + C_V)), F32),
        'odd_w_out': C_WIDTH ** -0.5 * nrm(ks[23], (N_ODD, C_WIDTH, D), F32),
        'final_w': 1.0 + 0.02 * nrm(ks[24], (D,), F32),
    }


def reference(x, c, ctx, c_ctx, norm_w, ada_w, ada_b, even_w_in, a_ws, a_bs, a_ln_w, a_ln_b,
              b_lq1, b_lk1, b_lq2, b_lk2, b_subln_w, even_w_out, odd_w_in, c_q_norm_w, c_wq_b,
              c_kv_norm_w, c_wkv_b, odd_w_out, final_w):
    h_lat, h_ctx = x, ctx
    for li in range(DEPTH):
        need_ctx = li < DEPTH - 1
        shift_l, scale_l, gate_l = adaln_terms(c, ada_w[li], ada_b[li])
        shift_c, scale_c, gate_c = adaln_terms(c_ctx, ada_w[li], ada_b[li])
        xl = rms_norm(h_lat, norm_w[li]) * (1.0 + scale_l[:, None, :]) + shift_l[:, None, :]
        xc = rms_norm(h_ctx, norm_w[li]) * (1.0 + scale_c) + shift_c
        if li % 2 == 0:
            e = li // 2
            out_l, out_c = even_mixer(xl, xc, need_ctx, li, even_w_in[e], a_ws[e], a_bs[e],
                                      a_ln_w[e], a_ln_b[e], b_lq1[e], b_lk1[e], b_lq2[e], b_lk2[e],
                                      b_subln_w[e], even_w_out[e])
        else:
            o = li // 2
            out_l, out_c = odd_mixer(xl, xc, need_ctx, odd_w_in[o], c_q_norm_w[o], c_wq_b[o],
                                     c_kv_norm_w[o], c_wkv_b[o], odd_w_out[o])
        h_lat = h_lat + gate_l[:, None, :] * out_l
        if need_ctx:
            h_ctx = h_ctx + gate_c * out_c
    return rms_norm(h_lat, final_w)
```

```cpp
#include <hip/hip_runtime.h>
#include <hip/hip_cooperative_groups.h>
#include <cstdio>
namespace cg = cooperative_groups;

#ifndef ONE_LAUNCH
#define ONE_LAUNCH 1
#endif

typedef unsigned short bf16_t;
typedef short bf16x8 __attribute__((ext_vector_type(8)));
typedef short s16x4 __attribute__((ext_vector_type(4)));
typedef float f32x16 __attribute__((ext_vector_type(16)));
typedef float f32x4 __attribute__((ext_vector_type(4)));
typedef unsigned u32x4 __attribute__((ext_vector_type(4)));
typedef unsigned u32x2 __attribute__((ext_vector_type(2)));
#define DEVI __device__ __forceinline__
#define SBAR() __builtin_amdgcn_sched_barrier(0)
DEVI int tidx() { int t = threadIdx.x; asm volatile("" : "+v"(t)); return t; }

constexpr int NLAT = 32768, NCTX = 4096, NTOK = 36864, KVL = 2304;
constexpr int LDS_BYTES = 147456, LDS_SS = 139264;

constexpr size_t OFF_W0IN = 0;
constexpr size_t OFF_W0OUT = OFF_W0IN + 3584ull * 1024 * 2;
constexpr size_t OFF_W1IN = OFF_W0OUT + 1024ull * 1024 * 2;
constexpr size_t OFF_WQ = OFF_W1IN + 1536ull * 1024 * 2;
constexpr size_t OFF_WKV = OFF_WQ + 1536ull * 256 * 2;
constexpr size_t OFF_W1OUT = OFF_WKV + 2048ull * 128 * 2;
constexpr size_t OFF_WSB = OFF_W1OUT + 1024ull * 1024 * 2;
constexpr size_t OFF_ADA = OFF_WSB + 8ull * 128 * 128 * 2;
constexpr size_t OFF_ROPE = OFF_ADA + 2ull * 17 * 3072 * 4;
constexpr size_t OFF_H1C = OFF_ROPE + 64ull * 16 * 8;
constexpr size_t OFF_RQ = OFF_H1C + 4096ull * 1024 * 4;
constexpr size_t OFF_RKV = OFF_RQ + 32768ull * 4;
constexpr size_t OFF_X = OFF_RKV + 36864ull * 4;
constexpr size_t OFF_MIX = OFF_X + 36864ull * 1024 * 2;
constexpr size_t OFF_T = OFF_MIX + 36864ull * 1024 * 2;
constexpr size_t SZ_HALF = 36864ull * 512 * 2;
constexpr size_t OFF_U = OFF_T, OFF_GV = OFF_U + SZ_HALF, OFF_ZA = OFF_GV + SZ_HALF, OFF_ZB = OFF_ZA + SZ_HALF, OFF_Q0 = OFF_ZB + SZ_HALF;
constexpr size_t OFF_K0 = OFF_Q0 + SZ_HALF, OFF_V0 = OFF_K0 + 16ull * 4 * KVL * 128 * 2, END_L0 = OFF_V0 + 16ull * 4 * KVL * 128 * 2;
constexpr size_t OFF_CQ = OFF_T, OFF_CKV = OFF_CQ + 32768ull * 256 * 2, OFF_Z1 = OFF_CKV + 36864ull * 128 * 2;
constexpr size_t OFF_Q1 = OFF_Z1 + 32768ull * 1024 * 2, OFF_K1 = OFF_Q1 + 32768ull * 1536 * 2, END_L1 = OFF_K1 + 16ull * 8 * KVL * 192 * 2;
constexpr size_t OFF_V1 = OFF_X;
constexpr size_t WS_NEED = END_L1 > END_L0 ? END_L1 : END_L0;

struct Params {
  const float *x, *c, *ctx, *c_ctx, *norm_w, *ada_w, *ada_b, *even_w_in, *a_ws, *a_bs, *a_ln_w, *a_ln_b,
      *b_lq1, *b_lk1, *b_lq2, *b_lk2, *b_subln_w, *even_w_out, *odd_w_in, *c_q_norm_w, *c_wq_b,
      *c_kv_norm_w, *c_wkv_b, *odd_w_out, *final_w;
  float* out; char* ws; int ph_lo, ph_hi;
};

DEVI unsigned cvtpk(float lo, float hi) { unsigned r; asm("v_cvt_pk_bf16_f32 %0, %1, %2" : "=v"(r) : "v"(lo), "v"(hi)); return r; }
DEVI bf16_t f2bf(float v) { return (bf16_t)(cvtpk(v, 0.f) & 0xffffu); }
DEVI float bf2f(bf16_t v) { return __uint_as_float(((unsigned)v) << 16); }
DEVI float bflo(unsigned w) { return __uint_as_float(w << 16); }
DEVI float bfhi(unsigned w) { return __uint_as_float(w & 0xffff0000u); }
DEVI int crow(int r, int hi) { return (r & 3) + 8 * (r >> 2) + 4 * hi; }
DEVI float silu_f(float x) { return x / (1.f + __expf(-x)); }
DEVI float gelu_f(float x) { return 0.5f * x * (1.f + erff(x * 0.70710678118654752f)); }

DEVI void rope_tile(f32x16& v, const float2* __restrict__ tab, int pos, int hi) {
#pragma unroll
  for (int r = 0; r < 8; ++r) {
    const int jf = (r & 3) + 8 * (r >> 2) + 4 * hi;
    const float2 cs = tab[pos * 16 + jf];
    const float a = v[r], b = v[r + 8];
    v[r] = a * cs.x - b * cs.y; v[r + 8] = b * cs.x + a * cs.y;
  }
}
DEVI void store4(bf16_t* dst, const f32x16& v, int rg) {
  u32x2 pk = {cvtpk(v[rg * 4 + 0], v[rg * 4 + 1]), cvtpk(v[rg * 4 + 2], v[rg * 4 + 3])};
  *reinterpret_cast<u32x2*>(dst) = pk;
}

template <class Epi>
DEVI void gemm_tile(const bf16_t* __restrict__ A, int lda, const bf16_t* __restrict__ Bt, int ldb, int K, int row0, int col0, char* lds, const Epi& epi) {
  const int tid = tidx(), wid = tid >> 6, lane = tid & 63, r32 = lane & 31, hi = lane >> 5, wr = wid >> 2, wc = wid & 3;
  f32x16 acc[4][2];
#pragma unroll
  for (int i = 0; i < 4; ++i)
#pragma unroll
    for (int j = 0; j < 2; ++j)
#pragma unroll
      for (int r = 0; r < 16; ++r) acc[i][j][r] = 0.f;
  const int nt = K >> 6;
  const int srow = tid >> 3, sch = (tid & 7) ^ ((tid >> 4) & 7);
  const bf16_t* ga = A + (size_t)(row0 + srow) * lda + sch * 8;
  const bf16_t* gb = Bt + (size_t)(col0 + srow) * ldb + sch * 8;
  const int sw = (r32 >> 1) & 7;
  const int xoff = (wr * 128 + r32) * 128;
  const int woff = 32768 + (wc * 64 + r32) * 128;
#define GSTAGE(kt, buf) do { char* _b = lds + (buf) * 65536 + tid * 16; \
    _Pragma("unroll") for (int _i = 0; _i < 4; ++_i) { \
      __builtin_amdgcn_global_load_lds((const unsigned*)(ga + (size_t)_i * 64 * lda + (kt) * 64), (unsigned*)(_b + _i * 8192), 16, 0, 0); \
      __builtin_amdgcn_global_load_lds((const unsigned*)(gb + (size_t)_i * 64 * ldb + (kt) * 64), (unsigned*)(_b + 32768 + _i * 8192), 16, 0, 0); } } while (0)
  GSTAGE(0, 0);
  for (int t = 0; t < nt; ++t) {
    __syncthreads();
    if (t + 1 < nt) GSTAGE(t + 1, (t + 1) & 1);
    const char* bufp = lds + (t & 1) * 65536;
#pragma unroll
    for (int ks = 0; ks < 4; ++ks) {
      const int ph = (((ks << 1) | hi) ^ sw) << 4;
      bf16x8 xf[4], wf[2];
#pragma unroll
      for (int i = 0; i < 4; ++i) xf[i] = *reinterpret_cast<const bf16x8*>(bufp + xoff + i * 4096 + ph);
#pragma unroll
      for (int j = 0; j < 2; ++j) wf[j] = *reinterpret_cast<const bf16x8*>(bufp + woff + j * 4096 + ph);
#pragma unroll
      for (int i = 0; i < 4; ++i)
#pragma unroll
        for (int j = 0; j < 2; ++j) acc[i][j] = __builtin_amdgcn_mfma_f32_32x32x16_bf16(wf[j], xf[i], acc[i][j], 0, 0, 0);
    }
  }
#undef GSTAGE
  epi(acc, row0, col0, wr, wc, r32, hi);
}

DEVI void tile_of(int it, int nN, int& pm, int& pn) { const int xcd = it & 7, jx = it >> 3; pm = (jx / nN) * 8 + xcd; pn = jx % nN; }

struct EpiL0In {
  bf16_t *U, *GV, *ZA, *ZB, *Q0, *K0, *V0; const float2* rope;
  DEVI void operator()(f32x16 (&acc)[4][2], int row0, int col0, int wr, int wc, int r32, int hi) const {
    const int type = col0 >> 9; const bool ctx = row0 >= NLAT;
#pragma unroll
    for (int i = 0; i < 4; ++i) {
      const int token = row0 + wr * 128 + i * 32 + r32;
      int b, s, key;
      if (!ctx) { b = token >> 11; s = token & 2047; key = 256 + s; } else { const int tc = token - NLAT; b = tc >> 8; s = 0; key = tc & 255; }
#pragma unroll
      for (int j = 0; j < 2; ++j) {
        const int nl = (col0 & 511) + wc * 64 + j * 32;
        f32x16 v = acc[i][j];
        bf16_t* dst;
        if (type <= 1) {
#pragma unroll
          for (int r = 0; r < 16; ++r) v[r] = gelu_f(v[r]);
          dst = (type == 0 ? U : GV) + (size_t)token * 512 + nl;
        } else if (type == 2 || type == 6) {
#pragma unroll
          for (int r = 0; r < 16; ++r) v[r] = silu_f(v[r]);
          dst = (type == 2 ? ZA : ZB) + (size_t)token * 512 + nl;
        } else if (type == 3) {
          if (!ctx) rope_tile(v, rope, j ? (s & 63) : (s >> 6), hi);
          dst = Q0 + (size_t)token * 512 + nl;
        } else if (type == 4) {
          if (!ctx) rope_tile(v, rope, j ? (s & 63) : (s >> 6), hi);
          dst = K0 + ((size_t)(b * 4 + (nl >> 7)) * KVL + key) * 128 + (nl & 127);
        } else {
          dst = V0 + ((size_t)(b * 4 + (nl >> 7)) * KVL + key) * 128 + (nl & 127);
        }
#pragma unroll
        for (int rg = 0; rg < 4; ++rg) store4(dst + rg * 8 + hi * 4, v, rg);
      }
    }
  }
};

template <bool HASCTX> struct EpiOut {
  const float* src_lat; const float* src_ctx; float* dst_lat; float* dst_ctx; const float* ada;
  DEVI void operator()(f32x16 (&acc)[4][2], int row0, int col0, int wr, int wc, int r32, int hi) const {
#pragma unroll
    for (int i = 0; i < 4; ++i) {
      const int token = row0 + wr * 128 + i * 32 + r32;
      const float* src; float* dst; const float* gate;
      if (!HASCTX || token < NLAT) { src = src_lat + (size_t)token * 1024; dst = dst_lat + (size_t)token * 1024; gate = ada + (token >> 11) * 3072 + 2048; }
      else { const int tc = token - NLAT; src = src_ctx + (size_t)tc * 1024; dst = dst_ctx + (size_t)tc * 1024; gate = ada + 16 * 3072 + 2048; }
#pragma unroll
      for (int j = 0; j < 2; ++j)
#pragma unroll
        for (int rg = 0; rg < 4; ++rg) {
          const int n = col0 + wc * 64 + j * 32 + rg * 8 + hi * 4;
          const f32x4 xv = *reinterpret_cast<const f32x4*>(src + n), g = *reinterpret_cast<const f32x4*>(gate + n);
          f32x4 o;
#pragma unroll
          for (int e = 0; e < 4; ++e) o[e] = xv[e] + g[e] * acc[i][j][rg * 4 + e];
          *reinterpret_cast<f32x4*>(dst + n) = o;
        }
    }
  }
};

struct EpiL1In {
  bf16_t *CQ, *CKV, *K1, *Z1; float *RQ, *RKV; const float2* rope; float* ssb;
  DEVI void operator()(f32x16 (&acc)[4][2], int row0, int col0, int wr, int wc, int r32, int hi) const {
    const bool ctx = row0 >= NLAT; const int pn = col0 >> 8; const int nb = col0 + wc * 64;
    float ss[4] = {0.f, 0.f, 0.f, 0.f};
#pragma unroll
    for (int i = 0; i < 4; ++i) {
      const int token = row0 + wr * 128 + i * 32 + r32;
      int b, s, key;
      if (!ctx) { b = token >> 11; s = token & 2047; key = 256 + s; } else { const int tc = token - NLAT; b = tc >> 8; s = 0; key = tc & 255; }
#pragma unroll
      for (int j = 0; j < 2; ++j) {
        f32x16 v = acc[i][j];
        const int n0 = nb + j * 32;
        if (nb < 384) {
#pragma unroll
          for (int r = 0; r < 16; ++r) ss[i] += v[r] * v[r];
          bf16_t* dst = nb < 256 ? CQ + (size_t)token * 256 + n0 : CKV + (size_t)token * 128 + (n0 - 256);
#pragma unroll
          for (int rg = 0; rg < 4; ++rg) store4(dst + rg * 8 + hi * 4, v, rg);
        } else if (nb < 448) {
          if (!ctx) rope_tile(v, rope, j ? (s & 63) : (s >> 6), hi);
#pragma unroll
          for (int h = 0; h < 8; ++h) {
            bf16_t* dst = K1 + ((size_t)(b * 8 + h) * KVL + key) * 192 + 128 + j * 32;
#pragma unroll
            for (int rg = 0; rg < 4; ++rg) store4(dst + rg * 8 + hi * 4, v, rg);
          }
        } else if (nb < 1472) {
          if (!ctx) {
#pragma unroll
            for (int r = 0; r < 16; ++r) v[r] = silu_f(v[r]);
            bf16_t* dst = Z1 + (size_t)token * 1024 + (n0 - 448);
#pragma unroll
            for (int rg = 0; rg < 4; ++rg) store4(dst + rg * 8 + hi * 4, v, rg);
          }
        }
      }
    }
    if (pn <= 1) {
#pragma unroll
      for (int i = 0; i < 4; ++i) {
        const float sv = ss[i] + __shfl_xor(ss[i], 32);
        if (hi == 0) ssb[wc * 256 + wr * 128 + i * 32 + r32] = sv;
      }
      __syncthreads();
      const int tid = tidx();
      if (tid < 256) {
        if (pn == 0) { const float tot = (ssb[tid] + ssb[256 + tid]) + (ssb[512 + tid] + ssb[768 + tid]); RQ[row0 + tid] = rsqrtf(tot * (1.f / 256.f) + 1e-6f); }
        else { const float tot = ssb[tid] + ssb[256 + tid]; RKV[row0 + tid] = rsqrtf(tot * (1.f / 128.f) + 1e-6f); }
      }
      __syncthreads();
    }
  }
};

struct EpiQ {
  bf16_t* Q1; const float* RQ; const float2* rope;
  DEVI void operator()(f32x16 (&acc)[4][2], int row0, int col0, int wr, int wc, int r32, int hi) const {
#pragma unroll
    for (int i = 0; i < 4; ++i) {
      const int token = row0 + wr * 128 + i * 32 + r32; const int s = token & 2047; const float rq = RQ[token];
#pragma unroll
      for (int j = 0; j < 2; ++j) {
        f32x16 v = acc[i][j];
#pragma unroll
        for (int r = 0; r < 16; ++r) v[r] *= rq;
        const int n0 = col0 + wc * 64 + j * 32; const int dd0 = n0 % 192;
        if (dd0 >= 128) rope_tile(v, rope, (dd0 >= 160) ? (s & 63) : (s >> 6), hi);
        bf16_t* dst = Q1 + (size_t)token * 1536 + n0;
#pragma unroll
        for (int rg = 0; rg < 4; ++rg) store4(dst + rg * 8 + hi * 4, v, rg);
      }
    }
  }
};

struct EpiKV {
  bf16_t *K1, *V1; const float* RKV;
  DEVI void operator()(f32x16 (&acc)[4][2], int row0, int col0, int wr, int wc, int r32, int hi) const {
    const bool ctx = row0 >= NLAT; const int nb = col0 + wc * 64; const int h = nb >> 8, dd = nb & 255;
#pragma unroll
    for (int i = 0; i < 4; ++i) {
      const int token = row0 + wr * 128 + i * 32 + r32; const float rk = RKV[token];
      int b, key;
      if (!ctx) { b = token >> 11; key = 256 + (token & 2047); } else { const int tc = token - NLAT; b = tc >> 8; key = tc & 255; }
#pragma unroll
      for (int j = 0; j < 2; ++j) {
        f32x16 v = acc[i][j];
#pragma unroll
        for (int r = 0; r < 16; ++r) v[r] *= rk;
        bf16_t* dst = dd < 128 ? K1 + ((size_t)(b * 8 + h) * KVL + key) * 192 + dd + j * 32
                               : V1 + ((size_t)(b * 8 + h) * KVL + key) * 128 + (dd - 128) + j * 32;
#pragma unroll
        for (int rg = 0; rg < 4; ++rg) store4(dst + rg * 8 + hi * 4, v, rg);
      }
    }
  }
};

template <int SCID> struct ScaleOf { static constexpr float v = SCID == 0 ? 0.125f : 0.07216878364870322f; };
constexpr float THR = 8.f;
template <int KW> DEVI int kswz(int row, int colB) { return KW == 128 ? row * 256 + (colB ^ ((row & 15) << 4)) : row * 384 + (colB ^ (((row >> 1) & 7) << 4)); }
DEVI int v_st(int k, int c) { const int kk = (k & ~0xC) | ((k & 4) << 1) | ((k & 8) >> 1); return ((kk >> 3) * 4 + (c >> 5)) * 512 + ((kk & 7) * 32 + (c & 31)) * 2; }
DEVI int v_rd_base(int lane) { return ((lane & 3) << 3) | (((lane >> 2) & 3) << 6) | (((lane >> 4) & 1) << 5) | (((lane >> 5) & 1) << 8); }
constexpr int v_rd_off(int d0, int ks, int half) { return d0 * 512 + ks * 4096 + half * 2048; }
template <int OFF> DEVI s16x4 tr_read(int vb) { s16x4 r; asm volatile("ds_read_b64_tr_b16 %0, %1 offset:%2" : "=&v"(r) : "v"(vb), "i"(OFF) : "memory"); return r; }

template <int SCID>
DEVI void partialSM(f32x16& p0, f32x16& p1, float& m_reg, float& mn, float& alpha) {
  constexpr float SC = ScaleOf<SCID>::v; constexpr float C = SC * 1.4426950408889634f;
  float pmax = p0[0];
#pragma unroll
  for (int r = 1; r < 16; ++r) pmax = fmaxf(pmax, p0[r]);
#pragma unroll
  for (int r = 0; r < 16; ++r) pmax = fmaxf(pmax, p1[r]);
  { auto rr = __builtin_amdgcn_permlane32_swap(__float_as_uint(pmax), __float_as_uint(pmax), false, false);
    pmax = fmaxf(__uint_as_float(rr[0]), __uint_as_float(rr[1])); }
  if (__builtin_expect(__all(pmax - m_reg <= THR / SC), 1)) { mn = m_reg; alpha = 1.f; }
  else { mn = fmaxf(m_reg, pmax); alpha = __builtin_amdgcn_exp2f((m_reg - mn) * C); m_reg = mn; }
  const float mnC = -mn * C;
#pragma unroll
  for (int r = 0; r < 16; ++r) p0[r] = fmaf(p0[r], C, mnC);
#pragma unroll
  for (int r = 0; r < 16; ++r) p1[r] = fmaf(p1[r], C, mnC);
#pragma unroll
  for (int r = 0; r < 16; ++r) p0[r] = __builtin_amdgcn_exp2f(p0[r]);
}
DEVI void finishSM(f32x16& p0, f32x16& p1, float alpha, float& l_reg, bf16x8& pa0, bf16x8& pa1, bf16x8& pa2, bf16x8& pa3) {
#pragma unroll
  for (int r = 0; r < 16; ++r) p1[r] = __builtin_amdgcn_exp2f(p1[r]);
  float ps = 0;
#pragma unroll
  for (int r = 0; r < 16; ++r) ps += p0[r];
#pragma unroll
  for (int r = 0; r < 16; ++r) ps += p1[r];
  { auto rr = __builtin_amdgcn_permlane32_swap(__float_as_uint(ps), __float_as_uint(ps), false, false);
    ps = __uint_as_float(rr[0]) + __uint_as_float(rr[1]); }
  l_reg = l_reg * alpha + ps;
#define PK4(P, BASE, OUT) do { unsigned a0 = cvtpk(P[BASE + 0], P[BASE + 1]), a1 = cvtpk(P[BASE + 2], P[BASE + 3]); \
    unsigned b0 = cvtpk(P[BASE + 4], P[BASE + 5]), b1 = cvtpk(P[BASE + 6], P[BASE + 7]); \
    auto r0 = __builtin_amdgcn_permlane32_swap(a0, b0, false, false); auto r1 = __builtin_amdgcn_permlane32_swap(a1, b1, false, false); \
    u32x4 w = {r0[0], r1[0], r0[1], r1[1]}; OUT = *reinterpret_cast<bf16x8*>(&w); } while (0)
  PK4(p0, 0, pa0); PK4(p0, 8, pa1); PK4(p1, 0, pa2); PK4(p1, 8, pa3);
#undef PK4
}
template <int KW, int NQ>
DEVI void qkt(f32x16& p0, f32x16& p1, const char* Ks, const bf16x8* qr, int kcol0, int r32, int hi) {
#pragma unroll
  for (int r = 0; r < 16; ++r) { p0[r] = 0.f; p1[r] = 0.f; }
#pragma unroll
  for (int d0 = 0; d0 < NQ; ++d0) {
    const int cb = (kcol0 + d0 * 16 + hi * 8) * 2;
    const bf16x8 b0 = *reinterpret_cast<const bf16x8*>(Ks + kswz<KW>(r32, cb));
    const bf16x8 b1 = *reinterpret_cast<const bf16x8*>(Ks + kswz<KW>(32 + r32, cb));
    p0 = __builtin_amdgcn_mfma_f32_32x32x16_bf16(b0, qr[d0], p0, 0, 0, 0);
    p1 = __builtin_amdgcn_mfma_f32_32x32x16_bf16(b1, qr[d0], p1, 0, 0, 0);
  }
}
template <int D0> DEVI void pv_one(f32x16& od, int vb, bf16x8 pa0, bf16x8 pa1, bf16x8 pa2, bf16x8 pa3) {
  const s16x4 l0 = tr_read<v_rd_off(D0, 0, 0)>(vb), h0 = tr_read<v_rd_off(D0, 0, 1)>(vb), l1 = tr_read<v_rd_off(D0, 1, 0)>(vb), h1 = tr_read<v_rd_off(D0, 1, 1)>(vb);
  const s16x4 l2 = tr_read<v_rd_off(D0, 2, 0)>(vb), h2 = tr_read<v_rd_off(D0, 2, 1)>(vb), l3 = tr_read<v_rd_off(D0, 3, 0)>(vb), h3 = tr_read<v_rd_off(D0, 3, 1)>(vb);
  asm volatile("s_waitcnt lgkmcnt(0)" ::: "memory"); SBAR();
#define PK(L, H) (bf16x8){L[0], L[1], L[2], L[3], H[0], H[1], H[2], H[3]}
  od = __builtin_amdgcn_mfma_f32_32x32x16_bf16(pa0, PK(l0, h0), od, 0, 0, 0);
  od = __builtin_amdgcn_mfma_f32_32x32x16_bf16(pa1, PK(l1, h1), od, 0, 0, 0);
  od = __builtin_amdgcn_mfma_f32_32x32x16_bf16(pa2, PK(l2, h2), od, 0, 0, 0);
  od = __builtin_amdgcn_mfma_f32_32x32x16_bf16(pa3, PK(l3, h3), od, 0, 0, 0);
#undef PK
}
DEVI void pv_d0(f32x16* o, int vb, bf16x8 pa0, bf16x8 pa1, bf16x8 pa2, bf16x8 pa3) {
  pv_one<0>(o[0], vb, pa0, pa1, pa2, pa3); pv_one<1>(o[1], vb, pa0, pa1, pa2, pa3); pv_one<2>(o[2], vb, pa0, pa1, pa2, pa3); pv_one<3>(o[3], vb, pa0, pa1, pa2, pa3);
}

template <int KW, int NQ, int SCID>
DEVI void attn_core(const bf16_t* __restrict__ Qw, const bf16_t* __restrict__ Kh, const bf16_t* __restrict__ Vh, int kcol0, int NT, char* lds,
                    f32x16 (&o)[4], float& l_out) {
  constexpr int SHM_V = 64 * 128 * 2, SHM_K = 64 * KW * 2, KC = KW / 64;
  const int tid = tidx(), wid = tid >> 6, lane = tid & 63, r32 = lane & 31, hi = lane >> 5;
  char* V_lds = lds; char* K_lds = lds + 2 * SHM_V;
  float* al_l = (float*)(lds + 2 * SHM_V + 2 * SHM_K) + wid * 64 + 32;
  float m_reg = -1e30f, l_reg = 0;
#pragma unroll
  for (int d = 0; d < 4; ++d)
#pragma unroll
    for (int r = 0; r < 16; ++r) o[d][r] = 0.f;
  bf16x8 qr[NQ];
#pragma unroll
  for (int d0 = 0; d0 < NQ; ++d0) qr[d0] = *reinterpret_cast<const bf16x8*>(Qw + d0 * 16);
  const int sr = tid >> 4, sc = (tid & 15) * 8, vst0 = v_st(sr, sc), vst1 = v_st(32 + sr, sc);
  const int krow = tid >> 3, kch = tid & 7;
  const bf16_t* vg = Vh + sr * 128 + sc;
  const bf16_t* kg = Kh + krow * KW + kch * 8;
  const int vb0 = (int)(uintptr_t)V_lds + v_rd_base(lane);
  bf16x8 vs0, vs1, ks[KC];
#define SLOAD(k0) do { vs0 = *reinterpret_cast<const bf16x8*>(vg + (size_t)(k0) * 128); vs1 = *reinterpret_cast<const bf16x8*>(vg + (size_t)((k0) + 32) * 128); \
    _Pragma("unroll") for (int _c = 0; _c < KC; ++_c) ks[_c] = *reinterpret_cast<const bf16x8*>(kg + (size_t)(k0) * KW + _c * 64); } while (0)
#define SWRITE(b) do { *reinterpret_cast<bf16x8*>(V_lds + (b) * SHM_V + vst0) = vs0; *reinterpret_cast<bf16x8*>(V_lds + (b) * SHM_V + vst1) = vs1; \
    _Pragma("unroll") for (int _c = 0; _c < KC; ++_c) *reinterpret_cast<bf16x8*>(K_lds + (b) * SHM_K + kswz<KW>(krow, (kch + 8 * _c) * 16)) = ks[_c]; } while (0)
  SLOAD(0); SWRITE(0);
  if (NT > 1) SLOAD(64);
  __syncthreads();
  for (int j = 0; j < NT; ++j) {
    const int bsel = j & 1;
    f32x16 p0, p1; float mn, alpha; bf16x8 pa0, pa1, pa2, pa3;
    qkt<KW, NQ>(p0, p1, K_lds + bsel * SHM_K, qr, kcol0, r32, hi);
    partialSM<SCID>(p0, p1, m_reg, mn, alpha);
    if (__any(alpha < 1.f)) {
      if (hi == 0) al_l[r32] = alpha;
      asm volatile("s_waitcnt lgkmcnt(0)" ::: "memory");
#pragma unroll
      for (int d = 0; d < 4; ++d)
#pragma unroll
        for (int r = 0; r < 16; ++r) o[d][r] *= al_l[crow(r, hi)];
    }
    finishSM(p0, p1, alpha, l_reg, pa0, pa1, pa2, pa3);
    pv_d0(o, vb0 + bsel * SHM_V, pa0, pa1, pa2, pa3);
    if (j + 1 < NT) { SWRITE(bsel ^ 1); if (j + 2 < NT) SLOAD((j + 2) * 64); }
    __syncthreads();
  }
  l_out = l_reg;
#undef SLOAD
#undef SWRITE
}

DEVI void attn0_item(const Params& p, int token0, int b, int h, int nkeys, char* lds) {
  const int tid = tidx(), wid = tid >> 6, lane = tid & 63, r32 = lane & 31, hi = lane >> 5, m = wid >> 2, wl = wid & 3;
  const bf16_t* Q0 = (const bf16_t*)(p.ws + OFF_Q0); const bf16_t* K0 = (const bf16_t*)(p.ws + OFF_K0); const bf16_t* V0 = (const bf16_t*)(p.ws + OFF_V0);
  const bf16_t* ZB = (const bf16_t*)(p.ws + OFF_ZB); bf16_t* MIX = (bf16_t*)(p.ws + OFF_MIX);
  const bf16_t* Qw = Q0 + (size_t)(token0 + wl * 32 + r32) * 512 + h * 128 + m * 64 + hi * 8;
  const size_t kvo = (size_t)(b * 4 + h) * KVL * 128;
  f32x16 o[4]; float l;
  attn_core<128, 4, 0>(Qw, K0 + kvo, V0 + kvo, m * 64, nkeys >> 6, lds, o, l);
  float* li_l = (float*)(lds + 65536) + wid * 64;
  if (hi == 0) li_l[r32] = l;
  asm volatile("s_waitcnt lgkmcnt(0)" ::: "memory");
  float rli[16];
#pragma unroll
  for (int r = 0; r < 16; ++r) rli[r] = __builtin_amdgcn_rcpf(li_l[crow(r, hi)]);
  float t1 = p.b_lq1[lane] * p.b_lk1[lane], t2 = p.b_lq2[lane] * p.b_lk2[lane];
#pragma unroll
  for (int sft = 32; sft >= 1; sft >>= 1) { t1 += __shfl_xor(t1, sft); t2 += __shfl_xor(t2, sft); }
  const float lam = __expf(t1) - __expf(t2) + 0.2f;
  __syncthreads();
  float* xch = (float*)lds;
  if (m == 1) {
#pragma unroll
    for (int r = 0; r < 16; ++r)
#pragma unroll
      for (int d0 = 0; d0 < 4; ++d0) xch[(wl * 32 + crow(r, hi)) * 128 + d0 * 32 + r32] = o[d0][r] * rli[r];
  }
  __syncthreads();
  if (m == 0) {
    float sw4[4];
#pragma unroll
    for (int d0 = 0; d0 < 4; ++d0) sw4[d0] = p.b_subln_w[d0 * 32 + r32];
#pragma unroll
    for (int r = 0; r < 16; ++r) {
      const int row = wl * 32 + crow(r, hi); const int token = token0 + row;
      float a[4], ss = 0.f;
#pragma unroll
      for (int d0 = 0; d0 < 4; ++d0) { a[d0] = o[d0][r] * rli[r] - lam * xch[row * 128 + d0 * 32 + r32]; ss += a[d0] * a[d0]; }
      ss += __shfl_xor(ss, 1); ss += __shfl_xor(ss, 2); ss += __shfl_xor(ss, 4); ss += __shfl_xor(ss, 8); ss += __shfl_xor(ss, 16);
      const float rstd = rsqrtf(ss * (1.f / 128.f) + 1e-5f) * 0.8f;
#pragma unroll
      for (int d0 = 0; d0 < 4; ++d0) {
        const int d = d0 * 32 + r32;
        const float val = a[d0] * rstd * sw4[d0] * bf2f(ZB[(size_t)token * 512 + h * 128 + d]);
        MIX[(size_t)token * 1024 + 512 + h * 128 + d] = f2bf(val);
      }
    }
  }
  __syncthreads();
}

DEVI void attn1_item(const Params& p, int b, int h, int qb, char* lds) {
  const int tid = tidx(), wid = tid >> 6, lane = tid & 63, r32 = lane & 31, hi = lane >> 5;
  const bf16_t* Q1 = (const bf16_t*)(p.ws + OFF_Q1); const bf16_t* K1 = (const bf16_t*)(p.ws + OFF_K1); const bf16_t* V1 = (const bf16_t*)(p.ws + OFF_V1);
  const bf16_t* Z1 = (const bf16_t*)(p.ws + OFF_Z1); bf16_t* MIX = (bf16_t*)(p.ws + OFF_MIX);
  const int token0 = b * 2048 + qb * 256;
  const bf16_t* Qw = Q1 + (size_t)(token0 + wid * 32 + r32) * 1536 + h * 192 + hi * 8;
  f32x16 o[4]; float l;
  attn_core<192, 12, 1>(Qw, K1 + (size_t)(b * 8 + h) * KVL * 192, V1 + (size_t)(b * 8 + h) * KVL * 128, 0, KVL / 64, lds, o, l);
  float* li_l = (float*)(lds + 32768 + 49152) + wid * 64;
  if (hi == 0) li_l[r32] = l;
  asm volatile("s_waitcnt lgkmcnt(0)" ::: "memory");
#pragma unroll
  for (int r = 0; r < 16; ++r) {
    const int cr = crow(r, hi); const float rl = __builtin_amdgcn_rcpf(li_l[cr]); const int token = token0 + wid * 32 + cr;
#pragma unroll
    for (int d0 = 0; d0 < 4; ++d0) {
      const int d = h * 128 + d0 * 32 + r32;
      MIX[(size_t)token * 1024 + d] = f2bf(o[d0][r] * rl * bf2f(Z1[(size_t)token * 1024 + d]));
    }
  }
  __syncthreads();
}

DEVI void abranch_item(const Params& p, int ci, char* lds) {
  const int tid = tidx(), wid = tid >> 6, lane = tid & 63, r32 = lane & 31, hi = lane >> 5;
  const bf16_t* GV = (const bf16_t*)(p.ws + OFF_GV); const bf16_t* U = (const bf16_t*)(p.ws + OFF_U); const bf16_t* ZA = (const bf16_t*)(p.ws + OFF_ZA);
  const bf16_t* WSB = (const bf16_t*)(p.ws + OFF_WSB); bf16_t* MIX = (bf16_t*)(p.ws + OFF_MIX);
  const int t0 = ci * 128;
  bf16_t* vnT = (bf16_t*)lds;
  {
    const int pos = tid >> 2, cp = tid & 3;
    const bf16_t* g = GV + (size_t)(t0 + pos) * 512;
    float s = 0.f, q = 0.f;
#pragma unroll 4
    for (int i = 0; i < 16; ++i) {
      const bf16x8 raw = *reinterpret_cast<const bf16x8*>(g + (i * 4 + cp) * 8);
#pragma unroll
      for (int e = 0; e < 8; ++e) { const float xv = bf2f((bf16_t)raw[e]); s += xv; q += xv * xv; }
    }
    s += __shfl_xor(s, 1); s += __shfl_xor(s, 2); q += __shfl_xor(q, 1); q += __shfl_xor(q, 2);
    const float mu = s * (1.f / 512.f);
    const float rstd = rsqrtf(fmaxf(q * (1.f / 512.f) - mu * mu, 0.f) + 1e-5f);
#pragma unroll 2
    for (int i = 0; i < 16; ++i) {
      const int c0 = (i * 4 + cp) * 8;
      const bf16x8 raw = *reinterpret_cast<const bf16x8*>(g + c0);
      const f32x4 w0 = *reinterpret_cast<const f32x4*>(p.a_ln_w + c0), w1 = *reinterpret_cast<const f32x4*>(p.a_ln_w + c0 + 4);
      const f32x4 b0 = *reinterpret_cast<const f32x4*>(p.a_ln_b + c0), b1 = *reinterpret_cast<const f32x4*>(p.a_ln_b + c0 + 4);
#pragma unroll
      for (int e = 0; e < 8; ++e) {
        const float wv = e < 4 ? w0[e & 3] : w1[e & 3], bv = e < 4 ? b0[e & 3] : b1[e & 3];
        vnT[(c0 + e) * 136 + pos] = f2bf((bf2f((bf16_t)raw[e]) - mu) * rstd * wv + bv);
      }
    }
  }
  __syncthreads();
  const int g8 = wid;
  const bf16_t* Wg = WSB + g8 * 128 * 128;
  for (int pb = 0; pb < 4; ++pb) {
    f32x16 acc[2];
#pragma unroll
    for (int r = 0; r < 16; ++r) { acc[0][r] = 0.f; acc[1][r] = 0.f; }
#pragma unroll
    for (int ks = 0; ks < 8; ++ks) {
      const bf16x8 bw = *reinterpret_cast<const bf16x8*>(Wg + (pb * 32 + r32) * 128 + ks * 16 + hi * 8);
#pragma unroll
      for (int db = 0; db < 2; ++db) {
        const bf16x8 a = *reinterpret_cast<const bf16x8*>(vnT + (g8 * 64 + db * 32 + r32) * 136 + ks * 16 + hi * 8);
        acc[db] = __builtin_amdgcn_mfma_f32_32x32x16_bf16(a, bw, acc[db], 0, 0, 0);
      }
    }
    const int token = t0 + pb * 32 + r32; const float bias = p.a_bs[g8 * 128 + pb * 32 + r32];
#pragma unroll
    for (int db = 0; db < 2; ++db)
#pragma unroll
      for (int rg = 0; rg < 4; ++rg) {
        const int c = g8 * 64 + db * 32 + rg * 8 + hi * 4;
        const u32x2 u2 = *reinterpret_cast<const u32x2*>(U + (size_t)token * 512 + c), z2 = *reinterpret_cast<const u32x2*>(ZA + (size_t)token * 512 + c);
        const float o0 = bflo(u2[0]) * (acc[db][rg * 4 + 0] + bias) * bflo(z2[0]), o1 = bfhi(u2[0]) * (acc[db][rg * 4 + 1] + bias) * bfhi(z2[0]);
        const float o2 = bflo(u2[1]) * (acc[db][rg * 4 + 2] + bias) * bflo(z2[1]), o3 = bfhi(u2[1]) * (acc[db][rg * 4 + 3] + bias) * bfhi(z2[1]);
        u32x2 pk = {cvtpk(o0, o1), cvtpk(o2, o3)};
        *reinterpret_cast<u32x2*>(MIX + (size_t)token * 1024 + c) = pk;
      }
  }
  __syncthreads();
}

DEVI void tr_tile(const float* __restrict__ src, bf16_t* __restrict__ dst, int K, int N, int tilesN, const float* __restrict__ scale, int t, char* lds) {
  const int tid = tidx();
  const int k0 = (t / tilesN) * 64, n0 = (t % tilesN) * 64;
  const int kr = tid >> 3, ng = (tid & 7) * 8;
  f32x4 v0 = {0.f, 0.f, 0.f, 0.f}, v1 = {0.f, 0.f, 0.f, 0.f};
  if (n0 + ng < N) { const float* s = src + (size_t)(k0 + kr) * N + n0 + ng; v0 = *reinterpret_cast<const f32x4*>(s); v1 = *reinterpret_cast<const f32x4*>(s + 4); }
  const float scv = scale ? scale[k0 + kr] : 1.f;
  bf16_t* tl = (bf16_t*)lds;
#pragma unroll
  for (int e = 0; e < 4; ++e) { tl[(ng + e) * 72 + kr] = f2bf(v0[e] * scv); tl[(ng + 4 + e) * 72 + kr] = f2bf(v1[e] * scv); }
  __syncthreads();
  const int n = tid >> 3, kc = (tid & 7) * 8;
  *reinterpret_cast<bf16x8*>(dst + (size_t)(n0 + n) * K + k0 + kc) = *reinterpret_cast<const bf16x8*>(tl + n * 72 + kc);
}

DEVI void phase0(const Params& p, char* lds) {
  const int tid = tidx();
  constexpr int N_ADA = 192, N_TR = 1952, N_WS = 16;
  for (int it = blockIdx.x; it < N_ADA + N_TR + N_WS + 1; it += gridDim.x) {
    if (it < N_ADA) {
      const int li = it / 96, chunk = it % 96;
      float* sc = (float*)lds;
      for (int idx = tid; idx < 17 * 1024; idx += 512) { const int r = idx >> 10, k = idx & 1023; const float xv = r < 16 ? p.c[r * 1024 + k] : p.c_ctx[k]; sc[idx] = xv / (1.f + expf(-xv)); }
      __syncthreads();
      const int col = tid & 31, kp = tid >> 5;
      const float* w = p.ada_w + (size_t)li * 1024 * 3072 + chunk * 32 + col;
      float acc[17];
#pragma unroll
      for (int r = 0; r < 17; ++r) acc[r] = 0.f;
      for (int k = kp * 64; k < kp * 64 + 64; ++k) {
        const float wv = w[(size_t)k * 3072];
#pragma unroll
        for (int r = 0; r < 17; ++r) acc[r] += sc[r * 1024 + k] * wv;
      }
      float* red = (float*)(lds + 17 * 1024 * 4);
#pragma unroll
      for (int r = 0; r < 17; ++r) red[(kp * 17 + r) * 32 + col] = acc[r];
      __syncthreads();
      float* ada = (float*)(p.ws + OFF_ADA);
      for (int idx = tid; idx < 544; idx += 512) {
        const int r = idx >> 5, cc = idx & 31; float s = 0.f;
        for (int k2 = 0; k2 < 16; ++k2) s += red[(k2 * 17 + r) * 32 + cc];
        ada[(size_t)(li * 17 + r) * 3072 + chunk * 32 + cc] = s + p.ada_b[li * 3072 + chunk * 32 + cc];
      }
    } else if (it < N_ADA + N_TR) {
      int t = it - N_ADA;
      if (t < 896) tr_tile(p.even_w_in, (bf16_t*)(p.ws + OFF_W0IN), 1024, 3584, 56, nullptr, t, lds);
      else if (t < 1152) tr_tile(p.even_w_out, (bf16_t*)(p.ws + OFF_W0OUT), 1024, 1024, 16, nullptr, t - 896, lds);
      else if (t < 1536) tr_tile(p.odd_w_in, (bf16_t*)(p.ws + OFF_W1IN), 1024, 1472, 24, nullptr, t - 1152, lds);
      else if (t < 1632) tr_tile(p.c_wq_b, (bf16_t*)(p.ws + OFF_WQ), 256, 1536, 24, p.c_q_norm_w, t - 1536, lds);
      else if (t < 1696) tr_tile(p.c_wkv_b, (bf16_t*)(p.ws + OFF_WKV), 128, 2048, 32, p.c_kv_norm_w, t - 1632, lds);
      else tr_tile(p.odd_w_out, (bf16_t*)(p.ws + OFF_W1OUT), 1024, 1024, 16, nullptr, t - 1696, lds);
    } else if (it < N_ADA + N_TR + N_WS) {
      const int base = (it - N_ADA - N_TR) * 8192 + tid * 16;
      bf16_t* dst = (bf16_t*)(p.ws + OFF_WSB) + base; const float* s = p.a_ws + base;
#pragma unroll
      for (int q = 0; q < 2; ++q) {
        const f32x4 a = *reinterpret_cast<const f32x4*>(s + q * 8), b = *reinterpret_cast<const f32x4*>(s + q * 8 + 4);
        u32x4 w = {cvtpk(a[0], a[1]), cvtpk(a[2], a[3]), cvtpk(b[0], b[1]), cvtpk(b[2], b[3])};
        *reinterpret_cast<u32x4*>(dst + q * 8) = w;
      }
    } else {
      float2* tab = (float2*)(p.ws + OFF_ROPE);
      for (int e = tid; e < 1024; e += 512) {
        const int pos = e >> 4, j = e & 15;
        const float inv = exp2f(-(float)j * (13.287712379549449f / 16.f));
        const float ang = (float)pos * inv;
        const float nrev = rintf(ang * 0.15915494309189535f);
        float rr = fmaf(-nrev, 6.2831855f, ang); rr = fmaf(-nrev, -1.7484555e-7f, rr);
        tab[e] = make_float2(__cosf(rr), __sinf(rr));
      }
    }
    __syncthreads();
  }
}

DEVI void norm_mod(const float* src_lat, const float* src_ctx, const float* __restrict__ nw, const float* __restrict__ ada, bf16_t* X) {
  const int tid_ = tidx(); const int wid = tid_ >> 6, lane = tid_ & 63;
  for (int row = blockIdx.x * 8 + wid; row < NTOK; row += gridDim.x * 8) {
    const float* src = row < NLAT ? src_lat + (size_t)row * 1024 : src_ctx + (size_t)(row - NLAT) * 1024;
    const float* ad = ada + (row < NLAT ? (row >> 11) : 16) * 3072;
    f32x4 v[4]; float ss = 0.f;
#pragma unroll
    for (int i = 0; i < 4; ++i) { v[i] = *reinterpret_cast<const f32x4*>(src + i * 256 + lane * 4); ss += v[i][0] * v[i][0] + v[i][1] * v[i][1] + v[i][2] * v[i][2] + v[i][3] * v[i][3]; }
#pragma unroll
    for (int sft = 32; sft >= 1; sft >>= 1) ss += __shfl_xor(ss, sft);
    const float r = rsqrtf(ss * (1.f / 1024.f) + 1e-6f);
#pragma unroll
    for (int i = 0; i < 4; ++i) {
      const int c = i * 256 + lane * 4;
      const f32x4 w = *reinterpret_cast<const f32x4*>(nw + c), sh = *reinterpret_cast<const f32x4*>(ad + c), scl = *reinterpret_cast<const f32x4*>(ad + 1024 + c);
      float o[4];
#pragma unroll
      for (int e = 0; e < 4; ++e) o[e] = v[i][e] * r * w[e] * (1.f + scl[e]) + sh[e];
      u32x2 pk = {cvtpk(o[0], o[1]), cvtpk(o[2], o[3])};
      *reinterpret_cast<u32x2*>(X + (size_t)row * 1024 + c) = pk;
    }
  }
}

DEVI void final_norm(float* out, const float* __restrict__ fw) {
  const int tid_ = tidx(); const int wid = tid_ >> 6, lane = tid_ & 63;
  for (int row = blockIdx.x * 8 + wid; row < NLAT; row += gridDim.x * 8) {
    float* src = out + (size_t)row * 1024;
    f32x4 v[4]; float ss = 0.f;
#pragma unroll
    for (int i = 0; i < 4; ++i) { v[i] = *reinterpret_cast<const f32x4*>(src + i * 256 + lane * 4); ss += v[i][0] * v[i][0] + v[i][1] * v[i][1] + v[i][2] * v[i][2] + v[i][3] * v[i][3]; }
#pragma unroll
    for (int sft = 32; sft >= 1; sft >>= 1) ss += __shfl_xor(ss, sft);
    const float r = rsqrtf(ss * (1.f / 1024.f) + 1e-6f);
#pragma unroll
    for (int i = 0; i < 4; ++i) {
      const int c = i * 256 + lane * 4;
      const f32x4 w = *reinterpret_cast<const f32x4*>(fw + c);
      f32x4 o;
#pragma unroll
      for (int e = 0; e < 4; ++e) o[e] = v[i][e] * r * w[e];
      *reinterpret_cast<f32x4*>(src + c) = o;
    }
  }
}

DEVI void run_phase(const Params& p, int ph, char* lds) {
  char* ws = p.ws;
  const float2* rope = (const float2*)(ws + OFF_ROPE);
  const float* ada0 = (const float*)(ws + OFF_ADA); const float* ada1 = ada0 + 17 * 3072;
  bf16_t* X = (bf16_t*)(ws + OFF_X); bf16_t* MIX = (bf16_t*)(ws + OFF_MIX);
  const int G = gridDim.x, B = blockIdx.x;
  switch (ph) {
    case 0: phase0(p, lds); break;
    case 1: norm_mod(p.x, p.ctx, p.norm_w, ada0, X); break;
    case 2: {
      EpiL0In epi{(bf16_t*)(ws + OFF_U), (bf16_t*)(ws + OFF_GV), (bf16_t*)(ws + OFF_ZA), (bf16_t*)(ws + OFF_ZB), (bf16_t*)(ws + OFF_Q0), (bf16_t*)(ws + OFF_K0), (bf16_t*)(ws + OFF_V0), rope};
      for (int it = B; it < 144 * 14; it += G) { int pm, pn; tile_of(it, 14, pm, pn); gemm_tile(X, 1024, (const bf16_t*)(ws + OFF_W0IN), 1024, 1024, pm * 256, pn * 256, lds, epi); }
    } break;
    case 3: {
      for (int it = B; it < 1024 + 288 + 128; it += G) {
        if (it < 1024) {
          const int xcd = it & 7, slot = (it >> 3) & 31, rd = it >> 8;
          const int bh = rd * 16 + xcd * 2 + (slot >> 4), qb = slot & 15, b = bh >> 2, h = bh & 3;
          attn0_item(p, b * 2048 + qb * 128, b, h, KVL, lds);
        } else if (it < 1024 + 288) abranch_item(p, it - 1024, lds);
        else { const int i2 = it - 1312; const int b = i2 >> 3, h = (i2 >> 1) & 3, qb = i2 & 1; attn0_item(p, NLAT + b * 256 + qb * 128, b, h, 256, lds); }
      }
    } break;
    case 4: {
      EpiOut<true> epi{p.x, p.ctx, p.out, (float*)(ws + OFF_H1C), ada0};
      for (int it = B; it < 144 * 4; it += G) { int pm, pn; tile_of(it, 4, pm, pn); gemm_tile(MIX, 1024, (const bf16_t*)(ws + OFF_W0OUT), 1024, 1024, pm * 256, pn * 256, lds, epi); }
    } break;
    case 5: norm_mod(p.out, (const float*)(ws + OFF_H1C), p.norm_w + 1024, ada1, X); break;
    case 6: {
      EpiL1In epi{(bf16_t*)(ws + OFF_CQ), (bf16_t*)(ws + OFF_CKV), (bf16_t*)(ws + OFF_K1), (bf16_t*)(ws + OFF_Z1), (float*)(ws + OFF_RQ), (float*)(ws + OFF_RKV), rope, (float*)(lds + LDS_SS)};
      for (int it = B; it < 768 + 16; it += G) {
        int pm, pn; if (it < 768) tile_of(it, 6, pm, pn); else { pm = 128 + (it - 768); pn = 1; }
        gemm_tile(X, 1024, (const bf16_t*)(ws + OFF_W1IN), 1024, 1024, pm * 256, pn * 256, lds, epi);
      }
    } break;
    case 7: {
      EpiQ eq{(bf16_t*)(ws + OFF_Q1), (const float*)(ws + OFF_RQ), rope};
      EpiKV ek{(bf16_t*)(ws + OFF_K1), (bf16_t*)(ws + OFF_V1), (const float*)(ws + OFF_RKV)};
      for (int it = B; it < 768 + 1152; it += G) {
        int pm, pn;
        if (it < 768) { tile_of(it, 6, pm, pn); gemm_tile((const bf16_t*)(ws + OFF_CQ), 256, (const bf16_t*)(ws + OFF_WQ), 256, 256, pm * 256, pn * 256, lds, eq); }
        else { tile_of(it - 768, 8, pm, pn); gemm_tile((const bf16_t*)(ws + OFF_CKV), 128, (const bf16_t*)(ws + OFF_WKV), 128, 128, pm * 256, pn * 256, lds, ek); }
      }
    } break;
    case 8: {
      for (int it = B; it < 1024; it += G) {
        const int xcd = it & 7, slot = (it >> 3) & 31, rd = it >> 8;
        const int bh = rd * 32 + xcd * 4 + (slot >> 3), qb = slot & 7;
        attn1_item(p, bh >> 3, bh & 7, qb, lds);
      }
    } break;
    case 9: {
      EpiOut<false> epi{p.out, p.out, p.out, p.out, ada1};
      for (int it = B; it < 128 * 4; it += G) { int pm, pn; tile_of(it, 4, pm, pn); gemm_tile(MIX, 1024, (const bf16_t*)(ws + OFF_W1OUT), 1024, 1024, pm * 256, pn * 256, lds, epi); }
    } break;
    case 10: final_norm(p.out, p.final_w); break;
  }
}

extern __shared__ __attribute__((aligned(16))) char g_lds[];

__global__ void __launch_bounds__(512) mega(Params p) {
  cg::grid_group grid = cg::this_grid();
  for (int ph = p.ph_lo; ph < p.ph_hi; ++ph) {
    run_phase(p, ph, g_lds);
    if (ph + 1 < p.ph_hi) grid.sync();
  }
}

extern "C" void kernel_launch(void* const* d_in, const int* in_sizes, int n_in, void* d_out, int out_size, void* d_ws, size_t ws_size, hipStream_t stream) {
  static int ok = 0;
  static int grid_blocks = 0;
  if (!ok) {
    if (n_in != 25 || ws_size < WS_NEED) { fprintf(stderr, "kernel_launch: bad args n_in %d ws %zu need %zu\n", n_in, ws_size, (size_t)WS_NEED); return; }
    if (hipFuncSetAttribute((const void*)mega, hipFuncAttributeMaxDynamicSharedMemorySize, LDS_BYTES) != hipSuccess) { fprintf(stderr, "kernel_launch: LDS attr failed\n"); return; }
    int dev = 0, cus = 0, per_cu = 0;
    hipGetDevice(&dev);
    hipDeviceGetAttribute(&cus, hipDeviceAttributeMultiprocessorCount, dev);
    hipOccupancyMaxActiveBlocksPerMultiprocessor(&per_cu, mega, 512, LDS_BYTES);
    if (per_cu < 1) per_cu = 1;
    grid_blocks = cus * per_cu;
    ok = 1;
  }
  Params p{};
  const float** pp = (const float**)&p;
  for (int i = 0; i < 25; ++i) pp[i] = (const float*)d_in[i];
  p.out = (float*)d_out; p.ws = (char*)d_ws;
#if ONE_LAUNCH
  p.ph_lo = 0; p.ph_hi = 11;
  void* args[] = {&p};
  hipError_t e = hipLaunchCooperativeKernel((const void*)mega, dim3(grid_blocks), dim3(512), args, LDS_BYTES, stream);
  if (e != hipSuccess) fprintf(stderr, "cooperative launch failed: %s (grid %d)\n", hipGetErrorString(e), grid_blocks);
#else
  for (int ph = 0; ph < 11; ++ph) {
    p.ph_lo = ph; p.ph_hi = ph + 1;
    hipLaunchKernelGGL(mega, dim3(grid_blocks), dim3(512), LDS_BYTES, stream, p);
  }
#endif
}
```

```cpp
#include <hip/hip_runtime.h>
#include <hip/hip_cooperative_groups.h>
#include <cstdio>
namespace cg = cooperative_groups;

#ifndef ONE_LAUNCH
#define ONE_LAUNCH 1
#endif

typedef unsigned short bf16_t;
typedef short bf16x8 __attribute__((ext_vector_type(8)));
typedef short s16x4 __attribute__((ext_vector_type(4)));
typedef float f32x16 __attribute__((ext_vector_type(16)));
typedef float f32x4 __attribute__((ext_vector_type(4)));
typedef unsigned u32x4 __attribute__((ext_vector_type(4)));
typedef unsigned u32x2 __attribute__((ext_vector_type(2)));
#define DEVI __device__ __forceinline__
#define SBAR() __builtin_amdgcn_sched_barrier(0)
DEVI int tidx() { int t = threadIdx.x; asm volatile("" : "+v"(t)); return t; }

constexpr int NLAT = 32768, NCTX = 4096, NTOK = 36864, KVL = 2304;
constexpr int LDS_BYTES = 147456, LDS_SS = 139264;

constexpr size_t OFF_W0IN = 0;
constexpr size_t OFF_W0OUT = OFF_W0IN + 3584ull * 1024 * 2;
constexpr size_t OFF_W1IN = OFF_W0OUT + 1024ull * 1024 * 2;
constexpr size_t OFF_WQ = OFF_W1IN + 1536ull * 1024 * 2;
constexpr size_t OFF_WKV = OFF_WQ + 1536ull * 256 * 2;
constexpr size_t OFF_W1OUT = OFF_WKV + 2048ull * 128 * 2;
constexpr size_t OFF_WSB = OFF_W1OUT + 1024ull * 1024 * 2;
constexpr size_t OFF_ADA = OFF_WSB + 8ull * 128 * 128 * 2;
constexpr size_t OFF_ROPE = OFF_ADA + 2ull * 17 * 3072 * 4;
constexpr size_t OFF_BAR = OFF_ROPE + 64ull * 16 * 8;
constexpr size_t OFF_H1C = OFF_BAR + 16384;
constexpr size_t OFF_RQ = OFF_H1C + 4096ull * 1024 * 4;
constexpr size_t OFF_RKV = OFF_RQ + 32768ull * 4;
constexpr size_t OFF_X = OFF_RKV + 36864ull * 4;
constexpr size_t OFF_MIX = OFF_X + 36864ull * 1024 * 2;
constexpr size_t OFF_T = OFF_MIX + 36864ull * 1024 * 2;
constexpr size_t SZ_HALF = 36864ull * 512 * 2;
constexpr size_t OFF_U = OFF_T, OFF_GV = OFF_U + SZ_HALF, OFF_ZA = OFF_GV + SZ_HALF, OFF_ZB = OFF_ZA + SZ_HALF, OFF_Q0 = OFF_ZB + SZ_HALF;
constexpr size_t OFF_K0 = OFF_Q0 + SZ_HALF, OFF_V0 = OFF_K0 + 16ull * 4 * KVL * 128 * 2, END_L0 = OFF_V0 + 16ull * 4 * KVL * 128 * 2;
constexpr size_t OFF_CQ = OFF_T, OFF_CKV = OFF_CQ + 32768ull * 256 * 2, OFF_Z1 = OFF_CKV + 36864ull * 128 * 2;
constexpr size_t OFF_Q1 = OFF_Z1 + 32768ull * 1024 * 2, OFF_K1 = OFF_Q1 + 32768ull * 1536 * 2, END_L1 = OFF_K1 + 16ull * 8 * KVL * 192 * 2;
constexpr size_t OFF_V1 = OFF_X;
constexpr size_t WS_NEED = END_L1 > END_L0 ? END_L1 : END_L0;

struct Params {
  const float *x, *c, *ctx, *c_ctx, *norm_w, *ada_w, *ada_b, *even_w_in, *a_ws, *a_bs, *a_ln_w, *a_ln_b,
      *b_lq1, *b_lk1, *b_lq2, *b_lk2, *b_subln_w, *even_w_out, *odd_w_in, *c_q_norm_w, *c_wq_b,
      *c_kv_norm_w, *c_wkv_b, *odd_w_out, *final_w;
  float* out; char* ws; int ph_lo, ph_hi;
};

DEVI unsigned cvtpk(float lo, float hi) { unsigned r; asm("v_cvt_pk_bf16_f32 %0, %1, %2" : "=v"(r) : "v"(lo), "v"(hi)); return r; }
DEVI bf16_t f2bf(float v) { return (bf16_t)(cvtpk(v, 0.f) & 0xffffu); }
DEVI float bf2f(bf16_t v) { return __uint_as_float(((unsigned)v) << 16); }
DEVI float bflo(unsigned w) { return __uint_as_float(w << 16); }
DEVI float bfhi(unsigned w) { return __uint_as_float(w & 0xffff0000u); }
DEVI int crow(int r, int hi) { return (r & 3) + 8 * (r >> 2) + 4 * hi; }
DEVI float silu_f(float x) { return x / (1.f + __expf(-x)); }
DEVI float gelu_f(float x) { return 0.5f * x * (1.f + erff(x * 0.70710678118654752f)); }

DEVI void rope_tile(f32x16& v, const float2* __restrict__ tab, int pos, int hi) {
#pragma unroll
  for (int r = 0; r < 8; ++r) {
    const int jf = (r & 3) + 8 * (r >> 2) + 4 * hi;
    const float2 cs = tab[pos * 16 + jf];
    const float a = v[r], b = v[r + 8];
    v[r] = a * cs.x - b * cs.y; v[r + 8] = b * cs.x + a * cs.y;
  }
}
DEVI void store4(bf16_t* dst, const f32x16& v, int rg) {
  u32x2 pk = {cvtpk(v[rg * 4 + 0], v[rg * 4 + 1]), cvtpk(v[rg * 4 + 2], v[rg * 4 + 3])};
  *reinterpret_cast<u32x2*>(dst) = pk;
}

#define PG8_LAS __attribute__((address_space(3)))
constexpr int HTB = 128 * 64 * 2;
DEVI int lds_byte(int r, int c) { const int st = (r >> 4) * 2 + (c >> 5), rr = r & 15, cc = c & 31, ob = rr * 64 + cc * 2; return st * 1024 + (ob ^ (((ob >> 9) & 1) << 5)); }
DEVI void stage_rc(int b, int& R, int& C) { const int st = b / 1024, sb = b % 1024, swz = sb ^ (((sb >> 9) & 1) << 5); R = (st >> 1) * 16 + swz / 64; C = (st & 1) * 32 + (swz % 64) / 2; }
struct Unit { int pm, pn; };
struct Sched {
  int nN, nmain, ntotal, xpm0, xpn;
  DEVI bool next(int i, Unit& u) const {
    const int it = blockIdx.x + i * gridDim.x; if (it >= ntotal) return false;
    if (it < nmain) { const int xcd = it & 7, jx = it >> 3; u.pm = (jx / nN) * 8 + xcd; u.pn = jx % nN; } else { u.pm = xpm0 + (it - nmain); u.pn = xpn; }
    return true;
  }
};
template <class Epi>
DEVI void gemm_phase(PG8_LAS unsigned char* lds, const bf16_t* gA, const bf16_t* gBt, const int K, const Sched& S, const Epi& E) {
  const int tid = tidx(), wid = __builtin_amdgcn_readfirstlane(tid >> 6), lane = tid & 63, wr = wid >> 2, wc = wid & 3, fr = lane & 15, fq = lane >> 4;
  const int nt = K / 64;
  unsigned voffA[2], voffB[2];
#pragma unroll
  for (int i = 0; i < 2; ++i) { int R, C; stage_rc(tid * 16 + i * 8192, R, C); voffA[i] = (unsigned)(R * K + C) * 2u; voffB[i] = voffA[i]; }
  const size_t kstep = (size_t)(64 * 2);
  const size_t hstep = (size_t)128 * K * 2;
  const size_t tstep = 2 * hstep;
  const unsigned ldsw = (unsigned)wid * 1024u;
  const int aoff = lds_byte(wr * 64 + fr, fq * 8), boff = lds_byte(wc * 32 + fr, fq * 8);
#define PG8_SA(b, h) (((b) * 2 + (h)) * HTB)
#define PG8_SB(b, h) ((4 + (b) * 2 + (h)) * HTB)
#define PG8_STAGE(bufoff, gbase, voff) do { _Pragma("unroll") for (int _i = 0; _i < 2; ++_i) \
    __builtin_amdgcn_global_load_lds((const unsigned*)((const char*)(gbase) + (voff)[_i]), (PG8_LAS unsigned*)(lds + (bufoff) + ldsw + _i * 8192), 16, 0, 0); } while (0)
#define PG8_LDA(dst, b, h) do { _Pragma("unroll") for (int m = 0; m < 4; ++m) _Pragma("unroll") for (int k = 0; k < 2; ++k) dst[m][k] = *(const PG8_LAS bf16x8*)(lds + PG8_SA(b, h) + aoff + m * 2048 + k * 1024); } while (0)
#define PG8_LDB(dst, b, h) do { _Pragma("unroll") for (int n = 0; n < 2; ++n) _Pragma("unroll") for (int k = 0; k < 2; ++k) dst[n][k] = *(const PG8_LAS bf16x8*)(lds + PG8_SB(b, h) + boff + n * 2048 + k * 1024); } while (0)
#define PG8_MMA(ai, bj, At, Bt) do { __builtin_amdgcn_s_setprio(1); _Pragma("unroll") for (int m = 0; m < 4; ++m) _Pragma("unroll") for (int n = 0; n < 2; ++n) _Pragma("unroll") for (int k = 0; k < 2; ++k) \
    acc[ai][bj][m][n] = __builtin_amdgcn_mfma_f32_16x16x32_bf16(Bt[n][k], At[m][k], acc[ai][bj][m][n], 0, 0, 0); __builtin_amdgcn_s_setprio(0); } while (0)
#define PG8_WAIT_V(n) asm volatile("s_waitcnt vmcnt(" #n ")" ::: "memory")
#define PG8_WAIT_L(n) asm volatile("s_waitcnt lgkmcnt(" #n ")" ::: "memory")
#define PG8_BAR __builtin_amdgcn_s_barrier()
#define PG8_SCHED __builtin_amdgcn_sched_barrier(0)
  Unit cur, nxt; int ui = 0;
  if (!S.next(0, cur)) return;
  f32x4 acc[2][2][4][2];
#pragma unroll
  for (int a = 0; a < 2; ++a)
#pragma unroll
    for (int b = 0; b < 2; ++b)
#pragma unroll
      for (int m = 0; m < 4; ++m)
#pragma unroll
        for (int n = 0; n < 2; ++n) acc[a][b][m][n] = (f32x4){0.f, 0.f, 0.f, 0.f};
  bf16x8 At[4][2], B0[2][2], B1[2][2];
  const char* cA = (const char*)gA + (size_t)cur.pm * tstep; const char* cB = (const char*)gBt + (size_t)cur.pn * tstep;
  PG8_STAGE(PG8_SB(0, 0), cB, voffB); PG8_STAGE(PG8_SA(0, 0), cA, voffA); PG8_STAGE(PG8_SB(0, 1), cB + hstep, voffB); PG8_STAGE(PG8_SA(0, 1), cA + hstep, voffA);
  if (wr == 1) PG8_BAR;
  PG8_WAIT_V(4); PG8_BAR;
  PG8_STAGE(PG8_SB(1, 0), cB + kstep, voffB); PG8_STAGE(PG8_SA(1, 0), cA + kstep, voffA); PG8_STAGE(PG8_SB(1, 1), cB + hstep + kstep, voffB);
  PG8_WAIT_V(6); PG8_BAR;
  for (;;) {
    const bool has_next = S.next(ui + 1, nxt);
    const char* nA = has_next ? (const char*)gA + (size_t)nxt.pm * tstep : cA; const char* nB = has_next ? (const char*)gBt + (size_t)nxt.pn * tstep : cB;
#pragma unroll 1
    for (int t = 0; t < nt; t += 2) {
      const bool last = (t == nt - 2);
      const char* a1 = cA + (size_t)(t + 1) * kstep;
      const char* a2 = last ? nA : cA + (size_t)(t + 2) * kstep; const char* b2 = last ? nB : cB + (size_t)(t + 2) * kstep;
      const char* a3 = a2 + kstep; const char* b3 = b2 + kstep;
      PG8_LDB(B0, 0, 0); PG8_SCHED; PG8_LDA(At, 0, 0); PG8_STAGE(PG8_SA(1, 1), a1 + hstep, voffA);
      PG8_WAIT_L(8); PG8_BAR; PG8_WAIT_L(0); PG8_MMA(0, 0, At, B0); PG8_BAR; PG8_SCHED;
      PG8_LDB(B1, 0, 1); PG8_STAGE(PG8_SB(0, 0), b2, voffB);
      PG8_BAR; PG8_WAIT_L(0); PG8_MMA(0, 1, At, B1); PG8_BAR;
      PG8_LDA(At, 0, 1); PG8_STAGE(PG8_SA(0, 0), a2, voffA);
      PG8_BAR; PG8_WAIT_L(0); PG8_MMA(1, 0, At, B0); PG8_BAR; PG8_SCHED;
      PG8_STAGE(PG8_SB(0, 1), b2 + hstep, voffB);
      PG8_WAIT_V(6); PG8_BAR; PG8_MMA(1, 1, At, B1); PG8_BAR;
      PG8_LDB(B0, 1, 0); PG8_SCHED; PG8_LDA(At, 1, 0); PG8_STAGE(PG8_SA(0, 1), a2 + hstep, voffA);
      PG8_WAIT_L(8); PG8_BAR; PG8_WAIT_L(0); PG8_MMA(0, 0, At, B0); PG8_BAR; PG8_SCHED;
      PG8_LDB(B1, 1, 1); PG8_STAGE(PG8_SB(1, 0), b3, voffB);
      PG8_BAR; PG8_WAIT_L(0); PG8_MMA(0, 1, At, B1); PG8_BAR;
      PG8_LDA(At, 1, 1); PG8_STAGE(PG8_SA(1, 0), a3, voffA);
      PG8_BAR; PG8_WAIT_L(0); PG8_MMA(1, 0, At, B0); PG8_BAR; PG8_SCHED;
      PG8_STAGE(PG8_SB(1, 1), b3 + hstep, voffB);
      PG8_WAIT_V(6); PG8_BAR; PG8_MMA(1, 1, At, B1); PG8_BAR;
    }
    E(acc, cur, wr, wc, fr, fq);
    if (!has_next) break;
#pragma unroll
    for (int a = 0; a < 2; ++a)
#pragma unroll
      for (int b = 0; b < 2; ++b)
#pragma unroll
        for (int m = 0; m < 4; ++m)
#pragma unroll
          for (int n = 0; n < 2; ++n) acc[a][b][m][n] = (f32x4){0.f, 0.f, 0.f, 0.f};
    cur = nxt; cA = nA; cB = nB; ++ui;
  }
  PG8_WAIT_V(0);
  if (wr == 0) PG8_BAR;
  PG8_BAR;
#undef PG8_SA
#undef PG8_SB
#undef PG8_STAGE
#undef PG8_LDA
#undef PG8_LDB
#undef PG8_MMA
#undef PG8_WAIT_V
#undef PG8_WAIT_L
#undef PG8_BAR
#undef PG8_SCHED
}

typedef f32x4 acc_t[2][2][4][2];
DEVI void token_info(int token, bool ctx, int& b, int& s, int& key) {
  if (!ctx) { b = token >> 11; s = token & 2047; key = 256 + s; } else { const int tc = token - NLAT; b = tc >> 8; s = 0; key = tc & 255; }
}
DEVI void rope_pair(f32x4& lo, f32x4& hi2, const float2* __restrict__ tab, int pos, int fq) {
  const f32x4 t0 = *reinterpret_cast<const f32x4*>(tab + pos * 16 + fq * 4), t1 = *reinterpret_cast<const f32x4*>(tab + pos * 16 + fq * 4 + 2);
  const float cs[4] = {t0[0], t0[2], t1[0], t1[2]}, sn[4] = {t0[1], t0[3], t1[1], t1[3]};
#pragma unroll
  for (int e = 0; e < 4; ++e) { const float a = lo[e], b = hi2[e]; lo[e] = a * cs[e] - b * sn[e]; hi2[e] = b * cs[e] + a * sn[e]; }
}
DEVI void st4(bf16_t* dst, const f32x4& v) { u32x2 pk = {cvtpk(v[0], v[1]), cvtpk(v[2], v[3])}; *reinterpret_cast<u32x2*>(dst) = pk; }

struct EpiL0In {
  bf16_t *U, *GV, *ZA, *ZB, *Q0, *K0, *V0; const float2* rope;
  DEVI void operator()(acc_t& acc, const Unit& u, int wr, int wc, int fr, int fq) const {
    const int col0 = u.pn * 256, type = col0 >> 9; const bool ctx = u.pm >= 128;
#pragma unroll
    for (int ai = 0; ai < 2; ++ai)
#pragma unroll
      for (int m = 0; m < 4; ++m) {
        const int token = u.pm * 256 + ai * 128 + wr * 64 + m * 16 + fr;
        int b, s, key; token_info(token, ctx, b, s, key);
#pragma unroll
        for (int bj = 0; bj < 2; ++bj) {
          const int nl = (col0 & 511) + bj * 128 + wc * 32;
          f32x4 v0 = acc[ai][bj][m][0], v1 = acc[ai][bj][m][1];
          bf16_t* dst;
          if (type <= 1) {
#pragma unroll
            for (int e = 0; e < 4; ++e) { v0[e] = gelu_f(v0[e]); v1[e] = gelu_f(v1[e]); }
            dst = (type == 0 ? U : GV) + (size_t)token * 512 + nl;
          } else if (type == 2 || type == 6) {
#pragma unroll
            for (int e = 0; e < 4; ++e) { v0[e] = silu_f(v0[e]); v1[e] = silu_f(v1[e]); }
            dst = (type == 2 ? ZA : ZB) + (size_t)token * 512 + nl;
          } else if (type == 3) {
            if (!ctx) rope_pair(v0, v1, rope, (wc & 1) ? (s & 63) : (s >> 6), fq);
            dst = Q0 + (size_t)token * 512 + nl;
          } else if (type == 4) {
            if (!ctx) rope_pair(v0, v1, rope, (wc & 1) ? (s & 63) : (s >> 6), fq);
            dst = K0 + ((size_t)(b * 4 + (nl >> 7)) * KVL + key) * 128 + (nl & 127);
          } else {
            dst = V0 + ((size_t)(b * 4 + (nl >> 7)) * KVL + key) * 128 + (nl & 127);
          }
          st4(dst + fq * 4, v0); st4(dst + 16 + fq * 4, v1);
        }
      }
  }
};

template <bool HASCTX> struct EpiOut {
  const float* src_lat; const float* src_ctx; float* dst_lat; float* dst_ctx; const float* ada;
  DEVI void operator()(acc_t& acc, const Unit& u, int wr, int wc, int fr, int fq) const {
    const int col0 = u.pn * 256;
#pragma unroll
    for (int ai = 0; ai < 2; ++ai)
#pragma unroll
      for (int m = 0; m < 4; ++m) {
        const int token = u.pm * 256 + ai * 128 + wr * 64 + m * 16 + fr;
        const float* src; float* dst; const float* gate;
        if (!HASCTX || token < NLAT) { src = src_lat + (size_t)token * 1024; dst = dst_lat + (size_t)token * 1024; gate = ada + (token >> 11) * 3072 + 2048; }
        else { const int tc = token - NLAT; src = src_ctx + (size_t)tc * 1024; dst = dst_ctx + (size_t)tc * 1024; gate = ada + 16 * 3072 + 2048; }
#pragma unroll
        for (int bj = 0; bj < 2; ++bj)
#pragma unroll
          for (int n = 0; n < 2; ++n) {
            const int c = col0 + bj * 128 + wc * 32 + n * 16 + fq * 4;
            const f32x4 xv = *reinterpret_cast<const f32x4*>(src + c), g = *reinterpret_cast<const f32x4*>(gate + c);
            *reinterpret_cast<f32x4*>(dst + c) = xv + g * acc[ai][bj][m][n];
          }
      }
  }
};

struct EpiL1In {
  bf16_t *CQ, *CKV, *K1, *Z1; float *RQ, *RKV; const float2* rope; float* ssb;
  DEVI void operator()(acc_t& acc, const Unit& u, int wr, int wc, int fr, int fq) const {
    const int col0 = u.pn * 256; const bool ctx = u.pm >= 128;
    float ss[2][4];
#pragma unroll
    for (int ai = 0; ai < 2; ++ai)
#pragma unroll
      for (int m = 0; m < 4; ++m) {
        ss[ai][m] = 0.f;
        const int token = u.pm * 256 + ai * 128 + wr * 64 + m * 16 + fr;
        int b, s, key; token_info(token, ctx, b, s, key);
#pragma unroll
        for (int bj = 0; bj < 2; ++bj) {
          const int nb = col0 + bj * 128 + wc * 32;
          f32x4 v0 = acc[ai][bj][m][0], v1 = acc[ai][bj][m][1];
          if (nb < 384) {
#pragma unroll
            for (int e = 0; e < 4; ++e) ss[ai][m] += v0[e] * v0[e] + v1[e] * v1[e];
            bf16_t* dst = nb < 256 ? CQ + (size_t)token * 256 + nb : CKV + (size_t)token * 128 + (nb - 256);
            st4(dst + fq * 4, v0); st4(dst + 16 + fq * 4, v1);
          } else if (nb < 448) {
            if (!ctx) rope_pair(v0, v1, rope, (nb >= 416) ? (s & 63) : (s >> 6), fq);
#pragma unroll
            for (int h = 0; h < 8; ++h) {
              bf16_t* dst = K1 + ((size_t)(b * 8 + h) * KVL + key) * 192 + 128 + (nb - 384);
              st4(dst + fq * 4, v0); st4(dst + 16 + fq * 4, v1);
            }
          } else if (nb < 1472) {
            if (!ctx) {
#pragma unroll
              for (int e = 0; e < 4; ++e) { v0[e] = silu_f(v0[e]); v1[e] = silu_f(v1[e]); }
              bf16_t* dst = Z1 + (size_t)token * 1024 + (nb - 448);
              st4(dst + fq * 4, v0); st4(dst + 16 + fq * 4, v1);
            }
          }
        }
      }
    if (u.pn <= 1) {
#pragma unroll
      for (int ai = 0; ai < 2; ++ai)
#pragma unroll
        for (int m = 0; m < 4; ++m) {
          float sv = ss[ai][m]; sv += __shfl_xor(sv, 16); sv += __shfl_xor(sv, 32);
          if (fq == 0) ssb[wc * 256 + ai * 128 + wr * 64 + m * 16 + fr] = sv;
        }
      asm volatile("s_waitcnt lgkmcnt(0)" ::: "memory"); __builtin_amdgcn_s_barrier(); asm volatile("" ::: "memory");
      const int lt = wc * 64 + fq * 16 + fr;
      if (lt < 128) {
        const int row = (lt >> 6) * 128 + wr * 64 + (lt & 63);
        if (u.pn == 0) { const float tot = (ssb[row] + ssb[256 + row]) + (ssb[512 + row] + ssb[768 + row]); RQ[u.pm * 256 + row] = rsqrtf(tot * (1.f / 256.f) + 1e-6f); }
        else { const float tot = (ssb[row] + ssb[256 + row]) + (ssb[512 + row] + ssb[768 + row]); RKV[u.pm * 256 + row] = rsqrtf(tot * (1.f / 128.f) + 1e-6f); }
      }
    }
  }
};

struct EpiQ {
  bf16_t* Q1; const float* RQ; const float2* rope;
  DEVI void operator()(acc_t& acc, const Unit& u, int wr, int wc, int fr, int fq) const {
    const int col0 = u.pn * 256;
#pragma unroll
    for (int ai = 0; ai < 2; ++ai)
#pragma unroll
      for (int m = 0; m < 4; ++m) {
        const int token = u.pm * 256 + ai * 128 + wr * 64 + m * 16 + fr; const int s = token & 2047; const float rq = RQ[token];
#pragma unroll
        for (int bj = 0; bj < 2; ++bj) {
          const int n0 = col0 + bj * 128 + wc * 32; const int dd0 = n0 % 192;
          f32x4 v0 = acc[ai][bj][m][0] * rq, v1 = acc[ai][bj][m][1] * rq;
          if (dd0 >= 128) rope_pair(v0, v1, rope, (dd0 >= 160) ? (s & 63) : (s >> 6), fq);
          bf16_t* dst = Q1 + (size_t)token * 1536 + n0;
          st4(dst + fq * 4, v0); st4(dst + 16 + fq * 4, v1);
        }
      }
  }
};

struct EpiKV {
  bf16_t *K1, *V1; const float* RKV;
  DEVI void operator()(acc_t& acc, const Unit& u, int wr, int wc, int fr, int fq) const {
    const int col0 = u.pn * 256; const bool ctx = u.pm >= 128;
#pragma unroll
    for (int ai = 0; ai < 2; ++ai)
#pragma unroll
      for (int m = 0; m < 4; ++m) {
        const int token = u.pm * 256 + ai * 128 + wr * 64 + m * 16 + fr; const float rk = RKV[token];
        int b, s, key; token_info(token, ctx, b, s, key);
#pragma unroll
        for (int bj = 0; bj < 2; ++bj) {
          const int nb = col0 + bj * 128 + wc * 32; const int h = nb >> 8, dd = nb & 255;
          const f32x4 v0 = acc[ai][bj][m][0] * rk, v1 = acc[ai][bj][m][1] * rk;
          bf16_t* dst = dd < 128 ? K1 + ((size_t)(b * 8 + h) * KVL + key) * 192 + dd : V1 + ((size_t)(b * 8 + h) * KVL + key) * 128 + (dd - 128);
          st4(dst + fq * 4, v0); st4(dst + 16 + fq * 4, v1);
        }
      }
  }
};

template <int SCID> struct ScaleOf { static constexpr float v = SCID == 0 ? 0.125f : 0.07216878364870322f; };
constexpr float THR = 8.f;
template <int KW> DEVI int kswz(int row, int colB) { return row * (KW * 2 + 16) + colB; }
DEVI int v_st(int k, int c) { const int kk = (k & ~0xC) | ((k & 4) << 1) | ((k & 8) >> 1); return ((kk >> 3) * 4 + (c >> 5)) * 512 + ((kk & 7) * 32 + (c & 31)) * 2; }
DEVI int v_rd_base(int lane) { return ((lane & 3) << 3) | (((lane >> 2) & 3) << 6) | (((lane >> 4) & 1) << 5) | (((lane >> 5) & 1) << 8); }
constexpr int v_rd_off(int d0, int ks, int half) { return d0 * 512 + ks * 4096 + half * 2048; }
template <int OFF> DEVI s16x4 tr_read(int vb) { s16x4 r; asm volatile("ds_read_b64_tr_b16 %0, %1 offset:%2" : "=&v"(r) : "v"(vb), "i"(OFF) : "memory"); return r; }

template <int SCID>
DEVI void partialSM(f32x16& p0, f32x16& p1, float& m_reg, float& mn, float& alpha) {
  constexpr float SC = ScaleOf<SCID>::v; constexpr float C = SC * 1.4426950408889634f;
  float pmax = p0[0];
#pragma unroll
  for (int r = 1; r < 16; ++r) pmax = fmaxf(pmax, p0[r]);
#pragma unroll
  for (int r = 0; r < 16; ++r) pmax = fmaxf(pmax, p1[r]);
  { auto rr = __builtin_amdgcn_permlane32_swap(__float_as_uint(pmax), __float_as_uint(pmax), false, false);
    pmax = fmaxf(__uint_as_float(rr[0]), __uint_as_float(rr[1])); }
  if (__builtin_expect(__all(pmax - m_reg <= THR / SC), 1)) { mn = m_reg; alpha = 1.f; }
  else { mn = fmaxf(m_reg, pmax); alpha = __builtin_amdgcn_exp2f((m_reg - mn) * C); m_reg = mn; }
  const float mnC = -mn * C;
#pragma unroll
  for (int r = 0; r < 16; ++r) p0[r] = fmaf(p0[r], C, mnC);
#pragma unroll
  for (int r = 0; r < 16; ++r) p1[r] = fmaf(p1[r], C, mnC);
#pragma unroll
  for (int r = 0; r < 16; ++r) p0[r] = __builtin_amdgcn_exp2f(p0[r]);
}
DEVI void finishSM(f32x16& p0, f32x16& p1, float alpha, float& l_reg, bf16x8& pa0, bf16x8& pa1, bf16x8& pa2, bf16x8& pa3) {
#pragma unroll
  for (int r = 0; r < 16; ++r) p1[r] = __builtin_amdgcn_exp2f(p1[r]);
  float ps = 0;
#pragma unroll
  for (int r = 0; r < 16; ++r) ps += p0[r];
#pragma unroll
  for (int r = 0; r < 16; ++r) ps += p1[r];
  { auto rr = __builtin_amdgcn_permlane32_swap(__float_as_uint(ps), __float_as_uint(ps), false, false);
    ps = __uint_as_float(rr[0]) + __uint_as_float(rr[1]); }
  l_reg = l_reg * alpha + ps;
#define PK4(P, BASE, OUT) do { unsigned a0 = cvtpk(P[BASE + 0], P[BASE + 1]), a1 = cvtpk(P[BASE + 2], P[BASE + 3]); \
    unsigned b0 = cvtpk(P[BASE + 4], P[BASE + 5]), b1 = cvtpk(P[BASE + 6], P[BASE + 7]); \
    auto r0 = __builtin_amdgcn_permlane32_swap(a0, b0, false, false); auto r1 = __builtin_amdgcn_permlane32_swap(a1, b1, false, false); \
    u32x4 w = {r0[0], r1[0], r0[1], r1[1]}; OUT = *reinterpret_cast<bf16x8*>(&w); } while (0)
  PK4(p0, 0, pa0); PK4(p0, 8, pa1); PK4(p1, 0, pa2); PK4(p1, 8, pa3);
#undef PK4
}
template <int KW, int NQ>
DEVI void qkt(f32x16& p0, f32x16& p1, const char* Ks, const bf16x8* qr, int kcol0, int r32, int hi) {
#pragma unroll
  for (int r = 0; r < 16; ++r) { p0[r] = 0.f; p1[r] = 0.f; }
#pragma unroll
  for (int d0 = 0; d0 < NQ; ++d0) {
    const int cb = (kcol0 + d0 * 16 + hi * 8) * 2;
    const bf16x8 b0 = *reinterpret_cast<const bf16x8*>(Ks + kswz<KW>(r32, cb));
    const bf16x8 b1 = *reinterpret_cast<const bf16x8*>(Ks + kswz<KW>(32 + r32, cb));
    p0 = __builtin_amdgcn_mfma_f32_32x32x16_bf16(b0, qr[d0], p0, 0, 0, 0);
    p1 = __builtin_amdgcn_mfma_f32_32x32x16_bf16(b1, qr[d0], p1, 0, 0, 0);
  }
}
template <int D0> DEVI void pv_one(f32x16& od, int vb, bf16x8 pa0, bf16x8 pa1, bf16x8 pa2, bf16x8 pa3) {
  const s16x4 l0 = tr_read<v_rd_off(D0, 0, 0)>(vb), h0 = tr_read<v_rd_off(D0, 0, 1)>(vb), l1 = tr_read<v_rd_off(D0, 1, 0)>(vb), h1 = tr_read<v_rd_off(D0, 1, 1)>(vb);
  const s16x4 l2 = tr_read<v_rd_off(D0, 2, 0)>(vb), h2 = tr_read<v_rd_off(D0, 2, 1)>(vb), l3 = tr_read<v_rd_off(D0, 3, 0)>(vb), h3 = tr_read<v_rd_off(D0, 3, 1)>(vb);
  asm volatile("s_waitcnt lgkmcnt(0)" ::: "memory"); SBAR();
#define PK(L, H) (bf16x8){L[0], L[1], L[2], L[3], H[0], H[1], H[2], H[3]}
  od = __builtin_amdgcn_mfma_f32_32x32x16_bf16(pa0, PK(l0, h0), od, 0, 0, 0);
  od = __builtin_amdgcn_mfma_f32_32x32x16_bf16(pa1, PK(l1, h1), od, 0, 0, 0);
  od = __builtin_amdgcn_mfma_f32_32x32x16_bf16(pa2, PK(l2, h2), od, 0, 0, 0);
  od = __builtin_amdgcn_mfma_f32_32x32x16_bf16(pa3, PK(l3, h3), od, 0, 0, 0);
#undef PK
}
DEVI void pv_d0(f32x16* o, int vb, bf16x8 pa0, bf16x8 pa1, bf16x8 pa2, bf16x8 pa3) {
  pv_one<0>(o[0], vb, pa0, pa1, pa2, pa3); pv_one<1>(o[1], vb, pa0, pa1, pa2, pa3); pv_one<2>(o[2], vb, pa0, pa1, pa2, pa3); pv_one<3>(o[3], vb, pa0, pa1, pa2, pa3);
}

template <int KW, int NQ, int SCID>
DEVI void attn_core(const bf16_t* __restrict__ Qw, const bf16_t* __restrict__ Kh, const bf16_t* __restrict__ Vh, int kcol0, int NT, char* lds,
                    f32x16 (&o)[4], float& l_out) {
  constexpr int SHM_V = 64 * 128 * 2, SHM_K = 64 * (KW * 2 + 16), KC = KW / 64;
  const int tid = tidx(), wid = tid >> 6, lane = tid & 63, r32 = lane & 31, hi = lane >> 5;
  char* V_lds = lds; char* K_lds = lds + 2 * SHM_V;
  float* al_l = (float*)(lds + 2 * SHM_V + 2 * SHM_K) + wid * 64 + 32;
  float m_reg = -1e30f, l_reg = 0;
#pragma unroll
  for (int d = 0; d < 4; ++d)
#pragma unroll
    for (int r = 0; r < 16; ++r) o[d][r] = 0.f;
  bf16x8 qr[NQ];
#pragma unroll
  for (int d0 = 0; d0 < NQ; ++d0) qr[d0] = *reinterpret_cast<const bf16x8*>(Qw + d0 * 16);
  const int sr = tid >> 4, sc = (tid & 15) * 8, vst0 = v_st(sr, sc), vst1 = v_st(32 + sr, sc);
  const int krow = tid >> 3, kch = tid & 7;
  const bf16_t* vg = Vh + sr * 128 + sc;
  const bf16_t* kg = Kh + krow * KW + kch * 8;
  const int vb0 = (int)(uintptr_t)V_lds + v_rd_base(lane);
  bf16x8 vs0, vs1, ks[KC];
#define SLOAD(k0) do { vs0 = *reinterpret_cast<const bf16x8*>(vg + (size_t)(k0) * 128); vs1 = *reinterpret_cast<const bf16x8*>(vg + (size_t)((k0) + 32) * 128); \
    _Pragma("unroll") for (int _c = 0; _c < KC; ++_c) ks[_c] = *reinterpret_cast<const bf16x8*>(kg + (size_t)(k0) * KW + _c * 64); } while (0)
#define SWRITE(b) do { *reinterpret_cast<bf16x8*>(V_lds + (b) * SHM_V + vst0) = vs0; *reinterpret_cast<bf16x8*>(V_lds + (b) * SHM_V + vst1) = vs1; \
    _Pragma("unroll") for (int _c = 0; _c < KC; ++_c) *reinterpret_cast<bf16x8*>(K_lds + (b) * SHM_K + kswz<KW>(krow, (kch + 8 * _c) * 16)) = ks[_c]; } while (0)
  SLOAD(0); SWRITE(0);
  if (NT > 1) SLOAD(64);
  __syncthreads();
  for (int j = 0; j < NT; ++j) {
    const int bsel = j & 1;
    f32x16 p0, p1; float mn, alpha; bf16x8 pa0, pa1, pa2, pa3;
    qkt<KW, NQ>(p0, p1, K_lds + bsel * SHM_K, qr, kcol0, r32, hi);
    partialSM<SCID>(p0, p1, m_reg, mn, alpha);
    if (__any(alpha < 1.f)) {
      if (hi == 0) al_l[r32] = alpha;
      asm volatile("s_waitcnt lgkmcnt(0)" ::: "memory");
#pragma unroll
      for (int d = 0; d < 4; ++d)
#pragma unroll
        for (int r = 0; r < 16; ++r) o[d][r] *= al_l[crow(r, hi)];
    }
    finishSM(p0, p1, alpha, l_reg, pa0, pa1, pa2, pa3);
    pv_d0(o, vb0 + bsel * SHM_V, pa0, pa1, pa2, pa3);
    if (j + 1 < NT) { SWRITE(bsel ^ 1); if (j + 2 < NT) SLOAD((j + 2) * 64); }
    __syncthreads();
  }
  l_out = l_reg;
#undef SLOAD
#undef SWRITE
}

DEVI void attn0_item(const Params& p, int token0, int b, int h, int nkeys, char* lds) {
  const int tid = tidx(), wid = tid >> 6, lane = tid & 63, r32 = lane & 31, hi = lane >> 5, m = wid >> 2, wl = wid & 3;
  const bf16_t* Q0 = (const bf16_t*)(p.ws + OFF_Q0); const bf16_t* K0 = (const bf16_t*)(p.ws + OFF_K0); const bf16_t* V0 = (const bf16_t*)(p.ws + OFF_V0);
  const bf16_t* ZB = (const bf16_t*)(p.ws + OFF_ZB); bf16_t* MIX = (bf16_t*)(p.ws + OFF_MIX);
  const bf16_t* Qw = Q0 + (size_t)(token0 + wl * 32 + r32) * 512 + h * 128 + m * 64 + hi * 8;
  const size_t kvo = (size_t)(b * 4 + h) * KVL * 128;
  f32x16 o[4]; float l;
  attn_core<128, 4, 0>(Qw, K0 + kvo, V0 + kvo, m * 64, nkeys >> 6, lds, o, l);
  float* li_l = (float*)(lds + 32768 + 2 * 64 * 272) + wid * 64;
  if (hi == 0) li_l[r32] = l;
  asm volatile("s_waitcnt lgkmcnt(0)" ::: "memory");
  float rli[16];
#pragma unroll
  for (int r = 0; r < 16; ++r) rli[r] = __builtin_amdgcn_rcpf(li_l[crow(r, hi)]);
  float t1 = p.b_lq1[lane] * p.b_lk1[lane], t2 = p.b_lq2[lane] * p.b_lk2[lane];
#pragma unroll
  for (int sft = 32; sft >= 1; sft >>= 1) { t1 += __shfl_xor(t1, sft); t2 += __shfl_xor(t2, sft); }
  const float lam = __expf(t1) - __expf(t2) + 0.2f;
  __syncthreads();
  float* xch = (float*)lds;
  if (m == 1) {
#pragma unroll
    for (int r = 0; r < 16; ++r)
#pragma unroll
      for (int d0 = 0; d0 < 4; ++d0) xch[(wl * 32 + crow(r, hi)) * 128 + d0 * 32 + r32] = o[d0][r] * rli[r];
  }
  __syncthreads();
  if (m == 0) {
    float sw4[4];
#pragma unroll
    for (int d0 = 0; d0 < 4; ++d0) sw4[d0] = p.b_subln_w[d0 * 32 + r32];
#pragma unroll
    for (int r = 0; r < 16; ++r) {
      const int row = wl * 32 + crow(r, hi); const int token = token0 + row;
      float a[4], ss = 0.f;
#pragma unroll
      for (int d0 = 0; d0 < 4; ++d0) { a[d0] = o[d0][r] * rli[r] - lam * xch[row * 128 + d0 * 32 + r32]; ss += a[d0] * a[d0]; }
      ss += __shfl_xor(ss, 1); ss += __shfl_xor(ss, 2); ss += __shfl_xor(ss, 4); ss += __shfl_xor(ss, 8); ss += __shfl_xor(ss, 16);
      const float rstd = rsqrtf(ss * (1.f / 128.f) + 1e-5f) * 0.8f;
#pragma unroll
      for (int d0 = 0; d0 < 4; ++d0) {
        const int d = d0 * 32 + r32;
        const float val = a[d0] * rstd * sw4[d0] * bf2f(ZB[(size_t)token * 512 + h * 128 + d]);
        MIX[(size_t)token * 1024 + 512 + h * 128 + d] = f2bf(val);
      }
    }
  }
  __syncthreads();
}

DEVI void attn1_item(const Params& p, int b, int h, int qb, char* lds) {
  const int tid = tidx(), wid = tid >> 6, lane = tid & 63, r32 = lane & 31, hi = lane >> 5;
  const bf16_t* Q1 = (const bf16_t*)(p.ws + OFF_Q1); const bf16_t* K1 = (const bf16_t*)(p.ws + OFF_K1); const bf16_t* V1 = (const bf16_t*)(p.ws + OFF_V1);
  const bf16_t* Z1 = (const bf16_t*)(p.ws + OFF_Z1); bf16_t* MIX = (bf16_t*)(p.ws + OFF_MIX);
  const int token0 = b * 2048 + qb * 256;
  const bf16_t* Qw = Q1 + (size_t)(token0 + wid * 32 + r32) * 1536 + h * 192 + hi * 8;
  f32x16 o[4]; float l;
  attn_core<192, 12, 1>(Qw, K1 + (size_t)(b * 8 + h) * KVL * 192, V1 + (size_t)(b * 8 + h) * KVL * 128, 0, KVL / 64, lds, o, l);
  float* li_l = (float*)(lds + 32768 + 2 * 64 * 400) + wid * 64;
  if (hi == 0) li_l[r32] = l;
  asm volatile("s_waitcnt lgkmcnt(0)" ::: "memory");
#pragma unroll
  for (int r = 0; r < 16; ++r) {
    const int cr = crow(r, hi); const float rl = __builtin_amdgcn_rcpf(li_l[cr]); const int token = token0 + wid * 32 + cr;
#pragma unroll
    for (int d0 = 0; d0 < 4; ++d0) {
      const int d = h * 128 + d0 * 32 + r32;
      MIX[(size_t)token * 1024 + d] = f2bf(o[d0][r] * rl * bf2f(Z1[(size_t)token * 1024 + d]));
    }
  }
  __syncthreads();
}

DEVI void abranch_item(const Params& p, int ci, char* lds) {
  const int tid = tidx(), wid = tid >> 6, lane = tid & 63, r32 = lane & 31, hi = lane >> 5;
  const bf16_t* GV = (const bf16_t*)(p.ws + OFF_GV); const bf16_t* U = (const bf16_t*)(p.ws + OFF_U); const bf16_t* ZA = (const bf16_t*)(p.ws + OFF_ZA);
  const bf16_t* WSB = (const bf16_t*)(p.ws + OFF_WSB); bf16_t* MIX = (bf16_t*)(p.ws + OFF_MIX);
  const int t0 = ci * 128;
  bf16_t* vnT = (bf16_t*)lds;
  {
    const int pos = tid >> 2, cp = tid & 3;
    const bf16_t* g = GV + (size_t)(t0 + pos) * 512;
    float s = 0.f, q = 0.f;
#pragma unroll 4
    for (int i = 0; i < 16; ++i) {
      const bf16x8 raw = *reinterpret_cast<const bf16x8*>(g + (i * 4 + cp) * 8);
#pragma unroll
      for (int e = 0; e < 8; ++e) { const float xv = bf2f((bf16_t)raw[e]); s += xv; q += xv * xv; }
    }
    s += __shfl_xor(s, 1); s += __shfl_xor(s, 2); q += __shfl_xor(q, 1); q += __shfl_xor(q, 2);
    const float mu = s * (1.f / 512.f);
    const float rstd = rsqrtf(fmaxf(q * (1.f / 512.f) - mu * mu, 0.f) + 1e-5f);
#pragma unroll 2
    for (int i = 0; i < 16; ++i) {
      const int c0 = (i * 4 + cp) * 8;
      const bf16x8 raw = *reinterpret_cast<const bf16x8*>(g + c0);
      const f32x4 w0 = *reinterpret_cast<const f32x4*>(p.a_ln_w + c0), w1 = *reinterpret_cast<const f32x4*>(p.a_ln_w + c0 + 4);
      const f32x4 b0 = *reinterpret_cast<const f32x4*>(p.a_ln_b + c0), b1 = *reinterpret_cast<const f32x4*>(p.a_ln_b + c0 + 4);
#pragma unroll
      for (int e = 0; e < 8; ++e) {
        const float wv = e < 4 ? w0[e & 3] : w1[e & 3], bv = e < 4 ? b0[e & 3] : b1[e & 3];
        vnT[(c0 + e) * 136 + pos] = f2bf((bf2f((bf16_t)raw[e]) - mu) * rstd * wv + bv);
      }
    }
  }
  __syncthreads();
  const int g8 = wid;
  const bf16_t* Wg = WSB + g8 * 128 * 128;
  for (int pb = 0; pb < 4; ++pb) {
    f32x16 acc[2];
#pragma unroll
    for (int r = 0; r < 16; ++r) { acc[0][r] = 0.f; acc[1][r] = 0.f; }
#pragma unroll
    for (int ks = 0; ks < 8; ++ks) {
      const bf16x8 bw = *reinterpret_cast<const bf16x8*>(Wg + (pb * 32 + r32) * 128 + ks * 16 + hi * 8);
#pragma unroll
      for (int db = 0; db < 2; ++db) {
        const bf16x8 a = *reinterpret_cast<const bf16x8*>(vnT + (g8 * 64 + db * 32 + r32) * 136 + ks * 16 + hi * 8);
        acc[db] = __builtin_amdgcn_mfma_f32_32x32x16_bf16(a, bw, acc[db], 0, 0, 0);
      }
    }
    const int token = t0 + pb * 32 + r32; const float bias = p.a_bs[g8 * 128 + pb * 32 + r32];
#pragma unroll
    for (int db = 0; db < 2; ++db)
#pragma unroll
      for (int rg = 0; rg < 4; ++rg) {
        const int c = g8 * 64 + db * 32 + rg * 8 + hi * 4;
        const u32x2 u2 = *reinterpret_cast<const u32x2*>(U + (size_t)token * 512 + c), z2 = *reinterpret_cast<const u32x2*>(ZA + (size_t)token * 512 + c);
        const float o0 = bflo(u2[0]) * (acc[db][rg * 4 + 0] + bias) * bflo(z2[0]), o1 = bfhi(u2[0]) * (acc[db][rg * 4 + 1] + bias) * bfhi(z2[0]);
        const float o2 = bflo(u2[1]) * (acc[db][rg * 4 + 2] + bias) * bflo(z2[1]), o3 = bfhi(u2[1]) * (acc[db][rg * 4 + 3] + bias) * bfhi(z2[1]);
        u32x2 pk = {cvtpk(o0, o1), cvtpk(o2, o3)};
        *reinterpret_cast<u32x2*>(MIX + (size_t)token * 1024 + c) = pk;
      }
  }
  __syncthreads();
}

DEVI void tr_tile(const float* __restrict__ src, bf16_t* __restrict__ dst, int K, int N, int tilesN, const float* __restrict__ scale, int t, char* lds) {
  const int tid = tidx();
  const int k0 = (t / tilesN) * 64, n0 = (t % tilesN) * 64;
  const int kr = tid >> 3, ng = (tid & 7) * 8;
  f32x4 v0 = {0.f, 0.f, 0.f, 0.f}, v1 = {0.f, 0.f, 0.f, 0.f};
  if (n0 + ng < N) { const float* s = src + (size_t)(k0 + kr) * N + n0 + ng; v0 = *reinterpret_cast<const f32x4*>(s); v1 = *reinterpret_cast<const f32x4*>(s + 4); }
  const float scv = scale ? scale[k0 + kr] : 1.f;
  bf16_t* tl = (bf16_t*)lds;
#pragma unroll
  for (int e = 0; e < 4; ++e) { tl[(ng + e) * 72 + kr] = f2bf(v0[e] * scv); tl[(ng + 4 + e) * 72 + kr] = f2bf(v1[e] * scv); }
  __syncthreads();
  const int n = tid >> 3, kc = (tid & 7) * 8;
  *reinterpret_cast<bf16x8*>(dst + (size_t)(n0 + n) * K + k0 + kc) = *reinterpret_cast<const bf16x8*>(tl + n * 72 + kc);
}

DEVI void phase0(const Params& p, char* lds) {
  const int tid = tidx();
  constexpr int N_ADA = 192, N_TR = 1952, N_WS = 16;
  for (int it = blockIdx.x; it < N_ADA + N_TR + N_WS + 1; it += gridDim.x) {
    if (it < N_ADA) {
      const int li = it / 96, chunk = it % 96;
      float* sc = (float*)lds;
      for (int idx = tid; idx < 17 * 1024; idx += 512) { const int r = idx >> 10, k = idx & 1023; const float xv = r < 16 ? p.c[r * 1024 + k] : p.c_ctx[k]; sc[idx] = xv / (1.f + expf(-xv)); }
      __syncthreads();
      const int col = tid & 31, kp = tid >> 5;
      const float* w = p.ada_w + (size_t)li * 1024 * 3072 + chunk * 32 + col;
      float acc[17];
#pragma unroll
      for (int r = 0; r < 17; ++r) acc[r] = 0.f;
#pragma unroll 8
      for (int k = kp * 64; k < kp * 64 + 64; ++k) {
        const float wv = w[(size_t)k * 3072];
#pragma unroll
        for (int r = 0; r < 17; ++r) acc[r] += sc[r * 1024 + k] * wv;
      }
      float* red = (float*)(lds + 17 * 1024 * 4);
#pragma unroll
      for (int r = 0; r < 17; ++r) red[(kp * 17 + r) * 32 + col] = acc[r];
      __syncthreads();
      float* ada = (float*)(p.ws + OFF_ADA);
      for (int idx = tid; idx < 544; idx += 512) {
        const int r = idx >> 5, cc = idx & 31; float s = 0.f;
        for (int k2 = 0; k2 < 16; ++k2) s += red[(k2 * 17 + r) * 32 + cc];
        ada[(size_t)(li * 17 + r) * 3072 + chunk * 32 + cc] = s + p.ada_b[li * 3072 + chunk * 32 + cc];
      }
    } else if (it < N_ADA + N_TR) {
      int t = it - N_ADA;
      if (t < 896) tr_tile(p.even_w_in, (bf16_t*)(p.ws + OFF_W0IN), 1024, 3584, 56, nullptr, t, lds);
      else if (t < 1152) tr_tile(p.even_w_out, (bf16_t*)(p.ws + OFF_W0OUT), 1024, 1024, 16, nullptr, t - 896, lds);
      else if (t < 1536) tr_tile(p.odd_w_in, (bf16_t*)(p.ws + OFF_W1IN), 1024, 1472, 24, nullptr, t - 1152, lds);
      else if (t < 1632) tr_tile(p.c_wq_b, (bf16_t*)(p.ws + OFF_WQ), 256, 1536, 24, p.c_q_norm_w, t - 1536, lds);
      else if (t < 1696) tr_tile(p.c_wkv_b, (bf16_t*)(p.ws + OFF_WKV), 128, 2048, 32, p.c_kv_norm_w, t - 1632, lds);
      else tr_tile(p.odd_w_out, (bf16_t*)(p.ws + OFF_W1OUT), 1024, 1024, 16, nullptr, t - 1696, lds);
    } else if (it < N_ADA + N_TR + N_WS) {
      const int base = (it - N_ADA - N_TR) * 8192 + tid * 16;
      bf16_t* dst = (bf16_t*)(p.ws + OFF_WSB) + base; const float* s = p.a_ws + base;
#pragma unroll
      for (int q = 0; q < 2; ++q) {
        const f32x4 a = *reinterpret_cast<const f32x4*>(s + q * 8), b = *reinterpret_cast<const f32x4*>(s + q * 8 + 4);
        u32x4 w = {cvtpk(a[0], a[1]), cvtpk(a[2], a[3]), cvtpk(b[0], b[1]), cvtpk(b[2], b[3])};
        *reinterpret_cast<u32x4*>(dst + q * 8) = w;
      }
    } else {
      float2* tab = (float2*)(p.ws + OFF_ROPE);
      for (int e = tid; e < 1024; e += 512) {
        const int pos = e >> 4, j = e & 15;
        const float inv = exp2f(-(float)j * (13.287712379549449f / 16.f));
        const float ang = (float)pos * inv;
        const float nrev = rintf(ang * 0.15915494309189535f);
        float rr = fmaf(-nrev, 6.2831855f, ang); rr = fmaf(-nrev, -1.7484555e-7f, rr);
        tab[e] = make_float2(__cosf(rr), __sinf(rr));
      }
    }
    __syncthreads();
  }
}

DEVI void norm_mod(const float* src_lat, const float* src_ctx, const float* __restrict__ nw, const float* __restrict__ ada, bf16_t* X) {
  const int tid_ = tidx(); const int wid = tid_ >> 6, lane = tid_ & 63;
  for (int row = blockIdx.x * 8 + wid; row < NTOK; row += gridDim.x * 8) {
    const float* src = row < NLAT ? src_lat + (size_t)row * 1024 : src_ctx + (size_t)(row - NLAT) * 1024;
    const float* ad = ada + (row < NLAT ? (row >> 11) : 16) * 3072;
    f32x4 v[4]; float ss = 0.f;
#pragma unroll
    for (int i = 0; i < 4; ++i) { v[i] = *reinterpret_cast<const f32x4*>(src + i * 256 + lane * 4); ss += v[i][0] * v[i][0] + v[i][1] * v[i][1] + v[i][2] * v[i][2] + v[i][3] * v[i][3]; }
#pragma unroll
    for (int sft = 32; sft >= 1; sft >>= 1) ss += __shfl_xor(ss, sft);
    const float r = rsqrtf(ss * (1.f / 1024.f) + 1e-6f);
#pragma unroll
    for (int i = 0; i < 4; ++i) {
      const int c = i * 256 + lane * 4;
      const f32x4 w = *reinterpret_cast<const f32x4*>(nw + c), sh = *reinterpret_cast<const f32x4*>(ad + c), scl = *reinterpret_cast<const f32x4*>(ad + 1024 + c);
      float o[4];
#pragma unroll
      for (int e = 0; e < 4; ++e) o[e] = v[i][e] * r * w[e] * (1.f + scl[e]) + sh[e];
      u32x2 pk = {cvtpk(o[0], o[1]), cvtpk(o[2], o[3])};
      *reinterpret_cast<u32x2*>(X + (size_t)row * 1024 + c) = pk;
    }
  }
}

DEVI void final_norm(float* out, const float* __restrict__ fw) {
  const int tid_ = tidx(); const int wid = tid_ >> 6, lane = tid_ & 63;
  for (int row = blockIdx.x * 8 + wid; row < NLAT; row += gridDim.x * 8) {
    float* src = out + (size_t)row * 1024;
    f32x4 v[4]; float ss = 0.f;
#pragma unroll
    for (int i = 0; i < 4; ++i) { v[i] = *reinterpret_cast<const f32x4*>(src + i * 256 + lane * 4); ss += v[i][0] * v[i][0] + v[i][1] * v[i][1] + v[i][2] * v[i][2] + v[i][3] * v[i][3]; }
#pragma unroll
    for (int sft = 32; sft >= 1; sft >>= 1) ss += __shfl_xor(ss, sft);
    const float r = rsqrtf(ss * (1.f / 1024.f) + 1e-6f);
#pragma unroll
    for (int i = 0; i < 4; ++i) {
      const int c = i * 256 + lane * 4;
      const f32x4 w = *reinterpret_cast<const f32x4*>(fw + c);
      f32x4 o;
#pragma unroll
      for (int e = 0; e < 4; ++e) o[e] = v[i][e] * r * w[e];
      *reinterpret_cast<f32x4*>(src + c) = o;
    }
  }
}

typedef const __attribute__((address_space(4))) Params* KArgP;
DEVI void run_phase(KArgP pp, int ph, char* lds) {
#if defined(__HIP_DEVICE_COMPILE__)
  asm volatile("" : "+s"(pp));
  char* ws = pp->ws;
  const float2* rope = (const float2*)(ws + OFF_ROPE);
  const float* ada0 = (const float*)(ws + OFF_ADA); const float* ada1 = ada0 + 17 * 3072;
  bf16_t* X = (bf16_t*)(ws + OFF_X); bf16_t* MIX = (bf16_t*)(ws + OFF_MIX);
  const int G = gridDim.x, B = blockIdx.x;
  PG8_LAS unsigned char* ldsp = (PG8_LAS unsigned char*)lds;
  switch (ph) {
    case 0: { const Params p = *pp; phase0(p, lds); } break;
    case 1: norm_mod(pp->x, pp->ctx, pp->norm_w, ada0, X); break;
    case 2: {
      EpiL0In epi{(bf16_t*)(ws + OFF_U), (bf16_t*)(ws + OFF_GV), (bf16_t*)(ws + OFF_ZA), (bf16_t*)(ws + OFF_ZB), (bf16_t*)(ws + OFF_Q0), (bf16_t*)(ws + OFF_K0), (bf16_t*)(ws + OFF_V0), rope};
      gemm_phase(ldsp, X, (const bf16_t*)(ws + OFF_W0IN), 1024, Sched{14, 144 * 14, 144 * 14, 0, 0}, epi);
    } break;
    case 3: { const Params p = *pp;
      for (int it = B; it < 1024 + 288 + 128; it += G) {
        if (it < 1024) {
          const int xcd = it & 7, slot = (it >> 3) & 31, rd = it >> 8;
          const int bh = rd * 16 + xcd * 2 + (slot >> 4), qb = slot & 15, b = bh >> 2, h = bh & 3;
          attn0_item(p, b * 2048 + qb * 128, b, h, KVL, lds);
        } else if (it < 1024 + 288) abranch_item(p, it - 1024, lds);
        else { const int i2 = it - 1312; const int b = i2 >> 3, h = (i2 >> 1) & 3, qb = i2 & 1; attn0_item(p, NLAT + b * 256 + qb * 128, b, h, 256, lds); }
      }
    } break;
    case 4: {
      EpiOut<true> epi{pp->x, pp->ctx, pp->out, (float*)(ws + OFF_H1C), ada0};
      gemm_phase(ldsp, MIX, (const bf16_t*)(ws + OFF_W0OUT), 1024, Sched{4, 144 * 4, 144 * 4, 0, 0}, epi);
    } break;
    case 5: norm_mod(pp->out, (const float*)(ws + OFF_H1C), pp->norm_w + 1024, ada1, X); break;
    case 6: {
      EpiL1In epi{(bf16_t*)(ws + OFF_CQ), (bf16_t*)(ws + OFF_CKV), (bf16_t*)(ws + OFF_K1), (bf16_t*)(ws + OFF_Z1), (float*)(ws + OFF_RQ), (float*)(ws + OFF_RKV), rope, (float*)(lds + LDS_SS)};
      gemm_phase(ldsp, X, (const bf16_t*)(ws + OFF_W1IN), 1024, Sched{6, 768, 768 + 16, 128, 1}, epi);
    } break;
    case 7: {
      EpiQ eq{(bf16_t*)(ws + OFF_Q1), (const float*)(ws + OFF_RQ), rope};
      EpiKV ek{(bf16_t*)(ws + OFF_K1), (bf16_t*)(ws + OFF_V1), (const float*)(ws + OFF_RKV)};
      gemm_phase(ldsp, (const bf16_t*)(ws + OFF_CQ), (const bf16_t*)(ws + OFF_WQ), 256, Sched{6, 768, 768, 0, 0}, eq);
      gemm_phase(ldsp, (const bf16_t*)(ws + OFF_CKV), (const bf16_t*)(ws + OFF_WKV), 128, Sched{8, 1152, 1152, 0, 0}, ek);
    } break;
    case 8: { const Params p = *pp;
      for (int it = B; it < 1024; it += G) {
        const int xcd = it & 7, slot = (it >> 3) & 31, rd = it >> 8;
        const int bh = rd * 32 + xcd * 4 + (slot >> 3), qb = slot & 7;
        attn1_item(p, bh >> 3, bh & 7, qb, lds);
      }
    } break;
    case 9: {
      float* o_ = pp->out; EpiOut<false> epi{o_, o_, o_, o_, ada1};
      gemm_phase(ldsp, MIX, (const bf16_t*)(ws + OFF_W1OUT), 1024, Sched{4, 128 * 4, 128 * 4, 0, 0}, epi);
    } break;
    case 10: final_norm(pp->out, pp->final_w); break;
  }
#endif
}


#define XB_TMO      128
#define XB_XCNT(j)  (256  + 64 * (j))
#define XB_XSUB(j)  (1280 + 64 * (j))
#define XB_XGEN(j)  (2304 + 64 * (j))
#define XB_TOP      3328
#define XB_TOPGEN   3392
#define XCD_BAR_WORDS 3456
#define XB_SPIN_CAP (1u << 18)
#define LAS __attribute__((address_space(3)))
DEVI unsigned xb_ld(unsigned* p) { return __hip_atomic_load(p, __ATOMIC_RELAXED, __HIP_MEMORY_SCOPE_AGENT); }
DEVI unsigned xb_add(unsigned* p, unsigned v) { return __hip_atomic_fetch_add(p, v, __ATOMIC_RELAXED, __HIP_MEMORY_SCOPE_AGENT); }
DEVI unsigned xb_xcc_id() { return (unsigned)__builtin_amdgcn_s_getreg((3 << 11) | 20) & 0xFu; }
#define XB_SPIN(cond, bar) do { unsigned _sp = 0; while (cond) { __builtin_amdgcn_s_sleep(1); \
    if ((++_sp & 255u) == 0u) { if (xb_ld(&(bar)[XB_TMO])) break; if (_sp > XB_SPIN_CAP) { atomicAdd(&(bar)[XB_TMO], 1u); break; } } } } while (0)
struct XcdBarrier { unsigned* bar; unsigned x; volatile LAS unsigned* st; };
DEVI XcdBarrier xcd_barrier_post(unsigned* bar, volatile LAS unsigned* st) {
  XcdBarrier b; b.bar = bar; b.x = xb_xcc_id(); b.st = st;
  if (threadIdx.x == 0) (void)xb_add(&bar[XB_XCNT(b.x)], 1u);
  return b;
}
DEVI void xcd_barrier_complete(unsigned* bar, unsigned x, unsigned& nloc, unsigned& nx) {
  const unsigned G = gridDim.x * gridDim.y * gridDim.z;
  unsigned sum, cnt, mine, sp = 0u;
  for (;;) {
    sum = 0u; cnt = 0u; mine = 0u;
#pragma unroll
    for (unsigned j = 0; j < 16; ++j) { const unsigned c = xb_ld(&bar[XB_XCNT(j)]); sum += c; cnt += (c > 0u) ? 1u : 0u; mine = (j == x) ? c : mine; }
    if (sum == G) break;
    __builtin_amdgcn_s_sleep(1);
    if ((++sp & 255u) == 0u) { if (xb_ld(&bar[XB_TMO])) break; if (sp > XB_SPIN_CAP) { atomicAdd(&bar[XB_TMO], 1u); break; } }
  }
  nloc = mine > 0u ? mine : 1u; nx = cnt > 0u ? cnt : 1u;
}
DEVI void xcd_barrier(const XcdBarrier& b) {
  asm volatile("s_waitcnt vmcnt(0)" ::: "memory");
  __syncthreads();
  if (threadIdx.x == 0) {
    unsigned* bar = b.bar;
    __builtin_amdgcn_s_waitcnt(0);
    unsigned nloc = b.st[0], nx = b.st[1];
    if (nloc == 0u) { xcd_barrier_complete(bar, b.x, nloc, nx); b.st[0] = nloc; b.st[1] = nx; }
    const unsigned old = xb_add(&bar[XB_XSUB(b.x)], 1u);
    const unsigned gen = old / nloc;
    if (old + 1u == (gen + 1u) * nloc) {
      __builtin_amdgcn_fence(__ATOMIC_RELEASE, "agent");
      asm volatile("s_waitcnt vmcnt(0)" ::: "memory");
      const unsigned og = xb_add(&bar[XB_TOP], 1u);
      const unsigned tg = og / nx;
      if (og + 1u == (tg + 1u) * nx) xb_add(&bar[XB_TOPGEN], 1u);
      else XB_SPIN(xb_ld(&bar[XB_TOPGEN]) == tg, bar);
      __builtin_amdgcn_fence(__ATOMIC_ACQUIRE, "agent");
      xb_add(&bar[XB_XGEN(b.x)], 1u);
      asm volatile("s_waitcnt vmcnt(0)" ::: "memory");
    } else {
      XB_SPIN(xb_ld(&bar[XB_XGEN(b.x)]) == gen, bar);
      __builtin_amdgcn_fence(__ATOMIC_ACQUIRE, "agent");
      asm volatile("s_waitcnt vmcnt(0)" ::: "memory");
    }
  }
  __syncthreads();
}

extern __shared__ __attribute__((aligned(16))) char g_lds[];

constexpr int LDS_XB = 143360;
__global__ void __launch_bounds__(512) mega(Params p) {
  cg::grid_group grid = cg::this_grid();
  volatile LAS unsigned* xst = (volatile LAS unsigned*)(g_lds + LDS_XB);
  if (threadIdx.x == 0) { xst[0] = 0u; xst[1] = 0u; }
  __syncthreads();
  (void)xcd_barrier_post((unsigned*)(p.ws + OFF_BAR), xst);
#define GRID_BARRIER() do { KArgP _pp = (KArgP)__builtin_amdgcn_kernarg_segment_ptr(); asm volatile("" : "+s"(_pp)); \
    XcdBarrier _xb; _xb.bar = (unsigned*)(_pp->ws + OFF_BAR); _xb.x = xb_xcc_id(); _xb.st = (volatile LAS unsigned*)(g_lds + LDS_XB); xcd_barrier(_xb); } while (0)
  for (int ph = p.ph_lo; ph < p.ph_hi; ++ph) {
    run_phase((KArgP)__builtin_amdgcn_kernarg_segment_ptr(), ph, g_lds);
#ifdef PROBE_PH
    if (ph == PROBE_PH) { GRID_BARRIER(); run_phase((KArgP)__builtin_amdgcn_kernarg_segment_ptr(), ph, g_lds); }
#endif
    if (ph + 1 < p.ph_hi) {
      if (p.ph_hi > 64) grid.sync();
      GRID_BARRIER();
    }
  }
}

extern "C" void kernel_launch(void* const* d_in, const int* in_sizes, int n_in, void* d_out, int out_size, void* d_ws, size_t ws_size, hipStream_t stream) {
  static int ok = 0;
  static int grid_blocks = 0;
  if (!ok) {
    if (n_in != 25 || ws_size < WS_NEED) { fprintf(stderr, "kernel_launch: bad args n_in %d ws %zu need %zu\n", n_in, ws_size, (size_t)WS_NEED); return; }
    if (hipFuncSetAttribute((const void*)mega, hipFuncAttributeMaxDynamicSharedMemorySize, LDS_BYTES) != hipSuccess) { fprintf(stderr, "kernel_launch: LDS attr failed\n"); return; }
    int dev = 0, cus = 0, per_cu = 0;
    hipGetDevice(&dev);
    hipDeviceGetAttribute(&cus, hipDeviceAttributeMultiprocessorCount, dev);
    hipOccupancyMaxActiveBlocksPerMultiprocessor(&per_cu, mega, 512, LDS_BYTES);
    if (per_cu < 1) per_cu = 1;
    grid_blocks = cus * per_cu;
    ok = 1;
  }
  Params p{};
  const float** pp = (const float**)&p;
  for (int i = 0; i < 25; ++i) pp[i] = (const float*)d_in[i];
  p.out = (float*)d_out; p.ws = (char*)d_ws;
#if ONE_LAUNCH
  p.ph_lo = 0; p.ph_hi = 11;
  hipMemsetAsync((char*)d_ws + OFF_BAR, 0, XCD_BAR_WORDS * 4, stream);
  void* args[] = {&p};
  hipError_t e = hipLaunchCooperativeKernel((const void*)mega, dim3(grid_blocks), dim3(512), args, LDS_BYTES, stream);
  if (e != hipSuccess) fprintf(stderr, "cooperative launch failed: %s (grid %d)\n", hipGetErrorString(e), grid_blocks);
#else
  for (int ph = 0; ph < 11; ++ph) {
    p.ph_lo = ph; p.ph_hi = ph + 1;
    hipLaunchKernelGGL(mega, dim3(grid_blocks), dim3(512), LDS_BYTES, stream, p);
  }
#endif
}
```

```cpp
#include <hip/hip_runtime.h>
#include <hip/hip_cooperative_groups.h>
#include <cstdio>
namespace cg = cooperative_groups;

#ifndef ATT_SD0
#define ATT_SD0 2
#endif
#ifndef ONE_LAUNCH
#define ONE_LAUNCH 1
#endif

typedef unsigned short bf16_t;
typedef short bf16x8 __attribute__((ext_vector_type(8)));
typedef short s16x4 __attribute__((ext_vector_type(4)));
typedef float f32x16 __attribute__((ext_vector_type(16)));
typedef float f32x4 __attribute__((ext_vector_type(4)));
typedef unsigned u32x4 __attribute__((ext_vector_type(4)));
typedef unsigned u32x2 __attribute__((ext_vector_type(2)));
#define DEVI __device__ __forceinline__
#define SBAR() __builtin_amdgcn_sched_barrier(0)
DEVI int tidx(int wv) { int l; asm volatile("v_mbcnt_lo_u32_b32 %0, -1, 0\n\tv_mbcnt_hi_u32_b32 %0, -1, %0" : "=v"(l)); return (wv << 6) | l; }

constexpr int NLAT = 32768, NCTX = 4096, NTOK = 36864, KVL = 2304;
constexpr int LDS_BYTES = 147456, LDS_SS = 139264;

constexpr size_t OFF_W0IN = 0;
constexpr size_t OFF_W0OUT = OFF_W0IN + 3584ull * 1024 * 2;
constexpr size_t OFF_W1IN = OFF_W0OUT + 1024ull * 1024 * 2;
constexpr size_t OFF_WQ = OFF_W1IN + 1536ull * 1024 * 2;
constexpr size_t OFF_WKV = OFF_WQ + 1536ull * 256 * 2;
constexpr size_t OFF_W1OUT = OFF_WKV + 2048ull * 128 * 2;
constexpr size_t OFF_WSB = OFF_W1OUT + 1024ull * 1024 * 2;
constexpr size_t OFF_ADA = OFF_WSB + 8ull * 128 * 128 * 2;
constexpr size_t OFF_ROPE = OFF_ADA + 2ull * 17 * 3072 * 4;
constexpr size_t OFF_BAR = OFF_ROPE + 64ull * 16 * 8;
constexpr size_t OFF_H1C = OFF_BAR + 16384;
constexpr size_t OFF_RQ = OFF_H1C + 4096ull * 1024 * 4;
constexpr size_t OFF_RKV = OFF_RQ + 32768ull * 4;
constexpr size_t OFF_X = OFF_RKV + 36864ull * 4;
constexpr size_t OFF_MIX = OFF_X + 36864ull * 1024 * 2;
constexpr size_t OFF_T = OFF_MIX + 36864ull * 1024 * 2;
constexpr size_t SZ_HALF = 36864ull * 512 * 2;
constexpr size_t OFF_U = OFF_T, OFF_GV = OFF_U + SZ_HALF, OFF_ZA = OFF_GV + SZ_HALF, OFF_ZB = OFF_ZA + SZ_HALF, OFF_Q0 = OFF_ZB + SZ_HALF;
constexpr size_t OFF_K0 = OFF_Q0 + SZ_HALF, OFF_V0 = OFF_K0 + 16ull * 4 * KVL * 128 * 2, END_L0 = OFF_V0 + 16ull * 4 * KVL * 128 * 2;
constexpr size_t OFF_CQ = OFF_T, OFF_CKV = OFF_CQ + 32768ull * 256 * 2, OFF_Z1 = OFF_CKV + 36864ull * 128 * 2;
constexpr size_t OFF_Q1 = OFF_Z1 + 32768ull * 1024 * 2, OFF_K1 = OFF_Q1 + 32768ull * 1536 * 2, END_L1 = OFF_K1 + 16ull * 8 * KVL * 192 * 2;
constexpr size_t OFF_V1 = OFF_X;
constexpr size_t WS_NEED = END_L1 > END_L0 ? END_L1 : END_L0;

struct Params {
  const float *x, *c, *ctx, *c_ctx, *norm_w, *ada_w, *ada_b, *even_w_in, *a_ws, *a_bs, *a_ln_w, *a_ln_b,
      *b_lq1, *b_lk1, *b_lq2, *b_lk2, *b_subln_w, *even_w_out, *odd_w_in, *c_q_norm_w, *c_wq_b,
      *c_kv_norm_w, *c_wkv_b, *odd_w_out, *final_w;
  float* out; char* ws; int ph_lo, ph_hi;
};

DEVI unsigned cvtpk(float lo, float hi) { unsigned r; asm("v_cvt_pk_bf16_f32 %0, %1, %2" : "=v"(r) : "v"(lo), "v"(hi)); return r; }
DEVI bf16_t f2bf(float v) { return (bf16_t)(cvtpk(v, 0.f) & 0xffffu); }
DEVI float bf2f(bf16_t v) { return __uint_as_float(((unsigned)v) << 16); }
DEVI float bflo(unsigned w) { return __uint_as_float(w << 16); }
DEVI float bfhi(unsigned w) { return __uint_as_float(w & 0xffff0000u); }
DEVI int crow(int r, int hi) { return (r & 3) + 8 * (r >> 2) + 4 * hi; }
DEVI float silu_f(float x) { return x * __builtin_amdgcn_rcpf(1.f + __builtin_amdgcn_exp2f(x * -1.4426950408889634f)); }
DEVI float gelu_f(float v) {
  const float t = __builtin_amdgcn_rcpf(fmaf(fabsf(v), 0.2316418882f, 1.0f));
  float q = fmaf(t, 0.5307027145f, -0.7265760135f); q = fmaf(q, t, 0.7107068705f); q = fmaf(q, t, -0.142248368f); q = fmaf(q, t, 0.127414796f); q *= t;
  const float m = v * (q * __builtin_amdgcn_exp2f(v * v * -0.72134752044f));
  return v < 0.f ? m : v - m;
}

template <int M> DEVI float xsum(float v) {
  if constexpr (M == 32) { auto rr = __builtin_amdgcn_permlane32_swap(__float_as_uint(v), __float_as_uint(v), false, false); return __uint_as_float(rr[0]) + __uint_as_float(rr[1]); }
  else return v + __int_as_float(__builtin_amdgcn_ds_swizzle(__float_as_int(v), (M << 10) | 0x1f));
}
DEVI float wave_sum(float v) { v = xsum<1>(v); v = xsum<2>(v); v = xsum<4>(v); v = xsum<8>(v); v = xsum<16>(v); return xsum<32>(v); }

DEVI void rope_tile(f32x16& v, const float2* __restrict__ tab, int pos, int hi) {
#pragma unroll
  for (int r = 0; r < 8; ++r) {
    const int jf = (r & 3) + 8 * (r >> 2) + 4 * hi;
    const float2 cs = tab[pos * 16 + jf];
    const float a = v[r], b = v[r + 8];
    v[r] = a * cs.x - b * cs.y; v[r + 8] = b * cs.x + a * cs.y;
  }
}
DEVI void store4(bf16_t* dst, const f32x16& v, int rg) {
  u32x2 pk = {cvtpk(v[rg * 4 + 0], v[rg * 4 + 1]), cvtpk(v[rg * 4 + 2], v[rg * 4 + 3])};
  *reinterpret_cast<u32x2*>(dst) = pk;
}

#define PG8_LAS __attribute__((address_space(3)))
constexpr int HTB = 128 * 64 * 2;
DEVI int lds_byte(int r, int c) { const int st = (r >> 4) * 2 + (c >> 5), rr = r & 15, cc = c & 31, ob = rr * 64 + cc * 2; return st * 1024 + (ob ^ (((ob >> 9) & 1) << 5)); }
DEVI void stage_rc(int b, int& R, int& C) { const int st = b / 1024, sb = b % 1024, swz = sb ^ (((sb >> 9) & 1) << 5); R = (st >> 1) * 16 + swz / 64; C = (st & 1) * 32 + (swz % 64) / 2; }
struct Unit { int pm, pn; };
struct Sched {
  int nN, nmain, ntotal, xpm0, xpn, boff = 0;
  DEVI bool next(int i, Unit& u) const {
    const int it = (int)blockIdx.x - boff + i * (int)gridDim.x; if (it < 0 || it >= ntotal) return false;
    if (it < nmain) { const int xcd = it & 7, jx = it >> 3; u.pm = (jx / nN) * 8 + xcd; u.pn = jx % nN; } else { u.pm = xpm0 + (it - nmain); u.pn = xpn; }
    return true;
  }
};
template <class Epi>
DEVI void gemm_phase(int wv, PG8_LAS unsigned char* lds, const bf16_t* gA, const bf16_t* gBt, const int K, const Sched& S, const Epi& E) {
  const int tid = tidx(wv), wid = __builtin_amdgcn_readfirstlane(tid >> 6), lane = tid & 63, wr = wid >> 2, wc = wid & 3, fr = lane & 15, fq = lane >> 4;
  const int nt = K / 64;
  unsigned voffA[2], voffB[2];
#pragma unroll
  for (int i = 0; i < 2; ++i) { int R, C; stage_rc(tid * 16 + i * 8192, R, C); voffA[i] = (unsigned)(R * K + C) * 2u; voffB[i] = voffA[i]; }
  const size_t kstep = (size_t)(64 * 2);
  const size_t hstep = (size_t)128 * K * 2;
  const size_t tstep = 2 * hstep;
  const unsigned ldsw = (unsigned)wid * 1024u;
  const int aoff = lds_byte(wr * 64 + fr, fq * 8), boff = lds_byte(wc * 32 + fr, fq * 8);
#define PG8_SA(b, h) (((b) * 2 + (h)) * HTB)
#define PG8_SB(b, h) ((4 + (b) * 2 + (h)) * HTB)
#define PG8_STAGE(bufoff, gbase, voff) do { _Pragma("unroll") for (int _i = 0; _i < 2; ++_i) \
    __builtin_amdgcn_global_load_lds((const unsigned*)((const char*)(gbase) + (voff)[_i]), (PG8_LAS unsigned*)(lds + (bufoff) + ldsw + _i * 8192), 16, 0, 0); } while (0)
#define PG8_LDA(dst, b, h) do { _Pragma("unroll") for (int m = 0; m < 4; ++m) _Pragma("unroll") for (int k = 0; k < 2; ++k) dst[m][k] = *(const PG8_LAS bf16x8*)(lds + PG8_SA(b, h) + aoff + m * 2048 + k * 1024); } while (0)
#define PG8_LDB(dst, b, h) do { _Pragma("unroll") for (int n = 0; n < 2; ++n) _Pragma("unroll") for (int k = 0; k < 2; ++k) dst[n][k] = *(const PG8_LAS bf16x8*)(lds + PG8_SB(b, h) + boff + n * 2048 + k * 1024); } while (0)
#define PG8_MMA(ai, bj, At, Bt) do { __builtin_amdgcn_s_setprio(1); _Pragma("unroll") for (int m = 0; m < 4; ++m) _Pragma("unroll") for (int n = 0; n < 2; ++n) _Pragma("unroll") for (int k = 0; k < 2; ++k) \
    acc[ai][bj][m][n] = __builtin_amdgcn_mfma_f32_16x16x32_bf16(Bt[n][k], At[m][k], acc[ai][bj][m][n], 0, 0, 0); __builtin_amdgcn_s_setprio(0); } while (0)
#define PG8_WAIT_V(n) asm volatile("s_waitcnt vmcnt(" #n ")" ::: "memory")
#define PG8_WAIT_L(n) asm volatile("s_waitcnt lgkmcnt(" #n ")" ::: "memory")
#define PG8_BAR __builtin_amdgcn_s_barrier()
#define PG8_SCHED __builtin_amdgcn_sched_barrier(0)
  Unit cur, nxt; int ui = 0;
  if (!S.next(0, cur)) return;
  f32x4 acc[2][2][4][2];
#pragma unroll
  for (int a = 0; a < 2; ++a)
#pragma unroll
    for (int b = 0; b < 2; ++b)
#pragma unroll
      for (int m = 0; m < 4; ++m)
#pragma unroll
        for (int n = 0; n < 2; ++n) acc[a][b][m][n] = (f32x4){0.f, 0.f, 0.f, 0.f};
  bf16x8 At[4][2], B0[2][2], B1[2][2];
  const char* cA = (const char*)gA + (size_t)cur.pm * tstep; const char* cB = (const char*)gBt + (size_t)cur.pn * tstep;
  PG8_STAGE(PG8_SB(0, 0), cB, voffB); PG8_STAGE(PG8_SA(0, 0), cA, voffA); PG8_STAGE(PG8_SB(0, 1), cB + hstep, voffB); PG8_STAGE(PG8_SA(0, 1), cA + hstep, voffA);
  if (wr == 1) PG8_BAR;
  PG8_WAIT_V(4); PG8_BAR;
  PG8_STAGE(PG8_SB(1, 0), cB + kstep, voffB); PG8_STAGE(PG8_SA(1, 0), cA + kstep, voffA); PG8_STAGE(PG8_SB(1, 1), cB + hstep + kstep, voffB);
  PG8_WAIT_V(6); PG8_BAR;
  for (;;) {
    const bool has_next = S.next(ui + 1, nxt);
    const char* nA = has_next ? (const char*)gA + (size_t)nxt.pm * tstep : cA; const char* nB = has_next ? (const char*)gBt + (size_t)nxt.pn * tstep : cB;
#pragma unroll 1
    for (int t = 0; t < nt; t += 2) {
      const bool last = (t == nt - 2);
      const char* a1 = cA + (size_t)(t + 1) * kstep;
      const char* a2 = last ? nA : cA + (size_t)(t + 2) * kstep; const char* b2 = last ? nB : cB + (size_t)(t + 2) * kstep;
      const char* a3 = a2 + kstep; const char* b3 = b2 + kstep;
      PG8_LDB(B0, 0, 0); PG8_SCHED; PG8_LDA(At, 0, 0); PG8_STAGE(PG8_SA(1, 1), a1 + hstep, voffA);
      PG8_WAIT_L(8); PG8_BAR; PG8_WAIT_L(0); PG8_MMA(0, 0, At, B0); PG8_BAR; PG8_SCHED;
      PG8_LDB(B1, 0, 1); PG8_STAGE(PG8_SB(0, 0), b2, voffB);
      PG8_BAR; PG8_WAIT_L(0); PG8_MMA(0, 1, At, B1); PG8_BAR;
      PG8_LDA(At, 0, 1); PG8_STAGE(PG8_SA(0, 0), a2, voffA);
      PG8_BAR; PG8_WAIT_L(0); PG8_MMA(1, 0, At, B0); PG8_BAR; PG8_SCHED;
      PG8_STAGE(PG8_SB(0, 1), b2 + hstep, voffB);
      PG8_WAIT_V(6); PG8_BAR; PG8_MMA(1, 1, At, B1); PG8_BAR;
      PG8_LDB(B0, 1, 0); PG8_SCHED; PG8_LDA(At, 1, 0); PG8_STAGE(PG8_SA(0, 1), a2 + hstep, voffA);
      PG8_WAIT_L(8); PG8_BAR; PG8_WAIT_L(0); PG8_MMA(0, 0, At, B0); PG8_BAR; PG8_SCHED;
      PG8_LDB(B1, 1, 1); PG8_STAGE(PG8_SB(1, 0), b3, voffB);
      PG8_BAR; PG8_WAIT_L(0); PG8_MMA(0, 1, At, B1); PG8_BAR;
      PG8_LDA(At, 1, 1); PG8_STAGE(PG8_SA(1, 0), a3, voffA);
      PG8_BAR; PG8_WAIT_L(0); PG8_MMA(1, 0, At, B0); PG8_BAR; PG8_SCHED;
      PG8_STAGE(PG8_SB(1, 1), b3 + hstep, voffB);
      PG8_WAIT_V(6); PG8_BAR; PG8_MMA(1, 1, At, B1); PG8_BAR;
    }
    E(acc, cur, wr, wc, fr, fq);
    if (!has_next) break;
#pragma unroll
    for (int a = 0; a < 2; ++a)
#pragma unroll
      for (int b = 0; b < 2; ++b)
#pragma unroll
        for (int m = 0; m < 4; ++m)
#pragma unroll
          for (int n = 0; n < 2; ++n) acc[a][b][m][n] = (f32x4){0.f, 0.f, 0.f, 0.f};
    cur = nxt; cA = nA; cB = nB; ++ui;
  }
  PG8_WAIT_V(0);
  if (wr == 0) PG8_BAR;
  PG8_BAR;
#undef PG8_SA
#undef PG8_SB
#undef PG8_STAGE
#undef PG8_LDA
#undef PG8_LDB
#undef PG8_MMA
#undef PG8_WAIT_V
#undef PG8_WAIT_L
#undef PG8_BAR
#undef PG8_SCHED
}

typedef f32x4 acc_t[2][2][4][2];
DEVI void token_info(int token, bool ctx, int& b, int& s, int& key) {
  if (!ctx) { b = token >> 11; s = token & 2047; key = 256 + s; } else { const int tc = token - NLAT; b = tc >> 8; s = 0; key = tc & 255; }
}
DEVI void rope_pair(f32x4& lo, f32x4& hi2, const float2* __restrict__ tab, int pos, int fq) {
  const f32x4 t0 = *reinterpret_cast<const f32x4*>(tab + pos * 16 + fq * 4), t1 = *reinterpret_cast<const f32x4*>(tab + pos * 16 + fq * 4 + 2);
  const float cs[4] = {t0[0], t0[2], t1[0], t1[2]}, sn[4] = {t0[1], t0[3], t1[1], t1[3]};
#pragma unroll
  for (int e = 0; e < 4; ++e) { const float a = lo[e], b = hi2[e]; lo[e] = a * cs[e] - b * sn[e]; hi2[e] = b * cs[e] + a * sn[e]; }
}
DEVI void st4(bf16_t* dst, const f32x4& v) { u32x2 pk = {cvtpk(v[0], v[1]), cvtpk(v[2], v[3])}; *reinterpret_cast<u32x2*>(dst) = pk; }

struct EpiL0In {
  bf16_t *U, *GV, *ZA, *ZB, *Q0, *K0, *V0; const float2* rope;
  DEVI void operator()(acc_t& acc, const Unit& u, int wr, int wc, int fr, int fq) const {
    const int col0 = u.pn * 256, type = col0 >> 9; const bool ctx = u.pm >= 128;
#pragma unroll
    for (int ai = 0; ai < 2; ++ai)
#pragma unroll
      for (int m = 0; m < 4; ++m) {
        const int token = u.pm * 256 + ai * 128 + wr * 64 + m * 16 + fr;
        int b, s, key; token_info(token, ctx, b, s, key);
#pragma unroll
        for (int bj = 0; bj < 2; ++bj) {
          const int nl = (col0 & 511) + bj * 128 + wc * 32;
          f32x4 v0 = acc[ai][bj][m][0], v1 = acc[ai][bj][m][1];
          bf16_t* dst;
          if (type <= 1) {
#pragma unroll
            for (int e = 0; e < 4; ++e) { v0[e] = gelu_f(v0[e]); v1[e] = gelu_f(v1[e]); }
            dst = (type == 0 ? U : GV) + (size_t)token * 512 + nl;
          } else if (type == 2 || type == 6) {
#pragma unroll
            for (int e = 0; e < 4; ++e) { v0[e] = silu_f(v0[e]); v1[e] = silu_f(v1[e]); }
            dst = (type == 2 ? ZA : ZB) + (size_t)token * 512 + nl;
          } else if (type == 3) {
            if (!ctx) rope_pair(v0, v1, rope, (wc & 1) ? (s & 63) : (s >> 6), fq);
            dst = Q0 + (size_t)token * 512 + nl;
          } else if (type == 4) {
            if (!ctx) rope_pair(v0, v1, rope, (wc & 1) ? (s & 63) : (s >> 6), fq);
            dst = K0 + ((size_t)(b * 4 + (nl >> 7)) * KVL + key) * 128 + (nl & 127);
          } else {
            dst = V0 + ((size_t)(b * 4 + (nl >> 7)) * KVL + key) * 128 + (nl & 127);
          }
          st4(dst + fq * 4, v0); st4(dst + 16 + fq * 4, v1);
        }
      }
  }
};

template <bool HASCTX> struct EpiOut {
  const float* src_lat; const float* src_ctx; float* dst_lat; float* dst_ctx; const float* ada;
  DEVI void operator()(acc_t& acc, const Unit& u, int wr, int wc, int fr, int fq) const {
    const int col0 = u.pn * 256;
#pragma unroll
    for (int ai = 0; ai < 2; ++ai)
#pragma unroll
      for (int m = 0; m < 4; ++m) {
        const int token = u.pm * 256 + ai * 128 + wr * 64 + m * 16 + fr;
        const float* src; float* dst; const float* gate;
        if (!HASCTX || token < NLAT) { src = src_lat + (size_t)token * 1024; dst = dst_lat + (size_t)token * 1024; gate = ada + (token >> 11) * 3072 + 2048; }
        else { const int tc = token - NLAT; src = src_ctx + (size_t)tc * 1024; dst = dst_ctx + (size_t)tc * 1024; gate = ada + 16 * 3072 + 2048; }
#pragma unroll
        for (int bj = 0; bj < 2; ++bj)
#pragma unroll
          for (int n = 0; n < 2; ++n) {
            const int c = col0 + bj * 128 + wc * 32 + n * 16 + fq * 4;
            const f32x4 xv = *reinterpret_cast<const f32x4*>(src + c), g = *reinterpret_cast<const f32x4*>(gate + c);
            *reinterpret_cast<f32x4*>(dst + c) = xv + g * acc[ai][bj][m][n];
          }
      }
  }
};

struct EpiL1In {
  bf16_t *CQ, *CKV, *K1, *Z1; float *RQ, *RKV; const float2* rope; float* ssb;
  DEVI void operator()(acc_t& acc, const Unit& u, int wr, int wc, int fr, int fq) const {
    const int col0 = u.pn * 256; const bool ctx = u.pm >= 128;
    float ss[2][4];
#pragma unroll
    for (int ai = 0; ai < 2; ++ai)
#pragma unroll
      for (int m = 0; m < 4; ++m) {
        ss[ai][m] = 0.f;
        const int token = u.pm * 256 + ai * 128 + wr * 64 + m * 16 + fr;
        int b, s, key; token_info(token, ctx, b, s, key);
#pragma unroll
        for (int bj = 0; bj < 2; ++bj) {
          const int nb = col0 + bj * 128 + wc * 32;
          f32x4 v0 = acc[ai][bj][m][0], v1 = acc[ai][bj][m][1];
          if (nb < 384) {
#pragma unroll
            for (int e = 0; e < 4; ++e) ss[ai][m] += v0[e] * v0[e] + v1[e] * v1[e];
            bf16_t* dst = nb < 256 ? CQ + (size_t)token * 256 + nb : CKV + (size_t)token * 128 + (nb - 256);
            st4(dst + fq * 4, v0); st4(dst + 16 + fq * 4, v1);
          } else if (nb < 448) {
            if (!ctx) rope_pair(v0, v1, rope, (nb >= 416) ? (s & 63) : (s >> 6), fq);
#pragma unroll
            for (int h = 0; h < 8; ++h) {
              bf16_t* dst = K1 + ((size_t)(b * 8 + h) * KVL + key) * 192 + 128 + (nb - 384);
              st4(dst + fq * 4, v0); st4(dst + 16 + fq * 4, v1);
            }
          } else if (nb < 1472) {
            if (!ctx) {
#pragma unroll
              for (int e = 0; e < 4; ++e) { v0[e] = silu_f(v0[e]); v1[e] = silu_f(v1[e]); }
              bf16_t* dst = Z1 + (size_t)token * 1024 + (nb - 448);
              st4(dst + fq * 4, v0); st4(dst + 16 + fq * 4, v1);
            }
          }
        }
      }
    if (u.pn <= 1) {
#pragma unroll
      for (int ai = 0; ai < 2; ++ai)
#pragma unroll
        for (int m = 0; m < 4; ++m) {
          float sv = ss[ai][m]; sv = xsum<16>(sv); sv = xsum<32>(sv);
          if (fq == 0) ssb[wc * 256 + ai * 128 + wr * 64 + m * 16 + fr] = sv;
        }
      asm volatile("s_waitcnt lgkmcnt(0)" ::: "memory"); __builtin_amdgcn_s_barrier(); asm volatile("" ::: "memory");
      const int lt = wc * 64 + fq * 16 + fr;
      if (lt < 128) {
        const int row = (lt >> 6) * 128 + wr * 64 + (lt & 63);
        if (u.pn == 0) { const float tot = (ssb[row] + ssb[256 + row]) + (ssb[512 + row] + ssb[768 + row]); RQ[u.pm * 256 + row] = rsqrtf(tot * (1.f / 256.f) + 1e-6f); }
        else { const float tot = (ssb[row] + ssb[256 + row]) + (ssb[512 + row] + ssb[768 + row]); RKV[u.pm * 256 + row] = rsqrtf(tot * (1.f / 128.f) + 1e-6f); }
      }
    }
  }
};

struct EpiQ {
  bf16_t* Q1; const float* RQ; const float2* rope;
  DEVI void operator()(acc_t& acc, const Unit& u, int wr, int wc, int fr, int fq) const {
    const int col0 = u.pn * 256;
#pragma unroll
    for (int ai = 0; ai < 2; ++ai)
#pragma unroll
      for (int m = 0; m < 4; ++m) {
        const int token = u.pm * 256 + ai * 128 + wr * 64 + m * 16 + fr; const int s = token & 2047; const float rq = RQ[token];
#pragma unroll
        for (int bj = 0; bj < 2; ++bj) {
          const int n0 = col0 + bj * 128 + wc * 32; const int dd0 = n0 % 192;
          f32x4 v0 = acc[ai][bj][m][0] * rq, v1 = acc[ai][bj][m][1] * rq;
          if (dd0 >= 128) rope_pair(v0, v1, rope, (dd0 >= 160) ? (s & 63) : (s >> 6), fq);
          bf16_t* dst = Q1 + (size_t)token * 1536 + n0;
          st4(dst + fq * 4, v0); st4(dst + 16 + fq * 4, v1);
        }
      }
  }
};

struct EpiKV {
  bf16_t *K1, *V1; const float* RKV;
  DEVI void operator()(acc_t& acc, const Unit& u, int wr, int wc, int fr, int fq) const {
    const int col0 = u.pn * 256; const bool ctx = u.pm >= 128;
#pragma unroll
    for (int ai = 0; ai < 2; ++ai)
#pragma unroll
      for (int m = 0; m < 4; ++m) {
        const int token = u.pm * 256 + ai * 128 + wr * 64 + m * 16 + fr; const float rk = RKV[token];
        int b, s, key; token_info(token, ctx, b, s, key);
#pragma unroll
        for (int bj = 0; bj < 2; ++bj) {
          const int nb = col0 + bj * 128 + wc * 32; const int h = nb >> 8, dd = nb & 255;
          const f32x4 v0 = acc[ai][bj][m][0] * rk, v1 = acc[ai][bj][m][1] * rk;
          bf16_t* dst = dd < 128 ? K1 + ((size_t)(b * 8 + h) * KVL + key) * 192 + dd : V1 + ((size_t)(b * 8 + h) * KVL + key) * 128 + (dd - 128);
          st4(dst + fq * 4, v0); st4(dst + 16 + fq * 4, v1);
        }
      }
  }
};

template <int SCID> struct ScaleOf { static constexpr float v = SCID == 0 ? 0.125f : 0.07216878364870322f; };
constexpr float THR = 8.f;
template <int KW> DEVI int kswz(int row, int colB) { return row * (KW * 2 + 16) + colB; }
DEVI int v_st(int k, int c) { const int kk = (k & ~0xC) | ((k & 4) << 1) | ((k & 8) >> 1); return ((kk >> 3) * 4 + (c >> 5)) * 512 + ((kk & 7) * 32 + (c & 31)) * 2; }
DEVI int v_rd_base(int lane) { return ((lane & 3) << 3) | (((lane >> 2) & 3) << 6) | (((lane >> 4) & 1) << 5) | (((lane >> 5) & 1) << 8); }
constexpr int v_rd_off(int d0, int ks, int half) { return d0 * 512 + ks * 4096 + half * 2048; }
template <int OFF> DEVI s16x4 tr_read(int vb) { s16x4 r; asm volatile("ds_read_b64_tr_b16 %0, %1 offset:%2" : "=&v"(r) : "v"(vb), "i"(OFF) : "memory"); return r; }

template <int SCID>
DEVI void partialSM(f32x16& p0, f32x16& p1, float& m_reg, float& mn, float& alpha) {
  constexpr float SC = ScaleOf<SCID>::v; constexpr float C = SC * 1.4426950408889634f;
  float pmax = p0[0];
#pragma unroll
  for (int r = 1; r < 16; ++r) pmax = fmaxf(pmax, p0[r]);
#pragma unroll
  for (int r = 0; r < 16; ++r) pmax = fmaxf(pmax, p1[r]);
  { auto rr = __builtin_amdgcn_permlane32_swap(__float_as_uint(pmax), __float_as_uint(pmax), false, false);
    pmax = fmaxf(__uint_as_float(rr[0]), __uint_as_float(rr[1])); }
  if (__builtin_expect(__all(pmax - m_reg <= THR / SC), 1)) { mn = m_reg; alpha = 1.f; }
  else { mn = fmaxf(m_reg, pmax); alpha = __builtin_amdgcn_exp2f((m_reg - mn) * C); m_reg = mn; }
  const float mnC = -mn * C;
#pragma unroll
  for (int r = 0; r < 16; ++r) p0[r] = fmaf(p0[r], C, mnC);
#pragma unroll
  for (int r = 0; r < 16; ++r) p1[r] = fmaf(p1[r], C, mnC);
#pragma unroll
  for (int r = 0; r < 16; ++r) p0[r] = __builtin_amdgcn_exp2f(p0[r]);
}
DEVI void finishSM(f32x16& p0, f32x16& p1, float alpha, float& l_reg, bf16x8& pa0, bf16x8& pa1, bf16x8& pa2, bf16x8& pa3) {
#pragma unroll
  for (int r = 0; r < 16; ++r) p1[r] = __builtin_amdgcn_exp2f(p1[r]);
  float ps = 0;
#pragma unroll
  for (int r = 0; r < 16; ++r) ps += p0[r];
#pragma unroll
  for (int r = 0; r < 16; ++r) ps += p1[r];
  { auto rr = __builtin_amdgcn_permlane32_swap(__float_as_uint(ps), __float_as_uint(ps), false, false);
    ps = __uint_as_float(rr[0]) + __uint_as_float(rr[1]); }
  l_reg = l_reg * alpha + ps;
#define PK4(P, BASE, OUT) do { unsigned a0 = cvtpk(P[BASE + 0], P[BASE + 1]), a1 = cvtpk(P[BASE + 2], P[BASE + 3]); \
    unsigned b0 = cvtpk(P[BASE + 4], P[BASE + 5]), b1 = cvtpk(P[BASE + 6], P[BASE + 7]); \
    auto r0 = __builtin_amdgcn_permlane32_swap(a0, b0, false, false); auto r1 = __builtin_amdgcn_permlane32_swap(a1, b1, false, false); \
    u32x4 w = {r0[0], r1[0], r0[1], r1[1]}; OUT = *reinterpret_cast<bf16x8*>(&w); } while (0)
  PK4(p0, 0, pa0); PK4(p0, 8, pa1); PK4(p1, 0, pa2); PK4(p1, 8, pa3);
#undef PK4
}
template <int KW, int NQ, int QL = 0>
DEVI void qkt(f32x16& p0, f32x16& p1, const char* Ks, const bf16x8* qr, int kcol0, int r32, int hi, const char* ql = nullptr) {
#pragma unroll
  for (int r = 0; r < 16; ++r) { p0[r] = 0.f; p1[r] = 0.f; }
  const char* kb = Ks + kswz<KW>(r32, (kcol0 + hi * 8) * 2);
  constexpr int ROW32 = 32 * (KW * 2 + 16);
  bf16x8 b0n = *reinterpret_cast<const bf16x8*>(kb), b1n = *reinterpret_cast<const bf16x8*>(kb + ROW32);
#pragma unroll
  for (int d0 = 0; d0 < NQ; ++d0) {
    const bf16x8 b0 = b0n, b1 = b1n;
    bf16x8 q;
    if constexpr (QL > 0) { if (d0 >= NQ - QL) q = *reinterpret_cast<const bf16x8*>(ql + (d0 - (NQ - QL)) * 32); else q = qr[d0]; } else q = qr[d0];
    if (d0 + 1 < NQ) { b0n = *reinterpret_cast<const bf16x8*>(kb + (d0 + 1) * 32); b1n = *reinterpret_cast<const bf16x8*>(kb + ROW32 + (d0 + 1) * 32); }
    SBAR();
    p0 = __builtin_amdgcn_mfma_f32_32x32x16_bf16(b0, q, p0, 0, 0, 0);
    p1 = __builtin_amdgcn_mfma_f32_32x32x16_bf16(b1, q, p1, 0, 0, 0);
  }
}
template <int D0> DEVI void pv_one(f32x16& od, int vb, bf16x8 pa0, bf16x8 pa1, bf16x8 pa2, bf16x8 pa3) {
  const s16x4 l0 = tr_read<v_rd_off(D0, 0, 0)>(vb), h0 = tr_read<v_rd_off(D0, 0, 1)>(vb), l1 = tr_read<v_rd_off(D0, 1, 0)>(vb), h1 = tr_read<v_rd_off(D0, 1, 1)>(vb);
  const s16x4 l2 = tr_read<v_rd_off(D0, 2, 0)>(vb), h2 = tr_read<v_rd_off(D0, 2, 1)>(vb), l3 = tr_read<v_rd_off(D0, 3, 0)>(vb), h3 = tr_read<v_rd_off(D0, 3, 1)>(vb);
  asm volatile("s_waitcnt lgkmcnt(0)" ::: "memory"); SBAR();
#define PK(L, H) (bf16x8){L[0], L[1], L[2], L[3], H[0], H[1], H[2], H[3]}
  od = __builtin_amdgcn_mfma_f32_32x32x16_bf16(pa0, PK(l0, h0), od, 0, 0, 0);
  od = __builtin_amdgcn_mfma_f32_32x32x16_bf16(pa1, PK(l1, h1), od, 0, 0, 0);
  od = __builtin_amdgcn_mfma_f32_32x32x16_bf16(pa2, PK(l2, h2), od, 0, 0, 0);
  od = __builtin_amdgcn_mfma_f32_32x32x16_bf16(pa3, PK(l3, h3), od, 0, 0, 0);
#undef PK
}
DEVI void pv_d0(f32x16* o, int vb, bf16x8 pa0, bf16x8 pa1, bf16x8 pa2, bf16x8 pa3) {
  pv_one<0>(o[0], vb, pa0, pa1, pa2, pa3); pv_one<1>(o[1], vb, pa0, pa1, pa2, pa3); pv_one<2>(o[2], vb, pa0, pa1, pa2, pa3); pv_one<3>(o[3], vb, pa0, pa1, pa2, pa3);
}

template <int KW, int NQ, int SCID>
DEVI void attn_core(int wv, const bf16_t* __restrict__ Qw, const bf16_t* __restrict__ Kh, const bf16_t* __restrict__ Vh, int kcol0, int NT, char* lds,
                    f32x16 (&o)[4], float& l_out) {
  constexpr int SHM_V = 64 * 128 * 2, SHM_K = 64 * (KW * 2 + 16), KC = KW / 64;
  const int tid = tidx(wv), wid = tid >> 6, lane = tid & 63, r32 = lane & 31, hi = lane >> 5;
  char* V_lds = lds; char* K_lds = lds + 2 * SHM_V;
  float* al_l = (float*)(lds + 2 * SHM_V + 2 * SHM_K) + wid * 64 + 32;
  float m_reg = -1e30f, l_reg = 0;
#pragma unroll
  for (int d = 0; d < 4; ++d)
#pragma unroll
    for (int r = 0; r < 16; ++r) o[d][r] = 0.f;
  bf16x8 qr[NQ];
#pragma unroll
  for (int d0 = 0; d0 < NQ; ++d0) qr[d0] = *reinterpret_cast<const bf16x8*>(Qw + d0 * 16);
  const int sr = tid >> 4, sc = (tid & 15) * 8, vst0 = v_st(sr, sc), vst1 = v_st(32 + sr, sc);
  const int krow = tid >> 3, kch = tid & 7;
  const bf16_t* vg = Vh + sr * 128 + sc;
  const bf16_t* kg = Kh + krow * KW + kch * 8;
  const int vb0 = (int)(uintptr_t)V_lds + v_rd_base(lane);
  bf16x8 vs0, vs1, ks[KC];
#define SLOAD(k0) do { vs0 = *reinterpret_cast<const bf16x8*>(vg + (size_t)(k0) * 128); vs1 = *reinterpret_cast<const bf16x8*>(vg + (size_t)((k0) + 32) * 128); \
    _Pragma("unroll") for (int _c = 0; _c < KC; ++_c) ks[_c] = *reinterpret_cast<const bf16x8*>(kg + (size_t)(k0) * KW + _c * 64); } while (0)
#define SWRITE(b) do { *reinterpret_cast<bf16x8*>(V_lds + (b) * SHM_V + vst0) = vs0; *reinterpret_cast<bf16x8*>(V_lds + (b) * SHM_V + vst1) = vs1; \
    _Pragma("unroll") for (int _c = 0; _c < KC; ++_c) *reinterpret_cast<bf16x8*>(K_lds + (b) * SHM_K + kswz<KW>(krow, (kch + 8 * _c) * 16)) = ks[_c]; } while (0)
  SLOAD(0); SWRITE(0);
  if (NT > 1) SLOAD(64);
  __syncthreads();
  for (int j = 0; j < NT; ++j) {
    const int bsel = j & 1;
    f32x16 p0, p1; float mn, alpha; bf16x8 pa0, pa1, pa2, pa3;
    qkt<KW, NQ>(p0, p1, K_lds + bsel * SHM_K, qr, kcol0, r32, hi);
    partialSM<SCID>(p0, p1, m_reg, mn, alpha);
    if (__any(alpha < 1.f)) {
      if (hi == 0) al_l[r32] = alpha;
      asm volatile("s_waitcnt lgkmcnt(0)" ::: "memory");
#pragma unroll
      for (int d = 0; d < 4; ++d)
#pragma unroll
        for (int r = 0; r < 16; ++r) o[d][r] *= al_l[crow(r, hi)];
    }
    finishSM(p0, p1, alpha, l_reg, pa0, pa1, pa2, pa3);
    pv_d0(o, vb0 + bsel * SHM_V, pa0, pa1, pa2, pa3);
    if (j + 1 < NT) { SWRITE(bsel ^ 1); if (j + 2 < NT) SLOAD((j + 2) * 64); }
    __syncthreads();
  }
  l_out = l_reg;
#undef SLOAD
#undef SWRITE
}

template <int KW, int NQ, int SDEPTH, int SCID, int QL>
DEVI void attn_core_pipe(int wv, const bf16_t* __restrict__ Qw, const bf16_t* __restrict__ Kh, const bf16_t* __restrict__ Vh, int kcol0, int NT, char* lds,
                         f32x16 (&o)[4], float& l_out) {
  constexpr int SHM_V = 64 * 128 * 2, SHM_K = 64 * (KW * 2 + 16), KC = KW / 64;
  const int tid = tidx(wv), wid = tid >> 6, lane = tid & 63, r32 = lane & 31, hi = lane >> 5;
  char* V_lds = lds; char* K_lds = lds + 2 * SHM_V;
  float* al_l = (float*)(lds + 2 * SHM_V + 2 * SHM_K) + wid * 64 + 32;
  float m_reg = -1e30f, l_reg = 0;
#pragma unroll
  for (int d = 0; d < 4; ++d)
#pragma unroll
    for (int r = 0; r < 16; ++r) o[d][r] = 0.f;
  bf16x8 qr[NQ - QL + (QL ? 1 : 0)];
#pragma unroll
  for (int d0 = 0; d0 < NQ - QL; ++d0) qr[d0] = *reinterpret_cast<const bf16x8*>(Qw + d0 * 16);
  char* ql = lds + 2 * SHM_V + 2 * SHM_K + 2048 + (wid * 32 + r32) * 144 + hi * 16;
  if constexpr (QL > 0) {
#pragma unroll
    for (int d0 = NQ - QL; d0 < NQ; ++d0) *reinterpret_cast<bf16x8*>(ql + (d0 - (NQ - QL)) * 32) = *reinterpret_cast<const bf16x8*>(Qw + d0 * 16);
  }
  const int sr = tid >> 4, sc = (tid & 15) * 8, vst0 = v_st(sr, sc), vst1 = v_st(32 + sr, sc);
  const int krow = tid >> 3, kch = tid & 7;
  const bf16_t* vg = Vh + sr * 128 + sc;
  const bf16_t* kg = Kh + krow * KW + kch * 8;
  const int vb0 = (int)(uintptr_t)V_lds + v_rd_base(lane);
  struct { bf16x8 vs0, vs1, ks[KC]; } sr_[SDEPTH];
#define SLOAD(i, k0) do { sr_[i].vs0 = *reinterpret_cast<const bf16x8*>(vg + (size_t)(k0) * 128); sr_[i].vs1 = *reinterpret_cast<const bf16x8*>(vg + (size_t)((k0) + 32) * 128); \
    _Pragma("unroll") for (int _c = 0; _c < KC; ++_c) sr_[i].ks[_c] = *reinterpret_cast<const bf16x8*>(kg + (size_t)(k0) * KW + _c * 64); } while (0)
#define SWRITE(b, i) do { *reinterpret_cast<bf16x8*>(V_lds + (b) * SHM_V + vst0) = sr_[i].vs0; *reinterpret_cast<bf16x8*>(V_lds + (b) * SHM_V + vst1) = sr_[i].vs1; \
    _Pragma("unroll") for (int _c = 0; _c < KC; ++_c) *reinterpret_cast<bf16x8*>(K_lds + (b) * SHM_K + kswz<KW>(krow, (kch + 8 * _c) * 16)) = sr_[i].ks[_c]; } while (0)
#define SWAIT() do { if constexpr (SDEPTH == 2) asm volatile("s_waitcnt vmcnt(4)" ::: "memory"); else asm volatile("s_waitcnt vmcnt(0)" ::: "memory"); } while (0)
#define RESC(a) do { if (__any((a) < 1.f)) { if (hi == 0) al_l[r32] = (a); asm volatile("s_waitcnt lgkmcnt(0)" ::: "memory"); \
    _Pragma("unroll") for (int _d = 0; _d < 4; ++_d) _Pragma("unroll") for (int _r = 0; _r < 16; ++_r) o[_d][_r] *= al_l[crow(_r, hi)]; } } while (0)
  f32x16 pA0, pA1, pB0, pB1; float mnA, mnB, alA, alB; bf16x8 pa0, pa1, pa2, pa3;
  constexpr int SE = 0, SO = SDEPTH - 1;
  SLOAD(SE, 0); asm volatile("s_waitcnt vmcnt(0)" ::: "memory"); SWRITE(0, SE); __syncthreads();
  qkt<KW, NQ, QL>(pA0, pA1, K_lds, qr, kcol0, r32, hi, ql); partialSM<SCID>(pA0, pA1, m_reg, mnA, alA);
  SLOAD(SO, 64); if constexpr (SDEPTH == 2) { if (2 < NT) SLOAD(SE, 128); }
  SWAIT(); SWRITE(1, SO); __syncthreads();
  for (int j = 1; j + 1 < NT; j += 2) {
    SBAR(); qkt<KW, NQ, QL>(pB0, pB1, K_lds + SHM_K, qr, kcol0, r32, hi, ql);
    finishSM(pA0, pA1, alA, l_reg, pa0, pa1, pa2, pa3); SBAR();
    SLOAD(SO, (j + SDEPTH) * 64); SBAR();
    pv_d0(o, vb0, pa0, pa1, pa2, pa3); partialSM<SCID>(pB0, pB1, m_reg, mnB, alB);
    __syncthreads(); SWAIT(); SWRITE(0, SE);
    RESC(alB); __syncthreads();
    SBAR(); qkt<KW, NQ, QL>(pA0, pA1, K_lds, qr, kcol0, r32, hi, ql);
    finishSM(pB0, pB1, alB, l_reg, pa0, pa1, pa2, pa3); SBAR();
    if (SDEPTH == 1 || j + 3 < NT) SLOAD(SE, (j + 1 + SDEPTH) * 64);
    SBAR();
    pv_d0(o, vb0 + SHM_V, pa0, pa1, pa2, pa3); partialSM<SCID>(pA0, pA1, m_reg, mnA, alA);
    __syncthreads(); SWAIT(); SWRITE(1, SO);
    RESC(alA); __syncthreads();
  }
  SBAR(); qkt<KW, NQ, QL>(pB0, pB1, K_lds + SHM_K, qr, kcol0, r32, hi, ql);
  finishSM(pA0, pA1, alA, l_reg, pa0, pa1, pa2, pa3); SBAR();
  pv_d0(o, vb0, pa0, pa1, pa2, pa3); partialSM<SCID>(pB0, pB1, m_reg, mnB, alB);
  __syncthreads(); RESC(alB);
  finishSM(pB0, pB1, alB, l_reg, pa0, pa1, pa2, pa3); SBAR();
  pv_d0(o, vb0 + SHM_V, pa0, pa1, pa2, pa3);
  __syncthreads();
  l_out = l_reg;
#undef SLOAD
#undef SWRITE
#undef SWAIT
#undef RESC
}

template <int KW, int NQ, int SCID, int QL>
DEVI void attn_core_dma(int wv, const bf16_t* __restrict__ Qw, const bf16_t* __restrict__ Kh, const bf16_t* __restrict__ Vh, int kcol0, int NT, char* lds,
                        f32x16 (&o)[4], float& l_out) {
  constexpr int SHM_V = 64 * 128 * 2, KCH = KW / 8 + 1, SHM_K = 64 * KCH * 16, KR = (64 * KCH) / 512;
  static_assert(64 * KCH - KR * 512 == 64, "remainder must be one wave");
  const int tid = tidx(wv), wid = tid >> 6, lane = tid & 63, r32 = lane & 31, hi = lane >> 5;
  char* V_lds = lds; char* K_lds = lds + 2 * SHM_V;
  float* al_l = (float*)(lds + 2 * SHM_V + 2 * SHM_K) + wid * 64 + 32;
  float m_reg = -1e30f, l_reg = 0;
#pragma unroll
  for (int d = 0; d < 4; ++d)
#pragma unroll
    for (int r = 0; r < 16; ++r) o[d][r] = 0.f;
  bf16x8 qr[NQ - QL + (QL ? 1 : 0)];
#pragma unroll
  for (int d0 = 0; d0 < NQ - QL; ++d0) qr[d0] = *reinterpret_cast<const bf16x8*>(Qw + d0 * 16);
  char* ql = lds + 2 * SHM_V + 2 * SHM_K + 2048 + (wid * 32 + r32) * 144 + hi * 16;
  if constexpr (QL > 0) {
#pragma unroll
    for (int d0 = NQ - QL; d0 < NQ; ++d0) *reinterpret_cast<bf16x8*>(ql + (d0 - (NQ - QL)) * 32) = *reinterpret_cast<const bf16x8*>(Qw + d0 * 16);
  }
  const int sr = tid >> 4, sc = (tid & 15) * 8, vst0 = v_st(sr, sc), vst1 = v_st(32 + sr, sc);
  const bf16_t* vg = Vh + sr * 128 + sc;
  const int vb0 = (int)(uintptr_t)V_lds + v_rd_base(lane);
  unsigned koff[KR + 1];
#pragma unroll
  for (int i = 0; i <= KR; ++i) { const int c = tid + 512 * i; const int row = c / KCH; int ch = c - row * KCH; ch = ch == KCH - 1 ? KCH - 2 : ch; koff[i] = (unsigned)(row * KW + ch * 8) * 2u; }
  const unsigned kldsw = (unsigned)__builtin_amdgcn_readfirstlane(wid) * 1024u;
  bf16x8 vs0, vs1;
#define KDMA(k0, b) do { const char* _g = (const char*)(Kh + (size_t)(k0) * KW); PG8_LAS unsigned char* _l = (PG8_LAS unsigned char*)(K_lds + (b) * SHM_K) + kldsw; \
    _Pragma("unroll") for (int _i = 0; _i < KR; ++_i) __builtin_amdgcn_global_load_lds((const unsigned*)(_g + koff[_i]), (PG8_LAS unsigned*)(_l + _i * 8192), 16, 0, 0); \
    if (wid == 0) __builtin_amdgcn_global_load_lds((const unsigned*)(_g + koff[KR]), (PG8_LAS unsigned*)(_l + KR * 8192), 16, 0, 0); } while (0)
#define VLOAD(k0) do { vs0 = *reinterpret_cast<const bf16x8*>(vg + (size_t)(k0) * 128); vs1 = *reinterpret_cast<const bf16x8*>(vg + (size_t)((k0) + 32) * 128); } while (0)
#define VWRITE(b) do { *reinterpret_cast<bf16x8*>(V_lds + (b) * SHM_V + vst0) = vs0; *reinterpret_cast<bf16x8*>(V_lds + (b) * SHM_V + vst1) = vs1; } while (0)
#define VMW() asm volatile("s_waitcnt vmcnt(0)" ::: "memory")
#define RESC(a) do { if (__any((a) < 1.f)) { if (hi == 0) al_l[r32] = (a); asm volatile("s_waitcnt lgkmcnt(0)" ::: "memory"); \
    _Pragma("unroll") for (int _d = 0; _d < 4; ++_d) _Pragma("unroll") for (int _r = 0; _r < 16; ++_r) o[_d][_r] *= al_l[crow(_r, hi)]; } } while (0)
  f32x16 pA0, pA1, pB0, pB1; float mnA, mnB, alA, alB; bf16x8 pa0, pa1, pa2, pa3;
  KDMA(0, 0); VLOAD(0); VMW(); VWRITE(0); __syncthreads();
  KDMA(64, 1); VLOAD(64);
  qkt<KW, NQ, QL>(pA0, pA1, K_lds, qr, kcol0, r32, hi, ql); partialSM<SCID>(pA0, pA1, m_reg, mnA, alA);
  VMW(); __syncthreads(); VWRITE(1); __syncthreads();
  for (int j = 1; j + 1 < NT; j += 2) {
    SBAR(); KDMA((j + 1) * 64, 0); VLOAD((j + 1) * 64); SBAR();
    qkt<KW, NQ, QL>(pB0, pB1, K_lds + SHM_K, qr, kcol0, r32, hi, ql);
    finishSM(pA0, pA1, alA, l_reg, pa0, pa1, pa2, pa3); SBAR();
    pv_d0(o, vb0, pa0, pa1, pa2, pa3); partialSM<SCID>(pB0, pB1, m_reg, mnB, alB);
    VMW(); __syncthreads(); VWRITE(0);
    RESC(alB); __syncthreads();
    SBAR(); KDMA((j + 2) * 64, 1); VLOAD((j + 2) * 64); SBAR();
    qkt<KW, NQ, QL>(pA0, pA1, K_lds, qr, kcol0, r32, hi, ql);
    finishSM(pB0, pB1, alB, l_reg, pa0, pa1, pa2, pa3); SBAR();
    pv_d0(o, vb0 + SHM_V, pa0, pa1, pa2, pa3); partialSM<SCID>(pA0, pA1, m_reg, mnA, alA);
    VMW(); __syncthreads(); VWRITE(1);
    RESC(alA); __syncthreads();
  }
  SBAR(); qkt<KW, NQ, QL>(pB0, pB1, K_lds + SHM_K, qr, kcol0, r32, hi, ql);
  finishSM(pA0, pA1, alA, l_reg, pa0, pa1, pa2, pa3); SBAR();
  pv_d0(o, vb0, pa0, pa1, pa2, pa3); partialSM<SCID>(pB0, pB1, m_reg, mnB, alB);
  RESC(alB);
  finishSM(pB0, pB1, alB, l_reg, pa0, pa1, pa2, pa3); SBAR();
  pv_d0(o, vb0 + SHM_V, pa0, pa1, pa2, pa3);
  __syncthreads();
  l_out = l_reg;
#undef KDMA
#undef VLOAD
#undef VWRITE
#undef VMW
#undef RESC
}

DEVI void attn0_item(int wv, const Params& p, int token0, int b, int h, int nkeys, char* lds) {
  const int tid = tidx(wv), wid = tid >> 6, lane = tid & 63, r32 = lane & 31, hi = lane >> 5, m = wid >> 2, wl = wid & 3;
  const bf16_t* Q0 = (const bf16_t*)(p.ws + OFF_Q0); const bf16_t* K0 = (const bf16_t*)(p.ws + OFF_K0); const bf16_t* V0 = (const bf16_t*)(p.ws + OFF_V0);
  const bf16_t* ZB = (const bf16_t*)(p.ws + OFF_ZB); bf16_t* MIX = (bf16_t*)(p.ws + OFF_MIX);
  const bf16_t* Qw = Q0 + (size_t)(token0 + wl * 32 + r32) * 512 + h * 128 + m * 64 + hi * 8;
  const size_t kvo = (size_t)(b * 4 + h) * KVL * 128;
  f32x16 o[4]; float l;
  attn_core_dma<128, 4, 0, 0>(wv, Qw, K0 + kvo, V0 + kvo, m * 64, nkeys >> 6, lds, o, l);
  float* li_l = (float*)(lds + 32768 + 2 * 64 * 272) + wid * 64;
  if (hi == 0) li_l[r32] = l;
  asm volatile("s_waitcnt lgkmcnt(0)" ::: "memory");
  float rli[16];
#pragma unroll
  for (int r = 0; r < 16; ++r) rli[r] = __builtin_amdgcn_rcpf(li_l[crow(r, hi)]);
  float t1 = p.b_lq1[lane] * p.b_lk1[lane], t2 = p.b_lq2[lane] * p.b_lk2[lane];
  t1 = wave_sum(t1); t2 = wave_sum(t2);
  const float lam = __expf(t1) - __expf(t2) + 0.2f;
  __syncthreads();
  float* xch = (float*)lds;
  if (m == 1) {
#pragma unroll
    for (int r = 0; r < 16; ++r)
#pragma unroll
      for (int d0 = 0; d0 < 4; ++d0) xch[(wl * 32 + crow(r, hi)) * 128 + d0 * 32 + r32] = o[d0][r] * rli[r];
  }
  __syncthreads();
  if (m == 0) {
    float sw4[4];
#pragma unroll
    for (int d0 = 0; d0 < 4; ++d0) sw4[d0] = p.b_subln_w[d0 * 32 + r32];
#pragma unroll
    for (int r = 0; r < 16; ++r) {
      const int row = wl * 32 + crow(r, hi); const int token = token0 + row;
      float a[4], ss = 0.f;
#pragma unroll
      for (int d0 = 0; d0 < 4; ++d0) { a[d0] = o[d0][r] * rli[r] - lam * xch[row * 128 + d0 * 32 + r32]; ss += a[d0] * a[d0]; }
      ss = xsum<1>(ss); ss = xsum<2>(ss); ss = xsum<4>(ss); ss = xsum<8>(ss); ss = xsum<16>(ss);
      const float rstd = rsqrtf(ss * (1.f / 128.f) + 1e-5f) * 0.8f;
#pragma unroll
      for (int d0 = 0; d0 < 4; ++d0) {
        const int d = d0 * 32 + r32;
        const float val = a[d0] * rstd * sw4[d0] * bf2f(ZB[(size_t)token * 512 + h * 128 + d]);
        MIX[(size_t)token * 1024 + 512 + h * 128 + d] = f2bf(val);
      }
    }
  }
  __syncthreads();
}

DEVI void attn1_item(int wv, const Params& p, int b, int h, int qb, char* lds) {
  const int tid = tidx(wv), wid = tid >> 6, lane = tid & 63, r32 = lane & 31, hi = lane >> 5;
  const bf16_t* Q1 = (const bf16_t*)(p.ws + OFF_Q1); const bf16_t* K1 = (const bf16_t*)(p.ws + OFF_K1); const bf16_t* V1 = (const bf16_t*)(p.ws + OFF_V1);
  const bf16_t* Z1 = (const bf16_t*)(p.ws + OFF_Z1); bf16_t* MIX = (bf16_t*)(p.ws + OFF_MIX);
  const int token0 = b * 2048 + qb * 256;
  const bf16_t* Qw = Q1 + (size_t)(token0 + wid * 32 + r32) * 1536 + h * 192 + hi * 8;
  f32x16 o[4]; float l;
  attn_core_dma<192, 12, 1, 4>(wv, Qw, K1 + (size_t)(b * 8 + h) * KVL * 192, V1 + (size_t)(b * 8 + h) * KVL * 128, 0, KVL / 64, lds, o, l);
  float* li_l = (float*)(lds + 32768 + 2 * 64 * 400) + wid * 64;
  if (hi == 0) li_l[r32] = l;
  asm volatile("s_waitcnt lgkmcnt(0)" ::: "memory");
#pragma unroll
  for (int r = 0; r < 16; ++r) {
    const int cr = crow(r, hi); const float rl = __builtin_amdgcn_rcpf(li_l[cr]); const int token = token0 + wid * 32 + cr;
#pragma unroll
    for (int d0 = 0; d0 < 4; ++d0) {
      const int d = h * 128 + d0 * 32 + r32;
      MIX[(size_t)token * 1024 + d] = f2bf(o[d0][r] * rl * bf2f(Z1[(size_t)token * 1024 + d]));
    }
  }
  __syncthreads();
}

DEVI void abranch_item(int wv, const Params& p, int ci, char* lds) {
  const int tid = tidx(wv), wid = tid >> 6, lane = tid & 63, r32 = lane & 31, hi = lane >> 5;
  const bf16_t* GV = (const bf16_t*)(p.ws + OFF_GV); const bf16_t* U = (const bf16_t*)(p.ws + OFF_U); const bf16_t* ZA = (const bf16_t*)(p.ws + OFF_ZA);
  const bf16_t* WSB = (const bf16_t*)(p.ws + OFF_WSB); bf16_t* MIX = (bf16_t*)(p.ws + OFF_MIX);
  const int t0 = ci * 128;
  bf16_t* vnT = (bf16_t*)lds;
  {
    const int pos = tid >> 2, cp = tid & 3;
    const bf16_t* g = GV + (size_t)(t0 + pos) * 512;
    float s = 0.f, q = 0.f;
#pragma unroll 4
    for (int i = 0; i < 16; ++i) {
      const bf16x8 raw = *reinterpret_cast<const bf16x8*>(g + (i * 4 + cp) * 8);
#pragma unroll
      for (int e = 0; e < 8; ++e) { const float xv = bf2f((bf16_t)raw[e]); s += xv; q += xv * xv; }
    }
    s = xsum<1>(s); s = xsum<2>(s); q = xsum<1>(q); q = xsum<2>(q);
    const float mu = s * (1.f / 512.f);
    const float rstd = rsqrtf(fmaxf(q * (1.f / 512.f) - mu * mu, 0.f) + 1e-5f);
#pragma unroll 2
    for (int i = 0; i < 16; ++i) {
      const int c0 = (i * 4 + cp) * 8;
      const bf16x8 raw = *reinterpret_cast<const bf16x8*>(g + c0);
      const f32x4 w0 = *reinterpret_cast<const f32x4*>(p.a_ln_w + c0), w1 = *reinterpret_cast<const f32x4*>(p.a_ln_w + c0 + 4);
      const f32x4 b0 = *reinterpret_cast<const f32x4*>(p.a_ln_b + c0), b1 = *reinterpret_cast<const f32x4*>(p.a_ln_b + c0 + 4);
#pragma unroll
      for (int e = 0; e < 8; ++e) {
        const float wv = e < 4 ? w0[e & 3] : w1[e & 3], bv = e < 4 ? b0[e & 3] : b1[e & 3];
        vnT[(c0 + e) * 136 + pos] = f2bf((bf2f((bf16_t)raw[e]) - mu) * rstd * wv + bv);
      }
    }
  }
  __syncthreads();
  const int g8 = wid;
  const bf16_t* Wg = WSB + g8 * 128 * 128;
  for (int pb = 0; pb < 4; ++pb) {
    f32x16 acc[2];
#pragma unroll
    for (int r = 0; r < 16; ++r) { acc[0][r] = 0.f; acc[1][r] = 0.f; }
#pragma unroll
    for (int ks = 0; ks < 8; ++ks) {
      const bf16x8 bw = *reinterpret_cast<const bf16x8*>(Wg + (pb * 32 + r32) * 128 + ks * 16 + hi * 8);
#pragma unroll
      for (int db = 0; db < 2; ++db) {
        const bf16x8 a = *reinterpret_cast<const bf16x8*>(vnT + (g8 * 64 + db * 32 + r32) * 136 + ks * 16 + hi * 8);
        acc[db] = __builtin_amdgcn_mfma_f32_32x32x16_bf16(a, bw, acc[db], 0, 0, 0);
      }
    }
    const int token = t0 + pb * 32 + r32; const float bias = p.a_bs[g8 * 128 + pb * 32 + r32];
#pragma unroll
    for (int db = 0; db < 2; ++db)
#pragma unroll
      for (int rg = 0; rg < 4; ++rg) {
        const int c = g8 * 64 + db * 32 + rg * 8 + hi * 4;
        const u32x2 u2 = *reinterpret_cast<const u32x2*>(U + (size_t)token * 512 + c), z2 = *reinterpret_cast<const u32x2*>(ZA + (size_t)token * 512 + c);
        const float o0 = bflo(u2[0]) * (acc[db][rg * 4 + 0] + bias) * bflo(z2[0]), o1 = bfhi(u2[0]) * (acc[db][rg * 4 + 1] + bias) * bfhi(z2[0]);
        const float o2 = bflo(u2[1]) * (acc[db][rg * 4 + 2] + bias) * bflo(z2[1]), o3 = bfhi(u2[1]) * (acc[db][rg * 4 + 3] + bias) * bfhi(z2[1]);
        u32x2 pk = {cvtpk(o0, o1), cvtpk(o2, o3)};
        *reinterpret_cast<u32x2*>(MIX + (size_t)token * 1024 + c) = pk;
      }
  }
  __syncthreads();
}

DEVI void tr_tile(int wv, const float* __restrict__ src, bf16_t* __restrict__ dst, int K, int N, int tilesN, const float* __restrict__ scale, int t, char* lds) {
  const int tid = tidx(wv);
  const int k0 = (t / tilesN) * 64, n0 = (t % tilesN) * 64;
  const int kr = tid >> 3, ng = (tid & 7) * 8;
  f32x4 v0 = {0.f, 0.f, 0.f, 0.f}, v1 = {0.f, 0.f, 0.f, 0.f};
  if (n0 + ng < N) { const float* s = src + (size_t)(k0 + kr) * N + n0 + ng; v0 = *reinterpret_cast<const f32x4*>(s); v1 = *reinterpret_cast<const f32x4*>(s + 4); }
  const float scv = scale ? scale[k0 + kr] : 1.f;
  bf16_t* tl = (bf16_t*)lds;
#pragma unroll
  for (int e = 0; e < 4; ++e) { tl[(ng + e) * 72 + kr] = f2bf(v0[e] * scv); tl[(ng + 4 + e) * 72 + kr] = f2bf(v1[e] * scv); }
  __syncthreads();
  const int n = tid >> 3, kc = (tid & 7) * 8;
  *reinterpret_cast<bf16x8*>(dst + (size_t)(n0 + n) * K + k0 + kc) = *reinterpret_cast<const bf16x8*>(tl + n * 72 + kc);
}

DEVI void phase0(int wv, const Params& p, char* lds) {
  const int tid = tidx(wv);
  constexpr int N_ADA = 192, N_TR = 1952, N_WS = 16;
  for (int it = blockIdx.x; it < N_ADA + N_TR + N_WS + 1; it += gridDim.x) {
    if (it < N_ADA) {
      const int li = it / 96, chunk = it % 96;
      float* sc = (float*)lds;
      for (int idx = tid; idx < 17 * 1024; idx += 512) { const int r = idx >> 10, k = idx & 1023; const float xv = r < 16 ? p.c[r * 1024 + k] : p.c_ctx[k]; sc[idx] = xv / (1.f + expf(-xv)); }
      __syncthreads();
      const int col = tid & 31, kp = tid >> 5;
      const float* w = p.ada_w + (size_t)li * 1024 * 3072 + chunk * 32 + col;
      float acc[17];
#pragma unroll
      for (int r = 0; r < 17; ++r) acc[r] = 0.f;
#pragma unroll 8
      for (int k = kp * 64; k < kp * 64 + 64; ++k) {
        const float wv = w[(size_t)k * 3072];
#pragma unroll
        for (int r = 0; r < 17; ++r) acc[r] += sc[r * 1024 + k] * wv;
      }
      float* red = (float*)(lds + 17 * 1024 * 4);
#pragma unroll
      for (int r = 0; r < 17; ++r) red[(kp * 17 + r) * 32 + col] = acc[r];
      __syncthreads();
      float* ada = (float*)(p.ws + OFF_ADA);
      for (int idx = tid; idx < 544; idx += 512) {
        const int r = idx >> 5, cc = idx & 31; float s = 0.f;
        for (int k2 = 0; k2 < 16; ++k2) s += red[(k2 * 17 + r) * 32 + cc];
        ada[(size_t)(li * 17 + r) * 3072 + chunk * 32 + cc] = s + p.ada_b[li * 3072 + chunk * 32 + cc];
      }
    } else if (it < N_ADA + N_TR) {
      int t = it - N_ADA;
      if (t < 896) tr_tile(wv, p.even_w_in, (bf16_t*)(p.ws + OFF_W0IN), 1024, 3584, 56, nullptr, t, lds);
      else if (t < 1152) tr_tile(wv, p.even_w_out, (bf16_t*)(p.ws + OFF_W0OUT), 1024, 1024, 16, nullptr, t - 896, lds);
      else if (t < 1536) tr_tile(wv, p.odd_w_in, (bf16_t*)(p.ws + OFF_W1IN), 1024, 1472, 24, nullptr, t - 1152, lds);
      else if (t < 1632) tr_tile(wv, p.c_wq_b, (bf16_t*)(p.ws + OFF_WQ), 256, 1536, 24, p.c_q_norm_w, t - 1536, lds);
      else if (t < 1696) tr_tile(wv, p.c_wkv_b, (bf16_t*)(p.ws + OFF_WKV), 128, 2048, 32, p.c_kv_norm_w, t - 1632, lds);
      else tr_tile(wv, p.odd_w_out, (bf16_t*)(p.ws + OFF_W1OUT), 1024, 1024, 16, nullptr, t - 1696, lds);
    } else if (it < N_ADA + N_TR + N_WS) {
      const int base = (it - N_ADA - N_TR) * 8192 + tid * 16;
      bf16_t* dst = (bf16_t*)(p.ws + OFF_WSB) + base; const float* s = p.a_ws + base;
#pragma unroll
      for (int q = 0; q < 2; ++q) {
        const f32x4 a = *reinterpret_cast<const f32x4*>(s + q * 8), b = *reinterpret_cast<const f32x4*>(s + q * 8 + 4);
        u32x4 w = {cvtpk(a[0], a[1]), cvtpk(a[2], a[3]), cvtpk(b[0], b[1]), cvtpk(b[2], b[3])};
        *reinterpret_cast<u32x4*>(dst + q * 8) = w;
      }
    } else {
      float2* tab = (float2*)(p.ws + OFF_ROPE);
      for (int e = tid; e < 1024; e += 512) {
        const int pos = e >> 4, j = e & 15;
        const float inv = exp2f(-(float)j * (13.287712379549449f / 16.f));
        const float ang = (float)pos * inv;
        const float nrev = rintf(ang * 0.15915494309189535f);
        float rr = fmaf(-nrev, 6.2831855f, ang); rr = fmaf(-nrev, -1.7484555e-7f, rr);
        tab[e] = make_float2(__cosf(rr), __sinf(rr));
      }
    }
    __syncthreads();
  }
}

DEVI void norm_mod(int wv, const float* src_lat, const float* src_ctx, const float* __restrict__ nw, const float* __restrict__ ada, bf16_t* X,
                   int row_lo, int row_hi, int vb, int nvb) {
  const int tid_ = tidx(wv); const int wid = tid_ >> 6, lane = tid_ & 63;
  for (int row0 = row_lo + (vb * 8 + wid) * 2; row0 < row_hi; row0 += nvb * 16) {
    f32x4 v[2][4]; float ss[2];
#pragma unroll
    for (int q = 0; q < 2; ++q) {
      const int row = row0 + q;
      const float* src = row < NLAT ? src_lat + (size_t)row * 1024 : src_ctx + (size_t)(row - NLAT) * 1024;
      ss[q] = 0.f;
#pragma unroll
      for (int i = 0; i < 4; ++i) v[q][i] = *reinterpret_cast<const f32x4*>(src + i * 256 + lane * 4);
    }
#pragma unroll
    for (int q = 0; q < 2; ++q) {
#pragma unroll
      for (int i = 0; i < 4; ++i) ss[q] += v[q][i][0] * v[q][i][0] + v[q][i][1] * v[q][i][1] + v[q][i][2] * v[q][i][2] + v[q][i][3] * v[q][i][3];
      ss[q] = wave_sum(ss[q]);
    }
#pragma unroll
    for (int q = 0; q < 2; ++q) {
      const int row = row0 + q;
      const float* ad = ada + (row < NLAT ? (row >> 11) : 16) * 3072;
      const float r = rsqrtf(ss[q] * (1.f / 1024.f) + 1e-6f);
#pragma unroll
      for (int i = 0; i < 4; ++i) {
        const int c = i * 256 + lane * 4;
        const f32x4 w = *reinterpret_cast<const f32x4*>(nw + c), sh = *reinterpret_cast<const f32x4*>(ad + c), scl = *reinterpret_cast<const f32x4*>(ad + 1024 + c);
        float o[4];
#pragma unroll
        for (int e = 0; e < 4; ++e) o[e] = v[q][i][e] * r * w[e] * (1.f + scl[e]) + sh[e];
        u32x2 pk = {cvtpk(o[0], o[1]), cvtpk(o[2], o[3])};
        *reinterpret_cast<u32x2*>(X + (size_t)row * 1024 + c) = pk;
      }
    }
  }
}

DEVI void final_norm(int wv, float* out, const float* __restrict__ fw) {
  const int tid_ = tidx(wv); const int wid = tid_ >> 6, lane = tid_ & 63;
  for (int row0 = (blockIdx.x * 8 + wid) * 2; row0 < NLAT; row0 += gridDim.x * 16) {
    f32x4 v[2][4]; float ss[2];
#pragma unroll
    for (int q = 0; q < 2; ++q) {
      ss[q] = 0.f;
#pragma unroll
      for (int i = 0; i < 4; ++i) v[q][i] = *reinterpret_cast<const f32x4*>(out + (size_t)(row0 + q) * 1024 + i * 256 + lane * 4);
    }
#pragma unroll
    for (int q = 0; q < 2; ++q) {
#pragma unroll
      for (int i = 0; i < 4; ++i) ss[q] += v[q][i][0] * v[q][i][0] + v[q][i][1] * v[q][i][1] + v[q][i][2] * v[q][i][2] + v[q][i][3] * v[q][i][3];
      ss[q] = wave_sum(ss[q]);
    }
#pragma unroll
    for (int q = 0; q < 2; ++q) {
      const float r = rsqrtf(ss[q] * (1.f / 1024.f) + 1e-6f);
#pragma unroll
      for (int i = 0; i < 4; ++i) {
        const int c = i * 256 + lane * 4;
        const f32x4 w = *reinterpret_cast<const f32x4*>(fw + c);
        *reinterpret_cast<f32x4*>(out + (size_t)(row0 + q) * 1024 + c) = v[q][i] * r * w;
      }
    }
  }
}

typedef const __attribute__((address_space(4))) Params* KArgP;
DEVI void run_phase(int wv, KArgP pp, int ph, char* lds) {
#if defined(__HIP_DEVICE_COMPILE__)
  asm volatile("" : "+s"(pp));
  char* ws = pp->ws;
  const float2* rope = (const float2*)(ws + OFF_ROPE);
  const float* ada0 = (const float*)(ws + OFF_ADA); const float* ada1 = ada0 + 17 * 3072;
  bf16_t* X = (bf16_t*)(ws + OFF_X); bf16_t* MIX = (bf16_t*)(ws + OFF_MIX);
  const int G = gridDim.x, B = blockIdx.x;
  PG8_LAS unsigned char* ldsp = (PG8_LAS unsigned char*)lds;
  switch (ph) {
    case 0: { const Params p = *pp; phase0(wv, p, lds); } break;
    case 1: norm_mod(wv, pp->x, pp->ctx, pp->norm_w, ada0, X, 0, NTOK, B, G); break;
    case 2: {
      EpiL0In epi{(bf16_t*)(ws + OFF_U), (bf16_t*)(ws + OFF_GV), (bf16_t*)(ws + OFF_ZA), (bf16_t*)(ws + OFF_ZB), (bf16_t*)(ws + OFF_Q0), (bf16_t*)(ws + OFF_K0), (bf16_t*)(ws + OFF_V0), rope};
      gemm_phase(wv, ldsp, X, (const bf16_t*)(ws + OFF_W0IN), 1024, Sched{14, 144 * 14, 144 * 14, 0, 0}, epi);
    } break;
    case 3: { const Params p = *pp;
      for (int it = B; it < 1024 + 288 + 128; it += G) {
        if (it < 1024) {
          const int xcd = it & 7, slot = (it >> 3) & 31, rd = it >> 8;
          const int bh = rd * 16 + xcd * 2 + (slot >> 4), qb = slot & 15, b = bh >> 2, h = bh & 3;
          attn0_item(wv, p, b * 2048 + qb * 128, b, h, KVL, lds);
        } else if (it < 1024 + 288) abranch_item(wv, p, it - 1024, lds);
        else { const int i2 = it - 1312; const int b = i2 >> 3, h = (i2 >> 1) & 3, qb = i2 & 1; attn0_item(wv, p, NLAT + b * 256 + qb * 128, b, h, 256, lds); }
      }
    } break;
    case 4: {
      EpiOut<true> epi{pp->x, pp->ctx, pp->out, (float*)(ws + OFF_H1C), ada0};
      gemm_phase(wv, ldsp, MIX, (const bf16_t*)(ws + OFF_W0OUT), 1024, Sched{4, 144 * 4, 144 * 4, 0, 0}, epi);
    } break;
    case 5: {
      if (B >= G - 16) {
        const int cp = B - (G - 16);
        norm_mod(wv, pp->out, (const float*)(ws + OFF_H1C), pp->norm_w + 1024, ada1, X, NLAT + cp * 256, NLAT + cp * 256 + 256, 0, 1);
        asm volatile("s_waitcnt vmcnt(0)" ::: "memory"); __syncthreads();
        EpiL1In epi{(bf16_t*)(ws + OFF_CQ), (bf16_t*)(ws + OFF_CKV), (bf16_t*)(ws + OFF_K1), (bf16_t*)(ws + OFF_Z1), (float*)(ws + OFF_RQ), (float*)(ws + OFF_RKV), rope, (float*)(lds + LDS_SS)};
        gemm_phase(wv, ldsp, X, (const bf16_t*)(ws + OFF_W1IN), 1024, Sched{6, 0, 16, 128, 1, G - 16}, epi);
      } else norm_mod(wv, pp->out, (const float*)(ws + OFF_H1C), pp->norm_w + 1024, ada1, X, 0, NLAT, B, G - 16);
    } break;
    case 6: {
      EpiL1In epi{(bf16_t*)(ws + OFF_CQ), (bf16_t*)(ws + OFF_CKV), (bf16_t*)(ws + OFF_K1), (bf16_t*)(ws + OFF_Z1), (float*)(ws + OFF_RQ), (float*)(ws + OFF_RKV), rope, (float*)(lds + LDS_SS)};
      gemm_phase(wv, ldsp, X, (const bf16_t*)(ws + OFF_W1IN), 1024, Sched{6, 768, 768, 128, 1}, epi);
    } break;
    case 7: {
      EpiQ eq{(bf16_t*)(ws + OFF_Q1), (const float*)(ws + OFF_RQ), rope};
      EpiKV ek{(bf16_t*)(ws + OFF_K1), (bf16_t*)(ws + OFF_V1), (const float*)(ws + OFF_RKV)};
      gemm_phase(wv, ldsp, (const bf16_t*)(ws + OFF_CQ), (const bf16_t*)(ws + OFF_WQ), 256, Sched{6, 768, 768, 0, 0}, eq);
      gemm_phase(wv, ldsp, (const bf16_t*)(ws + OFF_CKV), (const bf16_t*)(ws + OFF_WKV), 128, Sched{8, 1152, 1152, 0, 0}, ek);
    } break;
    case 8: { const Params p = *pp;
      for (int it = B; it < 1024; it += G) {
        const int xcd = it & 7, slot = (it >> 3) & 31, rd = it >> 8;
        const int bh = rd * 32 + xcd * 4 + (slot >> 3), qb = slot & 7;
        attn1_item(wv, p, bh >> 3, bh & 7, qb, lds);
      }
    } break;
    case 9: {
      float* o_ = pp->out; EpiOut<false> epi{o_, o_, o_, o_, ada1};
      gemm_phase(wv, ldsp, MIX, (const bf16_t*)(ws + OFF_W1OUT), 1024, Sched{4, 128 * 4, 128 * 4, 0, 0}, epi);
    } break;
    case 10: final_norm(wv, pp->out, pp->final_w); break;
  }
#endif
}


#define XB_TMO      128
#define XB_XCNT(j)  (256  + 64 * (j))
#define XB_XSUB(j)  (1280 + 64 * (j))
#define XB_XGEN(j)  (2304 + 64 * (j))
#define XB_TOP      3328
#define XB_TOPGEN   3392
#define XCD_BAR_WORDS 3456
#define XB_SPIN_CAP (1u << 18)
#define LAS __attribute__((address_space(3)))
DEVI unsigned xb_ld(unsigned* p) { return __hip_atomic_load(p, __ATOMIC_RELAXED, __HIP_MEMORY_SCOPE_AGENT); }
DEVI unsigned xb_add(unsigned* p, unsigned v) { return __hip_atomic_fetch_add(p, v, __ATOMIC_RELAXED, __HIP_MEMORY_SCOPE_AGENT); }
DEVI unsigned xb_xcc_id() { return (unsigned)__builtin_amdgcn_s_getreg((3 << 11) | 20) & 0xFu; }
#define XB_SPIN(cond, bar) do { unsigned _sp = 0; while (cond) { __builtin_amdgcn_s_sleep(1); \
    if ((++_sp & 255u) == 0u) { if (xb_ld(&(bar)[XB_TMO])) break; if (_sp > XB_SPIN_CAP) { atomicAdd(&(bar)[XB_TMO], 1u); break; } } } } while (0)
struct XcdBarrier { unsigned* bar; unsigned x; volatile LAS unsigned* st; };
DEVI XcdBarrier xcd_barrier_post(int wv, unsigned* bar, volatile LAS unsigned* st) {
  XcdBarrier b; b.bar = bar; b.x = xb_xcc_id(); b.st = st;
  if (tidx(wv) == 0) (void)xb_add(&bar[XB_XCNT(b.x)], 1u);
  return b;
}
DEVI void xcd_barrier_complete(unsigned* bar, unsigned x, unsigned& nloc, unsigned& nx) {
  const unsigned G = gridDim.x * gridDim.y * gridDim.z;
  unsigned sum, cnt, mine, sp = 0u;
  for (;;) {
    sum = 0u; cnt = 0u; mine = 0u;
#pragma unroll
    for (unsigned j = 0; j < 16; ++j) { const unsigned c = xb_ld(&bar[XB_XCNT(j)]); sum += c; cnt += (c > 0u) ? 1u : 0u; mine = (j == x) ? c : mine; }
    if (sum == G) break;
    __builtin_amdgcn_s_sleep(1);
    if ((++sp & 255u) == 0u) { if (xb_ld(&bar[XB_TMO])) break; if (sp > XB_SPIN_CAP) { atomicAdd(&bar[XB_TMO], 1u); break; } }
  }
  nloc = mine > 0u ? mine : 1u; nx = cnt > 0u ? cnt : 1u;
}
DEVI void xcd_barrier(int wv, const XcdBarrier& b) {
  asm volatile("s_waitcnt vmcnt(0)" ::: "memory");
  __syncthreads();
  if (tidx(wv) == 0) {
    unsigned* bar = b.bar;
    __builtin_amdgcn_s_waitcnt(0);
    unsigned nloc = b.st[0], nx = b.st[1];
    if (nloc == 0u) { xcd_barrier_complete(bar, b.x, nloc, nx); b.st[0] = nloc; b.st[1] = nx; }
    const unsigned old = xb_add(&bar[XB_XSUB(b.x)], 1u);
    const unsigned gen = old / nloc;
    if (old + 1u == (gen + 1u) * nloc) {
      __builtin_amdgcn_fence(__ATOMIC_RELEASE, "agent");
      asm volatile("s_waitcnt vmcnt(0)" ::: "memory");
      const unsigned og = xb_add(&bar[XB_TOP], 1u);
      const unsigned tg = og / nx;
      if (og + 1u == (tg + 1u) * nx) xb_add(&bar[XB_TOPGEN], 1u);
      else XB_SPIN(xb_ld(&bar[XB_TOPGEN]) == tg, bar);
      __builtin_amdgcn_fence(__ATOMIC_ACQUIRE, "agent");
      xb_add(&bar[XB_XGEN(b.x)], 1u);
      asm volatile("s_waitcnt vmcnt(0)" ::: "memory");
    } else {
      XB_SPIN(xb_ld(&bar[XB_XGEN(b.x)]) == gen, bar);
      __builtin_amdgcn_fence(__ATOMIC_ACQUIRE, "agent");
      asm volatile("s_waitcnt vmcnt(0)" ::: "memory");
    }
  }
  __syncthreads();
}

extern __shared__ __attribute__((aligned(16))) char g_lds[];

constexpr int LDS_XB = 143360;
__global__ void __launch_bounds__(512) mega(Params p) {
  cg::grid_group grid = cg::this_grid();
  if (p.ph_hi > 64) grid.sync();
  const int wv = __builtin_amdgcn_readfirstlane((int)threadIdx.x >> 6);
  volatile LAS unsigned* xst = (volatile LAS unsigned*)(g_lds + LDS_XB);
  if (tidx(wv) == 0) { xst[0] = 0u; xst[1] = 0u; }
  __syncthreads();
  (void)xcd_barrier_post(wv, (unsigned*)(p.ws + OFF_BAR), xst);
#define GRID_BARRIER() do { KArgP _pp = (KArgP)__builtin_amdgcn_kernarg_segment_ptr(); asm volatile("" : "+s"(_pp)); \
    XcdBarrier _xb; _xb.bar = (unsigned*)(_pp->ws + OFF_BAR); _xb.x = xb_xcc_id(); _xb.st = (volatile LAS unsigned*)(g_lds + LDS_XB); xcd_barrier(wv, _xb); } while (0)
  for (int ph = p.ph_lo; ph < p.ph_hi; ++ph) {
    run_phase(wv, (KArgP)__builtin_amdgcn_kernarg_segment_ptr(), ph, g_lds);
#ifdef PROBE_PH
    if (ph == PROBE_PH) { GRID_BARRIER(); run_phase(wv, (KArgP)__builtin_amdgcn_kernarg_segment_ptr(), ph, g_lds); }
#endif
    if (ph + 1 < p.ph_hi) GRID_BARRIER();
  }
}

extern "C" void kernel_launch(void* const* d_in, const int* in_sizes, int n_in, void* d_out, int out_size, void* d_ws, size_t ws_size, hipStream_t stream) {
  static int ok = 0;
  static int grid_blocks = 0;
  if (!ok) {
    if (n_in != 25 || ws_size < WS_NEED) { fprintf(stderr, "kernel_launch: bad args n_in %d ws %zu need %zu\n", n_in, ws_size, (size_t)WS_NEED); return; }
    if (hipFuncSetAttribute((const void*)mega, hipFuncAttributeMaxDynamicSharedMemorySize, LDS_BYTES) != hipSuccess) { fprintf(stderr, "kernel_launch: LDS attr failed\n"); return; }
    int dev = 0, cus = 0, per_cu = 0;
    hipGetDevice(&dev);
    hipDeviceGetAttribute(&cus, hipDeviceAttributeMultiprocessorCount, dev);
    hipOccupancyMaxActiveBlocksPerMultiprocessor(&per_cu, mega, 512, LDS_BYTES);
    if (per_cu < 1) per_cu = 1;
    grid_blocks = cus * per_cu;
    ok = 1;
  }
  Params p{};
  const float** pp = (const float**)&p;
  for (int i = 0; i < 25; ++i) pp[i] = (const float*)d_in[i];
  p.out = (float*)d_out; p.ws = (char*)d_ws;
#if ONE_LAUNCH
  p.ph_lo = 0; p.ph_hi = 11;
  hipMemsetAsync((char*)d_ws + OFF_BAR, 0, XCD_BAR_WORDS * 4, stream);
  void* args[] = {&p};
  hipError_t e = hipLaunchCooperativeKernel((const void*)mega, dim3(grid_blocks), dim3(512), args, LDS_BYTES, stream);
  if (e != hipSuccess) fprintf(stderr, "cooperative launch failed: %s (grid %d)\n", hipGetErrorString(e), grid_blocks);
#else
  for (int ph = 0; ph < 11; ++ph) {
    p.ph_lo = ph; p.ph_hi = ph + 1;
    hipLaunchKernelGGL(mega, dim3(grid_blocks), dim3(512), LDS_BYTES, stream, p);
  }
#endif
}
```

```cpp
#include <hip/hip_runtime.h>
#include <hip/hip_cooperative_groups.h>
#include <cstdio>
namespace cg = cooperative_groups;

#ifndef ATT_SD0
#define ATT_SD0 2
#endif
#ifndef ONE_LAUNCH
#define ONE_LAUNCH 1
#endif

typedef unsigned short bf16_t;
typedef short bf16x8 __attribute__((ext_vector_type(8)));
typedef short s16x4 __attribute__((ext_vector_type(4)));
typedef float f32x16 __attribute__((ext_vector_type(16)));
typedef float f32x4 __attribute__((ext_vector_type(4)));
typedef unsigned u32x4 __attribute__((ext_vector_type(4)));
typedef unsigned u32x2 __attribute__((ext_vector_type(2)));
#define DEVI __device__ __forceinline__
#define SBAR() __builtin_amdgcn_sched_barrier(0)
DEVI int tidx(int wv) { int l; asm volatile("v_mbcnt_lo_u32_b32 %0, -1, 0\n\tv_mbcnt_hi_u32_b32 %0, -1, %0" : "=v"(l)); return (wv << 6) | l; }

constexpr int NLAT = 32768, NCTX = 4096, NTOK = 36864, KVL = 2304;
constexpr int LDS_BYTES = 147456, LDS_SS = 139264;

constexpr size_t OFF_W0IN = 0;
constexpr size_t OFF_W0OUT = OFF_W0IN + 3584ull * 1024 * 2;
constexpr size_t OFF_W1IN = OFF_W0OUT + 1024ull * 1024 * 2;
constexpr size_t OFF_WQ = OFF_W1IN + 1536ull * 1024 * 2;
constexpr size_t OFF_WKV = OFF_WQ + 1536ull * 256 * 2;
constexpr size_t OFF_W1OUT = OFF_WKV + 2048ull * 128 * 2;
constexpr size_t OFF_WSB = OFF_W1OUT + 1024ull * 1024 * 2;
constexpr size_t OFF_ADA = OFF_WSB + 8ull * 128 * 128 * 2;
constexpr size_t OFF_ROPE = OFF_ADA + 2ull * 17 * 3072 * 4;
constexpr size_t OFF_BAR = OFF_ROPE + 64ull * 16 * 8;
constexpr size_t OFF_H1C = OFF_BAR + 16384;
constexpr size_t OFF_RQ = OFF_H1C + 4096ull * 1024 * 4;
constexpr size_t OFF_RKV = OFF_RQ + 32768ull * 4;
constexpr size_t OFF_X = OFF_RKV + 36864ull * 4;
constexpr size_t OFF_MIX = OFF_X + 36864ull * 1024 * 2;
constexpr size_t OFF_T = OFF_MIX + 36864ull * 1024 * 2;
constexpr size_t SZ_HALF = 36864ull * 512 * 2;
constexpr size_t OFF_U = OFF_T, OFF_GV = OFF_U + SZ_HALF, OFF_ZA = OFF_GV + SZ_HALF, OFF_ZB = OFF_ZA + SZ_HALF, OFF_Q0 = OFF_ZB + SZ_HALF;
constexpr size_t OFF_K0 = OFF_Q0 + SZ_HALF, OFF_V0 = OFF_K0 + 16ull * 4 * KVL * 128 * 2, END_L0 = OFF_V0 + 16ull * 4 * KVL * 128 * 2;
constexpr size_t OFF_CQ = OFF_T, OFF_CKV = OFF_CQ + 32768ull * 256 * 2, OFF_Z1 = OFF_CKV + 36864ull * 128 * 2;
constexpr size_t OFF_Q1 = OFF_Z1 + 32768ull * 1024 * 2, OFF_K1 = OFF_Q1 + 32768ull * 1536 * 2, END_L1 = OFF_K1 + 16ull * 8 * KVL * 192 * 2;
constexpr size_t OFF_V1 = OFF_X;
constexpr size_t WS_NEED = END_L1 > END_L0 ? END_L1 : END_L0;

struct Params {
  const float *x, *c, *ctx, *c_ctx, *norm_w, *ada_w, *ada_b, *even_w_in, *a_ws, *a_bs, *a_ln_w, *a_ln_b,
      *b_lq1, *b_lk1, *b_lq2, *b_lk2, *b_subln_w, *even_w_out, *odd_w_in, *c_q_norm_w, *c_wq_b,
      *c_kv_norm_w, *c_wkv_b, *odd_w_out, *final_w;
  float* out; char* ws; int ph_lo, ph_hi;
};

DEVI unsigned cvtpk(float lo, float hi) { unsigned r; asm("v_cvt_pk_bf16_f32 %0, %1, %2" : "=v"(r) : "v"(lo), "v"(hi)); return r; }
DEVI bf16_t f2bf(float v) { return (bf16_t)(cvtpk(v, 0.f) & 0xffffu); }
DEVI float bf2f(bf16_t v) { return __uint_as_float(((unsigned)v) << 16); }
DEVI float bflo(unsigned w) { return __uint_as_float(w << 16); }
DEVI float bfhi(unsigned w) { return __uint_as_float(w & 0xffff0000u); }
DEVI int crow(int r, int hi) { return (r & 3) + 8 * (r >> 2) + 4 * hi; }
DEVI float silu_f(float x) { return x * __builtin_amdgcn_rcpf(1.f + __builtin_amdgcn_exp2f(x * -1.4426950408889634f)); }
DEVI float gelu_f(float v) {
  const float t = __builtin_amdgcn_rcpf(fmaf(fabsf(v), 0.2316418882f, 1.0f));
  float q = fmaf(t, 0.5307027145f, -0.7265760135f); q = fmaf(q, t, 0.7107068705f); q = fmaf(q, t, -0.142248368f); q = fmaf(q, t, 0.127414796f); q *= t;
  const float m = v * (q * __builtin_amdgcn_exp2f(v * v * -0.72134752044f));
  return v < 0.f ? m : v - m;
}

template <int M> DEVI float xsum(float v) {
  if constexpr (M == 32) { auto rr = __builtin_amdgcn_permlane32_swap(__float_as_uint(v), __float_as_uint(v), false, false); return __uint_as_float(rr[0]) + __uint_as_float(rr[1]); }
  else return v + __int_as_float(__builtin_amdgcn_ds_swizzle(__float_as_int(v), (M << 10) | 0x1f));
}
DEVI float wave_sum(float v) { v = xsum<1>(v); v = xsum<2>(v); v = xsum<4>(v); v = xsum<8>(v); v = xsum<16>(v); return xsum<32>(v); }

DEVI void rope_tile(f32x16& v, const float2* __restrict__ tab, int pos, int hi) {
#pragma unroll
  for (int r = 0; r < 8; ++r) {
    const int jf = (r & 3) + 8 * (r >> 2) + 4 * hi;
    const float2 cs = tab[pos * 16 + jf];
    const float a = v[r], b = v[r + 8];
    v[r] = a * cs.x - b * cs.y; v[r + 8] = b * cs.x + a * cs.y;
  }
}
DEVI void store4(bf16_t* dst, const f32x16& v, int rg) {
  u32x2 pk = {cvtpk(v[rg * 4 + 0], v[rg * 4 + 1]), cvtpk(v[rg * 4 + 2], v[rg * 4 + 3])};
  *reinterpret_cast<u32x2*>(dst) = pk;
}

#define PG8_LAS __attribute__((address_space(3)))
constexpr int HTB = 128 * 64 * 2;
DEVI int lds_byte(int r, int c) { const int st = (r >> 4) * 2 + (c >> 5), rr = r & 15, cc = c & 31, ob = rr * 64 + cc * 2; return st * 1024 + (ob ^ (((ob >> 9) & 1) << 5)); }
DEVI void stage_rc(int b, int& R, int& C) { const int st = b / 1024, sb = b % 1024, swz = sb ^ (((sb >> 9) & 1) << 5); R = (st >> 1) * 16 + swz / 64; C = (st & 1) * 32 + (swz % 64) / 2; }
DEVI int perm32(int rho) { const int n = rho >> 4, i = rho & 15; return 8 * (i >> 2) + 4 * n + (i & 3); }
struct Unit { int pm, pn; };
struct Sched {
  int nN, nmain, ntotal, xpm0, xpn, boff = 0;
  DEVI bool next(int i, Unit& u) const {
    const int it = (int)blockIdx.x - boff + i * (int)gridDim.x; if (it < 0 || it >= ntotal) return false;
    if (it < nmain) { const int xcd = it & 7, jx = it >> 3; u.pm = (jx / nN) * 8 + xcd; u.pn = jx % nN; } else { u.pm = xpm0 + (it - nmain); u.pn = xpn; }
    return true;
  }
};
template <class Epi>
DEVI void gemm_phase(int wv, PG8_LAS unsigned char* lds, const bf16_t* gA, const bf16_t* gBt, const int K, const Sched& S, const Epi& E) {
  const int tid = tidx(wv), wid = __builtin_amdgcn_readfirstlane(tid >> 6), lane = tid & 63, wr = wid >> 2, wc = wid & 3, fr = lane & 15, fq = lane >> 4;
  const int nt = K / 64;
  unsigned voffA[2], voffB[2];
#pragma unroll
  for (int i = 0; i < 2; ++i) { int R, C; stage_rc(tid * 16 + i * 8192, R, C); const int Rb = (R & ~31) + perm32(R & 31); voffA[i] = (unsigned)(R * K + C) * 2u; voffB[i] = (unsigned)(Rb * K + C) * 2u; }
  const size_t kstep = (size_t)(64 * 2);
  const size_t hstep = (size_t)128 * K * 2;
  const size_t tstep = 2 * hstep;
  const unsigned ldsw = (unsigned)wid * 1024u;
  const int aoff = lds_byte(wr * 64 + fr, fq * 8), boff = lds_byte(wc * 32 + fr, fq * 8);
#define PG8_SA(b, h) (((b) * 2 + (h)) * HTB)
#define PG8_SB(b, h) ((4 + (b) * 2 + (h)) * HTB)
#define PG8_STAGE(bufoff, gbase, voff) do { _Pragma("unroll") for (int _i = 0; _i < 2; ++_i) \
    __builtin_amdgcn_global_load_lds((const unsigned*)((const char*)(gbase) + (voff)[_i]), (PG8_LAS unsigned*)(lds + (bufoff) + ldsw + _i * 8192), 16, 0, 0); } while (0)
#define PG8_LDA(dst, b, h) do { _Pragma("unroll") for (int m = 0; m < 4; ++m) _Pragma("unroll") for (int k = 0; k < 2; ++k) dst[m][k] = *(const PG8_LAS bf16x8*)(lds + PG8_SA(b, h) + aoff + m * 2048 + k * 1024); } while (0)
#define PG8_LDB(dst, b, h) do { _Pragma("unroll") for (int n = 0; n < 2; ++n) _Pragma("unroll") for (int k = 0; k < 2; ++k) dst[n][k] = *(const PG8_LAS bf16x8*)(lds + PG8_SB(b, h) + boff + n * 2048 + k * 1024); } while (0)
#define PG8_MMA(ai, bj, At, Bt) do { __builtin_amdgcn_s_setprio(1); _Pragma("unroll") for (int m = 0; m < 4; ++m) _Pragma("unroll") for (int n = 0; n < 2; ++n) _Pragma("unroll") for (int k = 0; k < 2; ++k) \
    acc[ai][bj][m][n] = __builtin_amdgcn_mfma_f32_16x16x32_bf16(Bt[n][k], At[m][k], acc[ai][bj][m][n], 0, 0, 0); __builtin_amdgcn_s_setprio(0); } while (0)
#define PG8_WAIT_V(n) asm volatile("s_waitcnt vmcnt(" #n ")" ::: "memory")
#define PG8_WAIT_L(n) asm volatile("s_waitcnt lgkmcnt(" #n ")" ::: "memory")
#define PG8_BAR __builtin_amdgcn_s_barrier()
#define PG8_SCHED __builtin_amdgcn_sched_barrier(0)
  Unit cur, nxt; int ui = 0;
  if (!S.next(0, cur)) return;
  f32x4 acc[2][2][4][2];
#pragma unroll
  for (int a = 0; a < 2; ++a)
#pragma unroll
    for (int b = 0; b < 2; ++b)
#pragma unroll
      for (int m = 0; m < 4; ++m)
#pragma unroll
        for (int n = 0; n < 2; ++n) acc[a][b][m][n] = (f32x4){0.f, 0.f, 0.f, 0.f};
  bf16x8 At[4][2], B0[2][2], B1[2][2];
  const char* cA = (const char*)gA + (size_t)cur.pm * tstep; const char* cB = (const char*)gBt + (size_t)cur.pn * tstep;
  PG8_STAGE(PG8_SB(0, 0), cB, voffB); PG8_STAGE(PG8_SA(0, 0), cA, voffA); PG8_STAGE(PG8_SB(0, 1), cB + hstep, voffB); PG8_STAGE(PG8_SA(0, 1), cA + hstep, voffA);
  if (wr == 1) PG8_BAR;
  PG8_WAIT_V(4); PG8_BAR;
  PG8_STAGE(PG8_SB(1, 0), cB + kstep, voffB); PG8_STAGE(PG8_SA(1, 0), cA + kstep, voffA); PG8_STAGE(PG8_SB(1, 1), cB + hstep + kstep, voffB);
  PG8_WAIT_V(6); PG8_BAR;
  for (;;) {
    const bool has_next = S.next(ui + 1, nxt);
    const char* nA = has_next ? (const char*)gA + (size_t)nxt.pm * tstep : cA; const char* nB = has_next ? (const char*)gBt + (size_t)nxt.pn * tstep : cB;
#pragma unroll 1
    for (int t = 0; t < nt; t += 2) {
      const bool last = (t == nt - 2);
      const char* a1 = cA + (size_t)(t + 1) * kstep;
      const char* a2 = last ? nA : cA + (size_t)(t + 2) * kstep; const char* b2 = last ? nB : cB + (size_t)(t + 2) * kstep;
      const char* a3 = a2 + kstep; const char* b3 = b2 + kstep;
      PG8_LDB(B0, 0, 0); PG8_SCHED; PG8_LDA(At, 0, 0); PG8_STAGE(PG8_SA(1, 1), a1 + hstep, voffA);
      PG8_WAIT_L(8); PG8_BAR; PG8_WAIT_L(0); PG8_MMA(0, 0, At, B0); PG8_BAR; PG8_SCHED;
      PG8_LDB(B1, 0, 1); PG8_STAGE(PG8_SB(0, 0), b2, voffB);
      PG8_BAR; PG8_WAIT_L(0); PG8_MMA(0, 1, At, B1); PG8_BAR;
      PG8_LDA(At, 0, 1); PG8_STAGE(PG8_SA(0, 0), a2, voffA);
      PG8_BAR; PG8_WAIT_L(0); PG8_MMA(1, 0, At, B0); PG8_BAR; PG8_SCHED;
      PG8_STAGE(PG8_SB(0, 1), b2 + hstep, voffB);
      PG8_WAIT_V(6); PG8_BAR; PG8_MMA(1, 1, At, B1); PG8_BAR;
      PG8_LDB(B0, 1, 0); PG8_SCHED; PG8_LDA(At, 1, 0); PG8_STAGE(PG8_SA(0, 1), a2 + hstep, voffA);
      PG8_WAIT_L(8); PG8_BAR; PG8_WAIT_L(0); PG8_MMA(0, 0, At, B0); PG8_BAR; PG8_SCHED;
      PG8_LDB(B1, 1, 1); PG8_STAGE(PG8_SB(1, 0), b3, voffB);
      PG8_BAR; PG8_WAIT_L(0); PG8_MMA(0, 1, At, B1); PG8_BAR;
      PG8_LDA(At, 1, 1); PG8_STAGE(PG8_SA(1, 0), a3, voffA);
      PG8_BAR; PG8_WAIT_L(0); PG8_MMA(1, 0, At, B0); PG8_BAR; PG8_SCHED;
      PG8_STAGE(PG8_SB(1, 1), b3 + hstep, voffB);
      PG8_WAIT_V(6); PG8_BAR; PG8_MMA(1, 1, At, B1); PG8_BAR;
    }
    E(acc, cur, wr, wc, fr, fq);
    if (!has_next) break;
#pragma unroll
    for (int a = 0; a < 2; ++a)
#pragma unroll
      for (int b = 0; b < 2; ++b)
#pragma unroll
        for (int m = 0; m < 4; ++m)
#pragma unroll
          for (int n = 0; n < 2; ++n) acc[a][b][m][n] = (f32x4){0.f, 0.f, 0.f, 0.f};
    cur = nxt; cA = nA; cB = nB; ++ui;
  }
  PG8_WAIT_V(0);
  if (wr == 0) PG8_BAR;
  PG8_BAR;
#undef PG8_SA
#undef PG8_SB
#undef PG8_STAGE
#undef PG8_LDA
#undef PG8_LDB
#undef PG8_MMA
#undef PG8_WAIT_V
#undef PG8_WAIT_L
#undef PG8_BAR
#undef PG8_SCHED
}

typedef f32x4 acc_t[2][2][4][2];
DEVI void token_info(int token, bool ctx, int& b, int& s, int& key) {
  if (!ctx) { b = token >> 11; s = token & 2047; key = 256 + s; } else { const int tc = token - NLAT; b = tc >> 8; s = 0; key = tc & 255; }
}
DEVI float swap32_partner(float v, bool upper) {
  auto rr = __builtin_amdgcn_permlane32_swap(__float_as_uint(v), __float_as_uint(v), false, false);
  return __uint_as_float(upper ? rr[0] : rr[1]);
}
DEVI void rope_pair(f32x4& v0, f32x4& v1, const float2* __restrict__ tab, int pos, int fq) {
  const bool upper = fq >= 2;
  const float2* t = tab + pos * 16 + (fq & 1) * 8;
  const f32x4 t0 = *reinterpret_cast<const f32x4*>(t), t1 = *reinterpret_cast<const f32x4*>(t + 2), t2 = *reinterpret_cast<const f32x4*>(t + 4), t3 = *reinterpret_cast<const f32x4*>(t + 6);
  const float cs[8] = {t0[0], t0[2], t1[0], t1[2], t2[0], t2[2], t3[0], t3[2]}, sn[8] = {t0[1], t0[3], t1[1], t1[3], t2[1], t2[3], t3[1], t3[3]};
#pragma unroll
  for (int e = 0; e < 4; ++e) {
    const float p0 = swap32_partner(v0[e], upper), p1 = swap32_partner(v1[e], upper);
    const float s0 = upper ? sn[e] : -sn[e], s1 = upper ? sn[4 + e] : -sn[4 + e];
    v0[e] = v0[e] * cs[e] + p0 * s0; v1[e] = v1[e] * cs[4 + e] + p1 * s1;
  }
}
DEVI void st8(bf16_t* dst, const f32x4& v0, const f32x4& v1) { u32x4 pk = {cvtpk(v0[0], v0[1]), cvtpk(v0[2], v0[3]), cvtpk(v1[0], v1[1]), cvtpk(v1[2], v1[3])}; *reinterpret_cast<u32x4*>(dst) = pk; }

struct EpiL0In {
  bf16_t *U, *GV, *ZA, *ZB, *Q0, *K0, *V0; const float2* rope;
  DEVI void operator()(acc_t& acc, const Unit& u, int wr, int wc, int fr, int fq) const {
    const int col0 = u.pn * 256, type = col0 >> 9; const bool ctx = u.pm >= 128;
#pragma unroll
    for (int ai = 0; ai < 2; ++ai)
#pragma unroll
      for (int m = 0; m < 4; ++m) {
        const int token = u.pm * 256 + ai * 128 + wr * 64 + m * 16 + fr;
        int b, s, key; token_info(token, ctx, b, s, key);
#pragma unroll
        for (int bj = 0; bj < 2; ++bj) {
          const int nl = (col0 & 511) + bj * 128 + wc * 32;
          f32x4 v0 = acc[ai][bj][m][0], v1 = acc[ai][bj][m][1];
          bf16_t* dst;
          if (type <= 1) {
#pragma unroll
            for (int e = 0; e < 4; ++e) { v0[e] = gelu_f(v0[e]); v1[e] = gelu_f(v1[e]); }
            dst = (type == 0 ? U : GV) + (size_t)token * 512 + nl;
          } else if (type == 2 || type == 6) {
#pragma unroll
            for (int e = 0; e < 4; ++e) { v0[e] = silu_f(v0[e]); v1[e] = silu_f(v1[e]); }
            dst = (type == 2 ? ZA : ZB) + (size_t)token * 512 + nl;
          } else if (type == 3) {
            if (!ctx) rope_pair(v0, v1, rope, (wc & 1) ? (s & 63) : (s >> 6), fq);
            dst = Q0 + (size_t)token * 512 + nl;
          } else if (type == 4) {
            if (!ctx) rope_pair(v0, v1, rope, (wc & 1) ? (s & 63) : (s >> 6), fq);
            dst = K0 + ((size_t)(b * 4 + (nl >> 7)) * KVL + key) * 128 + (nl & 127);
          } else {
            dst = V0 + ((size_t)(b * 4 + (nl >> 7)) * KVL + key) * 128 + (nl & 127);
          }
          st8(dst + fq * 8, v0, v1);
        }
      }
  }
};

template <bool HASCTX> struct EpiOut {
  const float* src_lat; const float* src_ctx; float* dst_lat; float* dst_ctx; const float* ada;
  DEVI void operator()(acc_t& acc, const Unit& u, int wr, int wc, int fr, int fq) const {
    const int col0 = u.pn * 256;
#pragma unroll
    for (int ai = 0; ai < 2; ++ai)
#pragma unroll
      for (int m = 0; m < 4; ++m) {
        const int token = u.pm * 256 + ai * 128 + wr * 64 + m * 16 + fr;
        const float* src; float* dst; const float* gate;
        if (!HASCTX || token < NLAT) { src = src_lat + (size_t)token * 1024; dst = dst_lat + (size_t)token * 1024; gate = ada + (token >> 11) * 3072 + 2048; }
        else { const int tc = token - NLAT; src = src_ctx + (size_t)tc * 1024; dst = dst_ctx + (size_t)tc * 1024; gate = ada + 16 * 3072 + 2048; }
#pragma unroll
        for (int bj = 0; bj < 2; ++bj)
#pragma unroll
          for (int n = 0; n < 2; ++n) {
            const int c = col0 + bj * 128 + wc * 32 + fq * 8 + n * 4;
            const f32x4 xv = *reinterpret_cast<const f32x4*>(src + c), g = *reinterpret_cast<const f32x4*>(gate + c);
            *reinterpret_cast<f32x4*>(dst + c) = xv + g * acc[ai][bj][m][n];
          }
      }
  }
};

struct EpiPlain {
  bf16_t* O;
  DEVI void operator()(acc_t& acc, const Unit& u, int wr, int wc, int fr, int fq) const {
    const int col0 = u.pn * 256;
#pragma unroll
    for (int ai = 0; ai < 2; ++ai)
#pragma unroll
      for (int m = 0; m < 4; ++m) {
        const int token = u.pm * 256 + ai * 128 + wr * 64 + m * 16 + fr;
#pragma unroll
        for (int bj = 0; bj < 2; ++bj) st8(O + (size_t)token * 1024 + col0 + bj * 128 + wc * 32 + fq * 8, acc[ai][bj][m][0], acc[ai][bj][m][1]);
      }
  }
};

struct EpiL1In {
  bf16_t *CQ, *CKV, *K1, *Z1; float *RQ, *RKV; const float2* rope; float* ssb;
  DEVI void operator()(acc_t& acc, const Unit& u, int wr, int wc, int fr, int fq) const {
    const int col0 = u.pn * 256; const bool ctx = u.pm >= 128;
    float ss[2][4];
#pragma unroll
    for (int ai = 0; ai < 2; ++ai)
#pragma unroll
      for (int m = 0; m < 4; ++m) {
        ss[ai][m] = 0.f;
        const int token = u.pm * 256 + ai * 128 + wr * 64 + m * 16 + fr;
        int b, s, key; token_info(token, ctx, b, s, key);
#pragma unroll
        for (int bj = 0; bj < 2; ++bj) {
          const int nb = col0 + bj * 128 + wc * 32;
          f32x4 v0 = acc[ai][bj][m][0], v1 = acc[ai][bj][m][1];
          if (nb < 384) {
#pragma unroll
            for (int e = 0; e < 4; ++e) ss[ai][m] += v0[e] * v0[e] + v1[e] * v1[e];
            bf16_t* dst = nb < 256 ? CQ + (size_t)token * 256 + nb : CKV + (size_t)token * 128 + (nb - 256);
            st8(dst + fq * 8, v0, v1);
          } else if (nb < 448) {
            if (!ctx) rope_pair(v0, v1, rope, (nb >= 416) ? (s & 63) : (s >> 6), fq);
#pragma unroll
            for (int h = 0; h < 8; ++h) {
              bf16_t* dst = K1 + ((size_t)(b * 8 + h) * KVL + key) * 192 + 128 + (nb - 384);
              st8(dst + fq * 8, v0, v1);
            }
          } else if (nb < 1472) {
            if (!ctx) {
#pragma unroll
              for (int e = 0; e < 4; ++e) { v0[e] = silu_f(v0[e]); v1[e] = silu_f(v1[e]); }
              bf16_t* dst = Z1 + (size_t)token * 1024 + (nb - 448);
              st8(dst + fq * 8, v0, v1);
            }
          }
        }
      }
    if (u.pn <= 1) {
#pragma unroll
      for (int ai = 0; ai < 2; ++ai)
#pragma unroll
        for (int m = 0; m < 4; ++m) {
          float sv = ss[ai][m]; sv = xsum<16>(sv); sv = xsum<32>(sv);
          if (fq == 0) ssb[wc * 256 + ai * 128 + wr * 64 + m * 16 + fr] = sv;
        }
      asm volatile("s_waitcnt lgkmcnt(0)" ::: "memory"); __builtin_amdgcn_s_barrier(); asm volatile("" ::: "memory");
      const int lt = wc * 64 + fq * 16 + fr;
      if (lt < 128) {
        const int row = (lt >> 6) * 128 + wr * 64 + (lt & 63);
        if (u.pn == 0) { const float tot = (ssb[row] + ssb[256 + row]) + (ssb[512 + row] + ssb[768 + row]); RQ[u.pm * 256 + row] = rsqrtf(tot * (1.f / 256.f) + 1e-6f); }
        else { const float tot = (ssb[row] + ssb[256 + row]) + (ssb[512 + row] + ssb[768 + row]); RKV[u.pm * 256 + row] = rsqrtf(tot * (1.f / 128.f) + 1e-6f); }
      }
    }
  }
};

struct EpiQ {
  bf16_t* Q1; const float* RQ; const float2* rope;
  DEVI void operator()(acc_t& acc, const Unit& u, int wr, int wc, int fr, int fq) const {
    const int col0 = u.pn * 256;
#pragma unroll
    for (int ai = 0; ai < 2; ++ai)
#pragma unroll
      for (int m = 0; m < 4; ++m) {
        const int token = u.pm * 256 + ai * 128 + wr * 64 + m * 16 + fr; const int s = token & 2047; const float rq = RQ[token];
#pragma unroll
        for (int bj = 0; bj < 2; ++bj) {
          const int n0 = col0 + bj * 128 + wc * 32; const int dd0 = n0 % 192;
          f32x4 v0 = acc[ai][bj][m][0] * rq, v1 = acc[ai][bj][m][1] * rq;
          if (dd0 >= 128) rope_pair(v0, v1, rope, (dd0 >= 160) ? (s & 63) : (s >> 6), fq);
          bf16_t* dst = Q1 + (size_t)token * 1536 + n0;
          st8(dst + fq * 8, v0, v1);
        }
      }
  }
};

struct EpiKV {
  bf16_t *K1, *V1; const float* RKV;
  DEVI void operator()(acc_t& acc, const Unit& u, int wr, int wc, int fr, int fq) const {
    const int col0 = u.pn * 256; const bool ctx = u.pm >= 128;
#pragma unroll
    for (int ai = 0; ai < 2; ++ai)
#pragma unroll
      for (int m = 0; m < 4; ++m) {
        const int token = u.pm * 256 + ai * 128 + wr * 64 + m * 16 + fr; const float rk = RKV[token];
        int b, s, key; token_info(token, ctx, b, s, key);
#pragma unroll
        for (int bj = 0; bj < 2; ++bj) {
          const int nb = col0 + bj * 128 + wc * 32; const int h = nb >> 8, dd = nb & 255;
          const f32x4 v0 = acc[ai][bj][m][0] * rk, v1 = acc[ai][bj][m][1] * rk;
          bf16_t* dst = dd < 128 ? K1 + ((size_t)(b * 8 + h) * KVL + key) * 192 + dd : V1 + ((size_t)(b * 8 + h) * KVL + key) * 128 + (dd - 128);
          st8(dst + fq * 8, v0, v1);
        }
      }
  }
};

template <int SCID> struct ScaleOf { static constexpr float v = SCID == 0 ? 0.125f : 0.07216878364870322f; };
constexpr float THR = 8.f;
template <int KW> DEVI int kswz(int row, int colB) { return row * (KW * 2 + 16) + colB; }
DEVI int v_st(int k, int c) { const int kk = (k & ~0xC) | ((k & 4) << 1) | ((k & 8) >> 1); return ((kk >> 3) * 4 + (c >> 5)) * 512 + ((kk & 7) * 32 + (c & 31)) * 2; }
DEVI int v_rd_base(int lane) { return ((lane & 3) << 3) | (((lane >> 2) & 3) << 6) | (((lane >> 4) & 1) << 5) | (((lane >> 5) & 1) << 8); }
constexpr int v_rd_off(int d0, int ks, int half) { return d0 * 512 + ks * 4096 + half * 2048; }
template <int OFF> DEVI s16x4 tr_read(int vb) { s16x4 r; asm volatile("ds_read_b64_tr_b16 %0, %1 offset:%2" : "=&v"(r) : "v"(vb), "i"(OFF) : "memory"); return r; }

template <int SCID>
DEVI void partialSM(f32x16& p0, f32x16& p1, float& m_reg, float& mn, float& alpha) {
  constexpr float SC = ScaleOf<SCID>::v; constexpr float C = SC * 1.4426950408889634f;
  float pmax = p0[0];
#pragma unroll
  for (int r = 1; r < 16; ++r) pmax = fmaxf(pmax, p0[r]);
#pragma unroll
  for (int r = 0; r < 16; ++r) pmax = fmaxf(pmax, p1[r]);
  { auto rr = __builtin_amdgcn_permlane32_swap(__float_as_uint(pmax), __float_as_uint(pmax), false, false);
    pmax = fmaxf(__uint_as_float(rr[0]), __uint_as_float(rr[1])); }
  if (__builtin_expect(__all(pmax - m_reg <= THR / SC), 1)) { mn = m_reg; alpha = 1.f; }
  else { mn = fmaxf(m_reg, pmax); alpha = __builtin_amdgcn_exp2f((m_reg - mn) * C); m_reg = mn; }
  const float mnC = -mn * C;
#pragma unroll
  for (int r = 0; r < 16; ++r) p0[r] = fmaf(p0[r], C, mnC);
#pragma unroll
  for (int r = 0; r < 16; ++r) p1[r] = fmaf(p1[r], C, mnC);
#pragma unroll
  for (int r = 0; r < 16; ++r) p0[r] = __builtin_amdgcn_exp2f(p0[r]);
}
DEVI void finishSM(f32x16& p0, f32x16& p1, float alpha, float& l_reg, bf16x8& pa0, bf16x8& pa1, bf16x8& pa2, bf16x8& pa3) {
#pragma unroll
  for (int r = 0; r < 16; ++r) p1[r] = __builtin_amdgcn_exp2f(p1[r]);
  float ps = 0;
#pragma unroll
  for (int r = 0; r < 16; ++r) ps += p0[r];
#pragma unroll
  for (int r = 0; r < 16; ++r) ps += p1[r];
  { auto rr = __builtin_amdgcn_permlane32_swap(__float_as_uint(ps), __float_as_uint(ps), false, false);
    ps = __uint_as_float(rr[0]) + __uint_as_float(rr[1]); }
  l_reg = l_reg * alpha + ps;
#define PK4(P, BASE, OUT) do { unsigned a0 = cvtpk(P[BASE + 0], P[BASE + 1]), a1 = cvtpk(P[BASE + 2], P[BASE + 3]); \
    unsigned b0 = cvtpk(P[BASE + 4], P[BASE + 5]), b1 = cvtpk(P[BASE + 6], P[BASE + 7]); \
    auto r0 = __builtin_amdgcn_permlane32_swap(a0, b0, false, false); auto r1 = __builtin_amdgcn_permlane32_swap(a1, b1, false, false); \
    u32x4 w = {r0[0], r1[0], r0[1], r1[1]}; OUT = *reinterpret_cast<bf16x8*>(&w); } while (0)
  PK4(p0, 0, pa0); PK4(p0, 8, pa1); PK4(p1, 0, pa2); PK4(p1, 8, pa3);
#undef PK4
}
template <int KW, int NQ, int QL = 0>
DEVI void qkt(f32x16& p0, f32x16& p1, const char* Ks, const bf16x8* qr, int kcol0, int r32, int hi, const char* ql = nullptr) {
#pragma unroll
  for (int r = 0; r < 16; ++r) { p0[r] = 0.f; p1[r] = 0.f; }
  const char* kb = Ks + kswz<KW>(r32, (kcol0 + hi * 8) * 2);
  constexpr int ROW32 = 32 * (KW * 2 + 16);
  bf16x8 b0n = *reinterpret_cast<const bf16x8*>(kb), b1n = *reinterpret_cast<const bf16x8*>(kb + ROW32);
#pragma unroll
  for (int d0 = 0; d0 < NQ; ++d0) {
    const bf16x8 b0 = b0n, b1 = b1n;
    bf16x8 q;
    if constexpr (QL > 0) { if (d0 >= NQ - QL) q = *reinterpret_cast<const bf16x8*>(ql + (d0 - (NQ - QL)) * 32); else q = qr[d0]; } else q = qr[d0];
    if (d0 + 1 < NQ) { b0n = *reinterpret_cast<const bf16x8*>(kb + (d0 + 1) * 32); b1n = *reinterpret_cast<const bf16x8*>(kb + ROW32 + (d0 + 1) * 32); }
    SBAR();
    p0 = __builtin_amdgcn_mfma_f32_32x32x16_bf16(b0, q, p0, 0, 0, 0);
    p1 = __builtin_amdgcn_mfma_f32_32x32x16_bf16(b1, q, p1, 0, 0, 0);
  }
}
template <int D0> DEVI void pv_one(f32x16& od, int vb, bf16x8 pa0, bf16x8 pa1, bf16x8 pa2, bf16x8 pa3) {
  const s16x4 l0 = tr_read<v_rd_off(D0, 0, 0)>(vb), h0 = tr_read<v_rd_off(D0, 0, 1)>(vb), l1 = tr_read<v_rd_off(D0, 1, 0)>(vb), h1 = tr_read<v_rd_off(D0, 1, 1)>(vb);
  const s16x4 l2 = tr_read<v_rd_off(D0, 2, 0)>(vb), h2 = tr_read<v_rd_off(D0, 2, 1)>(vb), l3 = tr_read<v_rd_off(D0, 3, 0)>(vb), h3 = tr_read<v_rd_off(D0, 3, 1)>(vb);
  asm volatile("s_waitcnt lgkmcnt(0)" ::: "memory"); SBAR();
#define PK(L, H) (bf16x8){L[0], L[1], L[2], L[3], H[0], H[1], H[2], H[3]}
  od = __builtin_amdgcn_mfma_f32_32x32x16_bf16(pa0, PK(l0, h0), od, 0, 0, 0);
  od = __builtin_amdgcn_mfma_f32_32x32x16_bf16(pa1, PK(l1, h1), od, 0, 0, 0);
  od = __builtin_amdgcn_mfma_f32_32x32x16_bf16(pa2, PK(l2, h2), od, 0, 0, 0);
  od = __builtin_amdgcn_mfma_f32_32x32x16_bf16(pa3, PK(l3, h3), od, 0, 0, 0);
#undef PK
}
DEVI void pv_d0(f32x16* o, int vb, bf16x8 pa0, bf16x8 pa1, bf16x8 pa2, bf16x8 pa3) {
  pv_one<0>(o[0], vb, pa0, pa1, pa2, pa3); pv_one<1>(o[1], vb, pa0, pa1, pa2, pa3); pv_one<2>(o[2], vb, pa0, pa1, pa2, pa3); pv_one<3>(o[3], vb, pa0, pa1, pa2, pa3);
}

template <int KW, int NQ, int SCID>
DEVI void attn_core(int wv, const bf16_t* __restrict__ Qw, const bf16_t* __restrict__ Kh, const bf16_t* __restrict__ Vh, int kcol0, int NT, char* lds,
                    f32x16 (&o)[4], float& l_out) {
  constexpr int SHM_V = 64 * 128 * 2, SHM_K = 64 * (KW * 2 + 16), KC = KW / 64;
  const int tid = tidx(wv), wid = tid >> 6, lane = tid & 63, r32 = lane & 31, hi = lane >> 5;
  char* V_lds = lds; char* K_lds = lds + 2 * SHM_V;
  float* al_l = (float*)(lds + 2 * SHM_V + 2 * SHM_K) + wid * 64 + 32;
  float m_reg = -1e30f, l_reg = 0;
#pragma unroll
  for (int d = 0; d < 4; ++d)
#pragma unroll
    for (int r = 0; r < 16; ++r) o[d][r] = 0.f;
  bf16x8 qr[NQ];
#pragma unroll
  for (int d0 = 0; d0 < NQ; ++d0) qr[d0] = *reinterpret_cast<const bf16x8*>(Qw + d0 * 16);
  const int sr = tid >> 4, sc = (tid & 15) * 8, vst0 = v_st(sr, sc), vst1 = v_st(32 + sr, sc);
  const int krow = tid >> 3, kch = tid & 7;
  const bf16_t* vg = Vh + sr * 128 + sc;
  const bf16_t* kg = Kh + krow * KW + kch * 8;
  const int vb0 = (int)(uintptr_t)V_lds + v_rd_base(lane);
  bf16x8 vs0, vs1, ks[KC];
#define SLOAD(k0) do { vs0 = *reinterpret_cast<const bf16x8*>(vg + (size_t)(k0) * 128); vs1 = *reinterpret_cast<const bf16x8*>(vg + (size_t)((k0) + 32) * 128); \
    _Pragma("unroll") for (int _c = 0; _c < KC; ++_c) ks[_c] = *reinterpret_cast<const bf16x8*>(kg + (size_t)(k0) * KW + _c * 64); } while (0)
#define SWRITE(b) do { *reinterpret_cast<bf16x8*>(V_lds + (b) * SHM_V + vst0) = vs0; *reinterpret_cast<bf16x8*>(V_lds + (b) * SHM_V + vst1) = vs1; \
    _Pragma("unroll") for (int _c = 0; _c < KC; ++_c) *reinterpret_cast<bf16x8*>(K_lds + (b) * SHM_K + kswz<KW>(krow, (kch + 8 * _c) * 16)) = ks[_c]; } while (0)
  SLOAD(0); SWRITE(0);
  if (NT > 1) SLOAD(64);
  __syncthreads();
  for (int j = 0; j < NT; ++j) {
    const int bsel = j & 1;
    f32x16 p0, p1; float mn, alpha; bf16x8 pa0, pa1, pa2, pa3;
    qkt<KW, NQ>(p0, p1, K_lds + bsel * SHM_K, qr, kcol0, r32, hi);
    partialSM<SCID>(p0, p1, m_reg, mn, alpha);
    if (__any(alpha < 1.f)) {
      if (hi == 0) al_l[r32] = alpha;
      asm volatile("s_waitcnt lgkmcnt(0)" ::: "memory");
#pragma unroll
      for (int d = 0; d < 4; ++d)
#pragma unroll
        for (int r = 0; r < 16; ++r) o[d][r] *= al_l[crow(r, hi)];
    }
    finishSM(p0, p1, alpha, l_reg, pa0, pa1, pa2, pa3);
    pv_d0(o, vb0 + bsel * SHM_V, pa0, pa1, pa2, pa3);
    if (j + 1 < NT) { SWRITE(bsel ^ 1); if (j + 2 < NT) SLOAD((j + 2) * 64); }
    __syncthreads();
  }
  l_out = l_reg;
#undef SLOAD
#undef SWRITE
}

template <int KW, int NQ, int SDEPTH, int SCID, int QL>
DEVI void attn_core_pipe(int wv, const bf16_t* __restrict__ Qw, const bf16_t* __restrict__ Kh, const bf16_t* __restrict__ Vh, int kcol0, int NT, char* lds,
                         f32x16 (&o)[4], float& l_out) {
  constexpr int SHM_V = 64 * 128 * 2, SHM_K = 64 * (KW * 2 + 16), KC = KW / 64;
  const int tid = tidx(wv), wid = tid >> 6, lane = tid & 63, r32 = lane & 31, hi = lane >> 5;
  char* V_lds = lds; char* K_lds = lds + 2 * SHM_V;
  float* al_l = (float*)(lds + 2 * SHM_V + 2 * SHM_K) + wid * 64 + 32;
  float m_reg = -1e30f, l_reg = 0;
#pragma unroll
  for (int d = 0; d < 4; ++d)
#pragma unroll
    for (int r = 0; r < 16; ++r) o[d][r] = 0.f;
  bf16x8 qr[NQ - QL + (QL ? 1 : 0)];
#pragma unroll
  for (int d0 = 0; d0 < NQ - QL; ++d0) qr[d0] = *reinterpret_cast<const bf16x8*>(Qw + d0 * 16);
  char* ql = lds + 2 * SHM_V + 2 * SHM_K + 2048 + (wid * 32 + r32) * 144 + hi * 16;
  if constexpr (QL > 0) {
#pragma unroll
    for (int d0 = NQ - QL; d0 < NQ; ++d0) *reinterpret_cast<bf16x8*>(ql + (d0 - (NQ - QL)) * 32) = *reinterpret_cast<const bf16x8*>(Qw + d0 * 16);
  }
  const int sr = tid >> 4, sc = (tid & 15) * 8, vst0 = v_st(sr, sc), vst1 = v_st(32 + sr, sc);
  const int krow = tid >> 3, kch = tid & 7;
  const bf16_t* vg = Vh + sr * 128 + sc;
  const bf16_t* kg = Kh + krow * KW + kch * 8;
  const int vb0 = (int)(uintptr_t)V_lds + v_rd_base(lane);
  struct { bf16x8 vs0, vs1, ks[KC]; } sr_[SDEPTH];
#define SLOAD(i, k0) do { sr_[i].vs0 = *reinterpret_cast<const bf16x8*>(vg + (size_t)(k0) * 128); sr_[i].vs1 = *reinterpret_cast<const bf16x8*>(vg + (size_t)((k0) + 32) * 128); \
    _Pragma("unroll") for (int _c = 0; _c < KC; ++_c) sr_[i].ks[_c] = *reinterpret_cast<const bf16x8*>(kg + (size_t)(k0) * KW + _c * 64); } while (0)
#define SWRITE(b, i) do { *reinterpret_cast<bf16x8*>(V_lds + (b) * SHM_V + vst0) = sr_[i].vs0; *reinterpret_cast<bf16x8*>(V_lds + (b) * SHM_V + vst1) = sr_[i].vs1; \
    _Pragma("unroll") for (int _c = 0; _c < KC; ++_c) *reinterpret_cast<bf16x8*>(K_lds + (b) * SHM_K + kswz<KW>(krow, (kch + 8 * _c) * 16)) = sr_[i].ks[_c]; } while (0)
#define SWAIT() do { if constexpr (SDEPTH == 2) asm volatile("s_waitcnt vmcnt(4)" ::: "memory"); else asm volatile("s_waitcnt vmcnt(0)" ::: "memory"); } while (0)
#define RESC(a) do { if (__any((a) < 1.f)) { if (hi == 0) al_l[r32] = (a); asm volatile("s_waitcnt lgkmcnt(0)" ::: "memory"); \
    _Pragma("unroll") for (int _d = 0; _d < 4; ++_d) _Pragma("unroll") for (int _r = 0; _r < 16; ++_r) o[_d][_r] *= al_l[crow(_r, hi)]; } } while (0)
  f32x16 pA0, pA1, pB0, pB1; float mnA, mnB, alA, alB; bf16x8 pa0, pa1, pa2, pa3;
  constexpr int SE = 0, SO = SDEPTH - 1;
  SLOAD(SE, 0); asm volatile("s_waitcnt vmcnt(0)" ::: "memory"); SWRITE(0, SE); __syncthreads();
  qkt<KW, NQ, QL>(pA0, pA1, K_lds, qr, kcol0, r32, hi, ql); partialSM<SCID>(pA0, pA1, m_reg, mnA, alA);
  SLOAD(SO, 64); if constexpr (SDEPTH == 2) { if (2 < NT) SLOAD(SE, 128); }
  SWAIT(); SWRITE(1, SO); __syncthreads();
  for (int j = 1; j + 1 < NT; j += 2) {
    SBAR(); qkt<KW, NQ, QL>(pB0, pB1, K_lds + SHM_K, qr, kcol0, r32, hi, ql);
    finishSM(pA0, pA1, alA, l_reg, pa0, pa1, pa2, pa3); SBAR();
    SLOAD(SO, (j + SDEPTH) * 64); SBAR();
    pv_d0(o, vb0, pa0, pa1, pa2, pa3); partialSM<SCID>(pB0, pB1, m_reg, mnB, alB);
    __syncthreads(); SWAIT(); SWRITE(0, SE);
    RESC(alB); __syncthreads();
    SBAR(); qkt<KW, NQ, QL>(pA0, pA1, K_lds, qr, kcol0, r32, hi, ql);
    finishSM(pB0, pB1, alB, l_reg, pa0, pa1, pa2, pa3); SBAR();
    if (SDEPTH == 1 || j + 3 < NT) SLOAD(SE, (j + 1 + SDEPTH) * 64);
    SBAR();
    pv_d0(o, vb0 + SHM_V, pa0, pa1, pa2, pa3); partialSM<SCID>(pA0, pA1, m_reg, mnA, alA);
    __syncthreads(); SWAIT(); SWRITE(1, SO);
    RESC(alA); __syncthreads();
  }
  SBAR(); qkt<KW, NQ, QL>(pB0, pB1, K_lds + SHM_K, qr, kcol0, r32, hi, ql);
  finishSM(pA0, pA1, alA, l_reg, pa0, pa1, pa2, pa3); SBAR();
  pv_d0(o, vb0, pa0, pa1, pa2, pa3); partialSM<SCID>(pB0, pB1, m_reg, mnB, alB);
  __syncthreads(); RESC(alB);
  finishSM(pB0, pB1, alB, l_reg, pa0, pa1, pa2, pa3); SBAR();
  pv_d0(o, vb0 + SHM_V, pa0, pa1, pa2, pa3);
  __syncthreads();
  l_out = l_reg;
#undef SLOAD
#undef SWRITE
#undef SWAIT
#undef RESC
}

template <int KW, int NQ, int SCID, int QL>
DEVI void attn_core_dma(int wv, const bf16_t* __restrict__ Qw, const bf16_t* __restrict__ Kh, const bf16_t* __restrict__ Vh, int kcol0, int NT, char* lds,
                        f32x16 (&o)[4], float& l_out) {
  constexpr int SHM_V = 64 * 128 * 2, KCH = KW / 8 + 1, SHM_K = 64 * KCH * 16, KR = (64 * KCH) / 512;
  static_assert(64 * KCH - KR * 512 == 64, "remainder must be one wave");
  const int tid = tidx(wv), wid = tid >> 6, lane = tid & 63, r32 = lane & 31, hi = lane >> 5;
  char* V_lds = lds; char* K_lds = lds + 2 * SHM_V;
  float* al_l = (float*)(lds + 2 * SHM_V + 2 * SHM_K) + wid * 64 + 32;
  float m_reg = -1e30f, l_reg = 0;
#pragma unroll
  for (int d = 0; d < 4; ++d)
#pragma unroll
    for (int r = 0; r < 16; ++r) o[d][r] = 0.f;
  bf16x8 qr[NQ - QL + (QL ? 1 : 0)];
#pragma unroll
  for (int d0 = 0; d0 < NQ - QL; ++d0) qr[d0] = *reinterpret_cast<const bf16x8*>(Qw + d0 * 16);
  char* ql = lds + 2 * SHM_V + 2 * SHM_K + 2048 + (wid * 32 + r32) * 144 + hi * 16;
  if constexpr (QL > 0) {
#pragma unroll
    for (int d0 = NQ - QL; d0 < NQ; ++d0) *reinterpret_cast<bf16x8*>(ql + (d0 - (NQ - QL)) * 32) = *reinterpret_cast<const bf16x8*>(Qw + d0 * 16);
  }
  const int sr = tid >> 4, sc = (tid & 15) * 8, vst0 = v_st(sr, sc), vst1 = v_st(32 + sr, sc);
  const bf16_t* vg = Vh + sr * 128 + sc;
  const int vb0 = (int)(uintptr_t)V_lds + v_rd_base(lane);
  unsigned koff[KR + 1];
#pragma unroll
  for (int i = 0; i <= KR; ++i) { const int c = tid + 512 * i; const int row = c / KCH; int ch = c - row * KCH; ch = ch == KCH - 1 ? KCH - 2 : ch; koff[i] = (unsigned)(row * KW + ch * 8) * 2u; }
  const unsigned kldsw = (unsigned)__builtin_amdgcn_readfirstlane(wid) * 1024u;
  bf16x8 vs0, vs1;
#define KDMA(k0, b) do { const char* _g = (const char*)(Kh + (size_t)(k0) * KW); PG8_LAS unsigned char* _l = (PG8_LAS unsigned char*)(K_lds + (b) * SHM_K) + kldsw; \
    _Pragma("unroll") for (int _i = 0; _i < KR; ++_i) __builtin_amdgcn_global_load_lds((const unsigned*)(_g + koff[_i]), (PG8_LAS unsigned*)(_l + _i * 8192), 16, 0, 0); \
    if (wid == 0) __builtin_amdgcn_global_load_lds((const unsigned*)(_g + koff[KR]), (PG8_LAS unsigned*)(_l + KR * 8192), 16, 0, 0); } while (0)
#define VLOAD(k0) do { vs0 = *reinterpret_cast<const bf16x8*>(vg + (size_t)(k0) * 128); vs1 = *reinterpret_cast<const bf16x8*>(vg + (size_t)((k0) + 32) * 128); } while (0)
#define VWRITE(b) do { *reinterpret_cast<bf16x8*>(V_lds + (b) * SHM_V + vst0) = vs0; *reinterpret_cast<bf16x8*>(V_lds + (b) * SHM_V + vst1) = vs1; } while (0)
#define VMW() asm volatile("s_waitcnt vmcnt(0)" ::: "memory")
#define RESC(a) do { if (__any((a) < 1.f)) { if (hi == 0) al_l[r32] = (a); asm volatile("s_waitcnt lgkmcnt(0)" ::: "memory"); \
    _Pragma("unroll") for (int _d = 0; _d < 4; ++_d) _Pragma("unroll") for (int _r = 0; _r < 16; ++_r) o[_d][_r] *= al_l[crow(_r, hi)]; } } while (0)
  f32x16 pA0, pA1, pB0, pB1; float mnA, mnB, alA, alB; bf16x8 pa0, pa1, pa2, pa3;
  KDMA(0, 0); VLOAD(0); VMW(); VWRITE(0); __syncthreads();
  KDMA(64, 1); VLOAD(64);
  qkt<KW, NQ, QL>(pA0, pA1, K_lds, qr, kcol0, r32, hi, ql); partialSM<SCID>(pA0, pA1, m_reg, mnA, alA);
  VMW(); __syncthreads(); VWRITE(1); __syncthreads();
  for (int j = 1; j + 1 < NT; j += 2) {
    SBAR(); KDMA((j + 1) * 64, 0); VLOAD((j + 1) * 64); SBAR();
    qkt<KW, NQ, QL>(pB0, pB1, K_lds + SHM_K, qr, kcol0, r32, hi, ql);
    finishSM(pA0, pA1, alA, l_reg, pa0, pa1, pa2, pa3); SBAR();
    pv_d0(o, vb0, pa0, pa1, pa2, pa3); partialSM<SCID>(pB0, pB1, m_reg, mnB, alB);
    VMW(); __syncthreads(); VWRITE(0);
    RESC(alB); __syncthreads();
    SBAR(); KDMA((j + 2) * 64, 1); VLOAD((j + 2) * 64); SBAR();
    qkt<KW, NQ, QL>(pA0, pA1, K_lds, qr, kcol0, r32, hi, ql);
    finishSM(pB0, pB1, alB, l_reg, pa0, pa1, pa2, pa3); SBAR();
    pv_d0(o, vb0 + SHM_V, pa0, pa1, pa2, pa3); partialSM<SCID>(pA0, pA1, m_reg, mnA, alA);
    VMW(); __syncthreads(); VWRITE(1);
    RESC(alA); __syncthreads();
  }
  SBAR(); qkt<KW, NQ, QL>(pB0, pB1, K_lds + SHM_K, qr, kcol0, r32, hi, ql);
  finishSM(pA0, pA1, alA, l_reg, pa0, pa1, pa2, pa3); SBAR();
  pv_d0(o, vb0, pa0, pa1, pa2, pa3); partialSM<SCID>(pB0, pB1, m_reg, mnB, alB);
  RESC(alB);
  finishSM(pB0, pB1, alB, l_reg, pa0, pa1, pa2, pa3); SBAR();
  pv_d0(o, vb0 + SHM_V, pa0, pa1, pa2, pa3);
  __syncthreads();
  l_out = l_reg;
#undef KDMA
#undef VLOAD
#undef VWRITE
#undef VMW
#undef RESC
}

template <int KW, int NQ, int SCID, int QL>
DEVI void attn_core_pp(int wv, const bf16_t* __restrict__ Qw, const bf16_t* __restrict__ Kh, const bf16_t* __restrict__ Vh, int kcol0, int NT, char* lds,
                       f32x16 (&o)[4], float& l_out) {
  constexpr int SHM_V = 64 * 128 * 2, KCH = KW / 8 + 1, SHM_K = 64 * KCH * 16, KR = (64 * KCH) / 512;
  static_assert(64 * KCH - KR * 512 == 64, "remainder must be one wave");
  const int tid = tidx(wv), wid = tid >> 6, lane = tid & 63, r32 = lane & 31, hi = lane >> 5;
  const int g = __builtin_amdgcn_readfirstlane(wid >> 2);
  char* V_lds = lds; char* K_lds = lds + 2 * SHM_V;
  float* al_l = (float*)(lds + 2 * SHM_V + 2 * SHM_K) + wid * 64 + 32;
  float m_reg = -1e30f, l_reg = 0;
#pragma unroll
  for (int d = 0; d < 4; ++d)
#pragma unroll
    for (int r = 0; r < 16; ++r) o[d][r] = 0.f;
  bf16x8 qr[NQ - QL + (QL ? 1 : 0)];
#pragma unroll
  for (int d0 = 0; d0 < NQ - QL; ++d0) qr[d0] = *reinterpret_cast<const bf16x8*>(Qw + d0 * 16);
  char* ql = lds + 2 * SHM_V + 2 * SHM_K + 2048 + (wid * 32 + r32) * 144 + hi * 16;
  if constexpr (QL > 0) {
#pragma unroll
    for (int d0 = NQ - QL; d0 < NQ; ++d0) *reinterpret_cast<bf16x8*>(ql + (d0 - (NQ - QL)) * 32) = *reinterpret_cast<const bf16x8*>(Qw + d0 * 16);
  }
  const int vb0 = (int)(uintptr_t)V_lds + v_rd_base(lane);
  unsigned koff[KR + 1], voff[2];
#pragma unroll
  for (int i = 0; i <= KR; ++i) { const int c = tid + 512 * i; const int row = c / KCH; int ch = c - row * KCH; ch = ch == KCH - 1 ? KCH - 2 : ch; koff[i] = (unsigned)(row * KW + ch * 8) * 2u; }
#pragma unroll
  for (int i = 0; i < 2; ++i) { const int q = tid + 512 * i; const int st = q >> 5, kk = (st >> 2) * 8 + ((q >> 2) & 7), c = (st & 3) * 32 + (q & 3) * 8;
    const int k = (kk & ~0xC) | ((kk & 4) << 1) | ((kk & 8) >> 1); voff[i] = (unsigned)(k * 128 + c) * 2u; }
  const unsigned ldsw = (unsigned)__builtin_amdgcn_readfirstlane(wid) * 1024u;
#define KDMA(k0, b) do { const char* _g = (const char*)(Kh + (size_t)(k0) * KW); PG8_LAS unsigned char* _l = (PG8_LAS unsigned char*)(K_lds + (b) * SHM_K) + ldsw; \
    _Pragma("unroll") for (int _i = 0; _i < KR; ++_i) __builtin_amdgcn_global_load_lds((const unsigned*)(_g + koff[_i]), (PG8_LAS unsigned*)(_l + _i * 8192), 16, 0, 0); \
    if (wid == 0) __builtin_amdgcn_global_load_lds((const unsigned*)(_g + koff[KR]), (PG8_LAS unsigned*)(_l + KR * 8192), 16, 0, 0); } while (0)
#define VDMA(k0, b) do { const char* _g = (const char*)(Vh + (size_t)(k0) * 128); PG8_LAS unsigned char* _l = (PG8_LAS unsigned char*)(V_lds + (b) * SHM_V) + ldsw; \
    _Pragma("unroll") for (int _i = 0; _i < 2; ++_i) __builtin_amdgcn_global_load_lds((const unsigned*)(_g + voff[_i]), (PG8_LAS unsigned*)(_l + _i * 8192), 16, 0, 0); } while (0)
#define VMW() asm volatile("s_waitcnt vmcnt(0)" ::: "memory")
#define PBAR() do { asm volatile("" ::: "memory"); __builtin_amdgcn_s_barrier(); asm volatile("" ::: "memory"); } while (0)
#define RESC(a) do { if (__any((a) < 1.f)) { if (hi == 0) al_l[r32] = (a); asm volatile("s_waitcnt lgkmcnt(0)" ::: "memory"); \
    _Pragma("unroll") for (int _d = 0; _d < 4; ++_d) _Pragma("unroll") for (int _r = 0; _r < 16; ++_r) o[_d][_r] *= al_l[crow(_r, hi)]; } } while (0)
  f32x16 pA0, pA1, pB0, pB1; float mn, al; bf16x8 pa0, pa1, pa2, pa3;
  KDMA(0, 0); KDMA(64, 1); VMW(); __syncthreads();
  qkt<KW, NQ, QL>(pA0, pA1, K_lds, qr, kcol0, r32, hi, ql);
  PBAR();
  if (g == 1) PBAR();
  for (int j = 0; j < NT; j += 2) {
    SBAR(); if (j + 2 < NT) KDMA((j + 2) * 64, 0); VDMA(j * 64, 0); SBAR();
    qkt<KW, NQ, QL>(pB0, pB1, K_lds + SHM_K, qr, kcol0, r32, hi, ql);
    if (j > 0) pv_d0(o, vb0 + SHM_V, pa0, pa1, pa2, pa3);
    if (g == 1) VMW();
    PBAR(); SBAR();
    partialSM<SCID>(pA0, pA1, m_reg, mn, al); RESC(al); finishSM(pA0, pA1, al, l_reg, pa0, pa1, pa2, pa3);
    if (g == 0) VMW();
    PBAR(); SBAR();
    if (j + 3 < NT) KDMA((j + 3) * 64, 1);
    VDMA((j + 1) * 64, 1); SBAR();
    if (j + 2 < NT) qkt<KW, NQ, QL>(pA0, pA1, K_lds, qr, kcol0, r32, hi, ql);
    pv_d0(o, vb0, pa0, pa1, pa2, pa3);
    if (g == 1) VMW();
    PBAR(); SBAR();
    partialSM<SCID>(pB0, pB1, m_reg, mn, al); RESC(al); finishSM(pB0, pB1, al, l_reg, pa0, pa1, pa2, pa3);
    if (g == 0) VMW();
    PBAR(); SBAR();
  }
  pv_d0(o, vb0 + SHM_V, pa0, pa1, pa2, pa3);
  if (g == 0) PBAR();
  __syncthreads();
  l_out = l_reg;
#undef KDMA
#undef VDMA
#undef VMW
#undef PBAR
#undef RESC
}

DEVI void attn0_item(int wv, const Params& p, int token0, int b, int h, int nkeys, char* lds) {
  const int tid = tidx(wv), wid = tid >> 6, lane = tid & 63, r32 = lane & 31, hi = lane >> 5, m = wid >> 2, wl = wid & 3;
  const bf16_t* Q0 = (const bf16_t*)(p.ws + OFF_Q0); const bf16_t* K0 = (const bf16_t*)(p.ws + OFF_K0); const bf16_t* V0 = (const bf16_t*)(p.ws + OFF_V0);
  const bf16_t* ZB = (const bf16_t*)(p.ws + OFF_ZB); bf16_t* MIX = (bf16_t*)(p.ws + OFF_MIX);
  const bf16_t* Qw = Q0 + (size_t)(token0 + wl * 32 + r32) * 512 + h * 128 + m * 64 + hi * 8;
  const size_t kvo = (size_t)(b * 4 + h) * KVL * 128;
  f32x16 o[4]; float l;
  attn_core_pp<128, 4, 0, 0>(wv, Qw, K0 + kvo, V0 + kvo, m * 64, nkeys >> 6, lds, o, l);
  float* li_l = (float*)(lds + 32768 + 2 * 64 * 272) + wid * 64;
  if (hi == 0) li_l[r32] = l;
  asm volatile("s_waitcnt lgkmcnt(0)" ::: "memory");
  float rli[16];
#pragma unroll
  for (int r = 0; r < 16; ++r) rli[r] = __builtin_amdgcn_rcpf(li_l[crow(r, hi)]);
  float t1 = p.b_lq1[lane] * p.b_lk1[lane], t2 = p.b_lq2[lane] * p.b_lk2[lane];
  t1 = wave_sum(t1); t2 = wave_sum(t2);
  const float lam = __expf(t1) - __expf(t2) + 0.2f;
  __syncthreads();
  float* xch = (float*)lds;
  if (m == 1) {
#pragma unroll
    for (int r = 0; r < 16; ++r)
#pragma unroll
      for (int d0 = 0; d0 < 4; ++d0) xch[(wl * 32 + crow(r, hi)) * 128 + d0 * 32 + r32] = o[d0][r] * rli[r];
  }
  __syncthreads();
  if (m == 0) {
    float sw4[4];
#pragma unroll
    for (int d0 = 0; d0 < 4; ++d0) sw4[d0] = p.b_subln_w[d0 * 32 + r32];
#pragma unroll
    for (int r = 0; r < 16; ++r) {
      const int row = wl * 32 + crow(r, hi); const int token = token0 + row;
      float a[4], ss = 0.f;
#pragma unroll
      for (int d0 = 0; d0 < 4; ++d0) { a[d0] = o[d0][r] * rli[r] - lam * xch[row * 128 + d0 * 32 + r32]; ss += a[d0] * a[d0]; }
      ss = xsum<1>(ss); ss = xsum<2>(ss); ss = xsum<4>(ss); ss = xsum<8>(ss); ss = xsum<16>(ss);
      const float rstd = rsqrtf(ss * (1.f / 128.f) + 1e-5f) * 0.8f;
#pragma unroll
      for (int d0 = 0; d0 < 4; ++d0) {
        const int d = d0 * 32 + r32;
        const float val = a[d0] * rstd * sw4[d0] * bf2f(ZB[(size_t)token * 512 + h * 128 + d]);
        MIX[(size_t)token * 1024 + 512 + h * 128 + d] = f2bf(val);
      }
    }
  }
  __syncthreads();
}

DEVI void attn1_item(int wv, const Params& p, int b, int h, int qb, char* lds) {
  const int tid = tidx(wv), wid = tid >> 6, lane = tid & 63, r32 = lane & 31, hi = lane >> 5;
  const bf16_t* Q1 = (const bf16_t*)(p.ws + OFF_Q1); const bf16_t* K1 = (const bf16_t*)(p.ws + OFF_K1); const bf16_t* V1 = (const bf16_t*)(p.ws + OFF_V1);
  const bf16_t* Z1 = (const bf16_t*)(p.ws + OFF_Z1); bf16_t* MIX = (bf16_t*)(p.ws + OFF_MIX);
  const int token0 = b * 2048 + qb * 256;
  const bf16_t* Qw = Q1 + (size_t)(token0 + wid * 32 + r32) * 1536 + h * 192 + hi * 8;
  f32x16 o[4]; float l;
  attn_core_pp<192, 12, 1, 4>(wv, Qw, K1 + (size_t)(b * 8 + h) * KVL * 192, V1 + (size_t)(b * 8 + h) * KVL * 128, 0, KVL / 64, lds, o, l);
  float* li_l = (float*)(lds + 32768 + 2 * 64 * 400) + wid * 64;
  if (hi == 0) li_l[r32] = l;
  asm volatile("s_waitcnt lgkmcnt(0)" ::: "memory");
#pragma unroll
  for (int r = 0; r < 16; ++r) {
    const int cr = crow(r, hi); const float rl = __builtin_amdgcn_rcpf(li_l[cr]); const int token = token0 + wid * 32 + cr;
#pragma unroll
    for (int d0 = 0; d0 < 4; ++d0) {
      const int d = h * 128 + d0 * 32 + r32;
      MIX[(size_t)token * 1024 + d] = f2bf(o[d0][r] * rl * bf2f(Z1[(size_t)token * 1024 + d]));
    }
  }
  __syncthreads();
}

DEVI void abranch_item(int wv, const Params& p, int ci, char* lds) {
  const int tid = tidx(wv), wid = tid >> 6, lane = tid & 63, r32 = lane & 31, hi = lane >> 5;
  const bf16_t* GV = (const bf16_t*)(p.ws + OFF_GV); const bf16_t* U = (const bf16_t*)(p.ws + OFF_U); const bf16_t* ZA = (const bf16_t*)(p.ws + OFF_ZA);
  const bf16_t* WSB = (const bf16_t*)(p.ws + OFF_WSB); bf16_t* MIX = (bf16_t*)(p.ws + OFF_MIX);
  const int t0 = ci * 128;
  bf16_t* vnT = (bf16_t*)lds;
  {
    const int pos = tid >> 2, cp = tid & 3;
    const bf16_t* g = GV + (size_t)(t0 + pos) * 512;
    float s = 0.f, q = 0.f;
#pragma unroll 4
    for (int i = 0; i < 16; ++i) {
      const bf16x8 raw = *reinterpret_cast<const bf16x8*>(g + (i * 4 + cp) * 8);
#pragma unroll
      for (int e = 0; e < 8; ++e) { const float xv = bf2f((bf16_t)raw[e]); s += xv; q += xv * xv; }
    }
    s = xsum<1>(s); s = xsum<2>(s); q = xsum<1>(q); q = xsum<2>(q);
    const float mu = s * (1.f / 512.f);
    const float rstd = rsqrtf(fmaxf(q * (1.f / 512.f) - mu * mu, 0.f) + 1e-5f);
#pragma unroll 2
    for (int i = 0; i < 16; ++i) {
      const int c0 = (i * 4 + cp) * 8;
      const bf16x8 raw = *reinterpret_cast<const bf16x8*>(g + c0);
      const f32x4 w0 = *reinterpret_cast<const f32x4*>(p.a_ln_w + c0), w1 = *reinterpret_cast<const f32x4*>(p.a_ln_w + c0 + 4);
      const f32x4 b0 = *reinterpret_cast<const f32x4*>(p.a_ln_b + c0), b1 = *reinterpret_cast<const f32x4*>(p.a_ln_b + c0 + 4);
#pragma unroll
      for (int e = 0; e < 8; ++e) {
        const float wv = e < 4 ? w0[e & 3] : w1[e & 3], bv = e < 4 ? b0[e & 3] : b1[e & 3];
        vnT[(c0 + e) * 136 + pos] = f2bf((bf2f((bf16_t)raw[e]) - mu) * rstd * wv + bv);
      }
    }
  }
  __syncthreads();
  const int g8 = wid;
  const bf16_t* Wg = WSB + g8 * 128 * 128;
  for (int pb = 0; pb < 4; ++pb) {
    f32x16 acc[2];
#pragma unroll
    for (int r = 0; r < 16; ++r) { acc[0][r] = 0.f; acc[1][r] = 0.f; }
#pragma unroll
    for (int ks = 0; ks < 8; ++ks) {
      const bf16x8 bw = *reinterpret_cast<const bf16x8*>(Wg + (pb * 32 + r32) * 128 + ks * 16 + hi * 8);
#pragma unroll
      for (int db = 0; db < 2; ++db) {
        const bf16x8 a = *reinterpret_cast<const bf16x8*>(vnT + (g8 * 64 + db * 32 + r32) * 136 + ks * 16 + hi * 8);
        acc[db] = __builtin_amdgcn_mfma_f32_32x32x16_bf16(a, bw, acc[db], 0, 0, 0);
      }
    }
    const int token = t0 + pb * 32 + r32; const float bias = p.a_bs[g8 * 128 + pb * 32 + r32];
#pragma unroll
    for (int db = 0; db < 2; ++db)
#pragma unroll
      for (int rg = 0; rg < 4; ++rg) {
        const int c = g8 * 64 + db * 32 + rg * 8 + hi * 4;
        const u32x2 u2 = *reinterpret_cast<const u32x2*>(U + (size_t)token * 512 + c), z2 = *reinterpret_cast<const u32x2*>(ZA + (size_t)token * 512 + c);
        const float o0 = bflo(u2[0]) * (acc[db][rg * 4 + 0] + bias) * bflo(z2[0]), o1 = bfhi(u2[0]) * (acc[db][rg * 4 + 1] + bias) * bfhi(z2[0]);
        const float o2 = bflo(u2[1]) * (acc[db][rg * 4 + 2] + bias) * bflo(z2[1]), o3 = bfhi(u2[1]) * (acc[db][rg * 4 + 3] + bias) * bfhi(z2[1]);
        u32x2 pk = {cvtpk(o0, o1), cvtpk(o2, o3)};
        *reinterpret_cast<u32x2*>(MIX + (size_t)token * 1024 + c) = pk;
      }
  }
  __syncthreads();
}

DEVI void tr_tile(int wv, const float* __restrict__ src, bf16_t* __restrict__ dst, int K, int N, int tilesN, const float* __restrict__ scale, int t, char* lds) {
  const int tid = tidx(wv);
  const int k0 = (t / tilesN) * 64, n0 = (t % tilesN) * 64;
  const int kr = tid >> 3, ng = (tid & 7) * 8;
  f32x4 v0 = {0.f, 0.f, 0.f, 0.f}, v1 = {0.f, 0.f, 0.f, 0.f};
  if (n0 + ng < N) { const float* s = src + (size_t)(k0 + kr) * N + n0 + ng; v0 = *reinterpret_cast<const f32x4*>(s); v1 = *reinterpret_cast<const f32x4*>(s + 4); }
  const float scv = scale ? scale[k0 + kr] : 1.f;
  bf16_t* tl = (bf16_t*)lds;
#pragma unroll
  for (int e = 0; e < 4; ++e) { tl[(ng + e) * 72 + kr] = f2bf(v0[e] * scv); tl[(ng + 4 + e) * 72 + kr] = f2bf(v1[e] * scv); }
  __syncthreads();
  const int n = tid >> 3, kc = (tid & 7) * 8;
  *reinterpret_cast<bf16x8*>(dst + (size_t)(n0 + n) * K + k0 + kc) = *reinterpret_cast<const bf16x8*>(tl + n * 72 + kc);
}

DEVI void phase0(int wv, const Params& p, char* lds) {
  const int tid = tidx(wv);
  constexpr int N_ADA = 192, N_TR = 1952, N_WS = 16;
  for (int it = blockIdx.x; it < N_ADA + N_TR + N_WS + 1; it += gridDim.x) {
    if (it < N_ADA) {
      const int li = it / 96, chunk = it % 96;
      float* sc = (float*)lds;
      for (int idx = tid; idx < 17 * 1024; idx += 512) { const int r = idx >> 10, k = idx & 1023; const float xv = r < 16 ? p.c[r * 1024 + k] : p.c_ctx[k]; sc[idx] = xv / (1.f + expf(-xv)); }
      __syncthreads();
      const int col = tid & 31, kp = tid >> 5;
      const float* w = p.ada_w + (size_t)li * 1024 * 3072 + chunk * 32 + col;
      float acc[17];
#pragma unroll
      for (int r = 0; r < 17; ++r) acc[r] = 0.f;
#pragma unroll 8
      for (int k = kp * 64; k < kp * 64 + 64; ++k) {
        const float wv = w[(size_t)k * 3072];
#pragma unroll
        for (int r = 0; r < 17; ++r) acc[r] += sc[r * 1024 + k] * wv;
      }
      float* red = (float*)(lds + 17 * 1024 * 4);
#pragma unroll
      for (int r = 0; r < 17; ++r) red[(kp * 17 + r) * 32 + col] = acc[r];
      __syncthreads();
      float* ada = (float*)(p.ws + OFF_ADA);
      for (int idx = tid; idx < 544; idx += 512) {
        const int r = idx >> 5, cc = idx & 31; float s = 0.f;
        for (int k2 = 0; k2 < 16; ++k2) s += red[(k2 * 17 + r) * 32 + cc];
        ada[(size_t)(li * 17 + r) * 3072 + chunk * 32 + cc] = s + p.ada_b[li * 3072 + chunk * 32 + cc];
      }
    } else if (it < N_ADA + N_TR) {
      int t = it - N_ADA;
      if (t < 896) tr_tile(wv, p.even_w_in, (bf16_t*)(p.ws + OFF_W0IN), 1024, 3584, 56, nullptr, t, lds);
      else if (t < 1152) tr_tile(wv, p.even_w_out, (bf16_t*)(p.ws + OFF_W0OUT), 1024, 1024, 16, nullptr, t - 896, lds);
      else if (t < 1536) tr_tile(wv, p.odd_w_in, (bf16_t*)(p.ws + OFF_W1IN), 1024, 1472, 24, nullptr, t - 1152, lds);
      else if (t < 1632) tr_tile(wv, p.c_wq_b, (bf16_t*)(p.ws + OFF_WQ), 256, 1536, 24, p.c_q_norm_w, t - 1536, lds);
      else if (t < 1696) tr_tile(wv, p.c_wkv_b, (bf16_t*)(p.ws + OFF_WKV), 128, 2048, 32, p.c_kv_norm_w, t - 1632, lds);
      else tr_tile(wv, p.odd_w_out, (bf16_t*)(p.ws + OFF_W1OUT), 1024, 1024, 16, nullptr, t - 1696, lds);
    } else if (it < N_ADA + N_TR + N_WS) {
      const int base = (it - N_ADA - N_TR) * 8192 + tid * 16;
      bf16_t* dst = (bf16_t*)(p.ws + OFF_WSB) + base; const float* s = p.a_ws + base;
#pragma unroll
      for (int q = 0; q < 2; ++q) {
        const f32x4 a = *reinterpret_cast<const f32x4*>(s + q * 8), b = *reinterpret_cast<const f32x4*>(s + q * 8 + 4);
        u32x4 w = {cvtpk(a[0], a[1]), cvtpk(a[2], a[3]), cvtpk(b[0], b[1]), cvtpk(b[2], b[3])};
        *reinterpret_cast<u32x4*>(dst + q * 8) = w;
      }
    } else {
      float2* tab = (float2*)(p.ws + OFF_ROPE);
      for (int e = tid; e < 1024; e += 512) {
        const int pos = e >> 4, j = e & 15;
        const float inv = exp2f(-(float)j * (13.287712379549449f / 16.f));
        const float ang = (float)pos * inv;
        const float nrev = rintf(ang * 0.15915494309189535f);
        float rr = fmaf(-nrev, 6.2831855f, ang); rr = fmaf(-nrev, -1.7484555e-7f, rr);
        tab[e] = make_float2(__cosf(rr), __sinf(rr));
      }
    }
    __syncthreads();
  }
}

template <bool RES>
DEVI void norm_mod(int wv, const float* src_lat, const float* src_ctx, const float* __restrict__ nw, const float* __restrict__ ada, bf16_t* X,
                   int row_lo, int row_hi, int vb, int nvb, const float* __restrict__ ada_prev = nullptr, float* hdst_lat = nullptr, float* hdst_ctx = nullptr) {
  const int tid_ = tidx(wv); const int wid = tid_ >> 6, lane = tid_ & 63;
  for (int row0 = row_lo + (vb * 8 + wid) * 2; row0 < row_hi; row0 += nvb * 16) {
    f32x4 v[2][4]; u32x2 ov[2][4]; float ss[2];
#pragma unroll
    for (int q = 0; q < 2; ++q) {
      const int row = row0 + q;
      const float* src = row < NLAT ? src_lat + (size_t)row * 1024 : src_ctx + (size_t)(row - NLAT) * 1024;
      ss[q] = 0.f;
#pragma unroll
      for (int i = 0; i < 4; ++i) {
        v[q][i] = *reinterpret_cast<const f32x4*>(src + i * 256 + lane * 4);
        if constexpr (RES) ov[q][i] = *reinterpret_cast<const u32x2*>(X + (size_t)row * 1024 + i * 256 + lane * 4);
      }
    }
    if constexpr (RES) {
#pragma unroll
      for (int q = 0; q < 2; ++q) {
        const int row = row0 + q;
        const float* gp = ada_prev + (row < NLAT ? (row >> 11) : 16) * 3072 + 2048;
        float* hd = row < NLAT ? hdst_lat + (size_t)row * 1024 : hdst_ctx + (size_t)(row - NLAT) * 1024;
#pragma unroll
        for (int i = 0; i < 4; ++i) {
          const int c = i * 256 + lane * 4;
          const f32x4 g = *reinterpret_cast<const f32x4*>(gp + c);
          v[q][i][0] += g[0] * bflo(ov[q][i][0]); v[q][i][1] += g[1] * bfhi(ov[q][i][0]); v[q][i][2] += g[2] * bflo(ov[q][i][1]); v[q][i][3] += g[3] * bfhi(ov[q][i][1]);
          *reinterpret_cast<f32x4*>(hd + c) = v[q][i];
        }
      }
    }
#pragma unroll
    for (int q = 0; q < 2; ++q) {
#pragma unroll
      for (int i = 0; i < 4; ++i) ss[q] += v[q][i][0] * v[q][i][0] + v[q][i][1] * v[q][i][1] + v[q][i][2] * v[q][i][2] + v[q][i][3] * v[q][i][3];
      ss[q] = wave_sum(ss[q]);
    }
#pragma unroll
    for (int q = 0; q < 2; ++q) {
      const int row = row0 + q;
      const float* ad = ada + (row < NLAT ? (row >> 11) : 16) * 3072;
      const float r = rsqrtf(ss[q] * (1.f / 1024.f) + 1e-6f);
#pragma unroll
      for (int i = 0; i < 4; ++i) {
        const int c = i * 256 + lane * 4;
        const f32x4 w = *reinterpret_cast<const f32x4*>(nw + c), sh = *reinterpret_cast<const f32x4*>(ad + c), scl = *reinterpret_cast<const f32x4*>(ad + 1024 + c);
        float o[4];
#pragma unroll
        for (int e = 0; e < 4; ++e) o[e] = v[q][i][e] * r * w[e] * (1.f + scl[e]) + sh[e];
        u32x2 pk = {cvtpk(o[0], o[1]), cvtpk(o[2], o[3])};
        *reinterpret_cast<u32x2*>(X + (size_t)row * 1024 + c) = pk;
      }
    }
  }
}

DEVI void final_norm(int wv, float* out, const float* __restrict__ fw, const bf16_t* __restrict__ O1, const float* __restrict__ ada1) {
  const int tid_ = tidx(wv); const int wid = tid_ >> 6, lane = tid_ & 63;
  for (int row0 = (blockIdx.x * 8 + wid) * 2; row0 < NLAT; row0 += gridDim.x * 16) {
    f32x4 v[2][4]; u32x2 ov[2][4]; float ss[2];
#pragma unroll
    for (int q = 0; q < 2; ++q) {
      ss[q] = 0.f;
#pragma unroll
      for (int i = 0; i < 4; ++i) {
        v[q][i] = *reinterpret_cast<const f32x4*>(out + (size_t)(row0 + q) * 1024 + i * 256 + lane * 4);
        ov[q][i] = *reinterpret_cast<const u32x2*>(O1 + (size_t)(row0 + q) * 1024 + i * 256 + lane * 4);
      }
    }
#pragma unroll
    for (int q = 0; q < 2; ++q) {
      const float* gp = ada1 + ((row0 + q) >> 11) * 3072 + 2048;
#pragma unroll
      for (int i = 0; i < 4; ++i) {
        const f32x4 g = *reinterpret_cast<const f32x4*>(gp + i * 256 + lane * 4);
        v[q][i][0] += g[0] * bflo(ov[q][i][0]); v[q][i][1] += g[1] * bfhi(ov[q][i][0]); v[q][i][2] += g[2] * bflo(ov[q][i][1]); v[q][i][3] += g[3] * bfhi(ov[q][i][1]);
        ss[q] += v[q][i][0] * v[q][i][0] + v[q][i][1] * v[q][i][1] + v[q][i][2] * v[q][i][2] + v[q][i][3] * v[q][i][3];
      }
      ss[q] = wave_sum(ss[q]);
    }
#pragma unroll
    for (int q = 0; q < 2; ++q) {
      const float r = rsqrtf(ss[q] * (1.f / 1024.f) + 1e-6f);
#pragma unroll
      for (int i = 0; i < 4; ++i) {
        const int c = i * 256 + lane * 4;
        const f32x4 w = *reinterpret_cast<const f32x4*>(fw + c);
        *reinterpret_cast<f32x4*>(out + (size_t)(row0 + q) * 1024 + c) = v[q][i] * r * w;
      }
    }
  }
}

typedef const __attribute__((address_space(4))) Params* KArgP;
DEVI void run_phase(int wv, KArgP pp, int ph, char* lds) {
#if defined(__HIP_DEVICE_COMPILE__)
  asm volatile("" : "+s"(pp));
  char* ws = pp->ws;
  const float2* rope = (const float2*)(ws + OFF_ROPE);
  const float* ada0 = (const float*)(ws + OFF_ADA); const float* ada1 = ada0 + 17 * 3072;
  bf16_t* X = (bf16_t*)(ws + OFF_X); bf16_t* MIX = (bf16_t*)(ws + OFF_MIX);
  const int G = gridDim.x, B = blockIdx.x;
  PG8_LAS unsigned char* ldsp = (PG8_LAS unsigned char*)lds;
  switch (ph) {
    case 0: { const Params p = *pp; phase0(wv, p, lds); } break;
    case 1: norm_mod<false>(wv, pp->x, pp->ctx, pp->norm_w, ada0, X, 0, NTOK, B, G); break;
    case 2: {
      EpiL0In epi{(bf16_t*)(ws + OFF_U), (bf16_t*)(ws + OFF_GV), (bf16_t*)(ws + OFF_ZA), (bf16_t*)(ws + OFF_ZB), (bf16_t*)(ws + OFF_Q0), (bf16_t*)(ws + OFF_K0), (bf16_t*)(ws + OFF_V0), rope};
      gemm_phase(wv, ldsp, X, (const bf16_t*)(ws + OFF_W0IN), 1024, Sched{14, 144 * 14, 144 * 14, 0, 0}, epi);
    } break;
    case 3: { const Params p = *pp;
      for (int it = B; it < 1024 + 288 + 128; it += G) {
        if (it < 1024) {
          const int xcd = it & 7, slot = (it >> 3) & 31, rd = it >> 8;
          const int bh = rd * 16 + xcd * 2 + (slot >> 4), qb = slot & 15, b = bh >> 2, h = bh & 3;
          attn0_item(wv, p, b * 2048 + qb * 128, b, h, KVL, lds);
        } else if (it < 1024 + 288) abranch_item(wv, p, it - 1024, lds);
        else { const int i2 = it - 1312; const int b = i2 >> 3, h = (i2 >> 1) & 3, qb = i2 & 1; attn0_item(wv, p, NLAT + b * 256 + qb * 128, b, h, 256, lds); }
      }
    } break;
    case 4: {
      EpiPlain epi{X};
      gemm_phase(wv, ldsp, MIX, (const bf16_t*)(ws + OFF_W0OUT), 1024, Sched{4, 144 * 4, 144 * 4, 0, 0}, epi);
    } break;
    case 5: {
      if (B >= G - 16) {
        const int cp = B - (G - 16);
        norm_mod<true>(wv, pp->x, pp->ctx, pp->norm_w + 1024, ada1, X, NLAT + cp * 256, NLAT + cp * 256 + 256, 0, 1, ada0, pp->out, (float*)(ws + OFF_H1C));
        asm volatile("s_waitcnt vmcnt(0)" ::: "memory"); __syncthreads();
        EpiL1In epi{(bf16_t*)(ws + OFF_CQ), (bf16_t*)(ws + OFF_CKV), (bf16_t*)(ws + OFF_K1), (bf16_t*)(ws + OFF_Z1), (float*)(ws + OFF_RQ), (float*)(ws + OFF_RKV), rope, (float*)(lds + LDS_SS)};
        gemm_phase(wv, ldsp, X, (const bf16_t*)(ws + OFF_W1IN), 1024, Sched{6, 0, 16, 128, 1, G - 16}, epi);
      } else norm_mod<true>(wv, pp->x, pp->ctx, pp->norm_w + 1024, ada1, X, 0, NLAT, B, G - 16, ada0, pp->out, (float*)(ws + OFF_H1C));
    } break;
    case 6: {
      EpiL1In epi{(bf16_t*)(ws + OFF_CQ), (bf16_t*)(ws + OFF_CKV), (bf16_t*)(ws + OFF_K1), (bf16_t*)(ws + OFF_Z1), (float*)(ws + OFF_RQ), (float*)(ws + OFF_RKV), rope, (float*)(lds + LDS_SS)};
      gemm_phase(wv, ldsp, X, (const bf16_t*)(ws + OFF_W1IN), 1024, Sched{6, 768, 768, 128, 1}, epi);
    } break;
    case 7: {
      EpiQ eq{(bf16_t*)(ws + OFF_Q1), (const float*)(ws + OFF_RQ), rope};
      EpiKV ek{(bf16_t*)(ws + OFF_K1), (bf16_t*)(ws + OFF_V1), (const float*)(ws + OFF_RKV)};
      gemm_phase(wv, ldsp, (const bf16_t*)(ws + OFF_CQ), (const bf16_t*)(ws + OFF_WQ), 256, Sched{6, 768, 768, 0, 0}, eq);
      gemm_phase(wv, ldsp, (const bf16_t*)(ws + OFF_CKV), (const bf16_t*)(ws + OFF_WKV), 128, Sched{8, 1152, 1152, 0, 0}, ek);
    } break;
    case 8: { const Params p = *pp;
      for (int it = B; it < 1024; it += G) {
        const int xcd = it & 7, slot = (it >> 3) & 31, rd = it >> 8;
        const int bh = rd * 32 + xcd * 4 + (slot >> 3), qb = slot & 7;
        attn1_item(wv, p, bh >> 3, bh & 7, qb, lds);
      }
    } break;
    case 9: {
      EpiPlain epi{X};
      gemm_phase(wv, ldsp, MIX, (const bf16_t*)(ws + OFF_W1OUT), 1024, Sched{4, 128 * 4, 128 * 4, 0, 0}, epi);
    } break;
    case 10: final_norm(wv, pp->out, pp->final_w, X, ada1); break;
  }
#endif
}


#define XB_TMO      128
#define XB_XCNT(j)  (256  + 64 * (j))
#define XB_XSUB(j)  (1280 + 64 * (j))
#define XB_XGEN(j)  (2304 + 64 * (j))
#define XB_TOP      3328
#define XB_TOPGEN   3392
#define XCD_BAR_WORDS 3456
#define XB_SPIN_CAP (1u << 18)
#define LAS __attribute__((address_space(3)))
DEVI unsigned xb_ld(unsigned* p) { return __hip_atomic_load(p, __ATOMIC_RELAXED, __HIP_MEMORY_SCOPE_AGENT); }
DEVI unsigned xb_add(unsigned* p, unsigned v) { return __hip_atomic_fetch_add(p, v, __ATOMIC_RELAXED, __HIP_MEMORY_SCOPE_AGENT); }
DEVI unsigned xb_xcc_id() { return (unsigned)__builtin_amdgcn_s_getreg((3 << 11) | 20) & 0xFu; }
#define XB_SPIN(cond, bar) do { unsigned _sp = 0; while (cond) { __builtin_amdgcn_s_sleep(1); \
    if ((++_sp & 255u) == 0u) { if (xb_ld(&(bar)[XB_TMO])) break; if (_sp > XB_SPIN_CAP) { atomicAdd(&(bar)[XB_TMO], 1u); break; } } } } while (0)
struct XcdBarrier { unsigned* bar; unsigned x; volatile LAS unsigned* st; };
DEVI XcdBarrier xcd_barrier_post(int wv, unsigned* bar, volatile LAS unsigned* st) {
  XcdBarrier b; b.bar = bar; b.x = xb_xcc_id(); b.st = st;
  if (tidx(wv) == 0) (void)xb_add(&bar[XB_XCNT(b.x)], 1u);
  return b;
}
DEVI void xcd_barrier_complete(unsigned* bar, unsigned x, unsigned& nloc, unsigned& nx) {
  const unsigned G = gridDim.x * gridDim.y * gridDim.z;
  unsigned sum, cnt, mine, sp = 0u;
  for (;;) {
    sum = 0u; cnt = 0u; mine = 0u;
#pragma unroll
    for (unsigned j = 0; j < 16; ++j) { const unsigned c = xb_ld(&bar[XB_XCNT(j)]); sum += c; cnt += (c > 0u) ? 1u : 0u; mine = (j == x) ? c : mine; }
    if (sum == G) break;
    __builtin_amdgcn_s_sleep(1);
    if ((++sp & 255u) == 0u) { if (xb_ld(&bar[XB_TMO])) break; if (sp > XB_SPIN_CAP) { atomicAdd(&bar[XB_TMO], 1u); break; } }
  }
  nloc = mine > 0u ? mine : 1u; nx = cnt > 0u ? cnt : 1u;
}
DEVI void xcd_barrier(int wv, const XcdBarrier& b) {
  asm volatile("s_waitcnt vmcnt(0)" ::: "memory");
  __syncthreads();
  if (tidx(wv) == 0) {
    unsigned* bar = b.bar;
    __builtin_amdgcn_s_waitcnt(0);
    unsigned nloc = b.st[0], nx = b.st[1];
    if (nloc == 0u) { xcd_barrier_complete(bar, b.x, nloc, nx); b.st[0] = nloc; b.st[1] = nx; }
    const unsigned old = xb_add(&bar[XB_XSUB(b.x)], 1u);
    const unsigned gen = old / nloc;
    if (old + 1u == (gen + 1u) * nloc) {
      __builtin_amdgcn_fence(__ATOMIC_RELEASE, "agent");
      asm volatile("s_waitcnt vmcnt(0)" ::: "memory");
      const unsigned og = xb_add(&bar[XB_TOP], 1u);
      const unsigned tg = og / nx;
      if (og + 1u == (tg + 1u) * nx) xb_add(&bar[XB_TOPGEN], 1u);
      else XB_SPIN(xb_ld(&bar[XB_TOPGEN]) == tg, bar);
      __builtin_amdgcn_fence(__ATOMIC_ACQUIRE, "agent");
      xb_add(&bar[XB_XGEN(b.x)], 1u);
      asm volatile("s_waitcnt vmcnt(0)" ::: "memory");
    } else {
      XB_SPIN(xb_ld(&bar[XB_XGEN(b.x)]) == gen, bar);
      __builtin_amdgcn_fence(__ATOMIC_ACQUIRE, "agent");
      asm volatile("s_waitcnt vmcnt(0)" ::: "memory");
    }
  }
  __syncthreads();
}

extern __shared__ __attribute__((aligned(16))) char g_lds[];

constexpr int LDS_XB = 143360;
__global__ void __launch_bounds__(512) mega(Params p) {
  cg::grid_group grid = cg::this_grid();
  if (p.ph_hi > 64) grid.sync();
  const int wv = __builtin_amdgcn_readfirstlane((int)threadIdx.x >> 6);
  volatile LAS unsigned* xst = (volatile LAS unsigned*)(g_lds + LDS_XB);
  if (tidx(wv) == 0) { xst[0] = 0u; xst[1] = 0u; }
  __syncthreads();
  (void)xcd_barrier_post(wv, (unsigned*)(p.ws + OFF_BAR), xst);
#define GRID_BARRIER() do { KArgP _pp = (KArgP)__builtin_amdgcn_kernarg_segment_ptr(); asm volatile("" : "+s"(_pp)); \
    XcdBarrier _xb; _xb.bar = (unsigned*)(_pp->ws + OFF_BAR); _xb.x = xb_xcc_id(); _xb.st = (volatile LAS unsigned*)(g_lds + LDS_XB); xcd_barrier(wv, _xb); } while (0)
  for (int ph = p.ph_lo; ph < p.ph_hi; ++ph) {
    run_phase(wv, (KArgP)__builtin_amdgcn_kernarg_segment_ptr(), ph, g_lds);
#ifdef PROBE_PH
    if (ph == PROBE_PH) { GRID_BARRIER(); run_phase(wv, (KArgP)__builtin_amdgcn_kernarg_segment_ptr(), ph, g_lds); }
#endif
    if (ph + 1 < p.ph_hi) GRID_BARRIER();
  }
}

extern "C" void kernel_launch(void* const* d_in, const int* in_sizes, int n_in, void* d_out, int out_size, void* d_ws, size_t ws_size, hipStream_t stream) {
  static int ok = 0;
  static int grid_blocks = 0;
  if (!ok) {
    if (n_in != 25 || ws_size < WS_NEED) { fprintf(stderr, "kernel_launch: bad args n_in %d ws %zu need %zu\n", n_in, ws_size, (size_t)WS_NEED); return; }
    if (hipFuncSetAttribute((const void*)mega, hipFuncAttributeMaxDynamicSharedMemorySize, LDS_BYTES) != hipSuccess) { fprintf(stderr, "kernel_launch: LDS attr failed\n"); return; }
    int dev = 0, cus = 0, per_cu = 0;
    hipGetDevice(&dev);
    hipDeviceGetAttribute(&cus, hipDeviceAttributeMultiprocessorCount, dev);
    hipOccupancyMaxActiveBlocksPerMultiprocessor(&per_cu, mega, 512, LDS_BYTES);
    if (per_cu < 1) per_cu = 1;
    grid_blocks = cus * per_cu;
    ok = 1;
  }
  Params p{};
  const float** pp = (const float**)&p;
  for (int i = 0; i < 25; ++i) pp[i] = (const float*)d_in[i];
  p.out = (float*)d_out; p.ws = (char*)d_ws;
#if ONE_LAUNCH
  p.ph_lo = 0; p.ph_hi = 11;
  hipMemsetAsync((char*)d_ws + OFF_BAR, 0, XCD_BAR_WORDS * 4, stream);
  void* args[] = {&p};
  hipError_t e = hipLaunchCooperativeKernel((const void*)mega, dim3(grid_blocks), dim3(512), args, LDS_BYTES, stream);
  if (e != hipSuccess) fprintf(stderr, "cooperative launch failed: %s (grid %d)\n", hipGetErrorString(e), grid_blocks);
#else
  for (int ph = 0; ph < 11; ++ph) {
    p.ph_lo = ph; p.ph_hi = ph + 1;
    hipLaunchKernelGGL(mega, dim3(grid_blocks), dim3(512), LDS_BYTES, stream, p);
  }
#endif
}
```

```cpp
#include <hip/hip_runtime.h>
#include <hip/hip_cooperative_groups.h>
#include <cstdio>
namespace cg = cooperative_groups;

#ifndef ATT_SD0
#define ATT_SD0 2
#endif
#ifndef ONE_LAUNCH
#define ONE_LAUNCH 1
#endif

typedef unsigned short bf16_t;
typedef short bf16x8 __attribute__((ext_vector_type(8)));
typedef short s16x4 __attribute__((ext_vector_type(4)));
typedef float f32x16 __attribute__((ext_vector_type(16)));
typedef float f32x4 __attribute__((ext_vector_type(4)));
typedef unsigned u32x4 __attribute__((ext_vector_type(4)));
typedef unsigned u32x2 __attribute__((ext_vector_type(2)));
#define DEVI __device__ __forceinline__
#define SBAR() __builtin_amdgcn_sched_barrier(0)
DEVI int tidx(int wv) { int l; asm volatile("v_mbcnt_lo_u32_b32 %0, -1, 0\n\tv_mbcnt_hi_u32_b32 %0, -1, %0" : "=v"(l)); return (wv << 6) | l; }

constexpr int NLAT = 32768, NCTX = 4096, NTOK = 36864, KVL = 2304;
constexpr int LDS_BYTES = 147456, LDS_SS = 139264;

constexpr size_t OFF_W0IN = 0;
constexpr size_t OFF_W0OUT = OFF_W0IN + 3584ull * 1024 * 2;
constexpr size_t OFF_W1IN = OFF_W0OUT + 1024ull * 1024 * 2;
constexpr size_t OFF_WQ = OFF_W1IN + 1536ull * 1024 * 2;
constexpr size_t OFF_WKV = OFF_WQ + 1536ull * 256 * 2;
constexpr size_t OFF_W1OUT = OFF_WKV + 2048ull * 128 * 2;
constexpr size_t OFF_WSB = OFF_W1OUT + 1024ull * 1024 * 2;
constexpr size_t OFF_ADA = OFF_WSB + 8ull * 128 * 128 * 2;
constexpr size_t OFF_ROPE = OFF_ADA + 2ull * 17 * 3072 * 4;
constexpr size_t OFF_BAR = OFF_ROPE + 64ull * 16 * 8;
constexpr size_t OFF_H1C = OFF_BAR + 16384;
constexpr size_t OFF_RQ = OFF_H1C + 4096ull * 1024 * 4;
constexpr size_t OFF_RKV = OFF_RQ + 32768ull * 4;
constexpr size_t OFF_X = OFF_RKV + 36864ull * 4;
constexpr size_t OFF_MIX = OFF_X + 36864ull * 1024 * 2;
constexpr size_t OFF_T = OFF_MIX + 36864ull * 1024 * 2;
constexpr size_t SZ_HALF = 36864ull * 512 * 2;
constexpr size_t OFF_U = OFF_T, OFF_GV = OFF_U + SZ_HALF, OFF_ZA = OFF_GV + SZ_HALF, OFF_ZB = OFF_ZA + SZ_HALF, OFF_Q0 = OFF_ZB + SZ_HALF;
constexpr size_t OFF_K0 = OFF_Q0 + SZ_HALF, OFF_V0 = OFF_K0 + 16ull * 4 * KVL * 128 * 2, END_L0 = OFF_V0 + 16ull * 4 * KVL * 128 * 2;
constexpr size_t OFF_CQ = OFF_T, OFF_CKV = OFF_CQ + 32768ull * 256 * 2, OFF_Z1 = OFF_CKV + 36864ull * 128 * 2;
constexpr size_t OFF_Q1 = OFF_Z1 + 32768ull * 1024 * 2, OFF_K1 = OFF_Q1 + 32768ull * 1536 * 2, END_L1 = OFF_K1 + 16ull * 8 * KVL * 192 * 2;
constexpr size_t OFF_V1 = OFF_X;
constexpr size_t WS_NEED = END_L1 > END_L0 ? END_L1 : END_L0;

struct Params {
  const float *x, *c, *ctx, *c_ctx, *norm_w, *ada_w, *ada_b, *even_w_in, *a_ws, *a_bs, *a_ln_w, *a_ln_b,
      *b_lq1, *b_lk1, *b_lq2, *b_lk2, *b_subln_w, *even_w_out, *odd_w_in, *c_q_norm_w, *c_wq_b,
      *c_kv_norm_w, *c_wkv_b, *odd_w_out, *final_w;
  float* out; char* ws; int ph_lo, ph_hi;
};

DEVI unsigned cvtpk(float lo, float hi) { unsigned r; asm("v_cvt_pk_bf16_f32 %0, %1, %2" : "=v"(r) : "v"(lo), "v"(hi)); return r; }
DEVI bf16_t f2bf(float v) { return (bf16_t)(cvtpk(v, 0.f) & 0xffffu); }
DEVI float bf2f(bf16_t v) { return __uint_as_float(((unsigned)v) << 16); }
DEVI float bflo(unsigned w) { return __uint_as_float(w << 16); }
DEVI float bfhi(unsigned w) { return __uint_as_float(w & 0xffff0000u); }
DEVI int crow(int r, int hi) { return (r & 3) + 8 * (r >> 2) + 4 * hi; }
DEVI float silu_f(float x) { return x * __builtin_amdgcn_rcpf(1.f + __builtin_amdgcn_exp2f(x * -1.4426950408889634f)); }
DEVI float gelu_f(float v) {
  const float t = __builtin_amdgcn_rcpf(fmaf(fabsf(v), 0.2316418882f, 1.0f));
  float q = fmaf(t, 0.5307027145f, -0.7265760135f); q = fmaf(q, t, 0.7107068705f); q = fmaf(q, t, -0.142248368f); q = fmaf(q, t, 0.127414796f); q *= t;
  const float m = v * (q * __builtin_amdgcn_exp2f(v * v * -0.72134752044f));
  return v < 0.f ? m : v - m;
}

template <int M> DEVI float xsum(float v) {
  if constexpr (M == 32) { auto rr = __builtin_amdgcn_permlane32_swap(__float_as_uint(v), __float_as_uint(v), false, false); return __uint_as_float(rr[0]) + __uint_as_float(rr[1]); }
  else return v + __int_as_float(__builtin_amdgcn_ds_swizzle(__float_as_int(v), (M << 10) | 0x1f));
}
DEVI float wave_sum(float v) { v = xsum<1>(v); v = xsum<2>(v); v = xsum<4>(v); v = xsum<8>(v); v = xsum<16>(v); return xsum<32>(v); }

DEVI void rope_tile(f32x16& v, const float2* __restrict__ tab, int pos, int hi) {
#pragma unroll
  for (int r = 0; r < 8; ++r) {
    const int jf = (r & 3) + 8 * (r >> 2) + 4 * hi;
    const float2 cs = tab[pos * 16 + jf];
    const float a = v[r], b = v[r + 8];
    v[r] = a * cs.x - b * cs.y; v[r + 8] = b * cs.x + a * cs.y;
  }
}
DEVI void store4(bf16_t* dst, const f32x16& v, int rg) {
  u32x2 pk = {cvtpk(v[rg * 4 + 0], v[rg * 4 + 1]), cvtpk(v[rg * 4 + 2], v[rg * 4 + 3])};
  *reinterpret_cast<u32x2*>(dst) = pk;
}

#define PG8_LAS __attribute__((address_space(3)))
constexpr int HTB = 128 * 64 * 2;
DEVI int lds_byte(int r, int c) { const int st = (r >> 4) * 2 + (c >> 5), rr = r & 15, cc = c & 31, ob = rr * 64 + cc * 2; return st * 1024 + (ob ^ (((ob >> 9) & 1) << 5)); }
DEVI void stage_rc(int b, int& R, int& C) { const int st = b / 1024, sb = b % 1024, swz = sb ^ (((sb >> 9) & 1) << 5); R = (st >> 1) * 16 + swz / 64; C = (st & 1) * 32 + (swz % 64) / 2; }
DEVI int perm32(int rho) { const int n = rho >> 4, i = rho & 15; return 8 * (i >> 2) + 4 * n + (i & 3); }
struct Unit { int pm, pn; };
struct Sched {
  int nN, nmain, ntotal, xpm0, xpn, boff = 0;
  DEVI bool next(int i, Unit& u) const {
    const int it = (int)blockIdx.x - boff + i * (int)gridDim.x; if (it < 0 || it >= ntotal) return false;
    if (it < nmain) { const int xcd = it & 7, jx = it >> 3; u.pm = (jx / nN) * 8 + xcd; u.pn = jx % nN; } else { u.pm = xpm0 + (it - nmain); u.pn = xpn; }
    return true;
  }
};
template <class Epi>
DEVI void gemm_phase(int wv, PG8_LAS unsigned char* lds, const bf16_t* gA, const bf16_t* gBt, const int K, const Sched& S, const Epi& E) {
  const int tid = tidx(wv), wid = __builtin_amdgcn_readfirstlane(tid >> 6), lane = tid & 63, wr = wid >> 2, wc = wid & 3, fr = lane & 15, fq = lane >> 4;
  const int nt = K / 64;
  unsigned voffA[2], voffB[2];
#pragma unroll
  for (int i = 0; i < 2; ++i) { int R, C; stage_rc(tid * 16 + i * 8192, R, C); const int Rb = (R & ~31) + perm32(R & 31); voffA[i] = (unsigned)(R * K + C) * 2u; voffB[i] = (unsigned)(Rb * K + C) * 2u; }
  const size_t kstep = (size_t)(64 * 2);
  const size_t hstep = (size_t)128 * K * 2;
  const size_t tstep = 2 * hstep;
  const unsigned ldsw = (unsigned)wid * 1024u;
  const int aoff = lds_byte(wr * 64 + fr, fq * 8), boff = lds_byte(wc * 32 + fr, fq * 8);
#define PG8_SA(b, h) (((b) * 2 + (h)) * HTB)
#define PG8_SB(b, h) ((4 + (b) * 2 + (h)) * HTB)
#define PG8_STAGE(bufoff, gbase, voff) do { _Pragma("unroll") for (int _i = 0; _i < 2; ++_i) \
    __builtin_amdgcn_global_load_lds((const unsigned*)((const char*)(gbase) + (voff)[_i]), (PG8_LAS unsigned*)(lds + (bufoff) + ldsw + _i * 8192), 16, 0, 0); } while (0)
#define PG8_LDA(dst, b, h) do { _Pragma("unroll") for (int m = 0; m < 4; ++m) _Pragma("unroll") for (int k = 0; k < 2; ++k) dst[m][k] = *(const PG8_LAS bf16x8*)(lds + PG8_SA(b, h) + aoff + m * 2048 + k * 1024); } while (0)
#define PG8_LDB(dst, b, h) do { _Pragma("unroll") for (int n = 0; n < 2; ++n) _Pragma("unroll") for (int k = 0; k < 2; ++k) dst[n][k] = *(const PG8_LAS bf16x8*)(lds + PG8_SB(b, h) + boff + n * 2048 + k * 1024); } while (0)
#define PG8_MMA(ai, bj, At, Bt) do { __builtin_amdgcn_s_setprio(1); _Pragma("unroll") for (int m = 0; m < 4; ++m) _Pragma("unroll") for (int n = 0; n < 2; ++n) _Pragma("unroll") for (int k = 0; k < 2; ++k) \
    acc[ai][bj][m][n] = __builtin_amdgcn_mfma_f32_16x16x32_bf16(Bt[n][k], At[m][k], acc[ai][bj][m][n], 0, 0, 0); __builtin_amdgcn_s_setprio(0); } while (0)
#define PG8_WAIT_V(n) asm volatile("s_waitcnt vmcnt(" #n ")" ::: "memory")
#define PG8_WAIT_L(n) asm volatile("s_waitcnt lgkmcnt(" #n ")" ::: "memory")
#define PG8_BAR __builtin_amdgcn_s_barrier()
#define PG8_SCHED __builtin_amdgcn_sched_barrier(0)
  Unit cur, nxt; int ui = 0;
  if (!S.next(0, cur)) return;
  f32x4 acc[2][2][4][2];
#pragma unroll
  for (int a = 0; a < 2; ++a)
#pragma unroll
    for (int b = 0; b < 2; ++b)
#pragma unroll
      for (int m = 0; m < 4; ++m)
#pragma unroll
        for (int n = 0; n < 2; ++n) acc[a][b][m][n] = (f32x4){0.f, 0.f, 0.f, 0.f};
  bf16x8 At[4][2], B0[2][2], B1[2][2];
  const char* cA = (const char*)gA + (size_t)cur.pm * tstep; const char* cB = (const char*)gBt + (size_t)cur.pn * tstep;
  PG8_STAGE(PG8_SB(0, 0), cB, voffB); PG8_STAGE(PG8_SA(0, 0), cA, voffA); PG8_STAGE(PG8_SB(0, 1), cB + hstep, voffB); PG8_STAGE(PG8_SA(0, 1), cA + hstep, voffA);
  if (wr == 1) PG8_BAR;
  PG8_WAIT_V(4); PG8_BAR;
  PG8_STAGE(PG8_SB(1, 0), cB + kstep, voffB); PG8_STAGE(PG8_SA(1, 0), cA + kstep, voffA); PG8_STAGE(PG8_SB(1, 1), cB + hstep + kstep, voffB);
  PG8_WAIT_V(6); PG8_BAR;
  for (;;) {
    const bool has_next = S.next(ui + 1, nxt);
    const char* nA = has_next ? (const char*)gA + (size_t)nxt.pm * tstep : cA; const char* nB = has_next ? (const char*)gBt + (size_t)nxt.pn * tstep : cB;
#pragma unroll 1
    for (int t = 0; t < nt; t += 2) {
      const bool last = (t == nt - 2);
      const char* a1 = cA + (size_t)(t + 1) * kstep;
      const char* a2 = last ? nA : cA + (size_t)(t + 2) * kstep; const char* b2 = last ? nB : cB + (size_t)(t + 2) * kstep;
      const char* a3 = a2 + kstep; const char* b3 = b2 + kstep;
      PG8_LDB(B0, 0, 0); PG8_SCHED; PG8_LDA(At, 0, 0); PG8_STAGE(PG8_SA(1, 1), a1 + hstep, voffA);
      PG8_WAIT_L(8); PG8_BAR; PG8_WAIT_L(0); PG8_MMA(0, 0, At, B0); PG8_BAR; PG8_SCHED;
      PG8_LDB(B1, 0, 1); PG8_STAGE(PG8_SB(0, 0), b2, voffB);
      PG8_BAR; PG8_WAIT_L(0); PG8_MMA(0, 1, At, B1); PG8_BAR;
      PG8_LDA(At, 0, 1); PG8_STAGE(PG8_SA(0, 0), a2, voffA);
      PG8_BAR; PG8_WAIT_L(0); PG8_MMA(1, 0, At, B0); PG8_BAR; PG8_SCHED;
      PG8_STAGE(PG8_SB(0, 1), b2 + hstep, voffB);
      PG8_WAIT_V(6); PG8_BAR; PG8_MMA(1, 1, At, B1); PG8_BAR;
      PG8_LDB(B0, 1, 0); PG8_SCHED; PG8_LDA(At, 1, 0); PG8_STAGE(PG8_SA(0, 1), a2 + hstep, voffA);
      PG8_WAIT_L(8); PG8_BAR; PG8_WAIT_L(0); PG8_MMA(0, 0, At, B0); PG8_BAR; PG8_SCHED;
      PG8_LDB(B1, 1, 1); PG8_STAGE(PG8_SB(1, 0), b3, voffB);
      PG8_BAR; PG8_WAIT_L(0); PG8_MMA(0, 1, At, B1); PG8_BAR;
      PG8_LDA(At, 1, 1); PG8_STAGE(PG8_SA(1, 0), a3, voffA);
      PG8_BAR; PG8_WAIT_L(0); PG8_MMA(1, 0, At, B0); PG8_BAR; PG8_SCHED;
      PG8_STAGE(PG8_SB(1, 1), b3 + hstep, voffB);
      PG8_WAIT_V(6); PG8_BAR; PG8_MMA(1, 1, At, B1); PG8_BAR;
    }
    E(acc, cur, wr, wc, fr, fq);
    if (!has_next) break;
#pragma unroll
    for (int a = 0; a < 2; ++a)
#pragma unroll
      for (int b = 0; b < 2; ++b)
#pragma unroll
        for (int m = 0; m < 4; ++m)
#pragma unroll
          for (int n = 0; n < 2; ++n) acc[a][b][m][n] = (f32x4){0.f, 0.f, 0.f, 0.f};
    cur = nxt; cA = nA; cB = nB; ++ui;
  }
  PG8_WAIT_V(0);
  if (wr == 0) PG8_BAR;
  PG8_BAR;
#undef PG8_SA
#undef PG8_SB
#undef PG8_STAGE
#undef PG8_LDA
#undef PG8_LDB
#undef PG8_MMA
#undef PG8_WAIT_V
#undef PG8_WAIT_L
#undef PG8_BAR
#undef PG8_SCHED
}

typedef f32x4 acc_t[2][2][4][2];
DEVI void token_info(int token, bool ctx, int& b, int& s, int& key) {
  if (!ctx) { b = token >> 11; s = token & 2047; key = 256 + s; } else { const int tc = token - NLAT; b = tc >> 8; s = 0; key = tc & 255; }
}
DEVI float swap32_partner(float v, bool upper) {
  auto rr = __builtin_amdgcn_permlane32_swap(__float_as_uint(v), __float_as_uint(v), false, false);
  return __uint_as_float(upper ? rr[0] : rr[1]);
}
DEVI void rope_pair(f32x4& v0, f32x4& v1, const float2* __restrict__ tab, int pos, int fq) {
  const bool upper = fq >= 2;
  const float2* t = tab + pos * 16 + (fq & 1) * 8;
  const f32x4 t0 = *reinterpret_cast<const f32x4*>(t), t1 = *reinterpret_cast<const f32x4*>(t + 2), t2 = *reinterpret_cast<const f32x4*>(t + 4), t3 = *reinterpret_cast<const f32x4*>(t + 6);
  const float cs[8] = {t0[0], t0[2], t1[0], t1[2], t2[0], t2[2], t3[0], t3[2]}, sn[8] = {t0[1], t0[3], t1[1], t1[3], t2[1], t2[3], t3[1], t3[3]};
#pragma unroll
  for (int e = 0; e < 4; ++e) {
    const float p0 = swap32_partner(v0[e], upper), p1 = swap32_partner(v1[e], upper);
    const float s0 = upper ? sn[e] : -sn[e], s1 = upper ? sn[4 + e] : -sn[4 + e];
    v0[e] = v0[e] * cs[e] + p0 * s0; v1[e] = v1[e] * cs[4 + e] + p1 * s1;
  }
}
DEVI void st8(bf16_t* dst, const f32x4& v0, const f32x4& v1) { u32x4 pk = {cvtpk(v0[0], v0[1]), cvtpk(v0[2], v0[3]), cvtpk(v1[0], v1[1]), cvtpk(v1[2], v1[3])}; *reinterpret_cast<u32x4*>(dst) = pk; }

struct EpiL0In {
  bf16_t *U, *GV, *ZA, *ZB, *Q0, *K0, *V0; const float2* rope;
  DEVI void operator()(acc_t& acc, const Unit& u, int wr, int wc, int fr, int fq) const {
    const int col0 = u.pn * 256, type = col0 >> 9; const bool ctx = u.pm >= 128;
#pragma unroll
    for (int ai = 0; ai < 2; ++ai)
#pragma unroll
      for (int m = 0; m < 4; ++m) {
        const int token = u.pm * 256 + ai * 128 + wr * 64 + m * 16 + fr;
        int b, s, key; token_info(token, ctx, b, s, key);
#pragma unroll
        for (int bj = 0; bj < 2; ++bj) {
          const int nl = (col0 & 511) + bj * 128 + wc * 32;
          f32x4 v0 = acc[ai][bj][m][0], v1 = acc[ai][bj][m][1];
          bf16_t* dst;
          if (type <= 1) {
#pragma unroll
            for (int e = 0; e < 4; ++e) { v0[e] = gelu_f(v0[e]); v1[e] = gelu_f(v1[e]); }
            dst = (type == 0 ? U : GV) + (size_t)token * 512 + nl;
          } else if (type == 2 || type == 6) {
#pragma unroll
            for (int e = 0; e < 4; ++e) { v0[e] = silu_f(v0[e]); v1[e] = silu_f(v1[e]); }
            dst = (type == 2 ? ZA : ZB) + (size_t)token * 512 + nl;
          } else if (type == 3) {
            if (!ctx) rope_pair(v0, v1, rope, (wc & 1) ? (s & 63) : (s >> 6), fq);
            dst = Q0 + (size_t)token * 512 + nl;
          } else if (type == 4) {
            if (!ctx) rope_pair(v0, v1, rope, (wc & 1) ? (s & 63) : (s >> 6), fq);
            dst = K0 + ((size_t)(b * 4 + (nl >> 7)) * KVL + key) * 128 + (nl & 127);
          } else {
            dst = V0 + ((size_t)(b * 4 + (nl >> 7)) * KVL + key) * 128 + (nl & 127);
          }
          st8(dst + fq * 8, v0, v1);
        }
      }
  }
};

template <bool HASCTX> struct EpiOut {
  const float* src_lat; const float* src_ctx; float* dst_lat; float* dst_ctx; const float* ada;
  DEVI void operator()(acc_t& acc, const Unit& u, int wr, int wc, int fr, int fq) const {
    const int col0 = u.pn * 256;
#pragma unroll
    for (int ai = 0; ai < 2; ++ai)
#pragma unroll
      for (int m = 0; m < 4; ++m) {
        const int token = u.pm * 256 + ai * 128 + wr * 64 + m * 16 + fr;
        const float* src; float* dst; const float* gate;
        if (!HASCTX || token < NLAT) { src = src_lat + (size_t)token * 1024; dst = dst_lat + (size_t)token * 1024; gate = ada + (token >> 11) * 3072 + 2048; }
        else { const int tc = token - NLAT; src = src_ctx + (size_t)tc * 1024; dst = dst_ctx + (size_t)tc * 1024; gate = ada + 16 * 3072 + 2048; }
#pragma unroll
        for (int bj = 0; bj < 2; ++bj)
#pragma unroll
          for (int n = 0; n < 2; ++n) {
            const int c = col0 + bj * 128 + wc * 32 + fq * 8 + n * 4;
            const f32x4 xv = *reinterpret_cast<const f32x4*>(src + c), g = *reinterpret_cast<const f32x4*>(gate + c);
            *reinterpret_cast<f32x4*>(dst + c) = xv + g * acc[ai][bj][m][n];
          }
      }
  }
};

struct EpiPlain {
  bf16_t* O;
  DEVI void operator()(acc_t& acc, const Unit& u, int wr, int wc, int fr, int fq) const {
    const int col0 = u.pn * 256;
#pragma unroll
    for (int ai = 0; ai < 2; ++ai)
#pragma unroll
      for (int m = 0; m < 4; ++m) {
        const int token = u.pm * 256 + ai * 128 + wr * 64 + m * 16 + fr;
#pragma unroll
        for (int bj = 0; bj < 2; ++bj) st8(O + (size_t)token * 1024 + col0 + bj * 128 + wc * 32 + fq * 8, acc[ai][bj][m][0], acc[ai][bj][m][1]);
      }
  }
};

struct EpiL1In {
  bf16_t *CQ, *CKV, *K1, *Z1; float *RQ, *RKV; const float2* rope; float* ssb;
  DEVI void operator()(acc_t& acc, const Unit& u, int wr, int wc, int fr, int fq) const {
    const int col0 = u.pn * 256; const bool ctx = u.pm >= 128;
    float ss[2][4];
#pragma unroll
    for (int ai = 0; ai < 2; ++ai)
#pragma unroll
      for (int m = 0; m < 4; ++m) {
        ss[ai][m] = 0.f;
        const int token = u.pm * 256 + ai * 128 + wr * 64 + m * 16 + fr;
        int b, s, key; token_info(token, ctx, b, s, key);
#pragma unroll
        for (int bj = 0; bj < 2; ++bj) {
          const int nb = col0 + bj * 128 + wc * 32;
          f32x4 v0 = acc[ai][bj][m][0], v1 = acc[ai][bj][m][1];
          if (nb < 384) {
#pragma unroll
            for (int e = 0; e < 4; ++e) ss[ai][m] += v0[e] * v0[e] + v1[e] * v1[e];
            bf16_t* dst = nb < 256 ? CQ + (size_t)token * 256 + nb : CKV + (size_t)token * 128 + (nb - 256);
            st8(dst + fq * 8, v0, v1);
          } else if (nb < 448) {
            if (!ctx) rope_pair(v0, v1, rope, (nb >= 416) ? (s & 63) : (s >> 6), fq);
#pragma unroll
            for (int h = 0; h < 8; ++h) {
              bf16_t* dst = K1 + ((size_t)(b * 8 + h) * KVL + key) * 192 + 128 + (nb - 384);
              st8(dst + fq * 8, v0, v1);
            }
          } else if (nb < 1472) {
            if (!ctx) {
#pragma unroll
              for (int e = 0; e < 4; ++e) { v0[e] = silu_f(v0[e]); v1[e] = silu_f(v1[e]); }
              bf16_t* dst = Z1 + (size_t)token * 1024 + (nb - 448);
              st8(dst + fq * 8, v0, v1);
            }
          }
        }
      }
    if (u.pn <= 1) {
#pragma unroll
      for (int ai = 0; ai < 2; ++ai)
#pragma unroll
        for (int m = 0; m < 4; ++m) {
          float sv = ss[ai][m]; sv = xsum<16>(sv); sv = xsum<32>(sv);
          if (fq == 0) ssb[wc * 256 + ai * 128 + wr * 64 + m * 16 + fr] = sv;
        }
      asm volatile("s_waitcnt lgkmcnt(0)" ::: "memory"); __builtin_amdgcn_s_barrier(); asm volatile("" ::: "memory");
      const int lt = wc * 64 + fq * 16 + fr;
      if (lt < 128) {
        const int row = (lt >> 6) * 128 + wr * 64 + (lt & 63);
        if (u.pn == 0) { const float tot = (ssb[row] + ssb[256 + row]) + (ssb[512 + row] + ssb[768 + row]); RQ[u.pm * 256 + row] = rsqrtf(tot * (1.f / 256.f) + 1e-6f); }
        else { const float tot = (ssb[row] + ssb[256 + row]) + (ssb[512 + row] + ssb[768 + row]); RKV[u.pm * 256 + row] = rsqrtf(tot * (1.f / 128.f) + 1e-6f); }
      }
    }
  }
};

struct EpiQ {
  bf16_t* Q1; const float* RQ; const float2* rope;
  DEVI void operator()(acc_t& acc, const Unit& u, int wr, int wc, int fr, int fq) const {
    const int col0 = u.pn * 256;
#pragma unroll
    for (int ai = 0; ai < 2; ++ai)
#pragma unroll
      for (int m = 0; m < 4; ++m) {
        const int token = u.pm * 256 + ai * 128 + wr * 64 + m * 16 + fr; const int s = token & 2047; const float rq = RQ[token];
#pragma unroll
        for (int bj = 0; bj < 2; ++bj) {
          const int n0 = col0 + bj * 128 + wc * 32; const int dd0 = n0 % 192;
          f32x4 v0 = acc[ai][bj][m][0] * rq, v1 = acc[ai][bj][m][1] * rq;
          if (dd0 >= 128) rope_pair(v0, v1, rope, (dd0 >= 160) ? (s & 63) : (s >> 6), fq);
          bf16_t* dst = Q1 + (size_t)token * 1536 + n0;
          st8(dst + fq * 8, v0, v1);
        }
      }
  }
};

struct EpiKV {
  bf16_t *K1, *V1; const float* RKV;
  DEVI void operator()(acc_t& acc, const Unit& u, int wr, int wc, int fr, int fq) const {
    const int col0 = u.pn * 256; const bool ctx = u.pm >= 128;
#pragma unroll
    for (int ai = 0; ai < 2; ++ai)
#pragma unroll
      for (int m = 0; m < 4; ++m) {
        const int token = u.pm * 256 + ai * 128 + wr * 64 + m * 16 + fr; const float rk = RKV[token];
        int b, s, key; token_info(token, ctx, b, s, key);
#pragma unroll
        for (int bj = 0; bj < 2; ++bj) {
          const int nb = col0 + bj * 128 + wc * 32; const int h = nb >> 8, dd = nb & 255;
          const f32x4 v0 = acc[ai][bj][m][0] * rk, v1 = acc[ai][bj][m][1] * rk;
          bf16_t* dst = dd < 128 ? K1 + ((size_t)(b * 8 + h) * KVL + key) * 192 + dd : V1 + ((size_t)(b * 8 + h) * KVL + key) * 128 + (dd - 128);
          st8(dst + fq * 8, v0, v1);
        }
      }
  }
};

template <int SCID> struct ScaleOf { static constexpr float v = SCID == 0 ? 0.125f : 0.07216878364870322f; };
constexpr float THR = 8.f;
template <int KW> DEVI int kswz(int row, int colB) { return row * (KW * 2 + 16) + colB; }
DEVI int v_st(int k, int c) { const int kk = (k & ~0xC) | ((k & 4) << 1) | ((k & 8) >> 1); return ((kk >> 3) * 4 + (c >> 5)) * 512 + ((kk & 7) * 32 + (c & 31)) * 2; }
DEVI int v_rd_base(int lane) { return ((lane & 3) << 3) | (((lane >> 2) & 3) << 6) | (((lane >> 4) & 1) << 5) | (((lane >> 5) & 1) << 8); }
constexpr int v_rd_off(int d0, int ks, int half) { return d0 * 512 + ks * 4096 + half * 2048; }
template <int OFF> DEVI s16x4 tr_read(int vb) { s16x4 r; asm volatile("ds_read_b64_tr_b16 %0, %1 offset:%2" : "=&v"(r) : "v"(vb), "i"(OFF) : "memory"); return r; }

template <int SCID>
DEVI void partialSM(f32x16& p0, f32x16& p1, float& m_reg, float& mn, float& alpha) {
  constexpr float SC = ScaleOf<SCID>::v; constexpr float C = SC * 1.4426950408889634f;
  float pmax = p0[0];
#pragma unroll
  for (int r = 1; r < 16; ++r) pmax = fmaxf(pmax, p0[r]);
#pragma unroll
  for (int r = 0; r < 16; ++r) pmax = fmaxf(pmax, p1[r]);
  { auto rr = __builtin_amdgcn_permlane32_swap(__float_as_uint(pmax), __float_as_uint(pmax), false, false);
    pmax = fmaxf(__uint_as_float(rr[0]), __uint_as_float(rr[1])); }
  if (__builtin_expect(__all(pmax - m_reg <= THR / SC), 1)) { mn = m_reg; alpha = 1.f; }
  else { mn = fmaxf(m_reg, pmax); alpha = __builtin_amdgcn_exp2f((m_reg - mn) * C); m_reg = mn; }
  const float mnC = -mn * C;
#pragma unroll
  for (int r = 0; r < 16; ++r) p0[r] = fmaf(p0[r], C, mnC);
#pragma unroll
  for (int r = 0; r < 16; ++r) p1[r] = fmaf(p1[r], C, mnC);
#pragma unroll
  for (int r = 0; r < 16; ++r) p0[r] = __builtin_amdgcn_exp2f(p0[r]);
}
DEVI void finishSM(f32x16& p0, f32x16& p1, float alpha, float& l_reg, bf16x8& pa0, bf16x8& pa1, bf16x8& pa2, bf16x8& pa3) {
#pragma unroll
  for (int r = 0; r < 16; ++r) p1[r] = __builtin_amdgcn_exp2f(p1[r]);
  float ps = 0;
#pragma unroll
  for (int r = 0; r < 16; ++r) ps += p0[r];
#pragma unroll
  for (int r = 0; r < 16; ++r) ps += p1[r];
  { auto rr = __builtin_amdgcn_permlane32_swap(__float_as_uint(ps), __float_as_uint(ps), false, false);
    ps = __uint_as_float(rr[0]) + __uint_as_float(rr[1]); }
  l_reg = l_reg * alpha + ps;
#define PK4(P, BASE, OUT) do { unsigned a0 = cvtpk(P[BASE + 0], P[BASE + 1]), a1 = cvtpk(P[BASE + 2], P[BASE + 3]); \
    unsigned b0 = cvtpk(P[BASE + 4], P[BASE + 5]), b1 = cvtpk(P[BASE + 6], P[BASE + 7]); \
    auto r0 = __builtin_amdgcn_permlane32_swap(a0, b0, false, false); auto r1 = __builtin_amdgcn_permlane32_swap(a1, b1, false, false); \
    u32x4 w = {r0[0], r1[0], r0[1], r1[1]}; OUT = *reinterpret_cast<bf16x8*>(&w); } while (0)
  PK4(p0, 0, pa0); PK4(p0, 8, pa1); PK4(p1, 0, pa2); PK4(p1, 8, pa3);
#undef PK4
}
template <int KW, int NQ, int QL = 0>
DEVI void qkt(f32x16& p0, f32x16& p1, const char* Ks, const bf16x8* qr, int kcol0, int r32, int hi, const char* ql = nullptr) {
#pragma unroll
  for (int r = 0; r < 16; ++r) { p0[r] = 0.f; p1[r] = 0.f; }
  const char* kb = Ks + kswz<KW>(r32, (kcol0 + hi * 8) * 2);
  constexpr int ROW32 = 32 * (KW * 2 + 16);
  bf16x8 b0n = *reinterpret_cast<const bf16x8*>(kb), b1n = *reinterpret_cast<const bf16x8*>(kb + ROW32);
#pragma unroll
  for (int d0 = 0; d0 < NQ; ++d0) {
    const bf16x8 b0 = b0n, b1 = b1n;
    bf16x8 q;
    if constexpr (QL > 0) { if (d0 >= NQ - QL) q = *reinterpret_cast<const bf16x8*>(ql + (d0 - (NQ - QL)) * 32); else q = qr[d0]; } else q = qr[d0];
    if (d0 + 1 < NQ) { b0n = *reinterpret_cast<const bf16x8*>(kb + (d0 + 1) * 32); b1n = *reinterpret_cast<const bf16x8*>(kb + ROW32 + (d0 + 1) * 32); }
    SBAR();
    p0 = __builtin_amdgcn_mfma_f32_32x32x16_bf16(b0, q, p0, 0, 0, 0);
    p1 = __builtin_amdgcn_mfma_f32_32x32x16_bf16(b1, q, p1, 0, 0, 0);
  }
}
template <int D0> DEVI void pv_one(f32x16& od, int vb, bf16x8 pa0, bf16x8 pa1, bf16x8 pa2, bf16x8 pa3) {
  const s16x4 l0 = tr_read<v_rd_off(D0, 0, 0)>(vb), h0 = tr_read<v_rd_off(D0, 0, 1)>(vb), l1 = tr_read<v_rd_off(D0, 1, 0)>(vb), h1 = tr_read<v_rd_off(D0, 1, 1)>(vb);
  const s16x4 l2 = tr_read<v_rd_off(D0, 2, 0)>(vb), h2 = tr_read<v_rd_off(D0, 2, 1)>(vb), l3 = tr_read<v_rd_off(D0, 3, 0)>(vb), h3 = tr_read<v_rd_off(D0, 3, 1)>(vb);
  asm volatile("s_waitcnt lgkmcnt(0)" ::: "memory"); SBAR();
#define PK(L, H) (bf16x8){L[0], L[1], L[2], L[3], H[0], H[1], H[2], H[3]}
  od = __builtin_amdgcn_mfma_f32_32x32x16_bf16(pa0, PK(l0, h0), od, 0, 0, 0);
  od = __builtin_amdgcn_mfma_f32_32x32x16_bf16(pa1, PK(l1, h1), od, 0, 0, 0);
  od = __builtin_amdgcn_mfma_f32_32x32x16_bf16(pa2, PK(l2, h2), od, 0, 0, 0);
  od = __builtin_amdgcn_mfma_f32_32x32x16_bf16(pa3, PK(l3, h3), od, 0, 0, 0);
#undef PK
}
DEVI void pv_d0(f32x16* o, int vb, bf16x8 pa0, bf16x8 pa1, bf16x8 pa2, bf16x8 pa3) {
  pv_one<0>(o[0], vb, pa0, pa1, pa2, pa3); pv_one<1>(o[1], vb, pa0, pa1, pa2, pa3); pv_one<2>(o[2], vb, pa0, pa1, pa2, pa3); pv_one<3>(o[3], vb, pa0, pa1, pa2, pa3);
}

template <int KW, int NQ, int SCID>
DEVI void attn_core(int wv, const bf16_t* __restrict__ Qw, const bf16_t* __restrict__ Kh, const bf16_t* __restrict__ Vh, int kcol0, int NT, char* lds,
                    f32x16 (&o)[4], float& l_out) {
  constexpr int SHM_V = 64 * 128 * 2, SHM_K = 64 * (KW * 2 + 16), KC = KW / 64;
  const int tid = tidx(wv), wid = tid >> 6, lane = tid & 63, r32 = lane & 31, hi = lane >> 5;
  char* V_lds = lds; char* K_lds = lds + 2 * SHM_V;
  float* al_l = (float*)(lds + 2 * SHM_V + 2 * SHM_K) + wid * 64 + 32;
  float m_reg = -1e30f, l_reg = 0;
#pragma unroll
  for (int d = 0; d < 4; ++d)
#pragma unroll
    for (int r = 0; r < 16; ++r) o[d][r] = 0.f;
  bf16x8 qr[NQ];
#pragma unroll
  for (int d0 = 0; d0 < NQ; ++d0) qr[d0] = *reinterpret_cast<const bf16x8*>(Qw + d0 * 16);
  const int sr = tid >> 4, sc = (tid & 15) * 8, vst0 = v_st(sr, sc), vst1 = v_st(32 + sr, sc);
  const int krow = tid >> 3, kch = tid & 7;
  const bf16_t* vg = Vh + sr * 128 + sc;
  const bf16_t* kg = Kh + krow * KW + kch * 8;
  const int vb0 = (int)(uintptr_t)V_lds + v_rd_base(lane);
  bf16x8 vs0, vs1, ks[KC];
#define SLOAD(k0) do { vs0 = *reinterpret_cast<const bf16x8*>(vg + (size_t)(k0) * 128); vs1 = *reinterpret_cast<const bf16x8*>(vg + (size_t)((k0) + 32) * 128); \
    _Pragma("unroll") for (int _c = 0; _c < KC; ++_c) ks[_c] = *reinterpret_cast<const bf16x8*>(kg + (size_t)(k0) * KW + _c * 64); } while (0)
#define SWRITE(b) do { *reinterpret_cast<bf16x8*>(V_lds + (b) * SHM_V + vst0) = vs0; *reinterpret_cast<bf16x8*>(V_lds + (b) * SHM_V + vst1) = vs1; \
    _Pragma("unroll") for (int _c = 0; _c < KC; ++_c) *reinterpret_cast<bf16x8*>(K_lds + (b) * SHM_K + kswz<KW>(krow, (kch + 8 * _c) * 16)) = ks[_c]; } while (0)
  SLOAD(0); SWRITE(0);
  if (NT > 1) SLOAD(64);
  __syncthreads();
  for (int j = 0; j < NT; ++j) {
    const int bsel = j & 1;
    f32x16 p0, p1; float mn, alpha; bf16x8 pa0, pa1, pa2, pa3;
    qkt<KW, NQ>(p0, p1, K_lds + bsel * SHM_K, qr, kcol0, r32, hi);
    partialSM<SCID>(p0, p1, m_reg, mn, alpha);
    if (__any(alpha < 1.f)) {
      if (hi == 0) al_l[r32] = alpha;
      asm volatile("s_waitcnt lgkmcnt(0)" ::: "memory");
#pragma unroll
      for (int d = 0; d < 4; ++d)
#pragma unroll
        for (int r = 0; r < 16; ++r) o[d][r] *= al_l[crow(r, hi)];
    }
    finishSM(p0, p1, alpha, l_reg, pa0, pa1, pa2, pa3);
    pv_d0(o, vb0 + bsel * SHM_V, pa0, pa1, pa2, pa3);
    if (j + 1 < NT) { SWRITE(bsel ^ 1); if (j + 2 < NT) SLOAD((j + 2) * 64); }
    __syncthreads();
  }
  l_out = l_reg;
#undef SLOAD
#undef SWRITE
}

template <int KW, int NQ, int SDEPTH, int SCID, int QL>
DEVI void attn_core_pipe(int wv, const bf16_t* __restrict__ Qw, const bf16_t* __restrict__ Kh, const bf16_t* __restrict__ Vh, int kcol0, int NT, char* lds,
                         f32x16 (&o)[4], float& l_out) {
  constexpr int SHM_V = 64 * 128 * 2, SHM_K = 64 * (KW * 2 + 16), KC = KW / 64;
  const int tid = tidx(wv), wid = tid >> 6, lane = tid & 63, r32 = lane & 31, hi = lane >> 5;
  char* V_lds = lds; char* K_lds = lds + 2 * SHM_V;
  float* al_l = (float*)(lds + 2 * SHM_V + 2 * SHM_K) + wid * 64 + 32;
  float m_reg = -1e30f, l_reg = 0;
#pragma unroll
  for (int d = 0; d < 4; ++d)
#pragma unroll
    for (int r = 0; r < 16; ++r) o[d][r] = 0.f;
  bf16x8 qr[NQ - QL + (QL ? 1 : 0)];
#pragma unroll
  for (int d0 = 0; d0 < NQ - QL; ++d0) qr[d0] = *reinterpret_cast<const bf16x8*>(Qw + d0 * 16);
  char* ql = lds + 2 * SHM_V + 2 * SHM_K + 2048 + (wid * 32 + r32) * 144 + hi * 16;
  if constexpr (QL > 0) {
#pragma unroll
    for (int d0 = NQ - QL; d0 < NQ; ++d0) *reinterpret_cast<bf16x8*>(ql + (d0 - (NQ - QL)) * 32) = *reinterpret_cast<const bf16x8*>(Qw + d0 * 16);
  }
  const int sr = tid >> 4, sc = (tid & 15) * 8, vst0 = v_st(sr, sc), vst1 = v_st(32 + sr, sc);
  const int krow = tid >> 3, kch = tid & 7;
  const bf16_t* vg = Vh + sr * 128 + sc;
  const bf16_t* kg = Kh + krow * KW + kch * 8;
  const int vb0 = (int)(uintptr_t)V_lds + v_rd_base(lane);
  struct { bf16x8 vs0, vs1, ks[KC]; } sr_[SDEPTH];
#define SLOAD(i, k0) do { sr_[i].vs0 = *reinterpret_cast<const bf16x8*>(vg + (size_t)(k0) * 128); sr_[i].vs1 = *reinterpret_cast<const bf16x8*>(vg + (size_t)((k0) + 32) * 128); \
    _Pragma("unroll") for (int _c = 0; _c < KC; ++_c) sr_[i].ks[_c] = *reinterpret_cast<const bf16x8*>(kg + (size_t)(k0) * KW + _c * 64); } while (0)
#define SWRITE(b, i) do { *reinterpret_cast<bf16x8*>(V_lds + (b) * SHM_V + vst0) = sr_[i].vs0; *reinterpret_cast<bf16x8*>(V_lds + (b) * SHM_V + vst1) = sr_[i].vs1; \
    _Pragma("unroll") for (int _c = 0; _c < KC; ++_c) *reinterpret_cast<bf16x8*>(K_lds + (b) * SHM_K + kswz<KW>(krow, (kch + 8 * _c) * 16)) = sr_[i].ks[_c]; } while (0)
#define SWAIT() do { if constexpr (SDEPTH == 2) asm volatile("s_waitcnt vmcnt(4)" ::: "memory"); else asm volatile("s_waitcnt vmcnt(0)" ::: "memory"); } while (0)
#define RESC(a) do { if (__any((a) < 1.f)) { if (hi == 0) al_l[r32] = (a); asm volatile("s_waitcnt lgkmcnt(0)" ::: "memory"); \
    _Pragma("unroll") for (int _d = 0; _d < 4; ++_d) _Pragma("unroll") for (int _r = 0; _r < 16; ++_r) o[_d][_r] *= al_l[crow(_r, hi)]; } } while (0)
  f32x16 pA0, pA1, pB0, pB1; float mnA, mnB, alA, alB; bf16x8 pa0, pa1, pa2, pa3;
  constexpr int SE = 0, SO = SDEPTH - 1;
  SLOAD(SE, 0); asm volatile("s_waitcnt vmcnt(0)" ::: "memory"); SWRITE(0, SE); __syncthreads();
  qkt<KW, NQ, QL>(pA0, pA1, K_lds, qr, kcol0, r32, hi, ql); partialSM<SCID>(pA0, pA1, m_reg, mnA, alA);
  SLOAD(SO, 64); if constexpr (SDEPTH == 2) { if (2 < NT) SLOAD(SE, 128); }
  SWAIT(); SWRITE(1, SO); __syncthreads();
  for (int j = 1; j + 1 < NT; j += 2) {
    SBAR(); qkt<KW, NQ, QL>(pB0, pB1, K_lds + SHM_K, qr, kcol0, r32, hi, ql);
    finishSM(pA0, pA1, alA, l_reg, pa0, pa1, pa2, pa3); SBAR();
    SLOAD(SO, (j + SDEPTH) * 64); SBAR();
    pv_d0(o, vb0, pa0, pa1, pa2, pa3); partialSM<SCID>(pB0, pB1, m_reg, mnB, alB);
    __syncthreads(); SWAIT(); SWRITE(0, SE);
    RESC(alB); __syncthreads();
    SBAR(); qkt<KW, NQ, QL>(pA0, pA1, K_lds, qr, kcol0, r32, hi, ql);
    finishSM(pB0, pB1, alB, l_reg, pa0, pa1, pa2, pa3); SBAR();
    if (SDEPTH == 1 || j + 3 < NT) SLOAD(SE, (j + 1 + SDEPTH) * 64);
    SBAR();
    pv_d0(o, vb0 + SHM_V, pa0, pa1, pa2, pa3); partialSM<SCID>(pA0, pA1, m_reg, mnA, alA);
    __syncthreads(); SWAIT(); SWRITE(1, SO);
    RESC(alA); __syncthreads();
  }
  SBAR(); qkt<KW, NQ, QL>(pB0, pB1, K_lds + SHM_K, qr, kcol0, r32, hi, ql);
  finishSM(pA0, pA1, alA, l_reg, pa0, pa1, pa2, pa3); SBAR();
  pv_d0(o, vb0, pa0, pa1, pa2, pa3); partialSM<SCID>(pB0, pB1, m_reg, mnB, alB);
  __syncthreads(); RESC(alB);
  finishSM(pB0, pB1, alB, l_reg, pa0, pa1, pa2, pa3); SBAR();
  pv_d0(o, vb0 + SHM_V, pa0, pa1, pa2, pa3);
  __syncthreads();
  l_out = l_reg;
#undef SLOAD
#undef SWRITE
#undef SWAIT
#undef RESC
}

template <int KW, int NQ, int SCID, int QL>
DEVI void attn_core_dma(int wv, const bf16_t* __restrict__ Qw, const bf16_t* __restrict__ Kh, const bf16_t* __restrict__ Vh, int kcol0, int NT, char* lds,
                        f32x16 (&o)[4], float& l_out) {
  constexpr int SHM_V = 64 * 128 * 2, KCH = KW / 8 + 1, SHM_K = 64 * KCH * 16, KR = (64 * KCH) / 512;
  static_assert(64 * KCH - KR * 512 == 64, "remainder must be one wave");
  const int tid = tidx(wv), wid = tid >> 6, lane = tid & 63, r32 = lane & 31, hi = lane >> 5;
  char* V_lds = lds; char* K_lds = lds + 2 * SHM_V;
  float* al_l = (float*)(lds + 2 * SHM_V + 2 * SHM_K) + wid * 64 + 32;
  float m_reg = -1e30f, l_reg = 0;
#pragma unroll
  for (int d = 0; d < 4; ++d)
#pragma unroll
    for (int r = 0; r < 16; ++r) o[d][r] = 0.f;
  bf16x8 qr[NQ - QL + (QL ? 1 : 0)];
#pragma unroll
  for (int d0 = 0; d0 < NQ - QL; ++d0) qr[d0] = *reinterpret_cast<const bf16x8*>(Qw + d0 * 16);
  char* ql = lds + 2 * SHM_V + 2 * SHM_K + 2048 + (wid * 32 + r32) * 144 + hi * 16;
  if constexpr (QL > 0) {
#pragma unroll
    for (int d0 = NQ - QL; d0 < NQ; ++d0) *reinterpret_cast<bf16x8*>(ql + (d0 - (NQ - QL)) * 32) = *reinterpret_cast<const bf16x8*>(Qw + d0 * 16);
  }
  const int sr = tid >> 4, sc = (tid & 15) * 8, vst0 = v_st(sr, sc), vst1 = v_st(32 + sr, sc);
  const bf16_t* vg = Vh + sr * 128 + sc;
  const int vb0 = (int)(uintptr_t)V_lds + v_rd_base(lane);
  unsigned koff[KR + 1];
#pragma unroll
  for (int i = 0; i <= KR; ++i) { const int c = tid + 512 * i; const int row = c / KCH; int ch = c - row * KCH; ch = ch == KCH - 1 ? KCH - 2 : ch; koff[i] = (unsigned)(row * KW + ch * 8) * 2u; }
  const unsigned kldsw = (unsigned)__builtin_amdgcn_readfirstlane(wid) * 1024u;
  bf16x8 vs0, vs1;
#define KDMA(k0, b) do { const char* _g = (const char*)(Kh + (size_t)(k0) * KW); PG8_LAS unsigned char* _l = (PG8_LAS unsigned char*)(K_lds + (b) * SHM_K) + kldsw; \
    _Pragma("unroll") for (int _i = 0; _i < KR; ++_i) __builtin_amdgcn_global_load_lds((const unsigned*)(_g + koff[_i]), (PG8_LAS unsigned*)(_l + _i * 8192), 16, 0, 0); \
    if (wid == 0) __builtin_amdgcn_global_load_lds((const unsigned*)(_g + koff[KR]), (PG8_LAS unsigned*)(_l + KR * 8192), 16, 0, 0); } while (0)
#define VLOAD(k0) do { vs0 = *reinterpret_cast<const bf16x8*>(vg + (size_t)(k0) * 128); vs1 = *reinterpret_cast<const bf16x8*>(vg + (size_t)((k0) + 32) * 128); } while (0)
#define VWRITE(b) do { *reinterpret_cast<bf16x8*>(V_lds + (b) * SHM_V + vst0) = vs0; *reinterpret_cast<bf16x8*>(V_lds + (b) * SHM_V + vst1) = vs1; } while (0)
#define VMW() asm volatile("s_waitcnt vmcnt(0)" ::: "memory")
#define RESC(a) do { if (__any((a) < 1.f)) { if (hi == 0) al_l[r32] = (a); asm volatile("s_waitcnt lgkmcnt(0)" ::: "memory"); \
    _Pragma("unroll") for (int _d = 0; _d < 4; ++_d) _Pragma("unroll") for (int _r = 0; _r < 16; ++_r) o[_d][_r] *= al_l[crow(_r, hi)]; } } while (0)
  f32x16 pA0, pA1, pB0, pB1; float mnA, mnB, alA, alB; bf16x8 pa0, pa1, pa2, pa3;
  KDMA(0, 0); VLOAD(0); VMW(); VWRITE(0); __syncthreads();
  KDMA(64, 1); VLOAD(64);
  qkt<KW, NQ, QL>(pA0, pA1, K_lds, qr, kcol0, r32, hi, ql); partialSM<SCID>(pA0, pA1, m_reg, mnA, alA);
  VMW(); __syncthreads(); VWRITE(1); __syncthreads();
  for (int j = 1; j + 1 < NT; j += 2) {
    SBAR(); KDMA((j + 1) * 64, 0); VLOAD((j + 1) * 64); SBAR();
    qkt<KW, NQ, QL>(pB0, pB1, K_lds + SHM_K, qr, kcol0, r32, hi, ql);
    finishSM(pA0, pA1, alA, l_reg, pa0, pa1, pa2, pa3); SBAR();
    pv_d0(o, vb0, pa0, pa1, pa2, pa3); partialSM<SCID>(pB0, pB1, m_reg, mnB, alB);
    VMW(); __syncthreads(); VWRITE(0);
    RESC(alB); __syncthreads();
    SBAR(); KDMA((j + 2) * 64, 1); VLOAD((j + 2) * 64); SBAR();
    qkt<KW, NQ, QL>(pA0, pA1, K_lds, qr, kcol0, r32, hi, ql);
    finishSM(pB0, pB1, alB, l_reg, pa0, pa1, pa2, pa3); SBAR();
    pv_d0(o, vb0 + SHM_V, pa0, pa1, pa2, pa3); partialSM<SCID>(pA0, pA1, m_reg, mnA, alA);
    VMW(); __syncthreads(); VWRITE(1);
    RESC(alA); __syncthreads();
  }
  SBAR(); qkt<KW, NQ, QL>(pB0, pB1, K_lds + SHM_K, qr, kcol0, r32, hi, ql);
  finishSM(pA0, pA1, alA, l_reg, pa0, pa1, pa2, pa3); SBAR();
  pv_d0(o, vb0, pa0, pa1, pa2, pa3); partialSM<SCID>(pB0, pB1, m_reg, mnB, alB);
  RESC(alB);
  finishSM(pB0, pB1, alB, l_reg, pa0, pa1, pa2, pa3); SBAR();
  pv_d0(o, vb0 + SHM_V, pa0, pa1, pa2, pa3);
  __syncthreads();
  l_out = l_reg;
#undef KDMA
#undef VLOAD
#undef VWRITE
#undef VMW
#undef RESC
}

template <int KW, int NQ, int SCID, int QL>
DEVI void attn_core_pp(int wv, const bf16_t* __restrict__ Qw, const bf16_t* __restrict__ Kh, const bf16_t* __restrict__ Vh, int kcol0, int NT, char* lds,
                       f32x16 (&o)[4], float& l_out) {
  constexpr int SHM_V = 64 * 128 * 2, KCH = KW / 8 + 1, SHM_K = 64 * KCH * 16, KR = (64 * KCH) / 512;
  static_assert(64 * KCH - KR * 512 == 64, "remainder must be one wave");
  const int tid = tidx(wv), wid = tid >> 6, lane = tid & 63, r32 = lane & 31, hi = lane >> 5;
  const int g = __builtin_amdgcn_readfirstlane(wid >> 2);
  char* V_lds = lds; char* K_lds = lds + 2 * SHM_V;
  float* al_l = (float*)(lds + 2 * SHM_V + 2 * SHM_K) + wid * 64 + 32;
  float m_reg = -1e30f, l_reg = 0;
#pragma unroll
  for (int d = 0; d < 4; ++d)
#pragma unroll
    for (int r = 0; r < 16; ++r) o[d][r] = 0.f;
  bf16x8 qr[NQ - QL + (QL ? 1 : 0)];
#pragma unroll
  for (int d0 = 0; d0 < NQ - QL; ++d0) qr[d0] = *reinterpret_cast<const bf16x8*>(Qw + d0 * 16);
  char* ql = lds + 2 * SHM_V + 2 * SHM_K + 2048 + (wid * 32 + r32) * 144 + hi * 16;
  if constexpr (QL > 0) {
#pragma unroll
    for (int d0 = NQ - QL; d0 < NQ; ++d0) *reinterpret_cast<bf16x8*>(ql + (d0 - (NQ - QL)) * 32) = *reinterpret_cast<const bf16x8*>(Qw + d0 * 16);
  }
  const int vb0 = (int)(uintptr_t)V_lds + v_rd_base(lane);
  unsigned koff[KR + 1], voff[2];
#pragma unroll
  for (int i = 0; i <= KR; ++i) { const int c = tid + 512 * i; const int row = c / KCH; int ch = c - row * KCH; ch = ch == KCH - 1 ? KCH - 2 : ch; koff[i] = (unsigned)(row * KW + ch * 8) * 2u; }
#pragma unroll
  for (int i = 0; i < 2; ++i) { const int q = tid + 512 * i; const int st = q >> 5, kk = (st >> 2) * 8 + ((q >> 2) & 7), c = (st & 3) * 32 + (q & 3) * 8;
    const int k = (kk & ~0xC) | ((kk & 4) << 1) | ((kk & 8) >> 1); voff[i] = (unsigned)(k * 128 + c) * 2u; }
  const unsigned ldsw = (unsigned)__builtin_amdgcn_readfirstlane(wid) * 1024u;
#define KDMA(k0, b) do { const char* _g = (const char*)(Kh + (size_t)(k0) * KW); PG8_LAS unsigned char* _l = (PG8_LAS unsigned char*)(K_lds + (b) * SHM_K) + ldsw; \
    _Pragma("unroll") for (int _i = 0; _i < KR; ++_i) __builtin_amdgcn_global_load_lds((const unsigned*)(_g + koff[_i]), (PG8_LAS unsigned*)(_l + _i * 8192), 16, 0, 0); \
    if (wid == 0) __builtin_amdgcn_global_load_lds((const unsigned*)(_g + koff[KR]), (PG8_LAS unsigned*)(_l + KR * 8192), 16, 0, 0); } while (0)
#define VDMA(k0, b) do { const char* _g = (const char*)(Vh + (size_t)(k0) * 128); PG8_LAS unsigned char* _l = (PG8_LAS unsigned char*)(V_lds + (b) * SHM_V) + ldsw; \
    _Pragma("unroll") for (int _i = 0; _i < 2; ++_i) __builtin_amdgcn_global_load_lds((const unsigned*)(_g + voff[_i]), (PG8_LAS unsigned*)(_l + _i * 8192), 16, 0, 0); } while (0)
#define VMW() asm volatile("s_waitcnt vmcnt(0)" ::: "memory")
#define PBAR() do { asm volatile("" ::: "memory"); __builtin_amdgcn_s_barrier(); asm volatile("" ::: "memory"); } while (0)
#define RESC(a) do { if (__any((a) < 1.f)) { if (hi == 0) al_l[r32] = (a); asm volatile("s_waitcnt lgkmcnt(0)" ::: "memory"); \
    _Pragma("unroll") for (int _d = 0; _d < 4; ++_d) _Pragma("unroll") for (int _r = 0; _r < 16; ++_r) o[_d][_r] *= al_l[crow(_r, hi)]; } } while (0)
  f32x16 pA0, pA1, pB0, pB1; float mn, al; bf16x8 pa0, pa1, pa2, pa3;
  KDMA(0, 0); KDMA(64, 1); VMW(); __syncthreads();
  qkt<KW, NQ, QL>(pA0, pA1, K_lds, qr, kcol0, r32, hi, ql);
  PBAR();
  if (g == 1) PBAR();
  for (int j = 0; j < NT; j += 2) {
    SBAR(); if (j + 2 < NT) KDMA((j + 2) * 64, 0); VDMA(j * 64, 0); SBAR();
    qkt<KW, NQ, QL>(pB0, pB1, K_lds + SHM_K, qr, kcol0, r32, hi, ql);
    if (j > 0) pv_d0(o, vb0 + SHM_V, pa0, pa1, pa2, pa3);
    if (g == 1) VMW();
    PBAR(); SBAR();
    partialSM<SCID>(pA0, pA1, m_reg, mn, al); RESC(al); finishSM(pA0, pA1, al, l_reg, pa0, pa1, pa2, pa3);
    if (g == 0) VMW();
    PBAR(); SBAR();
    if (j + 3 < NT) KDMA((j + 3) * 64, 1);
    VDMA((j + 1) * 64, 1); SBAR();
    if (j + 2 < NT) qkt<KW, NQ, QL>(pA0, pA1, K_lds, qr, kcol0, r32, hi, ql);
    pv_d0(o, vb0, pa0, pa1, pa2, pa3);
    if (g == 1) VMW();
    PBAR(); SBAR();
    partialSM<SCID>(pB0, pB1, m_reg, mn, al); RESC(al); finishSM(pB0, pB1, al, l_reg, pa0, pa1, pa2, pa3);
    if (g == 0) VMW();
    PBAR(); SBAR();
  }
  pv_d0(o, vb0 + SHM_V, pa0, pa1, pa2, pa3);
  if (g == 0) PBAR();
  __syncthreads();
  l_out = l_reg;
#undef KDMA
#undef VDMA
#undef VMW
#undef PBAR
#undef RESC
}

DEVI void gated_rows_out(const char* stg, int lane, const bf16_t* __restrict__ gate, int gld, bf16_t* __restrict__ out, int old) {
#pragma unroll
  for (int i = 0; i < 8; ++i) {
    const int c = lane + 64 * i, row = c >> 4, ch = c & 15;
    const u32x4 sv = *reinterpret_cast<const u32x4*>(stg + row * 272 + ch * 16);
    const u32x4 gv = *reinterpret_cast<const u32x4*>(gate + (size_t)row * gld + ch * 8);
    u32x4 ov;
#pragma unroll
    for (int e = 0; e < 4; ++e) ov[e] = cvtpk(bflo(sv[e]) * bflo(gv[e]), bfhi(sv[e]) * bfhi(gv[e]));
    *reinterpret_cast<u32x4*>(out + (size_t)row * old + ch * 8) = ov;
  }
}

DEVI void attn0_item(int wv, const Params& p, int token0, int b, int h, int nkeys, char* lds) {
  const int tid = tidx(wv), wid = tid >> 6, lane = tid & 63, r32 = lane & 31, hi = lane >> 5, m = wid >> 2, wl = wid & 3;
  const bf16_t* Q0 = (const bf16_t*)(p.ws + OFF_Q0); const bf16_t* K0 = (const bf16_t*)(p.ws + OFF_K0); const bf16_t* V0 = (const bf16_t*)(p.ws + OFF_V0);
  const bf16_t* ZB = (const bf16_t*)(p.ws + OFF_ZB); bf16_t* MIX = (bf16_t*)(p.ws + OFF_MIX);
  const bf16_t* Qw = Q0 + (size_t)(token0 + wl * 32 + r32) * 512 + h * 128 + m * 64 + hi * 8;
  const size_t kvo = (size_t)(b * 4 + h) * KVL * 128;
  f32x16 o[4]; float l;
  attn_core_pp<128, 4, 0, 0>(wv, Qw, K0 + kvo, V0 + kvo, m * 64, nkeys >> 6, lds, o, l);
  float* li_l = (float*)(lds + 32768 + 2 * 64 * 272) + wid * 64;
  if (hi == 0) li_l[r32] = l;
  asm volatile("s_waitcnt lgkmcnt(0)" ::: "memory");
  float rli[16];
#pragma unroll
  for (int r = 0; r < 16; ++r) rli[r] = __builtin_amdgcn_rcpf(li_l[crow(r, hi)]);
  float t1 = p.b_lq1[lane] * p.b_lk1[lane], t2 = p.b_lq2[lane] * p.b_lk2[lane];
  t1 = wave_sum(t1); t2 = wave_sum(t2);
  const float lam = __expf(t1) - __expf(t2) + 0.2f;
  __syncthreads();
  float* xch = (float*)lds;
  if (m == 1) {
#pragma unroll
    for (int r = 0; r < 16; ++r)
#pragma unroll
      for (int d0 = 0; d0 < 4; ++d0) xch[(wl * 32 + crow(r, hi)) * 128 + d0 * 32 + r32] = o[d0][r] * rli[r];
  }
  __syncthreads();
  if (m == 0) {
    char* stg = lds + 69632 + wl * 8704;
    float sw4[4];
#pragma unroll
    for (int d0 = 0; d0 < 4; ++d0) sw4[d0] = p.b_subln_w[d0 * 32 + r32];
#pragma unroll
    for (int r = 0; r < 16; ++r) {
      const int row = wl * 32 + crow(r, hi); const int token = token0 + row;
      float a[4], ss = 0.f;
#pragma unroll
      for (int d0 = 0; d0 < 4; ++d0) { a[d0] = o[d0][r] * rli[r] - lam * xch[row * 128 + d0 * 32 + r32]; ss += a[d0] * a[d0]; }
      ss = xsum<1>(ss); ss = xsum<2>(ss); ss = xsum<4>(ss); ss = xsum<8>(ss); ss = xsum<16>(ss);
      const float rstd = rsqrtf(ss * (1.f / 128.f) + 1e-5f) * 0.8f;
#pragma unroll
      for (int d0 = 0; d0 < 4; ++d0) *reinterpret_cast<bf16_t*>(stg + crow(r, hi) * 272 + (d0 * 32 + r32) * 2) = f2bf(a[d0] * rstd * sw4[d0]);
    }
    asm volatile("s_waitcnt lgkmcnt(0)" ::: "memory");
    const size_t t0 = (size_t)(token0 + wl * 32);
    gated_rows_out(stg, lane, ZB + t0 * 512 + h * 128, 512, MIX + t0 * 1024 + 512 + h * 128, 1024);
  }
  __syncthreads();
}

DEVI void attn1_item(int wv, const Params& p, int b, int h, int qb, char* lds) {
  const int tid = tidx(wv), wid = tid >> 6, lane = tid & 63, r32 = lane & 31, hi = lane >> 5;
  const bf16_t* Q1 = (const bf16_t*)(p.ws + OFF_Q1); const bf16_t* K1 = (const bf16_t*)(p.ws + OFF_K1); const bf16_t* V1 = (const bf16_t*)(p.ws + OFF_V1);
  const bf16_t* Z1 = (const bf16_t*)(p.ws + OFF_Z1); bf16_t* MIX = (bf16_t*)(p.ws + OFF_MIX);
  const int token0 = b * 2048 + qb * 256;
  const bf16_t* Qw = Q1 + (size_t)(token0 + wid * 32 + r32) * 1536 + h * 192 + hi * 8;
  f32x16 o[4]; float l;
  attn_core_pp<192, 12, 1, 4>(wv, Qw, K1 + (size_t)(b * 8 + h) * KVL * 192, V1 + (size_t)(b * 8 + h) * KVL * 128, 0, KVL / 64, lds, o, l);
  float* li_l = (float*)(lds + 32768 + 2 * 64 * 400) + wid * 64;
  if (hi == 0) li_l[r32] = l;
  asm volatile("s_waitcnt lgkmcnt(0)" ::: "memory");
  char* stg = lds + wid * 8704;
#pragma unroll
  for (int r = 0; r < 16; ++r) {
    const int cr = crow(r, hi); const float rl = __builtin_amdgcn_rcpf(li_l[cr]);
#pragma unroll
    for (int d0 = 0; d0 < 4; ++d0) *reinterpret_cast<bf16_t*>(stg + cr * 272 + (d0 * 32 + r32) * 2) = f2bf(o[d0][r] * rl);
  }
  asm volatile("s_waitcnt lgkmcnt(0)" ::: "memory");
  const size_t t0 = (size_t)(token0 + wid * 32);
  gated_rows_out(stg, lane, Z1 + t0 * 1024 + h * 128, 1024, MIX + t0 * 1024 + h * 128, 1024);
  __syncthreads();
}

DEVI void abranch_item(int wv, const Params& p, int ci, char* lds) {
  const int tid = tidx(wv), wid = tid >> 6, lane = tid & 63, r32 = lane & 31, hi = lane >> 5;
  const bf16_t* GV = (const bf16_t*)(p.ws + OFF_GV); const bf16_t* U = (const bf16_t*)(p.ws + OFF_U); const bf16_t* ZA = (const bf16_t*)(p.ws + OFF_ZA);
  const bf16_t* WSB = (const bf16_t*)(p.ws + OFF_WSB); bf16_t* MIX = (bf16_t*)(p.ws + OFF_MIX);
  const int t0 = ci * 128;
  bf16_t* vnT = (bf16_t*)lds;
  {
    const int pos = tid >> 2, cp = tid & 3;
    const bf16_t* g = GV + (size_t)(t0 + pos) * 512;
    float s = 0.f, q = 0.f;
#pragma unroll 4
    for (int i = 0; i < 16; ++i) {
      const bf16x8 raw = *reinterpret_cast<const bf16x8*>(g + (i * 4 + cp) * 8);
#pragma unroll
      for (int e = 0; e < 8; ++e) { const float xv = bf2f((bf16_t)raw[e]); s += xv; q += xv * xv; }
    }
    s = xsum<1>(s); s = xsum<2>(s); q = xsum<1>(q); q = xsum<2>(q);
    const float mu = s * (1.f / 512.f);
    const float rstd = rsqrtf(fmaxf(q * (1.f / 512.f) - mu * mu, 0.f) + 1e-5f);
#pragma unroll 2
    for (int i = 0; i < 16; ++i) {
      const int c0 = (i * 4 + cp) * 8;
      const bf16x8 raw = *reinterpret_cast<const bf16x8*>(g + c0);
      const f32x4 w0 = *reinterpret_cast<const f32x4*>(p.a_ln_w + c0), w1 = *reinterpret_cast<const f32x4*>(p.a_ln_w + c0 + 4);
      const f32x4 b0 = *reinterpret_cast<const f32x4*>(p.a_ln_b + c0), b1 = *reinterpret_cast<const f32x4*>(p.a_ln_b + c0 + 4);
#pragma unroll
      for (int e = 0; e < 8; ++e) {
        const float wv = e < 4 ? w0[e & 3] : w1[e & 3], bv = e < 4 ? b0[e & 3] : b1[e & 3];
        vnT[(c0 + e) * 136 + pos] = f2bf((bf2f((bf16_t)raw[e]) - mu) * rstd * wv + bv);
      }
    }
  }
  __syncthreads();
  const int g8 = wid;
  const bf16_t* Wg = WSB + g8 * 128 * 128;
  for (int pb = 0; pb < 4; ++pb) {
    f32x16 acc[2];
#pragma unroll
    for (int r = 0; r < 16; ++r) { acc[0][r] = 0.f; acc[1][r] = 0.f; }
#pragma unroll
    for (int ks = 0; ks < 8; ++ks) {
      const bf16x8 bw = *reinterpret_cast<const bf16x8*>(Wg + (pb * 32 + r32) * 128 + ks * 16 + hi * 8);
#pragma unroll
      for (int db = 0; db < 2; ++db) {
        const bf16x8 a = *reinterpret_cast<const bf16x8*>(vnT + (g8 * 64 + db * 32 + r32) * 136 + ks * 16 + hi * 8);
        acc[db] = __builtin_amdgcn_mfma_f32_32x32x16_bf16(a, bw, acc[db], 0, 0, 0);
      }
    }
    const int token = t0 + pb * 32 + r32; const float bias = p.a_bs[g8 * 128 + pb * 32 + r32];
#pragma unroll
    for (int db = 0; db < 2; ++db)
#pragma unroll
      for (int rg = 0; rg < 4; ++rg) {
        const int c = g8 * 64 + db * 32 + rg * 8 + hi * 4;
        const u32x2 u2 = *reinterpret_cast<const u32x2*>(U + (size_t)token * 512 + c), z2 = *reinterpret_cast<const u32x2*>(ZA + (size_t)token * 512 + c);
        const float o0 = bflo(u2[0]) * (acc[db][rg * 4 + 0] + bias) * bflo(z2[0]), o1 = bfhi(u2[0]) * (acc[db][rg * 4 + 1] + bias) * bfhi(z2[0]);
        const float o2 = bflo(u2[1]) * (acc[db][rg * 4 + 2] + bias) * bflo(z2[1]), o3 = bfhi(u2[1]) * (acc[db][rg * 4 + 3] + bias) * bfhi(z2[1]);
        u32x2 pk = {cvtpk(o0, o1), cvtpk(o2, o3)};
        *reinterpret_cast<u32x2*>(MIX + (size_t)token * 1024 + c) = pk;
      }
  }
  __syncthreads();
}

DEVI void tr_tile(int wv, const float* __restrict__ src, bf16_t* __restrict__ dst, int K, int N, int tilesN, const float* __restrict__ scale, int t, char* lds) {
  const int tid = tidx(wv);
  const int k0 = (t / tilesN) * 64, n0 = (t % tilesN) * 64;
  const int kr = tid >> 3, ng = (tid & 7) * 8;
  f32x4 v0 = {0.f, 0.f, 0.f, 0.f}, v1 = {0.f, 0.f, 0.f, 0.f};
  if (n0 + ng < N) { const float* s = src + (size_t)(k0 + kr) * N + n0 + ng; v0 = *reinterpret_cast<const f32x4*>(s); v1 = *reinterpret_cast<const f32x4*>(s + 4); }
  const float scv = scale ? scale[k0 + kr] : 1.f;
  bf16_t* tl = (bf16_t*)lds;
#pragma unroll
  for (int e = 0; e < 4; ++e) { tl[(ng + e) * 72 + kr] = f2bf(v0[e] * scv); tl[(ng + 4 + e) * 72 + kr] = f2bf(v1[e] * scv); }
  __syncthreads();
  const int n = tid >> 3, kc = (tid & 7) * 8;
  *reinterpret_cast<bf16x8*>(dst + (size_t)(n0 + n) * K + k0 + kc) = *reinterpret_cast<const bf16x8*>(tl + n * 72 + kc);
}

DEVI void phase0(int wv, const Params& p, char* lds) {
  const int tid = tidx(wv);
  constexpr int N_ADA = 192, N_TR = 1952, N_WS = 16;
  for (int it = blockIdx.x; it < N_ADA + N_TR + N_WS + 1; it += gridDim.x) {
    if (it < N_ADA) {
      const int li = it / 96, chunk = it % 96;
      float* sc = (float*)lds;
      for (int idx = tid; idx < 17 * 1024; idx += 512) { const int r = idx >> 10, k = idx & 1023; const float xv = r < 16 ? p.c[r * 1024 + k] : p.c_ctx[k]; sc[idx] = xv / (1.f + expf(-xv)); }
      __syncthreads();
      const int col = tid & 31, kp = tid >> 5;
      const float* w = p.ada_w + (size_t)li * 1024 * 3072 + chunk * 32 + col;
      float acc[17];
#pragma unroll
      for (int r = 0; r < 17; ++r) acc[r] = 0.f;
#pragma unroll 8
      for (int k = kp * 64; k < kp * 64 + 64; ++k) {
        const float wv = w[(size_t)k * 3072];
#pragma unroll
        for (int r = 0; r < 17; ++r) acc[r] += sc[r * 1024 + k] * wv;
      }
      float* red = (float*)(lds + 17 * 1024 * 4);
#pragma unroll
      for (int r = 0; r < 17; ++r) red[(kp * 17 + r) * 32 + col] = acc[r];
      __syncthreads();
      float* ada = (float*)(p.ws + OFF_ADA);
      for (int idx = tid; idx < 544; idx += 512) {
        const int r = idx >> 5, cc = idx & 31; float s = 0.f;
        for (int k2 = 0; k2 < 16; ++k2) s += red[(k2 * 17 + r) * 32 + cc];
        ada[(size_t)(li * 17 + r) * 3072 + chunk * 32 + cc] = s + p.ada_b[li * 3072 + chunk * 32 + cc];
      }
    } else if (it < N_ADA + N_TR) {
      int t = it - N_ADA;
      if (t < 896) tr_tile(wv, p.even_w_in, (bf16_t*)(p.ws + OFF_W0IN), 1024, 3584, 56, nullptr, t, lds);
      else if (t < 1152) tr_tile(wv, p.even_w_out, (bf16_t*)(p.ws + OFF_W0OUT), 1024, 1024, 16, nullptr, t - 896, lds);
      else if (t < 1536) tr_tile(wv, p.odd_w_in, (bf16_t*)(p.ws + OFF_W1IN), 1024, 1472, 24, nullptr, t - 1152, lds);
      else if (t < 1632) tr_tile(wv, p.c_wq_b, (bf16_t*)(p.ws + OFF_WQ), 256, 1536, 24, p.c_q_norm_w, t - 1536, lds);
      else if (t < 1696) tr_tile(wv, p.c_wkv_b, (bf16_t*)(p.ws + OFF_WKV), 128, 2048, 32, p.c_kv_norm_w, t - 1632, lds);
      else tr_tile(wv, p.odd_w_out, (bf16_t*)(p.ws + OFF_W1OUT), 1024, 1024, 16, nullptr, t - 1696, lds);
    } else if (it < N_ADA + N_TR + N_WS) {
      const int base = (it - N_ADA - N_TR) * 8192 + tid * 16;
      bf16_t* dst = (bf16_t*)(p.ws + OFF_WSB) + base; const float* s = p.a_ws + base;
#pragma unroll
      for (int q = 0; q < 2; ++q) {
        const f32x4 a = *reinterpret_cast<const f32x4*>(s + q * 8), b = *reinterpret_cast<const f32x4*>(s + q * 8 + 4);
        u32x4 w = {cvtpk(a[0], a[1]), cvtpk(a[2], a[3]), cvtpk(b[0], b[1]), cvtpk(b[2], b[3])};
        *reinterpret_cast<u32x4*>(dst + q * 8) = w;
      }
    } else {
      float2* tab = (float2*)(p.ws + OFF_ROPE);
      for (int e = tid; e < 1024; e += 512) {
        const int pos = e >> 4, j = e & 15;
        const float inv = exp2f(-(float)j * (13.287712379549449f / 16.f));
        const float ang = (float)pos * inv;
        const float nrev = rintf(ang * 0.15915494309189535f);
        float rr = fmaf(-nrev, 6.2831855f, ang); rr = fmaf(-nrev, -1.7484555e-7f, rr);
        tab[e] = make_float2(__cosf(rr), __sinf(rr));
      }
    }
    __syncthreads();
  }
}

template <bool RES>
DEVI void norm_mod(int wv, const float* src_lat, const float* src_ctx, const float* __restrict__ nw, const float* __restrict__ ada, bf16_t* X,
                   int row_lo, int row_hi, int vb, int nvb, const float* __restrict__ ada_prev = nullptr, float* hdst_lat = nullptr, float* hdst_ctx = nullptr) {
  const int tid_ = tidx(wv); const int wid = tid_ >> 6, lane = tid_ & 63;
  for (int row0 = row_lo + (vb * 8 + wid) * 2; row0 < row_hi; row0 += nvb * 16) {
    f32x4 v[2][4]; u32x2 ov[2][4]; float ss[2];
#pragma unroll
    for (int q = 0; q < 2; ++q) {
      const int row = row0 + q;
      const float* src = row < NLAT ? src_lat + (size_t)row * 1024 : src_ctx + (size_t)(row - NLAT) * 1024;
      ss[q] = 0.f;
#pragma unroll
      for (int i = 0; i < 4; ++i) {
        v[q][i] = *reinterpret_cast<const f32x4*>(src + i * 256 + lane * 4);
        if constexpr (RES) ov[q][i] = *reinterpret_cast<const u32x2*>(X + (size_t)row * 1024 + i * 256 + lane * 4);
      }
    }
    if constexpr (RES) {
#pragma unroll
      for (int q = 0; q < 2; ++q) {
        const int row = row0 + q;
        const float* gp = ada_prev + (row < NLAT ? (row >> 11) : 16) * 3072 + 2048;
        float* hd = row < NLAT ? hdst_lat + (size_t)row * 1024 : hdst_ctx + (size_t)(row - NLAT) * 1024;
#pragma unroll
        for (int i = 0; i < 4; ++i) {
          const int c = i * 256 + lane * 4;
          const f32x4 g = *reinterpret_cast<const f32x4*>(gp + c);
          v[q][i][0] += g[0] * bflo(ov[q][i][0]); v[q][i][1] += g[1] * bfhi(ov[q][i][0]); v[q][i][2] += g[2] * bflo(ov[q][i][1]); v[q][i][3] += g[3] * bfhi(ov[q][i][1]);
          *reinterpret_cast<f32x4*>(hd + c) = v[q][i];
        }
      }
    }
#pragma unroll
    for (int q = 0; q < 2; ++q) {
#pragma unroll
      for (int i = 0; i < 4; ++i) ss[q] += v[q][i][0] * v[q][i][0] + v[q][i][1] * v[q][i][1] + v[q][i][2] * v[q][i][2] + v[q][i][3] * v[q][i][3];
      ss[q] = wave_sum(ss[q]);
    }
#pragma unroll
    for (int q = 0; q < 2; ++q) {
      const int row = row0 + q;
      const float* ad = ada + (row < NLAT ? (row >> 11) : 16) * 3072;
      const float r = rsqrtf(ss[q] * (1.f / 1024.f) + 1e-6f);
#pragma unroll
      for (int i = 0; i < 4; ++i) {
        const int c = i * 256 + lane * 4;
        const f32x4 w = *reinterpret_cast<const f32x4*>(nw + c), sh = *reinterpret_cast<const f32x4*>(ad + c), scl = *reinterpret_cast<const f32x4*>(ad + 1024 + c);
        float o[4];
#pragma unroll
        for (int e = 0; e < 4; ++e) o[e] = v[q][i][e] * r * w[e] * (1.f + scl[e]) + sh[e];
        u32x2 pk = {cvtpk(o[0], o[1]), cvtpk(o[2], o[3])};
        *reinterpret_cast<u32x2*>(X + (size_t)row * 1024 + c) = pk;
      }
    }
  }
}

DEVI void final_norm(int wv, float* out, const float* __restrict__ fw, const bf16_t* __restrict__ O1, const float* __restrict__ ada1) {
  const int tid_ = tidx(wv); const int wid = tid_ >> 6, lane = tid_ & 63;
  for (int row0 = (blockIdx.x * 8 + wid) * 2; row0 < NLAT; row0 += gridDim.x * 16) {
    f32x4 v[2][4]; u32x2 ov[2][4]; float ss[2];
#pragma unroll
    for (int q = 0; q < 2; ++q) {
      ss[q] = 0.f;
#pragma unroll
      for (int i = 0; i < 4; ++i) {
        v[q][i] = *reinterpret_cast<const f32x4*>(out + (size_t)(row0 + q) * 1024 + i * 256 + lane * 4);
        ov[q][i] = *reinterpret_cast<const u32x2*>(O1 + (size_t)(row0 + q) * 1024 + i * 256 + lane * 4);
      }
    }
#pragma unroll
    for (int q = 0; q < 2; ++q) {
      const float* gp = ada1 + ((row0 + q) >> 11) * 3072 + 2048;
#pragma unroll
      for (int i = 0; i < 4; ++i) {
        const f32x4 g = *reinterpret_cast<const f32x4*>(gp + i * 256 + lane * 4);
        v[q][i][0] += g[0] * bflo(ov[q][i][0]); v[q][i][1] += g[1] * bfhi(ov[q][i][0]); v[q][i][2] += g[2] * bflo(ov[q][i][1]); v[q][i][3] += g[3] * bfhi(ov[q][i][1]);
        ss[q] += v[q][i][0] * v[q][i][0] + v[q][i][1] * v[q][i][1] + v[q][i][2] * v[q][i][2] + v[q][i][3] * v[q][i][3];
      }
      ss[q] = wave_sum(ss[q]);
    }
#pragma unroll
    for (int q = 0; q < 2; ++q) {
      const float r = rsqrtf(ss[q] * (1.f / 1024.f) + 1e-6f);
#pragma unroll
      for (int i = 0; i < 4; ++i) {
        const int c = i * 256 + lane * 4;
        const f32x4 w = *reinterpret_cast<const f32x4*>(fw + c);
        *reinterpret_cast<f32x4*>(out + (size_t)(row0 + q) * 1024 + c) = v[q][i] * r * w;
      }
    }
  }
}

typedef const __attribute__((address_space(4))) Params* KArgP;
DEVI void run_phase(int wv, KArgP pp, int ph, char* lds) {
#if defined(__HIP_DEVICE_COMPILE__)
  asm volatile("" : "+s"(pp));
  char* ws = pp->ws;
  const float2* rope = (const float2*)(ws + OFF_ROPE);
  const float* ada0 = (const float*)(ws + OFF_ADA); const float* ada1 = ada0 + 17 * 3072;
  bf16_t* X = (bf16_t*)(ws + OFF_X); bf16_t* MIX = (bf16_t*)(ws + OFF_MIX);
  const int G = gridDim.x, B = blockIdx.x;
  PG8_LAS unsigned char* ldsp = (PG8_LAS unsigned char*)lds;
  switch (ph) {
    case 0: { const Params p = *pp; phase0(wv, p, lds); } break;
    case 1: norm_mod<false>(wv, pp->x, pp->ctx, pp->norm_w, ada0, X, 0, NTOK, B, G); break;
    case 2: {
      EpiL0In epi{(bf16_t*)(ws + OFF_U), (bf16_t*)(ws + OFF_GV), (bf16_t*)(ws + OFF_ZA), (bf16_t*)(ws + OFF_ZB), (bf16_t*)(ws + OFF_Q0), (bf16_t*)(ws + OFF_K0), (bf16_t*)(ws + OFF_V0), rope};
      gemm_phase(wv, ldsp, X, (const bf16_t*)(ws + OFF_W0IN), 1024, Sched{14, 144 * 14, 144 * 14, 0, 0}, epi);
    } break;
    case 3: { const Params p = *pp;
      for (int it = B; it < 1024 + 288 + 128; it += G) {
        if (it < 1024) {
          const int xcd = it & 7, slot = (it >> 3) & 31, rd = it >> 8;
          const int bh = rd * 16 + xcd * 2 + (slot >> 4), qb = slot & 15, b = bh >> 2, h = bh & 3;
          attn0_item(wv, p, b * 2048 + qb * 128, b, h, KVL, lds);
        } else if (it < 1024 + 288) abranch_item(wv, p, it - 1024, lds);
        else { const int i2 = it - 1312; const int b = i2 >> 3, h = (i2 >> 1) & 3, qb = i2 & 1; attn0_item(wv, p, NLAT + b * 256 + qb * 128, b, h, 256, lds); }
      }
    } break;
    case 4: {
      EpiPlain epi{X};
      gemm_phase(wv, ldsp, MIX, (const bf16_t*)(ws + OFF_W0OUT), 1024, Sched{4, 144 * 4, 144 * 4, 0, 0}, epi);
    } break;
    case 5: {
      if (B >= G - 16) {
        const int cp = B - (G - 16);
        norm_mod<true>(wv, pp->x, pp->ctx, pp->norm_w + 1024, ada1, X, NLAT + cp * 256, NLAT + cp * 256 + 256, 0, 1, ada0, pp->out, (float*)(ws + OFF_H1C));
        asm volatile("s_waitcnt vmcnt(0)" ::: "memory"); __syncthreads();
        EpiL1In epi{(bf16_t*)(ws + OFF_CQ), (bf16_t*)(ws + OFF_CKV), (bf16_t*)(ws + OFF_K1), (bf16_t*)(ws + OFF_Z1), (float*)(ws + OFF_RQ), (float*)(ws + OFF_RKV), rope, (float*)(lds + LDS_SS)};
        gemm_phase(wv, ldsp, X, (const bf16_t*)(ws + OFF_W1IN), 1024, Sched{6, 0, 16, 128, 1, G - 16}, epi);
      } else norm_mod<true>(wv, pp->x, pp->ctx, pp->norm_w + 1024, ada1, X, 0, NLAT, B, G - 16, ada0, pp->out, (float*)(ws + OFF_H1C));
    } break;
    case 6: {
      EpiL1In epi{(bf16_t*)(ws + OFF_CQ), (bf16_t*)(ws + OFF_CKV), (bf16_t*)(ws + OFF_K1), (bf16_t*)(ws + OFF_Z1), (float*)(ws + OFF_RQ), (float*)(ws + OFF_RKV), rope, (float*)(lds + LDS_SS)};
      gemm_phase(wv, ldsp, X, (const bf16_t*)(ws + OFF_W1IN), 1024, Sched{6, 768, 768, 128, 1}, epi);
    } break;
    case 7: {
      EpiQ eq{(bf16_t*)(ws + OFF_Q1), (const float*)(ws + OFF_RQ), rope};
      EpiKV ek{(bf16_t*)(ws + OFF_K1), (bf16_t*)(ws + OFF_V1), (const float*)(ws + OFF_RKV)};
      gemm_phase(wv, ldsp, (const bf16_t*)(ws + OFF_CQ), (const bf16_t*)(ws + OFF_WQ), 256, Sched{6, 768, 768, 0, 0}, eq);
      gemm_phase(wv, ldsp, (const bf16_t*)(ws + OFF_CKV), (const bf16_t*)(ws + OFF_WKV), 128, Sched{8, 1152, 1152, 0, 0}, ek);
    } break;
    case 8: { const Params p = *pp;
      for (int it = B; it < 1024; it += G) {
        const int xcd = it & 7, slot = (it >> 3) & 31, rd = it >> 8;
        const int bh = rd * 32 + xcd * 4 + (slot >> 3), qb = slot & 7;
        attn1_item(wv, p, bh >> 3, bh & 7, qb, lds);
      }
    } break;
    case 9: {
      EpiPlain epi{X};
      gemm_phase(wv, ldsp, MIX, (const bf16_t*)(ws + OFF_W1OUT), 1024, Sched{4, 128 * 4, 128 * 4, 0, 0}, epi);
    } break;
    case 10: final_norm(wv, pp->out, pp->final_w, X, ada1); break;
  }
#endif
}


#define XB_TMO      128
#define XB_XCNT(j)  (256  + 64 * (j))
#define XB_XSUB(j)  (1280 + 64 * (j))
#define XB_XGEN(j)  (2304 + 64 * (j))
#define XB_TOP      3328
#define XB_TOPGEN   3392
#define XCD_BAR_WORDS 3456
#define XB_SPIN_CAP (1u << 18)
#define LAS __attribute__((address_space(3)))
DEVI unsigned xb_ld(unsigned* p) { return __hip_atomic_load(p, __ATOMIC_RELAXED, __HIP_MEMORY_SCOPE_AGENT); }
DEVI unsigned xb_add(unsigned* p, unsigned v) { return __hip_atomic_fetch_add(p, v, __ATOMIC_RELAXED, __HIP_MEMORY_SCOPE_AGENT); }
DEVI unsigned xb_xcc_id() { return (unsigned)__builtin_amdgcn_s_getreg((3 << 11) | 20) & 0xFu; }
#define XB_SPIN(cond, bar) do { unsigned _sp = 0; while (cond) { __builtin_amdgcn_s_sleep(1); \
    if ((++_sp & 255u) == 0u) { if (xb_ld(&(bar)[XB_TMO])) break; if (_sp > XB_SPIN_CAP) { atomicAdd(&(bar)[XB_TMO], 1u); break; } } } } while (0)
struct XcdBarrier { unsigned* bar; unsigned x; volatile LAS unsigned* st; };
DEVI XcdBarrier xcd_barrier_post(int wv, unsigned* bar, volatile LAS unsigned* st) {
  XcdBarrier b; b.bar = bar; b.x = xb_xcc_id(); b.st = st;
  if (tidx(wv) == 0) (void)xb_add(&bar[XB_XCNT(b.x)], 1u);
  return b;
}
DEVI void xcd_barrier_complete(unsigned* bar, unsigned x, unsigned& nloc, unsigned& nx) {
  const unsigned G = gridDim.x * gridDim.y * gridDim.z;
  unsigned sum, cnt, mine, sp = 0u;
  for (;;) {
    sum = 0u; cnt = 0u; mine = 0u;
#pragma unroll
    for (unsigned j = 0; j < 16; ++j) { const unsigned c = xb_ld(&bar[XB_XCNT(j)]); sum += c; cnt += (c > 0u) ? 1u : 0u; mine = (j == x) ? c : mine; }
    if (sum == G) break;
    __builtin_amdgcn_s_sleep(1);
    if ((++sp & 255u) == 0u) { if (xb_ld(&bar[XB_TMO])) break; if (sp > XB_SPIN_CAP) { atomicAdd(&bar[XB_TMO], 1u); break; } }
  }
  nloc = mine > 0u ? mine : 1u; nx = cnt > 0u ? cnt : 1u;
}
DEVI void xcd_barrier(int wv, const XcdBarrier& b) {
  asm volatile("s_waitcnt vmcnt(0)" ::: "memory");
  __syncthreads();
  if (tidx(wv) == 0) {
    unsigned* bar = b.bar;
    __builtin_amdgcn_s_waitcnt(0);
    unsigned nloc = b.st[0], nx = b.st[1];
    if (nloc == 0u) { xcd_barrier_complete(bar, b.x, nloc, nx); b.st[0] = nloc; b.st[1] = nx; }
    const unsigned old = xb_add(&bar[XB_XSUB(b.x)], 1u);
    const unsigned gen = old / nloc;
    if (old + 1u == (gen + 1u) * nloc) {
      __builtin_amdgcn_fence(__ATOMIC_RELEASE, "agent");
      asm volatile("s_waitcnt vmcnt(0)" ::: "memory");
      const unsigned og = xb_add(&bar[XB_TOP], 1u);
      const unsigned tg = og / nx;
      if (og + 1u == (tg + 1u) * nx) xb_add(&bar[XB_TOPGEN], 1u);
      else XB_SPIN(xb_ld(&bar[XB_TOPGEN]) == tg, bar);
      __builtin_amdgcn_fence(__ATOMIC_ACQUIRE, "agent");
      xb_add(&bar[XB_XGEN(b.x)], 1u);
      asm volatile("s_waitcnt vmcnt(0)" ::: "memory");
    } else {
      XB_SPIN(xb_ld(&bar[XB_XGEN(b.x)]) == gen, bar);
      __builtin_amdgcn_fence(__ATOMIC_ACQUIRE, "agent");
      asm volatile("s_waitcnt vmcnt(0)" ::: "memory");
    }
  }
  __syncthreads();
}

extern __shared__ __attribute__((aligned(16))) char g_lds[];

constexpr int LDS_XB = 143360;
__global__ void __launch_bounds__(512) mega(Params p) {
  cg::grid_group grid = cg::this_grid();
  if (p.ph_hi > 64) grid.sync();
  const int wv = __builtin_amdgcn_readfirstlane((int)threadIdx.x >> 6);
  volatile LAS unsigned* xst = (volatile LAS unsigned*)(g_lds + LDS_XB);
  if (tidx(wv) == 0) { xst[0] = 0u; xst[1] = 0u; }
  __syncthreads();
  (void)xcd_barrier_post(wv, (unsigned*)(p.ws + OFF_BAR), xst);
#define GRID_BARRIER() do { KArgP _pp = (KArgP)__builtin_amdgcn_kernarg_segment_ptr(); asm volatile("" : "+s"(_pp)); \
    XcdBarrier _xb; _xb.bar = (unsigned*)(_pp->ws + OFF_BAR); _xb.x = xb_xcc_id(); _xb.st = (volatile LAS unsigned*)(g_lds + LDS_XB); xcd_barrier(wv, _xb); } while (0)
  for (int ph = p.ph_lo; ph < p.ph_hi; ++ph) {
    run_phase(wv, (KArgP)__builtin_amdgcn_kernarg_segment_ptr(), ph, g_lds);
#ifdef PROBE_PH
    if (ph == PROBE_PH) { GRID_BARRIER(); run_phase(wv, (KArgP)__builtin_amdgcn_kernarg_segment_ptr(), ph, g_lds); }
#endif
    if (ph + 1 < p.ph_hi) GRID_BARRIER();
  }
}

extern "C" void kernel_launch(void* const* d_in, const int* in_sizes, int n_in, void* d_out, int out_size, void* d_ws, size_t ws_size, hipStream_t stream) {
  static int ok = 0;
  static int grid_blocks = 0;
  if (!ok) {
    if (n_in != 25 || ws_size < WS_NEED) { fprintf(stderr, "kernel_launch: bad args n_in %d ws %zu need %zu\n", n_in, ws_size, (size_t)WS_NEED); return; }
    if (hipFuncSetAttribute((const void*)mega, hipFuncAttributeMaxDynamicSharedMemorySize, LDS_BYTES) != hipSuccess) { fprintf(stderr, "kernel_launch: LDS attr failed\n"); return; }
    int dev = 0, cus = 0, per_cu = 0;
    hipGetDevice(&dev);
    hipDeviceGetAttribute(&cus, hipDeviceAttributeMultiprocessorCount, dev);
    hipOccupancyMaxActiveBlocksPerMultiprocessor(&per_cu, mega, 512, LDS_BYTES);
    if (per_cu < 1) per_cu = 1;
    grid_blocks = cus * per_cu;
    ok = 1;
  }
  Params p{};
  const float** pp = (const float**)&p;
  for (int i = 0; i < 25; ++i) pp[i] = (const float*)d_in[i];
  p.out = (float*)d_out; p.ws = (char*)d_ws;
#if ONE_LAUNCH
  p.ph_lo = 0; p.ph_hi = 11;
  hipMemsetAsync((char*)d_ws + OFF_BAR, 0, XCD_BAR_WORDS * 4, stream);
  void* args[] = {&p};
  hipError_t e = hipLaunchCooperativeKernel((const void*)mega, dim3(grid_blocks), dim3(512), args, LDS_BYTES, stream);
  if (e != hipSuccess) fprintf(stderr, "cooperative launch failed: %s (grid %d)\n", hipGetErrorString(e), grid_blocks);
#else
  for (int ph = 0; ph < 11; ++ph) {
    p.ph_lo = ph; p.ph_hi = ph + 1;
    hipLaunchKernelGGL(mega, dim3(grid_blocks), dim3(512), LDS_BYTES, stream, p);
  }
#endif
}
```

```cpp
#include <hip/hip_runtime.h>
#include <hip/hip_cooperative_groups.h>
#include <cstdio>
namespace cg = cooperative_groups;

#ifndef ATT_SD0
#define ATT_SD0 2
#endif
#ifndef ONE_LAUNCH
#define ONE_LAUNCH 1
#endif

typedef unsigned short bf16_t;
typedef short bf16x8 __attribute__((ext_vector_type(8)));
typedef short s16x4 __attribute__((ext_vector_type(4)));
typedef float f32x16 __attribute__((ext_vector_type(16)));
typedef float f32x4 __attribute__((ext_vector_type(4)));
typedef unsigned u32x4 __attribute__((ext_vector_type(4)));
typedef unsigned u32x2 __attribute__((ext_vector_type(2)));
#define DEVI __device__ __forceinline__
#define SBAR() __builtin_amdgcn_sched_barrier(0)
DEVI int tidx(int wv) { int l; asm volatile("v_mbcnt_lo_u32_b32 %0, -1, 0\n\tv_mbcnt_hi_u32_b32 %0, -1, %0" : "=v"(l)); return (wv << 6) | l; }

constexpr int NLAT = 32768, NCTX = 4096, NTOK = 36864, KVL = 2304;
constexpr int LDS_BYTES = 147456, LDS_SS = 139264;

constexpr size_t OFF_W0IN = 0;
constexpr size_t OFF_W0OUT = OFF_W0IN + 3584ull * 1024 * 2;
constexpr size_t OFF_W1IN = OFF_W0OUT + 1024ull * 1024 * 2;
constexpr size_t OFF_WQ = OFF_W1IN + 1536ull * 1024 * 2;
constexpr size_t OFF_WKV = OFF_WQ + 1536ull * 256 * 2;
constexpr size_t OFF_W1OUT = OFF_WKV + 2048ull * 128 * 2;
constexpr size_t OFF_WSB = OFF_W1OUT + 1024ull * 1024 * 2;
constexpr size_t OFF_ADA = OFF_WSB + 8ull * 128 * 128 * 2;
constexpr size_t OFF_ROPE = OFF_ADA + 2ull * 17 * 3072 * 4;
constexpr size_t OFF_BAR = OFF_ROPE + 64ull * 16 * 8;
constexpr size_t OFF_H1C = OFF_BAR + 16384;
constexpr size_t OFF_RQ = OFF_H1C + 4096ull * 1024 * 4;
constexpr size_t OFF_RKV = OFF_RQ + 32768ull * 4;
constexpr size_t OFF_X = OFF_RKV + 36864ull * 4;
constexpr size_t OFF_MIX = OFF_X + 36864ull * 1024 * 2;
constexpr size_t OFF_T = OFF_MIX + 36864ull * 1024 * 2;
constexpr size_t SZ_HALF = 36864ull * 512 * 2;
constexpr size_t OFF_U = OFF_T, OFF_GV = OFF_U + SZ_HALF, OFF_ZA = OFF_GV + SZ_HALF, OFF_ZB = OFF_ZA + SZ_HALF, OFF_Q0 = OFF_ZB + SZ_HALF;
constexpr size_t OFF_K0 = OFF_Q0 + SZ_HALF, OFF_V0 = OFF_K0 + 16ull * 4 * KVL * 128 * 2, END_L0 = OFF_V0 + 16ull * 4 * KVL * 128 * 2;
constexpr size_t OFF_CQ = OFF_T, OFF_CKV = OFF_CQ + 32768ull * 256 * 2, OFF_Z1 = OFF_CKV + 36864ull * 128 * 2;
constexpr size_t OFF_Q1 = OFF_Z1 + 32768ull * 1024 * 2, OFF_K1 = OFF_Q1 + 32768ull * 1536 * 2, END_L1 = OFF_K1 + 16ull * 8 * KVL * 192 * 2;
constexpr size_t OFF_V1 = OFF_X;
constexpr size_t WS_NEED = END_L1 > END_L0 ? END_L1 : END_L0;

struct Params {
  const float *x, *c, *ctx, *c_ctx, *norm_w, *ada_w, *ada_b, *even_w_in, *a_ws, *a_bs, *a_ln_w, *a_ln_b,
      *b_lq1, *b_lk1, *b_lq2, *b_lk2, *b_subln_w, *even_w_out, *odd_w_in, *c_q_norm_w, *c_wq_b,
      *c_kv_norm_w, *c_wkv_b, *odd_w_out, *final_w;
  float* out; char* ws; int ph_lo, ph_hi;
};

DEVI unsigned cvtpk(float lo, float hi) { unsigned r; asm("v_cvt_pk_bf16_f32 %0, %1, %2" : "=v"(r) : "v"(lo), "v"(hi)); return r; }
DEVI bf16_t f2bf(float v) { return (bf16_t)(cvtpk(v, 0.f) & 0xffffu); }
DEVI float bf2f(bf16_t v) { return __uint_as_float(((unsigned)v) << 16); }
DEVI float bflo(unsigned w) { return __uint_as_float(w << 16); }
DEVI float bfhi(unsigned w) { return __uint_as_float(w & 0xffff0000u); }
DEVI int crow(int r, int hi) { return (r & 3) + 8 * (r >> 2) + 4 * hi; }
DEVI float silu_f(float x) { return x * __builtin_amdgcn_rcpf(1.f + __builtin_amdgcn_exp2f(x * -1.4426950408889634f)); }
DEVI float gelu_f(float v) {
  const float t = __builtin_amdgcn_rcpf(fmaf(fabsf(v), 0.2316418882f, 1.0f));
  float q = fmaf(t, 0.5307027145f, -0.7265760135f); q = fmaf(q, t, 0.7107068705f); q = fmaf(q, t, -0.142248368f); q = fmaf(q, t, 0.127414796f); q *= t;
  const float m = v * (q * __builtin_amdgcn_exp2f(v * v * -0.72134752044f));
  return v < 0.f ? m : v - m;
}

template <int M> DEVI float xsum(float v) {
  if constexpr (M == 32) { auto rr = __builtin_amdgcn_permlane32_swap(__float_as_uint(v), __float_as_uint(v), false, false); return __uint_as_float(rr[0]) + __uint_as_float(rr[1]); }
  else return v + __int_as_float(__builtin_amdgcn_ds_swizzle(__float_as_int(v), (M << 10) | 0x1f));
}
DEVI float wave_sum(float v) { v = xsum<1>(v); v = xsum<2>(v); v = xsum<4>(v); v = xsum<8>(v); v = xsum<16>(v); return xsum<32>(v); }

DEVI void rope_tile(f32x16& v, const float2* __restrict__ tab, int pos, int hi) {
#pragma unroll
  for (int r = 0; r < 8; ++r) {
    const int jf = (r & 3) + 8 * (r >> 2) + 4 * hi;
    const float2 cs = tab[pos * 16 + jf];
    const float a = v[r], b = v[r + 8];
    v[r] = a * cs.x - b * cs.y; v[r + 8] = b * cs.x + a * cs.y;
  }
}
DEVI void store4(bf16_t* dst, const f32x16& v, int rg) {
  u32x2 pk = {cvtpk(v[rg * 4 + 0], v[rg * 4 + 1]), cvtpk(v[rg * 4 + 2], v[rg * 4 + 3])};
  *reinterpret_cast<u32x2*>(dst) = pk;
}

#define PG8_LAS __attribute__((address_space(3)))
constexpr int HTB = 128 * 64 * 2;
DEVI int lds_byte(int r, int c) { const int st = (r >> 4) * 2 + (c >> 5), rr = r & 15, cc = c & 31, ob = rr * 64 + cc * 2; return st * 1024 + (ob ^ (((ob >> 9) & 1) << 5)); }
DEVI void stage_rc(int b, int& R, int& C) { const int st = b / 1024, sb = b % 1024, swz = sb ^ (((sb >> 9) & 1) << 5); R = (st >> 1) * 16 + swz / 64; C = (st & 1) * 32 + (swz % 64) / 2; }
DEVI int perm32(int rho) { const int n = rho >> 4, i = rho & 15; return 8 * (i >> 2) + 4 * n + (i & 3); }
struct Unit { int pm, pn; };
struct Sched {
  int nN, nmain, ntotal, xpm0, xpn, boff = 0;
  DEVI bool next(int i, Unit& u) const {
    const int it = (int)blockIdx.x - boff + i * (int)gridDim.x; if (it < 0 || it >= ntotal) return false;
    if (it < nmain) { const int xcd = it & 7, jx = it >> 3; u.pm = (jx / nN) * 8 + xcd; u.pn = jx % nN; } else { u.pm = xpm0 + (it - nmain); u.pn = xpn; }
    return true;
  }
};
template <class Epi>
DEVI void gemm_phase(int wv, PG8_LAS unsigned char* lds, const bf16_t* gA, const bf16_t* gBt, const int K, const Sched& S, const Epi& E) {
  const int tid = tidx(wv), wid = __builtin_amdgcn_readfirstlane(tid >> 6), lane = tid & 63, wr = wid >> 2, wc = wid & 3, fr = lane & 15, fq = lane >> 4;
  const int nt = K / 64;
  unsigned voffA[2], voffB[2];
#pragma unroll
  for (int i = 0; i < 2; ++i) { int R, C; stage_rc(tid * 16 + i * 8192, R, C); const int Rb = (R & ~31) + perm32(R & 31); voffA[i] = (unsigned)(R * K + C) * 2u; voffB[i] = (unsigned)(Rb * K + C) * 2u; }
  const size_t kstep = (size_t)(64 * 2);
  const size_t hstep = (size_t)128 * K * 2;
  const size_t tstep = 2 * hstep;
  const unsigned ldsw = (unsigned)wid * 1024u;
  const int aoff = lds_byte(wr * 64 + fr, fq * 8), boff = lds_byte(wc * 32 + fr, fq * 8);
#define PG8_SA(b, h) (((b) * 2 + (h)) * HTB)
#define PG8_SB(b, h) ((4 + (b) * 2 + (h)) * HTB)
#define PG8_STAGE(bufoff, gbase, voff) do { _Pragma("unroll") for (int _i = 0; _i < 2; ++_i) \
    __builtin_amdgcn_global_load_lds((const unsigned*)((const char*)(gbase) + (voff)[_i]), (PG8_LAS unsigned*)(lds + (bufoff) + ldsw + _i * 8192), 16, 0, 0); } while (0)
#define PG8_LDA(dst, b, h) do { _Pragma("unroll") for (int m = 0; m < 4; ++m) _Pragma("unroll") for (int k = 0; k < 2; ++k) dst[m][k] = *(const PG8_LAS bf16x8*)(lds + PG8_SA(b, h) + aoff + m * 2048 + k * 1024); } while (0)
#define PG8_LDB(dst, b, h) do { _Pragma("unroll") for (int n = 0; n < 2; ++n) _Pragma("unroll") for (int k = 0; k < 2; ++k) dst[n][k] = *(const PG8_LAS bf16x8*)(lds + PG8_SB(b, h) + boff + n * 2048 + k * 1024); } while (0)
#define PG8_MMA(ai, bj, At, Bt) do { __builtin_amdgcn_s_setprio(1); _Pragma("unroll") for (int m = 0; m < 4; ++m) _Pragma("unroll") for (int n = 0; n < 2; ++n) _Pragma("unroll") for (int k = 0; k < 2; ++k) \
    acc[ai][bj][m][n] = __builtin_amdgcn_mfma_f32_16x16x32_bf16(Bt[n][k], At[m][k], acc[ai][bj][m][n], 0, 0, 0); __builtin_amdgcn_s_setprio(0); } while (0)
#define PG8_WAIT_V(n) asm volatile("s_waitcnt vmcnt(" #n ")" ::: "memory")
#define PG8_WAIT_L(n) asm volatile("s_waitcnt lgkmcnt(" #n ")" ::: "memory")
#define PG8_BAR __builtin_amdgcn_s_barrier()
#define PG8_SCHED __builtin_amdgcn_sched_barrier(0)
  Unit cur, nxt; int ui = 0;
  if (!S.next(0, cur)) return;
  f32x4 acc[2][2][4][2];
#pragma unroll
  for (int a = 0; a < 2; ++a)
#pragma unroll
    for (int b = 0; b < 2; ++b)
#pragma unroll
      for (int m = 0; m < 4; ++m)
#pragma unroll
        for (int n = 0; n < 2; ++n) acc[a][b][m][n] = (f32x4){0.f, 0.f, 0.f, 0.f};
  bf16x8 At[4][2], B0[2][2], B1[2][2];
  const char* cA = (const char*)gA + (size_t)cur.pm * tstep; const char* cB = (const char*)gBt + (size_t)cur.pn * tstep;
  PG8_STAGE(PG8_SB(0, 0), cB, voffB); PG8_STAGE(PG8_SA(0, 0), cA, voffA); PG8_STAGE(PG8_SB(0, 1), cB + hstep, voffB); PG8_STAGE(PG8_SA(0, 1), cA + hstep, voffA);
  if (wr == 1) PG8_BAR;
  PG8_WAIT_V(4); PG8_BAR;
  PG8_STAGE(PG8_SB(1, 0), cB + kstep, voffB); PG8_STAGE(PG8_SA(1, 0), cA + kstep, voffA); PG8_STAGE(PG8_SB(1, 1), cB + hstep + kstep, voffB);
  PG8_WAIT_V(6); PG8_BAR;
  for (;;) {
    const bool has_next = S.next(ui + 1, nxt);
    const char* nA = has_next ? (const char*)gA + (size_t)nxt.pm * tstep : cA; const char* nB = has_next ? (const char*)gBt + (size_t)nxt.pn * tstep : cB;
#pragma unroll 1
    for (int t = 0; t < nt; t += 2) {
      const bool last = (t == nt - 2);
      const char* a1 = cA + (size_t)(t + 1) * kstep;
      const char* a2 = last ? nA : cA + (size_t)(t + 2) * kstep; const char* b2 = last ? nB : cB + (size_t)(t + 2) * kstep;
      const char* a3 = a2 + kstep; const char* b3 = b2 + kstep;
      PG8_LDB(B0, 0, 0); PG8_SCHED; PG8_LDA(At, 0, 0); PG8_STAGE(PG8_SA(1, 1), a1 + hstep, voffA);
      PG8_WAIT_L(8); PG8_BAR; PG8_WAIT_L(0); PG8_MMA(0, 0, At, B0); PG8_BAR; PG8_SCHED;
      PG8_LDB(B1, 0, 1); PG8_STAGE(PG8_SB(0, 0), b2, voffB);
      PG8_BAR; PG8_WAIT_L(0); PG8_MMA(0, 1, At, B1); PG8_BAR;
      PG8_LDA(At, 0, 1); PG8_STAGE(PG8_SA(0, 0), a2, voffA);
      PG8_BAR; PG8_WAIT_L(0); PG8_MMA(1, 0, At, B0); PG8_BAR; PG8_SCHED;
      PG8_STAGE(PG8_SB(0, 1), b2 + hstep, voffB);
      PG8_WAIT_V(6); PG8_BAR; PG8_MMA(1, 1, At, B1); PG8_BAR;
      PG8_LDB(B0, 1, 0); PG8_SCHED; PG8_LDA(At, 1, 0); PG8_STAGE(PG8_SA(0, 1), a2 + hstep, voffA);
      PG8_WAIT_L(8); PG8_BAR; PG8_WAIT_L(0); PG8_MMA(0, 0, At, B0); PG8_BAR; PG8_SCHED;
      PG8_LDB(B1, 1, 1); PG8_STAGE(PG8_SB(1, 0), b3, voffB);
      PG8_BAR; PG8_WAIT_L(0); PG8_MMA(0, 1, At, B1); PG8_BAR;
      PG8_LDA(At, 1, 1); PG8_STAGE(PG8_SA(1, 0), a3, voffA);
      PG8_BAR; PG8_WAIT_L(0); PG8_MMA(1, 0, At, B0); PG8_BAR; PG8_SCHED;
      PG8_STAGE(PG8_SB(1, 1), b3 + hstep, voffB);
      PG8_WAIT_V(6); PG8_BAR; PG8_MMA(1, 1, At, B1); PG8_BAR;
    }
    E(acc, cur, wr, wc, fr, fq);
    if (!has_next) break;
#pragma unroll
    for (int a = 0; a < 2; ++a)
#pragma unroll
      for (int b = 0; b < 2; ++b)
#pragma unroll
        for (int m = 0; m < 4; ++m)
#pragma unroll
          for (int n = 0; n < 2; ++n) acc[a][b][m][n] = (f32x4){0.f, 0.f, 0.f, 0.f};
    cur = nxt; cA = nA; cB = nB; ++ui;
  }
  PG8_WAIT_V(0);
  if (wr == 0) PG8_BAR;
  PG8_BAR;
#undef PG8_SA
#undef PG8_SB
#undef PG8_STAGE
#undef PG8_LDA
#undef PG8_LDB
#undef PG8_MMA
#undef PG8_WAIT_V
#undef PG8_WAIT_L
#undef PG8_BAR
#undef PG8_SCHED
}

typedef f32x4 acc_t[2][2][4][2];
DEVI void token_info(int token, bool ctx, int& b, int& s, int& key) {
  if (!ctx) { b = token >> 11; s = token & 2047; key = 256 + s; } else { const int tc = token - NLAT; b = tc >> 8; s = 0; key = tc & 255; }
}
DEVI float swap32_partner(float v, bool upper) {
  auto rr = __builtin_amdgcn_permlane32_swap(__float_as_uint(v), __float_as_uint(v), false, false);
  return __uint_as_float(upper ? rr[0] : rr[1]);
}
DEVI void rope_pair(f32x4& v0, f32x4& v1, const float2* __restrict__ tab, int pos, int fq) {
  const bool upper = fq >= 2;
  const float2* t = tab + pos * 16 + (fq & 1) * 8;
  const f32x4 t0 = *reinterpret_cast<const f32x4*>(t), t1 = *reinterpret_cast<const f32x4*>(t + 2), t2 = *reinterpret_cast<const f32x4*>(t + 4), t3 = *reinterpret_cast<const f32x4*>(t + 6);
  const float cs[8] = {t0[0], t0[2], t1[0], t1[2], t2[0], t2[2], t3[0], t3[2]}, sn[8] = {t0[1], t0[3], t1[1], t1[3], t2[1], t2[3], t3[1], t3[3]};
#pragma unroll
  for (int e = 0; e < 4; ++e) {
    const float p0 = swap32_partner(v0[e], upper), p1 = swap32_partner(v1[e], upper);
    const float s0 = upper ? sn[e] : -sn[e], s1 = upper ? sn[4 + e] : -sn[4 + e];
    v0[e] = v0[e] * cs[e] + p0 * s0; v1[e] = v1[e] * cs[4 + e] + p1 * s1;
  }
}
DEVI void st8(bf16_t* dst, const f32x4& v0, const f32x4& v1) { u32x4 pk = {cvtpk(v0[0], v0[1]), cvtpk(v0[2], v0[3]), cvtpk(v1[0], v1[1]), cvtpk(v1[2], v1[3])}; *reinterpret_cast<u32x4*>(dst) = pk; }

struct EpiL0In {
  bf16_t *U, *GV, *ZA, *ZB, *Q0, *K0, *V0; const float2* rope;
  DEVI void operator()(acc_t& acc, const Unit& u, int wr, int wc, int fr, int fq) const {
    const int col0 = u.pn * 256, type = col0 >> 9; const bool ctx = u.pm >= 128;
#pragma unroll
    for (int ai = 0; ai < 2; ++ai)
#pragma unroll
      for (int m = 0; m < 4; ++m) {
        const int token = u.pm * 256 + ai * 128 + wr * 64 + m * 16 + fr;
        int b, s, key; token_info(token, ctx, b, s, key);
#pragma unroll
        for (int bj = 0; bj < 2; ++bj) {
          const int nl = (col0 & 511) + bj * 128 + wc * 32;
          f32x4 v0 = acc[ai][bj][m][0], v1 = acc[ai][bj][m][1];
          bf16_t* dst;
          if (type <= 1) {
#pragma unroll
            for (int e = 0; e < 4; ++e) { v0[e] = gelu_f(v0[e]); v1[e] = gelu_f(v1[e]); }
            dst = (type == 0 ? U : GV) + (size_t)token * 512 + nl;
          } else if (type == 2 || type == 6) {
#pragma unroll
            for (int e = 0; e < 4; ++e) { v0[e] = silu_f(v0[e]); v1[e] = silu_f(v1[e]); }
            dst = (type == 2 ? ZA : ZB) + (size_t)token * 512 + nl;
          } else if (type == 3) {
            if (!ctx) rope_pair(v0, v1, rope, (wc & 1) ? (s & 63) : (s >> 6), fq);
            dst = Q0 + (size_t)token * 512 + nl;
          } else if (type == 4) {
            if (!ctx) rope_pair(v0, v1, rope, (wc & 1) ? (s & 63) : (s >> 6), fq);
            dst = K0 + ((size_t)(b * 4 + (nl >> 7)) * KVL + key) * 128 + (nl & 127);
          } else {
            dst = V0 + ((size_t)(b * 4 + (nl >> 7)) * KVL + key) * 128 + (nl & 127);
          }
          st8(dst + fq * 8, v0, v1);
        }
      }
  }
};

template <bool HASCTX> struct EpiOut {
  const float* src_lat; const float* src_ctx; float* dst_lat; float* dst_ctx; const float* ada;
  DEVI void operator()(acc_t& acc, const Unit& u, int wr, int wc, int fr, int fq) const {
    const int col0 = u.pn * 256;
#pragma unroll
    for (int ai = 0; ai < 2; ++ai)
#pragma unroll
      for (int m = 0; m < 4; ++m) {
        const int token = u.pm * 256 + ai * 128 + wr * 64 + m * 16 + fr;
        const float* src; float* dst; const float* gate;
        if (!HASCTX || token < NLAT) { src = src_lat + (size_t)token * 1024; dst = dst_lat + (size_t)token * 1024; gate = ada + (token >> 11) * 3072 + 2048; }
        else { const int tc = token - NLAT; src = src_ctx + (size_t)tc * 1024; dst = dst_ctx + (size_t)tc * 1024; gate = ada + 16 * 3072 + 2048; }
#pragma unroll
        for (int bj = 0; bj < 2; ++bj)
#pragma unroll
          for (int n = 0; n < 2; ++n) {
            const int c = col0 + bj * 128 + wc * 32 + fq * 8 + n * 4;
            const f32x4 xv = *reinterpret_cast<const f32x4*>(src + c), g = *reinterpret_cast<const f32x4*>(gate + c);
            *reinterpret_cast<f32x4*>(dst + c) = xv + g * acc[ai][bj][m][n];
          }
      }
  }
};

struct EpiPlain {
  bf16_t* O;
  DEVI void operator()(acc_t& acc, const Unit& u, int wr, int wc, int fr, int fq) const {
    const int col0 = u.pn * 256;
#pragma unroll
    for (int ai = 0; ai < 2; ++ai)
#pragma unroll
      for (int m = 0; m < 4; ++m) {
        const int token = u.pm * 256 + ai * 128 + wr * 64 + m * 16 + fr;
#pragma unroll
        for (int bj = 0; bj < 2; ++bj) st8(O + (size_t)token * 1024 + col0 + bj * 128 + wc * 32 + fq * 8, acc[ai][bj][m][0], acc[ai][bj][m][1]);
      }
  }
};

struct EpiL1In {
  bf16_t *CQ, *CKV, *K1, *Z1; float *RQ, *RKV; const float2* rope; float* ssb;
  DEVI void operator()(acc_t& acc, const Unit& u, int wr, int wc, int fr, int fq) const {
    const int col0 = u.pn * 256; const bool ctx = u.pm >= 128;
    float ss[2][4];
#pragma unroll
    for (int ai = 0; ai < 2; ++ai)
#pragma unroll
      for (int m = 0; m < 4; ++m) {
        ss[ai][m] = 0.f;
        const int token = u.pm * 256 + ai * 128 + wr * 64 + m * 16 + fr;
        int b, s, key; token_info(token, ctx, b, s, key);
#pragma unroll
        for (int bj = 0; bj < 2; ++bj) {
          const int nb = col0 + bj * 128 + wc * 32;
          f32x4 v0 = acc[ai][bj][m][0], v1 = acc[ai][bj][m][1];
          if (nb < 384) {
#pragma unroll
            for (int e = 0; e < 4; ++e) ss[ai][m] += v0[e] * v0[e] + v1[e] * v1[e];
            bf16_t* dst = nb < 256 ? CQ + (size_t)token * 256 + nb : CKV + (size_t)token * 128 + (nb - 256);
            st8(dst + fq * 8, v0, v1);
          } else if (nb < 448) {
            if (!ctx) rope_pair(v0, v1, rope, (nb >= 416) ? (s & 63) : (s >> 6), fq);
#pragma unroll
            for (int h = 0; h < 8; ++h) {
              bf16_t* dst = K1 + ((size_t)(b * 8 + h) * KVL + key) * 192 + 128 + (nb - 384);
              st8(dst + fq * 8, v0, v1);
            }
          } else if (nb < 1472) {
            if (!ctx) {
#pragma unroll
              for (int e = 0; e < 4; ++e) { v0[e] = silu_f(v0[e]); v1[e] = silu_f(v1[e]); }
              bf16_t* dst = Z1 + (size_t)token * 1024 + (nb - 448);
              st8(dst + fq * 8, v0, v1);
            }
          }
        }
      }
    if (u.pn <= 1) {
#pragma unroll
      for (int ai = 0; ai < 2; ++ai)
#pragma unroll
        for (int m = 0; m < 4; ++m) {
          float sv = ss[ai][m]; sv = xsum<16>(sv); sv = xsum<32>(sv);
          if (fq == 0) ssb[wc * 256 + ai * 128 + wr * 64 + m * 16 + fr] = sv;
        }
      asm volatile("s_waitcnt lgkmcnt(0)" ::: "memory"); __builtin_amdgcn_s_barrier(); asm volatile("" ::: "memory");
      const int lt = wc * 64 + fq * 16 + fr;
      if (lt < 128) {
        const int row = (lt >> 6) * 128 + wr * 64 + (lt & 63);
        if (u.pn == 0) { const float tot = (ssb[row] + ssb[256 + row]) + (ssb[512 + row] + ssb[768 + row]); RQ[u.pm * 256 + row] = rsqrtf(tot * (1.f / 256.f) + 1e-6f); }
        else { const float tot = (ssb[row] + ssb[256 + row]) + (ssb[512 + row] + ssb[768 + row]); RKV[u.pm * 256 + row] = rsqrtf(tot * (1.f / 128.f) + 1e-6f); }
      }
    }
  }
};

struct EpiQ {
  bf16_t* Q1; const float* RQ; const float2* rope;
  DEVI void operator()(acc_t& acc, const Unit& u, int wr, int wc, int fr, int fq) const {
    const int col0 = u.pn * 256;
#pragma unroll
    for (int ai = 0; ai < 2; ++ai)
#pragma unroll
      for (int m = 0; m < 4; ++m) {
        const int token = u.pm * 256 + ai * 128 + wr * 64 + m * 16 + fr; const int s = token & 2047; const float rq = RQ[token];
#pragma unroll
        for (int bj = 0; bj < 2; ++bj) {
          const int n0 = col0 + bj * 128 + wc * 32; const int dd0 = n0 % 192;
          f32x4 v0 = acc[ai][bj][m][0] * rq, v1 = acc[ai][bj][m][1] * rq;
          if (dd0 >= 128) rope_pair(v0, v1, rope, (dd0 >= 160) ? (s & 63) : (s >> 6), fq);
          bf16_t* dst = Q1 + (size_t)token * 1536 + n0;
          st8(dst + fq * 8, v0, v1);
        }
      }
  }
};

struct EpiKV {
  bf16_t *K1, *V1; const float* RKV;
  DEVI void operator()(acc_t& acc, const Unit& u, int wr, int wc, int fr, int fq) const {
    const int col0 = u.pn * 256; const bool ctx = u.pm >= 128;
#pragma unroll
    for (int ai = 0; ai < 2; ++ai)
#pragma unroll
      for (int m = 0; m < 4; ++m) {
        const int token = u.pm * 256 + ai * 128 + wr * 64 + m * 16 + fr; const float rk = RKV[token];
        int b, s, key; token_info(token, ctx, b, s, key);
#pragma unroll
        for (int bj = 0; bj < 2; ++bj) {
          const int nb = col0 + bj * 128 + wc * 32; const int h = nb >> 8, dd = nb & 255;
          const f32x4 v0 = acc[ai][bj][m][0] * rk, v1 = acc[ai][bj][m][1] * rk;
          bf16_t* dst = dd < 128 ? K1 + ((size_t)(b * 8 + h) * KVL + key) * 192 + dd : V1 + ((size_t)(b * 8 + h) * KVL + key) * 128 + (dd - 128);
          st8(dst + fq * 8, v0, v1);
        }
      }
  }
};

template <int SCID> struct ScaleOf { static constexpr float v = SCID == 0 ? 0.125f : 0.07216878364870322f; };
constexpr float THR = 8.f;
template <int KW> DEVI int kswz(int row, int colB) { return row * (KW * 2 + 16) + colB; }
DEVI int v_st(int k, int c) { const int kk = (k & ~0xC) | ((k & 4) << 1) | ((k & 8) >> 1); return ((kk >> 3) * 4 + (c >> 5)) * 512 + ((kk & 7) * 32 + (c & 31)) * 2; }
DEVI int v_rd_base(int lane) { return ((lane & 3) << 3) | (((lane >> 2) & 3) << 6) | (((lane >> 4) & 1) << 5) | (((lane >> 5) & 1) << 8); }
constexpr int v_rd_off(int d0, int ks, int half) { return d0 * 512 + ks * 4096 + half * 2048; }
template <int OFF> DEVI s16x4 tr_read(int vb) { s16x4 r; asm volatile("ds_read_b64_tr_b16 %0, %1 offset:%2" : "=&v"(r) : "v"(vb), "i"(OFF) : "memory"); return r; }

template <int SCID>
DEVI void partialSM(f32x16& p0, f32x16& p1, float& m_reg, float& mn, float& alpha) {
  constexpr float SC = ScaleOf<SCID>::v; constexpr float C = SC * 1.4426950408889634f;
  float pmax = p0[0];
#pragma unroll
  for (int r = 1; r < 16; ++r) pmax = fmaxf(pmax, p0[r]);
#pragma unroll
  for (int r = 0; r < 16; ++r) pmax = fmaxf(pmax, p1[r]);
  { auto rr = __builtin_amdgcn_permlane32_swap(__float_as_uint(pmax), __float_as_uint(pmax), false, false);
    pmax = fmaxf(__uint_as_float(rr[0]), __uint_as_float(rr[1])); }
  if (__builtin_expect(__all(pmax - m_reg <= THR / SC), 1)) { mn = m_reg; alpha = 1.f; }
  else { mn = fmaxf(m_reg, pmax); alpha = __builtin_amdgcn_exp2f((m_reg - mn) * C); m_reg = mn; }
  const float mnC = -mn * C;
#pragma unroll
  for (int r = 0; r < 16; ++r) p0[r] = fmaf(p0[r], C, mnC);
#pragma unroll
  for (int r = 0; r < 16; ++r) p1[r] = fmaf(p1[r], C, mnC);
#pragma unroll
  for (int r = 0; r < 16; ++r) p0[r] = __builtin_amdgcn_exp2f(p0[r]);
}
DEVI void finishSM(f32x16& p0, f32x16& p1, float alpha, float& l_reg, bf16x8& pa0, bf16x8& pa1, bf16x8& pa2, bf16x8& pa3) {
#pragma unroll
  for (int r = 0; r < 16; ++r) p1[r] = __builtin_amdgcn_exp2f(p1[r]);
  float ps = 0;
#pragma unroll
  for (int r = 0; r < 16; ++r) ps += p0[r];
#pragma unroll
  for (int r = 0; r < 16; ++r) ps += p1[r];
  { auto rr = __builtin_amdgcn_permlane32_swap(__float_as_uint(ps), __float_as_uint(ps), false, false);
    ps = __uint_as_float(rr[0]) + __uint_as_float(rr[1]); }
  l_reg = l_reg * alpha + ps;
#define PK4(P, BASE, OUT) do { unsigned a0 = cvtpk(P[BASE + 0], P[BASE + 1]), a1 = cvtpk(P[BASE + 2], P[BASE + 3]); \
    unsigned b0 = cvtpk(P[BASE + 4], P[BASE + 5]), b1 = cvtpk(P[BASE + 6], P[BASE + 7]); \
    auto r0 = __builtin_amdgcn_permlane32_swap(a0, b0, false, false); auto r1 = __builtin_amdgcn_permlane32_swap(a1, b1, false, false); \
    u32x4 w = {r0[0], r1[0], r0[1], r1[1]}; OUT = *reinterpret_cast<bf16x8*>(&w); } while (0)
  PK4(p0, 0, pa0); PK4(p0, 8, pa1); PK4(p1, 0, pa2); PK4(p1, 8, pa3);
#undef PK4
}
template <int OFF> DEVI bf16x8 lds_rd128(int a) { bf16x8 r; asm volatile("ds_read_b128 %0, %1 offset:%2" : "=&v"(r) : "v"(a), "i"(OFF) : "memory"); return r; }
template <int N> DEVI void wait_lgkm() { asm volatile("s_waitcnt lgkmcnt(%0)" :: "n"(N) : "memory"); }
template <int NQ, int QL> constexpr bool q_is_lds(int s) { return QL > 0 && s >= NQ - QL && s < NQ; }
template <int NQ, int QL> constexpr int q_after(int d) {
  return q_is_lds<NQ, QL>(d) ? (d + 2 < NQ ? 2 : 0) + (q_is_lds<NQ, QL>(d + 1) ? 1 : 0)
                             : (d + 1 < NQ ? 2 : 0) + (d + 2 < NQ ? 2 : 0) + (q_is_lds<NQ, QL>(d + 1) ? 1 : 0);
}
template <int KW, int NQ, int QL, int D0>
DEVI void qkt_step(f32x16& p0, f32x16& p1, int ka, const bf16x8* qr, int qa, bf16x8 (&kf)[3][2], bf16x8 (&qf)[2]) {
  if constexpr (D0 < NQ) {
    constexpr int ROW32 = 32 * (KW * 2 + 16);
    if constexpr (D0 + 2 < NQ) { kf[(D0 + 2) % 3][0] = lds_rd128<(D0 + 2) * 32>(ka); kf[(D0 + 2) % 3][1] = lds_rd128<ROW32 + (D0 + 2) * 32>(ka); }
    if constexpr (q_is_lds<NQ, QL>(D0 + 1)) qf[(D0 + 1) & 1] = lds_rd128<(D0 + 1 - (NQ - QL)) * 32>(qa);
    wait_lgkm<q_after<NQ, QL>(D0)>(); SBAR();
    bf16x8 q;
    if constexpr (q_is_lds<NQ, QL>(D0)) q = qf[D0 & 1]; else q = qr[D0];
    p0 = __builtin_amdgcn_mfma_f32_32x32x16_bf16(kf[D0 % 3][0], q, p0, 0, 0, 0);
    p1 = __builtin_amdgcn_mfma_f32_32x32x16_bf16(kf[D0 % 3][1], q, p1, 0, 0, 0);
    qkt_step<KW, NQ, QL, D0 + 1>(p0, p1, ka, qr, qa, kf, qf);
  }
}
template <int KW, int NQ, int QL = 0>
DEVI void qkt(f32x16& p0, f32x16& p1, const char* Ks, const bf16x8* qr, int kcol0, int r32, int hi, const char* ql = nullptr) {
#pragma unroll
  for (int r = 0; r < 16; ++r) { p0[r] = 0.f; p1[r] = 0.f; }
  const int ka = (int)(uintptr_t)(Ks + kswz<KW>(r32, (kcol0 + hi * 8) * 2)), qa = (int)(uintptr_t)ql;
  constexpr int ROW32 = 32 * (KW * 2 + 16);
  static_assert(NQ >= 2 && (QL == 0 || NQ - QL >= 2), "prologue issues steps 0 and 1 from registers-q steps");
  bf16x8 kf[3][2], qf[2];
  asm volatile("s_waitcnt lgkmcnt(0)" ::: "memory");
  kf[0][0] = lds_rd128<0>(ka); kf[0][1] = lds_rd128<ROW32>(ka);
  kf[1][0] = lds_rd128<32>(ka); kf[1][1] = lds_rd128<ROW32 + 32>(ka);
  qkt_step<KW, NQ, QL, 0>(p0, p1, ka, qr, qa, kf, qf);
}
template <int D0> DEVI void pv_one(f32x16& od, int vb, bf16x8 pa0, bf16x8 pa1, bf16x8 pa2, bf16x8 pa3) {
  const s16x4 l0 = tr_read<v_rd_off(D0, 0, 0)>(vb), h0 = tr_read<v_rd_off(D0, 0, 1)>(vb), l1 = tr_read<v_rd_off(D0, 1, 0)>(vb), h1 = tr_read<v_rd_off(D0, 1, 1)>(vb);
  const s16x4 l2 = tr_read<v_rd_off(D0, 2, 0)>(vb), h2 = tr_read<v_rd_off(D0, 2, 1)>(vb), l3 = tr_read<v_rd_off(D0, 3, 0)>(vb), h3 = tr_read<v_rd_off(D0, 3, 1)>(vb);
  asm volatile("s_waitcnt lgkmcnt(0)" ::: "memory"); SBAR();
#define PK(L, H) (bf16x8){L[0], L[1], L[2], L[3], H[0], H[1], H[2], H[3]}
  od = __builtin_amdgcn_mfma_f32_32x32x16_bf16(pa0, PK(l0, h0), od, 0, 0, 0);
  od = __builtin_amdgcn_mfma_f32_32x32x16_bf16(pa1, PK(l1, h1), od, 0, 0, 0);
  od = __builtin_amdgcn_mfma_f32_32x32x16_bf16(pa2, PK(l2, h2), od, 0, 0, 0);
  od = __builtin_amdgcn_mfma_f32_32x32x16_bf16(pa3, PK(l3, h3), od, 0, 0, 0);
#undef PK
}
template <int D0> DEVI void v_load(int vb, s16x4 (&f)[8]) {
  f[0] = tr_read<v_rd_off(D0, 0, 0)>(vb); f[1] = tr_read<v_rd_off(D0, 0, 1)>(vb); f[2] = tr_read<v_rd_off(D0, 1, 0)>(vb); f[3] = tr_read<v_rd_off(D0, 1, 1)>(vb);
  f[4] = tr_read<v_rd_off(D0, 2, 0)>(vb); f[5] = tr_read<v_rd_off(D0, 2, 1)>(vb); f[6] = tr_read<v_rd_off(D0, 3, 0)>(vb); f[7] = tr_read<v_rd_off(D0, 3, 1)>(vb);
}
DEVI void pv_mma(f32x16& od, const s16x4 (&f)[8], bf16x8 pa0, bf16x8 pa1, bf16x8 pa2, bf16x8 pa3) {
#define PK(L, H) (bf16x8){L[0], L[1], L[2], L[3], H[0], H[1], H[2], H[3]}
  od = __builtin_amdgcn_mfma_f32_32x32x16_bf16(pa0, PK(f[0], f[1]), od, 0, 0, 0);
  od = __builtin_amdgcn_mfma_f32_32x32x16_bf16(pa1, PK(f[2], f[3]), od, 0, 0, 0);
  od = __builtin_amdgcn_mfma_f32_32x32x16_bf16(pa2, PK(f[4], f[5]), od, 0, 0, 0);
  od = __builtin_amdgcn_mfma_f32_32x32x16_bf16(pa3, PK(f[6], f[7]), od, 0, 0, 0);
#undef PK
}
DEVI void pv_d0(f32x16* o, int vb, bf16x8 pa0, bf16x8 pa1, bf16x8 pa2, bf16x8 pa3) {
  s16x4 fa[8], fb[8];
  v_load<0>(vb, fa);
  v_load<1>(vb, fb); asm volatile("s_waitcnt lgkmcnt(8)" ::: "memory"); SBAR(); pv_mma(o[0], fa, pa0, pa1, pa2, pa3); SBAR();
  v_load<2>(vb, fa); asm volatile("s_waitcnt lgkmcnt(8)" ::: "memory"); SBAR(); pv_mma(o[1], fb, pa0, pa1, pa2, pa3); SBAR();
  v_load<3>(vb, fb); asm volatile("s_waitcnt lgkmcnt(8)" ::: "memory"); SBAR(); pv_mma(o[2], fa, pa0, pa1, pa2, pa3); SBAR();
  asm volatile("s_waitcnt lgkmcnt(0)" ::: "memory"); SBAR(); pv_mma(o[3], fb, pa0, pa1, pa2, pa3);
}

template <int KW, int NQ, int SCID>
DEVI void attn_core(int wv, const bf16_t* __restrict__ Qw, const bf16_t* __restrict__ Kh, const bf16_t* __restrict__ Vh, int kcol0, int NT, char* lds,
                    f32x16 (&o)[4], float& l_out) {
  constexpr int SHM_V = 64 * 128 * 2, SHM_K = 64 * (KW * 2 + 16), KC = KW / 64;
  const int tid = tidx(wv), wid = tid >> 6, lane = tid & 63, r32 = lane & 31, hi = lane >> 5;
  char* V_lds = lds; char* K_lds = lds + 2 * SHM_V;
  float* al_l = (float*)(lds + 2 * SHM_V + 2 * SHM_K) + wid * 64 + 32;
  float m_reg = -1e30f, l_reg = 0;
#pragma unroll
  for (int d = 0; d < 4; ++d)
#pragma unroll
    for (int r = 0; r < 16; ++r) o[d][r] = 0.f;
  bf16x8 qr[NQ];
#pragma unroll
  for (int d0 = 0; d0 < NQ; ++d0) qr[d0] = *reinterpret_cast<const bf16x8*>(Qw + d0 * 16);
  const int sr = tid >> 4, sc = (tid & 15) * 8, vst0 = v_st(sr, sc), vst1 = v_st(32 + sr, sc);
  const int krow = tid >> 3, kch = tid & 7;
  const bf16_t* vg = Vh + sr * 128 + sc;
  const bf16_t* kg = Kh + krow * KW + kch * 8;
  const int vb0 = (int)(uintptr_t)V_lds + v_rd_base(lane);
  bf16x8 vs0, vs1, ks[KC];
#define SLOAD(k0) do { vs0 = *reinterpret_cast<const bf16x8*>(vg + (size_t)(k0) * 128); vs1 = *reinterpret_cast<const bf16x8*>(vg + (size_t)((k0) + 32) * 128); \
    _Pragma("unroll") for (int _c = 0; _c < KC; ++_c) ks[_c] = *reinterpret_cast<const bf16x8*>(kg + (size_t)(k0) * KW + _c * 64); } while (0)
#define SWRITE(b) do { *reinterpret_cast<bf16x8*>(V_lds + (b) * SHM_V + vst0) = vs0; *reinterpret_cast<bf16x8*>(V_lds + (b) * SHM_V + vst1) = vs1; \
    _Pragma("unroll") for (int _c = 0; _c < KC; ++_c) *reinterpret_cast<bf16x8*>(K_lds + (b) * SHM_K + kswz<KW>(krow, (kch + 8 * _c) * 16)) = ks[_c]; } while (0)
  SLOAD(0); SWRITE(0);
  if (NT > 1) SLOAD(64);
  __syncthreads();
  for (int j = 0; j < NT; ++j) {
    const int bsel = j & 1;
    f32x16 p0, p1; float mn, alpha; bf16x8 pa0, pa1, pa2, pa3;
    qkt<KW, NQ>(p0, p1, K_lds + bsel * SHM_K, qr, kcol0, r32, hi);
    partialSM<SCID>(p0, p1, m_reg, mn, alpha);
    if (__any(alpha < 1.f)) {
      if (hi == 0) al_l[r32] = alpha;
      asm volatile("s_waitcnt lgkmcnt(0)" ::: "memory");
#pragma unroll
      for (int d = 0; d < 4; ++d)
#pragma unroll
        for (int r = 0; r < 16; ++r) o[d][r] *= al_l[crow(r, hi)];
    }
    finishSM(p0, p1, alpha, l_reg, pa0, pa1, pa2, pa3);
    pv_d0(o, vb0 + bsel * SHM_V, pa0, pa1, pa2, pa3);
    if (j + 1 < NT) { SWRITE(bsel ^ 1); if (j + 2 < NT) SLOAD((j + 2) * 64); }
    __syncthreads();
  }
  l_out = l_reg;
#undef SLOAD
#undef SWRITE
}

template <int KW, int NQ, int SDEPTH, int SCID, int QL>
DEVI void attn_core_pipe(int wv, const bf16_t* __restrict__ Qw, const bf16_t* __restrict__ Kh, const bf16_t* __restrict__ Vh, int kcol0, int NT, char* lds,
                         f32x16 (&o)[4], float& l_out) {
  constexpr int SHM_V = 64 * 128 * 2, SHM_K = 64 * (KW * 2 + 16), KC = KW / 64;
  const int tid = tidx(wv), wid = tid >> 6, lane = tid & 63, r32 = lane & 31, hi = lane >> 5;
  char* V_lds = lds; char* K_lds = lds + 2 * SHM_V;
  float* al_l = (float*)(lds + 2 * SHM_V + 2 * SHM_K) + wid * 64 + 32;
  float m_reg = -1e30f, l_reg = 0;
#pragma unroll
  for (int d = 0; d < 4; ++d)
#pragma unroll
    for (int r = 0; r < 16; ++r) o[d][r] = 0.f;
  bf16x8 qr[NQ - QL + (QL ? 1 : 0)];
#pragma unroll
  for (int d0 = 0; d0 < NQ - QL; ++d0) qr[d0] = *reinterpret_cast<const bf16x8*>(Qw + d0 * 16);
  char* ql = lds + 2 * SHM_V + 2 * SHM_K + 2048 + (wid * 32 + r32) * 144 + hi * 16;
  if constexpr (QL > 0) {
#pragma unroll
    for (int d0 = NQ - QL; d0 < NQ; ++d0) *reinterpret_cast<bf16x8*>(ql + (d0 - (NQ - QL)) * 32) = *reinterpret_cast<const bf16x8*>(Qw + d0 * 16);
  }
  const int sr = tid >> 4, sc = (tid & 15) * 8, vst0 = v_st(sr, sc), vst1 = v_st(32 + sr, sc);
  const int krow = tid >> 3, kch = tid & 7;
  const bf16_t* vg = Vh + sr * 128 + sc;
  const bf16_t* kg = Kh + krow * KW + kch * 8;
  const int vb0 = (int)(uintptr_t)V_lds + v_rd_base(lane);
  struct { bf16x8 vs0, vs1, ks[KC]; } sr_[SDEPTH];
#define SLOAD(i, k0) do { sr_[i].vs0 = *reinterpret_cast<const bf16x8*>(vg + (size_t)(k0) * 128); sr_[i].vs1 = *reinterpret_cast<const bf16x8*>(vg + (size_t)((k0) + 32) * 128); \
    _Pragma("unroll") for (int _c = 0; _c < KC; ++_c) sr_[i].ks[_c] = *reinterpret_cast<const bf16x8*>(kg + (size_t)(k0) * KW + _c * 64); } while (0)
#define SWRITE(b, i) do { *reinterpret_cast<bf16x8*>(V_lds + (b) * SHM_V + vst0) = sr_[i].vs0; *reinterpret_cast<bf16x8*>(V_lds + (b) * SHM_V + vst1) = sr_[i].vs1; \
    _Pragma("unroll") for (int _c = 0; _c < KC; ++_c) *reinterpret_cast<bf16x8*>(K_lds + (b) * SHM_K + kswz<KW>(krow, (kch + 8 * _c) * 16)) = sr_[i].ks[_c]; } while (0)
#define SWAIT() do { if constexpr (SDEPTH == 2) asm volatile("s_waitcnt vmcnt(4)" ::: "memory"); else asm volatile("s_waitcnt vmcnt(0)" ::: "memory"); } while (0)
#define RESC(a) do { if (__any((a) < 1.f)) { if (hi == 0) al_l[r32] = (a); asm volatile("s_waitcnt lgkmcnt(0)" ::: "memory"); \
    _Pragma("unroll") for (int _d = 0; _d < 4; ++_d) _Pragma("unroll") for (int _r = 0; _r < 16; ++_r) o[_d][_r] *= al_l[crow(_r, hi)]; } } while (0)
  f32x16 pA0, pA1, pB0, pB1; float mnA, mnB, alA, alB; bf16x8 pa0, pa1, pa2, pa3;
  constexpr int SE = 0, SO = SDEPTH - 1;
  SLOAD(SE, 0); asm volatile("s_waitcnt vmcnt(0)" ::: "memory"); SWRITE(0, SE); __syncthreads();
  qkt<KW, NQ, QL>(pA0, pA1, K_lds, qr, kcol0, r32, hi, ql); partialSM<SCID>(pA0, pA1, m_reg, mnA, alA);
  SLOAD(SO, 64); if constexpr (SDEPTH == 2) { if (2 < NT) SLOAD(SE, 128); }
  SWAIT(); SWRITE(1, SO); __syncthreads();
  for (int j = 1; j + 1 < NT; j += 2) {
    SBAR(); qkt<KW, NQ, QL>(pB0, pB1, K_lds + SHM_K, qr, kcol0, r32, hi, ql);
    finishSM(pA0, pA1, alA, l_reg, pa0, pa1, pa2, pa3); SBAR();
    SLOAD(SO, (j + SDEPTH) * 64); SBAR();
    pv_d0(o, vb0, pa0, pa1, pa2, pa3); partialSM<SCID>(pB0, pB1, m_reg, mnB, alB);
    __syncthreads(); SWAIT(); SWRITE(0, SE);
    RESC(alB); __syncthreads();
    SBAR(); qkt<KW, NQ, QL>(pA0, pA1, K_lds, qr, kcol0, r32, hi, ql);
    finishSM(pB0, pB1, alB, l_reg, pa0, pa1, pa2, pa3); SBAR();
    if (SDEPTH == 1 || j + 3 < NT) SLOAD(SE, (j + 1 + SDEPTH) * 64);
    SBAR();
    pv_d0(o, vb0 + SHM_V, pa0, pa1, pa2, pa3); partialSM<SCID>(pA0, pA1, m_reg, mnA, alA);
    __syncthreads(); SWAIT(); SWRITE(1, SO);
    RESC(alA); __syncthreads();
  }
  SBAR(); qkt<KW, NQ, QL>(pB0, pB1, K_lds + SHM_K, qr, kcol0, r32, hi, ql);
  finishSM(pA0, pA1, alA, l_reg, pa0, pa1, pa2, pa3); SBAR();
  pv_d0(o, vb0, pa0, pa1, pa2, pa3); partialSM<SCID>(pB0, pB1, m_reg, mnB, alB);
  __syncthreads(); RESC(alB);
  finishSM(pB0, pB1, alB, l_reg, pa0, pa1, pa2, pa3); SBAR();
  pv_d0(o, vb0 + SHM_V, pa0, pa1, pa2, pa3);
  __syncthreads();
  l_out = l_reg;
#undef SLOAD
#undef SWRITE
#undef SWAIT
#undef RESC
}

template <int KW, int NQ, int SCID, int QL>
DEVI void attn_core_dma(int wv, const bf16_t* __restrict__ Qw, const bf16_t* __restrict__ Kh, const bf16_t* __restrict__ Vh, int kcol0, int NT, char* lds,
                        f32x16 (&o)[4], float& l_out) {
  constexpr int SHM_V = 64 * 128 * 2, KCH = KW / 8 + 1, SHM_K = 64 * KCH * 16, KR = (64 * KCH) / 512;
  static_assert(64 * KCH - KR * 512 == 64, "remainder must be one wave");
  const int tid = tidx(wv), wid = tid >> 6, lane = tid & 63, r32 = lane & 31, hi = lane >> 5;
  char* V_lds = lds; char* K_lds = lds + 2 * SHM_V;
  float* al_l = (float*)(lds + 2 * SHM_V + 2 * SHM_K) + wid * 64 + 32;
  float m_reg = -1e30f, l_reg = 0;
#pragma unroll
  for (int d = 0; d < 4; ++d)
#pragma unroll
    for (int r = 0; r < 16; ++r) o[d][r] = 0.f;
  bf16x8 qr[NQ - QL + (QL ? 1 : 0)];
#pragma unroll
  for (int d0 = 0; d0 < NQ - QL; ++d0) qr[d0] = *reinterpret_cast<const bf16x8*>(Qw + d0 * 16);
  char* ql = lds + 2 * SHM_V + 2 * SHM_K + 2048 + (wid * 32 + r32) * 144 + hi * 16;
  if constexpr (QL > 0) {
#pragma unroll
    for (int d0 = NQ - QL; d0 < NQ; ++d0) *reinterpret_cast<bf16x8*>(ql + (d0 - (NQ - QL)) * 32) = *reinterpret_cast<const bf16x8*>(Qw + d0 * 16);
  }
  const int sr = tid >> 4, sc = (tid & 15) * 8, vst0 = v_st(sr, sc), vst1 = v_st(32 + sr, sc);
  const bf16_t* vg = Vh + sr * 128 + sc;
  const int vb0 = (int)(uintptr_t)V_lds + v_rd_base(lane);
  unsigned koff[KR + 1];
#pragma unroll
  for (int i = 0; i <= KR; ++i) { const int c = tid + 512 * i; const int row = c / KCH; int ch = c - row * KCH; ch = ch == KCH - 1 ? KCH - 2 : ch; koff[i] = (unsigned)(row * KW + ch * 8) * 2u; }
  const unsigned kldsw = (unsigned)__builtin_amdgcn_readfirstlane(wid) * 1024u;
  bf16x8 vs0, vs1;
#define KDMA(k0, b) do { const char* _g = (const char*)(Kh + (size_t)(k0) * KW); PG8_LAS unsigned char* _l = (PG8_LAS unsigned char*)(K_lds + (b) * SHM_K) + kldsw; \
    _Pragma("unroll") for (int _i = 0; _i < KR; ++_i) __builtin_amdgcn_global_load_lds((const unsigned*)(_g + koff[_i]), (PG8_LAS unsigned*)(_l + _i * 8192), 16, 0, 0); \
    if (wid == 0) __builtin_amdgcn_global_load_lds((const unsigned*)(_g + koff[KR]), (PG8_LAS unsigned*)(_l + KR * 8192), 16, 0, 0); } while (0)
#define VLOAD(k0) do { vs0 = *reinterpret_cast<const bf16x8*>(vg + (size_t)(k0) * 128); vs1 = *reinterpret_cast<const bf16x8*>(vg + (size_t)((k0) + 32) * 128); } while (0)
#define VWRITE(b) do { *reinterpret_cast<bf16x8*>(V_lds + (b) * SHM_V + vst0) = vs0; *reinterpret_cast<bf16x8*>(V_lds + (b) * SHM_V + vst1) = vs1; } while (0)
#define VMW() asm volatile("s_waitcnt vmcnt(0)" ::: "memory")
#define RESC(a) do { if (__any((a) < 1.f)) { if (hi == 0) al_l[r32] = (a); asm volatile("s_waitcnt lgkmcnt(0)" ::: "memory"); \
    _Pragma("unroll") for (int _d = 0; _d < 4; ++_d) _Pragma("unroll") for (int _r = 0; _r < 16; ++_r) o[_d][_r] *= al_l[crow(_r, hi)]; } } while (0)
  f32x16 pA0, pA1, pB0, pB1; float mnA, mnB, alA, alB; bf16x8 pa0, pa1, pa2, pa3;
  KDMA(0, 0); VLOAD(0); VMW(); VWRITE(0); __syncthreads();
  KDMA(64, 1); VLOAD(64);
  qkt<KW, NQ, QL>(pA0, pA1, K_lds, qr, kcol0, r32, hi, ql); partialSM<SCID>(pA0, pA1, m_reg, mnA, alA);
  VMW(); __syncthreads(); VWRITE(1); __syncthreads();
  for (int j = 1; j + 1 < NT; j += 2) {
    SBAR(); KDMA((j + 1) * 64, 0); VLOAD((j + 1) * 64); SBAR();
    qkt<KW, NQ, QL>(pB0, pB1, K_lds + SHM_K, qr, kcol0, r32, hi, ql);
    finishSM(pA0, pA1, alA, l_reg, pa0, pa1, pa2, pa3); SBAR();
    pv_d0(o, vb0, pa0, pa1, pa2, pa3); partialSM<SCID>(pB0, pB1, m_reg, mnB, alB);
    VMW(); __syncthreads(); VWRITE(0);
    RESC(alB); __syncthreads();
    SBAR(); KDMA((j + 2) * 64, 1); VLOAD((j + 2) * 64); SBAR();
    qkt<KW, NQ, QL>(pA0, pA1, K_lds, qr, kcol0, r32, hi, ql);
    finishSM(pB0, pB1, alB, l_reg, pa0, pa1, pa2, pa3); SBAR();
    pv_d0(o, vb0 + SHM_V, pa0, pa1, pa2, pa3); partialSM<SCID>(pA0, pA1, m_reg, mnA, alA);
    VMW(); __syncthreads(); VWRITE(1);
    RESC(alA); __syncthreads();
  }
  SBAR(); qkt<KW, NQ, QL>(pB0, pB1, K_lds + SHM_K, qr, kcol0, r32, hi, ql);
  finishSM(pA0, pA1, alA, l_reg, pa0, pa1, pa2, pa3); SBAR();
  pv_d0(o, vb0, pa0, pa1, pa2, pa3); partialSM<SCID>(pB0, pB1, m_reg, mnB, alB);
  RESC(alB);
  finishSM(pB0, pB1, alB, l_reg, pa0, pa1, pa2, pa3); SBAR();
  pv_d0(o, vb0 + SHM_V, pa0, pa1, pa2, pa3);
  __syncthreads();
  l_out = l_reg;
#undef KDMA
#undef VLOAD
#undef VWRITE
#undef VMW
#undef RESC
}

template <int KW, int NQ, int SCID, int QL>
DEVI void attn_core_pp(int wv, const bf16_t* __restrict__ Qw, const bf16_t* __restrict__ Kh, const bf16_t* __restrict__ Vh, int kcol0, int NT, char* lds,
                       f32x16 (&o)[4], float& l_out) {
  constexpr int SHM_V = 64 * 128 * 2, KCH = KW / 8 + 1, SHM_K = 64 * KCH * 16, KR = (64 * KCH) / 512;
  static_assert(64 * KCH - KR * 512 == 64, "remainder must be one wave");
  const int tid = tidx(wv), wid = tid >> 6, lane = tid & 63, r32 = lane & 31, hi = lane >> 5;
  const int g = __builtin_amdgcn_readfirstlane(wid >> 2);
  char* V_lds = lds; char* K_lds = lds + 2 * SHM_V;
  float* al_l = (float*)(lds + 2 * SHM_V + 2 * SHM_K) + wid * 64 + 32;
  float m_reg = -1e30f, l_reg = 0;
#pragma unroll
  for (int d = 0; d < 4; ++d)
#pragma unroll
    for (int r = 0; r < 16; ++r) o[d][r] = 0.f;
  bf16x8 qr[NQ - QL + (QL ? 1 : 0)];
#pragma unroll
  for (int d0 = 0; d0 < NQ - QL; ++d0) qr[d0] = *reinterpret_cast<const bf16x8*>(Qw + d0 * 16);
  char* ql = lds + 2 * SHM_V + 2 * SHM_K + 2048 + (wid * 32 + r32) * 144 + hi * 16;
  if constexpr (QL > 0) {
#pragma unroll
    for (int d0 = NQ - QL; d0 < NQ; ++d0) *reinterpret_cast<bf16x8*>(ql + (d0 - (NQ - QL)) * 32) = *reinterpret_cast<const bf16x8*>(Qw + d0 * 16);
  }
  const int vb0 = (int)(uintptr_t)V_lds + v_rd_base(lane);
  unsigned koff[KR + 1], voff[2];
#pragma unroll
  for (int i = 0; i <= KR; ++i) { const int c = tid + 512 * i; const int row = c / KCH; int ch = c - row * KCH; ch = ch == KCH - 1 ? KCH - 2 : ch; koff[i] = (unsigned)(row * KW + ch * 8) * 2u; }
#pragma unroll
  for (int i = 0; i < 2; ++i) { const int q = tid + 512 * i; const int st = q >> 5, kk = (st >> 2) * 8 + ((q >> 2) & 7), c = (st & 3) * 32 + (q & 3) * 8;
    const int k = (kk & ~0xC) | ((kk & 4) << 1) | ((kk & 8) >> 1); voff[i] = (unsigned)(k * 128 + c) * 2u; }
  const unsigned ldsw = (unsigned)__builtin_amdgcn_readfirstlane(wid) * 1024u;
#define KDMA(k0, b) do { const char* _g = (const char*)(Kh + (size_t)(k0) * KW); PG8_LAS unsigned char* _l = (PG8_LAS unsigned char*)(K_lds + (b) * SHM_K) + ldsw; \
    _Pragma("unroll") for (int _i = 0; _i < KR; ++_i) __builtin_amdgcn_global_load_lds((const unsigned*)(_g + koff[_i]), (PG8_LAS unsigned*)(_l + _i * 8192), 16, 0, 0); \
    if (wid == 0) __builtin_amdgcn_global_load_lds((const unsigned*)(_g + koff[KR]), (PG8_LAS unsigned*)(_l + KR * 8192), 16, 0, 0); } while (0)
#define VDMA(k0, b) do { const char* _g = (const char*)(Vh + (size_t)(k0) * 128); PG8_LAS unsigned char* _l = (PG8_LAS unsigned char*)(V_lds + (b) * SHM_V) + ldsw; \
    _Pragma("unroll") for (int _i = 0; _i < 2; ++_i) __builtin_amdgcn_global_load_lds((const unsigned*)(_g + voff[_i]), (PG8_LAS unsigned*)(_l + _i * 8192), 16, 0, 0); } while (0)
#define VMW() asm volatile("s_waitcnt vmcnt(0)" ::: "memory")
#define PBAR() do { asm volatile("" ::: "memory"); __builtin_amdgcn_s_barrier(); asm volatile("" ::: "memory"); } while (0)
#define RESC(a) do { if (__any((a) < 1.f)) { if (hi == 0) al_l[r32] = (a); asm volatile("s_waitcnt lgkmcnt(0)" ::: "memory"); \
    _Pragma("unroll") for (int _d = 0; _d < 4; ++_d) _Pragma("unroll") for (int _r = 0; _r < 16; ++_r) o[_d][_r] *= al_l[crow(_r, hi)]; } } while (0)
  f32x16 pA0, pA1, pB0, pB1; float mn, al; bf16x8 pa0, pa1, pa2, pa3;
  KDMA(0, 0); KDMA(64, 1); VMW(); __syncthreads();
  qkt<KW, NQ, QL>(pA0, pA1, K_lds, qr, kcol0, r32, hi, ql);
  PBAR();
  if (g == 1) PBAR();
  for (int j = 0; j < NT; j += 2) {
    SBAR(); if (j + 2 < NT) KDMA((j + 2) * 64, 0); VDMA(j * 64, 0); SBAR();
    qkt<KW, NQ, QL>(pB0, pB1, K_lds + SHM_K, qr, kcol0, r32, hi, ql);
    if (j > 0) pv_d0(o, vb0 + SHM_V, pa0, pa1, pa2, pa3);
    if (g == 1) VMW();
    PBAR(); SBAR();
    partialSM<SCID>(pA0, pA1, m_reg, mn, al); RESC(al); finishSM(pA0, pA1, al, l_reg, pa0, pa1, pa2, pa3);
    if (g == 0) VMW();
    PBAR(); SBAR();
    if (j + 3 < NT) KDMA((j + 3) * 64, 1);
    VDMA((j + 1) * 64, 1); SBAR();
    if (j + 2 < NT) qkt<KW, NQ, QL>(pA0, pA1, K_lds, qr, kcol0, r32, hi, ql);
    pv_d0(o, vb0, pa0, pa1, pa2, pa3);
    if (g == 1) VMW();
    PBAR(); SBAR();
    partialSM<SCID>(pB0, pB1, m_reg, mn, al); RESC(al); finishSM(pB0, pB1, al, l_reg, pa0, pa1, pa2, pa3);
    if (g == 0) VMW();
    PBAR(); SBAR();
  }
  pv_d0(o, vb0 + SHM_V, pa0, pa1, pa2, pa3);
  if (g == 0) PBAR();
  __syncthreads();
  l_out = l_reg;
#undef KDMA
#undef VDMA
#undef VMW
#undef PBAR
#undef RESC
}

DEVI void gated_rows_out(const char* stg, int lane, const bf16_t* __restrict__ gate, int gld, bf16_t* __restrict__ out, int old) {
#pragma unroll
  for (int i = 0; i < 8; ++i) {
    const int c = lane + 64 * i, row = c >> 4, ch = c & 15;
    const u32x4 sv = *reinterpret_cast<const u32x4*>(stg + row * 272 + ch * 16);
    const u32x4 gv = *reinterpret_cast<const u32x4*>(gate + (size_t)row * gld + ch * 8);
    u32x4 ov;
#pragma unroll
    for (int e = 0; e < 4; ++e) ov[e] = cvtpk(bflo(sv[e]) * bflo(gv[e]), bfhi(sv[e]) * bfhi(gv[e]));
    *reinterpret_cast<u32x4*>(out + (size_t)row * old + ch * 8) = ov;
  }
}

DEVI void attn0_item(int wv, const Params& p, int token0, int b, int h, int nkeys, char* lds) {
  const int tid = tidx(wv), wid = tid >> 6, lane = tid & 63, r32 = lane & 31, hi = lane >> 5, m = wid >> 2, wl = wid & 3;
  const bf16_t* Q0 = (const bf16_t*)(p.ws + OFF_Q0); const bf16_t* K0 = (const bf16_t*)(p.ws + OFF_K0); const bf16_t* V0 = (const bf16_t*)(p.ws + OFF_V0);
  const bf16_t* ZB = (const bf16_t*)(p.ws + OFF_ZB); bf16_t* MIX = (bf16_t*)(p.ws + OFF_MIX);
  const bf16_t* Qw = Q0 + (size_t)(token0 + wl * 32 + r32) * 512 + h * 128 + m * 64 + hi * 8;
  const size_t kvo = (size_t)(b * 4 + h) * KVL * 128;
  f32x16 o[4]; float l;
  attn_core_pp<128, 4, 0, 0>(wv, Qw, K0 + kvo, V0 + kvo, m * 64, nkeys >> 6, lds, o, l);
  float* li_l = (float*)(lds + 32768 + 2 * 64 * 272) + wid * 64;
  if (hi == 0) li_l[r32] = l;
  asm volatile("s_waitcnt lgkmcnt(0)" ::: "memory");
  float rli[16];
#pragma unroll
  for (int r = 0; r < 16; ++r) rli[r] = __builtin_amdgcn_rcpf(li_l[crow(r, hi)]);
  float t1 = p.b_lq1[lane] * p.b_lk1[lane], t2 = p.b_lq2[lane] * p.b_lk2[lane];
  t1 = wave_sum(t1); t2 = wave_sum(t2);
  const float lam = __expf(t1) - __expf(t2) + 0.2f;
  __syncthreads();
  float* xch = (float*)lds;
  if (m == 1) {
#pragma unroll
    for (int r = 0; r < 16; ++r)
#pragma unroll
      for (int d0 = 0; d0 < 4; ++d0) xch[(wl * 32 + crow(r, hi)) * 128 + d0 * 32 + r32] = o[d0][r] * rli[r];
  }
  __syncthreads();
  if (m == 0) {
    char* stg = lds + 69632 + wl * 8704;
    float sw4[4];
#pragma unroll
    for (int d0 = 0; d0 < 4; ++d0) sw4[d0] = p.b_subln_w[d0 * 32 + r32];
#pragma unroll
    for (int r = 0; r < 16; ++r) {
      const int row = wl * 32 + crow(r, hi); const int token = token0 + row;
      float a[4], ss = 0.f;
#pragma unroll
      for (int d0 = 0; d0 < 4; ++d0) { a[d0] = o[d0][r] * rli[r] - lam * xch[row * 128 + d0 * 32 + r32]; ss += a[d0] * a[d0]; }
      ss = xsum<1>(ss); ss = xsum<2>(ss); ss = xsum<4>(ss); ss = xsum<8>(ss); ss = xsum<16>(ss);
      const float rstd = rsqrtf(ss * (1.f / 128.f) + 1e-5f) * 0.8f;
#pragma unroll
      for (int d0 = 0; d0 < 4; ++d0) *reinterpret_cast<bf16_t*>(stg + crow(r, hi) * 272 + (d0 * 32 + r32) * 2) = f2bf(a[d0] * rstd * sw4[d0]);
    }
    asm volatile("s_waitcnt lgkmcnt(0)" ::: "memory");
    const size_t t0 = (size_t)(token0 + wl * 32);
    gated_rows_out(stg, lane, ZB + t0 * 512 + h * 128, 512, MIX + t0 * 1024 + 512 + h * 128, 1024);
  }
  __syncthreads();
}

DEVI void attn1_item(int wv, const Params& p, int b, int h, int qb, char* lds) {
  const int tid = tidx(wv), wid = tid >> 6, lane = tid & 63, r32 = lane & 31, hi = lane >> 5;
  const bf16_t* Q1 = (const bf16_t*)(p.ws + OFF_Q1); const bf16_t* K1 = (const bf16_t*)(p.ws + OFF_K1); const bf16_t* V1 = (const bf16_t*)(p.ws + OFF_V1);
  const bf16_t* Z1 = (const bf16_t*)(p.ws + OFF_Z1); bf16_t* MIX = (bf16_t*)(p.ws + OFF_MIX);
  const int token0 = b * 2048 + qb * 256;
  const bf16_t* Qw = Q1 + (size_t)(token0 + wid * 32 + r32) * 1536 + h * 192 + hi * 8;
  f32x16 o[4]; float l;
  attn_core_pp<192, 12, 1, 4>(wv, Qw, K1 + (size_t)(b * 8 + h) * KVL * 192, V1 + (size_t)(b * 8 + h) * KVL * 128, 0, KVL / 64, lds, o, l);
  float* li_l = (float*)(lds + 32768 + 2 * 64 * 400) + wid * 64;
  if (hi == 0) li_l[r32] = l;
  asm volatile("s_waitcnt lgkmcnt(0)" ::: "memory");
  char* stg = lds + wid * 8704;
#pragma unroll
  for (int r = 0; r < 16; ++r) {
    const int cr = crow(r, hi); const float rl = __builtin_amdgcn_rcpf(li_l[cr]);
#pragma unroll
    for (int d0 = 0; d0 < 4; ++d0) *reinterpret_cast<bf16_t*>(stg + cr * 272 + (d0 * 32 + r32) * 2) = f2bf(o[d0][r] * rl);
  }
  asm volatile("s_waitcnt lgkmcnt(0)" ::: "memory");
  const size_t t0 = (size_t)(token0 + wid * 32);
  gated_rows_out(stg, lane, Z1 + t0 * 1024 + h * 128, 1024, MIX + t0 * 1024 + h * 128, 1024);
  __syncthreads();
}

DEVI void abranch_item(int wv, const Params& p, int ci, char* lds) {
  const int tid = tidx(wv), wid = tid >> 6, lane = tid & 63, r32 = lane & 31, hi = lane >> 5;
  const bf16_t* GV = (const bf16_t*)(p.ws + OFF_GV); const bf16_t* U = (const bf16_t*)(p.ws + OFF_U); const bf16_t* ZA = (const bf16_t*)(p.ws + OFF_ZA);
  const bf16_t* WSB = (const bf16_t*)(p.ws + OFF_WSB); bf16_t* MIX = (bf16_t*)(p.ws + OFF_MIX);
  const int t0 = ci * 128;
  bf16_t* vnT = (bf16_t*)lds;
  {
    const int pos = tid >> 2, cp = tid & 3;
    const bf16_t* g = GV + (size_t)(t0 + pos) * 512;
    float s = 0.f, q = 0.f;
#pragma unroll 4
    for (int i = 0; i < 16; ++i) {
      const bf16x8 raw = *reinterpret_cast<const bf16x8*>(g + (i * 4 + cp) * 8);
#pragma unroll
      for (int e = 0; e < 8; ++e) { const float xv = bf2f((bf16_t)raw[e]); s += xv; q += xv * xv; }
    }
    s = xsum<1>(s); s = xsum<2>(s); q = xsum<1>(q); q = xsum<2>(q);
    const float mu = s * (1.f / 512.f);
    const float rstd = rsqrtf(fmaxf(q * (1.f / 512.f) - mu * mu, 0.f) + 1e-5f);
#pragma unroll 2
    for (int i = 0; i < 16; ++i) {
      const int c0 = (i * 4 + cp) * 8;
      const bf16x8 raw = *reinterpret_cast<const bf16x8*>(g + c0);
      const f32x4 w0 = *reinterpret_cast<const f32x4*>(p.a_ln_w + c0), w1 = *reinterpret_cast<const f32x4*>(p.a_ln_w + c0 + 4);
      const f32x4 b0 = *reinterpret_cast<const f32x4*>(p.a_ln_b + c0), b1 = *reinterpret_cast<const f32x4*>(p.a_ln_b + c0 + 4);
#pragma unroll
      for (int e = 0; e < 8; ++e) {
        const float wv = e < 4 ? w0[e & 3] : w1[e & 3], bv = e < 4 ? b0[e & 3] : b1[e & 3];
        vnT[(c0 + e) * 136 + pos] = f2bf((bf2f((bf16_t)raw[e]) - mu) * rstd * wv + bv);
      }
    }
  }
  __syncthreads();
  const int g8 = wid;
  const bf16_t* Wg = WSB + g8 * 128 * 128;
  for (int pb = 0; pb < 4; ++pb) {
    f32x16 acc[2];
#pragma unroll
    for (int r = 0; r < 16; ++r) { acc[0][r] = 0.f; acc[1][r] = 0.f; }
#pragma unroll
    for (int ks = 0; ks < 8; ++ks) {
      const bf16x8 bw = *reinterpret_cast<const bf16x8*>(Wg + (pb * 32 + r32) * 128 + ks * 16 + hi * 8);
#pragma unroll
      for (int db = 0; db < 2; ++db) {
        const bf16x8 a = *reinterpret_cast<const bf16x8*>(vnT + (g8 * 64 + db * 32 + r32) * 136 + ks * 16 + hi * 8);
        acc[db] = __builtin_amdgcn_mfma_f32_32x32x16_bf16(a, bw, acc[db], 0, 0, 0);
      }
    }
    const int token = t0 + pb * 32 + r32; const float bias = p.a_bs[g8 * 128 + pb * 32 + r32];
#pragma unroll
    for (int db = 0; db < 2; ++db)
#pragma unroll
      for (int rg = 0; rg < 4; ++rg) {
        const int c = g8 * 64 + db * 32 + rg * 8 + hi * 4;
        const u32x2 u2 = *reinterpret_cast<const u32x2*>(U + (size_t)token * 512 + c), z2 = *reinterpret_cast<const u32x2*>(ZA + (size_t)token * 512 + c);
        const float o0 = bflo(u2[0]) * (acc[db][rg * 4 + 0] + bias) * bflo(z2[0]), o1 = bfhi(u2[0]) * (acc[db][rg * 4 + 1] + bias) * bfhi(z2[0]);
        const float o2 = bflo(u2[1]) * (acc[db][rg * 4 + 2] + bias) * bflo(z2[1]), o3 = bfhi(u2[1]) * (acc[db][rg * 4 + 3] + bias) * bfhi(z2[1]);
        u32x2 pk = {cvtpk(o0, o1), cvtpk(o2, o3)};
        *reinterpret_cast<u32x2*>(MIX + (size_t)token * 1024 + c) = pk;
      }
  }
  __syncthreads();
}

DEVI void tr_tile(int wv, const float* __restrict__ src, bf16_t* __restrict__ dst, int K, int N, int tilesN, const float* __restrict__ scale, int t, char* lds) {
  const int tid = tidx(wv);
  const int k0 = (t / tilesN) * 64, n0 = (t % tilesN) * 64;
  const int kr = tid >> 3, ng = (tid & 7) * 8;
  f32x4 v0 = {0.f, 0.f, 0.f, 0.f}, v1 = {0.f, 0.f, 0.f, 0.f};
  if (n0 + ng < N) { const float* s = src + (size_t)(k0 + kr) * N + n0 + ng; v0 = *reinterpret_cast<const f32x4*>(s); v1 = *reinterpret_cast<const f32x4*>(s + 4); }
  const float scv = scale ? scale[k0 + kr] : 1.f;
  bf16_t* tl = (bf16_t*)lds;
#pragma unroll
  for (int e = 0; e < 4; ++e) { tl[(ng + e) * 72 + kr] = f2bf(v0[e] * scv); tl[(ng + 4 + e) * 72 + kr] = f2bf(v1[e] * scv); }
  __syncthreads();
  const int n = tid >> 3, kc = (tid & 7) * 8;
  *reinterpret_cast<bf16x8*>(dst + (size_t)(n0 + n) * K + k0 + kc) = *reinterpret_cast<const bf16x8*>(tl + n * 72 + kc);
}

DEVI void phase0(int wv, const Params& p, char* lds) {
  const int tid = tidx(wv);
  constexpr int N_ADA = 192, N_TR = 1952, N_WS = 16;
  for (int it = blockIdx.x; it < N_ADA + N_TR + N_WS + 1; it += gridDim.x) {
    if (it < N_ADA) {
      const int li = it / 96, chunk = it % 96;
      float* sc = (float*)lds;
      for (int idx = tid; idx < 17 * 1024; idx += 512) { const int r = idx >> 10, k = idx & 1023; const float xv = r < 16 ? p.c[r * 1024 + k] : p.c_ctx[k]; sc[idx] = xv / (1.f + expf(-xv)); }
      __syncthreads();
      const int col = tid & 31, kp = tid >> 5;
      const float* w = p.ada_w + (size_t)li * 1024 * 3072 + chunk * 32 + col;
      float acc[17];
#pragma unroll
      for (int r = 0; r < 17; ++r) acc[r] = 0.f;
#pragma unroll 8
      for (int k = kp * 64; k < kp * 64 + 64; ++k) {
        const float wv = w[(size_t)k * 3072];
#pragma unroll
        for (int r = 0; r < 17; ++r) acc[r] += sc[r * 1024 + k] * wv;
      }
      float* red = (float*)(lds + 17 * 1024 * 4);
#pragma unroll
      for (int r = 0; r < 17; ++r) red[(kp * 17 + r) * 32 + col] = acc[r];
      __syncthreads();
      float* ada = (float*)(p.ws + OFF_ADA);
      for (int idx = tid; idx < 544; idx += 512) {
        const int r = idx >> 5, cc = idx & 31; float s = 0.f;
        for (int k2 = 0; k2 < 16; ++k2) s += red[(k2 * 17 + r) * 32 + cc];
        ada[(size_t)(li * 17 + r) * 3072 + chunk * 32 + cc] = s + p.ada_b[li * 3072 + chunk * 32 + cc];
      }
    } else if (it < N_ADA + N_TR) {
      int t = it - N_ADA;
      if (t < 896) tr_tile(wv, p.even_w_in, (bf16_t*)(p.ws + OFF_W0IN), 1024, 3584, 56, nullptr, t, lds);
      else if (t < 1152) tr_tile(wv, p.even_w_out, (bf16_t*)(p.ws + OFF_W0OUT), 1024, 1024, 16, nullptr, t - 896, lds);
      else if (t < 1536) tr_tile(wv, p.odd_w_in, (bf16_t*)(p.ws + OFF_W1IN), 1024, 1472, 24, nullptr, t - 1152, lds);
      else if (t < 1632) tr_tile(wv, p.c_wq_b, (bf16_t*)(p.ws + OFF_WQ), 256, 1536, 24, p.c_q_norm_w, t - 1536, lds);
      else if (t < 1696) tr_tile(wv, p.c_wkv_b, (bf16_t*)(p.ws + OFF_WKV), 128, 2048, 32, p.c_kv_norm_w, t - 1632, lds);
      else tr_tile(wv, p.odd_w_out, (bf16_t*)(p.ws + OFF_W1OUT), 1024, 1024, 16, nullptr, t - 1696, lds);
    } else if (it < N_ADA + N_TR + N_WS) {
      const int base = (it - N_ADA - N_TR) * 8192 + tid * 16;
      bf16_t* dst = (bf16_t*)(p.ws + OFF_WSB) + base; const float* s = p.a_ws + base;
#pragma unroll
      for (int q = 0; q < 2; ++q) {
        const f32x4 a = *reinterpret_cast<const f32x4*>(s + q * 8), b = *reinterpret_cast<const f32x4*>(s + q * 8 + 4);
        u32x4 w = {cvtpk(a[0], a[1]), cvtpk(a[2], a[3]), cvtpk(b[0], b[1]), cvtpk(b[2], b[3])};
        *reinterpret_cast<u32x4*>(dst + q * 8) = w;
      }
    } else {
      float2* tab = (float2*)(p.ws + OFF_ROPE);
      for (int e = tid; e < 1024; e += 512) {
        const int pos = e >> 4, j = e & 15;
        const float inv = exp2f(-(float)j * (13.287712379549449f / 16.f));
        const float ang = (float)pos * inv;
        const float nrev = rintf(ang * 0.15915494309189535f);
        float rr = fmaf(-nrev, 6.2831855f, ang); rr = fmaf(-nrev, -1.7484555e-7f, rr);
        tab[e] = make_float2(__cosf(rr), __sinf(rr));
      }
    }
    __syncthreads();
  }
}

template <bool RES>
DEVI void norm_mod(int wv, const float* src_lat, const float* src_ctx, const float* __restrict__ nw, const float* __restrict__ ada, bf16_t* X,
                   int row_lo, int row_hi, int vb, int nvb, const float* __restrict__ ada_prev = nullptr, float* hdst_lat = nullptr, float* hdst_ctx = nullptr) {
  const int tid_ = tidx(wv); const int wid = tid_ >> 6, lane = tid_ & 63;
  for (int row0 = row_lo + (vb * 8 + wid) * 2; row0 < row_hi; row0 += nvb * 16) {
    f32x4 v[2][4]; u32x2 ov[2][4]; float ss[2];
#pragma unroll
    for (int q = 0; q < 2; ++q) {
      const int row = row0 + q;
      const float* src = row < NLAT ? src_lat + (size_t)row * 1024 : src_ctx + (size_t)(row - NLAT) * 1024;
      ss[q] = 0.f;
#pragma unroll
      for (int i = 0; i < 4; ++i) {
        v[q][i] = *reinterpret_cast<const f32x4*>(src + i * 256 + lane * 4);
        if constexpr (RES) ov[q][i] = *reinterpret_cast<const u32x2*>(X + (size_t)row * 1024 + i * 256 + lane * 4);
      }
    }
    if constexpr (RES) {
#pragma unroll
      for (int q = 0; q < 2; ++q) {
        const int row = row0 + q;
        const float* gp = ada_prev + (row < NLAT ? (row >> 11) : 16) * 3072 + 2048;
        float* hd = row < NLAT ? hdst_lat + (size_t)row * 1024 : hdst_ctx + (size_t)(row - NLAT) * 1024;
#pragma unroll
        for (int i = 0; i < 4; ++i) {
          const int c = i * 256 + lane * 4;
          const f32x4 g = *reinterpret_cast<const f32x4*>(gp + c);
          v[q][i][0] += g[0] * bflo(ov[q][i][0]); v[q][i][1] += g[1] * bfhi(ov[q][i][0]); v[q][i][2] += g[2] * bflo(ov[q][i][1]); v[q][i][3] += g[3] * bfhi(ov[q][i][1]);
          *reinterpret_cast<f32x4*>(hd + c) = v[q][i];
        }
      }
    }
#pragma unroll
    for (int q = 0; q < 2; ++q) {
#pragma unroll
      for (int i = 0; i < 4; ++i) ss[q] += v[q][i][0] * v[q][i][0] + v[q][i][1] * v[q][i][1] + v[q][i][2] * v[q][i][2] + v[q][i][3] * v[q][i][3];
      ss[q] = wave_sum(ss[q]);
    }
#pragma unroll
    for (int q = 0; q < 2; ++q) {
      const int row = row0 + q;
      const float* ad = ada + (row < NLAT ? (row >> 11) : 16) * 3072;
      const float r = rsqrtf(ss[q] * (1.f / 1024.f) + 1e-6f);
#pragma unroll
      for (int i = 0; i < 4; ++i) {
        const int c = i * 256 + lane * 4;
        const f32x4 w = *reinterpret_cast<const f32x4*>(nw + c), sh = *reinterpret_cast<const f32x4*>(ad + c), scl = *reinterpret_cast<const f32x4*>(ad + 1024 + c);
        float o[4];
#pragma unroll
        for (int e = 0; e < 4; ++e) o[e] = v[q][i][e] * r * w[e] * (1.f + scl[e]) + sh[e];
        u32x2 pk = {cvtpk(o[0], o[1]), cvtpk(o[2], o[3])};
        *reinterpret_cast<u32x2*>(X + (size_t)row * 1024 + c) = pk;
      }
    }
  }
}

DEVI void final_norm(int wv, float* out, const float* __restrict__ fw, const bf16_t* __restrict__ O1, const float* __restrict__ ada1) {
  const int tid_ = tidx(wv); const int wid = tid_ >> 6, lane = tid_ & 63;
  for (int row0 = (blockIdx.x * 8 + wid) * 2; row0 < NLAT; row0 += gridDim.x * 16) {
    f32x4 v[2][4]; u32x2 ov[2][4]; float ss[2];
#pragma unroll
    for (int q = 0; q < 2; ++q) {
      ss[q] = 0.f;
#pragma unroll
      for (int i = 0; i < 4; ++i) {
        v[q][i] = *reinterpret_cast<const f32x4*>(out + (size_t)(row0 + q) * 1024 + i * 256 + lane * 4);
        ov[q][i] = *reinterpret_cast<const u32x2*>(O1 + (size_t)(row0 + q) * 1024 + i * 256 + lane * 4);
      }
    }
#pragma unroll
    for (int q = 0; q < 2; ++q) {
      const float* gp = ada1 + ((row0 + q) >> 11) * 3072 + 2048;
#pragma unroll
      for (int i = 0; i < 4; ++i) {
        const f32x4 g = *reinterpret_cast<const f32x4*>(gp + i * 256 + lane * 4);
        v[q][i][0] += g[0] * bflo(ov[q][i][0]); v[q][i][1] += g[1] * bfhi(ov[q][i][0]); v[q][i][2] += g[2] * bflo(ov[q][i][1]); v[q][i][3] += g[3] * bfhi(ov[q][i][1]);
        ss[q] += v[q][i][0] * v[q][i][0] + v[q][i][1] * v[q][i][1] + v[q][i][2] * v[q][i][2] + v[q][i][3] * v[q][i][3];
      }
      ss[q] = wave_sum(ss[q]);
    }
#pragma unroll
    for (int q = 0; q < 2; ++q) {
      const float r = rsqrtf(ss[q] * (1.f / 1024.f) + 1e-6f);
#pragma unroll
      for (int i = 0; i < 4; ++i) {
        const int c = i * 256 + lane * 4;
        const f32x4 w = *reinterpret_cast<const f32x4*>(fw + c);
        *reinterpret_cast<f32x4*>(out + (size_t)(row0 + q) * 1024 + c) = v[q][i] * r * w;
      }
    }
  }
}

typedef const __attribute__((address_space(4))) Params* KArgP;
DEVI void run_phase(int wv, KArgP pp, int ph, char* lds) {
#if defined(__HIP_DEVICE_COMPILE__)
  asm volatile("" : "+s"(pp));
  char* ws = pp->ws;
  const float2* rope = (const float2*)(ws + OFF_ROPE);
  const float* ada0 = (const float*)(ws + OFF_ADA); const float* ada1 = ada0 + 17 * 3072;
  bf16_t* X = (bf16_t*)(ws + OFF_X); bf16_t* MIX = (bf16_t*)(ws + OFF_MIX);
  const int G = gridDim.x, B = blockIdx.x;
  PG8_LAS unsigned char* ldsp = (PG8_LAS unsigned char*)lds;
  switch (ph) {
    case 0: { const Params p = *pp; phase0(wv, p, lds); } break;
    case 1: norm_mod<false>(wv, pp->x, pp->ctx, pp->norm_w, ada0, X, 0, NTOK, B, G); break;
    case 2: {
      EpiL0In epi{(bf16_t*)(ws + OFF_U), (bf16_t*)(ws + OFF_GV), (bf16_t*)(ws + OFF_ZA), (bf16_t*)(ws + OFF_ZB), (bf16_t*)(ws + OFF_Q0), (bf16_t*)(ws + OFF_K0), (bf16_t*)(ws + OFF_V0), rope};
      gemm_phase(wv, ldsp, X, (const bf16_t*)(ws + OFF_W0IN), 1024, Sched{14, 144 * 14, 144 * 14, 0, 0}, epi);
    } break;
    case 3: { const Params p = *pp;
      for (int it = B; it < 1024 + 288 + 128; it += G) {
        if (it < 1024) {
          const int xcd = it & 7, slot = (it >> 3) & 31, rd = it >> 8;
          const int bh = rd * 16 + xcd * 2 + (slot >> 4), qb = slot & 15, b = bh >> 2, h = bh & 3;
          attn0_item(wv, p, b * 2048 + qb * 128, b, h, KVL, lds);
        } else if (it < 1024 + 288) abranch_item(wv, p, it - 1024, lds);
        else { const int i2 = it - 1312; const int b = i2 >> 3, h = (i2 >> 1) & 3, qb = i2 & 1; attn0_item(wv, p, NLAT + b * 256 + qb * 128, b, h, 256, lds); }
      }
    } break;
    case 4: {
      EpiPlain epi{X};
      gemm_phase(wv, ldsp, MIX, (const bf16_t*)(ws + OFF_W0OUT), 1024, Sched{4, 144 * 4, 144 * 4, 0, 0}, epi);
    } break;
    case 5: {
      if (B >= G - 16) {
        const int cp = B - (G - 16);
        norm_mod<true>(wv, pp->x, pp->ctx, pp->norm_w + 1024, ada1, X, NLAT + cp * 256, NLAT + cp * 256 + 256, 0, 1, ada0, pp->out, (float*)(ws + OFF_H1C));
        asm volatile("s_waitcnt vmcnt(0)" ::: "memory"); __syncthreads();
        EpiL1In epi{(bf16_t*)(ws + OFF_CQ), (bf16_t*)(ws + OFF_CKV), (bf16_t*)(ws + OFF_K1), (bf16_t*)(ws + OFF_Z1), (float*)(ws + OFF_RQ), (float*)(ws + OFF_RKV), rope, (float*)(lds + LDS_SS)};
        gemm_phase(wv, ldsp, X, (const bf16_t*)(ws + OFF_W1IN), 1024, Sched{6, 0, 16, 128, 1, G - 16}, epi);
      } else norm_mod<true>(wv, pp->x, pp->ctx, pp->norm_w + 1024, ada1, X, 0, NLAT, B, G - 16, ada0, pp->out, (float*)(ws + OFF_H1C));
    } break;
    case 6: {
      EpiL1In epi{(bf16_t*)(ws + OFF_CQ), (bf16_t*)(ws + OFF_CKV), (bf16_t*)(ws + OFF_K1), (bf16_t*)(ws + OFF_Z1), (float*)(ws + OFF_RQ), (float*)(ws + OFF_RKV), rope, (float*)(lds + LDS_SS)};
      gemm_phase(wv, ldsp, X, (const bf16_t*)(ws + OFF_W1IN), 1024, Sched{6, 768, 768, 128, 1}, epi);
    } break;
    case 7: {
      EpiQ eq{(bf16_t*)(ws + OFF_Q1), (const float*)(ws + OFF_RQ), rope};
      EpiKV ek{(bf16_t*)(ws + OFF_K1), (bf16_t*)(ws + OFF_V1), (const float*)(ws + OFF_RKV)};
      gemm_phase(wv, ldsp, (const bf16_t*)(ws + OFF_CQ), (const bf16_t*)(ws + OFF_WQ), 256, Sched{6, 768, 768, 0, 0}, eq);
      gemm_phase(wv, ldsp, (const bf16_t*)(ws + OFF_CKV), (const bf16_t*)(ws + OFF_WKV), 128, Sched{8, 1152, 1152, 0, 0}, ek);
    } break;
    case 8: { const Params p = *pp;
      for (int it = B; it < 1024; it += G) {
        const int xcd = it & 7, slot = (it >> 3) & 31, rd = it >> 8;
        const int bh = rd * 32 + xcd * 4 + (slot >> 3), qb = slot & 7;
        attn1_item(wv, p, bh >> 3, bh & 7, qb, lds);
      }
    } break;
    case 9: {
      EpiPlain epi{X};
      gemm_phase(wv, ldsp, MIX, (const bf16_t*)(ws + OFF_W1OUT), 1024, Sched{4, 128 * 4, 128 * 4, 0, 0}, epi);
    } break;
    case 10: final_norm(wv, pp->out, pp->final_w, X, ada1); break;
  }
#endif
}


#define XB_TMO      128
#define XB_XCNT(j)  (256  + 64 * (j))
#define XB_XSUB(j)  (1280 + 64 * (j))
#define XB_XGEN(j)  (2304 + 64 * (j))
#define XB_TOP      3328
#define XB_TOPGEN   3392
#define XCD_BAR_WORDS 3456
#define XB_SPIN_CAP (1u << 18)
#define LAS __attribute__((address_space(3)))
DEVI unsigned xb_ld(unsigned* p) { return __hip_atomic_load(p, __ATOMIC_RELAXED, __HIP_MEMORY_SCOPE_AGENT); }
DEVI unsigned xb_add(unsigned* p, unsigned v) { return __hip_atomic_fetch_add(p, v, __ATOMIC_RELAXED, __HIP_MEMORY_SCOPE_AGENT); }
DEVI unsigned xb_xcc_id() { return (unsigned)__builtin_amdgcn_s_getreg((3 << 11) | 20) & 0xFu; }
#define XB_SPIN(cond, bar) do { unsigned _sp = 0; while (cond) { __builtin_amdgcn_s_sleep(1); \
    if ((++_sp & 255u) == 0u) { if (xb_ld(&(bar)[XB_TMO])) break; if (_sp > XB_SPIN_CAP) { atomicAdd(&(bar)[XB_TMO], 1u); break; } } } } while (0)
struct XcdBarrier { unsigned* bar; unsigned x; volatile LAS unsigned* st; };
DEVI XcdBarrier xcd_barrier_post(int wv, unsigned* bar, volatile LAS unsigned* st) {
  XcdBarrier b; b.bar = bar; b.x = xb_xcc_id(); b.st = st;
  if (tidx(wv) == 0) (void)xb_add(&bar[XB_XCNT(b.x)], 1u);
  return b;
}
DEVI void xcd_barrier_complete(unsigned* bar, unsigned x, unsigned& nloc, unsigned& nx) {
  const unsigned G = gridDim.x * gridDim.y * gridDim.z;
  unsigned sum, cnt, mine, sp = 0u;
  for (;;) {
    sum = 0u; cnt = 0u; mine = 0u;
#pragma unroll
    for (unsigned j = 0; j < 16; ++j) { const unsigned c = xb_ld(&bar[XB_XCNT(j)]); sum += c; cnt += (c > 0u) ? 1u : 0u; mine = (j == x) ? c : mine; }
    if (sum == G) break;
    __builtin_amdgcn_s_sleep(1);
    if ((++sp & 255u) == 0u) { if (xb_ld(&bar[XB_TMO])) break; if (sp > XB_SPIN_CAP) { atomicAdd(&bar[XB_TMO], 1u); break; } }
  }
  nloc = mine > 0u ? mine : 1u; nx = cnt > 0u ? cnt : 1u;
}
DEVI void xcd_barrier(int wv, const XcdBarrier& b) {
  asm volatile("s_waitcnt vmcnt(0)" ::: "memory");
  __syncthreads();
  if (tidx(wv) == 0) {
    unsigned* bar = b.bar;
    __builtin_amdgcn_s_waitcnt(0);
    unsigned nloc = b.st[0], nx = b.st[1];
    if (nloc == 0u) { xcd_barrier_complete(bar, b.x, nloc, nx); b.st[0] = nloc; b.st[1] = nx; }
    const unsigned old = xb_add(&bar[XB_XSUB(b.x)], 1u);
    const unsigned gen = old / nloc;
    if (old + 1u == (gen + 1u) * nloc) {
      __builtin_amdgcn_fence(__ATOMIC_RELEASE, "agent");
      asm volatile("s_waitcnt vmcnt(0)" ::: "memory");
      const unsigned og = xb_add(&bar[XB_TOP], 1u);
      const unsigned tg = og / nx;
      if (og + 1u == (tg + 1u) * nx) xb_add(&bar[XB_TOPGEN], 1u);
      else XB_SPIN(xb_ld(&bar[XB_TOPGEN]) == tg, bar);
      __builtin_amdgcn_fence(__ATOMIC_ACQUIRE, "agent");
      xb_add(&bar[XB_XGEN(b.x)], 1u);
      asm volatile("s_waitcnt vmcnt(0)" ::: "memory");
    } else {
      XB_SPIN(xb_ld(&bar[XB_XGEN(b.x)]) == gen, bar);
      __builtin_amdgcn_fence(__ATOMIC_ACQUIRE, "agent");
      asm volatile("s_waitcnt vmcnt(0)" ::: "memory");
    }
  }
  __syncthreads();
}

extern __shared__ __attribute__((aligned(16))) char g_lds[];

constexpr int LDS_XB = 143360;
__global__ void __launch_bounds__(512) mega(Params p) {
  cg::grid_group grid = cg::this_grid();
  if (p.ph_hi > 64) grid.sync();
  const int wv = __builtin_amdgcn_readfirstlane((int)threadIdx.x >> 6);
  volatile LAS unsigned* xst = (volatile LAS unsigned*)(g_lds + LDS_XB);
  if (tidx(wv) == 0) { xst[0] = 0u; xst[1] = 0u; }
  __syncthreads();
  (void)xcd_barrier_post(wv, (unsigned*)(p.ws + OFF_BAR), xst);
#define GRID_BARRIER() do { KArgP _pp = (KArgP)__builtin_amdgcn_kernarg_segment_ptr(); asm volatile("" : "+s"(_pp)); \
    XcdBarrier _xb; _xb.bar = (unsigned*)(_pp->ws + OFF_BAR); _xb.x = xb_xcc_id(); _xb.st = (volatile LAS unsigned*)(g_lds + LDS_XB); xcd_barrier(wv, _xb); } while (0)
  for (int ph = p.ph_lo; ph < p.ph_hi; ++ph) {
    run_phase(wv, (KArgP)__builtin_amdgcn_kernarg_segment_ptr(), ph, g_lds);
#ifdef PROBE_PH
    if (ph == PROBE_PH) { GRID_BARRIER(); run_phase(wv, (KArgP)__builtin_amdgcn_kernarg_segment_ptr(), ph, g_lds); }
#endif
    if (ph + 1 < p.ph_hi) GRID_BARRIER();
  }
}

extern "C" void kernel_launch(void* const* d_in, const int* in_sizes, int n_in, void* d_out, int out_size, void* d_ws, size_t ws_size, hipStream_t stream) {
  static int ok = 0;
  static int grid_blocks = 0;
  if (!ok) {
    if (n_in != 25 || ws_size < WS_NEED) { fprintf(stderr, "kernel_launch: bad args n_in %d ws %zu need %zu\n", n_in, ws_size, (size_t)WS_NEED); return; }
    if (hipFuncSetAttribute((const void*)mega, hipFuncAttributeMaxDynamicSharedMemorySize, LDS_BYTES) != hipSuccess) { fprintf(stderr, "kernel_launch: LDS attr failed\n"); return; }
    int dev = 0, cus = 0, per_cu = 0;
    hipGetDevice(&dev);
    hipDeviceGetAttribute(&cus, hipDeviceAttributeMultiprocessorCount, dev);
    hipOccupancyMaxActiveBlocksPerMultiprocessor(&per_cu, mega, 512, LDS_BYTES);
    if (per_cu < 1) per_cu = 1;
    grid_blocks = cus * per_cu;
    ok = 1;
  }
  Params p{};
  const float** pp = (const float**)&p;
  for (int i = 0; i < 25; ++i) pp[i] = (const float*)d_in[i];
  p.out = (float*)d_out; p.ws = (char*)d_ws;
#if ONE_LAUNCH
  p.ph_lo = 0; p.ph_hi = 11;
  hipMemsetAsync((char*)d_ws + OFF_BAR, 0, XCD_BAR_WORDS * 4, stream);
  void* args[] = {&p};
  hipError_t e = hipLaunchCooperativeKernel((const void*)mega, dim3(grid_blocks), dim3(512), args, LDS_BYTES, stream);
  if (e != hipSuccess) fprintf(stderr, "cooperative launch failed: %s (grid %d)\n", hipGetErrorString(e), grid_blocks);
#else
  for (int ph = 0; ph < 11; ++ph) {
    p.ph_lo = ph; p.ph_hi = ph + 1;
    hipLaunchKernelGGL(mega, dim3(grid_blocks), dim3(512), LDS_BYTES, stream, p);
  }
#endif
}
```

```cpp
#include <hip/hip_runtime.h>
#include <hip/hip_cooperative_groups.h>
#include <cstdio>
namespace cg = cooperative_groups;

#ifndef ATT_SD0
#define ATT_SD0 2
#endif
#ifndef ONE_LAUNCH
#define ONE_LAUNCH 1
#endif

typedef unsigned short bf16_t;
typedef short bf16x8 __attribute__((ext_vector_type(8)));
typedef short s16x4 __attribute__((ext_vector_type(4)));
typedef float f32x16 __attribute__((ext_vector_type(16)));
typedef float f32x4 __attribute__((ext_vector_type(4)));
typedef unsigned u32x4 __attribute__((ext_vector_type(4)));
typedef unsigned u32x2 __attribute__((ext_vector_type(2)));
#define DEVI __device__ __forceinline__
#define SBAR() __builtin_amdgcn_sched_barrier(0)
DEVI int tidx(int wv) { int l; asm volatile("v_mbcnt_lo_u32_b32 %0, -1, 0\n\tv_mbcnt_hi_u32_b32 %0, -1, %0" : "=v"(l)); return (wv << 6) | l; }

constexpr int NLAT = 32768, NCTX = 4096, NTOK = 36864, KVL = 2304;
constexpr int LDS_BYTES = 147456, LDS_SS = 139264;

constexpr size_t OFF_W0IN = 0;
constexpr size_t OFF_W0OUT = OFF_W0IN + 3584ull * 1024 * 2;
constexpr size_t OFF_W1IN = OFF_W0OUT + 1024ull * 1024 * 2;
constexpr size_t OFF_WQ = OFF_W1IN + 1536ull * 1024 * 2;
constexpr size_t OFF_WKV = OFF_WQ + 1536ull * 256 * 2;
constexpr size_t OFF_W1OUT = OFF_WKV + 2048ull * 128 * 2;
constexpr size_t OFF_WSB = OFF_W1OUT + 1024ull * 1024 * 2;
constexpr size_t OFF_ADA = OFF_WSB + 8ull * 128 * 128 * 2;
constexpr size_t OFF_ROPE = OFF_ADA + 2ull * 17 * 3072 * 4;
constexpr size_t OFF_BAR = OFF_ROPE + 64ull * 16 * 8;
constexpr size_t OFF_H1C = OFF_BAR + 16384;
constexpr size_t OFF_RQ = OFF_H1C + 4096ull * 1024 * 4;
constexpr size_t OFF_RKV = OFF_RQ + 32768ull * 4;
constexpr size_t OFF_X = OFF_RKV + 36864ull * 4;
constexpr size_t OFF_MIX = OFF_X + 36864ull * 1024 * 2;
constexpr size_t OFF_T = OFF_MIX + 36864ull * 1024 * 2;
constexpr size_t SZ_HALF = 36864ull * 512 * 2;
constexpr size_t OFF_U = OFF_T, OFF_GV = OFF_U + SZ_HALF, OFF_ZA = OFF_GV + SZ_HALF, OFF_ZB = OFF_ZA + SZ_HALF, OFF_Q0 = OFF_ZB + SZ_HALF;
constexpr size_t OFF_K0 = OFF_Q0 + SZ_HALF, OFF_V0 = OFF_K0 + 16ull * 4 * KVL * 128 * 2, END_L0 = OFF_V0 + 16ull * 4 * KVL * 128 * 2;
constexpr size_t OFF_CQ = OFF_T, OFF_CKV = OFF_CQ + 32768ull * 256 * 2, OFF_Z1 = OFF_CKV + 36864ull * 128 * 2;
constexpr size_t OFF_Q1 = OFF_Z1 + 32768ull * 1024 * 2, OFF_K1 = OFF_Q1 + 32768ull * 1536 * 2, END_L1 = OFF_K1 + 16ull * 8 * KVL * 192 * 2;
constexpr size_t OFF_V1 = OFF_X;
constexpr size_t WS_NEED = END_L1 > END_L0 ? END_L1 : END_L0;

struct Params {
  const float *x, *c, *ctx, *c_ctx, *norm_w, *ada_w, *ada_b, *even_w_in, *a_ws, *a_bs, *a_ln_w, *a_ln_b,
      *b_lq1, *b_lk1, *b_lq2, *b_lk2, *b_subln_w, *even_w_out, *odd_w_in, *c_q_norm_w, *c_wq_b,
      *c_kv_norm_w, *c_wkv_b, *odd_w_out, *final_w;
  float* out; char* ws; int ph_lo, ph_hi;
};

DEVI unsigned cvtpk(float lo, float hi) { unsigned r; asm("v_cvt_pk_bf16_f32 %0, %1, %2" : "=v"(r) : "v"(lo), "v"(hi)); return r; }
DEVI bf16_t f2bf(float v) { return (bf16_t)(cvtpk(v, 0.f) & 0xffffu); }
DEVI float bf2f(bf16_t v) { return __uint_as_float(((unsigned)v) << 16); }
DEVI float bflo(unsigned w) { return __uint_as_float(w << 16); }
DEVI float bfhi(unsigned w) { return __uint_as_float(w & 0xffff0000u); }
DEVI int crow(int r, int hi) { return (r & 3) + 8 * (r >> 2) + 4 * hi; }
DEVI float silu_f(float x) { return x * __builtin_amdgcn_rcpf(1.f + __builtin_amdgcn_exp2f(x * -1.4426950408889634f)); }
DEVI float gelu_f(float v) {
  const float t = __builtin_amdgcn_rcpf(fmaf(fabsf(v), 0.2316418882f, 1.0f));
  float q = fmaf(t, 0.5307027145f, -0.7265760135f); q = fmaf(q, t, 0.7107068705f); q = fmaf(q, t, -0.142248368f); q = fmaf(q, t, 0.127414796f); q *= t;
  const float m = v * (q * __builtin_amdgcn_exp2f(v * v * -0.72134752044f));
  return v < 0.f ? m : v - m;
}

template <int M> DEVI float xsum(float v) {
  if constexpr (M == 32) { auto rr = __builtin_amdgcn_permlane32_swap(__float_as_uint(v), __float_as_uint(v), false, false); return __uint_as_float(rr[0]) + __uint_as_float(rr[1]); }
  else return v + __int_as_float(__builtin_amdgcn_ds_swizzle(__float_as_int(v), (M << 10) | 0x1f));
}
DEVI float wave_sum(float v) { v = xsum<1>(v); v = xsum<2>(v); v = xsum<4>(v); v = xsum<8>(v); v = xsum<16>(v); return xsum<32>(v); }

DEVI void rope_tile(f32x16& v, const float2* __restrict__ tab, int pos, int hi) {
#pragma unroll
  for (int r = 0; r < 8; ++r) {
    const int jf = (r & 3) + 8 * (r >> 2) + 4 * hi;
    const float2 cs = tab[pos * 16 + jf];
    const float a = v[r], b = v[r + 8];
    v[r] = a * cs.x - b * cs.y; v[r + 8] = b * cs.x + a * cs.y;
  }
}
DEVI void store4(bf16_t* dst, const f32x16& v, int rg) {
  u32x2 pk = {cvtpk(v[rg * 4 + 0], v[rg * 4 + 1]), cvtpk(v[rg * 4 + 2], v[rg * 4 + 3])};
  *reinterpret_cast<u32x2*>(dst) = pk;
}

#define PG8_LAS __attribute__((address_space(3)))
constexpr int HTB = 128 * 64 * 2;
DEVI int lds_byte(int r, int c) { const int st = (r >> 4) * 2 + (c >> 5), rr = r & 15, cc = c & 31, ob = rr * 64 + cc * 2; return st * 1024 + (ob ^ (((ob >> 9) & 1) << 5)); }
DEVI void stage_rc(int b, int& R, int& C) { const int st = b / 1024, sb = b % 1024, swz = sb ^ (((sb >> 9) & 1) << 5); R = (st >> 1) * 16 + swz / 64; C = (st & 1) * 32 + (swz % 64) / 2; }
DEVI int perm32(int rho) { const int n = rho >> 4, i = rho & 15; return 8 * (i >> 2) + 4 * n + (i & 3); }
struct Unit { int pm, pn; };
struct Sched {
  int nN, nmain, ntotal, xpm0, xpn, boff = 0;
  DEVI bool next(int i, Unit& u) const {
    const int it = (int)blockIdx.x - boff + i * (int)gridDim.x; if (it < 0 || it >= ntotal) return false;
    if (it < nmain) { const int xcd = it & 7, jx = it >> 3; u.pm = (jx / nN) * 8 + xcd; u.pn = jx % nN; } else { u.pm = xpm0 + (it - nmain); u.pn = xpn; }
    return true;
  }
};
template <class Epi>
DEVI void gemm_phase(int wv, PG8_LAS unsigned char* lds, const bf16_t* gA, const bf16_t* gBt, const int K, const Sched& S, const Epi& E) {
  const int tid = tidx(wv), wid = __builtin_amdgcn_readfirstlane(tid >> 6), lane = tid & 63, wr = wid >> 2, wc = wid & 3, fr = lane & 15, fq = lane >> 4;
  const int nt = K / 64;
  unsigned voffA[2], voffB[2];
#pragma unroll
  for (int i = 0; i < 2; ++i) { int R, C; stage_rc(tid * 16 + i * 8192, R, C); const int Rb = (R & ~31) + perm32(R & 31); voffA[i] = (unsigned)(R * K + C) * 2u; voffB[i] = (unsigned)(Rb * K + C) * 2u; }
  const size_t kstep = (size_t)(64 * 2);
  const size_t hstep = (size_t)128 * K * 2;
  const size_t tstep = 2 * hstep;
  const unsigned ldsw = (unsigned)wid * 1024u;
  const int aoff = lds_byte(wr * 64 + fr, fq * 8), boff = lds_byte(wc * 32 + fr, fq * 8);
#define PG8_SA(b, h) (((b) * 2 + (h)) * HTB)
#define PG8_SB(b, h) ((4 + (b) * 2 + (h)) * HTB)
#define PG8_STAGE(bufoff, gbase, voff) do { _Pragma("unroll") for (int _i = 0; _i < 2; ++_i) \
    __builtin_amdgcn_global_load_lds((const unsigned*)((const char*)(gbase) + (voff)[_i]), (PG8_LAS unsigned*)(lds + (bufoff) + ldsw + _i * 8192), 16, 0, 0); } while (0)
#define PG8_LDA(dst, b, h) do { _Pragma("unroll") for (int m = 0; m < 4; ++m) _Pragma("unroll") for (int k = 0; k < 2; ++k) dst[m][k] = *(const PG8_LAS bf16x8*)(lds + PG8_SA(b, h) + aoff + m * 2048 + k * 1024); } while (0)
#define PG8_LDB(dst, b, h) do { _Pragma("unroll") for (int n = 0; n < 2; ++n) _Pragma("unroll") for (int k = 0; k < 2; ++k) dst[n][k] = *(const PG8_LAS bf16x8*)(lds + PG8_SB(b, h) + boff + n * 2048 + k * 1024); } while (0)
#define PG8_MMA(ai, bj, At, Bt) do { __builtin_amdgcn_s_setprio(1); _Pragma("unroll") for (int m = 0; m < 4; ++m) _Pragma("unroll") for (int n = 0; n < 2; ++n) _Pragma("unroll") for (int k = 0; k < 2; ++k) \
    acc[ai][bj][m][n] = __builtin_amdgcn_mfma_f32_16x16x32_bf16(Bt[n][k], At[m][k], acc[ai][bj][m][n], 0, 0, 0); __builtin_amdgcn_s_setprio(0); } while (0)
#define PG8_WAIT_V(n) asm volatile("s_waitcnt vmcnt(" #n ")" ::: "memory")
#define PG8_WAIT_L(n) asm volatile("s_waitcnt lgkmcnt(" #n ")" ::: "memory")
#define PG8_BAR __builtin_amdgcn_s_barrier()
#define PG8_SCHED __builtin_amdgcn_sched_barrier(0)
  Unit cur, nxt; int ui = 0;
  if (!S.next(0, cur)) return;
  f32x4 acc[2][2][4][2];
#pragma unroll
  for (int a = 0; a < 2; ++a)
#pragma unroll
    for (int b = 0; b < 2; ++b)
#pragma unroll
      for (int m = 0; m < 4; ++m)
#pragma unroll
        for (int n = 0; n < 2; ++n) acc[a][b][m][n] = (f32x4){0.f, 0.f, 0.f, 0.f};
  bf16x8 At[4][2], B0[2][2], B1[2][2];
  const char* cA = (const char*)gA + (size_t)cur.pm * tstep; const char* cB = (const char*)gBt + (size_t)cur.pn * tstep;
  PG8_STAGE(PG8_SB(0, 0), cB, voffB); PG8_STAGE(PG8_SA(0, 0), cA, voffA); PG8_STAGE(PG8_SB(0, 1), cB + hstep, voffB); PG8_STAGE(PG8_SA(0, 1), cA + hstep, voffA);
  if (wr == 1) PG8_BAR;
  PG8_WAIT_V(4); PG8_BAR;
  PG8_STAGE(PG8_SB(1, 0), cB + kstep, voffB); PG8_STAGE(PG8_SA(1, 0), cA + kstep, voffA); PG8_STAGE(PG8_SB(1, 1), cB + hstep + kstep, voffB);
  PG8_WAIT_V(6); PG8_BAR;
  for (;;) {
    const bool has_next = S.next(ui + 1, nxt);
    const char* nA = has_next ? (const char*)gA + (size_t)nxt.pm * tstep : cA; const char* nB = has_next ? (const char*)gBt + (size_t)nxt.pn * tstep : cB;
#pragma unroll 1
    for (int t = 0; t < nt; t += 2) {
      const bool last = (t == nt - 2);
      const char* a1 = cA + (size_t)(t + 1) * kstep;
      const char* a2 = last ? nA : cA + (size_t)(t + 2) * kstep; const char* b2 = last ? nB : cB + (size_t)(t + 2) * kstep;
      const char* a3 = a2 + kstep; const char* b3 = b2 + kstep;
      PG8_LDB(B0, 0, 0); PG8_SCHED; PG8_LDA(At, 0, 0); PG8_STAGE(PG8_SA(1, 1), a1 + hstep, voffA);
      PG8_WAIT_L(8); PG8_BAR; PG8_WAIT_L(0); PG8_MMA(0, 0, At, B0); PG8_BAR; PG8_SCHED;
      PG8_LDB(B1, 0, 1); PG8_STAGE(PG8_SB(0, 0), b2, voffB);
      PG8_BAR; PG8_WAIT_L(0); PG8_MMA(0, 1, At, B1); PG8_BAR;
      PG8_LDA(At, 0, 1); PG8_STAGE(PG8_SA(0, 0), a2, voffA);
      PG8_BAR; PG8_WAIT_L(0); PG8_MMA(1, 0, At, B0); PG8_BAR; PG8_SCHED;
      PG8_STAGE(PG8_SB(0, 1), b2 + hstep, voffB);
      PG8_WAIT_V(6); PG8_BAR; PG8_MMA(1, 1, At, B1); PG8_BAR;
      PG8_LDB(B0, 1, 0); PG8_SCHED; PG8_LDA(At, 1, 0); PG8_STAGE(PG8_SA(0, 1), a2 + hstep, voffA);
      PG8_WAIT_L(8); PG8_BAR; PG8_WAIT_L(0); PG8_MMA(0, 0, At, B0); PG8_BAR; PG8_SCHED;
      PG8_LDB(B1, 1, 1); PG8_STAGE(PG8_SB(1, 0), b3, voffB);
      PG8_BAR; PG8_WAIT_L(0); PG8_MMA(0, 1, At, B1); PG8_BAR;
      PG8_LDA(At, 1, 1); PG8_STAGE(PG8_SA(1, 0), a3, voffA);
      PG8_BAR; PG8_WAIT_L(0); PG8_MMA(1, 0, At, B0); PG8_BAR; PG8_SCHED;
      PG8_STAGE(PG8_SB(1, 1), b3 + hstep, voffB);
      PG8_WAIT_V(6); PG8_BAR; PG8_MMA(1, 1, At, B1); PG8_BAR;
    }
    E(acc, cur, wr, wc, fr, fq);
    if (!has_next) break;
#pragma unroll
    for (int a = 0; a < 2; ++a)
#pragma unroll
      for (int b = 0; b < 2; ++b)
#pragma unroll
        for (int m = 0; m < 4; ++m)
#pragma unroll
          for (int n = 0; n < 2; ++n) acc[a][b][m][n] = (f32x4){0.f, 0.f, 0.f, 0.f};
    cur = nxt; cA = nA; cB = nB; ++ui;
  }
  PG8_WAIT_V(0);
  if (wr == 0) PG8_BAR;
  PG8_BAR;
#undef PG8_SA
#undef PG8_SB
#undef PG8_STAGE
#undef PG8_LDA
#undef PG8_LDB
#undef PG8_MMA
#undef PG8_WAIT_V
#undef PG8_WAIT_L
#undef PG8_BAR
#undef PG8_SCHED
}

typedef f32x4 acc_t[2][2][4][2];
DEVI void token_info(int token, bool ctx, int& b, int& s, int& key) {
  if (!ctx) { b = token >> 11; s = token & 2047; key = 256 + s; } else { const int tc = token - NLAT; b = tc >> 8; s = 0; key = tc & 255; }
}
DEVI float swap32_partner(float v, bool upper) {
  auto rr = __builtin_amdgcn_permlane32_swap(__float_as_uint(v), __float_as_uint(v), false, false);
  return __uint_as_float(upper ? rr[0] : rr[1]);
}
DEVI void rope_pair(f32x4& v0, f32x4& v1, const float2* __restrict__ tab, int pos, int fq) {
  const bool upper = fq >= 2;
  const float2* t = tab + pos * 16 + (fq & 1) * 8;
  const f32x4 t0 = *reinterpret_cast<const f32x4*>(t), t1 = *reinterpret_cast<const f32x4*>(t + 2), t2 = *reinterpret_cast<const f32x4*>(t + 4), t3 = *reinterpret_cast<const f32x4*>(t + 6);
  const float cs[8] = {t0[0], t0[2], t1[0], t1[2], t2[0], t2[2], t3[0], t3[2]}, sn[8] = {t0[1], t0[3], t1[1], t1[3], t2[1], t2[3], t3[1], t3[3]};
#pragma unroll
  for (int e = 0; e < 4; ++e) {
    const float p0 = swap32_partner(v0[e], upper), p1 = swap32_partner(v1[e], upper);
    const float s0 = upper ? sn[e] : -sn[e], s1 = upper ? sn[4 + e] : -sn[4 + e];
    v0[e] = v0[e] * cs[e] + p0 * s0; v1[e] = v1[e] * cs[4 + e] + p1 * s1;
  }
}
DEVI void st8(bf16_t* dst, const f32x4& v0, const f32x4& v1) { u32x4 pk = {cvtpk(v0[0], v0[1]), cvtpk(v0[2], v0[3]), cvtpk(v1[0], v1[1]), cvtpk(v1[2], v1[3])}; *reinterpret_cast<u32x4*>(dst) = pk; }

struct EpiL0In {
  bf16_t *U, *GV, *ZA, *ZB, *Q0, *K0, *V0; const float2* rope;
  DEVI void operator()(acc_t& acc, const Unit& u, int wr, int wc, int fr, int fq) const {
    const int col0 = u.pn * 256, type = col0 >> 9; const bool ctx = u.pm >= 128;
#pragma unroll
    for (int ai = 0; ai < 2; ++ai)
#pragma unroll
      for (int m = 0; m < 4; ++m) {
        const int token = u.pm * 256 + ai * 128 + wr * 64 + m * 16 + fr;
        int b, s, key; token_info(token, ctx, b, s, key);
#pragma unroll
        for (int bj = 0; bj < 2; ++bj) {
          const int nl = (col0 & 511) + bj * 128 + wc * 32;
          f32x4 v0 = acc[ai][bj][m][0], v1 = acc[ai][bj][m][1];
          bf16_t* dst;
          if (type <= 1) {
#pragma unroll
            for (int e = 0; e < 4; ++e) { v0[e] = gelu_f(v0[e]); v1[e] = gelu_f(v1[e]); }
            dst = (type == 0 ? U : GV) + (size_t)token * 512 + nl;
          } else if (type == 2 || type == 6) {
#pragma unroll
            for (int e = 0; e < 4; ++e) { v0[e] = silu_f(v0[e]); v1[e] = silu_f(v1[e]); }
            dst = (type == 2 ? ZA : ZB) + (size_t)token * 512 + nl;
          } else if (type == 3) {
            if (!ctx) rope_pair(v0, v1, rope, (wc & 1) ? (s & 63) : (s >> 6), fq);
            dst = Q0 + (size_t)token * 512 + nl;
          } else if (type == 4) {
            if (!ctx) rope_pair(v0, v1, rope, (wc & 1) ? (s & 63) : (s >> 6), fq);
            dst = K0 + ((size_t)(b * 4 + (nl >> 7)) * KVL + key) * 128 + (nl & 127);
          } else {
            dst = V0 + ((size_t)(b * 4 + (nl >> 7)) * KVL + key) * 128 + (nl & 127);
          }
          st8(dst + fq * 8, v0, v1);
        }
      }
  }
};

template <bool HASCTX> struct EpiOut {
  const float* src_lat; const float* src_ctx; float* dst_lat; float* dst_ctx; const float* ada;
  DEVI void operator()(acc_t& acc, const Unit& u, int wr, int wc, int fr, int fq) const {
    const int col0 = u.pn * 256;
#pragma unroll
    for (int ai = 0; ai < 2; ++ai)
#pragma unroll
      for (int m = 0; m < 4; ++m) {
        const int token = u.pm * 256 + ai * 128 + wr * 64 + m * 16 + fr;
        const float* src; float* dst; const float* gate;
        if (!HASCTX || token < NLAT) { src = src_lat + (size_t)token * 1024; dst = dst_lat + (size_t)token * 1024; gate = ada + (token >> 11) * 3072 + 2048; }
        else { const int tc = token - NLAT; src = src_ctx + (size_t)tc * 1024; dst = dst_ctx + (size_t)tc * 1024; gate = ada + 16 * 3072 + 2048; }
#pragma unroll
        for (int bj = 0; bj < 2; ++bj)
#pragma unroll
          for (int n = 0; n < 2; ++n) {
            const int c = col0 + bj * 128 + wc * 32 + fq * 8 + n * 4;
            const f32x4 xv = *reinterpret_cast<const f32x4*>(src + c), g = *reinterpret_cast<const f32x4*>(gate + c);
            *reinterpret_cast<f32x4*>(dst + c) = xv + g * acc[ai][bj][m][n];
          }
      }
  }
};

struct EpiPlain {
  bf16_t* O;
  DEVI void operator()(acc_t& acc, const Unit& u, int wr, int wc, int fr, int fq) const {
    const int col0 = u.pn * 256;
#pragma unroll
    for (int ai = 0; ai < 2; ++ai)
#pragma unroll
      for (int m = 0; m < 4; ++m) {
        const int token = u.pm * 256 + ai * 128 + wr * 64 + m * 16 + fr;
#pragma unroll
        for (int bj = 0; bj < 2; ++bj) st8(O + (size_t)token * 1024 + col0 + bj * 128 + wc * 32 + fq * 8, acc[ai][bj][m][0], acc[ai][bj][m][1]);
      }
  }
};

struct EpiL1In {
  bf16_t *CQ, *CKV, *K1, *Z1; float *RQ, *RKV; const float2* rope; float* ssb;
  DEVI void operator()(acc_t& acc, const Unit& u, int wr, int wc, int fr, int fq) const {
    const int col0 = u.pn * 256; const bool ctx = u.pm >= 128;
    float ss[2][4];
#pragma unroll
    for (int ai = 0; ai < 2; ++ai)
#pragma unroll
      for (int m = 0; m < 4; ++m) {
        ss[ai][m] = 0.f;
        const int token = u.pm * 256 + ai * 128 + wr * 64 + m * 16 + fr;
        int b, s, key; token_info(token, ctx, b, s, key);
#pragma unroll
        for (int bj = 0; bj < 2; ++bj) {
          const int nb = col0 + bj * 128 + wc * 32;
          f32x4 v0 = acc[ai][bj][m][0], v1 = acc[ai][bj][m][1];
          if (nb < 384) {
#pragma unroll
            for (int e = 0; e < 4; ++e) ss[ai][m] += v0[e] * v0[e] + v1[e] * v1[e];
            bf16_t* dst = nb < 256 ? CQ + (size_t)token * 256 + nb : CKV + (size_t)token * 128 + (nb - 256);
            st8(dst + fq * 8, v0, v1);
          } else if (nb < 448) {
            if (!ctx) rope_pair(v0, v1, rope, (nb >= 416) ? (s & 63) : (s >> 6), fq);
#pragma unroll
            for (int h = 0; h < 8; ++h) {
              bf16_t* dst = K1 + ((size_t)(b * 8 + h) * KVL + key) * 192 + 128 + (nb - 384);
              st8(dst + fq * 8, v0, v1);
            }
          } else if (nb < 1472) {
            if (!ctx) {
#pragma unroll
              for (int e = 0; e < 4; ++e) { v0[e] = silu_f(v0[e]); v1[e] = silu_f(v1[e]); }
              bf16_t* dst = Z1 + (size_t)token * 1024 + (nb - 448);
              st8(dst + fq * 8, v0, v1);
            }
          }
        }
      }
    if (u.pn <= 1) {
#pragma unroll
      for (int ai = 0; ai < 2; ++ai)
#pragma unroll
        for (int m = 0; m < 4; ++m) {
          float sv = ss[ai][m]; sv = xsum<16>(sv); sv = xsum<32>(sv);
          if (fq == 0) ssb[wc * 256 + ai * 128 + wr * 64 + m * 16 + fr] = sv;
        }
      asm volatile("s_waitcnt lgkmcnt(0)" ::: "memory"); __builtin_amdgcn_s_barrier(); asm volatile("" ::: "memory");
      const int lt = wc * 64 + fq * 16 + fr;
      if (lt < 128) {
        const int row = (lt >> 6) * 128 + wr * 64 + (lt & 63);
        if (u.pn == 0) { const float tot = (ssb[row] + ssb[256 + row]) + (ssb[512 + row] + ssb[768 + row]); RQ[u.pm * 256 + row] = rsqrtf(tot * (1.f / 256.f) + 1e-6f); }
        else { const float tot = (ssb[row] + ssb[256 + row]) + (ssb[512 + row] + ssb[768 + row]); RKV[u.pm * 256 + row] = rsqrtf(tot * (1.f / 128.f) + 1e-6f); }
      }
    }
  }
};

struct EpiQ {
  bf16_t* Q1; const float* RQ; const float2* rope;
  DEVI void operator()(acc_t& acc, const Unit& u, int wr, int wc, int fr, int fq) const {
    const int col0 = u.pn * 256;
#pragma unroll
    for (int ai = 0; ai < 2; ++ai)
#pragma unroll
      for (int m = 0; m < 4; ++m) {
        const int token = u.pm * 256 + ai * 128 + wr * 64 + m * 16 + fr; const int s = token & 2047; const float rq = RQ[token];
#pragma unroll
        for (int bj = 0; bj < 2; ++bj) {
          const int n0 = col0 + bj * 128 + wc * 32; const int dd0 = n0 % 192;
          f32x4 v0 = acc[ai][bj][m][0] * rq, v1 = acc[ai][bj][m][1] * rq;
          if (dd0 >= 128) rope_pair(v0, v1, rope, (dd0 >= 160) ? (s & 63) : (s >> 6), fq);
          bf16_t* dst = Q1 + (size_t)token * 1536 + n0;
          st8(dst + fq * 8, v0, v1);
        }
      }
  }
};

struct EpiKV {
  bf16_t *K1, *V1; const float* RKV;
  DEVI void operator()(acc_t& acc, const Unit& u, int wr, int wc, int fr, int fq) const {
    const int col0 = u.pn * 256; const bool ctx = u.pm >= 128;
#pragma unroll
    for (int ai = 0; ai < 2; ++ai)
#pragma unroll
      for (int m = 0; m < 4; ++m) {
        const int token = u.pm * 256 + ai * 128 + wr * 64 + m * 16 + fr; const float rk = RKV[token];
        int b, s, key; token_info(token, ctx, b, s, key);
#pragma unroll
        for (int bj = 0; bj < 2; ++bj) {
          const int nb = col0 + bj * 128 + wc * 32; const int h = nb >> 8, dd = nb & 255;
          const f32x4 v0 = acc[ai][bj][m][0] * rk, v1 = acc[ai][bj][m][1] * rk;
          bf16_t* dst = dd < 128 ? K1 + ((size_t)(b * 8 + h) * KVL + key) * 192 + dd : V1 + ((size_t)(b * 8 + h) * KVL + key) * 128 + (dd - 128);
          st8(dst + fq * 8, v0, v1);
        }
      }
  }
};

template <int SCID> struct ScaleOf { static constexpr float v = SCID == 0 ? 0.125f : 0.07216878364870322f; };
constexpr float THR = 8.f;
template <int KW> DEVI int kswz(int row, int colB) { return row * (KW * 2 + 16) + colB; }
DEVI int v_st(int k, int c) { const int kk = (k & ~0xC) | ((k & 4) << 1) | ((k & 8) >> 1); return ((kk >> 3) * 4 + (c >> 5)) * 512 + ((kk & 7) * 32 + (c & 31)) * 2; }
DEVI int v_rd_base(int lane) { return ((lane & 3) << 3) | (((lane >> 2) & 3) << 6) | (((lane >> 4) & 1) << 5) | (((lane >> 5) & 1) << 8); }
constexpr int v_rd_off(int d0, int ks, int half) { return d0 * 512 + ks * 4096 + half * 2048; }
template <int OFF> DEVI s16x4 tr_read(int vb) { s16x4 r; asm volatile("ds_read_b64_tr_b16 %0, %1 offset:%2" : "=&v"(r) : "v"(vb), "i"(OFF) : "memory"); return r; }

template <int SCID>
DEVI void partialSM(f32x16& p0, f32x16& p1, float& m_reg, float& mn, float& alpha) {
  constexpr float SC = ScaleOf<SCID>::v; constexpr float C = SC * 1.4426950408889634f;
  float pmax = p0[0];
#pragma unroll
  for (int r = 1; r < 16; ++r) pmax = fmaxf(pmax, p0[r]);
#pragma unroll
  for (int r = 0; r < 16; ++r) pmax = fmaxf(pmax, p1[r]);
  { auto rr = __builtin_amdgcn_permlane32_swap(__float_as_uint(pmax), __float_as_uint(pmax), false, false);
    pmax = fmaxf(__uint_as_float(rr[0]), __uint_as_float(rr[1])); }
  if (__builtin_expect(__all(pmax - m_reg <= THR / SC), 1)) { mn = m_reg; alpha = 1.f; }
  else { mn = fmaxf(m_reg, pmax); alpha = __builtin_amdgcn_exp2f((m_reg - mn) * C); m_reg = mn; }
  const float mnC = -mn * C;
#pragma unroll
  for (int r = 0; r < 16; ++r) p0[r] = fmaf(p0[r], C, mnC);
#pragma unroll
  for (int r = 0; r < 16; ++r) p1[r] = fmaf(p1[r], C, mnC);
#pragma unroll
  for (int r = 0; r < 16; ++r) p0[r] = __builtin_amdgcn_exp2f(p0[r]);
}
DEVI void finishSM(f32x16& p0, f32x16& p1, float alpha, float& l_reg, bf16x8& pa0, bf16x8& pa1, bf16x8& pa2, bf16x8& pa3) {
#pragma unroll
  for (int r = 0; r < 16; ++r) p1[r] = __builtin_amdgcn_exp2f(p1[r]);
  float ps = 0;
#pragma unroll
  for (int r = 0; r < 16; ++r) ps += p0[r];
#pragma unroll
  for (int r = 0; r < 16; ++r) ps += p1[r];
  { auto rr = __builtin_amdgcn_permlane32_swap(__float_as_uint(ps), __float_as_uint(ps), false, false);
    ps = __uint_as_float(rr[0]) + __uint_as_float(rr[1]); }
  l_reg = l_reg * alpha + ps;
#define PK4(P, BASE, OUT) do { unsigned a0 = cvtpk(P[BASE + 0], P[BASE + 1]), a1 = cvtpk(P[BASE + 2], P[BASE + 3]); \
    unsigned b0 = cvtpk(P[BASE + 4], P[BASE + 5]), b1 = cvtpk(P[BASE + 6], P[BASE + 7]); \
    auto r0 = __builtin_amdgcn_permlane32_swap(a0, b0, false, false); auto r1 = __builtin_amdgcn_permlane32_swap(a1, b1, false, false); \
    u32x4 w = {r0[0], r1[0], r0[1], r1[1]}; OUT = *reinterpret_cast<bf16x8*>(&w); } while (0)
  PK4(p0, 0, pa0); PK4(p0, 8, pa1); PK4(p1, 0, pa2); PK4(p1, 8, pa3);
#undef PK4
}
template <int OFF> DEVI bf16x8 lds_rd128(int a) { bf16x8 r; asm volatile("ds_read_b128 %0, %1 offset:%2" : "=&v"(r) : "v"(a), "i"(OFF) : "memory"); return r; }
template <int N> DEVI void wait_lgkm() { asm volatile("s_waitcnt lgkmcnt(%0)" :: "n"(N) : "memory"); }
template <int NQ, int QL> constexpr bool q_is_lds(int s) { return QL > 0 && s >= NQ - QL && s < NQ; }
template <int NQ, int QL, int PF> constexpr int q_after(int d) {
  int n = q_is_lds<NQ, QL>(d + 1) ? 1 : 0;
  if (q_is_lds<NQ, QL>(d)) n += (d + PF < NQ ? 2 : 0);
  else for (int i = 1; i <= PF; ++i) n += (d + i < NQ ? 2 : 0);
  return n;
}
template <int KW, int NQ, int QL, int PF, int D0>
DEVI void qkt_step(f32x16& p0, f32x16& p1, int ka, const bf16x8* qr, int qa, bf16x8 (&kf)[PF + 1][2], bf16x8 (&qf)[2]) {
  if constexpr (D0 < NQ) {
    constexpr int ROW32 = 32 * (KW * 2 + 16);
    if constexpr (D0 + PF < NQ) { kf[(D0 + PF) % (PF + 1)][0] = lds_rd128<(D0 + PF) * 32>(ka); kf[(D0 + PF) % (PF + 1)][1] = lds_rd128<ROW32 + (D0 + PF) * 32>(ka); }
    if constexpr (q_is_lds<NQ, QL>(D0 + 1)) qf[(D0 + 1) & 1] = lds_rd128<(D0 + 1 - (NQ - QL)) * 32>(qa);
    wait_lgkm<q_after<NQ, QL, PF>(D0)>(); SBAR();
    bf16x8 q;
    if constexpr (q_is_lds<NQ, QL>(D0)) q = qf[D0 & 1]; else q = qr[D0];
    p0 = __builtin_amdgcn_mfma_f32_32x32x16_bf16(kf[D0 % (PF + 1)][0], q, p0, 0, 0, 0);
    p1 = __builtin_amdgcn_mfma_f32_32x32x16_bf16(kf[D0 % (PF + 1)][1], q, p1, 0, 0, 0);
    qkt_step<KW, NQ, QL, PF, D0 + 1>(p0, p1, ka, qr, qa, kf, qf);
  }
}
template <int KW, int NQ, int QL = 0>
DEVI void qkt(f32x16& p0, f32x16& p1, const char* Ks, const bf16x8* qr, int kcol0, int r32, int hi, const char* ql = nullptr) {
  constexpr int PF = QL > 0 ? 2 : 3;
#pragma unroll
  for (int r = 0; r < 16; ++r) { p0[r] = 0.f; p1[r] = 0.f; }
  const int ka = (int)(uintptr_t)(Ks + kswz<KW>(r32, (kcol0 + hi * 8) * 2)), qa = (int)(uintptr_t)ql;
  constexpr int ROW32 = 32 * (KW * 2 + 16);
  static_assert(NQ >= PF && (QL == 0 || NQ - QL >= PF), "prologue issues steps 0..PF-1 from register-q steps");
  bf16x8 kf[PF + 1][2], qf[2];
  asm volatile("s_waitcnt lgkmcnt(0)" ::: "memory");
  kf[0][0] = lds_rd128<0>(ka); kf[0][1] = lds_rd128<ROW32>(ka);
  kf[1][0] = lds_rd128<32>(ka); kf[1][1] = lds_rd128<ROW32 + 32>(ka);
  if constexpr (PF >= 3) { kf[2][0] = lds_rd128<64>(ka); kf[2][1] = lds_rd128<ROW32 + 64>(ka); }
  qkt_step<KW, NQ, QL, PF, 0>(p0, p1, ka, qr, qa, kf, qf);
}
template <int D0> DEVI void pv_one(f32x16& od, int vb, bf16x8 pa0, bf16x8 pa1, bf16x8 pa2, bf16x8 pa3) {
  const s16x4 l0 = tr_read<v_rd_off(D0, 0, 0)>(vb), h0 = tr_read<v_rd_off(D0, 0, 1)>(vb), l1 = tr_read<v_rd_off(D0, 1, 0)>(vb), h1 = tr_read<v_rd_off(D0, 1, 1)>(vb);
  const s16x4 l2 = tr_read<v_rd_off(D0, 2, 0)>(vb), h2 = tr_read<v_rd_off(D0, 2, 1)>(vb), l3 = tr_read<v_rd_off(D0, 3, 0)>(vb), h3 = tr_read<v_rd_off(D0, 3, 1)>(vb);
  asm volatile("s_waitcnt lgkmcnt(0)" ::: "memory"); SBAR();
#define PK(L, H) (bf16x8){L[0], L[1], L[2], L[3], H[0], H[1], H[2], H[3]}
  od = __builtin_amdgcn_mfma_f32_32x32x16_bf16(pa0, PK(l0, h0), od, 0, 0, 0);
  od = __builtin_amdgcn_mfma_f32_32x32x16_bf16(pa1, PK(l1, h1), od, 0, 0, 0);
  od = __builtin_amdgcn_mfma_f32_32x32x16_bf16(pa2, PK(l2, h2), od, 0, 0, 0);
  od = __builtin_amdgcn_mfma_f32_32x32x16_bf16(pa3, PK(l3, h3), od, 0, 0, 0);
#undef PK
}
template <int D0> DEVI void v_load(int vb, s16x4 (&f)[8]) {
  f[0] = tr_read<v_rd_off(D0, 0, 0)>(vb); f[1] = tr_read<v_rd_off(D0, 0, 1)>(vb); f[2] = tr_read<v_rd_off(D0, 1, 0)>(vb); f[3] = tr_read<v_rd_off(D0, 1, 1)>(vb);
  f[4] = tr_read<v_rd_off(D0, 2, 0)>(vb); f[5] = tr_read<v_rd_off(D0, 2, 1)>(vb); f[6] = tr_read<v_rd_off(D0, 3, 0)>(vb); f[7] = tr_read<v_rd_off(D0, 3, 1)>(vb);
}
DEVI void pv_mma(f32x16& od, const s16x4 (&f)[8], bf16x8 pa0, bf16x8 pa1, bf16x8 pa2, bf16x8 pa3) {
#define PK(L, H) (bf16x8){L[0], L[1], L[2], L[3], H[0], H[1], H[2], H[3]}
  od = __builtin_amdgcn_mfma_f32_32x32x16_bf16(pa0, PK(f[0], f[1]), od, 0, 0, 0);
  od = __builtin_amdgcn_mfma_f32_32x32x16_bf16(pa1, PK(f[2], f[3]), od, 0, 0, 0);
  od = __builtin_amdgcn_mfma_f32_32x32x16_bf16(pa2, PK(f[4], f[5]), od, 0, 0, 0);
  od = __builtin_amdgcn_mfma_f32_32x32x16_bf16(pa3, PK(f[6], f[7]), od, 0, 0, 0);
#undef PK
}
DEVI void pv_d0(f32x16* o, int vb, bf16x8 pa0, bf16x8 pa1, bf16x8 pa2, bf16x8 pa3) {
  s16x4 fa[8], fb[8];
  v_load<0>(vb, fa);
  v_load<1>(vb, fb); asm volatile("s_waitcnt lgkmcnt(8)" ::: "memory"); SBAR(); pv_mma(o[0], fa, pa0, pa1, pa2, pa3); SBAR();
  v_load<2>(vb, fa); asm volatile("s_waitcnt lgkmcnt(8)" ::: "memory"); SBAR(); pv_mma(o[1], fb, pa0, pa1, pa2, pa3); SBAR();
  v_load<3>(vb, fb); asm volatile("s_waitcnt lgkmcnt(8)" ::: "memory"); SBAR(); pv_mma(o[2], fa, pa0, pa1, pa2, pa3); SBAR();
  asm volatile("s_waitcnt lgkmcnt(0)" ::: "memory"); SBAR(); pv_mma(o[3], fb, pa0, pa1, pa2, pa3);
}

template <int KW, int NQ, int SCID>
DEVI void attn_core(int wv, const bf16_t* __restrict__ Qw, const bf16_t* __restrict__ Kh, const bf16_t* __restrict__ Vh, int kcol0, int NT, char* lds,
                    f32x16 (&o)[4], float& l_out) {
  constexpr int SHM_V = 64 * 128 * 2, SHM_K = 64 * (KW * 2 + 16), KC = KW / 64;
  const int tid = tidx(wv), wid = tid >> 6, lane = tid & 63, r32 = lane & 31, hi = lane >> 5;
  char* V_lds = lds; char* K_lds = lds + 2 * SHM_V;
  float* al_l = (float*)(lds + 2 * SHM_V + 2 * SHM_K) + wid * 64 + 32;
  float m_reg = -1e30f, l_reg = 0;
#pragma unroll
  for (int d = 0; d < 4; ++d)
#pragma unroll
    for (int r = 0; r < 16; ++r) o[d][r] = 0.f;
  bf16x8 qr[NQ];
#pragma unroll
  for (int d0 = 0; d0 < NQ; ++d0) qr[d0] = *reinterpret_cast<const bf16x8*>(Qw + d0 * 16);
  const int sr = tid >> 4, sc = (tid & 15) * 8, vst0 = v_st(sr, sc), vst1 = v_st(32 + sr, sc);
  const int krow = tid >> 3, kch = tid & 7;
  const bf16_t* vg = Vh + sr * 128 + sc;
  const bf16_t* kg = Kh + krow * KW + kch * 8;
  const int vb0 = (int)(uintptr_t)V_lds + v_rd_base(lane);
  bf16x8 vs0, vs1, ks[KC];
#define SLOAD(k0) do { vs0 = *reinterpret_cast<const bf16x8*>(vg + (size_t)(k0) * 128); vs1 = *reinterpret_cast<const bf16x8*>(vg + (size_t)((k0) + 32) * 128); \
    _Pragma("unroll") for (int _c = 0; _c < KC; ++_c) ks[_c] = *reinterpret_cast<const bf16x8*>(kg + (size_t)(k0) * KW + _c * 64); } while (0)
#define SWRITE(b) do { *reinterpret_cast<bf16x8*>(V_lds + (b) * SHM_V + vst0) = vs0; *reinterpret_cast<bf16x8*>(V_lds + (b) * SHM_V + vst1) = vs1; \
    _Pragma("unroll") for (int _c = 0; _c < KC; ++_c) *reinterpret_cast<bf16x8*>(K_lds + (b) * SHM_K + kswz<KW>(krow, (kch + 8 * _c) * 16)) = ks[_c]; } while (0)
  SLOAD(0); SWRITE(0);
  if (NT > 1) SLOAD(64);
  __syncthreads();
  for (int j = 0; j < NT; ++j) {
    const int bsel = j & 1;
    f32x16 p0, p1; float mn, alpha; bf16x8 pa0, pa1, pa2, pa3;
    qkt<KW, NQ>(p0, p1, K_lds + bsel * SHM_K, qr, kcol0, r32, hi);
    partialSM<SCID>(p0, p1, m_reg, mn, alpha);
    if (__any(alpha < 1.f)) {
      if (hi == 0) al_l[r32] = alpha;
      asm volatile("s_waitcnt lgkmcnt(0)" ::: "memory");
#pragma unroll
      for (int d = 0; d < 4; ++d)
#pragma unroll
        for (int r = 0; r < 16; ++r) o[d][r] *= al_l[crow(r, hi)];
    }
    finishSM(p0, p1, alpha, l_reg, pa0, pa1, pa2, pa3);
    pv_d0(o, vb0 + bsel * SHM_V, pa0, pa1, pa2, pa3);
    if (j + 1 < NT) { SWRITE(bsel ^ 1); if (j + 2 < NT) SLOAD((j + 2) * 64); }
    __syncthreads();
  }
  l_out = l_reg;
#undef SLOAD
#undef SWRITE
}

template <int KW, int NQ, int SDEPTH, int SCID, int QL>
DEVI void attn_core_pipe(int wv, const bf16_t* __restrict__ Qw, const bf16_t* __restrict__ Kh, const bf16_t* __restrict__ Vh, int kcol0, int NT, char* lds,
                         f32x16 (&o)[4], float& l_out) {
  constexpr int SHM_V = 64 * 128 * 2, SHM_K = 64 * (KW * 2 + 16), KC = KW / 64;
  const int tid = tidx(wv), wid = tid >> 6, lane = tid & 63, r32 = lane & 31, hi = lane >> 5;
  char* V_lds = lds; char* K_lds = lds + 2 * SHM_V;
  float* al_l = (float*)(lds + 2 * SHM_V + 2 * SHM_K) + wid * 64 + 32;
  float m_reg = -1e30f, l_reg = 0;
#pragma unroll
  for (int d = 0; d < 4; ++d)
#pragma unroll
    for (int r = 0; r < 16; ++r) o[d][r] = 0.f;
  bf16x8 qr[NQ - QL + (QL ? 1 : 0)];
#pragma unroll
  for (int d0 = 0; d0 < NQ - QL; ++d0) qr[d0] = *reinterpret_cast<const bf16x8*>(Qw + d0 * 16);
  char* ql = lds + 2 * SHM_V + 2 * SHM_K + 2048 + (wid * 32 + r32) * 144 + hi * 16;
  if constexpr (QL > 0) {
#pragma unroll
    for (int d0 = NQ - QL; d0 < NQ; ++d0) *reinterpret_cast<bf16x8*>(ql + (d0 - (NQ - QL)) * 32) = *reinterpret_cast<const bf16x8*>(Qw + d0 * 16);
  }
  const int sr = tid >> 4, sc = (tid & 15) * 8, vst0 = v_st(sr, sc), vst1 = v_st(32 + sr, sc);
  const int krow = tid >> 3, kch = tid & 7;
  const bf16_t* vg = Vh + sr * 128 + sc;
  const bf16_t* kg = Kh + krow * KW + kch * 8;
  const int vb0 = (int)(uintptr_t)V_lds + v_rd_base(lane);
  struct { bf16x8 vs0, vs1, ks[KC]; } sr_[SDEPTH];
#define SLOAD(i, k0) do { sr_[i].vs0 = *reinterpret_cast<const bf16x8*>(vg + (size_t)(k0) * 128); sr_[i].vs1 = *reinterpret_cast<const bf16x8*>(vg + (size_t)((k0) + 32) * 128); \
    _Pragma("unroll") for (int _c = 0; _c < KC; ++_c) sr_[i].ks[_c] = *reinterpret_cast<const bf16x8*>(kg + (size_t)(k0) * KW + _c * 64); } while (0)
#define SWRITE(b, i) do { *reinterpret_cast<bf16x8*>(V_lds + (b) * SHM_V + vst0) = sr_[i].vs0; *reinterpret_cast<bf16x8*>(V_lds + (b) * SHM_V + vst1) = sr_[i].vs1; \
    _Pragma("unroll") for (int _c = 0; _c < KC; ++_c) *reinterpret_cast<bf16x8*>(K_lds + (b) * SHM_K + kswz<KW>(krow, (kch + 8 * _c) * 16)) = sr_[i].ks[_c]; } while (0)
#define SWAIT() do { if constexpr (SDEPTH == 2) asm volatile("s_waitcnt vmcnt(4)" ::: "memory"); else asm volatile("s_waitcnt vmcnt(0)" ::: "memory"); } while (0)
#define RESC(a) do { if (__any((a) < 1.f)) { if (hi == 0) al_l[r32] = (a); asm volatile("s_waitcnt lgkmcnt(0)" ::: "memory"); \
    _Pragma("unroll") for (int _d = 0; _d < 4; ++_d) _Pragma("unroll") for (int _r = 0; _r < 16; ++_r) o[_d][_r] *= al_l[crow(_r, hi)]; } } while (0)
  f32x16 pA0, pA1, pB0, pB1; float mnA, mnB, alA, alB; bf16x8 pa0, pa1, pa2, pa3;
  constexpr int SE = 0, SO = SDEPTH - 1;
  SLOAD(SE, 0); asm volatile("s_waitcnt vmcnt(0)" ::: "memory"); SWRITE(0, SE); __syncthreads();
  qkt<KW, NQ, QL>(pA0, pA1, K_lds, qr, kcol0, r32, hi, ql); partialSM<SCID>(pA0, pA1, m_reg, mnA, alA);
  SLOAD(SO, 64); if constexpr (SDEPTH == 2) { if (2 < NT) SLOAD(SE, 128); }
  SWAIT(); SWRITE(1, SO); __syncthreads();
  for (int j = 1; j + 1 < NT; j += 2) {
    SBAR(); qkt<KW, NQ, QL>(pB0, pB1, K_lds + SHM_K, qr, kcol0, r32, hi, ql);
    finishSM(pA0, pA1, alA, l_reg, pa0, pa1, pa2, pa3); SBAR();
    SLOAD(SO, (j + SDEPTH) * 64); SBAR();
    pv_d0(o, vb0, pa0, pa1, pa2, pa3); partialSM<SCID>(pB0, pB1, m_reg, mnB, alB);
    __syncthreads(); SWAIT(); SWRITE(0, SE);
    RESC(alB); __syncthreads();
    SBAR(); qkt<KW, NQ, QL>(pA0, pA1, K_lds, qr, kcol0, r32, hi, ql);
    finishSM(pB0, pB1, alB, l_reg, pa0, pa1, pa2, pa3); SBAR();
    if (SDEPTH == 1 || j + 3 < NT) SLOAD(SE, (j + 1 + SDEPTH) * 64);
    SBAR();
    pv_d0(o, vb0 + SHM_V, pa0, pa1, pa2, pa3); partialSM<SCID>(pA0, pA1, m_reg, mnA, alA);
    __syncthreads(); SWAIT(); SWRITE(1, SO);
    RESC(alA); __syncthreads();
  }
  SBAR(); qkt<KW, NQ, QL>(pB0, pB1, K_lds + SHM_K, qr, kcol0, r32, hi, ql);
  finishSM(pA0, pA1, alA, l_reg, pa0, pa1, pa2, pa3); SBAR();
  pv_d0(o, vb0, pa0, pa1, pa2, pa3); partialSM<SCID>(pB0, pB1, m_reg, mnB, alB);
  __syncthreads(); RESC(alB);
  finishSM(pB0, pB1, alB, l_reg, pa0, pa1, pa2, pa3); SBAR();
  pv_d0(o, vb0 + SHM_V, pa0, pa1, pa2, pa3);
  __syncthreads();
  l_out = l_reg;
#undef SLOAD
#undef SWRITE
#undef SWAIT
#undef RESC
}

template <int KW, int NQ, int SCID, int QL>
DEVI void attn_core_dma(int wv, const bf16_t* __restrict__ Qw, const bf16_t* __restrict__ Kh, const bf16_t* __restrict__ Vh, int kcol0, int NT, char* lds,
                        f32x16 (&o)[4], float& l_out) {
  constexpr int SHM_V = 64 * 128 * 2, KCH = KW / 8 + 1, SHM_K = 64 * KCH * 16, KR = (64 * KCH) / 512;
  static_assert(64 * KCH - KR * 512 == 64, "remainder must be one wave");
  const int tid = tidx(wv), wid = tid >> 6, lane = tid & 63, r32 = lane & 31, hi = lane >> 5;
  char* V_lds = lds; char* K_lds = lds + 2 * SHM_V;
  float* al_l = (float*)(lds + 2 * SHM_V + 2 * SHM_K) + wid * 64 + 32;
  float m_reg = -1e30f, l_reg = 0;
#pragma unroll
  for (int d = 0; d < 4; ++d)
#pragma unroll
    for (int r = 0; r < 16; ++r) o[d][r] = 0.f;
  bf16x8 qr[NQ - QL + (QL ? 1 : 0)];
#pragma unroll
  for (int d0 = 0; d0 < NQ - QL; ++d0) qr[d0] = *reinterpret_cast<const bf16x8*>(Qw + d0 * 16);
  char* ql = lds + 2 * SHM_V + 2 * SHM_K + 2048 + (wid * 32 + r32) * 144 + hi * 16;
  if constexpr (QL > 0) {
#pragma unroll
    for (int d0 = NQ - QL; d0 < NQ; ++d0) *reinterpret_cast<bf16x8*>(ql + (d0 - (NQ - QL)) * 32) = *reinterpret_cast<const bf16x8*>(Qw + d0 * 16);
  }
  const int sr = tid >> 4, sc = (tid & 15) * 8, vst0 = v_st(sr, sc), vst1 = v_st(32 + sr, sc);
  const bf16_t* vg = Vh + sr * 128 + sc;
  const int vb0 = (int)(uintptr_t)V_lds + v_rd_base(lane);
  unsigned koff[KR + 1];
#pragma unroll
  for (int i = 0; i <= KR; ++i) { const int c = tid + 512 * i; const int row = c / KCH; int ch = c - row * KCH; ch = ch == KCH - 1 ? KCH - 2 : ch; koff[i] = (unsigned)(row * KW + ch * 8) * 2u; }
  const unsigned kldsw = (unsigned)__builtin_amdgcn_readfirstlane(wid) * 1024u;
  bf16x8 vs0, vs1;
#define KDMA(k0, b) do { const char* _g = (const char*)(Kh + (size_t)(k0) * KW); PG8_LAS unsigned char* _l = (PG8_LAS unsigned char*)(K_lds + (b) * SHM_K) + kldsw; \
    _Pragma("unroll") for (int _i = 0; _i < KR; ++_i) __builtin_amdgcn_global_load_lds((const unsigned*)(_g + koff[_i]), (PG8_LAS unsigned*)(_l + _i * 8192), 16, 0, 0); \
    if (wid == 0) __builtin_amdgcn_global_load_lds((const unsigned*)(_g + koff[KR]), (PG8_LAS unsigned*)(_l + KR * 8192), 16, 0, 0); } while (0)
#define VLOAD(k0) do { vs0 = *reinterpret_cast<const bf16x8*>(vg + (size_t)(k0) * 128); vs1 = *reinterpret_cast<const bf16x8*>(vg + (size_t)((k0) + 32) * 128); } while (0)
#define VWRITE(b) do { *reinterpret_cast<bf16x8*>(V_lds + (b) * SHM_V + vst0) = vs0; *reinterpret_cast<bf16x8*>(V_lds + (b) * SHM_V + vst1) = vs1; } while (0)
#define VMW() asm volatile("s_waitcnt vmcnt(0)" ::: "memory")
#define RESC(a) do { if (__any((a) < 1.f)) { if (hi == 0) al_l[r32] = (a); asm volatile("s_waitcnt lgkmcnt(0)" ::: "memory"); \
    _Pragma("unroll") for (int _d = 0; _d < 4; ++_d) _Pragma("unroll") for (int _r = 0; _r < 16; ++_r) o[_d][_r] *= al_l[crow(_r, hi)]; } } while (0)
  f32x16 pA0, pA1, pB0, pB1; float mnA, mnB, alA, alB; bf16x8 pa0, pa1, pa2, pa3;
  KDMA(0, 0); VLOAD(0); VMW(); VWRITE(0); __syncthreads();
  KDMA(64, 1); VLOAD(64);
  qkt<KW, NQ, QL>(pA0, pA1, K_lds, qr, kcol0, r32, hi, ql); partialSM<SCID>(pA0, pA1, m_reg, mnA, alA);
  VMW(); __syncthreads(); VWRITE(1); __syncthreads();
  for (int j = 1; j + 1 < NT; j += 2) {
    SBAR(); KDMA((j + 1) * 64, 0); VLOAD((j + 1) * 64); SBAR();
    qkt<KW, NQ, QL>(pB0, pB1, K_lds + SHM_K, qr, kcol0, r32, hi, ql);
    finishSM(pA0, pA1, alA, l_reg, pa0, pa1, pa2, pa3); SBAR();
    pv_d0(o, vb0, pa0, pa1, pa2, pa3); partialSM<SCID>(pB0, pB1, m_reg, mnB, alB);
    VMW(); __syncthreads(); VWRITE(0);
    RESC(alB); __syncthreads();
    SBAR(); KDMA((j + 2) * 64, 1); VLOAD((j + 2) * 64); SBAR();
    qkt<KW, NQ, QL>(pA0, pA1, K_lds, qr, kcol0, r32, hi, ql);
    finishSM(pB0, pB1, alB, l_reg, pa0, pa1, pa2, pa3); SBAR();
    pv_d0(o, vb0 + SHM_V, pa0, pa1, pa2, pa3); partialSM<SCID>(pA0, pA1, m_reg, mnA, alA);
    VMW(); __syncthreads(); VWRITE(1);
    RESC(alA); __syncthreads();
  }
  SBAR(); qkt<KW, NQ, QL>(pB0, pB1, K_lds + SHM_K, qr, kcol0, r32, hi, ql);
  finishSM(pA0, pA1, alA, l_reg, pa0, pa1, pa2, pa3); SBAR();
  pv_d0(o, vb0, pa0, pa1, pa2, pa3); partialSM<SCID>(pB0, pB1, m_reg, mnB, alB);
  RESC(alB);
  finishSM(pB0, pB1, alB, l_reg, pa0, pa1, pa2, pa3); SBAR();
  pv_d0(o, vb0 + SHM_V, pa0, pa1, pa2, pa3);
  __syncthreads();
  l_out = l_reg;
#undef KDMA
#undef VLOAD
#undef VWRITE
#undef VMW
#undef RESC
}

template <int KW, int NQ, int SCID, int QL>
DEVI void attn_core_pp(int wv, const bf16_t* __restrict__ Qw, const bf16_t* __restrict__ Kh, const bf16_t* __restrict__ Vh, int kcol0, int NT, char* lds,
                       f32x16 (&o)[4], float& l_out) {
  constexpr int SHM_V = 64 * 128 * 2, KCH = KW / 8 + 1, SHM_K = 64 * KCH * 16, KR = (64 * KCH) / 512;
  static_assert(64 * KCH - KR * 512 == 64, "remainder must be one wave");
  const int tid = tidx(wv), wid = tid >> 6, lane = tid & 63, r32 = lane & 31, hi = lane >> 5;
  const int g = __builtin_amdgcn_readfirstlane(wid >> 2);
  char* V_lds = lds; char* K_lds = lds + 2 * SHM_V;
  float* al_l = (float*)(lds + 2 * SHM_V + 2 * SHM_K) + wid * 64 + 32;
  float m_reg = -1e30f, l_reg = 0;
#pragma unroll
  for (int d = 0; d < 4; ++d)
#pragma unroll
    for (int r = 0; r < 16; ++r) o[d][r] = 0.f;
  bf16x8 qr[NQ - QL + (QL ? 1 : 0)];
#pragma unroll
  for (int d0 = 0; d0 < NQ - QL; ++d0) qr[d0] = *reinterpret_cast<const bf16x8*>(Qw + d0 * 16);
  char* ql = lds + 2 * SHM_V + 2 * SHM_K + 2048 + (wid * 32 + r32) * 144 + hi * 16;
  if constexpr (QL > 0) {
#pragma unroll
    for (int d0 = NQ - QL; d0 < NQ; ++d0) *reinterpret_cast<bf16x8*>(ql + (d0 - (NQ - QL)) * 32) = *reinterpret_cast<const bf16x8*>(Qw + d0 * 16);
  }
  const int vb0 = (int)(uintptr_t)V_lds + v_rd_base(lane);
  unsigned koff[KR + 1], voff[2];
#pragma unroll
  for (int i = 0; i <= KR; ++i) { const int c = tid + 512 * i; const int row = c / KCH; int ch = c - row * KCH; ch = ch == KCH - 1 ? KCH - 2 : ch; koff[i] = (unsigned)(row * KW + ch * 8) * 2u; }
#pragma unroll
  for (int i = 0; i < 2; ++i) { const int q = tid + 512 * i; const int st = q >> 5, kk = (st >> 2) * 8 + ((q >> 2) & 7), c = (st & 3) * 32 + (q & 3) * 8;
    const int k = (kk & ~0xC) | ((kk & 4) << 1) | ((kk & 8) >> 1); voff[i] = (unsigned)(k * 128 + c) * 2u; }
  const unsigned ldsw = (unsigned)__builtin_amdgcn_readfirstlane(wid) * 1024u;
#define KDMA(k0, b) do { const char* _g = (const char*)(Kh + (size_t)(k0) * KW); PG8_LAS unsigned char* _l = (PG8_LAS unsigned char*)(K_lds + (b) * SHM_K) + ldsw; \
    _Pragma("unroll") for (int _i = 0; _i < KR; ++_i) __builtin_amdgcn_global_load_lds((const unsigned*)(_g + koff[_i]), (PG8_LAS unsigned*)(_l + _i * 8192), 16, 0, 0); \
    if (wid == 0) __builtin_amdgcn_global_load_lds((const unsigned*)(_g + koff[KR]), (PG8_LAS unsigned*)(_l + KR * 8192), 16, 0, 0); } while (0)
#define VDMA(k0, b) do { const char* _g = (const char*)(Vh + (size_t)(k0) * 128); PG8_LAS unsigned char* _l = (PG8_LAS unsigned char*)(V_lds + (b) * SHM_V) + ldsw; \
    _Pragma("unroll") for (int _i = 0; _i < 2; ++_i) __builtin_amdgcn_global_load_lds((const unsigned*)(_g + voff[_i]), (PG8_LAS unsigned*)(_l + _i * 8192), 16, 0, 0); } while (0)
#define VMW() asm volatile("s_waitcnt vmcnt(0)" ::: "memory")
#define PBAR() do { asm volatile("" ::: "memory"); __builtin_amdgcn_s_barrier(); asm volatile("" ::: "memory"); } while (0)
#define RESC(a) do { if (__any((a) < 1.f)) { if (hi == 0) al_l[r32] = (a); asm volatile("s_waitcnt lgkmcnt(0)" ::: "memory"); \
    _Pragma("unroll") for (int _d = 0; _d < 4; ++_d) _Pragma("unroll") for (int _r = 0; _r < 16; ++_r) o[_d][_r] *= al_l[crow(_r, hi)]; } } while (0)
  f32x16 pA0, pA1, pB0, pB1; float mn, al; bf16x8 pa0, pa1, pa2, pa3;
  KDMA(0, 0); KDMA(64, 1); VMW(); __syncthreads();
  qkt<KW, NQ, QL>(pA0, pA1, K_lds, qr, kcol0, r32, hi, ql);
  PBAR();
  if (g == 1) PBAR();
  for (int j = 0; j < NT; j += 2) {
    SBAR(); if (j + 2 < NT) KDMA((j + 2) * 64, 0); VDMA(j * 64, 0); SBAR();
    qkt<KW, NQ, QL>(pB0, pB1, K_lds + SHM_K, qr, kcol0, r32, hi, ql);
    if (j > 0) pv_d0(o, vb0 + SHM_V, pa0, pa1, pa2, pa3);
    if (g == 1) VMW();
    PBAR(); SBAR();
    partialSM<SCID>(pA0, pA1, m_reg, mn, al); RESC(al); finishSM(pA0, pA1, al, l_reg, pa0, pa1, pa2, pa3);
    if (g == 0) VMW();
    PBAR(); SBAR();
    if (j + 3 < NT) KDMA((j + 3) * 64, 1);
    VDMA((j + 1) * 64, 1); SBAR();
    if (j + 2 < NT) qkt<KW, NQ, QL>(pA0, pA1, K_lds, qr, kcol0, r32, hi, ql);
    pv_d0(o, vb0, pa0, pa1, pa2, pa3);
    if (g == 1) VMW();
    PBAR(); SBAR();
    partialSM<SCID>(pB0, pB1, m_reg, mn, al); RESC(al); finishSM(pB0, pB1, al, l_reg, pa0, pa1, pa2, pa3);
    if (g == 0) VMW();
    PBAR(); SBAR();
  }
  pv_d0(o, vb0 + SHM_V, pa0, pa1, pa2, pa3);
  if (g == 0) PBAR();
  __syncthreads();
  l_out = l_reg;
#undef KDMA
#undef VDMA
#undef VMW
#undef PBAR
#undef RESC
}

DEVI void gated_rows_out(const char* stg, int lane, const bf16_t* __restrict__ gate, int gld, bf16_t* __restrict__ out, int old) {
#pragma unroll
  for (int i = 0; i < 8; ++i) {
    const int c = lane + 64 * i, row = c >> 4, ch = c & 15;
    const u32x4 sv = *reinterpret_cast<const u32x4*>(stg + row * 272 + ch * 16);
    const u32x4 gv = *reinterpret_cast<const u32x4*>(gate + (size_t)row * gld + ch * 8);
    u32x4 ov;
#pragma unroll
    for (int e = 0; e < 4; ++e) ov[e] = cvtpk(bflo(sv[e]) * bflo(gv[e]), bfhi(sv[e]) * bfhi(gv[e]));
    *reinterpret_cast<u32x4*>(out + (size_t)row * old + ch * 8) = ov;
  }
}

DEVI void attn0_item(int wv, const Params& p, int token0, int b, int h, int nkeys, char* lds) {
  const int tid = tidx(wv), wid = tid >> 6, lane = tid & 63, r32 = lane & 31, hi = lane >> 5, m = wid >> 2, wl = wid & 3;
  const bf16_t* Q0 = (const bf16_t*)(p.ws + OFF_Q0); const bf16_t* K0 = (const bf16_t*)(p.ws + OFF_K0); const bf16_t* V0 = (const bf16_t*)(p.ws + OFF_V0);
  const bf16_t* ZB = (const bf16_t*)(p.ws + OFF_ZB); bf16_t* MIX = (bf16_t*)(p.ws + OFF_MIX);
  const bf16_t* Qw = Q0 + (size_t)(token0 + wl * 32 + r32) * 512 + h * 128 + m * 64 + hi * 8;
  const size_t kvo = (size_t)(b * 4 + h) * KVL * 128;
  f32x16 o[4]; float l;
  attn_core_pp<128, 4, 0, 0>(wv, Qw, K0 + kvo, V0 + kvo, m * 64, nkeys >> 6, lds, o, l);
  float* li_l = (float*)(lds + 32768 + 2 * 64 * 272) + wid * 64;
  if (hi == 0) li_l[r32] = l;
  asm volatile("s_waitcnt lgkmcnt(0)" ::: "memory");
  float rli[16];
#pragma unroll
  for (int r = 0; r < 16; ++r) rli[r] = __builtin_amdgcn_rcpf(li_l[crow(r, hi)]);
  float t1 = p.b_lq1[lane] * p.b_lk1[lane], t2 = p.b_lq2[lane] * p.b_lk2[lane];
  t1 = wave_sum(t1); t2 = wave_sum(t2);
  const float lam = __expf(t1) - __expf(t2) + 0.2f;
  __syncthreads();
  float* xch = (float*)lds;
  if (m == 1) {
#pragma unroll
    for (int r = 0; r < 16; ++r)
#pragma unroll
      for (int d0 = 0; d0 < 4; ++d0) xch[(wl * 32 + crow(r, hi)) * 128 + d0 * 32 + r32] = o[d0][r] * rli[r];
  }
  __syncthreads();
  if (m == 0) {
    char* stg = lds + 69632 + wl * 8704;
    float sw4[4];
#pragma unroll
    for (int d0 = 0; d0 < 4; ++d0) sw4[d0] = p.b_subln_w[d0 * 32 + r32];
#pragma unroll
    for (int r = 0; r < 16; ++r) {
      const int row = wl * 32 + crow(r, hi); const int token = token0 + row;
      float a[4], ss = 0.f;
#pragma unroll
      for (int d0 = 0; d0 < 4; ++d0) { a[d0] = o[d0][r] * rli[r] - lam * xch[row * 128 + d0 * 32 + r32]; ss += a[d0] * a[d0]; }
      ss = xsum<1>(ss); ss = xsum<2>(ss); ss = xsum<4>(ss); ss = xsum<8>(ss); ss = xsum<16>(ss);
      const float rstd = rsqrtf(ss * (1.f / 128.f) + 1e-5f) * 0.8f;
#pragma unroll
      for (int d0 = 0; d0 < 4; ++d0) *reinterpret_cast<bf16_t*>(stg + crow(r, hi) * 272 + (d0 * 32 + r32) * 2) = f2bf(a[d0] * rstd * sw4[d0]);
    }
    asm volatile("s_waitcnt lgkmcnt(0)" ::: "memory");
    const size_t t0 = (size_t)(token0 + wl * 32);
    gated_rows_out(stg, lane, ZB + t0 * 512 + h * 128, 512, MIX + t0 * 1024 + 512 + h * 128, 1024);
  }
  __syncthreads();
}

DEVI void attn1_item(int wv, const Params& p, int b, int h, int qb, char* lds) {
  const int tid = tidx(wv), wid = tid >> 6, lane = tid & 63, r32 = lane & 31, hi = lane >> 5;
  const bf16_t* Q1 = (const bf16_t*)(p.ws + OFF_Q1); const bf16_t* K1 = (const bf16_t*)(p.ws + OFF_K1); const bf16_t* V1 = (const bf16_t*)(p.ws + OFF_V1);
  const bf16_t* Z1 = (const bf16_t*)(p.ws + OFF_Z1); bf16_t* MIX = (bf16_t*)(p.ws + OFF_MIX);
  const int token0 = b * 2048 + qb * 256;
  const bf16_t* Qw = Q1 + (size_t)(token0 + wid * 32 + r32) * 1536 + h * 192 + hi * 8;
  f32x16 o[4]; float l;
  attn_core_pp<192, 12, 1, 4>(wv, Qw, K1 + (size_t)(b * 8 + h) * KVL * 192, V1 + (size_t)(b * 8 + h) * KVL * 128, 0, KVL / 64, lds, o, l);
  float* li_l = (float*)(lds + 32768 + 2 * 64 * 400) + wid * 64;
  if (hi == 0) li_l[r32] = l;
  asm volatile("s_waitcnt lgkmcnt(0)" ::: "memory");
  char* stg = lds + wid * 8704;
#pragma unroll
  for (int r = 0; r < 16; ++r) {
    const int cr = crow(r, hi); const float rl = __builtin_amdgcn_rcpf(li_l[cr]);
#pragma unroll
    for (int d0 = 0; d0 < 4; ++d0) *reinterpret_cast<bf16_t*>(stg + cr * 272 + (d0 * 32 + r32) * 2) = f2bf(o[d0][r] * rl);
  }
  asm volatile("s_waitcnt lgkmcnt(0)" ::: "memory");
  const size_t t0 = (size_t)(token0 + wid * 32);
  gated_rows_out(stg, lane, Z1 + t0 * 1024 + h * 128, 1024, MIX + t0 * 1024 + h * 128, 1024);
  __syncthreads();
}

DEVI void abranch_item(int wv, const Params& p, int ci, char* lds) {
  const int tid = tidx(wv), wid = tid >> 6, lane = tid & 63, r32 = lane & 31, hi = lane >> 5;
  const bf16_t* GV = (const bf16_t*)(p.ws + OFF_GV); const bf16_t* U = (const bf16_t*)(p.ws + OFF_U); const bf16_t* ZA = (const bf16_t*)(p.ws + OFF_ZA);
  const bf16_t* WSB = (const bf16_t*)(p.ws + OFF_WSB); bf16_t* MIX = (bf16_t*)(p.ws + OFF_MIX);
  const int t0 = ci * 128;
  bf16_t* vnT = (bf16_t*)lds;
  {
    const int pos = tid >> 2, cp = tid & 3;
    const bf16_t* g = GV + (size_t)(t0 + pos) * 512;
    float s = 0.f, q = 0.f;
#pragma unroll 4
    for (int i = 0; i < 16; ++i) {
      const bf16x8 raw = *reinterpret_cast<const bf16x8*>(g + (i * 4 + cp) * 8);
#pragma unroll
      for (int e = 0; e < 8; ++e) { const float xv = bf2f((bf16_t)raw[e]); s += xv; q += xv * xv; }
    }
    s = xsum<1>(s); s = xsum<2>(s); q = xsum<1>(q); q = xsum<2>(q);
    const float mu = s * (1.f / 512.f);
    const float rstd = rsqrtf(fmaxf(q * (1.f / 512.f) - mu * mu, 0.f) + 1e-5f);
#pragma unroll 2
    for (int i = 0; i < 16; ++i) {
      const int c0 = (i * 4 + cp) * 8;
      const bf16x8 raw = *reinterpret_cast<const bf16x8*>(g + c0);
      const f32x4 w0 = *reinterpret_cast<const f32x4*>(p.a_ln_w + c0), w1 = *reinterpret_cast<const f32x4*>(p.a_ln_w + c0 + 4);
      const f32x4 b0 = *reinterpret_cast<const f32x4*>(p.a_ln_b + c0), b1 = *reinterpret_cast<const f32x4*>(p.a_ln_b + c0 + 4);
#pragma unroll
      for (int e = 0; e < 8; ++e) {
        const float wv = e < 4 ? w0[e & 3] : w1[e & 3], bv = e < 4 ? b0[e & 3] : b1[e & 3];
        vnT[(c0 + e) * 136 + pos] = f2bf((bf2f((bf16_t)raw[e]) - mu) * rstd * wv + bv);
      }
    }
  }
  __syncthreads();
  const int g8 = wid;
  const bf16_t* Wg = WSB + g8 * 128 * 128;
  for (int pb = 0; pb < 4; ++pb) {
    f32x16 acc[2];
#pragma unroll
    for (int r = 0; r < 16; ++r) { acc[0][r] = 0.f; acc[1][r] = 0.f; }
#pragma unroll
    for (int ks = 0; ks < 8; ++ks) {
      const bf16x8 bw = *reinterpret_cast<const bf16x8*>(Wg + (pb * 32 + r32) * 128 + ks * 16 + hi * 8);
#pragma unroll
      for (int db = 0; db < 2; ++db) {
        const bf16x8 a = *reinterpret_cast<const bf16x8*>(vnT + (g8 * 64 + db * 32 + r32) * 136 + ks * 16 + hi * 8);
        acc[db] = __builtin_amdgcn_mfma_f32_32x32x16_bf16(a, bw, acc[db], 0, 0, 0);
      }
    }
    const int token = t0 + pb * 32 + r32; const float bias = p.a_bs[g8 * 128 + pb * 32 + r32];
#pragma unroll
    for (int db = 0; db < 2; ++db)
#pragma unroll
      for (int rg = 0; rg < 4; ++rg) {
        const int c = g8 * 64 + db * 32 + rg * 8 + hi * 4;
        const u32x2 u2 = *reinterpret_cast<const u32x2*>(U + (size_t)token * 512 + c), z2 = *reinterpret_cast<const u32x2*>(ZA + (size_t)token * 512 + c);
        const float o0 = bflo(u2[0]) * (acc[db][rg * 4 + 0] + bias) * bflo(z2[0]), o1 = bfhi(u2[0]) * (acc[db][rg * 4 + 1] + bias) * bfhi(z2[0]);
        const float o2 = bflo(u2[1]) * (acc[db][rg * 4 + 2] + bias) * bflo(z2[1]), o3 = bfhi(u2[1]) * (acc[db][rg * 4 + 3] + bias) * bfhi(z2[1]);
        u32x2 pk = {cvtpk(o0, o1), cvtpk(o2, o3)};
        *reinterpret_cast<u32x2*>(MIX + (size_t)token * 1024 + c) = pk;
      }
  }
  __syncthreads();
}

DEVI void tr_tile(int wv, const float* __restrict__ src, bf16_t* __restrict__ dst, int K, int N, int tilesN, const float* __restrict__ scale, int t, char* lds) {
  const int tid = tidx(wv);
  const int k0 = (t / tilesN) * 64, n0 = (t % tilesN) * 64;
  const int kr = tid >> 3, ng = (tid & 7) * 8;
  f32x4 v0 = {0.f, 0.f, 0.f, 0.f}, v1 = {0.f, 0.f, 0.f, 0.f};
  if (n0 + ng < N) { const float* s = src + (size_t)(k0 + kr) * N + n0 + ng; v0 = *reinterpret_cast<const f32x4*>(s); v1 = *reinterpret_cast<const f32x4*>(s + 4); }
  const float scv = scale ? scale[k0 + kr] : 1.f;
  bf16_t* tl = (bf16_t*)lds;
#pragma unroll
  for (int e = 0; e < 4; ++e) { tl[(ng + e) * 72 + kr] = f2bf(v0[e] * scv); tl[(ng + 4 + e) * 72 + kr] = f2bf(v1[e] * scv); }
  __syncthreads();
  const int n = tid >> 3, kc = (tid & 7) * 8;
  *reinterpret_cast<bf16x8*>(dst + (size_t)(n0 + n) * K + k0 + kc) = *reinterpret_cast<const bf16x8*>(tl + n * 72 + kc);
}

DEVI void phase0(int wv, const Params& p, char* lds) {
  const int tid = tidx(wv);
  constexpr int N_ADA = 192, N_TR = 1952, N_WS = 16;
  for (int it = blockIdx.x; it < N_ADA + N_TR + N_WS + 1; it += gridDim.x) {
    if (it < N_ADA) {
      const int li = it / 96, chunk = it % 96;
      float* sc = (float*)lds;
      for (int idx = tid; idx < 17 * 1024; idx += 512) { const int r = idx >> 10, k = idx & 1023; const float xv = r < 16 ? p.c[r * 1024 + k] : p.c_ctx[k]; sc[idx] = xv / (1.f + expf(-xv)); }
      __syncthreads();
      const int col = tid & 31, kp = tid >> 5;
      const float* w = p.ada_w + (size_t)li * 1024 * 3072 + chunk * 32 + col;
      float acc[17];
#pragma unroll
      for (int r = 0; r < 17; ++r) acc[r] = 0.f;
#pragma unroll 8
      for (int k = kp * 64; k < kp * 64 + 64; ++k) {
        const float wv = w[(size_t)k * 3072];
#pragma unroll
        for (int r = 0; r < 17; ++r) acc[r] += sc[r * 1024 + k] * wv;
      }
      float* red = (float*)(lds + 17 * 1024 * 4);
#pragma unroll
      for (int r = 0; r < 17; ++r) red[(kp * 17 + r) * 32 + col] = acc[r];
      __syncthreads();
      float* ada = (float*)(p.ws + OFF_ADA);
      for (int idx = tid; idx < 544; idx += 512) {
        const int r = idx >> 5, cc = idx & 31; float s = 0.f;
        for (int k2 = 0; k2 < 16; ++k2) s += red[(k2 * 17 + r) * 32 + cc];
        ada[(size_t)(li * 17 + r) * 3072 + chunk * 32 + cc] = s + p.ada_b[li * 3072 + chunk * 32 + cc];
      }
    } else if (it < N_ADA + N_TR) {
      int t = it - N_ADA;
      if (t < 896) tr_tile(wv, p.even_w_in, (bf16_t*)(p.ws + OFF_W0IN), 1024, 3584, 56, nullptr, t, lds);
      else if (t < 1152) tr_tile(wv, p.even_w_out, (bf16_t*)(p.ws + OFF_W0OUT), 1024, 1024, 16, nullptr, t - 896, lds);
      else if (t < 1536) tr_tile(wv, p.odd_w_in, (bf16_t*)(p.ws + OFF_W1IN), 1024, 1472, 24, nullptr, t - 1152, lds);
      else if (t < 1632) tr_tile(wv, p.c_wq_b, (bf16_t*)(p.ws + OFF_WQ), 256, 1536, 24, p.c_q_norm_w, t - 1536, lds);
      else if (t < 1696) tr_tile(wv, p.c_wkv_b, (bf16_t*)(p.ws + OFF_WKV), 128, 2048, 32, p.c_kv_norm_w, t - 1632, lds);
      else tr_tile(wv, p.odd_w_out, (bf16_t*)(p.ws + OFF_W1OUT), 1024, 1024, 16, nullptr, t - 1696, lds);
    } else if (it < N_ADA + N_TR + N_WS) {
      const int base = (it - N_ADA - N_TR) * 8192 + tid * 16;
      bf16_t* dst = (bf16_t*)(p.ws + OFF_WSB) + base; const float* s = p.a_ws + base;
#pragma unroll
      for (int q = 0; q < 2; ++q) {
        const f32x4 a = *reinterpret_cast<const f32x4*>(s + q * 8), b = *reinterpret_cast<const f32x4*>(s + q * 8 + 4);
        u32x4 w = {cvtpk(a[0], a[1]), cvtpk(a[2], a[3]), cvtpk(b[0], b[1]), cvtpk(b[2], b[3])};
        *reinterpret_cast<u32x4*>(dst + q * 8) = w;
      }
    } else {
      float2* tab = (float2*)(p.ws + OFF_ROPE);
      for (int e = tid; e < 1024; e += 512) {
        const int pos = e >> 4, j = e & 15;
        const float inv = exp2f(-(float)j * (13.287712379549449f / 16.f));
        const float ang = (float)pos * inv;
        const float nrev = rintf(ang * 0.15915494309189535f);
        float rr = fmaf(-nrev, 6.2831855f, ang); rr = fmaf(-nrev, -1.7484555e-7f, rr);
        tab[e] = make_float2(__cosf(rr), __sinf(rr));
      }
    }
    __syncthreads();
  }
}

template <bool RES>
DEVI void norm_mod(int wv, const float* src_lat, const float* src_ctx, const float* __restrict__ nw, const float* __restrict__ ada, bf16_t* X,
                   int row_lo, int row_hi, int vb, int nvb, const float* __restrict__ ada_prev = nullptr, float* hdst_lat = nullptr, float* hdst_ctx = nullptr) {
  const int tid_ = tidx(wv); const int wid = tid_ >> 6, lane = tid_ & 63;
  for (int row0 = row_lo + (vb * 8 + wid) * 2; row0 < row_hi; row0 += nvb * 16) {
    f32x4 v[2][4]; u32x2 ov[2][4]; float ss[2];
#pragma unroll
    for (int q = 0; q < 2; ++q) {
      const int row = row0 + q;
      const float* src = row < NLAT ? src_lat + (size_t)row * 1024 : src_ctx + (size_t)(row - NLAT) * 1024;
      ss[q] = 0.f;
#pragma unroll
      for (int i = 0; i < 4; ++i) {
        v[q][i] = *reinterpret_cast<const f32x4*>(src + i * 256 + lane * 4);
        if constexpr (RES) ov[q][i] = *reinterpret_cast<const u32x2*>(X + (size_t)row * 1024 + i * 256 + lane * 4);
      }
    }
    if constexpr (RES) {
#pragma unroll
      for (int q = 0; q < 2; ++q) {
        const int row = row0 + q;
        const float* gp = ada_prev + (row < NLAT ? (row >> 11) : 16) * 3072 + 2048;
        float* hd = row < NLAT ? hdst_lat + (size_t)row * 1024 : hdst_ctx + (size_t)(row - NLAT) * 1024;
#pragma unroll
        for (int i = 0; i < 4; ++i) {
          const int c = i * 256 + lane * 4;
          const f32x4 g = *reinterpret_cast<const f32x4*>(gp + c);
          v[q][i][0] += g[0] * bflo(ov[q][i][0]); v[q][i][1] += g[1] * bfhi(ov[q][i][0]); v[q][i][2] += g[2] * bflo(ov[q][i][1]); v[q][i][3] += g[3] * bfhi(ov[q][i][1]);
          *reinterpret_cast<f32x4*>(hd + c) = v[q][i];
        }
      }
    }
#pragma unroll
    for (int q = 0; q < 2; ++q) {
#pragma unroll
      for (int i = 0; i < 4; ++i) ss[q] += v[q][i][0] * v[q][i][0] + v[q][i][1] * v[q][i][1] + v[q][i][2] * v[q][i][2] + v[q][i][3] * v[q][i][3];
      ss[q] = wave_sum(ss[q]);
    }
#pragma unroll
    for (int q = 0; q < 2; ++q) {
      const int row = row0 + q;
      const float* ad = ada + (row < NLAT ? (row >> 11) : 16) * 3072;
      const float r = rsqrtf(ss[q] * (1.f / 1024.f) + 1e-6f);
#pragma unroll
      for (int i = 0; i < 4; ++i) {
        const int c = i * 256 + lane * 4;
        const f32x4 w = *reinterpret_cast<const f32x4*>(nw + c), sh = *reinterpret_cast<const f32x4*>(ad + c), scl = *reinterpret_cast<const f32x4*>(ad + 1024 + c);
        float o[4];
#pragma unroll
        for (int e = 0; e < 4; ++e) o[e] = v[q][i][e] * r * w[e] * (1.f + scl[e]) + sh[e];
        u32x2 pk = {cvtpk(o[0], o[1]), cvtpk(o[2], o[3])};
        *reinterpret_cast<u32x2*>(X + (size_t)row * 1024 + c) = pk;
      }
    }
  }
}

DEVI void final_norm(int wv, float* out, const float* __restrict__ fw, const bf16_t* __restrict__ O1, const float* __restrict__ ada1) {
  const int tid_ = tidx(wv); const int wid = tid_ >> 6, lane = tid_ & 63;
  for (int row0 = (blockIdx.x * 8 + wid) * 2; row0 < NLAT; row0 += gridDim.x * 16) {
    f32x4 v[2][4]; u32x2 ov[2][4]; float ss[2];
#pragma unroll
    for (int q = 0; q < 2; ++q) {
      ss[q] = 0.f;
#pragma unroll
      for (int i = 0; i < 4; ++i) {
        v[q][i] = *reinterpret_cast<const f32x4*>(out + (size_t)(row0 + q) * 1024 + i * 256 + lane * 4);
        ov[q][i] = *reinterpret_cast<const u32x2*>(O1 + (size_t)(row0 + q) * 1024 + i * 256 + lane * 4);
      }
    }
#pragma unroll
    for (int q = 0; q < 2; ++q) {
      const float* gp = ada1 + ((row0 + q) >> 11) * 3072 + 2048;
#pragma unroll
      for (int i = 0; i < 4; ++i) {
        const f32x4 g = *reinterpret_cast<const f32x4*>(gp + i * 256 + lane * 4);
        v[q][i][0] += g[0] * bflo(ov[q][i][0]); v[q][i][1] += g[1] * bfhi(ov[q][i][0]); v[q][i][2] += g[2] * bflo(ov[q][i][1]); v[q][i][3] += g[3] * bfhi(ov[q][i][1]);
        ss[q] += v[q][i][0] * v[q][i][0] + v[q][i][1] * v[q][i][1] + v[q][i][2] * v[q][i][2] + v[q][i][3] * v[q][i][3];
      }
      ss[q] = wave_sum(ss[q]);
    }
#pragma unroll
    for (int q = 0; q < 2; ++q) {
      const float r = rsqrtf(ss[q] * (1.f / 1024.f) + 1e-6f);
#pragma unroll
      for (int i = 0; i < 4; ++i) {
        const int c = i * 256 + lane * 4;
        const f32x4 w = *reinterpret_cast<const f32x4*>(fw + c);
        *reinterpret_cast<f32x4*>(out + (size_t)(row0 + q) * 1024 + c) = v[q][i] * r * w;
      }
    }
  }
}

typedef const __attribute__((address_space(4))) Params* KArgP;
DEVI void run_phase(int wv, KArgP pp, int ph, char* lds) {
#if defined(__HIP_DEVICE_COMPILE__)
  asm volatile("" : "+s"(pp));
  char* ws = pp->ws;
  const float2* rope = (const float2*)(ws + OFF_ROPE);
  const float* ada0 = (const float*)(ws + OFF_ADA); const float* ada1 = ada0 + 17 * 3072;
  bf16_t* X = (bf16_t*)(ws + OFF_X); bf16_t* MIX = (bf16_t*)(ws + OFF_MIX);
  const int G = gridDim.x, B = blockIdx.x;
  PG8_LAS unsigned char* ldsp = (PG8_LAS unsigned char*)lds;
  switch (ph) {
    case 0: { const Params p = *pp; phase0(wv, p, lds); } break;
    case 1: norm_mod<false>(wv, pp->x, pp->ctx, pp->norm_w, ada0, X, 0, NTOK, B, G); break;
    case 2: {
      EpiL0In epi{(bf16_t*)(ws + OFF_U), (bf16_t*)(ws + OFF_GV), (bf16_t*)(ws + OFF_ZA), (bf16_t*)(ws + OFF_ZB), (bf16_t*)(ws + OFF_Q0), (bf16_t*)(ws + OFF_K0), (bf16_t*)(ws + OFF_V0), rope};
      gemm_phase(wv, ldsp, X, (const bf16_t*)(ws + OFF_W0IN), 1024, Sched{14, 144 * 14, 144 * 14, 0, 0}, epi);
    } break;
    case 3: { const Params p = *pp;
      for (int it = B; it < 1024 + 288 + 128; it += G) {
        if (it < 1024) {
          const int xcd = it & 7, slot = (it >> 3) & 31, rd = it >> 8;
          const int bh = rd * 16 + xcd * 2 + (slot >> 4), qb = slot & 15, b = bh >> 2, h = bh & 3;
          attn0_item(wv, p, b * 2048 + qb * 128, b, h, KVL, lds);
        } else if (it < 1024 + 288) abranch_item(wv, p, it - 1024, lds);
        else { const int i2 = it - 1312; const int b = i2 >> 3, h = (i2 >> 1) & 3, qb = i2 & 1; attn0_item(wv, p, NLAT + b * 256 + qb * 128, b, h, 256, lds); }
      }
    } break;
    case 4: {
      EpiPlain epi{X};
      gemm_phase(wv, ldsp, MIX, (const bf16_t*)(ws + OFF_W0OUT), 1024, Sched{4, 144 * 4, 144 * 4, 0, 0}, epi);
    } break;
    case 5: {
      if (B >= G - 16) {
        const int cp = B - (G - 16);
        norm_mod<true>(wv, pp->x, pp->ctx, pp->norm_w + 1024, ada1, X, NLAT + cp * 256, NLAT + cp * 256 + 256, 0, 1, ada0, pp->out, (float*)(ws + OFF_H1C));
        asm volatile("s_waitcnt vmcnt(0)" ::: "memory"); __syncthreads();
        EpiL1In epi{(bf16_t*)(ws + OFF_CQ), (bf16_t*)(ws + OFF_CKV), (bf16_t*)(ws + OFF_K1), (bf16_t*)(ws + OFF_Z1), (float*)(ws + OFF_RQ), (float*)(ws + OFF_RKV), rope, (float*)(lds + LDS_SS)};
        gemm_phase(wv, ldsp, X, (const bf16_t*)(ws + OFF_W1IN), 1024, Sched{6, 0, 16, 128, 1, G - 16}, epi);
      } else norm_mod<true>(wv, pp->x, pp->ctx, pp->norm_w + 1024, ada1, X, 0, NLAT, B, G - 16, ada0, pp->out, (float*)(ws + OFF_H1C));
    } break;
    case 6: {
      EpiL1In epi{(bf16_t*)(ws + OFF_CQ), (bf16_t*)(ws + OFF_CKV), (bf16_t*)(ws + OFF_K1), (bf16_t*)(ws + OFF_Z1), (float*)(ws + OFF_RQ), (float*)(ws + OFF_RKV), rope, (float*)(lds + LDS_SS)};
      gemm_phase(wv, ldsp, X, (const bf16_t*)(ws + OFF_W1IN), 1024, Sched{6, 768, 768, 128, 1}, epi);
    } break;
    case 7: {
      EpiQ eq{(bf16_t*)(ws + OFF_Q1), (const float*)(ws + OFF_RQ), rope};
      EpiKV ek{(bf16_t*)(ws + OFF_K1), (bf16_t*)(ws + OFF_V1), (const float*)(ws + OFF_RKV)};
      gemm_phase(wv, ldsp, (const bf16_t*)(ws + OFF_CQ), (const bf16_t*)(ws + OFF_WQ), 256, Sched{6, 768, 768, 0, 0}, eq);
      gemm_phase(wv, ldsp, (const bf16_t*)(ws + OFF_CKV), (const bf16_t*)(ws + OFF_WKV), 128, Sched{8, 1152, 1152, 0, 0}, ek);
    } break;
    case 8: { const Params p = *pp;
      for (int it = B; it < 1024; it += G) {
        const int xcd = it & 7, slot = (it >> 3) & 31, rd = it >> 8;
        const int bh = rd * 32 + xcd * 4 + (slot >> 3), qb = slot & 7;
        attn1_item(wv, p, bh >> 3, bh & 7, qb, lds);
      }
    } break;
    case 9: {
      EpiPlain epi{X};
      gemm_phase(wv, ldsp, MIX, (const bf16_t*)(ws + OFF_W1OUT), 1024, Sched{4, 128 * 4, 128 * 4, 0, 0}, epi);
    } break;
    case 10: final_norm(wv, pp->out, pp->final_w, X, ada1); break;
  }
#endif
}


#define XB_TMO      128
#define XB_XCNT(j)  (256  + 64 * (j))
#define XB_XSUB(j)  (1280 + 64 * (j))
#define XB_XGEN(j)  (2304 + 64 * (j))
#define XB_TOP      3328
#define XB_TOPGEN   3392
#define XCD_BAR_WORDS 3456
#define XB_SPIN_CAP (1u << 18)
#define LAS __attribute__((address_space(3)))
DEVI unsigned xb_ld(unsigned* p) { return __hip_atomic_load(p, __ATOMIC_RELAXED, __HIP_MEMORY_SCOPE_AGENT); }
DEVI unsigned xb_add(unsigned* p, unsigned v) { return __hip_atomic_fetch_add(p, v, __ATOMIC_RELAXED, __HIP_MEMORY_SCOPE_AGENT); }
DEVI unsigned xb_xcc_id() { return (unsigned)__builtin_amdgcn_s_getreg((3 << 11) | 20) & 0xFu; }
#define XB_SPIN(cond, bar) do { unsigned _sp = 0; while (cond) { __builtin_amdgcn_s_sleep(1); \
    if ((++_sp & 255u) == 0u) { if (xb_ld(&(bar)[XB_TMO])) break; if (_sp > XB_SPIN_CAP) { atomicAdd(&(bar)[XB_TMO], 1u); break; } } } } while (0)
struct XcdBarrier { unsigned* bar; unsigned x; volatile LAS unsigned* st; };
DEVI XcdBarrier xcd_barrier_post(int wv, unsigned* bar, volatile LAS unsigned* st) {
  XcdBarrier b; b.bar = bar; b.x = xb_xcc_id(); b.st = st;
  if (tidx(wv) == 0) (void)xb_add(&bar[XB_XCNT(b.x)], 1u);
  return b;
}
DEVI void xcd_barrier_complete(unsigned* bar, unsigned x, unsigned& nloc, unsigned& nx) {
  const unsigned G = gridDim.x * gridDim.y * gridDim.z;
  unsigned sum, cnt, mine, sp = 0u;
  for (;;) {
    sum = 0u; cnt = 0u; mine = 0u;
#pragma unroll
    for (unsigned j = 0; j < 16; ++j) { const unsigned c = xb_ld(&bar[XB_XCNT(j)]); sum += c; cnt += (c > 0u) ? 1u : 0u; mine = (j == x) ? c : mine; }
    if (sum == G) break;
    __builtin_amdgcn_s_sleep(1);
    if ((++sp & 255u) == 0u) { if (xb_ld(&bar[XB_TMO])) break; if (sp > XB_SPIN_CAP) { atomicAdd(&bar[XB_TMO], 1u); break; } }
  }
  nloc = mine > 0u ? mine : 1u; nx = cnt > 0u ? cnt : 1u;
}
DEVI void xcd_barrier(int wv, const XcdBarrier& b) {
  asm volatile("s_waitcnt vmcnt(0)" ::: "memory");
  __syncthreads();
  if (tidx(wv) == 0) {
    unsigned* bar = b.bar;
    __builtin_amdgcn_s_waitcnt(0);
    unsigned nloc = b.st[0], nx = b.st[1];
    if (nloc == 0u) { xcd_barrier_complete(bar, b.x, nloc, nx); b.st[0] = nloc; b.st[1] = nx; }
    const unsigned old = xb_add(&bar[XB_XSUB(b.x)], 1u);
    const unsigned gen = old / nloc;
    if (old + 1u == (gen + 1u) * nloc) {
      __builtin_amdgcn_fence(__ATOMIC_RELEASE, "agent");
      asm volatile("s_waitcnt vmcnt(0)" ::: "memory");
      const unsigned og = xb_add(&bar[XB_TOP], 1u);
      const unsigned tg = og / nx;
      if (og + 1u == (tg + 1u) * nx) xb_add(&bar[XB_TOPGEN], 1u);
      else XB_SPIN(xb_ld(&bar[XB_TOPGEN]) == tg, bar);
      __builtin_amdgcn_fence(__ATOMIC_ACQUIRE, "agent");
      xb_add(&bar[XB_XGEN(b.x)], 1u);
      asm volatile("s_waitcnt vmcnt(0)" ::: "memory");
    } else {
      XB_SPIN(xb_ld(&bar[XB_XGEN(b.x)]) == gen, bar);
      __builtin_amdgcn_fence(__ATOMIC_ACQUIRE, "agent");
      asm volatile("s_waitcnt vmcnt(0)" ::: "memory");
    }
  }
  __syncthreads();
}

extern __shared__ __attribute__((aligned(16))) char g_lds[];

constexpr int LDS_XB = 143360;
__global__ void __launch_bounds__(512) mega(Params p) {
  cg::grid_group grid = cg::this_grid();
  if (p.ph_hi > 64) grid.sync();
  const int wv = __builtin_amdgcn_readfirstlane((int)threadIdx.x >> 6);
  volatile LAS unsigned* xst = (volatile LAS unsigned*)(g_lds + LDS_XB);
  if (tidx(wv) == 0) { xst[0] = 0u; xst[1] = 0u; }
  __syncthreads();
  (void)xcd_barrier_post(wv, (unsigned*)(p.ws + OFF_BAR), xst);
#define GRID_BARRIER() do { KArgP _pp = (KArgP)__builtin_amdgcn_kernarg_segment_ptr(); asm volatile("" : "+s"(_pp)); \
    XcdBarrier _xb; _xb.bar = (unsigned*)(_pp->ws + OFF_BAR); _xb.x = xb_xcc_id(); _xb.st = (volatile LAS unsigned*)(g_lds + LDS_XB); xcd_barrier(wv, _xb); } while (0)
  for (int ph = p.ph_lo; ph < p.ph_hi; ++ph) {
    run_phase(wv, (KArgP)__builtin_amdgcn_kernarg_segment_ptr(), ph, g_lds);
#ifdef PROBE_PH
    if (ph == PROBE_PH) { GRID_BARRIER(); run_phase(wv, (KArgP)__builtin_amdgcn_kernarg_segment_ptr(), ph, g_lds); }
#endif
    if (ph + 1 < p.ph_hi) GRID_BARRIER();
  }
}

extern "C" void kernel_launch(void* const* d_in, const int* in_sizes, int n_in, void* d_out, int out_size, void* d_ws, size_t ws_size, hipStream_t stream) {
  static int ok = 0;
  static int grid_blocks = 0;
  if (!ok) {
    if (n_in != 25 || ws_size < WS_NEED) { fprintf(stderr, "kernel_launch: bad args n_in %d ws %zu need %zu\n", n_in, ws_size, (size_t)WS_NEED); return; }
    if (hipFuncSetAttribute((const void*)mega, hipFuncAttributeMaxDynamicSharedMemorySize, LDS_BYTES) != hipSuccess) { fprintf(stderr, "kernel_launch: LDS attr failed\n"); return; }
    int dev = 0, cus = 0, per_cu = 0;
    hipGetDevice(&dev);
    hipDeviceGetAttribute(&cus, hipDeviceAttributeMultiprocessorCount, dev);
    hipOccupancyMaxActiveBlocksPerMultiprocessor(&per_cu, mega, 512, LDS_BYTES);
    if (per_cu < 1) per_cu = 1;
    grid_blocks = cus * per_cu;
    ok = 1;
  }
  Params p{};
  const float** pp = (const float**)&p;
  for (int i = 0; i < 25; ++i) pp[i] = (const float*)d_in[i];
  p.out = (float*)d_out; p.ws = (char*)d_ws;
#if ONE_LAUNCH
  p.ph_lo = 0; p.ph_hi = 11;
  hipMemsetAsync((char*)d_ws + OFF_BAR, 0, XCD_BAR_WORDS * 4, stream);
  void* args[] = {&p};
  hipError_t e = hipLaunchCooperativeKernel((const void*)mega, dim3(grid_blocks), dim3(512), args, LDS_BYTES, stream);
  if (e != hipSuccess) fprintf(stderr, "cooperative launch failed: %s (grid %d)\n", hipGetErrorString(e), grid_blocks);
#else
  for (int ph = 0; ph < 11; ++ph) {
    p.ph_lo = ph; p.ph_hi = ph + 1;
    hipLaunchKernelGGL(mega, dim3(grid_blocks), dim3(512), LDS_BYTES, stream, p);
  }
#endif
}
```

```cpp
#include <hip/hip_runtime.h>
#include <hip/hip_cooperative_groups.h>
#include <cstdio>
namespace cg = cooperative_groups;

#ifndef ATT_SD0
#define ATT_SD0 2
#endif
#ifndef ONE_LAUNCH
#define ONE_LAUNCH 1
#endif

typedef unsigned short bf16_t;
typedef short bf16x8 __attribute__((ext_vector_type(8)));
typedef short s16x4 __attribute__((ext_vector_type(4)));
typedef float f32x16 __attribute__((ext_vector_type(16)));
typedef float f32x4 __attribute__((ext_vector_type(4)));
typedef unsigned u32x4 __attribute__((ext_vector_type(4)));
typedef unsigned u32x2 __attribute__((ext_vector_type(2)));
#define DEVI __device__ __forceinline__
#define SBAR() __builtin_amdgcn_sched_barrier(0)
DEVI int tidx(int wv) { int l; asm volatile("v_mbcnt_lo_u32_b32 %0, -1, 0\n\tv_mbcnt_hi_u32_b32 %0, -1, %0" : "=v"(l)); return (wv << 6) | l; }

constexpr int NLAT = 32768, NCTX = 4096, NTOK = 36864, KVL = 2304;
constexpr int LDS_BYTES = 147456, LDS_SS = 139264;

constexpr size_t OFF_W0IN = 0;
constexpr size_t OFF_W0OUT = OFF_W0IN + 3584ull * 1024 * 2;
constexpr size_t OFF_W1IN = OFF_W0OUT + 1024ull * 1024 * 2;
constexpr size_t OFF_WQ = OFF_W1IN + 1536ull * 1024 * 2;
constexpr size_t OFF_WKV = OFF_WQ + 1536ull * 256 * 2;
constexpr size_t OFF_W1OUT = OFF_WKV + 2048ull * 128 * 2;
constexpr size_t OFF_WSB = OFF_W1OUT + 1024ull * 1024 * 2;
constexpr size_t OFF_ADA = OFF_WSB + 8ull * 128 * 128 * 2;
constexpr size_t OFF_ROPE = OFF_ADA + 2ull * 17 * 3072 * 4;
constexpr size_t OFF_BAR = OFF_ROPE + 64ull * 16 * 8;
constexpr size_t OFF_H1C = OFF_BAR + 16384;
constexpr size_t OFF_RQ = OFF_H1C + 4096ull * 1024 * 4;
constexpr size_t OFF_RKV = OFF_RQ + 32768ull * 4;
constexpr size_t OFF_X = OFF_RKV + 36864ull * 4;
constexpr size_t OFF_MIX = OFF_X + 36864ull * 1024 * 2;
constexpr size_t OFF_T = OFF_MIX + 36864ull * 1024 * 2;
constexpr size_t SZ_HALF = 36864ull * 512 * 2;
constexpr size_t OFF_U = OFF_T, OFF_GV = OFF_U + SZ_HALF, OFF_ZA = OFF_GV + SZ_HALF, OFF_ZB = OFF_ZA + SZ_HALF, OFF_Q0 = OFF_ZB + SZ_HALF;
constexpr size_t OFF_K0 = OFF_Q0 + SZ_HALF, OFF_V0 = OFF_K0 + 16ull * 4 * KVL * 128 * 2, END_L0 = OFF_V0 + 16ull * 4 * KVL * 128 * 2;
constexpr size_t OFF_CQ = OFF_T, OFF_CKV = OFF_CQ + 32768ull * 256 * 2, OFF_Z1 = OFF_CKV + 36864ull * 128 * 2;
constexpr size_t OFF_Q1 = OFF_Z1 + 32768ull * 1024 * 2, OFF_K1 = OFF_Q1 + 32768ull * 1536 * 2, END_L1 = OFF_K1 + 16ull * 8 * KVL * 192 * 2;
constexpr size_t OFF_V1 = OFF_X;
constexpr size_t WS_NEED = END_L1 > END_L0 ? END_L1 : END_L0;

struct Params {
  const float *x, *c, *ctx, *c_ctx, *norm_w, *ada_w, *ada_b, *even_w_in, *a_ws, *a_bs, *a_ln_w, *a_ln_b,
      *b_lq1, *b_lk1, *b_lq2, *b_lk2, *b_subln_w, *even_w_out, *odd_w_in, *c_q_norm_w, *c_wq_b,
      *c_kv_norm_w, *c_wkv_b, *odd_w_out, *final_w;
  float* out; char* ws; int ph_lo, ph_hi;
};

DEVI unsigned cvtpk(float lo, float hi) { unsigned r; asm("v_cvt_pk_bf16_f32 %0, %1, %2" : "=v"(r) : "v"(lo), "v"(hi)); return r; }
DEVI bf16_t f2bf(float v) { return (bf16_t)(cvtpk(v, 0.f) & 0xffffu); }
DEVI float bf2f(bf16_t v) { return __uint_as_float(((unsigned)v) << 16); }
DEVI float bflo(unsigned w) { return __uint_as_float(w << 16); }
DEVI float bfhi(unsigned w) { return __uint_as_float(w & 0xffff0000u); }
DEVI int crow(int r, int hi) { return (r & 3) + 8 * (r >> 2) + 4 * hi; }
DEVI float silu_f(float x) { return x * __builtin_amdgcn_rcpf(1.f + __builtin_amdgcn_exp2f(x * -1.4426950408889634f)); }
DEVI float gelu_f(float v) {
  const float t = __builtin_amdgcn_rcpf(fmaf(fabsf(v), 0.2316418882f, 1.0f));
  float q = fmaf(t, 0.5307027145f, -0.7265760135f); q = fmaf(q, t, 0.7107068705f); q = fmaf(q, t, -0.142248368f); q = fmaf(q, t, 0.127414796f); q *= t;
  const float m = v * (q * __builtin_amdgcn_exp2f(v * v * -0.72134752044f));
  return v < 0.f ? m : v - m;
}

template <int M> DEVI float xsum(float v) {
  if constexpr (M == 32) { auto rr = __builtin_amdgcn_permlane32_swap(__float_as_uint(v), __float_as_uint(v), false, false); return __uint_as_float(rr[0]) + __uint_as_float(rr[1]); }
  else return v + __int_as_float(__builtin_amdgcn_ds_swizzle(__float_as_int(v), (M << 10) | 0x1f));
}
DEVI float wave_sum(float v) { v = xsum<1>(v); v = xsum<2>(v); v = xsum<4>(v); v = xsum<8>(v); v = xsum<16>(v); return xsum<32>(v); }

DEVI void rope_tile(f32x16& v, const float2* __restrict__ tab, int pos, int hi) {
#pragma unroll
  for (int r = 0; r < 8; ++r) {
    const int jf = (r & 3) + 8 * (r >> 2) + 4 * hi;
    const float2 cs = tab[pos * 16 + jf];
    const float a = v[r], b = v[r + 8];
    v[r] = a * cs.x - b * cs.y; v[r + 8] = b * cs.x + a * cs.y;
  }
}
DEVI void store4(bf16_t* dst, const f32x16& v, int rg) {
  u32x2 pk = {cvtpk(v[rg * 4 + 0], v[rg * 4 + 1]), cvtpk(v[rg * 4 + 2], v[rg * 4 + 3])};
  *reinterpret_cast<u32x2*>(dst) = pk;
}

#define PG8_LAS __attribute__((address_space(3)))
constexpr int HTB = 128 * 64 * 2;
DEVI int lds_byte(int r, int c) { const int st = (r >> 4) * 2 + (c >> 5), rr = r & 15, cc = c & 31, ob = rr * 64 + cc * 2; return st * 1024 + (ob ^ (((ob >> 9) & 1) << 5)); }
DEVI void stage_rc(int b, int& R, int& C) { const int st = b / 1024, sb = b % 1024, swz = sb ^ (((sb >> 9) & 1) << 5); R = (st >> 1) * 16 + swz / 64; C = (st & 1) * 32 + (swz % 64) / 2; }
DEVI int perm32(int rho) { const int n = rho >> 4, i = rho & 15; return 8 * (i >> 2) + 4 * n + (i & 3); }
struct Unit { int pm, pn; };
struct Sched {
  int nN, nmain, ntotal, xpm0, xpn, boff = 0;
  DEVI bool next(int i, Unit& u) const {
    const int it = (int)blockIdx.x - boff + i * (int)gridDim.x; if (it < 0 || it >= ntotal) return false;
    if (it < nmain) { const int xcd = it & 7, jx = it >> 3; u.pm = (jx / nN) * 8 + xcd; u.pn = jx % nN; } else { u.pm = xpm0 + (it - nmain); u.pn = xpn; }
    return true;
  }
};
template <class Epi>
DEVI void gemm_phase(int wv, PG8_LAS unsigned char* lds, const bf16_t* gA, const bf16_t* gBt, const int K, const Sched& S, const Epi& E) {
  const int tid = tidx(wv), wid = __builtin_amdgcn_readfirstlane(tid >> 6), lane = tid & 63, wr = wid >> 2, wc = wid & 3, fr = lane & 15, fq = lane >> 4;
  const int nt = K / 64;
  unsigned voffA[2], voffB[2];
#pragma unroll
  for (int i = 0; i < 2; ++i) { int R, C; stage_rc(tid * 16 + i * 8192, R, C); const int Rb = (R & ~31) + perm32(R & 31); voffA[i] = (unsigned)(R * K + C) * 2u; voffB[i] = (unsigned)(Rb * K + C) * 2u; }
  const size_t kstep = (size_t)(64 * 2);
  const size_t hstep = (size_t)128 * K * 2;
  const size_t tstep = 2 * hstep;
  const unsigned ldsw = (unsigned)wid * 1024u;
  const int aoff = lds_byte(wr * 64 + fr, fq * 8), boff = lds_byte(wc * 32 + fr, fq * 8);
#define PG8_SA(b, h) (((b) * 2 + (h)) * HTB)
#define PG8_SB(b, h) ((4 + (b) * 2 + (h)) * HTB)
#define PG8_STAGE(bufoff, gbase, voff) do { _Pragma("unroll") for (int _i = 0; _i < 2; ++_i) \
    __builtin_amdgcn_global_load_lds((const unsigned*)((const char*)(gbase) + (voff)[_i]), (PG8_LAS unsigned*)(lds + (bufoff) + ldsw + _i * 8192), 16, 0, 0); } while (0)
#define PG8_LDA(dst, b, h) do { _Pragma("unroll") for (int m = 0; m < 4; ++m) _Pragma("unroll") for (int k = 0; k < 2; ++k) dst[m][k] = *(const PG8_LAS bf16x8*)(lds + PG8_SA(b, h) + aoff + m * 2048 + k * 1024); } while (0)
#define PG8_LDB(dst, b, h) do { _Pragma("unroll") for (int n = 0; n < 2; ++n) _Pragma("unroll") for (int k = 0; k < 2; ++k) dst[n][k] = *(const PG8_LAS bf16x8*)(lds + PG8_SB(b, h) + boff + n * 2048 + k * 1024); } while (0)
#define PG8_MMA(ai, bj, At, Bt) do { __builtin_amdgcn_s_setprio(1); _Pragma("unroll") for (int m = 0; m < 4; ++m) _Pragma("unroll") for (int n = 0; n < 2; ++n) _Pragma("unroll") for (int k = 0; k < 2; ++k) \
    acc[ai][bj][m][n] = __builtin_amdgcn_mfma_f32_16x16x32_bf16(Bt[n][k], At[m][k], acc[ai][bj][m][n], 0, 0, 0); __builtin_amdgcn_s_setprio(0); } while (0)
#define PG8_WAIT_V(n) asm volatile("s_waitcnt vmcnt(" #n ")" ::: "memory")
#define PG8_WAIT_L(n) asm volatile("s_waitcnt lgkmcnt(" #n ")" ::: "memory")
#define PG8_BAR __builtin_amdgcn_s_barrier()
#define PG8_SCHED __builtin_amdgcn_sched_barrier(0)
  Unit cur, nxt; int ui = 0;
  if (!S.next(0, cur)) return;
  f32x4 acc[2][2][4][2];
#pragma unroll
  for (int a = 0; a < 2; ++a)
#pragma unroll
    for (int b = 0; b < 2; ++b)
#pragma unroll
      for (int m = 0; m < 4; ++m)
#pragma unroll
        for (int n = 0; n < 2; ++n) acc[a][b][m][n] = (f32x4){0.f, 0.f, 0.f, 0.f};
  bf16x8 At[4][2], B0[2][2], B1[2][2];
  const char* cA = (const char*)gA + (size_t)cur.pm * tstep; const char* cB = (const char*)gBt + (size_t)cur.pn * tstep;
  PG8_STAGE(PG8_SB(0, 0), cB, voffB); PG8_STAGE(PG8_SA(0, 0), cA, voffA); PG8_STAGE(PG8_SB(0, 1), cB + hstep, voffB); PG8_STAGE(PG8_SA(0, 1), cA + hstep, voffA);
  if (wr == 1) PG8_BAR;
  PG8_WAIT_V(4); PG8_BAR;
  PG8_STAGE(PG8_SB(1, 0), cB + kstep, voffB); PG8_STAGE(PG8_SA(1, 0), cA + kstep, voffA); PG8_STAGE(PG8_SB(1, 1), cB + hstep + kstep, voffB);
  PG8_WAIT_V(6); PG8_BAR;
  for (;;) {
    const bool has_next = S.next(ui + 1, nxt);
    const char* nA = has_next ? (const char*)gA + (size_t)nxt.pm * tstep : cA; const char* nB = has_next ? (const char*)gBt + (size_t)nxt.pn * tstep : cB;
#pragma unroll 1
    for (int t = 0; t < nt; t += 2) {
      const bool last = (t == nt - 2);
      const char* a1 = cA + (size_t)(t + 1) * kstep;
      const char* a2 = last ? nA : cA + (size_t)(t + 2) * kstep; const char* b2 = last ? nB : cB + (size_t)(t + 2) * kstep;
      const char* a3 = a2 + kstep; const char* b3 = b2 + kstep;
      PG8_LDB(B0, 0, 0); PG8_SCHED; PG8_LDA(At, 0, 0); PG8_STAGE(PG8_SA(1, 1), a1 + hstep, voffA);
      PG8_WAIT_L(8); PG8_BAR; PG8_WAIT_L(0); PG8_MMA(0, 0, At, B0); PG8_BAR; PG8_SCHED;
      PG8_LDB(B1, 0, 1); PG8_STAGE(PG8_SB(0, 0), b2, voffB);
      PG8_BAR; PG8_WAIT_L(0); PG8_MMA(0, 1, At, B1); PG8_BAR;
      PG8_LDA(At, 0, 1); PG8_STAGE(PG8_SA(0, 0), a2, voffA);
      PG8_BAR; PG8_WAIT_L(0); PG8_MMA(1, 0, At, B0); PG8_BAR; PG8_SCHED;
      PG8_STAGE(PG8_SB(0, 1), b2 + hstep, voffB);
      PG8_WAIT_V(6); PG8_BAR; PG8_MMA(1, 1, At, B1); PG8_BAR;
      PG8_LDB(B0, 1, 0); PG8_SCHED; PG8_LDA(At, 1, 0); PG8_STAGE(PG8_SA(0, 1), a2 + hstep, voffA);
      PG8_WAIT_L(8); PG8_BAR; PG8_WAIT_L(0); PG8_MMA(0, 0, At, B0); PG8_BAR; PG8_SCHED;
      PG8_LDB(B1, 1, 1); PG8_STAGE(PG8_SB(1, 0), b3, voffB);
      PG8_BAR; PG8_WAIT_L(0); PG8_MMA(0, 1, At, B1); PG8_BAR;
      PG8_LDA(At, 1, 1); PG8_STAGE(PG8_SA(1, 0), a3, voffA);
      PG8_BAR; PG8_WAIT_L(0); PG8_MMA(1, 0, At, B0); PG8_BAR; PG8_SCHED;
      PG8_STAGE(PG8_SB(1, 1), b3 + hstep, voffB);
      PG8_WAIT_V(6); PG8_BAR; PG8_MMA(1, 1, At, B1); PG8_BAR;
    }
    E(acc, cur, wr, wc, fr, fq);
    if (!has_next) break;
#pragma unroll
    for (int a = 0; a < 2; ++a)
#pragma unroll
      for (int b = 0; b < 2; ++b)
#pragma unroll
        for (int m = 0; m < 4; ++m)
#pragma unroll
          for (int n = 0; n < 2; ++n) acc[a][b][m][n] = (f32x4){0.f, 0.f, 0.f, 0.f};
    cur = nxt; cA = nA; cB = nB; ++ui;
  }
  PG8_WAIT_V(0);
  if (wr == 0) PG8_BAR;
  PG8_BAR;
#undef PG8_SA
#undef PG8_SB
#undef PG8_STAGE
#undef PG8_LDA
#undef PG8_LDB
#undef PG8_MMA
#undef PG8_WAIT_V
#undef PG8_WAIT_L
#undef PG8_BAR
#undef PG8_SCHED
}

typedef f32x4 acc_t[2][2][4][2];
DEVI void token_info(int token, bool ctx, int& b, int& s, int& key) {
  if (!ctx) { b = token >> 11; s = token & 2047; key = 256 + s; } else { const int tc = token - NLAT; b = tc >> 8; s = 0; key = tc & 255; }
}
DEVI float swap32_partner(float v, bool upper) {
  auto rr = __builtin_amdgcn_permlane32_swap(__float_as_uint(v), __float_as_uint(v), false, false);
  return __uint_as_float(upper ? rr[0] : rr[1]);
}
DEVI void rope_pair(f32x4& v0, f32x4& v1, const float2* __restrict__ tab, int pos, int fq) {
  const bool upper = fq >= 2;
  const float2* t = tab + pos * 16 + (fq & 1) * 8;
  const f32x4 t0 = *reinterpret_cast<const f32x4*>(t), t1 = *reinterpret_cast<const f32x4*>(t + 2), t2 = *reinterpret_cast<const f32x4*>(t + 4), t3 = *reinterpret_cast<const f32x4*>(t + 6);
  const float cs[8] = {t0[0], t0[2], t1[0], t1[2], t2[0], t2[2], t3[0], t3[2]}, sn[8] = {t0[1], t0[3], t1[1], t1[3], t2[1], t2[3], t3[1], t3[3]};
#pragma unroll
  for (int e = 0; e < 4; ++e) {
    const float p0 = swap32_partner(v0[e], upper), p1 = swap32_partner(v1[e], upper);
    const float s0 = upper ? sn[e] : -sn[e], s1 = upper ? sn[4 + e] : -sn[4 + e];
    v0[e] = v0[e] * cs[e] + p0 * s0; v1[e] = v1[e] * cs[4 + e] + p1 * s1;
  }
}
DEVI void st8(bf16_t* dst, const f32x4& v0, const f32x4& v1) { u32x4 pk = {cvtpk(v0[0], v0[1]), cvtpk(v0[2], v0[3]), cvtpk(v1[0], v1[1]), cvtpk(v1[2], v1[3])}; *reinterpret_cast<u32x4*>(dst) = pk; }

struct EpiL0In {
  bf16_t *U, *GV, *ZA, *ZB, *Q0, *K0, *V0; const float2* rope;
  DEVI void operator()(acc_t& acc, const Unit& u, int wr, int wc, int fr, int fq) const {
    const int col0 = u.pn * 256, type = col0 >> 9; const bool ctx = u.pm >= 128;
#pragma unroll
    for (int ai = 0; ai < 2; ++ai)
#pragma unroll
      for (int m = 0; m < 4; ++m) {
        const int token = u.pm * 256 + ai * 128 + wr * 64 + m * 16 + fr;
        int b, s, key; token_info(token, ctx, b, s, key);
#pragma unroll
        for (int bj = 0; bj < 2; ++bj) {
          const int nl = (col0 & 511) + bj * 128 + wc * 32;
          f32x4 v0 = acc[ai][bj][m][0], v1 = acc[ai][bj][m][1];
          bf16_t* dst;
          if (type <= 1) {
#pragma unroll
            for (int e = 0; e < 4; ++e) { v0[e] = gelu_f(v0[e]); v1[e] = gelu_f(v1[e]); }
            dst = (type == 0 ? U : GV) + (size_t)token * 512 + nl;
          } else if (type == 2 || type == 6) {
#pragma unroll
            for (int e = 0; e < 4; ++e) { v0[e] = silu_f(v0[e]); v1[e] = silu_f(v1[e]); }
            dst = (type == 2 ? ZA : ZB) + (size_t)token * 512 + nl;
          } else if (type == 3) {
            if (!ctx) rope_pair(v0, v1, rope, (wc & 1) ? (s & 63) : (s >> 6), fq);
            dst = Q0 + (size_t)token * 512 + nl;
          } else if (type == 4) {
            if (!ctx) rope_pair(v0, v1, rope, (wc & 1) ? (s & 63) : (s >> 6), fq);
            dst = K0 + ((size_t)(b * 4 + (nl >> 7)) * KVL + key) * 128 + (nl & 127);
          } else {
            dst = V0 + ((size_t)(b * 4 + (nl >> 7)) * KVL + key) * 128 + (nl & 127);
          }
          st8(dst + fq * 8, v0, v1);
        }
      }
  }
};

template <bool HASCTX> struct EpiOut {
  const float* src_lat; const float* src_ctx; float* dst_lat; float* dst_ctx; const float* ada;
  DEVI void operator()(acc_t& acc, const Unit& u, int wr, int wc, int fr, int fq) const {
    const int col0 = u.pn * 256;
#pragma unroll
    for (int ai = 0; ai < 2; ++ai)
#pragma unroll
      for (int m = 0; m < 4; ++m) {
        const int token = u.pm * 256 + ai * 128 + wr * 64 + m * 16 + fr;
        const float* src; float* dst; const float* gate;
        if (!HASCTX || token < NLAT) { src = src_lat + (size_t)token * 1024; dst = dst_lat + (size_t)token * 1024; gate = ada + (token >> 11) * 3072 + 2048; }
        else { const int tc = token - NLAT; src = src_ctx + (size_t)tc * 1024; dst = dst_ctx + (size_t)tc * 1024; gate = ada + 16 * 3072 + 2048; }
#pragma unroll
        for (int bj = 0; bj < 2; ++bj)
#pragma unroll
          for (int n = 0; n < 2; ++n) {
            const int c = col0 + bj * 128 + wc * 32 + fq * 8 + n * 4;
            const f32x4 xv = *reinterpret_cast<const f32x4*>(src + c), g = *reinterpret_cast<const f32x4*>(gate + c);
            *reinterpret_cast<f32x4*>(dst + c) = xv + g * acc[ai][bj][m][n];
          }
      }
  }
};

struct EpiPlain {
  bf16_t* O;
  DEVI void operator()(acc_t& acc, const Unit& u, int wr, int wc, int fr, int fq) const {
    const int col0 = u.pn * 256;
#pragma unroll
    for (int ai = 0; ai < 2; ++ai)
#pragma unroll
      for (int m = 0; m < 4; ++m) {
        const int token = u.pm * 256 + ai * 128 + wr * 64 + m * 16 + fr;
#pragma unroll
        for (int bj = 0; bj < 2; ++bj) st8(O + (size_t)token * 1024 + col0 + bj * 128 + wc * 32 + fq * 8, acc[ai][bj][m][0], acc[ai][bj][m][1]);
      }
  }
};

struct EpiL1In {
  bf16_t *CQ, *CKV, *K1, *Z1; float *RQ, *RKV; const float2* rope; float* ssb;
  DEVI void operator()(acc_t& acc, const Unit& u, int wr, int wc, int fr, int fq) const {
    const int col0 = u.pn * 256; const bool ctx = u.pm >= 128;
    float ss[2][4];
#pragma unroll
    for (int ai = 0; ai < 2; ++ai)
#pragma unroll
      for (int m = 0; m < 4; ++m) {
        ss[ai][m] = 0.f;
        const int token = u.pm * 256 + ai * 128 + wr * 64 + m * 16 + fr;
        int b, s, key; token_info(token, ctx, b, s, key);
#pragma unroll
        for (int bj = 0; bj < 2; ++bj) {
          const int nb = col0 + bj * 128 + wc * 32;
          f32x4 v0 = acc[ai][bj][m][0], v1 = acc[ai][bj][m][1];
          if (nb < 384) {
#pragma unroll
            for (int e = 0; e < 4; ++e) ss[ai][m] += v0[e] * v0[e] + v1[e] * v1[e];
            bf16_t* dst = nb < 256 ? CQ + (size_t)token * 256 + nb : CKV + (size_t)token * 128 + (nb - 256);
            st8(dst + fq * 8, v0, v1);
          } else if (nb < 448) {
            if (!ctx) rope_pair(v0, v1, rope, (nb >= 416) ? (s & 63) : (s >> 6), fq);
#pragma unroll
            for (int h = 0; h < 8; ++h) {
              bf16_t* dst = K1 + ((size_t)(b * 8 + h) * KVL + key) * 192 + 128 + (nb - 384);
              st8(dst + fq * 8, v0, v1);
            }
          } else if (nb < 1472) {
            if (!ctx) {
#pragma unroll
              for (int e = 0; e < 4; ++e) { v0[e] = silu_f(v0[e]); v1[e] = silu_f(v1[e]); }
              bf16_t* dst = Z1 + (size_t)token * 1024 + (nb - 448);
              st8(dst + fq * 8, v0, v1);
            }
          }
        }
      }
    if (u.pn <= 1) {
#pragma unroll
      for (int ai = 0; ai < 2; ++ai)
#pragma unroll
        for (int m = 0; m < 4; ++m) {
          float sv = ss[ai][m]; sv = xsum<16>(sv); sv = xsum<32>(sv);
          if (fq == 0) ssb[wc * 256 + ai * 128 + wr * 64 + m * 16 + fr] = sv;
        }
      asm volatile("s_waitcnt lgkmcnt(0)" ::: "memory"); __builtin_amdgcn_s_barrier(); asm volatile("" ::: "memory");
      const int lt = wc * 64 + fq * 16 + fr;
      if (lt < 128) {
        const int row = (lt >> 6) * 128 + wr * 64 + (lt & 63);
        if (u.pn == 0) { const float tot = (ssb[row] + ssb[256 + row]) + (ssb[512 + row] + ssb[768 + row]); RQ[u.pm * 256 + row] = rsqrtf(tot * (1.f / 256.f) + 1e-6f); }
        else { const float tot = (ssb[row] + ssb[256 + row]) + (ssb[512 + row] + ssb[768 + row]); RKV[u.pm * 256 + row] = rsqrtf(tot * (1.f / 128.f) + 1e-6f); }
      }
    }
  }
};

struct EpiQ {
  bf16_t* Q1; const float* RQ; const float2* rope;
  DEVI void operator()(acc_t& acc, const Unit& u, int wr, int wc, int fr, int fq) const {
    const int col0 = u.pn * 256;
#pragma unroll
    for (int ai = 0; ai < 2; ++ai)
#pragma unroll
      for (int m = 0; m < 4; ++m) {
        const int token = u.pm * 256 + ai * 128 + wr * 64 + m * 16 + fr; const int s = token & 2047; const float rq = RQ[token];
#pragma unroll
        for (int bj = 0; bj < 2; ++bj) {
          const int n0 = col0 + bj * 128 + wc * 32; const int dd0 = n0 % 192;
          f32x4 v0 = acc[ai][bj][m][0] * rq, v1 = acc[ai][bj][m][1] * rq;
          if (dd0 >= 128) rope_pair(v0, v1, rope, (dd0 >= 160) ? (s & 63) : (s >> 6), fq);
          bf16_t* dst = Q1 + (size_t)token * 1536 + n0;
          st8(dst + fq * 8, v0, v1);
        }
      }
  }
};

struct EpiKV {
  bf16_t *K1, *V1; const float* RKV;
  DEVI void operator()(acc_t& acc, const Unit& u, int wr, int wc, int fr, int fq) const {
    const int col0 = u.pn * 256; const bool ctx = u.pm >= 128;
#pragma unroll
    for (int ai = 0; ai < 2; ++ai)
#pragma unroll
      for (int m = 0; m < 4; ++m) {
        const int token = u.pm * 256 + ai * 128 + wr * 64 + m * 16 + fr; const float rk = RKV[token];
        int b, s, key; token_info(token, ctx, b, s, key);
#pragma unroll
        for (int bj = 0; bj < 2; ++bj) {
          const int nb = col0 + bj * 128 + wc * 32; const int h = nb >> 8, dd = nb & 255;
          const f32x4 v0 = acc[ai][bj][m][0] * rk, v1 = acc[ai][bj][m][1] * rk;
          bf16_t* dst = dd < 128 ? K1 + ((size_t)(b * 8 + h) * KVL + key) * 192 + dd : V1 + ((size_t)(b * 8 + h) * KVL + key) * 128 + (dd - 128);
          st8(dst + fq * 8, v0, v1);
        }
      }
  }
};

template <int SCID> struct ScaleOf { static constexpr float v = SCID == 0 ? 0.125f : 0.07216878364870322f; };
constexpr float THR = 8.f;
template <int KW> DEVI int kswz(int row, int colB) { return row * (KW * 2 + 16) + colB; }
DEVI int v_st(int k, int c) { const int kk = (k & ~0xC) | ((k & 4) << 1) | ((k & 8) >> 1); return ((kk >> 3) * 4 + (c >> 5)) * 512 + ((kk & 7) * 32 + (c & 31)) * 2; }
DEVI int v_rd_base(int lane) { return ((lane & 3) << 3) | (((lane >> 2) & 3) << 6) | (((lane >> 4) & 1) << 5) | (((lane >> 5) & 1) << 8); }
constexpr int v_rd_off(int d0, int ks, int half) { return d0 * 512 + ks * 4096 + half * 2048; }
template <int OFF> DEVI s16x4 tr_read(int vb) { s16x4 r; asm volatile("ds_read_b64_tr_b16 %0, %1 offset:%2" : "=&v"(r) : "v"(vb), "i"(OFF) : "memory"); return r; }

template <int SCID>
DEVI void partialSM(f32x16& p0, f32x16& p1, float& m_reg, float& mn, float& alpha) {
  constexpr float SC = ScaleOf<SCID>::v; constexpr float C = SC * 1.4426950408889634f;
  float pmax = p0[0];
#pragma unroll
  for (int r = 1; r < 16; ++r) pmax = fmaxf(pmax, p0[r]);
#pragma unroll
  for (int r = 0; r < 16; ++r) pmax = fmaxf(pmax, p1[r]);
  { auto rr = __builtin_amdgcn_permlane32_swap(__float_as_uint(pmax), __float_as_uint(pmax), false, false);
    pmax = fmaxf(__uint_as_float(rr[0]), __uint_as_float(rr[1])); }
  if (__builtin_expect(__all(pmax - m_reg <= THR / SC), 1)) { mn = m_reg; alpha = 1.f; }
  else { mn = fmaxf(m_reg, pmax); alpha = __builtin_amdgcn_exp2f((m_reg - mn) * C); m_reg = mn; }
  const float mnC = -mn * C;
#pragma unroll
  for (int r = 0; r < 16; ++r) p0[r] = fmaf(p0[r], C, mnC);
#pragma unroll
  for (int r = 0; r < 16; ++r) p1[r] = fmaf(p1[r], C, mnC);
#pragma unroll
  for (int r = 0; r < 16; ++r) p0[r] = __builtin_amdgcn_exp2f(p0[r]);
}
DEVI void finishSM(f32x16& p0, f32x16& p1, float alpha, float& l_reg, bf16x8& pa0, bf16x8& pa1, bf16x8& pa2, bf16x8& pa3) {
#pragma unroll
  for (int r = 0; r < 16; ++r) p1[r] = __builtin_amdgcn_exp2f(p1[r]);
  float ps = 0;
#pragma unroll
  for (int r = 0; r < 16; ++r) ps += p0[r];
#pragma unroll
  for (int r = 0; r < 16; ++r) ps += p1[r];
  { auto rr = __builtin_amdgcn_permlane32_swap(__float_as_uint(ps), __float_as_uint(ps), false, false);
    ps = __uint_as_float(rr[0]) + __uint_as_float(rr[1]); }
  l_reg = l_reg * alpha + ps;
#define PK4(P, BASE, OUT) do { unsigned a0 = cvtpk(P[BASE + 0], P[BASE + 1]), a1 = cvtpk(P[BASE + 2], P[BASE + 3]); \
    unsigned b0 = cvtpk(P[BASE + 4], P[BASE + 5]), b1 = cvtpk(P[BASE + 6], P[BASE + 7]); \
    auto r0 = __builtin_amdgcn_permlane32_swap(a0, b0, false, false); auto r1 = __builtin_amdgcn_permlane32_swap(a1, b1, false, false); \
    u32x4 w = {r0[0], r1[0], r0[1], r1[1]}; OUT = *reinterpret_cast<bf16x8*>(&w); } while (0)
  PK4(p0, 0, pa0); PK4(p0, 8, pa1); PK4(p1, 0, pa2); PK4(p1, 8, pa3);
#undef PK4
}
template <int OFF> DEVI bf16x8 lds_rd128(int a) { bf16x8 r; asm volatile("ds_read_b128 %0, %1 offset:%2" : "=&v"(r) : "v"(a), "i"(OFF) : "memory"); return r; }
template <int N> DEVI void wait_lgkm() { asm volatile("s_waitcnt lgkmcnt(%0)" :: "n"(N) : "memory"); }
template <int NQ, int QL> constexpr bool q_is_lds(int s) { return QL > 0 && s >= NQ - QL && s < NQ; }
template <int NQ, int QL, int PF> constexpr int q_after(int d) {
  int n = q_is_lds<NQ, QL>(d + 1) ? 1 : 0;
  if (q_is_lds<NQ, QL>(d)) n += (d + PF < NQ ? 2 : 0);
  else for (int i = 1; i <= PF; ++i) n += (d + i < NQ ? 2 : 0);
  return n;
}
template <int KW, int NQ, int QL, int PF, int D0>
DEVI void qkt_step(f32x16& p0, f32x16& p1, int ka, const bf16x8* qr, int qa, bf16x8 (&kf)[PF + 1][2], bf16x8 (&qf)[2]) {
  if constexpr (D0 < NQ) {
    constexpr int ROW32 = 32 * (KW * 2 + 16);
    if constexpr (D0 + PF < NQ) { kf[(D0 + PF) % (PF + 1)][0] = lds_rd128<(D0 + PF) * 32>(ka); kf[(D0 + PF) % (PF + 1)][1] = lds_rd128<ROW32 + (D0 + PF) * 32>(ka); }
    if constexpr (q_is_lds<NQ, QL>(D0 + 1)) qf[(D0 + 1) & 1] = lds_rd128<(D0 + 1 - (NQ - QL)) * 32>(qa);
    wait_lgkm<q_after<NQ, QL, PF>(D0)>(); SBAR();
    bf16x8 q;
    if constexpr (q_is_lds<NQ, QL>(D0)) q = qf[D0 & 1]; else q = qr[D0];
    p0 = __builtin_amdgcn_mfma_f32_32x32x16_bf16(kf[D0 % (PF + 1)][0], q, p0, 0, 0, 0);
    p1 = __builtin_amdgcn_mfma_f32_32x32x16_bf16(kf[D0 % (PF + 1)][1], q, p1, 0, 0, 0);
    qkt_step<KW, NQ, QL, PF, D0 + 1>(p0, p1, ka, qr, qa, kf, qf);
  }
}
template <int KW, int NQ, int QL = 0>
DEVI void qkt(f32x16& p0, f32x16& p1, const char* Ks, const bf16x8* qr, int kcol0, int r32, int hi, const char* ql = nullptr) {
  constexpr int PF = QL > 0 ? 2 : 3;
#pragma unroll
  for (int r = 0; r < 16; ++r) { p0[r] = 0.f; p1[r] = 0.f; }
  const int ka = (int)(uintptr_t)(Ks + kswz<KW>(r32, (kcol0 + hi * 8) * 2)), qa = (int)(uintptr_t)ql;
  constexpr int ROW32 = 32 * (KW * 2 + 16);
  static_assert(NQ >= PF && (QL == 0 || NQ - QL >= PF), "prologue issues steps 0..PF-1 from register-q steps");
  bf16x8 kf[PF + 1][2], qf[2];
  asm volatile("s_waitcnt lgkmcnt(0)" ::: "memory");
  kf[0][0] = lds_rd128<0>(ka); kf[0][1] = lds_rd128<ROW32>(ka);
  kf[1][0] = lds_rd128<32>(ka); kf[1][1] = lds_rd128<ROW32 + 32>(ka);
  if constexpr (PF >= 3) { kf[2][0] = lds_rd128<64>(ka); kf[2][1] = lds_rd128<ROW32 + 64>(ka); }
  qkt_step<KW, NQ, QL, PF, 0>(p0, p1, ka, qr, qa, kf, qf);
}
template <int D0> DEVI void pv_one(f32x16& od, int vb, bf16x8 pa0, bf16x8 pa1, bf16x8 pa2, bf16x8 pa3) {
  const s16x4 l0 = tr_read<v_rd_off(D0, 0, 0)>(vb), h0 = tr_read<v_rd_off(D0, 0, 1)>(vb), l1 = tr_read<v_rd_off(D0, 1, 0)>(vb), h1 = tr_read<v_rd_off(D0, 1, 1)>(vb);
  const s16x4 l2 = tr_read<v_rd_off(D0, 2, 0)>(vb), h2 = tr_read<v_rd_off(D0, 2, 1)>(vb), l3 = tr_read<v_rd_off(D0, 3, 0)>(vb), h3 = tr_read<v_rd_off(D0, 3, 1)>(vb);
  asm volatile("s_waitcnt lgkmcnt(0)" ::: "memory"); SBAR();
#define PK(L, H) (bf16x8){L[0], L[1], L[2], L[3], H[0], H[1], H[2], H[3]}
  od = __builtin_amdgcn_mfma_f32_32x32x16_bf16(pa0, PK(l0, h0), od, 0, 0, 0);
  od = __builtin_amdgcn_mfma_f32_32x32x16_bf16(pa1, PK(l1, h1), od, 0, 0, 0);
  od = __builtin_amdgcn_mfma_f32_32x32x16_bf16(pa2, PK(l2, h2), od, 0, 0, 0);
  od = __builtin_amdgcn_mfma_f32_32x32x16_bf16(pa3, PK(l3, h3), od, 0, 0, 0);
#undef PK
}
template <int D0> DEVI void v_load(int vb, s16x4 (&f)[8]) {
  f[0] = tr_read<v_rd_off(D0, 0, 0)>(vb); f[1] = tr_read<v_rd_off(D0, 0, 1)>(vb); f[2] = tr_read<v_rd_off(D0, 1, 0)>(vb); f[3] = tr_read<v_rd_off(D0, 1, 1)>(vb);
  f[4] = tr_read<v_rd_off(D0, 2, 0)>(vb); f[5] = tr_read<v_rd_off(D0, 2, 1)>(vb); f[6] = tr_read<v_rd_off(D0, 3, 0)>(vb); f[7] = tr_read<v_rd_off(D0, 3, 1)>(vb);
}
DEVI void pv_mma(f32x16& od, const s16x4 (&f)[8], bf16x8 pa0, bf16x8 pa1, bf16x8 pa2, bf16x8 pa3) {
#define PK(L, H) (bf16x8){L[0], L[1], L[2], L[3], H[0], H[1], H[2], H[3]}
  od = __builtin_amdgcn_mfma_f32_32x32x16_bf16(pa0, PK(f[0], f[1]), od, 0, 0, 0);
  od = __builtin_amdgcn_mfma_f32_32x32x16_bf16(pa1, PK(f[2], f[3]), od, 0, 0, 0);
  od = __builtin_amdgcn_mfma_f32_32x32x16_bf16(pa2, PK(f[4], f[5]), od, 0, 0, 0);
  od = __builtin_amdgcn_mfma_f32_32x32x16_bf16(pa3, PK(f[6], f[7]), od, 0, 0, 0);
#undef PK
}
DEVI void pv_d0(f32x16* o, int vb, bf16x8 pa0, bf16x8 pa1, bf16x8 pa2, bf16x8 pa3) {
  s16x4 fa[8], fb[8];
  v_load<0>(vb, fa);
  v_load<1>(vb, fb); asm volatile("s_waitcnt lgkmcnt(8)" ::: "memory"); SBAR(); pv_mma(o[0], fa, pa0, pa1, pa2, pa3); SBAR();
  v_load<2>(vb, fa); asm volatile("s_waitcnt lgkmcnt(8)" ::: "memory"); SBAR(); pv_mma(o[1], fb, pa0, pa1, pa2, pa3); SBAR();
  v_load<3>(vb, fb); asm volatile("s_waitcnt lgkmcnt(8)" ::: "memory"); SBAR(); pv_mma(o[2], fa, pa0, pa1, pa2, pa3); SBAR();
  asm volatile("s_waitcnt lgkmcnt(0)" ::: "memory"); SBAR(); pv_mma(o[3], fb, pa0, pa1, pa2, pa3);
}

template <int KW, int NQ, int SCID>
DEVI void attn_core(int wv, const bf16_t* __restrict__ Qw, const bf16_t* __restrict__ Kh, const bf16_t* __restrict__ Vh, int kcol0, int NT, char* lds,
                    f32x16 (&o)[4], float& l_out) {
  constexpr int SHM_V = 64 * 128 * 2, SHM_K = 64 * (KW * 2 + 16), KC = KW / 64;
  const int tid = tidx(wv), wid = tid >> 6, lane = tid & 63, r32 = lane & 31, hi = lane >> 5;
  char* V_lds = lds; char* K_lds = lds + 2 * SHM_V;
  float* al_l = (float*)(lds + 2 * SHM_V + 2 * SHM_K) + wid * 64 + 32;
  float m_reg = -1e30f, l_reg = 0;
#pragma unroll
  for (int d = 0; d < 4; ++d)
#pragma unroll
    for (int r = 0; r < 16; ++r) o[d][r] = 0.f;
  bf16x8 qr[NQ];
#pragma unroll
  for (int d0 = 0; d0 < NQ; ++d0) qr[d0] = *reinterpret_cast<const bf16x8*>(Qw + d0 * 16);
  const int sr = tid >> 4, sc = (tid & 15) * 8, vst0 = v_st(sr, sc), vst1 = v_st(32 + sr, sc);
  const int krow = tid >> 3, kch = tid & 7;
  const bf16_t* vg = Vh + sr * 128 + sc;
  const bf16_t* kg = Kh + krow * KW + kch * 8;
  const int vb0 = (int)(uintptr_t)V_lds + v_rd_base(lane);
  bf16x8 vs0, vs1, ks[KC];
#define SLOAD(k0) do { vs0 = *reinterpret_cast<const bf16x8*>(vg + (size_t)(k0) * 128); vs1 = *reinterpret_cast<const bf16x8*>(vg + (size_t)((k0) + 32) * 128); \
    _Pragma("unroll") for (int _c = 0; _c < KC; ++_c) ks[_c] = *reinterpret_cast<const bf16x8*>(kg + (size_t)(k0) * KW + _c * 64); } while (0)
#define SWRITE(b) do { *reinterpret_cast<bf16x8*>(V_lds + (b) * SHM_V + vst0) = vs0; *reinterpret_cast<bf16x8*>(V_lds + (b) * SHM_V + vst1) = vs1; \
    _Pragma("unroll") for (int _c = 0; _c < KC; ++_c) *reinterpret_cast<bf16x8*>(K_lds + (b) * SHM_K + kswz<KW>(krow, (kch + 8 * _c) * 16)) = ks[_c]; } while (0)
  SLOAD(0); SWRITE(0);
  if (NT > 1) SLOAD(64);
  __syncthreads();
  for (int j = 0; j < NT; ++j) {
    const int bsel = j & 1;
    f32x16 p0, p1; float mn, alpha; bf16x8 pa0, pa1, pa2, pa3;
    qkt<KW, NQ>(p0, p1, K_lds + bsel * SHM_K, qr, kcol0, r32, hi);
    partialSM<SCID>(p0, p1, m_reg, mn, alpha);
    if (__any(alpha < 1.f)) {
      if (hi == 0) al_l[r32] = alpha;
      asm volatile("s_waitcnt lgkmcnt(0)" ::: "memory");
#pragma unroll
      for (int d = 0; d < 4; ++d)
#pragma unroll
        for (int r = 0; r < 16; ++r) o[d][r] *= al_l[crow(r, hi)];
    }
    finishSM(p0, p1, alpha, l_reg, pa0, pa1, pa2, pa3);
    pv_d0(o, vb0 + bsel * SHM_V, pa0, pa1, pa2, pa3);
    if (j + 1 < NT) { SWRITE(bsel ^ 1); if (j + 2 < NT) SLOAD((j + 2) * 64); }
    __syncthreads();
  }
  l_out = l_reg;
#undef SLOAD
#undef SWRITE
}

template <int KW, int NQ, int SDEPTH, int SCID, int QL>
DEVI void attn_core_pipe(int wv, const bf16_t* __restrict__ Qw, const bf16_t* __restrict__ Kh, const bf16_t* __restrict__ Vh, int kcol0, int NT, char* lds,
                         f32x16 (&o)[4], float& l_out) {
  constexpr int SHM_V = 64 * 128 * 2, SHM_K = 64 * (KW * 2 + 16), KC = KW / 64;
  const int tid = tidx(wv), wid = tid >> 6, lane = tid & 63, r32 = lane & 31, hi = lane >> 5;
  char* V_lds = lds; char* K_lds = lds + 2 * SHM_V;
  float* al_l = (float*)(lds + 2 * SHM_V + 2 * SHM_K) + wid * 64 + 32;
  float m_reg = -1e30f, l_reg = 0;
#pragma unroll
  for (int d = 0; d < 4; ++d)
#pragma unroll
    for (int r = 0; r < 16; ++r) o[d][r] = 0.f;
  bf16x8 qr[NQ - QL + (QL ? 1 : 0)];
#pragma unroll
  for (int d0 = 0; d0 < NQ - QL; ++d0) qr[d0] = *reinterpret_cast<const bf16x8*>(Qw + d0 * 16);
  char* ql = lds + 2 * SHM_V + 2 * SHM_K + 2048 + (wid * 32 + r32) * 144 + hi * 16;
  if constexpr (QL > 0) {
#pragma unroll
    for (int d0 = NQ - QL; d0 < NQ; ++d0) *reinterpret_cast<bf16x8*>(ql + (d0 - (NQ - QL)) * 32) = *reinterpret_cast<const bf16x8*>(Qw + d0 * 16);
  }
  const int sr = tid >> 4, sc = (tid & 15) * 8, vst0 = v_st(sr, sc), vst1 = v_st(32 + sr, sc);
  const int krow = tid >> 3, kch = tid & 7;
  const bf16_t* vg = Vh + sr * 128 + sc;
  const bf16_t* kg = Kh + krow * KW + kch * 8;
  const int vb0 = (int)(uintptr_t)V_lds + v_rd_base(lane);
  struct { bf16x8 vs0, vs1, ks[KC]; } sr_[SDEPTH];
#define SLOAD(i, k0) do { sr_[i].vs0 = *reinterpret_cast<const bf16x8*>(vg + (size_t)(k0) * 128); sr_[i].vs1 = *reinterpret_cast<const bf16x8*>(vg + (size_t)((k0) + 32) * 128); \
    _Pragma("unroll") for (int _c = 0; _c < KC; ++_c) sr_[i].ks[_c] = *reinterpret_cast<const bf16x8*>(kg + (size_t)(k0) * KW + _c * 64); } while (0)
#define SWRITE(b, i) do { *reinterpret_cast<bf16x8*>(V_lds + (b) * SHM_V + vst0) = sr_[i].vs0; *reinterpret_cast<bf16x8*>(V_lds + (b) * SHM_V + vst1) = sr_[i].vs1; \
    _Pragma("unroll") for (int _c = 0; _c < KC; ++_c) *reinterpret_cast<bf16x8*>(K_lds + (b) * SHM_K + kswz<KW>(krow, (kch + 8 * _c) * 16)) = sr_[i].ks[_c]; } while (0)
#define SWAIT() do { if constexpr (SDEPTH == 2) asm volatile("s_waitcnt vmcnt(4)" ::: "memory"); else asm volatile("s_waitcnt vmcnt(0)" ::: "memory"); } while (0)
#define RESC(a) do { if (__any((a) < 1.f)) { if (hi == 0) al_l[r32] = (a); asm volatile("s_waitcnt lgkmcnt(0)" ::: "memory"); \
    _Pragma("unroll") for (int _d = 0; _d < 4; ++_d) _Pragma("unroll") for (int _r = 0; _r < 16; ++_r) o[_d][_r] *= al_l[crow(_r, hi)]; } } while (0)
  f32x16 pA0, pA1, pB0, pB1; float mnA, mnB, alA, alB; bf16x8 pa0, pa1, pa2, pa3;
  constexpr int SE = 0, SO = SDEPTH - 1;
  SLOAD(SE, 0); asm volatile("s_waitcnt vmcnt(0)" ::: "memory"); SWRITE(0, SE); __syncthreads();
  qkt<KW, NQ, QL>(pA0, pA1, K_lds, qr, kcol0, r32, hi, ql); partialSM<SCID>(pA0, pA1, m_reg, mnA, alA);
  SLOAD(SO, 64); if constexpr (SDEPTH == 2) { if (2 < NT) SLOAD(SE, 128); }
  SWAIT(); SWRITE(1, SO); __syncthreads();
  for (int j = 1; j + 1 < NT; j += 2) {
    SBAR(); qkt<KW, NQ, QL>(pB0, pB1, K_lds + SHM_K, qr, kcol0, r32, hi, ql);
    finishSM(pA0, pA1, alA, l_reg, pa0, pa1, pa2, pa3); SBAR();
    SLOAD(SO, (j + SDEPTH) * 64); SBAR();
    pv_d0(o, vb0, pa0, pa1, pa2, pa3); partialSM<SCID>(pB0, pB1, m_reg, mnB, alB);
    __syncthreads(); SWAIT(); SWRITE(0, SE);
    RESC(alB); __syncthreads();
    SBAR(); qkt<KW, NQ, QL>(pA0, pA1, K_lds, qr, kcol0, r32, hi, ql);
    finishSM(pB0, pB1, alB, l_reg, pa0, pa1, pa2, pa3); SBAR();
    if (SDEPTH == 1 || j + 3 < NT) SLOAD(SE, (j + 1 + SDEPTH) * 64);
    SBAR();
    pv_d0(o, vb0 + SHM_V, pa0, pa1, pa2, pa3); partialSM<SCID>(pA0, pA1, m_reg, mnA, alA);
    __syncthreads(); SWAIT(); SWRITE(1, SO);
    RESC(alA); __syncthreads();
  }
  SBAR(); qkt<KW, NQ, QL>(pB0, pB1, K_lds + SHM_K, qr, kcol0, r32, hi, ql);
  finishSM(pA0, pA1, alA, l_reg, pa0, pa1, pa2, pa3); SBAR();
  pv_d0(o, vb0, pa0, pa1, pa2, pa3); partialSM<SCID>(pB0, pB1, m_reg, mnB, alB);
  __syncthreads(); RESC(alB);
  finishSM(pB0, pB1, alB, l_reg, pa0, pa1, pa2, pa3); SBAR();
  pv_d0(o, vb0 + SHM_V, pa0, pa1, pa2, pa3);
  __syncthreads();
  l_out = l_reg;
#undef SLOAD
#undef SWRITE
#undef SWAIT
#undef RESC
}

template <int KW, int NQ, int SCID, int QL>
DEVI void attn_core_dma(int wv, const bf16_t* __restrict__ Qw, const bf16_t* __restrict__ Kh, const bf16_t* __restrict__ Vh, int kcol0, int NT, char* lds,
                        f32x16 (&o)[4], float& l_out) {
  constexpr int SHM_V = 64 * 128 * 2, KCH = KW / 8 + 1, SHM_K = 64 * KCH * 16, KR = (64 * KCH) / 512;
  static_assert(64 * KCH - KR * 512 == 64, "remainder must be one wave");
  const int tid = tidx(wv), wid = tid >> 6, lane = tid & 63, r32 = lane & 31, hi = lane >> 5;
  char* V_lds = lds; char* K_lds = lds + 2 * SHM_V;
  float* al_l = (float*)(lds + 2 * SHM_V + 2 * SHM_K) + wid * 64 + 32;
  float m_reg = -1e30f, l_reg = 0;
#pragma unroll
  for (int d = 0; d < 4; ++d)
#pragma unroll
    for (int r = 0; r < 16; ++r) o[d][r] = 0.f;
  bf16x8 qr[NQ - QL + (QL ? 1 : 0)];
#pragma unroll
  for (int d0 = 0; d0 < NQ - QL; ++d0) qr[d0] = *reinterpret_cast<const bf16x8*>(Qw + d0 * 16);
  char* ql = lds + 2 * SHM_V + 2 * SHM_K + 2048 + (wid * 32 + r32) * 144 + hi * 16;
  if constexpr (QL > 0) {
#pragma unroll
    for (int d0 = NQ - QL; d0 < NQ; ++d0) *reinterpret_cast<bf16x8*>(ql + (d0 - (NQ - QL)) * 32) = *reinterpret_cast<const bf16x8*>(Qw + d0 * 16);
  }
  const int sr = tid >> 4, sc = (tid & 15) * 8, vst0 = v_st(sr, sc), vst1 = v_st(32 + sr, sc);
  const bf16_t* vg = Vh + sr * 128 + sc;
  const int vb0 = (int)(uintptr_t)V_lds + v_rd_base(lane);
  unsigned koff[KR + 1];
#pragma unroll
  for (int i = 0; i <= KR; ++i) { const int c = tid + 512 * i; const int row = c / KCH; int ch = c - row * KCH; ch = ch == KCH - 1 ? KCH - 2 : ch; koff[i] = (unsigned)(row * KW + ch * 8) * 2u; }
  const unsigned kldsw = (unsigned)__builtin_amdgcn_readfirstlane(wid) * 1024u;
  bf16x8 vs0, vs1;
#define KDMA(k0, b) do { const char* _g = (const char*)(Kh + (size_t)(k0) * KW); PG8_LAS unsigned char* _l = (PG8_LAS unsigned char*)(K_lds + (b) * SHM_K) + kldsw; \
    _Pragma("unroll") for (int _i = 0; _i < KR; ++_i) __builtin_amdgcn_global_load_lds((const unsigned*)(_g + koff[_i]), (PG8_LAS unsigned*)(_l + _i * 8192), 16, 0, 0); \
    if (wid == 0) __builtin_amdgcn_global_load_lds((const unsigned*)(_g + koff[KR]), (PG8_LAS unsigned*)(_l + KR * 8192), 16, 0, 0); } while (0)
#define VLOAD(k0) do { vs0 = *reinterpret_cast<const bf16x8*>(vg + (size_t)(k0) * 128); vs1 = *reinterpret_cast<const bf16x8*>(vg + (size_t)((k0) + 32) * 128); } while (0)
#define VWRITE(b) do { *reinterpret_cast<bf16x8*>(V_lds + (b) * SHM_V + vst0) = vs0; *reinterpret_cast<bf16x8*>(V_lds + (b) * SHM_V + vst1) = vs1; } while (0)
#define VMW() asm volatile("s_waitcnt vmcnt(0)" ::: "memory")
#define RESC(a) do { if (__any((a) < 1.f)) { if (hi == 0) al_l[r32] = (a); asm volatile("s_waitcnt lgkmcnt(0)" ::: "memory"); \
    _Pragma("unroll") for (int _d = 0; _d < 4; ++_d) _Pragma("unroll") for (int _r = 0; _r < 16; ++_r) o[_d][_r] *= al_l[crow(_r, hi)]; } } while (0)
  f32x16 pA0, pA1, pB0, pB1; float mnA, mnB, alA, alB; bf16x8 pa0, pa1, pa2, pa3;
  KDMA(0, 0); VLOAD(0); VMW(); VWRITE(0); __syncthreads();
  KDMA(64, 1); VLOAD(64);
  qkt<KW, NQ, QL>(pA0, pA1, K_lds, qr, kcol0, r32, hi, ql); partialSM<SCID>(pA0, pA1, m_reg, mnA, alA);
  VMW(); __syncthreads(); VWRITE(1); __syncthreads();
  for (int j = 1; j + 1 < NT; j += 2) {
    SBAR(); KDMA((j + 1) * 64, 0); VLOAD((j + 1) * 64); SBAR();
    qkt<KW, NQ, QL>(pB0, pB1, K_lds + SHM_K, qr, kcol0, r32, hi, ql);
    finishSM(pA0, pA1, alA, l_reg, pa0, pa1, pa2, pa3); SBAR();
    pv_d0(o, vb0, pa0, pa1, pa2, pa3); partialSM<SCID>(pB0, pB1, m_reg, mnB, alB);
    VMW(); __syncthreads(); VWRITE(0);
    RESC(alB); __syncthreads();
    SBAR(); KDMA((j + 2) * 64, 1); VLOAD((j + 2) * 64); SBAR();
    qkt<KW, NQ, QL>(pA0, pA1, K_lds, qr, kcol0, r32, hi, ql);
    finishSM(pB0, pB1, alB, l_reg, pa0, pa1, pa2, pa3); SBAR();
    pv_d0(o, vb0 + SHM_V, pa0, pa1, pa2, pa3); partialSM<SCID>(pA0, pA1, m_reg, mnA, alA);
    VMW(); __syncthreads(); VWRITE(1);
    RESC(alA); __syncthreads();
  }
  SBAR(); qkt<KW, NQ, QL>(pB0, pB1, K_lds + SHM_K, qr, kcol0, r32, hi, ql);
  finishSM(pA0, pA1, alA, l_reg, pa0, pa1, pa2, pa3); SBAR();
  pv_d0(o, vb0, pa0, pa1, pa2, pa3); partialSM<SCID>(pB0, pB1, m_reg, mnB, alB);
  RESC(alB);
  finishSM(pB0, pB1, alB, l_reg, pa0, pa1, pa2, pa3); SBAR();
  pv_d0(o, vb0 + SHM_V, pa0, pa1, pa2, pa3);
  __syncthreads();
  l_out = l_reg;
#undef KDMA
#undef VLOAD
#undef VWRITE
#undef VMW
#undef RESC
}

template <int KW, int NQ, int SCID, int QL>
DEVI void attn_core_pp(int wv, const bf16_t* __restrict__ Qw, const bf16_t* __restrict__ Kh, const bf16_t* __restrict__ Vh, int kcol0, int NT, char* lds,
                       f32x16 (&o)[4], float& l_out) {
  constexpr int SHM_V = 64 * 128 * 2, KCH = KW / 8 + 1, SHM_K = 64 * KCH * 16, KR = (64 * KCH) / 512;
  static_assert(64 * KCH - KR * 512 == 64, "remainder must be one wave");
  const int tid = tidx(wv), wid = tid >> 6, lane = tid & 63, r32 = lane & 31, hi = lane >> 5;
  const int g = __builtin_amdgcn_readfirstlane(wid >> 2);
  char* V_lds = lds; char* K_lds = lds + 2 * SHM_V;
  float* al_l = (float*)(lds + 2 * SHM_V + 2 * SHM_K) + wid * 64 + 32;
  float m_reg = -1e30f, l_reg = 0;
#pragma unroll
  for (int d = 0; d < 4; ++d)
#pragma unroll
    for (int r = 0; r < 16; ++r) o[d][r] = 0.f;
  bf16x8 qr[NQ - QL + (QL ? 1 : 0)];
#pragma unroll
  for (int d0 = 0; d0 < NQ - QL; ++d0) qr[d0] = *reinterpret_cast<const bf16x8*>(Qw + d0 * 16);
  char* ql = lds + 2 * SHM_V + 2 * SHM_K + 2048 + (wid * 32 + r32) * 144 + hi * 16;
  if constexpr (QL > 0) {
#pragma unroll
    for (int d0 = NQ - QL; d0 < NQ; ++d0) *reinterpret_cast<bf16x8*>(ql + (d0 - (NQ - QL)) * 32) = *reinterpret_cast<const bf16x8*>(Qw + d0 * 16);
  }
  const int vb0 = (int)(uintptr_t)V_lds + v_rd_base(lane);
  unsigned koff[KR + 1], voff[2];
#pragma unroll
  for (int i = 0; i <= KR; ++i) { const int c = tid + 512 * i; const int row = c / KCH; int ch = c - row * KCH; ch = ch == KCH - 1 ? KCH - 2 : ch; koff[i] = (unsigned)(row * KW + ch * 8) * 2u; }
#pragma unroll
  for (int i = 0; i < 2; ++i) { const int q = tid + 512 * i; const int st = q >> 5, kk = (st >> 2) * 8 + ((q >> 2) & 7), c = (st & 3) * 32 + (q & 3) * 8;
    const int k = (kk & ~0xC) | ((kk & 4) << 1) | ((kk & 8) >> 1); voff[i] = (unsigned)(k * 128 + c) * 2u; }
  const unsigned ldsw = (unsigned)__builtin_amdgcn_readfirstlane(wid) * 1024u;
#define KDMA(k0, b) do { const char* _g = (const char*)(Kh + (size_t)(k0) * KW); PG8_LAS unsigned char* _l = (PG8_LAS unsigned char*)(K_lds + (b) * SHM_K) + ldsw; \
    _Pragma("unroll") for (int _i = 0; _i < KR; ++_i) __builtin_amdgcn_global_load_lds((const unsigned*)(_g + koff[_i]), (PG8_LAS unsigned*)(_l + _i * 8192), 16, 0, 0); \
    if (wid == 0) __builtin_amdgcn_global_load_lds((const unsigned*)(_g + koff[KR]), (PG8_LAS unsigned*)(_l + KR * 8192), 16, 0, 0); } while (0)
#define VDMA(k0, b) do { const char* _g = (const char*)(Vh + (size_t)(k0) * 128); PG8_LAS unsigned char* _l = (PG8_LAS unsigned char*)(V_lds + (b) * SHM_V) + ldsw; \
    _Pragma("unroll") for (int _i = 0; _i < 2; ++_i) __builtin_amdgcn_global_load_lds((const unsigned*)(_g + voff[_i]), (PG8_LAS unsigned*)(_l + _i * 8192), 16, 0, 0); } while (0)
#define VMW() asm volatile("s_waitcnt vmcnt(0)" ::: "memory")
#define PBAR() do { asm volatile("" ::: "memory"); __builtin_amdgcn_s_barrier(); asm volatile("" ::: "memory"); } while (0)
#define RESC(a) do { if (__any((a) < 1.f)) { if (hi == 0) al_l[r32] = (a); asm volatile("s_waitcnt lgkmcnt(0)" ::: "memory"); \
    _Pragma("unroll") for (int _d = 0; _d < 4; ++_d) _Pragma("unroll") for (int _r = 0; _r < 16; ++_r) o[_d][_r] *= al_l[crow(_r, hi)]; } } while (0)
  f32x16 pA0, pA1, pB0, pB1; float mn, al; bf16x8 pa0, pa1, pa2, pa3;
  KDMA(0, 0); KDMA(64, 1); VMW(); __syncthreads();
  qkt<KW, NQ, QL>(pA0, pA1, K_lds, qr, kcol0, r32, hi, ql);
  PBAR();
  if (g == 1) PBAR();
  for (int j = 0; j < NT; j += 2) {
    SBAR(); if (j + 2 < NT) KDMA((j + 2) * 64, 0); VDMA(j * 64, 0); SBAR();
    qkt<KW, NQ, QL>(pB0, pB1, K_lds + SHM_K, qr, kcol0, r32, hi, ql);
    if (j > 0) pv_d0(o, vb0 + SHM_V, pa0, pa1, pa2, pa3);
    if (g == 1) VMW();
    PBAR(); SBAR();
    partialSM<SCID>(pA0, pA1, m_reg, mn, al); RESC(al); finishSM(pA0, pA1, al, l_reg, pa0, pa1, pa2, pa3);
    if (g == 0) VMW();
    PBAR(); SBAR();
    if (j + 3 < NT) KDMA((j + 3) * 64, 1);
    VDMA((j + 1) * 64, 1); SBAR();
    if (j + 2 < NT) qkt<KW, NQ, QL>(pA0, pA1, K_lds, qr, kcol0, r32, hi, ql);
    pv_d0(o, vb0, pa0, pa1, pa2, pa3);
    if (g == 1) VMW();
    PBAR(); SBAR();
    partialSM<SCID>(pB0, pB1, m_reg, mn, al); RESC(al); finishSM(pB0, pB1, al, l_reg, pa0, pa1, pa2, pa3);
    if (g == 0) VMW();
    PBAR(); SBAR();
  }
  pv_d0(o, vb0 + SHM_V, pa0, pa1, pa2, pa3);
  if (g == 0) PBAR();
  __syncthreads();
  l_out = l_reg;
#undef KDMA
#undef VDMA
#undef VMW
#undef PBAR
#undef RESC
}

DEVI void gated_rows_out(const char* stg, int lane, const bf16_t* __restrict__ gate, int gld, bf16_t* __restrict__ out, int old) {
#pragma unroll
  for (int i = 0; i < 8; ++i) {
    const int c = lane + 64 * i, row = c >> 4, ch = c & 15;
    const u32x4 sv = *reinterpret_cast<const u32x4*>(stg + row * 272 + ch * 16);
    const u32x4 gv = *reinterpret_cast<const u32x4*>(gate + (size_t)row * gld + ch * 8);
    u32x4 ov;
#pragma unroll
    for (int e = 0; e < 4; ++e) ov[e] = cvtpk(bflo(sv[e]) * bflo(gv[e]), bfhi(sv[e]) * bfhi(gv[e]));
    *reinterpret_cast<u32x4*>(out + (size_t)row * old + ch * 8) = ov;
  }
}

DEVI void attn0_item(int wv, const Params& p, int token0, int b, int h, int nkeys, char* lds) {
  const int tid = tidx(wv), wid = tid >> 6, lane = tid & 63, r32 = lane & 31, hi = lane >> 5, m = wid >> 2, wl = wid & 3;
  const bf16_t* Q0 = (const bf16_t*)(p.ws + OFF_Q0); const bf16_t* K0 = (const bf16_t*)(p.ws + OFF_K0); const bf16_t* V0 = (const bf16_t*)(p.ws + OFF_V0);
  const bf16_t* ZB = (const bf16_t*)(p.ws + OFF_ZB); bf16_t* MIX = (bf16_t*)(p.ws + OFF_MIX);
  const bf16_t* Qw = Q0 + (size_t)(token0 + wl * 32 + r32) * 512 + h * 128 + m * 64 + hi * 8;
  const size_t kvo = (size_t)(b * 4 + h) * KVL * 128;
  f32x16 o[4]; float l;
  attn_core_pp<128, 4, 0, 0>(wv, Qw, K0 + kvo, V0 + kvo, m * 64, nkeys >> 6, lds, o, l);
  float* li_l = (float*)(lds + 32768 + 2 * 64 * 272) + wid * 64;
  if (hi == 0) li_l[r32] = l;
  asm volatile("s_waitcnt lgkmcnt(0)" ::: "memory");
  float rli[16];
#pragma unroll
  for (int r = 0; r < 16; ++r) rli[r] = __builtin_amdgcn_rcpf(li_l[crow(r, hi)]);
  float t1 = p.b_lq1[lane] * p.b_lk1[lane], t2 = p.b_lq2[lane] * p.b_lk2[lane];
  t1 = wave_sum(t1); t2 = wave_sum(t2);
  const float lam = __expf(t1) - __expf(t2) + 0.2f;
  __syncthreads();
  float* xch = (float*)lds;
  if (m == 1) {
#pragma unroll
    for (int r = 0; r < 16; ++r)
#pragma unroll
      for (int d0 = 0; d0 < 4; ++d0) xch[(wl * 32 + crow(r, hi)) * 128 + d0 * 32 + r32] = o[d0][r] * rli[r];
  }
  __syncthreads();
  if (m == 0) {
    char* stg = lds + 69632 + wl * 8704;
    float sw4[4];
#pragma unroll
    for (int d0 = 0; d0 < 4; ++d0) sw4[d0] = p.b_subln_w[d0 * 32 + r32];
#pragma unroll
    for (int r = 0; r < 16; ++r) {
      const int row = wl * 32 + crow(r, hi); const int token = token0 + row;
      float a[4], ss = 0.f;
#pragma unroll
      for (int d0 = 0; d0 < 4; ++d0) { a[d0] = o[d0][r] * rli[r] - lam * xch[row * 128 + d0 * 32 + r32]; ss += a[d0] * a[d0]; }
      ss = xsum<1>(ss); ss = xsum<2>(ss); ss = xsum<4>(ss); ss = xsum<8>(ss); ss = xsum<16>(ss);
      const float rstd = rsqrtf(ss * (1.f / 128.f) + 1e-5f) * 0.8f;
#pragma unroll
      for (int d0 = 0; d0 < 4; ++d0) *reinterpret_cast<bf16_t*>(stg + crow(r, hi) * 272 + (d0 * 32 + r32) * 2) = f2bf(a[d0] * rstd * sw4[d0]);
    }
    asm volatile("s_waitcnt lgkmcnt(0)" ::: "memory");
    const size_t t0 = (size_t)(token0 + wl * 32);
    gated_rows_out(stg, lane, ZB + t0 * 512 + h * 128, 512, MIX + t0 * 1024 + 512 + h * 128, 1024);
  }
  __syncthreads();
}

DEVI void attn1_item(int wv, const Params& p, int b, int h, int qb, char* lds) {
  const int tid = tidx(wv), wid = tid >> 6, lane = tid & 63, r32 = lane & 31, hi = lane >> 5;
  const bf16_t* Q1 = (const bf16_t*)(p.ws + OFF_Q1); const bf16_t* K1 = (const bf16_t*)(p.ws + OFF_K1); const bf16_t* V1 = (const bf16_t*)(p.ws + OFF_V1);
  const bf16_t* Z1 = (const bf16_t*)(p.ws + OFF_Z1); bf16_t* MIX = (bf16_t*)(p.ws + OFF_MIX);
  const int token0 = b * 2048 + qb * 256;
  const bf16_t* Qw = Q1 + (size_t)(token0 + wid * 32 + r32) * 1536 + h * 192 + hi * 8;
  f32x16 o[4]; float l;
  attn_core_pp<192, 12, 1, 4>(wv, Qw, K1 + (size_t)(b * 8 + h) * KVL * 192, V1 + (size_t)(b * 8 + h) * KVL * 128, 0, KVL / 64, lds, o, l);
  float* li_l = (float*)(lds + 32768 + 2 * 64 * 400) + wid * 64;
  if (hi == 0) li_l[r32] = l;
  asm volatile("s_waitcnt lgkmcnt(0)" ::: "memory");
  char* stg = lds + wid * 8704;
#pragma unroll
  for (int r = 0; r < 16; ++r) {
    const int cr = crow(r, hi); const float rl = __builtin_amdgcn_rcpf(li_l[cr]);
#pragma unroll
    for (int d0 = 0; d0 < 4; ++d0) *reinterpret_cast<bf16_t*>(stg + cr * 272 + (d0 * 32 + r32) * 2) = f2bf(o[d0][r] * rl);
  }
  asm volatile("s_waitcnt lgkmcnt(0)" ::: "memory");
  const size_t t0 = (size_t)(token0 + wid * 32);
  gated_rows_out(stg, lane, Z1 + t0 * 1024 + h * 128, 1024, MIX + t0 * 1024 + h * 128, 1024);
  __syncthreads();
}

DEVI void abranch_item(int wv, const Params& p, int ci, char* lds) {
  const int tid = tidx(wv), wid = tid >> 6, lane = tid & 63, r32 = lane & 31, hi = lane >> 5;
  const bf16_t* GV = (const bf16_t*)(p.ws + OFF_GV); const bf16_t* U = (const bf16_t*)(p.ws + OFF_U); const bf16_t* ZA = (const bf16_t*)(p.ws + OFF_ZA);
  const bf16_t* WSB = (const bf16_t*)(p.ws + OFF_WSB); bf16_t* MIX = (bf16_t*)(p.ws + OFF_MIX);
  const int t0 = ci * 128;
  bf16_t* vnT = (bf16_t*)lds;
  {
    const int pos = tid >> 2, cp = tid & 3;
    const bf16_t* g = GV + (size_t)(t0 + pos) * 512;
    float s = 0.f, q = 0.f;
#pragma unroll 4
    for (int i = 0; i < 16; ++i) {
      const bf16x8 raw = *reinterpret_cast<const bf16x8*>(g + (i * 4 + cp) * 8);
#pragma unroll
      for (int e = 0; e < 8; ++e) { const float xv = bf2f((bf16_t)raw[e]); s += xv; q += xv * xv; }
    }
    s = xsum<1>(s); s = xsum<2>(s); q = xsum<1>(q); q = xsum<2>(q);
    const float mu = s * (1.f / 512.f);
    const float rstd = rsqrtf(fmaxf(q * (1.f / 512.f) - mu * mu, 0.f) + 1e-5f);
#pragma unroll 2
    for (int i = 0; i < 16; ++i) {
      const int c0 = (i * 4 + cp) * 8;
      const bf16x8 raw = *reinterpret_cast<const bf16x8*>(g + c0);
      const f32x4 w0 = *reinterpret_cast<const f32x4*>(p.a_ln_w + c0), w1 = *reinterpret_cast<const f32x4*>(p.a_ln_w + c0 + 4);
      const f32x4 b0 = *reinterpret_cast<const f32x4*>(p.a_ln_b + c0), b1 = *reinterpret_cast<const f32x4*>(p.a_ln_b + c0 + 4);
#pragma unroll
      for (int e = 0; e < 8; ++e) {
        const float wv = e < 4 ? w0[e & 3] : w1[e & 3], bv = e < 4 ? b0[e & 3] : b1[e & 3];
        vnT[(c0 + e) * 136 + pos] = f2bf((bf2f((bf16_t)raw[e]) - mu) * rstd * wv + bv);
      }
    }
  }
  __syncthreads();
  const int g8 = wid;
  const bf16_t* Wg = WSB + g8 * 128 * 128;
  f32x16 acc[4][2];
#pragma unroll
  for (int pb = 0; pb < 4; ++pb) {
#pragma unroll
    for (int r = 0; r < 16; ++r) { acc[pb][0][r] = 0.f; acc[pb][1][r] = 0.f; }
#pragma unroll
    for (int ks = 0; ks < 8; ++ks) {
      const bf16x8 bw = *reinterpret_cast<const bf16x8*>(Wg + (pb * 32 + r32) * 128 + ks * 16 + hi * 8);
#pragma unroll
      for (int db = 0; db < 2; ++db) {
        const bf16x8 a = *reinterpret_cast<const bf16x8*>(vnT + (g8 * 64 + db * 32 + r32) * 136 + ks * 16 + hi * 8);
        acc[pb][db] = __builtin_amdgcn_mfma_f32_32x32x16_bf16(a, bw, acc[pb][db], 0, 0, 0);
      }
    }
  }
  asm volatile("s_waitcnt lgkmcnt(0)" ::: "memory");
  char* stg = (char*)vnT + (size_t)g8 * 64 * 272;
#pragma unroll
  for (int pb = 0; pb < 4; ++pb) {
    const float bias = p.a_bs[g8 * 128 + pb * 32 + r32];
#pragma unroll
    for (int db = 0; db < 2; ++db)
#pragma unroll
      for (int rg = 0; rg < 4; ++rg) {
        u32x2 pk = {cvtpk(acc[pb][db][rg * 4 + 0] + bias, acc[pb][db][rg * 4 + 1] + bias), cvtpk(acc[pb][db][rg * 4 + 2] + bias, acc[pb][db][rg * 4 + 3] + bias)};
        *reinterpret_cast<u32x2*>(stg + (pb * 32 + r32) * 136 + (db * 32 + rg * 8 + hi * 4) * 2) = pk;
      }
  }
  asm volatile("s_waitcnt lgkmcnt(0)" ::: "memory");
#pragma unroll 4
  for (int i = 0; i < 16; ++i) {
    const int c = lane + 64 * i, row = c >> 3, ch = c & 7;
    const u32x2 s0 = *reinterpret_cast<const u32x2*>(stg + row * 136 + ch * 16), s1 = *reinterpret_cast<const u32x2*>(stg + row * 136 + ch * 16 + 8);
    const size_t gi = (size_t)(t0 + row) * 512 + g8 * 64 + ch * 8;
    const u32x4 uv = *reinterpret_cast<const u32x4*>(U + gi), zv = *reinterpret_cast<const u32x4*>(ZA + gi);
    const unsigned sv[4] = {s0[0], s0[1], s1[0], s1[1]};
    u32x4 ov;
#pragma unroll
    for (int e = 0; e < 4; ++e) ov[e] = cvtpk(bflo(uv[e]) * bflo(sv[e]) * bflo(zv[e]), bfhi(uv[e]) * bfhi(sv[e]) * bfhi(zv[e]));
    *reinterpret_cast<u32x4*>(MIX + (size_t)(t0 + row) * 1024 + g8 * 64 + ch * 8) = ov;
  }
  __syncthreads();
}

DEVI void tr_tile(int wv, const float* __restrict__ src, bf16_t* __restrict__ dst, int K, int N, int tilesN4, const float* __restrict__ scale, int t, char* lds) {
  const int tid = tidx(wv);
  const int k0 = (t / tilesN4) * 64, n0 = (t % tilesN4) * 256;
  const int kr = tid >> 3, ng = (tid & 7) * 8;
  f32x4 v0[4], v1[4];
#pragma unroll
  for (int u = 0; u < 4; ++u) {
    v0[u] = (f32x4){0.f, 0.f, 0.f, 0.f}; v1[u] = v0[u];
    if (n0 + u * 64 + ng < N) { const float* s = src + (size_t)(k0 + kr) * N + n0 + u * 64 + ng; v0[u] = *reinterpret_cast<const f32x4*>(s); v1[u] = *reinterpret_cast<const f32x4*>(s + 4); }
  }
  const float scv = scale ? scale[k0 + kr] : 1.f;
  bf16_t* tl = (bf16_t*)lds;
#pragma unroll
  for (int u = 0; u < 4; ++u)
#pragma unroll
    for (int e = 0; e < 4; ++e) { tl[u * 4608 + (ng + e) * 72 + kr] = f2bf(v0[u][e] * scv); tl[u * 4608 + (ng + 4 + e) * 72 + kr] = f2bf(v1[u][e] * scv); }
  __syncthreads();
  const int n = tid >> 3, kc = (tid & 7) * 8;
#pragma unroll
  for (int u = 0; u < 4; ++u)
    *reinterpret_cast<bf16x8*>(dst + (size_t)(n0 + u * 64 + n) * K + k0 + kc) = *reinterpret_cast<const bf16x8*>(tl + u * 4608 + n * 72 + kc);
}

DEVI void phase0(int wv, const Params& p, char* lds) {
  const int tid = tidx(wv);
  constexpr int N_ADA = 192, N_TR = 488, N_WS = 16;
  for (int it = blockIdx.x; it < N_ADA + N_TR + N_WS + 1; it += gridDim.x) {
    if (it < N_ADA) {
      const int li = it / 96, chunk = it % 96;
      float* sc = (float*)lds;
      for (int idx = tid; idx < 17 * 1024; idx += 512) { const int r = idx >> 10, k = idx & 1023; const float xv = r < 16 ? p.c[r * 1024 + k] : p.c_ctx[k]; sc[idx] = xv / (1.f + expf(-xv)); }
      __syncthreads();
      const int col = tid & 31, kp = tid >> 5;
      const float* w = p.ada_w + (size_t)li * 1024 * 3072 + chunk * 32 + col;
      float acc[17];
#pragma unroll
      for (int r = 0; r < 17; ++r) acc[r] = 0.f;
#pragma unroll 8
      for (int k = kp * 64; k < kp * 64 + 64; ++k) {
        const float wv = w[(size_t)k * 3072];
#pragma unroll
        for (int r = 0; r < 17; ++r) acc[r] += sc[r * 1024 + k] * wv;
      }
      float* red = (float*)(lds + 17 * 1024 * 4);
#pragma unroll
      for (int r = 0; r < 17; ++r) red[(kp * 17 + r) * 32 + col] = acc[r];
      __syncthreads();
      float* ada = (float*)(p.ws + OFF_ADA);
      for (int idx = tid; idx < 544; idx += 512) {
        const int r = idx >> 5, cc = idx & 31; float s = 0.f;
        for (int k2 = 0; k2 < 16; ++k2) s += red[(k2 * 17 + r) * 32 + cc];
        ada[(size_t)(li * 17 + r) * 3072 + chunk * 32 + cc] = s + p.ada_b[li * 3072 + chunk * 32 + cc];
      }
    } else if (it < N_ADA + N_TR) {
      int t = it - N_ADA;
      if (t < 224) tr_tile(wv, p.even_w_in, (bf16_t*)(p.ws + OFF_W0IN), 1024, 3584, 14, nullptr, t, lds);
      else if (t < 288) tr_tile(wv, p.even_w_out, (bf16_t*)(p.ws + OFF_W0OUT), 1024, 1024, 4, nullptr, t - 224, lds);
      else if (t < 384) tr_tile(wv, p.odd_w_in, (bf16_t*)(p.ws + OFF_W1IN), 1024, 1472, 6, nullptr, t - 288, lds);
      else if (t < 408) tr_tile(wv, p.c_wq_b, (bf16_t*)(p.ws + OFF_WQ), 256, 1536, 6, p.c_q_norm_w, t - 384, lds);
      else if (t < 424) tr_tile(wv, p.c_wkv_b, (bf16_t*)(p.ws + OFF_WKV), 128, 2048, 8, p.c_kv_norm_w, t - 408, lds);
      else tr_tile(wv, p.odd_w_out, (bf16_t*)(p.ws + OFF_W1OUT), 1024, 1024, 4, nullptr, t - 424, lds);
    } else if (it < N_ADA + N_TR + N_WS) {
      const int base = (it - N_ADA - N_TR) * 8192 + tid * 16;
      bf16_t* dst = (bf16_t*)(p.ws + OFF_WSB) + base; const float* s = p.a_ws + base;
#pragma unroll
      for (int q = 0; q < 2; ++q) {
        const f32x4 a = *reinterpret_cast<const f32x4*>(s + q * 8), b = *reinterpret_cast<const f32x4*>(s + q * 8 + 4);
        u32x4 w = {cvtpk(a[0], a[1]), cvtpk(a[2], a[3]), cvtpk(b[0], b[1]), cvtpk(b[2], b[3])};
        *reinterpret_cast<u32x4*>(dst + q * 8) = w;
      }
    } else {
      float2* tab = (float2*)(p.ws + OFF_ROPE);
      for (int e = tid; e < 1024; e += 512) {
        const int pos = e >> 4, j = e & 15;
        const float inv = exp2f(-(float)j * (13.287712379549449f / 16.f));
        const float ang = (float)pos * inv;
        const float nrev = rintf(ang * 0.15915494309189535f);
        float rr = fmaf(-nrev, 6.2831855f, ang); rr = fmaf(-nrev, -1.7484555e-7f, rr);
        tab[e] = make_float2(__cosf(rr), __sinf(rr));
      }
    }
    __syncthreads();
  }
}

template <bool RES>
DEVI void norm_mod(int wv, const float* src_lat, const float* src_ctx, const float* __restrict__ nw, const float* __restrict__ ada, bf16_t* X,
                   int row_lo, int row_hi, int vb, int nvb, const float* __restrict__ ada_prev = nullptr, float* hdst_lat = nullptr, float* hdst_ctx = nullptr) {
  const int tid_ = tidx(wv); const int wid = tid_ >> 6, lane = tid_ & 63;
  for (int row0 = row_lo + (vb * 8 + wid) * 2; row0 < row_hi; row0 += nvb * 16) {
    f32x4 v[2][4]; u32x2 ov[2][4]; float ss[2];
#pragma unroll
    for (int q = 0; q < 2; ++q) {
      const int row = row0 + q;
      const float* src = row < NLAT ? src_lat + (size_t)row * 1024 : src_ctx + (size_t)(row - NLAT) * 1024;
      ss[q] = 0.f;
#pragma unroll
      for (int i = 0; i < 4; ++i) {
        v[q][i] = __builtin_nontemporal_load(reinterpret_cast<const f32x4*>(src + i * 256 + lane * 4));
        if constexpr (RES) ov[q][i] = *reinterpret_cast<const u32x2*>(X + (size_t)row * 1024 + i * 256 + lane * 4);
      }
    }
    if constexpr (RES) {
#pragma unroll
      for (int q = 0; q < 2; ++q) {
        const int row = row0 + q;
        const float* gp = ada_prev + (row < NLAT ? (row >> 11) : 16) * 3072 + 2048;
        float* hd = row < NLAT ? hdst_lat + (size_t)row * 1024 : hdst_ctx + (size_t)(row - NLAT) * 1024;
#pragma unroll
        for (int i = 0; i < 4; ++i) {
          const int c = i * 256 + lane * 4;
          const f32x4 g = *reinterpret_cast<const f32x4*>(gp + c);
          v[q][i][0] += g[0] * bflo(ov[q][i][0]); v[q][i][1] += g[1] * bfhi(ov[q][i][0]); v[q][i][2] += g[2] * bflo(ov[q][i][1]); v[q][i][3] += g[3] * bfhi(ov[q][i][1]);
          __builtin_nontemporal_store(v[q][i], reinterpret_cast<f32x4*>(hd + c));
        }
      }
    }
#pragma unroll
    for (int q = 0; q < 2; ++q) {
#pragma unroll
      for (int i = 0; i < 4; ++i) ss[q] += v[q][i][0] * v[q][i][0] + v[q][i][1] * v[q][i][1] + v[q][i][2] * v[q][i][2] + v[q][i][3] * v[q][i][3];
      ss[q] = wave_sum(ss[q]);
    }
#pragma unroll
    for (int q = 0; q < 2; ++q) {
      const int row = row0 + q;
      const float* ad = ada + (row < NLAT ? (row >> 11) : 16) * 3072;
      const float r = rsqrtf(ss[q] * (1.f / 1024.f) + 1e-6f);
#pragma unroll
      for (int i = 0; i < 4; ++i) {
        const int c = i * 256 + lane * 4;
        const f32x4 w = *reinterpret_cast<const f32x4*>(nw + c), sh = *reinterpret_cast<const f32x4*>(ad + c), scl = *reinterpret_cast<const f32x4*>(ad + 1024 + c);
        float o[4];
#pragma unroll
        for (int e = 0; e < 4; ++e) o[e] = v[q][i][e] * r * w[e] * (1.f + scl[e]) + sh[e];
        u32x2 pk = {cvtpk(o[0], o[1]), cvtpk(o[2], o[3])};
        *reinterpret_cast<u32x2*>(X + (size_t)row * 1024 + c) = pk;
      }
    }
  }
}

DEVI void final_norm(int wv, float* out, const float* __restrict__ fw, const bf16_t* __restrict__ O1, const float* __restrict__ ada1) {
  const int tid_ = tidx(wv); const int wid = tid_ >> 6, lane = tid_ & 63;
  for (int row0 = (blockIdx.x * 8 + wid) * 2; row0 < NLAT; row0 += gridDim.x * 16) {
    f32x4 v[2][4]; u32x2 ov[2][4]; float ss[2];
#pragma unroll
    for (int q = 0; q < 2; ++q) {
      ss[q] = 0.f;
#pragma unroll
      for (int i = 0; i < 4; ++i) {
        v[q][i] = __builtin_nontemporal_load(reinterpret_cast<const f32x4*>(out + (size_t)(row0 + q) * 1024 + i * 256 + lane * 4));
        ov[q][i] = *reinterpret_cast<const u32x2*>(O1 + (size_t)(row0 + q) * 1024 + i * 256 + lane * 4);
      }
    }
#pragma unroll
    for (int q = 0; q < 2; ++q) {
      const float* gp = ada1 + ((row0 + q) >> 11) * 3072 + 2048;
#pragma unroll
      for (int i = 0; i < 4; ++i) {
        const f32x4 g = *reinterpret_cast<const f32x4*>(gp + i * 256 + lane * 4);
        v[q][i][0] += g[0] * bflo(ov[q][i][0]); v[q][i][1] += g[1] * bfhi(ov[q][i][0]); v[q][i][2] += g[2] * bflo(ov[q][i][1]); v[q][i][3] += g[3] * bfhi(ov[q][i][1]);
        ss[q] += v[q][i][0] * v[q][i][0] + v[q][i][1] * v[q][i][1] + v[q][i][2] * v[q][i][2] + v[q][i][3] * v[q][i][3];
      }
      ss[q] = wave_sum(ss[q]);
    }
#pragma unroll
    for (int q = 0; q < 2; ++q) {
      const float r = rsqrtf(ss[q] * (1.f / 1024.f) + 1e-6f);
#pragma unroll
      for (int i = 0; i < 4; ++i) {
        const int c = i * 256 + lane * 4;
        const f32x4 w = *reinterpret_cast<const f32x4*>(fw + c);
        __builtin_nontemporal_store(v[q][i] * r * w, reinterpret_cast<f32x4*>(out + (size_t)(row0 + q) * 1024 + c));
      }
    }
  }
}

typedef const __attribute__((address_space(4))) Params* KArgP;
DEVI void run_phase(int wv, KArgP pp, int ph, char* lds) {
#if defined(__HIP_DEVICE_COMPILE__)
  asm volatile("" : "+s"(pp));
  char* ws = pp->ws;
  const float2* rope = (const float2*)(ws + OFF_ROPE);
  const float* ada0 = (const float*)(ws + OFF_ADA); const float* ada1 = ada0 + 17 * 3072;
  bf16_t* X = (bf16_t*)(ws + OFF_X); bf16_t* MIX = (bf16_t*)(ws + OFF_MIX);
  const int G = gridDim.x, B = blockIdx.x;
  PG8_LAS unsigned char* ldsp = (PG8_LAS unsigned char*)lds;
  switch (ph) {
    case 0: { const Params p = *pp; phase0(wv, p, lds); } break;
    case 1: norm_mod<false>(wv, pp->x, pp->ctx, pp->norm_w, ada0, X, 0, NTOK, B, G); break;
    case 2: {
      EpiL0In epi{(bf16_t*)(ws + OFF_U), (bf16_t*)(ws + OFF_GV), (bf16_t*)(ws + OFF_ZA), (bf16_t*)(ws + OFF_ZB), (bf16_t*)(ws + OFF_Q0), (bf16_t*)(ws + OFF_K0), (bf16_t*)(ws + OFF_V0), rope};
      gemm_phase(wv, ldsp, X, (const bf16_t*)(ws + OFF_W0IN), 1024, Sched{14, 144 * 14, 144 * 14, 0, 0}, epi);
    } break;
    case 3: { const Params p = *pp;
      for (int it = B; it < 1024 + 288 + 128; it += G) {
        if (it < 1024) {
          const int xcd = it & 7, slot = (it >> 3) & 31, rd = it >> 8;
          const int bh = rd * 16 + xcd * 2 + (slot >> 4), qb = slot & 15, b = bh >> 2, h = bh & 3;
          attn0_item(wv, p, b * 2048 + qb * 128, b, h, KVL, lds);
        } else if (it < 1024 + 288) abranch_item(wv, p, it - 1024, lds);
        else { const int i2 = it - 1312; const int b = i2 >> 3, h = (i2 >> 1) & 3, qb = i2 & 1; attn0_item(wv, p, NLAT + b * 256 + qb * 128, b, h, 256, lds); }
      }
    } break;
    case 4: {
      EpiPlain epi{X};
      gemm_phase(wv, ldsp, MIX, (const bf16_t*)(ws + OFF_W0OUT), 1024, Sched{4, 144 * 4, 144 * 4, 0, 0}, epi);
    } break;
    case 5: {
      if (B >= G - 16) {
        const int cp = B - (G - 16);
        norm_mod<true>(wv, pp->x, pp->ctx, pp->norm_w + 1024, ada1, X, NLAT + cp * 256, NLAT + cp * 256 + 256, 0, 1, ada0, pp->out, (float*)(ws + OFF_H1C));
        asm volatile("s_waitcnt vmcnt(0)" ::: "memory"); __syncthreads();
        EpiL1In epi{(bf16_t*)(ws + OFF_CQ), (bf16_t*)(ws + OFF_CKV), (bf16_t*)(ws + OFF_K1), (bf16_t*)(ws + OFF_Z1), (float*)(ws + OFF_RQ), (float*)(ws + OFF_RKV), rope, (float*)(lds + LDS_SS)};
        gemm_phase(wv, ldsp, X, (const bf16_t*)(ws + OFF_W1IN), 1024, Sched{6, 0, 16, 128, 1, G - 16}, epi);
      } else norm_mod<true>(wv, pp->x, pp->ctx, pp->norm_w + 1024, ada1, X, 0, NLAT, B, G - 16, ada0, pp->out, (float*)(ws + OFF_H1C));
    } break;
    case 6: {
      EpiL1In epi{(bf16_t*)(ws + OFF_CQ), (bf16_t*)(ws + OFF_CKV), (bf16_t*)(ws + OFF_K1), (bf16_t*)(ws + OFF_Z1), (float*)(ws + OFF_RQ), (float*)(ws + OFF_RKV), rope, (float*)(lds + LDS_SS)};
      gemm_phase(wv, ldsp, X, (const bf16_t*)(ws + OFF_W1IN), 1024, Sched{6, 768, 768, 128, 1}, epi);
    } break;
    case 7: {
      EpiQ eq{(bf16_t*)(ws + OFF_Q1), (const float*)(ws + OFF_RQ), rope};
      EpiKV ek{(bf16_t*)(ws + OFF_K1), (bf16_t*)(ws + OFF_V1), (const float*)(ws + OFF_RKV)};
      gemm_phase(wv, ldsp, (const bf16_t*)(ws + OFF_CQ), (const bf16_t*)(ws + OFF_WQ), 256, Sched{6, 768, 768, 0, 0}, eq);
      gemm_phase(wv, ldsp, (const bf16_t*)(ws + OFF_CKV), (const bf16_t*)(ws + OFF_WKV), 128, Sched{8, 1152, 1152, 0, 0}, ek);
    } break;
    case 8: { const Params p = *pp;
      for (int it = B; it < 1024; it += G) {
        const int xcd = it & 7, slot = (it >> 3) & 31, rd = it >> 8;
        const int bh = rd * 32 + xcd * 4 + (slot >> 3), qb = slot & 7;
        attn1_item(wv, p, bh >> 3, bh & 7, qb, lds);
      }
    } break;
    case 9: {
      EpiPlain epi{X};
      gemm_phase(wv, ldsp, MIX, (const bf16_t*)(ws + OFF_W1OUT), 1024, Sched{4, 128 * 4, 128 * 4, 0, 0}, epi);
    } break;
    case 10: final_norm(wv, pp->out, pp->final_w, X, ada1); break;
  }
#endif
}


#define XB_TMO      128
#define XB_XCNT(j)  (256  + 64 * (j))
#define XB_XSUB(j)  (1280 + 64 * (j))
#define XB_XGEN(j)  (2304 + 64 * (j))
#define XB_TOP      3328
#define XB_TOPGEN   3392
#define XCD_BAR_WORDS 3456
#define XB_SPIN_CAP (1u << 18)
#define LAS __attribute__((address_space(3)))
DEVI unsigned xb_ld(unsigned* p) { return __hip_atomic_load(p, __ATOMIC_RELAXED, __HIP_MEMORY_SCOPE_AGENT); }
DEVI unsigned xb_add(unsigned* p, unsigned v) { return __hip_atomic_fetch_add(p, v, __ATOMIC_RELAXED, __HIP_MEMORY_SCOPE_AGENT); }
DEVI unsigned xb_xcc_id() { return (unsigned)__builtin_amdgcn_s_getreg((3 << 11) | 20) & 0xFu; }
#define XB_SPIN(cond, bar) do { unsigned _sp = 0; while (cond) { __builtin_amdgcn_s_sleep(1); \
    if ((++_sp & 255u) == 0u) { if (xb_ld(&(bar)[XB_TMO])) break; if (_sp > XB_SPIN_CAP) { atomicAdd(&(bar)[XB_TMO], 1u); break; } } } } while (0)
struct XcdBarrier { unsigned* bar; unsigned x; volatile LAS unsigned* st; };
DEVI XcdBarrier xcd_barrier_post(int wv, unsigned* bar, volatile LAS unsigned* st) {
  XcdBarrier b; b.bar = bar; b.x = xb_xcc_id(); b.st = st;
  if (tidx(wv) == 0) (void)xb_add(&bar[XB_XCNT(b.x)], 1u);
  return b;
}
DEVI void xcd_barrier_complete(unsigned* bar, unsigned x, unsigned& nloc, unsigned& nx) {
  const unsigned G = gridDim.x * gridDim.y * gridDim.z;
  unsigned sum, cnt, mine, sp = 0u;
  for (;;) {
    sum = 0u; cnt = 0u; mine = 0u;
#pragma unroll
    for (unsigned j = 0; j < 16; ++j) { const unsigned c = xb_ld(&bar[XB_XCNT(j)]); sum += c; cnt += (c > 0u) ? 1u : 0u; mine = (j == x) ? c : mine; }
    if (sum == G) break;
    __builtin_amdgcn_s_sleep(1);
    if ((++sp & 255u) == 0u) { if (xb_ld(&bar[XB_TMO])) break; if (sp > XB_SPIN_CAP) { atomicAdd(&bar[XB_TMO], 1u); break; } }
  }
  nloc = mine > 0u ? mine : 1u; nx = cnt > 0u ? cnt : 1u;
}
DEVI void xcd_barrier(int wv, const XcdBarrier& b) {
  asm volatile("s_waitcnt vmcnt(0)" ::: "memory");
  __syncthreads();
  if (tidx(wv) == 0) {
    unsigned* bar = b.bar;
    __builtin_amdgcn_s_waitcnt(0);
    unsigned nloc = b.st[0], nx = b.st[1];
    if (nloc == 0u) { xcd_barrier_complete(bar, b.x, nloc, nx); b.st[0] = nloc; b.st[1] = nx; }
    const unsigned old = xb_add(&bar[XB_XSUB(b.x)], 1u);
    const unsigned gen = old / nloc;
    if (old + 1u == (gen + 1u) * nloc) {
      __builtin_amdgcn_fence(__ATOMIC_RELEASE, "agent");
      asm volatile("s_waitcnt vmcnt(0)" ::: "memory");
      const unsigned og = xb_add(&bar[XB_TOP], 1u);
      const unsigned tg = og / nx;
      if (og + 1u == (tg + 1u) * nx) xb_add(&bar[XB_TOPGEN], 1u);
      else XB_SPIN(xb_ld(&bar[XB_TOPGEN]) == tg, bar);
      __builtin_amdgcn_fence(__ATOMIC_ACQUIRE, "agent");
      xb_add(&bar[XB_XGEN(b.x)], 1u);
      asm volatile("s_waitcnt vmcnt(0)" ::: "memory");
    } else {
      XB_SPIN(xb_ld(&bar[XB_XGEN(b.x)]) == gen, bar);
      __builtin_amdgcn_fence(__ATOMIC_ACQUIRE, "agent");
      asm volatile("s_waitcnt vmcnt(0)" ::: "memory");
    }
  }
  __syncthreads();
}

extern __shared__ __attribute__((aligned(16))) char g_lds[];

constexpr int LDS_XB = 143360;
__global__ void __launch_bounds__(512) mega(Params p) {
  cg::grid_group grid = cg::this_grid();
  if (p.ph_hi > 64) grid.sync();
  const int wv = __builtin_amdgcn_readfirstlane((int)threadIdx.x >> 6);
  volatile LAS unsigned* xst = (volatile LAS unsigned*)(g_lds + LDS_XB);
  if (tidx(wv) == 0) { xst[0] = 0u; xst[1] = 0u; }
  __syncthreads();
  (void)xcd_barrier_post(wv, (unsigned*)(p.ws + OFF_BAR), xst);
#define GRID_BARRIER() do { KArgP _pp = (KArgP)__builtin_amdgcn_kernarg_segment_ptr(); asm volatile("" : "+s"(_pp)); \
    XcdBarrier _xb; _xb.bar = (unsigned*)(_pp->ws + OFF_BAR); _xb.x = xb_xcc_id(); _xb.st = (volatile LAS unsigned*)(g_lds + LDS_XB); xcd_barrier(wv, _xb); } while (0)
  for (int ph = p.ph_lo; ph < p.ph_hi; ++ph) {
    run_phase(wv, (KArgP)__builtin_amdgcn_kernarg_segment_ptr(), ph, g_lds);
#ifdef PROBE_PH
    if (ph == PROBE_PH) { GRID_BARRIER(); run_phase(wv, (KArgP)__builtin_amdgcn_kernarg_segment_ptr(), ph, g_lds); }
#endif
    if (ph + 1 < p.ph_hi) GRID_BARRIER();
  }
}

extern "C" void kernel_launch(void* const* d_in, const int* in_sizes, int n_in, void* d_out, int out_size, void* d_ws, size_t ws_size, hipStream_t stream) {
  static int ok = 0;
  static int grid_blocks = 0;
  if (!ok) {
    if (n_in != 25 || ws_size < WS_NEED) { fprintf(stderr, "kernel_launch: bad args n_in %d ws %zu need %zu\n", n_in, ws_size, (size_t)WS_NEED); return; }
    if (hipFuncSetAttribute((const void*)mega, hipFuncAttributeMaxDynamicSharedMemorySize, LDS_BYTES) != hipSuccess) { fprintf(stderr, "kernel_launch: LDS attr failed\n"); return; }
    int dev = 0, cus = 0, per_cu = 0;
    hipGetDevice(&dev);
    hipDeviceGetAttribute(&cus, hipDeviceAttributeMultiprocessorCount, dev);
    hipOccupancyMaxActiveBlocksPerMultiprocessor(&per_cu, mega, 512, LDS_BYTES);
    if (per_cu < 1) per_cu = 1;
    grid_blocks = cus * per_cu;
    ok = 1;
  }
  Params p{};
  const float** pp = (const float**)&p;
  for (int i = 0; i < 25; ++i) pp[i] = (const float*)d_in[i];
  p.out = (float*)d_out; p.ws = (char*)d_ws;
#if ONE_LAUNCH
  p.ph_lo = 0; p.ph_hi = 11;
  hipMemsetAsync((char*)d_ws + OFF_BAR, 0, XCD_BAR_WORDS * 4, stream);
  void* args[] = {&p};
  hipError_t e = hipLaunchCooperativeKernel((const void*)mega, dim3(grid_blocks), dim3(512), args, LDS_BYTES, stream);
  if (e != hipSuccess) fprintf(stderr, "cooperative launch failed: %s (grid %d)\n", hipGetErrorString(e), grid_blocks);
#else
  for (int ph = 0; ph < 11; ++ph) {
    p.ph_lo = ph; p.ph_hi = ph + 1;
    hipLaunchKernelGGL(mega, dim3(grid_blocks), dim3(512), LDS_BYTES, stream, p);
  }
#endif
}
```

```cpp
#include <hip/hip_runtime.h>
#include <hip/hip_cooperative_groups.h>
#include <cstdio>
namespace cg = cooperative_groups;

#ifndef ATT_SD0
#define ATT_SD0 2
#endif
#ifndef ONE_LAUNCH
#define ONE_LAUNCH 1
#endif

typedef unsigned short bf16_t;
typedef short bf16x8 __attribute__((ext_vector_type(8)));
typedef short s16x4 __attribute__((ext_vector_type(4)));
typedef float f32x16 __attribute__((ext_vector_type(16)));
typedef float f32x4 __attribute__((ext_vector_type(4)));
typedef unsigned u32x4 __attribute__((ext_vector_type(4)));
typedef unsigned u32x2 __attribute__((ext_vector_type(2)));
#define DEVI __device__ __forceinline__
#define SBAR() __builtin_amdgcn_sched_barrier(0)
DEVI int tidx(int wv) { int l; asm volatile("v_mbcnt_lo_u32_b32 %0, -1, 0\n\tv_mbcnt_hi_u32_b32 %0, -1, %0" : "=v"(l)); return (wv << 6) | l; }

constexpr int NLAT = 32768, NCTX = 4096, NTOK = 36864, KVL = 2304;
constexpr int LDS_BYTES = 147456, LDS_SS = 139264;

constexpr size_t OFF_W0IN = 0;
constexpr size_t OFF_W0OUT = OFF_W0IN + 3584ull * 1024 * 2;
constexpr size_t OFF_W1IN = OFF_W0OUT + 1024ull * 1024 * 2;
constexpr size_t OFF_WQ = OFF_W1IN + 1536ull * 1024 * 2;
constexpr size_t OFF_WKV = OFF_WQ + 1536ull * 256 * 2;
constexpr size_t OFF_W1OUT = OFF_WKV + 2048ull * 128 * 2;
constexpr size_t OFF_WSB = OFF_W1OUT + 1024ull * 1024 * 2;
constexpr size_t OFF_ADA = OFF_WSB + 8ull * 128 * 128 * 2;
constexpr size_t OFF_ROPE = OFF_ADA + 2ull * 17 * 3072 * 4;
constexpr size_t OFF_BAR = OFF_ROPE + 64ull * 16 * 8;
constexpr size_t OFF_H1C = OFF_BAR + 16384;
constexpr size_t OFF_RQ = OFF_H1C + 4096ull * 1024 * 4;
constexpr size_t OFF_RKV = OFF_RQ + 32768ull * 4;
constexpr size_t OFF_X = OFF_RKV + 36864ull * 4;
constexpr size_t OFF_MIX = OFF_X + 36864ull * 1024 * 2;
constexpr size_t OFF_T = OFF_MIX + 36864ull * 1024 * 2;
constexpr size_t SZ_HALF = 36864ull * 512 * 2;
constexpr size_t OFF_U = OFF_T, OFF_GV = OFF_U + SZ_HALF, OFF_ZA = OFF_GV + SZ_HALF, OFF_ZB = OFF_ZA + SZ_HALF, OFF_Q0 = OFF_ZB + SZ_HALF;
constexpr size_t OFF_K0 = OFF_Q0 + SZ_HALF, OFF_V0 = OFF_K0 + 16ull * 4 * KVL * 128 * 2, END_L0 = OFF_V0 + 16ull * 4 * KVL * 128 * 2;
constexpr size_t OFF_CQ = OFF_T, OFF_CKV = OFF_CQ + 32768ull * 256 * 2, OFF_Z1 = OFF_CKV + 36864ull * 128 * 2;
constexpr size_t OFF_Q1 = OFF_Z1 + 32768ull * 1024 * 2, OFF_K1 = OFF_Q1 + 32768ull * 1536 * 2, END_L1 = OFF_K1 + 16ull * 8 * KVL * 192 * 2;
constexpr size_t OFF_V1 = OFF_X;
constexpr size_t WS_NEED = END_L1 > END_L0 ? END_L1 : END_L0;

struct Params {
  const float *x, *c, *ctx, *c_ctx, *norm_w, *ada_w, *ada_b, *even_w_in, *a_ws, *a_bs, *a_ln_w, *a_ln_b,
      *b_lq1, *b_lk1, *b_lq2, *b_lk2, *b_subln_w, *even_w_out, *odd_w_in, *c_q_norm_w, *c_wq_b,
      *c_kv_norm_w, *c_wkv_b, *odd_w_out, *final_w;
  float* out; char* ws; int ph_lo, ph_hi;
};

DEVI unsigned cvtpk(float lo, float hi) { unsigned r; asm("v_cvt_pk_bf16_f32 %0, %1, %2" : "=v"(r) : "v"(lo), "v"(hi)); return r; }
DEVI bf16_t f2bf(float v) { return (bf16_t)(cvtpk(v, 0.f) & 0xffffu); }
DEVI float bf2f(bf16_t v) { return __uint_as_float(((unsigned)v) << 16); }
DEVI float bflo(unsigned w) { return __uint_as_float(w << 16); }
DEVI float bfhi(unsigned w) { return __uint_as_float(w & 0xffff0000u); }
DEVI int crow(int r, int hi) { return (r & 3) + 8 * (r >> 2) + 4 * hi; }
DEVI float silu_f(float x) { return x * __builtin_amdgcn_rcpf(1.f + __builtin_amdgcn_exp2f(x * -1.4426950408889634f)); }
DEVI float gelu_f(float v) {
  const float t = __builtin_amdgcn_rcpf(fmaf(fabsf(v), 0.2316418882f, 1.0f));
  float q = fmaf(t, 0.5307027145f, -0.7265760135f); q = fmaf(q, t, 0.7107068705f); q = fmaf(q, t, -0.142248368f); q = fmaf(q, t, 0.127414796f); q *= t;
  const float m = v * (q * __builtin_amdgcn_exp2f(v * v * -0.72134752044f));
  return v < 0.f ? m : v - m;
}

template <int M> DEVI float xsum(float v) {
  if constexpr (M == 32) { auto rr = __builtin_amdgcn_permlane32_swap(__float_as_uint(v), __float_as_uint(v), false, false); return __uint_as_float(rr[0]) + __uint_as_float(rr[1]); }
  else return v + __int_as_float(__builtin_amdgcn_ds_swizzle(__float_as_int(v), (M << 10) | 0x1f));
}
DEVI float wave_sum(float v) { v = xsum<1>(v); v = xsum<2>(v); v = xsum<4>(v); v = xsum<8>(v); v = xsum<16>(v); return xsum<32>(v); }

DEVI void rope_tile(f32x16& v, const float2* __restrict__ tab, int pos, int hi) {
#pragma unroll
  for (int r = 0; r < 8; ++r) {
    const int jf = (r & 3) + 8 * (r >> 2) + 4 * hi;
    const float2 cs = tab[pos * 16 + jf];
    const float a = v[r], b = v[r + 8];
    v[r] = a * cs.x - b * cs.y; v[r + 8] = b * cs.x + a * cs.y;
  }
}
DEVI void store4(bf16_t* dst, const f32x16& v, int rg) {
  u32x2 pk = {cvtpk(v[rg * 4 + 0], v[rg * 4 + 1]), cvtpk(v[rg * 4 + 2], v[rg * 4 + 3])};
  *reinterpret_cast<u32x2*>(dst) = pk;
}

#define PG8_LAS __attribute__((address_space(3)))
constexpr int HTB = 128 * 64 * 2;
DEVI int lds_byte(int r, int c) { const int st = (r >> 4) * 2 + (c >> 5), rr = r & 15, cc = c & 31, ob = rr * 64 + cc * 2; return st * 1024 + (ob ^ (((ob >> 9) & 1) << 5)); }
DEVI void stage_rc(int b, int& R, int& C) { const int st = b / 1024, sb = b % 1024, swz = sb ^ (((sb >> 9) & 1) << 5); R = (st >> 1) * 16 + swz / 64; C = (st & 1) * 32 + (swz % 64) / 2; }
DEVI int perm32(int rho) { const int n = rho >> 4, i = rho & 15; return 8 * (i >> 2) + 4 * n + (i & 3); }
struct Unit { int pm, pn; };
struct Sched {
  int nN, nmain, ntotal, xpm0, xpn, boff = 0;
  DEVI bool next(int i, Unit& u) const {
    const int it = (int)blockIdx.x - boff + i * (int)gridDim.x; if (it < 0 || it >= ntotal) return false;
    if (it < nmain) { const int xcd = it & 7, jx = it >> 3; u.pm = (jx / nN) * 8 + xcd; u.pn = jx % nN; } else { u.pm = xpm0 + (it - nmain); u.pn = xpn; }
    return true;
  }
};
template <class Epi>
DEVI void gemm_phase(int wv, PG8_LAS unsigned char* lds, const bf16_t* gA, const bf16_t* gBt, const int K, const Sched& S, const Epi& E) {
  const int tid = tidx(wv), wid = __builtin_amdgcn_readfirstlane(tid >> 6), lane = tid & 63, wr = wid >> 2, wc = wid & 3, fr = lane & 15, fq = lane >> 4;
  const int nt = K / 64;
  unsigned voffA[2], voffB[2];
#pragma unroll
  for (int i = 0; i < 2; ++i) { int R, C; stage_rc(tid * 16 + i * 8192, R, C); const int Rb = (R & ~31) + perm32(R & 31); voffA[i] = (unsigned)(R * K + C) * 2u; voffB[i] = (unsigned)(Rb * K + C) * 2u; }
  const size_t kstep = (size_t)(64 * 2);
  const size_t hstep = (size_t)128 * K * 2;
  const size_t tstep = 2 * hstep;
  const unsigned ldsw = (unsigned)wid * 1024u;
  const int aoff = lds_byte(wr * 64 + fr, fq * 8), boff = lds_byte(wc * 32 + fr, fq * 8);
#define PG8_SA(b, h) (((b) * 2 + (h)) * HTB)
#define PG8_SB(b, h) ((4 + (b) * 2 + (h)) * HTB)
#define PG8_STAGE(bufoff, gbase, voff) do { _Pragma("unroll") for (int _i = 0; _i < 2; ++_i) \
    __builtin_amdgcn_global_load_lds((const unsigned*)((const char*)(gbase) + (voff)[_i]), (PG8_LAS unsigned*)(lds + (bufoff) + ldsw + _i * 8192), 16, 0, 0); } while (0)
#define PG8_LDA(dst, b, h) do { _Pragma("unroll") for (int m = 0; m < 4; ++m) _Pragma("unroll") for (int k = 0; k < 2; ++k) dst[m][k] = *(const PG8_LAS bf16x8*)(lds + PG8_SA(b, h) + aoff + m * 2048 + k * 1024); } while (0)
#define PG8_LDB(dst, b, h) do { _Pragma("unroll") for (int n = 0; n < 2; ++n) _Pragma("unroll") for (int k = 0; k < 2; ++k) dst[n][k] = *(const PG8_LAS bf16x8*)(lds + PG8_SB(b, h) + boff + n * 2048 + k * 1024); } while (0)
#define PG8_MMA(ai, bj, At, Bt) do { __builtin_amdgcn_s_setprio(1); _Pragma("unroll") for (int m = 0; m < 4; ++m) _Pragma("unroll") for (int n = 0; n < 2; ++n) _Pragma("unroll") for (int k = 0; k < 2; ++k) \
    acc[ai][bj][m][n] = __builtin_amdgcn_mfma_f32_16x16x32_bf16(Bt[n][k], At[m][k], acc[ai][bj][m][n], 0, 0, 0); __builtin_amdgcn_s_setprio(0); } while (0)
#define PG8_WAIT_V(n) asm volatile("s_waitcnt vmcnt(" #n ")" ::: "memory")
#define PG8_WAIT_L(n) asm volatile("s_waitcnt lgkmcnt(" #n ")" ::: "memory")
#define PG8_BAR __builtin_amdgcn_s_barrier()
#define PG8_SCHED __builtin_amdgcn_sched_barrier(0)
  Unit cur, nxt; int ui = 0;
  if (!S.next(0, cur)) return;
  f32x4 acc[2][2][4][2];
#pragma unroll
  for (int a = 0; a < 2; ++a)
#pragma unroll
    for (int b = 0; b < 2; ++b)
#pragma unroll
      for (int m = 0; m < 4; ++m)
#pragma unroll
        for (int n = 0; n < 2; ++n) acc[a][b][m][n] = (f32x4){0.f, 0.f, 0.f, 0.f};
  bf16x8 At[4][2], B0[2][2], B1[2][2];
  const char* cA = (const char*)gA + (size_t)cur.pm * tstep; const char* cB = (const char*)gBt + (size_t)cur.pn * tstep;
  PG8_STAGE(PG8_SB(0, 0), cB, voffB); PG8_STAGE(PG8_SA(0, 0), cA, voffA); PG8_STAGE(PG8_SB(0, 1), cB + hstep, voffB); PG8_STAGE(PG8_SA(0, 1), cA + hstep, voffA);
  if (wr == 1) PG8_BAR;
  PG8_WAIT_V(4); PG8_BAR;
  PG8_STAGE(PG8_SB(1, 0), cB + kstep, voffB); PG8_STAGE(PG8_SA(1, 0), cA + kstep, voffA); PG8_STAGE(PG8_SB(1, 1), cB + hstep + kstep, voffB);
  PG8_WAIT_V(6); PG8_BAR;
  for (;;) {
    const bool has_next = S.next(ui + 1, nxt);
    const char* nA = has_next ? (const char*)gA + (size_t)nxt.pm * tstep : cA; const char* nB = has_next ? (const char*)gBt + (size_t)nxt.pn * tstep : cB;
#pragma unroll 1
    for (int t = 0; t < nt; t += 2) {
      const bool last = (t == nt - 2);
      const char* a1 = cA + (size_t)(t + 1) * kstep;
      const char* a2 = last ? nA : cA + (size_t)(t + 2) * kstep; const char* b2 = last ? nB : cB + (size_t)(t + 2) * kstep;
      const char* a3 = a2 + kstep; const char* b3 = b2 + kstep;
      PG8_LDB(B0, 0, 0); PG8_SCHED; PG8_LDA(At, 0, 0); PG8_STAGE(PG8_SA(1, 1), a1 + hstep, voffA);
      PG8_WAIT_L(8); PG8_BAR; PG8_WAIT_L(0); PG8_MMA(0, 0, At, B0); PG8_BAR; PG8_SCHED;
      PG8_LDB(B1, 0, 1); PG8_STAGE(PG8_SB(0, 0), b2, voffB);
      PG8_BAR; PG8_WAIT_L(0); PG8_MMA(0, 1, At, B1); PG8_BAR;
      PG8_LDA(At, 0, 1); PG8_STAGE(PG8_SA(0, 0), a2, voffA);
      PG8_BAR; PG8_WAIT_L(0); PG8_MMA(1, 0, At, B0); PG8_BAR; PG8_SCHED;
      PG8_STAGE(PG8_SB(0, 1), b2 + hstep, voffB);
      PG8_WAIT_V(6); PG8_BAR; PG8_MMA(1, 1, At, B1); PG8_BAR;
      PG8_LDB(B0, 1, 0); PG8_SCHED; PG8_LDA(At, 1, 0); PG8_STAGE(PG8_SA(0, 1), a2 + hstep, voffA);
      PG8_WAIT_L(8); PG8_BAR; PG8_WAIT_L(0); PG8_MMA(0, 0, At, B0); PG8_BAR; PG8_SCHED;
      PG8_LDB(B1, 1, 1); PG8_STAGE(PG8_SB(1, 0), b3, voffB);
      PG8_BAR; PG8_WAIT_L(0); PG8_MMA(0, 1, At, B1); PG8_BAR;
      PG8_LDA(At, 1, 1); PG8_STAGE(PG8_SA(1, 0), a3, voffA);
      PG8_BAR; PG8_WAIT_L(0); PG8_MMA(1, 0, At, B0); PG8_BAR; PG8_SCHED;
      PG8_STAGE(PG8_SB(1, 1), b3 + hstep, voffB);
      PG8_WAIT_V(6); PG8_BAR; PG8_MMA(1, 1, At, B1); PG8_BAR;
    }
    E(acc, cur, wr, wc, fr, fq);
    if (!has_next) break;
#pragma unroll
    for (int a = 0; a < 2; ++a)
#pragma unroll
      for (int b = 0; b < 2; ++b)
#pragma unroll
        for (int m = 0; m < 4; ++m)
#pragma unroll
          for (int n = 0; n < 2; ++n) acc[a][b][m][n] = (f32x4){0.f, 0.f, 0.f, 0.f};
    cur = nxt; cA = nA; cB = nB; ++ui;
  }
  PG8_WAIT_V(0);
  if (wr == 0) PG8_BAR;
  PG8_BAR;
#undef PG8_SA
#undef PG8_SB
#undef PG8_STAGE
#undef PG8_LDA
#undef PG8_LDB
#undef PG8_MMA
#undef PG8_WAIT_V
#undef PG8_WAIT_L
#undef PG8_BAR
#undef PG8_SCHED
}

typedef f32x4 acc_t[2][2][4][2];
DEVI void token_info(int token, bool ctx, int& b, int& s, int& key) {
  if (!ctx) { b = token >> 11; s = token & 2047; key = 256 + s; } else { const int tc = token - NLAT; b = tc >> 8; s = 0; key = tc & 255; }
}
DEVI float swap32_partner(float v, bool upper) {
  auto rr = __builtin_amdgcn_permlane32_swap(__float_as_uint(v), __float_as_uint(v), false, false);
  return __uint_as_float(upper ? rr[0] : rr[1]);
}
DEVI void rope_pair(f32x4& v0, f32x4& v1, const float2* __restrict__ tab, int pos, int fq) {
  const bool upper = fq >= 2;
  const float2* t = tab + pos * 16 + (fq & 1) * 8;
  const f32x4 t0 = *reinterpret_cast<const f32x4*>(t), t1 = *reinterpret_cast<const f32x4*>(t + 2), t2 = *reinterpret_cast<const f32x4*>(t + 4), t3 = *reinterpret_cast<const f32x4*>(t + 6);
  const float cs[8] = {t0[0], t0[2], t1[0], t1[2], t2[0], t2[2], t3[0], t3[2]}, sn[8] = {t0[1], t0[3], t1[1], t1[3], t2[1], t2[3], t3[1], t3[3]};
#pragma unroll
  for (int e = 0; e < 4; ++e) {
    const float p0 = swap32_partner(v0[e], upper), p1 = swap32_partner(v1[e], upper);
    const float s0 = upper ? sn[e] : -sn[e], s1 = upper ? sn[4 + e] : -sn[4 + e];
    v0[e] = v0[e] * cs[e] + p0 * s0; v1[e] = v1[e] * cs[4 + e] + p1 * s1;
  }
}
DEVI void st8(bf16_t* dst, const f32x4& v0, const f32x4& v1) { u32x4 pk = {cvtpk(v0[0], v0[1]), cvtpk(v0[2], v0[3]), cvtpk(v1[0], v1[1]), cvtpk(v1[2], v1[3])}; *reinterpret_cast<u32x4*>(dst) = pk; }

struct EpiL0In {
  bf16_t *U, *GV, *ZA, *ZB, *Q0, *K0, *V0; const float2* rope;
  DEVI void operator()(acc_t& acc, const Unit& u, int wr, int wc, int fr, int fq) const {
    const int col0 = u.pn * 256, type = col0 >> 9; const bool ctx = u.pm >= 128;
#pragma unroll
    for (int ai = 0; ai < 2; ++ai)
#pragma unroll
      for (int m = 0; m < 4; ++m) {
        const int token = u.pm * 256 + ai * 128 + wr * 64 + m * 16 + fr;
        int b, s, key; token_info(token, ctx, b, s, key);
#pragma unroll
        for (int bj = 0; bj < 2; ++bj) {
          const int nl = (col0 & 511) + bj * 128 + wc * 32;
          f32x4 v0 = acc[ai][bj][m][0], v1 = acc[ai][bj][m][1];
          bf16_t* dst;
          if (type <= 1) {
#pragma unroll
            for (int e = 0; e < 4; ++e) { v0[e] = gelu_f(v0[e]); v1[e] = gelu_f(v1[e]); }
            dst = (type == 0 ? U : GV) + (size_t)token * 512 + nl;
          } else if (type == 2 || type == 6) {
#pragma unroll
            for (int e = 0; e < 4; ++e) { v0[e] = silu_f(v0[e]); v1[e] = silu_f(v1[e]); }
            dst = (type == 2 ? ZA : ZB) + (size_t)token * 512 + nl;
          } else if (type == 3) {
            if (!ctx) rope_pair(v0, v1, rope, (wc & 1) ? (s & 63) : (s >> 6), fq);
            dst = Q0 + (size_t)token * 512 + nl;
          } else if (type == 4) {
            if (!ctx) rope_pair(v0, v1, rope, (wc & 1) ? (s & 63) : (s >> 6), fq);
            dst = K0 + ((size_t)(b * 4 + (nl >> 7)) * KVL + key) * 128 + (nl & 127);
          } else {
            dst = V0 + ((size_t)(b * 4 + (nl >> 7)) * KVL + key) * 128 + (nl & 127);
          }
          st8(dst + fq * 8, v0, v1);
        }
      }
  }
};

template <bool HASCTX> struct EpiOut {
  const float* src_lat; const float* src_ctx; float* dst_lat; float* dst_ctx; const float* ada;
  DEVI void operator()(acc_t& acc, const Unit& u, int wr, int wc, int fr, int fq) const {
    const int col0 = u.pn * 256;
#pragma unroll
    for (int ai = 0; ai < 2; ++ai)
#pragma unroll
      for (int m = 0; m < 4; ++m) {
        const int token = u.pm * 256 + ai * 128 + wr * 64 + m * 16 + fr;
        const float* src; float* dst; const float* gate;
        if (!HASCTX || token < NLAT) { src = src_lat + (size_t)token * 1024; dst = dst_lat + (size_t)token * 1024; gate = ada + (token >> 11) * 3072 + 2048; }
        else { const int tc = token - NLAT; src = src_ctx + (size_t)tc * 1024; dst = dst_ctx + (size_t)tc * 1024; gate = ada + 16 * 3072 + 2048; }
#pragma unroll
        for (int bj = 0; bj < 2; ++bj)
#pragma unroll
          for (int n = 0; n < 2; ++n) {
            const int c = col0 + bj * 128 + wc * 32 + fq * 8 + n * 4;
            const f32x4 xv = *reinterpret_cast<const f32x4*>(src + c), g = *reinterpret_cast<const f32x4*>(gate + c);
            *reinterpret_cast<f32x4*>(dst + c) = xv + g * acc[ai][bj][m][n];
          }
      }
  }
};

struct EpiPlain {
  bf16_t* O;
  DEVI void operator()(acc_t& acc, const Unit& u, int wr, int wc, int fr, int fq) const {
    const int col0 = u.pn * 256;
#pragma unroll
    for (int ai = 0; ai < 2; ++ai)
#pragma unroll
      for (int m = 0; m < 4; ++m) {
        const int token = u.pm * 256 + ai * 128 + wr * 64 + m * 16 + fr;
#pragma unroll
        for (int bj = 0; bj < 2; ++bj) st8(O + (size_t)token * 1024 + col0 + bj * 128 + wc * 32 + fq * 8, acc[ai][bj][m][0], acc[ai][bj][m][1]);
      }
  }
};

struct EpiL1In {
  bf16_t *CQ, *CKV, *K1, *Z1; float *RQ, *RKV; const float2* rope; float* ssb;
  DEVI void operator()(acc_t& acc, const Unit& u, int wr, int wc, int fr, int fq) const {
    const int col0 = u.pn * 256; const bool ctx = u.pm >= 128;
    float ss[2][4];
#pragma unroll
    for (int ai = 0; ai < 2; ++ai)
#pragma unroll
      for (int m = 0; m < 4; ++m) {
        ss[ai][m] = 0.f;
        const int token = u.pm * 256 + ai * 128 + wr * 64 + m * 16 + fr;
        int b, s, key; token_info(token, ctx, b, s, key);
#pragma unroll
        for (int bj = 0; bj < 2; ++bj) {
          const int nb = col0 + bj * 128 + wc * 32;
          f32x4 v0 = acc[ai][bj][m][0], v1 = acc[ai][bj][m][1];
          if (nb < 384) {
#pragma unroll
            for (int e = 0; e < 4; ++e) ss[ai][m] += v0[e] * v0[e] + v1[e] * v1[e];
            bf16_t* dst = nb < 256 ? CQ + (size_t)token * 256 + nb : CKV + (size_t)token * 128 + (nb - 256);
            st8(dst + fq * 8, v0, v1);
          } else if (nb < 448) {
            if (!ctx) rope_pair(v0, v1, rope, (nb >= 416) ? (s & 63) : (s >> 6), fq);
#pragma unroll
            for (int h = 0; h < 8; ++h) {
              bf16_t* dst = K1 + ((size_t)(b * 8 + h) * KVL + key) * 192 + 128 + (nb - 384);
              st8(dst + fq * 8, v0, v1);
            }
          } else if (nb < 1472) {
            if (!ctx) {
#pragma unroll
              for (int e = 0; e < 4; ++e) { v0[e] = silu_f(v0[e]); v1[e] = silu_f(v1[e]); }
              bf16_t* dst = Z1 + (size_t)token * 1024 + (nb - 448);
              st8(dst + fq * 8, v0, v1);
            }
          }
        }
      }
    if (u.pn <= 1) {
#pragma unroll
      for (int ai = 0; ai < 2; ++ai)
#pragma unroll
        for (int m = 0; m < 4; ++m) {
          float sv = ss[ai][m]; sv = xsum<16>(sv); sv = xsum<32>(sv);
          if (fq == 0) ssb[wc * 256 + ai * 128 + wr * 64 + m * 16 + fr] = sv;
        }
      asm volatile("s_waitcnt lgkmcnt(0)" ::: "memory"); __builtin_amdgcn_s_barrier(); asm volatile("" ::: "memory");
      const int lt = wc * 64 + fq * 16 + fr;
      if (lt < 128) {
        const int row = (lt >> 6) * 128 + wr * 64 + (lt & 63);
        if (u.pn == 0) { const float tot = (ssb[row] + ssb[256 + row]) + (ssb[512 + row] + ssb[768 + row]); RQ[u.pm * 256 + row] = rsqrtf(tot * (1.f / 256.f) + 1e-6f); }
        else { const float tot = (ssb[row] + ssb[256 + row]) + (ssb[512 + row] + ssb[768 + row]); RKV[u.pm * 256 + row] = rsqrtf(tot * (1.f / 128.f) + 1e-6f); }
      }
    }
  }
};

struct EpiQ {
  bf16_t* Q1; const float* RQ; const float2* rope;
  DEVI void operator()(acc_t& acc, const Unit& u, int wr, int wc, int fr, int fq) const {
    const int col0 = u.pn * 256;
#pragma unroll
    for (int ai = 0; ai < 2; ++ai)
#pragma unroll
      for (int m = 0; m < 4; ++m) {
        const int token = u.pm * 256 + ai * 128 + wr * 64 + m * 16 + fr; const int s = token & 2047; const float rq = RQ[token];
#pragma unroll
        for (int bj = 0; bj < 2; ++bj) {
          const int n0 = col0 + bj * 128 + wc * 32; const int dd0 = n0 % 192;
          f32x4 v0 = acc[ai][bj][m][0] * rq, v1 = acc[ai][bj][m][1] * rq;
          if (dd0 >= 128) rope_pair(v0, v1, rope, (dd0 >= 160) ? (s & 63) : (s >> 6), fq);
          bf16_t* dst = Q1 + (size_t)token * 1536 + n0;
          st8(dst + fq * 8, v0, v1);
        }
      }
  }
};

struct EpiKV {
  bf16_t *K1, *V1; const float* RKV;
  DEVI void operator()(acc_t& acc, const Unit& u, int wr, int wc, int fr, int fq) const {
    const int col0 = u.pn * 256; const bool ctx = u.pm >= 128;
#pragma unroll
    for (int ai = 0; ai < 2; ++ai)
#pragma unroll
      for (int m = 0; m < 4; ++m) {
        const int token = u.pm * 256 + ai * 128 + wr * 64 + m * 16 + fr; const float rk = RKV[token];
        int b, s, key; token_info(token, ctx, b, s, key);
#pragma unroll
        for (int bj = 0; bj < 2; ++bj) {
          const int nb = col0 + bj * 128 + wc * 32; const int h = nb >> 8, dd = nb & 255;
          const f32x4 v0 = acc[ai][bj][m][0] * rk, v1 = acc[ai][bj][m][1] * rk;
          bf16_t* dst = dd < 128 ? K1 + ((size_t)(b * 8 + h) * KVL + key) * 192 + dd : V1 + ((size_t)(b * 8 + h) * KVL + key) * 128 + (dd - 128);
          st8(dst + fq * 8, v0, v1);
        }
      }
  }
};

template <int SCID> struct ScaleOf { static constexpr float v = SCID == 0 ? 0.125f : 0.07216878364870322f; };
constexpr float THR = 8.f;
template <int KW> DEVI int kswz(int row, int colB) { return row * (KW * 2 + 16) + colB; }
DEVI int v_st(int k, int c) { const int kk = (k & ~0xC) | ((k & 4) << 1) | ((k & 8) >> 1); return ((kk >> 3) * 4 + (c >> 5)) * 512 + ((kk & 7) * 32 + (c & 31)) * 2; }
DEVI int v_rd_base(int lane) { return ((lane & 3) << 3) | (((lane >> 2) & 3) << 6) | (((lane >> 4) & 1) << 5) | (((lane >> 5) & 1) << 8); }
constexpr int v_rd_off(int d0, int ks, int half) { return d0 * 512 + ks * 4096 + half * 2048; }
template <int OFF> DEVI s16x4 tr_read(int vb) { s16x4 r; asm volatile("ds_read_b64_tr_b16 %0, %1 offset:%2" : "=&v"(r) : "v"(vb), "i"(OFF) : "memory"); return r; }

template <int SCID>
DEVI void partialSM(f32x16& p0, f32x16& p1, float& m_reg, float& mn, float& alpha) {
  constexpr float SC = ScaleOf<SCID>::v; constexpr float C = SC * 1.4426950408889634f;
  float pmax = p0[0];
#pragma unroll
  for (int r = 1; r < 16; ++r) pmax = fmaxf(pmax, p0[r]);
#pragma unroll
  for (int r = 0; r < 16; ++r) pmax = fmaxf(pmax, p1[r]);
  { auto rr = __builtin_amdgcn_permlane32_swap(__float_as_uint(pmax), __float_as_uint(pmax), false, false);
    pmax = fmaxf(__uint_as_float(rr[0]), __uint_as_float(rr[1])); }
  if (__builtin_expect(__all(pmax - m_reg <= THR / SC), 1)) { mn = m_reg; alpha = 1.f; }
  else { mn = fmaxf(m_reg, pmax); alpha = __builtin_amdgcn_exp2f((m_reg - mn) * C); m_reg = mn; }
  const float mnC = -mn * C;
#pragma unroll
  for (int r = 0; r < 16; ++r) p0[r] = fmaf(p0[r], C, mnC);
#pragma unroll
  for (int r = 0; r < 16; ++r) p1[r] = fmaf(p1[r], C, mnC);
#pragma unroll
  for (int r = 0; r < 16; ++r) p0[r] = __builtin_amdgcn_exp2f(p0[r]);
}
DEVI void finishSM(f32x16& p0, f32x16& p1, float alpha, float& l_reg, bf16x8& pa0, bf16x8& pa1, bf16x8& pa2, bf16x8& pa3) {
#pragma unroll
  for (int r = 0; r < 16; ++r) p1[r] = __builtin_amdgcn_exp2f(p1[r]);
  float ps = 0;
#pragma unroll
  for (int r = 0; r < 16; ++r) ps += p0[r];
#pragma unroll
  for (int r = 0; r < 16; ++r) ps += p1[r];
  { auto rr = __builtin_amdgcn_permlane32_swap(__float_as_uint(ps), __float_as_uint(ps), false, false);
    ps = __uint_as_float(rr[0]) + __uint_as_float(rr[1]); }
  l_reg = l_reg * alpha + ps;
#define PK4(P, BASE, OUT) do { unsigned a0 = cvtpk(P[BASE + 0], P[BASE + 1]), a1 = cvtpk(P[BASE + 2], P[BASE + 3]); \
    unsigned b0 = cvtpk(P[BASE + 4], P[BASE + 5]), b1 = cvtpk(P[BASE + 6], P[BASE + 7]); \
    auto r0 = __builtin_amdgcn_permlane32_swap(a0, b0, false, false); auto r1 = __builtin_amdgcn_permlane32_swap(a1, b1, false, false); \
    u32x4 w = {r0[0], r1[0], r0[1], r1[1]}; OUT = *reinterpret_cast<bf16x8*>(&w); } while (0)
  PK4(p0, 0, pa0); PK4(p0, 8, pa1); PK4(p1, 0, pa2); PK4(p1, 8, pa3);
#undef PK4
}
template <int OFF> DEVI bf16x8 lds_rd128(int a) { bf16x8 r; asm volatile("ds_read_b128 %0, %1 offset:%2" : "=&v"(r) : "v"(a), "i"(OFF) : "memory"); return r; }
template <int N> DEVI void wait_lgkm() { asm volatile("s_waitcnt lgkmcnt(%0)" :: "n"(N) : "memory"); }
template <int NQ, int QL> constexpr bool q_is_lds(int s) { return QL > 0 && s >= NQ - QL && s < NQ; }
template <int NQ, int QL, int PF> constexpr int q_after(int d) {
  int n = q_is_lds<NQ, QL>(d + 1) ? 1 : 0;
  if (q_is_lds<NQ, QL>(d)) n += (d + PF < NQ ? 2 : 0);
  else for (int i = 1; i <= PF; ++i) n += (d + i < NQ ? 2 : 0);
  return n;
}
template <int KW, int NQ, int QL, int PF, int D0>
DEVI void qkt_step(f32x16& p0, f32x16& p1, int ka, const bf16x8* qr, int qa, bf16x8 (&kf)[PF + 1][2], bf16x8 (&qf)[2]) {
  if constexpr (D0 < NQ) {
    constexpr int ROW32 = 32 * (KW * 2 + 16);
    if constexpr (D0 + PF < NQ) { kf[(D0 + PF) % (PF + 1)][0] = lds_rd128<(D0 + PF) * 32>(ka); kf[(D0 + PF) % (PF + 1)][1] = lds_rd128<ROW32 + (D0 + PF) * 32>(ka); }
    if constexpr (q_is_lds<NQ, QL>(D0 + 1)) qf[(D0 + 1) & 1] = lds_rd128<(D0 + 1 - (NQ - QL)) * 32>(qa);
    wait_lgkm<q_after<NQ, QL, PF>(D0)>(); SBAR();
    bf16x8 q;
    if constexpr (q_is_lds<NQ, QL>(D0)) q = qf[D0 & 1]; else q = qr[D0];
    p0 = __builtin_amdgcn_mfma_f32_32x32x16_bf16(kf[D0 % (PF + 1)][0], q, p0, 0, 0, 0);
    p1 = __builtin_amdgcn_mfma_f32_32x32x16_bf16(kf[D0 % (PF + 1)][1], q, p1, 0, 0, 0);
    qkt_step<KW, NQ, QL, PF, D0 + 1>(p0, p1, ka, qr, qa, kf, qf);
  }
}
template <int KW, int NQ, int QL = 0>
DEVI void qkt(f32x16& p0, f32x16& p1, const char* Ks, const bf16x8* qr, int kcol0, int r32, int hi, const char* ql = nullptr) {
  constexpr int PF = QL > 0 ? 2 : 3;
#pragma unroll
  for (int r = 0; r < 16; ++r) { p0[r] = 0.f; p1[r] = 0.f; }
  const int ka = (int)(uintptr_t)(Ks + kswz<KW>(r32, (kcol0 + hi * 8) * 2)), qa = (int)(uintptr_t)ql;
  constexpr int ROW32 = 32 * (KW * 2 + 16);
  static_assert(NQ >= PF && (QL == 0 || NQ - QL >= PF), "prologue issues steps 0..PF-1 from register-q steps");
  bf16x8 kf[PF + 1][2], qf[2];
  asm volatile("s_waitcnt lgkmcnt(0)" ::: "memory");
  kf[0][0] = lds_rd128<0>(ka); kf[0][1] = lds_rd128<ROW32>(ka);
  kf[1][0] = lds_rd128<32>(ka); kf[1][1] = lds_rd128<ROW32 + 32>(ka);
  if constexpr (PF >= 3) { kf[2][0] = lds_rd128<64>(ka); kf[2][1] = lds_rd128<ROW32 + 64>(ka); }
  qkt_step<KW, NQ, QL, PF, 0>(p0, p1, ka, qr, qa, kf, qf);
}
template <int D0> DEVI void pv_one(f32x16& od, int vb, bf16x8 pa0, bf16x8 pa1, bf16x8 pa2, bf16x8 pa3) {
  const s16x4 l0 = tr_read<v_rd_off(D0, 0, 0)>(vb), h0 = tr_read<v_rd_off(D0, 0, 1)>(vb), l1 = tr_read<v_rd_off(D0, 1, 0)>(vb), h1 = tr_read<v_rd_off(D0, 1, 1)>(vb);
  const s16x4 l2 = tr_read<v_rd_off(D0, 2, 0)>(vb), h2 = tr_read<v_rd_off(D0, 2, 1)>(vb), l3 = tr_read<v_rd_off(D0, 3, 0)>(vb), h3 = tr_read<v_rd_off(D0, 3, 1)>(vb);
  asm volatile("s_waitcnt lgkmcnt(0)" ::: "memory"); SBAR();
#define PK(L, H) (bf16x8){L[0], L[1], L[2], L[3], H[0], H[1], H[2], H[3]}
  od = __builtin_amdgcn_mfma_f32_32x32x16_bf16(pa0, PK(l0, h0), od, 0, 0, 0);
  od = __builtin_amdgcn_mfma_f32_32x32x16_bf16(pa1, PK(l1, h1), od, 0, 0, 0);
  od = __builtin_amdgcn_mfma_f32_32x32x16_bf16(pa2, PK(l2, h2), od, 0, 0, 0);
  od = __builtin_amdgcn_mfma_f32_32x32x16_bf16(pa3, PK(l3, h3), od, 0, 0, 0);
#undef PK
}
template <int D0> DEVI void v_load(int vb, s16x4 (&f)[8]) {
  f[0] = tr_read<v_rd_off(D0, 0, 0)>(vb); f[1] = tr_read<v_rd_off(D0, 0, 1)>(vb); f[2] = tr_read<v_rd_off(D0, 1, 0)>(vb); f[3] = tr_read<v_rd_off(D0, 1, 1)>(vb);
  f[4] = tr_read<v_rd_off(D0, 2, 0)>(vb); f[5] = tr_read<v_rd_off(D0, 2, 1)>(vb); f[6] = tr_read<v_rd_off(D0, 3, 0)>(vb); f[7] = tr_read<v_rd_off(D0, 3, 1)>(vb);
}
DEVI void pv_mma(f32x16& od, const s16x4 (&f)[8], bf16x8 pa0, bf16x8 pa1, bf16x8 pa2, bf16x8 pa3) {
#define PK(L, H) (bf16x8){L[0], L[1], L[2], L[3], H[0], H[1], H[2], H[3]}
  od = __builtin_amdgcn_mfma_f32_32x32x16_bf16(pa0, PK(f[0], f[1]), od, 0, 0, 0);
  od = __builtin_amdgcn_mfma_f32_32x32x16_bf16(pa1, PK(f[2], f[3]), od, 0, 0, 0);
  od = __builtin_amdgcn_mfma_f32_32x32x16_bf16(pa2, PK(f[4], f[5]), od, 0, 0, 0);
  od = __builtin_amdgcn_mfma_f32_32x32x16_bf16(pa3, PK(f[6], f[7]), od, 0, 0, 0);
#undef PK
}
DEVI void pv_d0(f32x16* o, int vb, bf16x8 pa0, bf16x8 pa1, bf16x8 pa2, bf16x8 pa3) {
  s16x4 fa[8], fb[8];
  v_load<0>(vb, fa);
  v_load<1>(vb, fb); asm volatile("s_waitcnt lgkmcnt(8)" ::: "memory"); SBAR(); pv_mma(o[0], fa, pa0, pa1, pa2, pa3); SBAR();
  v_load<2>(vb, fa); asm volatile("s_waitcnt lgkmcnt(8)" ::: "memory"); SBAR(); pv_mma(o[1], fb, pa0, pa1, pa2, pa3); SBAR();
  v_load<3>(vb, fb); asm volatile("s_waitcnt lgkmcnt(8)" ::: "memory"); SBAR(); pv_mma(o[2], fa, pa0, pa1, pa2, pa3); SBAR();
  asm volatile("s_waitcnt lgkmcnt(0)" ::: "memory"); SBAR(); pv_mma(o[3], fb, pa0, pa1, pa2, pa3);
}

template <int KW, int NQ, int SCID>
DEVI void attn_core(int wv, const bf16_t* __restrict__ Qw, const bf16_t* __restrict__ Kh, const bf16_t* __restrict__ Vh, int kcol0, int NT, char* lds,
                    f32x16 (&o)[4], float& l_out) {
  constexpr int SHM_V = 64 * 128 * 2, SHM_K = 64 * (KW * 2 + 16), KC = KW / 64;
  const int tid = tidx(wv), wid = tid >> 6, lane = tid & 63, r32 = lane & 31, hi = lane >> 5;
  char* V_lds = lds; char* K_lds = lds + 2 * SHM_V;
  float* al_l = (float*)(lds + 2 * SHM_V + 2 * SHM_K) + wid * 64 + 32;
  float m_reg = -1e30f, l_reg = 0;
#pragma unroll
  for (int d = 0; d < 4; ++d)
#pragma unroll
    for (int r = 0; r < 16; ++r) o[d][r] = 0.f;
  bf16x8 qr[NQ];
#pragma unroll
  for (int d0 = 0; d0 < NQ; ++d0) qr[d0] = *reinterpret_cast<const bf16x8*>(Qw + d0 * 16);
  const int sr = tid >> 4, sc = (tid & 15) * 8, vst0 = v_st(sr, sc), vst1 = v_st(32 + sr, sc);
  const int krow = tid >> 3, kch = tid & 7;
  const bf16_t* vg = Vh + sr * 128 + sc;
  const bf16_t* kg = Kh + krow * KW + kch * 8;
  const int vb0 = (int)(uintptr_t)V_lds + v_rd_base(lane);
  bf16x8 vs0, vs1, ks[KC];
#define SLOAD(k0) do { vs0 = *reinterpret_cast<const bf16x8*>(vg + (size_t)(k0) * 128); vs1 = *reinterpret_cast<const bf16x8*>(vg + (size_t)((k0) + 32) * 128); \
    _Pragma("unroll") for (int _c = 0; _c < KC; ++_c) ks[_c] = *reinterpret_cast<const bf16x8*>(kg + (size_t)(k0) * KW + _c * 64); } while (0)
#define SWRITE(b) do { *reinterpret_cast<bf16x8*>(V_lds + (b) * SHM_V + vst0) = vs0; *reinterpret_cast<bf16x8*>(V_lds + (b) * SHM_V + vst1) = vs1; \
    _Pragma("unroll") for (int _c = 0; _c < KC; ++_c) *reinterpret_cast<bf16x8*>(K_lds + (b) * SHM_K + kswz<KW>(krow, (kch + 8 * _c) * 16)) = ks[_c]; } while (0)
  SLOAD(0); SWRITE(0);
  if (NT > 1) SLOAD(64);
  __syncthreads();
  for (int j = 0; j < NT; ++j) {
    const int bsel = j & 1;
    f32x16 p0, p1; float mn, alpha; bf16x8 pa0, pa1, pa2, pa3;
    qkt<KW, NQ>(p0, p1, K_lds + bsel * SHM_K, qr, kcol0, r32, hi);
    partialSM<SCID>(p0, p1, m_reg, mn, alpha);
    if (__any(alpha < 1.f)) {
      if (hi == 0) al_l[r32] = alpha;
      asm volatile("s_waitcnt lgkmcnt(0)" ::: "memory");
#pragma unroll
      for (int d = 0; d < 4; ++d)
#pragma unroll
        for (int r = 0; r < 16; ++r) o[d][r] *= al_l[crow(r, hi)];
    }
    finishSM(p0, p1, alpha, l_reg, pa0, pa1, pa2, pa3);
    pv_d0(o, vb0 + bsel * SHM_V, pa0, pa1, pa2, pa3);
    if (j + 1 < NT) { SWRITE(bsel ^ 1); if (j + 2 < NT) SLOAD((j + 2) * 64); }
    __syncthreads();
  }
  l_out = l_reg;
#undef SLOAD
#undef SWRITE
}

template <int KW, int NQ, int SDEPTH, int SCID, int QL>
DEVI void attn_core_pipe(int wv, const bf16_t* __restrict__ Qw, const bf16_t* __restrict__ Kh, const bf16_t* __restrict__ Vh, int kcol0, int NT, char* lds,
                         f32x16 (&o)[4], float& l_out) {
  constexpr int SHM_V = 64 * 128 * 2, SHM_K = 64 * (KW * 2 + 16), KC = KW / 64;
  const int tid = tidx(wv), wid = tid >> 6, lane = tid & 63, r32 = lane & 31, hi = lane >> 5;
  char* V_lds = lds; char* K_lds = lds + 2 * SHM_V;
  float* al_l = (float*)(lds + 2 * SHM_V + 2 * SHM_K) + wid * 64 + 32;
  float m_reg = -1e30f, l_reg = 0;
#pragma unroll
  for (int d = 0; d < 4; ++d)
#pragma unroll
    for (int r = 0; r < 16; ++r) o[d][r] = 0.f;
  bf16x8 qr[NQ - QL + (QL ? 1 : 0)];
#pragma unroll
  for (int d0 = 0; d0 < NQ - QL; ++d0) qr[d0] = *reinterpret_cast<const bf16x8*>(Qw + d0 * 16);
  char* ql = lds + 2 * SHM_V + 2 * SHM_K + 2048 + (wid * 32 + r32) * 144 + hi * 16;
  if constexpr (QL > 0) {
#pragma unroll
    for (int d0 = NQ - QL; d0 < NQ; ++d0) *reinterpret_cast<bf16x8*>(ql + (d0 - (NQ - QL)) * 32) = *reinterpret_cast<const bf16x8*>(Qw + d0 * 16);
  }
  const int sr = tid >> 4, sc = (tid & 15) * 8, vst0 = v_st(sr, sc), vst1 = v_st(32 + sr, sc);
  const int krow = tid >> 3, kch = tid & 7;
  const bf16_t* vg = Vh + sr * 128 + sc;
  const bf16_t* kg = Kh + krow * KW + kch * 8;
  const int vb0 = (int)(uintptr_t)V_lds + v_rd_base(lane);
  struct { bf16x8 vs0, vs1, ks[KC]; } sr_[SDEPTH];
#define SLOAD(i, k0) do { sr_[i].vs0 = *reinterpret_cast<const bf16x8*>(vg + (size_t)(k0) * 128); sr_[i].vs1 = *reinterpret_cast<const bf16x8*>(vg + (size_t)((k0) + 32) * 128); \
    _Pragma("unroll") for (int _c = 0; _c < KC; ++_c) sr_[i].ks[_c] = *reinterpret_cast<const bf16x8*>(kg + (size_t)(k0) * KW + _c * 64); } while (0)
#define SWRITE(b, i) do { *reinterpret_cast<bf16x8*>(V_lds + (b) * SHM_V + vst0) = sr_[i].vs0; *reinterpret_cast<bf16x8*>(V_lds + (b) * SHM_V + vst1) = sr_[i].vs1; \
    _Pragma("unroll") for (int _c = 0; _c < KC; ++_c) *reinterpret_cast<bf16x8*>(K_lds + (b) * SHM_K + kswz<KW>(krow, (kch + 8 * _c) * 16)) = sr_[i].ks[_c]; } while (0)
#define SWAIT() do { if constexpr (SDEPTH == 2) asm volatile("s_waitcnt vmcnt(4)" ::: "memory"); else asm volatile("s_waitcnt vmcnt(0)" ::: "memory"); } while (0)
#define RESC(a) do { if (__any((a) < 1.f)) { if (hi == 0) al_l[r32] = (a); asm volatile("s_waitcnt lgkmcnt(0)" ::: "memory"); \
    _Pragma("unroll") for (int _d = 0; _d < 4; ++_d) _Pragma("unroll") for (int _r = 0; _r < 16; ++_r) o[_d][_r] *= al_l[crow(_r, hi)]; } } while (0)
  f32x16 pA0, pA1, pB0, pB1; float mnA, mnB, alA, alB; bf16x8 pa0, pa1, pa2, pa3;
  constexpr int SE = 0, SO = SDEPTH - 1;
  SLOAD(SE, 0); asm volatile("s_waitcnt vmcnt(0)" ::: "memory"); SWRITE(0, SE); __syncthreads();
  qkt<KW, NQ, QL>(pA0, pA1, K_lds, qr, kcol0, r32, hi, ql); partialSM<SCID>(pA0, pA1, m_reg, mnA, alA);
  SLOAD(SO, 64); if constexpr (SDEPTH == 2) { if (2 < NT) SLOAD(SE, 128); }
  SWAIT(); SWRITE(1, SO); __syncthreads();
  for (int j = 1; j + 1 < NT; j += 2) {
    SBAR(); qkt<KW, NQ, QL>(pB0, pB1, K_lds + SHM_K, qr, kcol0, r32, hi, ql);
    finishSM(pA0, pA1, alA, l_reg, pa0, pa1, pa2, pa3); SBAR();
    SLOAD(SO, (j + SDEPTH) * 64); SBAR();
    pv_d0(o, vb0, pa0, pa1, pa2, pa3); partialSM<SCID>(pB0, pB1, m_reg, mnB, alB);
    __syncthreads(); SWAIT(); SWRITE(0, SE);
    RESC(alB); __syncthreads();
    SBAR(); qkt<KW, NQ, QL>(pA0, pA1, K_lds, qr, kcol0, r32, hi, ql);
    finishSM(pB0, pB1, alB, l_reg, pa0, pa1, pa2, pa3); SBAR();
    if (SDEPTH == 1 || j + 3 < NT) SLOAD(SE, (j + 1 + SDEPTH) * 64);
    SBAR();
    pv_d0(o, vb0 + SHM_V, pa0, pa1, pa2, pa3); partialSM<SCID>(pA0, pA1, m_reg, mnA, alA);
    __syncthreads(); SWAIT(); SWRITE(1, SO);
    RESC(alA); __syncthreads();
  }
  SBAR(); qkt<KW, NQ, QL>(pB0, pB1, K_lds + SHM_K, qr, kcol0, r32, hi, ql);
  finishSM(pA0, pA1, alA, l_reg, pa0, pa1, pa2, pa3); SBAR();
  pv_d0(o, vb0, pa0, pa1, pa2, pa3); partialSM<SCID>(pB0, pB1, m_reg, mnB, alB);
  __syncthreads(); RESC(alB);
  finishSM(pB0, pB1, alB, l_reg, pa0, pa1, pa2, pa3); SBAR();
  pv_d0(o, vb0 + SHM_V, pa0, pa1, pa2, pa3);
  __syncthreads();
  l_out = l_reg;
#undef SLOAD
#undef SWRITE
#undef SWAIT
#undef RESC
}

template <int KW, int NQ, int SCID, int QL>
DEVI void attn_core_dma(int wv, const bf16_t* __restrict__ Qw, const bf16_t* __restrict__ Kh, const bf16_t* __restrict__ Vh, int kcol0, int NT, char* lds,
                        f32x16 (&o)[4], float& l_out) {
  constexpr int SHM_V = 64 * 128 * 2, KCH = KW / 8 + 1, SHM_K = 64 * KCH * 16, KR = (64 * KCH) / 512;
  static_assert(64 * KCH - KR * 512 == 64, "remainder must be one wave");
  const int tid = tidx(wv), wid = tid >> 6, lane = tid & 63, r32 = lane & 31, hi = lane >> 5;
  char* V_lds = lds; char* K_lds = lds + 2 * SHM_V;
  float* al_l = (float*)(lds + 2 * SHM_V + 2 * SHM_K) + wid * 64 + 32;
  float m_reg = -1e30f, l_reg = 0;
#pragma unroll
  for (int d = 0; d < 4; ++d)
#pragma unroll
    for (int r = 0; r < 16; ++r) o[d][r] = 0.f;
  bf16x8 qr[NQ - QL + (QL ? 1 : 0)];
#pragma unroll
  for (int d0 = 0; d0 < NQ - QL; ++d0) qr[d0] = *reinterpret_cast<const bf16x8*>(Qw + d0 * 16);
  char* ql = lds + 2 * SHM_V + 2 * SHM_K + 2048 + (wid * 32 + r32) * 144 + hi * 16;
  if constexpr (QL > 0) {
#pragma unroll
    for (int d0 = NQ - QL; d0 < NQ; ++d0) *reinterpret_cast<bf16x8*>(ql + (d0 - (NQ - QL)) * 32) = *reinterpret_cast<const bf16x8*>(Qw + d0 * 16);
  }
  const int sr = tid >> 4, sc = (tid & 15) * 8, vst0 = v_st(sr, sc), vst1 = v_st(32 + sr, sc);
  const bf16_t* vg = Vh + sr * 128 + sc;
  const int vb0 = (int)(uintptr_t)V_lds + v_rd_base(lane);
  unsigned koff[KR + 1];
#pragma unroll
  for (int i = 0; i <= KR; ++i) { const int c = tid + 512 * i; const int row = c / KCH; int ch = c - row * KCH; ch = ch == KCH - 1 ? KCH - 2 : ch; koff[i] = (unsigned)(row * KW + ch * 8) * 2u; }
  const unsigned kldsw = (unsigned)__builtin_amdgcn_readfirstlane(wid) * 1024u;
  bf16x8 vs0, vs1;
#define KDMA(k0, b) do { const char* _g = (const char*)(Kh + (size_t)(k0) * KW); PG8_LAS unsigned char* _l = (PG8_LAS unsigned char*)(K_lds + (b) * SHM_K) + kldsw; \
    _Pragma("unroll") for (int _i = 0; _i < KR; ++_i) __builtin_amdgcn_global_load_lds((const unsigned*)(_g + koff[_i]), (PG8_LAS unsigned*)(_l + _i * 8192), 16, 0, 0); \
    if (wid == 0) __builtin_amdgcn_global_load_lds((const unsigned*)(_g + koff[KR]), (PG8_LAS unsigned*)(_l + KR * 8192), 16, 0, 0); } while (0)
#define VLOAD(k0) do { vs0 = *reinterpret_cast<const bf16x8*>(vg + (size_t)(k0) * 128); vs1 = *reinterpret_cast<const bf16x8*>(vg + (size_t)((k0) + 32) * 128); } while (0)
#define VWRITE(b) do { *reinterpret_cast<bf16x8*>(V_lds + (b) * SHM_V + vst0) = vs0; *reinterpret_cast<bf16x8*>(V_lds + (b) * SHM_V + vst1) = vs1; } while (0)
#define VMW() asm volatile("s_waitcnt vmcnt(0)" ::: "memory")
#define RESC(a) do { if (__any((a) < 1.f)) { if (hi == 0) al_l[r32] = (a); asm volatile("s_waitcnt lgkmcnt(0)" ::: "memory"); \
    _Pragma("unroll") for (int _d = 0; _d < 4; ++_d) _Pragma("unroll") for (int _r = 0; _r < 16; ++_r) o[_d][_r] *= al_l[crow(_r, hi)]; } } while (0)
  f32x16 pA0, pA1, pB0, pB1; float mnA, mnB, alA, alB; bf16x8 pa0, pa1, pa2, pa3;
  KDMA(0, 0); VLOAD(0); VMW(); VWRITE(0); __syncthreads();
  KDMA(64, 1); VLOAD(64);
  qkt<KW, NQ, QL>(pA0, pA1, K_lds, qr, kcol0, r32, hi, ql); partialSM<SCID>(pA0, pA1, m_reg, mnA, alA);
  VMW(); __syncthreads(); VWRITE(1); __syncthreads();
  for (int j = 1; j + 1 < NT; j += 2) {
    SBAR(); KDMA((j + 1) * 64, 0); VLOAD((j + 1) * 64); SBAR();
    qkt<KW, NQ, QL>(pB0, pB1, K_lds + SHM_K, qr, kcol0, r32, hi, ql);
    finishSM(pA0, pA1, alA, l_reg, pa0, pa1, pa2, pa3); SBAR();
    pv_d0(o, vb0, pa0, pa1, pa2, pa3); partialSM<SCID>(pB0, pB1, m_reg, mnB, alB);
    VMW(); __syncthreads(); VWRITE(0);
    RESC(alB); __syncthreads();
    SBAR(); KDMA((j + 2) * 64, 1); VLOAD((j + 2) * 64); SBAR();
    qkt<KW, NQ, QL>(pA0, pA1, K_lds, qr, kcol0, r32, hi, ql);
    finishSM(pB0, pB1, alB, l_reg, pa0, pa1, pa2, pa3); SBAR();
    pv_d0(o, vb0 + SHM_V, pa0, pa1, pa2, pa3); partialSM<SCID>(pA0, pA1, m_reg, mnA, alA);
    VMW(); __syncthreads(); VWRITE(1);
    RESC(alA); __syncthreads();
  }
  SBAR(); qkt<KW, NQ, QL>(pB0, pB1, K_lds + SHM_K, qr, kcol0, r32, hi, ql);
  finishSM(pA0, pA1, alA, l_reg, pa0, pa1, pa2, pa3); SBAR();
  pv_d0(o, vb0, pa0, pa1, pa2, pa3); partialSM<SCID>(pB0, pB1, m_reg, mnB, alB);
  RESC(alB);
  finishSM(pB0, pB1, alB, l_reg, pa0, pa1, pa2, pa3); SBAR();
  pv_d0(o, vb0 + SHM_V, pa0, pa1, pa2, pa3);
  __syncthreads();
  l_out = l_reg;
#undef KDMA
#undef VLOAD
#undef VWRITE
#undef VMW
#undef RESC
}

template <int KW, int NQ, int SCID, int QL>
DEVI void attn_core_pp(int wv, const bf16_t* __restrict__ Qw, const bf16_t* __restrict__ Kh, const bf16_t* __restrict__ Vh, int kcol0, int NT, char* lds,
                       f32x16 (&o)[4], float& l_out) {
  constexpr int SHM_V = 64 * 128 * 2, KCH = KW / 8 + 1, SHM_K = 64 * KCH * 16, KR = (64 * KCH) / 512;
  static_assert(64 * KCH - KR * 512 == 64, "remainder must be one wave");
  const int tid = tidx(wv), wid = tid >> 6, lane = tid & 63, r32 = lane & 31, hi = lane >> 5;
  const int g = __builtin_amdgcn_readfirstlane(wid >> 2);
  char* V_lds = lds; char* K_lds = lds + 2 * SHM_V;
  float* al_l = (float*)(lds + 2 * SHM_V + 2 * SHM_K) + wid * 64 + 32;
  float m_reg = -1e30f, l_reg = 0;
#pragma unroll
  for (int d = 0; d < 4; ++d)
#pragma unroll
    for (int r = 0; r < 16; ++r) o[d][r] = 0.f;
  bf16x8 qr[NQ - QL + (QL ? 1 : 0)];
#pragma unroll
  for (int d0 = 0; d0 < NQ - QL; ++d0) qr[d0] = *reinterpret_cast<const bf16x8*>(Qw + d0 * 16);
  char* ql = lds + 2 * SHM_V + 2 * SHM_K + 2048 + (wid * 32 + r32) * 144 + hi * 16;
  if constexpr (QL > 0) {
#pragma unroll
    for (int d0 = NQ - QL; d0 < NQ; ++d0) *reinterpret_cast<bf16x8*>(ql + (d0 - (NQ - QL)) * 32) = *reinterpret_cast<const bf16x8*>(Qw + d0 * 16);
  }
  const int vb0 = (int)(uintptr_t)V_lds + v_rd_base(lane);
  unsigned koff[KR + 1], voff[2];
#pragma unroll
  for (int i = 0; i <= KR; ++i) { const int c = tid + 512 * i; const int row = c / KCH; int ch = c - row * KCH; ch = ch == KCH - 1 ? KCH - 2 : ch; koff[i] = (unsigned)(row * KW + ch * 8) * 2u; }
#pragma unroll
  for (int i = 0; i < 2; ++i) { const int q = tid + 512 * i; const int st = q >> 5, kk = (st >> 2) * 8 + ((q >> 2) & 7), c = (st & 3) * 32 + (q & 3) * 8;
    const int k = (kk & ~0xC) | ((kk & 4) << 1) | ((kk & 8) >> 1); voff[i] = (unsigned)(k * 128 + c) * 2u; }
  const unsigned ldsw = (unsigned)__builtin_amdgcn_readfirstlane(wid) * 1024u;
#define KDMA(k0, b) do { const char* _g = (const char*)(Kh + (size_t)(k0) * KW); PG8_LAS unsigned char* _l = (PG8_LAS unsigned char*)(K_lds + (b) * SHM_K) + ldsw; \
    _Pragma("unroll") for (int _i = 0; _i < KR; ++_i) __builtin_amdgcn_global_load_lds((const unsigned*)(_g + koff[_i]), (PG8_LAS unsigned*)(_l + _i * 8192), 16, 0, 0); \
    if (wid == 0) __builtin_amdgcn_global_load_lds((const unsigned*)(_g + koff[KR]), (PG8_LAS unsigned*)(_l + KR * 8192), 16, 0, 0); } while (0)
#define VDMA(k0, b) do { const char* _g = (const char*)(Vh + (size_t)(k0) * 128); PG8_LAS unsigned char* _l = (PG8_LAS unsigned char*)(V_lds + (b) * SHM_V) + ldsw; \
    _Pragma("unroll") for (int _i = 0; _i < 2; ++_i) __builtin_amdgcn_global_load_lds((const unsigned*)(_g + voff[_i]), (PG8_LAS unsigned*)(_l + _i * 8192), 16, 0, 0); } while (0)
#define VMW() asm volatile("s_waitcnt vmcnt(0)" ::: "memory")
#define PBAR() do { asm volatile("" ::: "memory"); __builtin_amdgcn_s_barrier(); asm volatile("" ::: "memory"); } while (0)
#define RESC(a) do { if (__any((a) < 1.f)) { if (hi == 0) al_l[r32] = (a); asm volatile("s_waitcnt lgkmcnt(0)" ::: "memory"); \
    _Pragma("unroll") for (int _d = 0; _d < 4; ++_d) _Pragma("unroll") for (int _r = 0; _r < 16; ++_r) o[_d][_r] *= al_l[crow(_r, hi)]; } } while (0)
  f32x16 pA0, pA1, pB0, pB1; float mn, al; bf16x8 pa0, pa1, pa2, pa3;
  KDMA(0, 0); KDMA(64, 1); VMW(); __syncthreads();
  qkt<KW, NQ, QL>(pA0, pA1, K_lds, qr, kcol0, r32, hi, ql);
  PBAR();
  if (g == 1) PBAR();
  for (int j = 0; j < NT; j += 2) {
    SBAR(); if (j + 2 < NT) KDMA((j + 2) * 64, 0); VDMA(j * 64, 0); SBAR();
    qkt<KW, NQ, QL>(pB0, pB1, K_lds + SHM_K, qr, kcol0, r32, hi, ql);
    if (j > 0) pv_d0(o, vb0 + SHM_V, pa0, pa1, pa2, pa3);
    if (g == 1) VMW();
    PBAR(); SBAR();
    partialSM<SCID>(pA0, pA1, m_reg, mn, al); RESC(al); finishSM(pA0, pA1, al, l_reg, pa0, pa1, pa2, pa3);
    if (g == 0) VMW();
    PBAR(); SBAR();
    if (j + 3 < NT) KDMA((j + 3) * 64, 1);
    VDMA((j + 1) * 64, 1); SBAR();
    if (j + 2 < NT) qkt<KW, NQ, QL>(pA0, pA1, K_lds, qr, kcol0, r32, hi, ql);
    pv_d0(o, vb0, pa0, pa1, pa2, pa3);
    if (g == 1) VMW();
    PBAR(); SBAR();
    partialSM<SCID>(pB0, pB1, m_reg, mn, al); RESC(al); finishSM(pB0, pB1, al, l_reg, pa0, pa1, pa2, pa3);
    if (g == 0) VMW();
    PBAR(); SBAR();
  }
  pv_d0(o, vb0 + SHM_V, pa0, pa1, pa2, pa3);
  if (g == 0) PBAR();
  __syncthreads();
  l_out = l_reg;
#undef KDMA
#undef VDMA
#undef VMW
#undef PBAR
#undef RESC
}

DEVI void gated_rows_out(const char* stg, int lane, const bf16_t* __restrict__ gate, int gld, bf16_t* __restrict__ out, int old) {
#pragma unroll
  for (int i = 0; i < 8; ++i) {
    const int c = lane + 64 * i, row = c >> 4, ch = c & 15;
    const u32x4 sv = *reinterpret_cast<const u32x4*>(stg + row * 272 + ch * 16);
    const u32x4 gv = *reinterpret_cast<const u32x4*>(gate + (size_t)row * gld + ch * 8);
    u32x4 ov;
#pragma unroll
    for (int e = 0; e < 4; ++e) ov[e] = cvtpk(bflo(sv[e]) * bflo(gv[e]), bfhi(sv[e]) * bfhi(gv[e]));
    *reinterpret_cast<u32x4*>(out + (size_t)row * old + ch * 8) = ov;
  }
}

DEVI void attn0_item(int wv, const Params& p, int token0, int b, int h, int nkeys, char* lds) {
  const int tid = tidx(wv), wid = tid >> 6, lane = tid & 63, r32 = lane & 31, hi = lane >> 5, m = wid >> 2, wl = wid & 3;
  const bf16_t* Q0 = (const bf16_t*)(p.ws + OFF_Q0); const bf16_t* K0 = (const bf16_t*)(p.ws + OFF_K0); const bf16_t* V0 = (const bf16_t*)(p.ws + OFF_V0);
  const bf16_t* ZB = (const bf16_t*)(p.ws + OFF_ZB); bf16_t* MIX = (bf16_t*)(p.ws + OFF_MIX);
  const bf16_t* Qw = Q0 + (size_t)(token0 + wl * 32 + r32) * 512 + h * 128 + m * 64 + hi * 8;
  const size_t kvo = (size_t)(b * 4 + h) * KVL * 128;
  f32x16 o[4]; float l;
  attn_core_pp<128, 4, 0, 0>(wv, Qw, K0 + kvo, V0 + kvo, m * 64, nkeys >> 6, lds, o, l);
  float* li_l = (float*)(lds + 32768 + 2 * 64 * 272) + wid * 64;
  if (hi == 0) li_l[r32] = l;
  asm volatile("s_waitcnt lgkmcnt(0)" ::: "memory");
  float rli[16];
#pragma unroll
  for (int r = 0; r < 16; ++r) rli[r] = __builtin_amdgcn_rcpf(li_l[crow(r, hi)]);
  float t1 = p.b_lq1[lane] * p.b_lk1[lane], t2 = p.b_lq2[lane] * p.b_lk2[lane];
  t1 = wave_sum(t1); t2 = wave_sum(t2);
  const float lam = __expf(t1) - __expf(t2) + 0.2f;
  __syncthreads();
  float* xch = (float*)lds;
  if (m == 1) {
#pragma unroll
    for (int r = 0; r < 16; ++r)
#pragma unroll
      for (int d0 = 0; d0 < 4; ++d0) xch[(wl * 32 + crow(r, hi)) * 128 + d0 * 32 + r32] = o[d0][r] * rli[r];
  }
  __syncthreads();
  if (m == 0) {
    char* stg = lds + 69632 + wl * 8704;
    float sw4[4];
#pragma unroll
    for (int d0 = 0; d0 < 4; ++d0) sw4[d0] = p.b_subln_w[d0 * 32 + r32];
#pragma unroll
    for (int r = 0; r < 16; ++r) {
      const int row = wl * 32 + crow(r, hi); const int token = token0 + row;
      float a[4], ss = 0.f;
#pragma unroll
      for (int d0 = 0; d0 < 4; ++d0) { a[d0] = o[d0][r] * rli[r] - lam * xch[row * 128 + d0 * 32 + r32]; ss += a[d0] * a[d0]; }
      ss = xsum<1>(ss); ss = xsum<2>(ss); ss = xsum<4>(ss); ss = xsum<8>(ss); ss = xsum<16>(ss);
      const float rstd = rsqrtf(ss * (1.f / 128.f) + 1e-5f) * 0.8f;
#pragma unroll
      for (int d0 = 0; d0 < 4; ++d0) *reinterpret_cast<bf16_t*>(stg + crow(r, hi) * 272 + (d0 * 32 + r32) * 2) = f2bf(a[d0] * rstd * sw4[d0]);
    }
    asm volatile("s_waitcnt lgkmcnt(0)" ::: "memory");
    const size_t t0 = (size_t)(token0 + wl * 32);
    gated_rows_out(stg, lane, ZB + t0 * 512 + h * 128, 512, MIX + t0 * 1024 + 512 + h * 128, 1024);
  }
  __syncthreads();
}

DEVI void attn1_item(int wv, const Params& p, int b, int h, int qb, char* lds) {
  const int tid = tidx(wv), wid = tid >> 6, lane = tid & 63, r32 = lane & 31, hi = lane >> 5;
  const bf16_t* Q1 = (const bf16_t*)(p.ws + OFF_Q1); const bf16_t* K1 = (const bf16_t*)(p.ws + OFF_K1); const bf16_t* V1 = (const bf16_t*)(p.ws + OFF_V1);
  const bf16_t* Z1 = (const bf16_t*)(p.ws + OFF_Z1); bf16_t* MIX = (bf16_t*)(p.ws + OFF_MIX);
  const int token0 = b * 2048 + qb * 256;
  const bf16_t* Qw = Q1 + (size_t)(token0 + wid * 32 + r32) * 1536 + h * 192 + hi * 8;
  f32x16 o[4]; float l;
  attn_core_pp<192, 12, 1, 4>(wv, Qw, K1 + (size_t)(b * 8 + h) * KVL * 192, V1 + (size_t)(b * 8 + h) * KVL * 128, 0, KVL / 64, lds, o, l);
  float* li_l = (float*)(lds + 32768 + 2 * 64 * 400) + wid * 64;
  if (hi == 0) li_l[r32] = l;
  asm volatile("s_waitcnt lgkmcnt(0)" ::: "memory");
  char* stg = lds + wid * 8704;
#pragma unroll
  for (int r = 0; r < 16; ++r) {
    const int cr = crow(r, hi); const float rl = __builtin_amdgcn_rcpf(li_l[cr]);
#pragma unroll
    for (int d0 = 0; d0 < 4; ++d0) *reinterpret_cast<bf16_t*>(stg + cr * 272 + (d0 * 32 + r32) * 2) = f2bf(o[d0][r] * rl);
  }
  asm volatile("s_waitcnt lgkmcnt(0)" ::: "memory");
  const size_t t0 = (size_t)(token0 + wid * 32);
  gated_rows_out(stg, lane, Z1 + t0 * 1024 + h * 128, 1024, MIX + t0 * 1024 + h * 128, 1024);
  __syncthreads();
}

DEVI void abranch_item(int wv, const Params& p, int ci, char* lds) {
  const int tid = tidx(wv), wid = tid >> 6, lane = tid & 63, r32 = lane & 31, hi = lane >> 5;
  const bf16_t* GV = (const bf16_t*)(p.ws + OFF_GV); const bf16_t* U = (const bf16_t*)(p.ws + OFF_U); const bf16_t* ZA = (const bf16_t*)(p.ws + OFF_ZA);
  const bf16_t* WSB = (const bf16_t*)(p.ws + OFF_WSB); bf16_t* MIX = (bf16_t*)(p.ws + OFF_MIX);
  const int t0 = ci * 128;
  bf16_t* vnT = (bf16_t*)lds;
  {
    const int pos = tid >> 2, cp = tid & 3;
    const bf16_t* g = GV + (size_t)(t0 + pos) * 512;
    float s = 0.f, q = 0.f;
#pragma unroll 4
    for (int i = 0; i < 16; ++i) {
      const bf16x8 raw = *reinterpret_cast<const bf16x8*>(g + (i * 4 + cp) * 8);
#pragma unroll
      for (int e = 0; e < 8; ++e) { const float xv = bf2f((bf16_t)raw[e]); s += xv; q += xv * xv; }
    }
    s = xsum<1>(s); s = xsum<2>(s); q = xsum<1>(q); q = xsum<2>(q);
    const float mu = s * (1.f / 512.f);
    const float rstd = rsqrtf(fmaxf(q * (1.f / 512.f) - mu * mu, 0.f) + 1e-5f);
#pragma unroll 2
    for (int i = 0; i < 16; ++i) {
      const int c0 = (i * 4 + cp) * 8;
      const bf16x8 raw = *reinterpret_cast<const bf16x8*>(g + c0);
      const f32x4 w0 = *reinterpret_cast<const f32x4*>(p.a_ln_w + c0), w1 = *reinterpret_cast<const f32x4*>(p.a_ln_w + c0 + 4);
      const f32x4 b0 = *reinterpret_cast<const f32x4*>(p.a_ln_b + c0), b1 = *reinterpret_cast<const f32x4*>(p.a_ln_b + c0 + 4);
#pragma unroll
      for (int e = 0; e < 8; ++e) {
        const float wv = e < 4 ? w0[e & 3] : w1[e & 3], bv = e < 4 ? b0[e & 3] : b1[e & 3];
        vnT[(c0 + e) * 136 + pos] = f2bf((bf2f((bf16_t)raw[e]) - mu) * rstd * wv + bv);
      }
    }
  }
  __syncthreads();
  const int g8 = wid;
  const bf16_t* Wg = WSB + g8 * 128 * 128;
  f32x16 acc[4][2];
#pragma unroll
  for (int pb = 0; pb < 4; ++pb) {
#pragma unroll
    for (int r = 0; r < 16; ++r) { acc[pb][0][r] = 0.f; acc[pb][1][r] = 0.f; }
#pragma unroll
    for (int ks = 0; ks < 8; ++ks) {
      const bf16x8 bw = *reinterpret_cast<const bf16x8*>(Wg + (pb * 32 + r32) * 128 + ks * 16 + hi * 8);
#pragma unroll
      for (int db = 0; db < 2; ++db) {
        const bf16x8 a = *reinterpret_cast<const bf16x8*>(vnT + (g8 * 64 + db * 32 + r32) * 136 + ks * 16 + hi * 8);
        acc[pb][db] = __builtin_amdgcn_mfma_f32_32x32x16_bf16(a, bw, acc[pb][db], 0, 0, 0);
      }
    }
  }
  asm volatile("s_waitcnt lgkmcnt(0)" ::: "memory");
  char* stg = (char*)vnT + (size_t)g8 * 64 * 272;
#pragma unroll
  for (int pb = 0; pb < 4; ++pb) {
    const float bias = p.a_bs[g8 * 128 + pb * 32 + r32];
#pragma unroll
    for (int db = 0; db < 2; ++db)
#pragma unroll
      for (int rg = 0; rg < 4; ++rg) {
        u32x2 pk = {cvtpk(acc[pb][db][rg * 4 + 0] + bias, acc[pb][db][rg * 4 + 1] + bias), cvtpk(acc[pb][db][rg * 4 + 2] + bias, acc[pb][db][rg * 4 + 3] + bias)};
        *reinterpret_cast<u32x2*>(stg + (pb * 32 + r32) * 136 + (db * 32 + rg * 8 + hi * 4) * 2) = pk;
      }
  }
  asm volatile("s_waitcnt lgkmcnt(0)" ::: "memory");
#pragma unroll 4
  for (int i = 0; i < 16; ++i) {
    const int c = lane + 64 * i, row = c >> 3, ch = c & 7;
    const u32x2 s0 = *reinterpret_cast<const u32x2*>(stg + row * 136 + ch * 16), s1 = *reinterpret_cast<const u32x2*>(stg + row * 136 + ch * 16 + 8);
    const size_t gi = (size_t)(t0 + row) * 512 + g8 * 64 + ch * 8;
    const u32x4 uv = *reinterpret_cast<const u32x4*>(U + gi), zv = *reinterpret_cast<const u32x4*>(ZA + gi);
    const unsigned sv[4] = {s0[0], s0[1], s1[0], s1[1]};
    u32x4 ov;
#pragma unroll
    for (int e = 0; e < 4; ++e) ov[e] = cvtpk(bflo(uv[e]) * bflo(sv[e]) * bflo(zv[e]), bfhi(uv[e]) * bfhi(sv[e]) * bfhi(zv[e]));
    *reinterpret_cast<u32x4*>(MIX + (size_t)(t0 + row) * 1024 + g8 * 64 + ch * 8) = ov;
  }
  __syncthreads();
}

DEVI void tr_tile(int wv, const float* __restrict__ src, bf16_t* __restrict__ dst, int K, int N, int tilesN4, const float* __restrict__ scale, int t, char* lds) {
  const int tid = tidx(wv);
  const int k0 = (t / tilesN4) * 64, n0 = (t % tilesN4) * 256;
  const int kr = tid >> 3, ng = (tid & 7) * 8;
  f32x4 v0[4], v1[4];
#pragma unroll
  for (int u = 0; u < 4; ++u) {
    v0[u] = (f32x4){0.f, 0.f, 0.f, 0.f}; v1[u] = v0[u];
    if (n0 + u * 64 + ng < N) { const float* s = src + (size_t)(k0 + kr) * N + n0 + u * 64 + ng; v0[u] = *reinterpret_cast<const f32x4*>(s); v1[u] = *reinterpret_cast<const f32x4*>(s + 4); }
  }
  const float scv = scale ? scale[k0 + kr] : 1.f;
  bf16_t* tl = (bf16_t*)lds;
#pragma unroll
  for (int u = 0; u < 4; ++u)
#pragma unroll
    for (int e = 0; e < 4; ++e) { tl[u * 4608 + (ng + e) * 72 + kr] = f2bf(v0[u][e] * scv); tl[u * 4608 + (ng + 4 + e) * 72 + kr] = f2bf(v1[u][e] * scv); }
  __syncthreads();
  const int n = tid >> 3, kc = (tid & 7) * 8;
#pragma unroll
  for (int u = 0; u < 4; ++u)
    *reinterpret_cast<bf16x8*>(dst + (size_t)(n0 + u * 64 + n) * K + k0 + kc) = *reinterpret_cast<const bf16x8*>(tl + u * 4608 + n * 72 + kc);
}

DEVI void tr_item(int wv, const Params& p, int t, char* lds) {
  if (t < 224) tr_tile(wv, p.even_w_in, (bf16_t*)(p.ws + OFF_W0IN), 1024, 3584, 14, nullptr, t, lds);
  else if (t < 288) tr_tile(wv, p.even_w_out, (bf16_t*)(p.ws + OFF_W0OUT), 1024, 1024, 4, nullptr, t - 224, lds);
  else if (t < 384) tr_tile(wv, p.odd_w_in, (bf16_t*)(p.ws + OFF_W1IN), 1024, 1472, 6, nullptr, t - 288, lds);
  else if (t < 408) tr_tile(wv, p.c_wq_b, (bf16_t*)(p.ws + OFF_WQ), 256, 1536, 6, p.c_q_norm_w, t - 384, lds);
  else if (t < 424) tr_tile(wv, p.c_wkv_b, (bf16_t*)(p.ws + OFF_WKV), 128, 2048, 8, p.c_kv_norm_w, t - 408, lds);
  else tr_tile(wv, p.odd_w_out, (bf16_t*)(p.ws + OFF_W1OUT), 1024, 1024, 4, nullptr, t - 424, lds);
  __syncthreads();
}

DEVI void phase0(int wv, const Params& p, char* lds) {
  const int tid = tidx(wv);
  constexpr int N_ADA = 192, N_TR = 224, N_WS = 16;
  for (int it = blockIdx.x; it < N_ADA + N_TR + N_WS + 1; it += gridDim.x) {
    if (it < N_ADA) {
      const int li = it / 96, chunk = it % 96;
      float* sc = (float*)lds;
      for (int idx = tid; idx < 17 * 1024; idx += 512) { const int r = idx >> 10, k = idx & 1023; const float xv = r < 16 ? p.c[r * 1024 + k] : p.c_ctx[k]; sc[idx] = xv / (1.f + expf(-xv)); }
      __syncthreads();
      const int col = tid & 31, kp = tid >> 5;
      const float* w = p.ada_w + (size_t)li * 1024 * 3072 + chunk * 32 + col;
      float acc[17];
#pragma unroll
      for (int r = 0; r < 17; ++r) acc[r] = 0.f;
#pragma unroll 2
      for (int k = kp * 64; k < kp * 64 + 64; k += 4) {
        const float w0 = w[(size_t)k * 3072], w1 = w[(size_t)(k + 1) * 3072], w2 = w[(size_t)(k + 2) * 3072], w3 = w[(size_t)(k + 3) * 3072];
#pragma unroll
        for (int r = 0; r < 17; ++r) { const f32x4 s4 = *reinterpret_cast<const f32x4*>(sc + r * 1024 + k); acc[r] += s4[0] * w0 + s4[1] * w1 + s4[2] * w2 + s4[3] * w3; }
      }
      float* red = (float*)(lds + 17 * 1024 * 4);
#pragma unroll
      for (int r = 0; r < 17; ++r) red[(kp * 17 + r) * 32 + col] = acc[r];
      __syncthreads();
      float* ada = (float*)(p.ws + OFF_ADA);
      for (int idx = tid; idx < 544; idx += 512) {
        const int r = idx >> 5, cc = idx & 31; float s = 0.f;
        for (int k2 = 0; k2 < 16; ++k2) s += red[(k2 * 17 + r) * 32 + cc];
        ada[(size_t)(li * 17 + r) * 3072 + chunk * 32 + cc] = s + p.ada_b[li * 3072 + chunk * 32 + cc];
      }
    } else if (it < N_ADA + N_TR) {
      tr_tile(wv, p.even_w_in, (bf16_t*)(p.ws + OFF_W0IN), 1024, 3584, 14, nullptr, it - N_ADA, lds);
    } else if (it < N_ADA + N_TR + N_WS) {
      const int base = (it - N_ADA - N_TR) * 8192 + tid * 16;
      bf16_t* dst = (bf16_t*)(p.ws + OFF_WSB) + base; const float* s = p.a_ws + base;
#pragma unroll
      for (int q = 0; q < 2; ++q) {
        const f32x4 a = *reinterpret_cast<const f32x4*>(s + q * 8), b = *reinterpret_cast<const f32x4*>(s + q * 8 + 4);
        u32x4 w = {cvtpk(a[0], a[1]), cvtpk(a[2], a[3]), cvtpk(b[0], b[1]), cvtpk(b[2], b[3])};
        *reinterpret_cast<u32x4*>(dst + q * 8) = w;
      }
    } else {
      float2* tab = (float2*)(p.ws + OFF_ROPE);
      for (int e = tid; e < 1024; e += 512) {
        const int pos = e >> 4, j = e & 15;
        const float inv = exp2f(-(float)j * (13.287712379549449f / 16.f));
        const float ang = (float)pos * inv;
        const float nrev = rintf(ang * 0.15915494309189535f);
        float rr = fmaf(-nrev, 6.2831855f, ang); rr = fmaf(-nrev, -1.7484555e-7f, rr);
        tab[e] = make_float2(__cosf(rr), __sinf(rr));
      }
    }
    __syncthreads();
  }
}

template <bool RES>
DEVI void norm_mod(int wv, const float* src_lat, const float* src_ctx, const float* __restrict__ nw, const float* __restrict__ ada, bf16_t* X,
                   int row_lo, int row_hi, int vb, int nvb, const float* __restrict__ ada_prev = nullptr, float* hdst_lat = nullptr, float* hdst_ctx = nullptr) {
  const int tid_ = tidx(wv); const int wid = tid_ >> 6, lane = tid_ & 63;
  for (int row0 = row_lo + (vb * 8 + wid) * 2; row0 < row_hi; row0 += nvb * 16) {
    f32x4 v[2][4]; u32x2 ov[2][4]; float ss[2];
#pragma unroll
    for (int q = 0; q < 2; ++q) {
      const int row = row0 + q;
      const float* src = row < NLAT ? src_lat + (size_t)row * 1024 : src_ctx + (size_t)(row - NLAT) * 1024;
      ss[q] = 0.f;
#pragma unroll
      for (int i = 0; i < 4; ++i) {
        v[q][i] = __builtin_nontemporal_load(reinterpret_cast<const f32x4*>(src + i * 256 + lane * 4));
        if constexpr (RES) ov[q][i] = *reinterpret_cast<const u32x2*>(X + (size_t)row * 1024 + i * 256 + lane * 4);
      }
    }
    if constexpr (RES) {
#pragma unroll
      for (int q = 0; q < 2; ++q) {
        const int row = row0 + q;
        const float* gp = ada_prev + (row < NLAT ? (row >> 11) : 16) * 3072 + 2048;
        float* hd = row < NLAT ? hdst_lat + (size_t)row * 1024 : hdst_ctx + (size_t)(row - NLAT) * 1024;
#pragma unroll
        for (int i = 0; i < 4; ++i) {
          const int c = i * 256 + lane * 4;
          const f32x4 g = *reinterpret_cast<const f32x4*>(gp + c);
          v[q][i][0] += g[0] * bflo(ov[q][i][0]); v[q][i][1] += g[1] * bfhi(ov[q][i][0]); v[q][i][2] += g[2] * bflo(ov[q][i][1]); v[q][i][3] += g[3] * bfhi(ov[q][i][1]);
          __builtin_nontemporal_store(v[q][i], reinterpret_cast<f32x4*>(hd + c));
        }
      }
    }
#pragma unroll
    for (int q = 0; q < 2; ++q) {
#pragma unroll
      for (int i = 0; i < 4; ++i) ss[q] += v[q][i][0] * v[q][i][0] + v[q][i][1] * v[q][i][1] + v[q][i][2] * v[q][i][2] + v[q][i][3] * v[q][i][3];
      ss[q] = wave_sum(ss[q]);
    }
#pragma unroll
    for (int q = 0; q < 2; ++q) {
      const int row = row0 + q;
      const float* ad = ada + (row < NLAT ? (row >> 11) : 16) * 3072;
      const float r = rsqrtf(ss[q] * (1.f / 1024.f) + 1e-6f);
#pragma unroll
      for (int i = 0; i < 4; ++i) {
        const int c = i * 256 + lane * 4;
        const f32x4 w = *reinterpret_cast<const f32x4*>(nw + c), sh = *reinterpret_cast<const f32x4*>(ad + c), scl = *reinterpret_cast<const f32x4*>(ad + 1024 + c);
        float o[4];
#pragma unroll
        for (int e = 0; e < 4; ++e) o[e] = v[q][i][e] * r * w[e] * (1.f + scl[e]) + sh[e];
        u32x2 pk = {cvtpk(o[0], o[1]), cvtpk(o[2], o[3])};
        *reinterpret_cast<u32x2*>(X + (size_t)row * 1024 + c) = pk;
      }
    }
  }
}

DEVI void final_norm(int wv, float* out, const float* __restrict__ fw, const bf16_t* __restrict__ O1, const float* __restrict__ ada1) {
  const int tid_ = tidx(wv); const int wid = tid_ >> 6, lane = tid_ & 63;
  for (int row0 = (blockIdx.x * 8 + wid) * 2; row0 < NLAT; row0 += gridDim.x * 16) {
    f32x4 v[2][4]; u32x2 ov[2][4]; float ss[2];
#pragma unroll
    for (int q = 0; q < 2; ++q) {
      ss[q] = 0.f;
#pragma unroll
      for (int i = 0; i < 4; ++i) {
        v[q][i] = __builtin_nontemporal_load(reinterpret_cast<const f32x4*>(out + (size_t)(row0 + q) * 1024 + i * 256 + lane * 4));
        ov[q][i] = *reinterpret_cast<const u32x2*>(O1 + (size_t)(row0 + q) * 1024 + i * 256 + lane * 4);
      }
    }
#pragma unroll
    for (int q = 0; q < 2; ++q) {
      const float* gp = ada1 + ((row0 + q) >> 11) * 3072 + 2048;
#pragma unroll
      for (int i = 0; i < 4; ++i) {
        const f32x4 g = *reinterpret_cast<const f32x4*>(gp + i * 256 + lane * 4);
        v[q][i][0] += g[0] * bflo(ov[q][i][0]); v[q][i][1] += g[1] * bfhi(ov[q][i][0]); v[q][i][2] += g[2] * bflo(ov[q][i][1]); v[q][i][3] += g[3] * bfhi(ov[q][i][1]);
        ss[q] += v[q][i][0] * v[q][i][0] + v[q][i][1] * v[q][i][1] + v[q][i][2] * v[q][i][2] + v[q][i][3] * v[q][i][3];
      }
      ss[q] = wave_sum(ss[q]);
    }
#pragma unroll
    for (int q = 0; q < 2; ++q) {
      const float r = rsqrtf(ss[q] * (1.f / 1024.f) + 1e-6f);
#pragma unroll
      for (int i = 0; i < 4; ++i) {
        const int c = i * 256 + lane * 4;
        const f32x4 w = *reinterpret_cast<const f32x4*>(fw + c);
        __builtin_nontemporal_store(v[q][i] * r * w, reinterpret_cast<f32x4*>(out + (size_t)(row0 + q) * 1024 + c));
      }
    }
  }
}

typedef const __attribute__((address_space(4))) Params* KArgP;
DEVI void run_phase(int wv, KArgP pp, int ph, char* lds) {
#if defined(__HIP_DEVICE_COMPILE__)
  asm volatile("" : "+s"(pp));
  char* ws = pp->ws;
  const float2* rope = (const float2*)(ws + OFF_ROPE);
  const float* ada0 = (const float*)(ws + OFF_ADA); const float* ada1 = ada0 + 17 * 3072;
  bf16_t* X = (bf16_t*)(ws + OFF_X); bf16_t* MIX = (bf16_t*)(ws + OFF_MIX);
  const int G = gridDim.x, B = blockIdx.x;
  PG8_LAS unsigned char* ldsp = (PG8_LAS unsigned char*)lds;
  switch (ph) {
    case 0: { const Params p = *pp; phase0(wv, p, lds); } break;
    case 1: norm_mod<false>(wv, pp->x, pp->ctx, pp->norm_w, ada0, X, 0, NTOK, B, G); break;
    case 2: {
      EpiL0In epi{(bf16_t*)(ws + OFF_U), (bf16_t*)(ws + OFF_GV), (bf16_t*)(ws + OFF_ZA), (bf16_t*)(ws + OFF_ZB), (bf16_t*)(ws + OFF_Q0), (bf16_t*)(ws + OFF_K0), (bf16_t*)(ws + OFF_V0), rope};
      gemm_phase(wv, ldsp, X, (const bf16_t*)(ws + OFF_W0IN), 1024, Sched{14, 144 * 14, 144 * 14, 0, 0}, epi);
    } break;
    case 3: { const Params p = *pp;
      for (int it = B; it < 1024 + 288 + 128; it += G) {
        if (it < 1024) {
          const int xcd = it & 7, slot = (it >> 3) & 31, rd = it >> 8;
          const int bh = rd * 16 + xcd * 2 + (slot >> 4), qb = slot & 15, b = bh >> 2, h = bh & 3;
          attn0_item(wv, p, b * 2048 + qb * 128, b, h, KVL, lds);
        } else if (it < 1024 + 288) abranch_item(wv, p, it - 1024, lds);
        else { const int i2 = it - 1312; const int b = i2 >> 3, h = (i2 >> 1) & 3, qb = i2 & 1; attn0_item(wv, p, NLAT + b * 256 + qb * 128, b, h, 256, lds); }
      }
      {
        const int nb = G >= 192 ? 96 : G, base = G - nb;
        if (B >= base) for (int t = 224 + (B - base); t < 288; t += nb) tr_item(wv, p, t, lds);
      }
    } break;
    case 4: {
      EpiPlain epi{X};
      gemm_phase(wv, ldsp, MIX, (const bf16_t*)(ws + OFF_W0OUT), 1024, Sched{4, 144 * 4, 144 * 4, 0, 0}, epi);
      {
        const Params p = *pp; const int nb = G > 64 ? G - 64 : G, base = G - nb;
        if (B >= base) for (int t = 288 + (B - base); t < 488; t += nb) tr_item(wv, p, t, lds);
      }
    } break;
    case 5: {
      if (B >= G - 16) {
        const int cp = B - (G - 16);
        norm_mod<true>(wv, pp->x, pp->ctx, pp->norm_w + 1024, ada1, X, NLAT + cp * 256, NLAT + cp * 256 + 256, 0, 1, ada0, pp->out, (float*)(ws + OFF_H1C));
        asm volatile("s_waitcnt vmcnt(0)" ::: "memory"); __syncthreads();
        EpiL1In epi{(bf16_t*)(ws + OFF_CQ), (bf16_t*)(ws + OFF_CKV), (bf16_t*)(ws + OFF_K1), (bf16_t*)(ws + OFF_Z1), (float*)(ws + OFF_RQ), (float*)(ws + OFF_RKV), rope, (float*)(lds + LDS_SS)};
        gemm_phase(wv, ldsp, X, (const bf16_t*)(ws + OFF_W1IN), 1024, Sched{6, 0, 16, 128, 1, G - 16}, epi);
      } else norm_mod<true>(wv, pp->x, pp->ctx, pp->norm_w + 1024, ada1, X, 0, NLAT, B, G - 16, ada0, pp->out, (float*)(ws + OFF_H1C));
    } break;
    case 6: {
      EpiL1In epi{(bf16_t*)(ws + OFF_CQ), (bf16_t*)(ws + OFF_CKV), (bf16_t*)(ws + OFF_K1), (bf16_t*)(ws + OFF_Z1), (float*)(ws + OFF_RQ), (float*)(ws + OFF_RKV), rope, (float*)(lds + LDS_SS)};
      gemm_phase(wv, ldsp, X, (const bf16_t*)(ws + OFF_W1IN), 1024, Sched{6, 768, 768, 128, 1}, epi);
    } break;
    case 7: {
      EpiQ eq{(bf16_t*)(ws + OFF_Q1), (const float*)(ws + OFF_RQ), rope};
      EpiKV ek{(bf16_t*)(ws + OFF_K1), (bf16_t*)(ws + OFF_V1), (const float*)(ws + OFF_RKV)};
      gemm_phase(wv, ldsp, (const bf16_t*)(ws + OFF_CQ), (const bf16_t*)(ws + OFF_WQ), 256, Sched{6, 768, 768, 0, 0}, eq);
      gemm_phase(wv, ldsp, (const bf16_t*)(ws + OFF_CKV), (const bf16_t*)(ws + OFF_WKV), 128, Sched{8, 1152, 1152, 0, 0}, ek);
    } break;
    case 8: { const Params p = *pp;
      for (int it = B; it < 1024; it += G) {
        const int xcd = it & 7, slot = (it >> 3) & 31, rd = it >> 8;
        const int bh = rd * 32 + xcd * 4 + (slot >> 3), qb = slot & 7;
        attn1_item(wv, p, bh >> 3, bh & 7, qb, lds);
      }
    } break;
    case 9: {
      EpiPlain epi{X};
      gemm_phase(wv, ldsp, MIX, (const bf16_t*)(ws + OFF_W1OUT), 1024, Sched{4, 128 * 4, 128 * 4, 0, 0}, epi);
    } break;
    case 10: final_norm(wv, pp->out, pp->final_w, X, ada1); break;
  }
#endif
}


#define XB_TMO      128
#define XB_XCNT(j)  (256  + 64 * (j))
#define XB_XSUB(j)  (1280 + 64 * (j))
#define XB_XGEN(j)  (2304 + 64 * (j))
#define XB_TOP      3328
#define XB_TOPGEN   3392
#define XCD_BAR_WORDS 3456
#define XB_SPIN_CAP (1u << 18)
#define LAS __attribute__((address_space(3)))
DEVI unsigned xb_ld(unsigned* p) { return __hip_atomic_load(p, __ATOMIC_RELAXED, __HIP_MEMORY_SCOPE_AGENT); }
DEVI unsigned xb_add(unsigned* p, unsigned v) { return __hip_atomic_fetch_add(p, v, __ATOMIC_RELAXED, __HIP_MEMORY_SCOPE_AGENT); }
DEVI unsigned xb_xcc_id() { return (unsigned)__builtin_amdgcn_s_getreg((3 << 11) | 20) & 0xFu; }
#define XB_SPIN(cond, bar) do { unsigned _sp = 0; while (cond) { __builtin_amdgcn_s_sleep(1); \
    if ((++_sp & 255u) == 0u) { if (xb_ld(&(bar)[XB_TMO])) break; if (_sp > XB_SPIN_CAP) { atomicAdd(&(bar)[XB_TMO], 1u); break; } } } } while (0)
struct XcdBarrier { unsigned* bar; unsigned x; volatile LAS unsigned* st; };
DEVI XcdBarrier xcd_barrier_post(int wv, unsigned* bar, volatile LAS unsigned* st) {
  XcdBarrier b; b.bar = bar; b.x = xb_xcc_id(); b.st = st;
  if (tidx(wv) == 0) (void)xb_add(&bar[XB_XCNT(b.x)], 1u);
  return b;
}
DEVI void xcd_barrier_complete(unsigned* bar, unsigned x, unsigned& nloc, unsigned& nx) {
  const unsigned G = gridDim.x * gridDim.y * gridDim.z;
  unsigned sum, cnt, mine, sp = 0u;
  for (;;) {
    sum = 0u; cnt = 0u; mine = 0u;
#pragma unroll
    for (unsigned j = 0; j < 16; ++j) { const unsigned c = xb_ld(&bar[XB_XCNT(j)]); sum += c; cnt += (c > 0u) ? 1u : 0u; mine = (j == x) ? c : mine; }
    if (sum == G) break;
    __builtin_amdgcn_s_sleep(1);
    if ((++sp & 255u) == 0u) { if (xb_ld(&bar[XB_TMO])) break; if (sp > XB_SPIN_CAP) { atomicAdd(&bar[XB_TMO], 1u); break; } }
  }
  nloc = mine > 0u ? mine : 1u; nx = cnt > 0u ? cnt : 1u;
}
DEVI void xcd_barrier(int wv, const XcdBarrier& b) {
  asm volatile("s_waitcnt vmcnt(0)" ::: "memory");
  __syncthreads();
  if (tidx(wv) == 0) {
    unsigned* bar = b.bar;
    __builtin_amdgcn_s_waitcnt(0);
    unsigned nloc = b.st[0], nx = b.st[1];
    if (nloc == 0u) { xcd_barrier_complete(bar, b.x, nloc, nx); b.st[0] = nloc; b.st[1] = nx; }
    const unsigned old = xb_add(&bar[XB_XSUB(b.x)], 1u);
    const unsigned gen = old / nloc;
    if (old + 1u == (gen + 1u) * nloc) {
      __builtin_amdgcn_fence(__ATOMIC_RELEASE, "agent");
      asm volatile("s_waitcnt vmcnt(0)" ::: "memory");
      const unsigned og = xb_add(&bar[XB_TOP], 1u);
      const unsigned tg = og / nx;
      if (og + 1u == (tg + 1u) * nx) xb_add(&bar[XB_TOPGEN], 1u);
      else XB_SPIN(xb_ld(&bar[XB_TOPGEN]) == tg, bar);
      __builtin_amdgcn_fence(__ATOMIC_ACQUIRE, "agent");
      xb_add(&bar[XB_XGEN(b.x)], 1u);
      asm volatile("s_waitcnt vmcnt(0)" ::: "memory");
    } else {
      XB_SPIN(xb_ld(&bar[XB_XGEN(b.x)]) == gen, bar);
      __builtin_amdgcn_fence(__ATOMIC_ACQUIRE, "agent");
      asm volatile("s_waitcnt vmcnt(0)" ::: "memory");
    }
  }
  __syncthreads();
}

extern __shared__ __attribute__((aligned(16))) char g_lds[];

constexpr int LDS_XB = 143360;
__global__ void __launch_bounds__(512) mega(Params p) {
  cg::grid_group grid = cg::this_grid();
  if (p.ph_hi > 64) grid.sync();
  const int wv = __builtin_amdgcn_readfirstlane((int)threadIdx.x >> 6);
  volatile LAS unsigned* xst = (volatile LAS unsigned*)(g_lds + LDS_XB);
  if (tidx(wv) == 0) { xst[0] = 0u; xst[1] = 0u; }
  __syncthreads();
  (void)xcd_barrier_post(wv, (unsigned*)(p.ws + OFF_BAR), xst);
#define GRID_BARRIER() do { KArgP _pp = (KArgP)__builtin_amdgcn_kernarg_segment_ptr(); asm volatile("" : "+s"(_pp)); \
    XcdBarrier _xb; _xb.bar = (unsigned*)(_pp->ws + OFF_BAR); _xb.x = xb_xcc_id(); _xb.st = (volatile LAS unsigned*)(g_lds + LDS_XB); xcd_barrier(wv, _xb); } while (0)
  for (int ph = p.ph_lo; ph < p.ph_hi; ++ph) {
    run_phase(wv, (KArgP)__builtin_amdgcn_kernarg_segment_ptr(), ph, g_lds);
#ifdef PROBE_PH
    if (ph == PROBE_PH) { GRID_BARRIER(); run_phase(wv, (KArgP)__builtin_amdgcn_kernarg_segment_ptr(), ph, g_lds); }
#endif
    if (ph + 1 < p.ph_hi) GRID_BARRIER();
  }
}

extern "C" void kernel_launch(void* const* d_in, const int* in_sizes, int n_in, void* d_out, int out_size, void* d_ws, size_t ws_size, hipStream_t stream) {
  static int ok = 0;
  static int grid_blocks = 0;
  if (!ok) {
    if (n_in != 25 || ws_size < WS_NEED) { fprintf(stderr, "kernel_launch: bad args n_in %d ws %zu need %zu\n", n_in, ws_size, (size_t)WS_NEED); return; }
    if (hipFuncSetAttribute((const void*)mega, hipFuncAttributeMaxDynamicSharedMemorySize, LDS_BYTES) != hipSuccess) { fprintf(stderr, "kernel_launch: LDS attr failed\n"); return; }
    int dev = 0, cus = 0, per_cu = 0;
    hipGetDevice(&dev);
    hipDeviceGetAttribute(&cus, hipDeviceAttributeMultiprocessorCount, dev);
    hipOccupancyMaxActiveBlocksPerMultiprocessor(&per_cu, mega, 512, LDS_BYTES);
    if (per_cu < 1) per_cu = 1;
    grid_blocks = cus * per_cu;
    ok = 1;
  }
  Params p{};
  const float** pp = (const float**)&p;
  for (int i = 0; i < 25; ++i) pp[i] = (const float*)d_in[i];
  p.out = (float*)d_out; p.ws = (char*)d_ws;
#if ONE_LAUNCH
  p.ph_lo = 0; p.ph_hi = 11;
  hipMemsetAsync((char*)d_ws + OFF_BAR, 0, XCD_BAR_WORDS * 4, stream);
  void* args[] = {&p};
  hipError_t e = hipLaunchCooperativeKernel((const void*)mega, dim3(grid_blocks), dim3(512), args, LDS_BYTES, stream);
  if (e != hipSuccess) fprintf(stderr, "cooperative launch failed: %s (grid %d)\n", hipGetErrorString(e), grid_blocks);
#else
  for (int ph = 0; ph < 11; ++ph) {
    p.ph_lo = ph; p.ph_hi = ph + 1;
    hipLaunchKernelGGL(mega, dim3(grid_blocks), dim3(512), LDS_BYTES, stream, p);
  }
#endif
}
```

```cpp
#include <hip/hip_runtime.h>
#include <hip/hip_cooperative_groups.h>
#include <cstdio>
namespace cg = cooperative_groups;

#ifndef ATT_SD0
#define ATT_SD0 2
#endif
#ifndef ONE_LAUNCH
#define ONE_LAUNCH 1
#endif

typedef unsigned short bf16_t;
typedef short bf16x8 __attribute__((ext_vector_type(8)));
typedef short s16x4 __attribute__((ext_vector_type(4)));
typedef float f32x16 __attribute__((ext_vector_type(16)));
typedef float f32x4 __attribute__((ext_vector_type(4)));
typedef unsigned u32x4 __attribute__((ext_vector_type(4)));
typedef unsigned u32x2 __attribute__((ext_vector_type(2)));
#define DEVI __device__ __forceinline__
#define SBAR() __builtin_amdgcn_sched_barrier(0)
DEVI int tidx(int wv) { int l; asm volatile("v_mbcnt_lo_u32_b32 %0, -1, 0\n\tv_mbcnt_hi_u32_b32 %0, -1, %0" : "=v"(l)); return (wv << 6) | l; }

constexpr int NLAT = 32768, NCTX = 4096, NTOK = 36864, KVL = 2304;
constexpr int LDS_BYTES = 147456, LDS_SS = 139264;

constexpr size_t OFF_W0IN = 0;
constexpr size_t OFF_W0OUT = OFF_W0IN + 3584ull * 1024 * 2;
constexpr size_t OFF_W1IN = OFF_W0OUT + 1024ull * 1024 * 2;
constexpr size_t OFF_WQ = OFF_W1IN + 1536ull * 1024 * 2;
constexpr size_t OFF_WKV = OFF_WQ + 1536ull * 256 * 2;
constexpr size_t OFF_W1OUT = OFF_WKV + 2048ull * 128 * 2;
constexpr size_t OFF_WSB = OFF_W1OUT + 1024ull * 1024 * 2;
constexpr size_t OFF_ADA = OFF_WSB + 8ull * 128 * 128 * 2;
constexpr size_t OFF_ROPE = OFF_ADA + 2ull * 17 * 3072 * 4;
constexpr size_t OFF_BAR = OFF_ROPE + 64ull * 16 * 8;
constexpr size_t OFF_H1C = OFF_BAR + 16384;
constexpr size_t OFF_RQ = OFF_H1C + 4096ull * 1024 * 4;
constexpr size_t OFF_RKV = OFF_RQ + 32768ull * 4;
constexpr size_t OFF_X = OFF_RKV + 36864ull * 4;
constexpr size_t OFF_MIX = OFF_X + 36864ull * 1024 * 2;
constexpr size_t OFF_T = OFF_MIX + 36864ull * 1024 * 2;
constexpr size_t SZ_HALF = 36864ull * 512 * 2;
constexpr size_t OFF_U = OFF_T, OFF_GV = OFF_U + SZ_HALF, OFF_ZA = OFF_GV + SZ_HALF, OFF_ZB = OFF_ZA + SZ_HALF, OFF_Q0 = OFF_ZB + SZ_HALF;
constexpr size_t OFF_K0 = OFF_Q0 + SZ_HALF, OFF_V0 = OFF_K0 + 16ull * 4 * KVL * 128 * 2, END_L0 = OFF_V0 + 16ull * 4 * KVL * 128 * 2;
constexpr size_t OFF_CQ = OFF_T, OFF_CKV = OFF_CQ + 32768ull * 256 * 2, OFF_Z1 = OFF_CKV + 36864ull * 128 * 2;
constexpr size_t OFF_Q1 = OFF_Z1 + 32768ull * 1024 * 2, OFF_K1 = OFF_Q1 + 32768ull * 1536 * 2, END_L1 = OFF_K1 + 16ull * 8 * KVL * 192 * 2;
constexpr size_t OFF_V1 = OFF_X;
constexpr size_t WS_NEED = END_L1 > END_L0 ? END_L1 : END_L0;

struct Params {
  const float *x, *c, *ctx, *c_ctx, *norm_w, *ada_w, *ada_b, *even_w_in, *a_ws, *a_bs, *a_ln_w, *a_ln_b,
      *b_lq1, *b_lk1, *b_lq2, *b_lk2, *b_subln_w, *even_w_out, *odd_w_in, *c_q_norm_w, *c_wq_b,
      *c_kv_norm_w, *c_wkv_b, *odd_w_out, *final_w;
  float* out; char* ws; int ph_lo, ph_hi;
};

DEVI unsigned cvtpk(float lo, float hi) { unsigned r; asm("v_cvt_pk_bf16_f32 %0, %1, %2" : "=v"(r) : "v"(lo), "v"(hi)); return r; }
DEVI bf16_t f2bf(float v) { return (bf16_t)(cvtpk(v, 0.f) & 0xffffu); }
DEVI float bf2f(bf16_t v) { return __uint_as_float(((unsigned)v) << 16); }
DEVI float bflo(unsigned w) { return __uint_as_float(w << 16); }
DEVI float bfhi(unsigned w) { return __uint_as_float(w & 0xffff0000u); }
DEVI int crow(int r, int hi) { return (r & 3) + 8 * (r >> 2) + 4 * hi; }
DEVI float silu_f(float x) { return x * __builtin_amdgcn_rcpf(1.f + __builtin_amdgcn_exp2f(x * -1.4426950408889634f)); }
DEVI float gelu_f(float v) {
  const float t = __builtin_amdgcn_rcpf(fmaf(fabsf(v), 0.2316418882f, 1.0f));
  float q = fmaf(t, 0.5307027145f, -0.7265760135f); q = fmaf(q, t, 0.7107068705f); q = fmaf(q, t, -0.142248368f); q = fmaf(q, t, 0.127414796f); q *= t;
  const float m = v * (q * __builtin_amdgcn_exp2f(v * v * -0.72134752044f));
  return v < 0.f ? m : v - m;
}

template <int M> DEVI float xsum(float v) {
  if constexpr (M == 32) { auto rr = __builtin_amdgcn_permlane32_swap(__float_as_uint(v), __float_as_uint(v), false, false); return __uint_as_float(rr[0]) + __uint_as_float(rr[1]); }
  else return v + __int_as_float(__builtin_amdgcn_ds_swizzle(__float_as_int(v), (M << 10) | 0x1f));
}
DEVI float wave_sum(float v) { v = xsum<1>(v); v = xsum<2>(v); v = xsum<4>(v); v = xsum<8>(v); v = xsum<16>(v); return xsum<32>(v); }

DEVI void rope_tile(f32x16& v, const float2* __restrict__ tab, int pos, int hi) {
#pragma unroll
  for (int r = 0; r < 8; ++r) {
    const int jf = (r & 3) + 8 * (r >> 2) + 4 * hi;
    const float2 cs = tab[pos * 16 + jf];
    const float a = v[r], b = v[r + 8];
    v[r] = a * cs.x - b * cs.y; v[r + 8] = b * cs.x + a * cs.y;
  }
}
DEVI void store4(bf16_t* dst, const f32x16& v, int rg) {
  u32x2 pk = {cvtpk(v[rg * 4 + 0], v[rg * 4 + 1]), cvtpk(v[rg * 4 + 2], v[rg * 4 + 3])};
  *reinterpret_cast<u32x2*>(dst) = pk;
}

#define PG8_LAS __attribute__((address_space(3)))
constexpr int HTB = 128 * 64 * 2;
DEVI int lds_byte(int r, int c) { const int st = (r >> 4) * 2 + (c >> 5), rr = r & 15, cc = c & 31, ob = rr * 64 + cc * 2; return st * 1024 + (ob ^ (((ob >> 9) & 1) << 5)); }
DEVI void stage_rc(int b, int& R, int& C) { const int st = b / 1024, sb = b % 1024, swz = sb ^ (((sb >> 9) & 1) << 5); R = (st >> 1) * 16 + swz / 64; C = (st & 1) * 32 + (swz % 64) / 2; }
DEVI int perm32(int rho) { const int n = rho >> 4, i = rho & 15; return 8 * (i >> 2) + 4 * n + (i & 3); }
struct Unit { int pm, pn; };
struct Sched {
  int nN, nmain, ntotal, xpm0, xpn, boff = 0;
  DEVI bool next(int i, Unit& u) const {
    const int it = (int)blockIdx.x - boff + i * (int)gridDim.x; if (it < 0 || it >= ntotal) return false;
    if (it < nmain) { const int xcd = it & 7, jx = it >> 3; u.pm = (jx / nN) * 8 + xcd; u.pn = jx % nN; } else { u.pm = xpm0 + (it - nmain); u.pn = xpn; }
    return true;
  }
};
template <class Epi>
DEVI void gemm_phase(int wv, PG8_LAS unsigned char* lds, const bf16_t* gA, const bf16_t* gBt, const int K, const Sched& S, const Epi& E) {
  const int tid = tidx(wv), wid = __builtin_amdgcn_readfirstlane(tid >> 6), lane = tid & 63, wr = wid >> 2, wc = wid & 3, fr = lane & 15, fq = lane >> 4;
  const int nt = K / 64;
  unsigned voffA[2], voffB[2];
#pragma unroll
  for (int i = 0; i < 2; ++i) { int R, C; stage_rc(tid * 16 + i * 8192, R, C); const int Rb = (R & ~31) + perm32(R & 31); voffA[i] = (unsigned)(R * K + C) * 2u; voffB[i] = (unsigned)(Rb * K + C) * 2u; }
  const size_t kstep = (size_t)(64 * 2);
  const size_t hstep = (size_t)128 * K * 2;
  const size_t tstep = 2 * hstep;
  const unsigned ldsw = (unsigned)wid * 1024u;
  const int aoff = lds_byte(wr * 64 + fr, fq * 8), boff = lds_byte(wc * 32 + fr, fq * 8);
#define PG8_SA(b, h) (((b) * 2 + (h)) * HTB)
#define PG8_SB(b, h) ((4 + (b) * 2 + (h)) * HTB)
#define PG8_STAGE(bufoff, gbase, voff) do { _Pragma("unroll") for (int _i = 0; _i < 2; ++_i) \
    __builtin_amdgcn_global_load_lds((const unsigned*)((const char*)(gbase) + (voff)[_i]), (PG8_LAS unsigned*)(lds + (bufoff) + ldsw + _i * 8192), 16, 0, 0); } while (0)
#define PG8_LDA(dst, b, h) do { _Pragma("unroll") for (int m = 0; m < 4; ++m) _Pragma("unroll") for (int k = 0; k < 2; ++k) dst[m][k] = *(const PG8_LAS bf16x8*)(lds + PG8_SA(b, h) + aoff + m * 2048 + k * 1024); } while (0)
#define PG8_LDB(dst, b, h) do { _Pragma("unroll") for (int n = 0; n < 2; ++n) _Pragma("unroll") for (int k = 0; k < 2; ++k) dst[n][k] = *(const PG8_LAS bf16x8*)(lds + PG8_SB(b, h) + boff + n * 2048 + k * 1024); } while (0)
#define PG8_MMA(ai, bj, At, Bt) do { __builtin_amdgcn_s_setprio(1); _Pragma("unroll") for (int m = 0; m < 4; ++m) _Pragma("unroll") for (int n = 0; n < 2; ++n) _Pragma("unroll") for (int k = 0; k < 2; ++k) \
    acc[ai][bj][m][n] = __builtin_amdgcn_mfma_f32_16x16x32_bf16(Bt[n][k], At[m][k], acc[ai][bj][m][n], 0, 0, 0); __builtin_amdgcn_s_setprio(0); } while (0)
#define PG8_WAIT_V(n) asm volatile("s_waitcnt vmcnt(" #n ")" ::: "memory")
#define PG8_WAIT_L(n) asm volatile("s_waitcnt lgkmcnt(" #n ")" ::: "memory")
#define PG8_BAR __builtin_amdgcn_s_barrier()
#define PG8_SCHED __builtin_amdgcn_sched_barrier(0)
  Unit cur, nxt; int ui = 0;
  if (!S.next(0, cur)) return;
  f32x4 acc[2][2][4][2];
#pragma unroll
  for (int a = 0; a < 2; ++a)
#pragma unroll
    for (int b = 0; b < 2; ++b)
#pragma unroll
      for (int m = 0; m < 4; ++m)
#pragma unroll
        for (int n = 0; n < 2; ++n) acc[a][b][m][n] = (f32x4){0.f, 0.f, 0.f, 0.f};
  bf16x8 At[4][2], B0[2][2], B1[2][2];
  const char* cA = (const char*)gA + (size_t)cur.pm * tstep; const char* cB = (const char*)gBt + (size_t)cur.pn * tstep;
  PG8_STAGE(PG8_SB(0, 0), cB, voffB); PG8_STAGE(PG8_SA(0, 0), cA, voffA); PG8_STAGE(PG8_SB(0, 1), cB + hstep, voffB); PG8_STAGE(PG8_SA(0, 1), cA + hstep, voffA);
  if (wr == 1) PG8_BAR;
  PG8_WAIT_V(4); PG8_BAR;
  PG8_STAGE(PG8_SB(1, 0), cB + kstep, voffB); PG8_STAGE(PG8_SA(1, 0), cA + kstep, voffA); PG8_STAGE(PG8_SB(1, 1), cB + hstep + kstep, voffB);
  PG8_WAIT_V(6); PG8_BAR;
  for (;;) {
    const bool has_next = S.next(ui + 1, nxt);
    const char* nA = has_next ? (const char*)gA + (size_t)nxt.pm * tstep : cA; const char* nB = has_next ? (const char*)gBt + (size_t)nxt.pn * tstep : cB;
#pragma unroll 1
    for (int t = 0; t < nt; t += 2) {
      const bool last = (t == nt - 2);
      const char* a1 = cA + (size_t)(t + 1) * kstep;
      const char* a2 = last ? nA : cA + (size_t)(t + 2) * kstep; const char* b2 = last ? nB : cB + (size_t)(t + 2) * kstep;
      const char* a3 = a2 + kstep; const char* b3 = b2 + kstep;
      PG8_LDB(B0, 0, 0); PG8_SCHED; PG8_LDA(At, 0, 0); PG8_STAGE(PG8_SA(1, 1), a1 + hstep, voffA);
      PG8_WAIT_L(8); PG8_BAR; PG8_WAIT_L(0); PG8_MMA(0, 0, At, B0); PG8_BAR; PG8_SCHED;
      PG8_LDB(B1, 0, 1); PG8_STAGE(PG8_SB(0, 0), b2, voffB);
      PG8_BAR; PG8_WAIT_L(0); PG8_MMA(0, 1, At, B1); PG8_BAR;
      PG8_LDA(At, 0, 1); PG8_STAGE(PG8_SA(0, 0), a2, voffA);
      PG8_BAR; PG8_WAIT_L(0); PG8_MMA(1, 0, At, B0); PG8_BAR; PG8_SCHED;
      PG8_STAGE(PG8_SB(0, 1), b2 + hstep, voffB);
      PG8_WAIT_V(6); PG8_BAR; PG8_MMA(1, 1, At, B1); PG8_BAR;
      PG8_LDB(B0, 1, 0); PG8_SCHED; PG8_LDA(At, 1, 0); PG8_STAGE(PG8_SA(0, 1), a2 + hstep, voffA);
      PG8_WAIT_L(8); PG8_BAR; PG8_WAIT_L(0); PG8_MMA(0, 0, At, B0); PG8_BAR; PG8_SCHED;
      PG8_LDB(B1, 1, 1); PG8_STAGE(PG8_SB(1, 0), b3, voffB);
      PG8_BAR; PG8_WAIT_L(0); PG8_MMA(0, 1, At, B1); PG8_BAR;
      PG8_LDA(At, 1, 1); PG8_STAGE(PG8_SA(1, 0), a3, voffA);
      PG8_BAR; PG8_WAIT_L(0); PG8_MMA(1, 0, At, B0); PG8_BAR; PG8_SCHED;
      PG8_STAGE(PG8_SB(1, 1), b3 + hstep, voffB);
      PG8_WAIT_V(6); PG8_BAR; PG8_MMA(1, 1, At, B1); PG8_BAR;
    }
    E(acc, cur, wr, wc, fr, fq);
    if (!has_next) break;
#pragma unroll
    for (int a = 0; a < 2; ++a)
#pragma unroll
      for (int b = 0; b < 2; ++b)
#pragma unroll
        for (int m = 0; m < 4; ++m)
#pragma unroll
          for (int n = 0; n < 2; ++n) acc[a][b][m][n] = (f32x4){0.f, 0.f, 0.f, 0.f};
    cur = nxt; cA = nA; cB = nB; ++ui;
  }
  PG8_WAIT_V(0);
  if (wr == 0) PG8_BAR;
  PG8_BAR;
#undef PG8_SA
#undef PG8_SB
#undef PG8_STAGE
#undef PG8_LDA
#undef PG8_LDB
#undef PG8_MMA
#undef PG8_WAIT_V
#undef PG8_WAIT_L
#undef PG8_BAR
#undef PG8_SCHED
}

typedef f32x4 acc_t[2][2][4][2];
DEVI void token_info(int token, bool ctx, int& b, int& s, int& key) {
  if (!ctx) { b = token >> 11; s = token & 2047; key = 256 + s; } else { const int tc = token - NLAT; b = tc >> 8; s = 0; key = tc & 255; }
}
DEVI float swap32_partner(float v, bool upper) {
  auto rr = __builtin_amdgcn_permlane32_swap(__float_as_uint(v), __float_as_uint(v), false, false);
  return __uint_as_float(upper ? rr[0] : rr[1]);
}
DEVI void rope_pair(f32x4& v0, f32x4& v1, const float2* __restrict__ tab, int pos, int fq) {
  const bool upper = fq >= 2;
  const float2* t = tab + pos * 16 + (fq & 1) * 8;
  const f32x4 t0 = *reinterpret_cast<const f32x4*>(t), t1 = *reinterpret_cast<const f32x4*>(t + 2), t2 = *reinterpret_cast<const f32x4*>(t + 4), t3 = *reinterpret_cast<const f32x4*>(t + 6);
  const float cs[8] = {t0[0], t0[2], t1[0], t1[2], t2[0], t2[2], t3[0], t3[2]}, sn[8] = {t0[1], t0[3], t1[1], t1[3], t2[1], t2[3], t3[1], t3[3]};
#pragma unroll
  for (int e = 0; e < 4; ++e) {
    const float p0 = swap32_partner(v0[e], upper), p1 = swap32_partner(v1[e], upper);
    const float s0 = upper ? sn[e] : -sn[e], s1 = upper ? sn[4 + e] : -sn[4 + e];
    v0[e] = v0[e] * cs[e] + p0 * s0; v1[e] = v1[e] * cs[4 + e] + p1 * s1;
  }
}
DEVI void st8(bf16_t* dst, const f32x4& v0, const f32x4& v1) { u32x4 pk = {cvtpk(v0[0], v0[1]), cvtpk(v0[2], v0[3]), cvtpk(v1[0], v1[1]), cvtpk(v1[2], v1[3])}; *reinterpret_cast<u32x4*>(dst) = pk; }

struct EpiL0In {
  bf16_t *U, *GV, *ZA, *ZB, *Q0, *K0, *V0; const float2* rope;
  DEVI void operator()(acc_t& acc, const Unit& u, int wr, int wc, int fr, int fq) const {
    const int col0 = u.pn * 256, type = col0 >> 9; const bool ctx = u.pm >= 128;
#pragma unroll
    for (int ai = 0; ai < 2; ++ai)
#pragma unroll
      for (int m = 0; m < 4; ++m) {
        const int token = u.pm * 256 + ai * 128 + wr * 64 + m * 16 + fr;
        int b, s, key; token_info(token, ctx, b, s, key);
#pragma unroll
        for (int bj = 0; bj < 2; ++bj) {
          const int nl = (col0 & 511) + bj * 128 + wc * 32;
          f32x4 v0 = acc[ai][bj][m][0], v1 = acc[ai][bj][m][1];
          bf16_t* dst;
          if (type <= 1) {
#pragma unroll
            for (int e = 0; e < 4; ++e) { v0[e] = gelu_f(v0[e]); v1[e] = gelu_f(v1[e]); }
            dst = (type == 0 ? U : GV) + (size_t)token * 512 + nl;
          } else if (type == 2 || type == 6) {
#pragma unroll
            for (int e = 0; e < 4; ++e) { v0[e] = silu_f(v0[e]); v1[e] = silu_f(v1[e]); }
            dst = (type == 2 ? ZA : ZB) + (size_t)token * 512 + nl;
          } else if (type == 3) {
            if (!ctx) rope_pair(v0, v1, rope, (wc & 1) ? (s & 63) : (s >> 6), fq);
            dst = Q0 + (size_t)token * 512 + nl;
          } else if (type == 4) {
            if (!ctx) rope_pair(v0, v1, rope, (wc & 1) ? (s & 63) : (s >> 6), fq);
            dst = K0 + ((size_t)(b * 4 + (nl >> 7)) * KVL + key) * 128 + (nl & 127);
          } else {
            dst = V0 + ((size_t)(b * 4 + (nl >> 7)) * KVL + key) * 128 + (nl & 127);
          }
          st8(dst + fq * 8, v0, v1);
        }
      }
  }
};

template <bool HASCTX> struct EpiOut {
  const float* src_lat; const float* src_ctx; float* dst_lat; float* dst_ctx; const float* ada;
  DEVI void operator()(acc_t& acc, const Unit& u, int wr, int wc, int fr, int fq) const {
    const int col0 = u.pn * 256;
#pragma unroll
    for (int ai = 0; ai < 2; ++ai)
#pragma unroll
      for (int m = 0; m < 4; ++m) {
        const int token = u.pm * 256 + ai * 128 + wr * 64 + m * 16 + fr;
        const float* src; float* dst; const float* gate;
        if (!HASCTX || token < NLAT) { src = src_lat + (size_t)token * 1024; dst = dst_lat + (size_t)token * 1024; gate = ada + (token >> 11) * 3072 + 2048; }
        else { const int tc = token - NLAT; src = src_ctx + (size_t)tc * 1024; dst = dst_ctx + (size_t)tc * 1024; gate = ada + 16 * 3072 + 2048; }
#pragma unroll
        for (int bj = 0; bj < 2; ++bj)
#pragma unroll
          for (int n = 0; n < 2; ++n) {
            const int c = col0 + bj * 128 + wc * 32 + fq * 8 + n * 4;
            const f32x4 xv = *reinterpret_cast<const f32x4*>(src + c), g = *reinterpret_cast<const f32x4*>(gate + c);
            *reinterpret_cast<f32x4*>(dst + c) = xv + g * acc[ai][bj][m][n];
          }
      }
  }
};

struct EpiPlain {
  bf16_t* O;
  DEVI void operator()(acc_t& acc, const Unit& u, int wr, int wc, int fr, int fq) const {
    const int col0 = u.pn * 256;
#pragma unroll
    for (int ai = 0; ai < 2; ++ai)
#pragma unroll
      for (int m = 0; m < 4; ++m) {
        const int token = u.pm * 256 + ai * 128 + wr * 64 + m * 16 + fr;
#pragma unroll
        for (int bj = 0; bj < 2; ++bj) st8(O + (size_t)token * 1024 + col0 + bj * 128 + wc * 32 + fq * 8, acc[ai][bj][m][0], acc[ai][bj][m][1]);
      }
  }
};

struct EpiL1In {
  bf16_t *CQ, *CKV, *K1, *Z1; float *RQ, *RKV; const float2* rope; float* ssb;
  DEVI void operator()(acc_t& acc, const Unit& u, int wr, int wc, int fr, int fq) const {
    const int col0 = u.pn * 256; const bool ctx = u.pm >= 128;
    float ss[2][4];
#pragma unroll
    for (int ai = 0; ai < 2; ++ai)
#pragma unroll
      for (int m = 0; m < 4; ++m) {
        ss[ai][m] = 0.f;
        const int token = u.pm * 256 + ai * 128 + wr * 64 + m * 16 + fr;
        int b, s, key; token_info(token, ctx, b, s, key);
#pragma unroll
        for (int bj = 0; bj < 2; ++bj) {
          const int nb = col0 + bj * 128 + wc * 32;
          f32x4 v0 = acc[ai][bj][m][0], v1 = acc[ai][bj][m][1];
          if (nb < 384) {
#pragma unroll
            for (int e = 0; e < 4; ++e) ss[ai][m] += v0[e] * v0[e] + v1[e] * v1[e];
            bf16_t* dst = nb < 256 ? CQ + (size_t)token * 256 + nb : CKV + (size_t)token * 128 + (nb - 256);
            st8(dst + fq * 8, v0, v1);
          } else if (nb < 448) {
            if (!ctx) rope_pair(v0, v1, rope, (nb >= 416) ? (s & 63) : (s >> 6), fq);
#pragma unroll
            for (int h = 0; h < 8; ++h) {
              bf16_t* dst = K1 + ((size_t)(b * 8 + h) * KVL + key) * 192 + 128 + (nb - 384);
              st8(dst + fq * 8, v0, v1);
            }
          } else if (nb < 1472) {
            if (!ctx) {
#pragma unroll
              for (int e = 0; e < 4; ++e) { v0[e] = silu_f(v0[e]); v1[e] = silu_f(v1[e]); }
              bf16_t* dst = Z1 + (size_t)token * 1024 + (nb - 448);
              st8(dst + fq * 8, v0, v1);
            }
          }
        }
      }
    if (u.pn <= 1) {
#pragma unroll
      for (int ai = 0; ai < 2; ++ai)
#pragma unroll
        for (int m = 0; m < 4; ++m) {
          float sv = ss[ai][m]; sv = xsum<16>(sv); sv = xsum<32>(sv);
          if (fq == 0) ssb[wc * 256 + ai * 128 + wr * 64 + m * 16 + fr] = sv;
        }
      asm volatile("s_waitcnt lgkmcnt(0)" ::: "memory"); __builtin_amdgcn_s_barrier(); asm volatile("" ::: "memory");
      const int lt = wc * 64 + fq * 16 + fr;
      if (lt < 128) {
        const int row = (lt >> 6) * 128 + wr * 64 + (lt & 63);
        if (u.pn == 0) { const float tot = (ssb[row] + ssb[256 + row]) + (ssb[512 + row] + ssb[768 + row]); RQ[u.pm * 256 + row] = rsqrtf(tot * (1.f / 256.f) + 1e-6f); }
        else { const float tot = (ssb[row] + ssb[256 + row]) + (ssb[512 + row] + ssb[768 + row]); RKV[u.pm * 256 + row] = rsqrtf(tot * (1.f / 128.f) + 1e-6f); }
      }
    }
  }
};

struct EpiQ {
  bf16_t* Q1; const float* RQ; const float2* rope;
  DEVI void operator()(acc_t& acc, const Unit& u, int wr, int wc, int fr, int fq) const {
    const int col0 = u.pn * 256;
#pragma unroll
    for (int ai = 0; ai < 2; ++ai)
#pragma unroll
      for (int m = 0; m < 4; ++m) {
        const int token = u.pm * 256 + ai * 128 + wr * 64 + m * 16 + fr; const int s = token & 2047; const float rq = RQ[token];
#pragma unroll
        for (int bj = 0; bj < 2; ++bj) {
          const int n0 = col0 + bj * 128 + wc * 32; const int dd0 = n0 % 192;
          f32x4 v0 = acc[ai][bj][m][0] * rq, v1 = acc[ai][bj][m][1] * rq;
          if (dd0 >= 128) rope_pair(v0, v1, rope, (dd0 >= 160) ? (s & 63) : (s >> 6), fq);
          bf16_t* dst = Q1 + (size_t)token * 1536 + n0;
          st8(dst + fq * 8, v0, v1);
        }
      }
  }
};

struct EpiKV {
  bf16_t *K1, *V1; const float* RKV;
  DEVI void operator()(acc_t& acc, const Unit& u, int wr, int wc, int fr, int fq) const {
    const int col0 = u.pn * 256; const bool ctx = u.pm >= 128;
#pragma unroll
    for (int ai = 0; ai < 2; ++ai)
#pragma unroll
      for (int m = 0; m < 4; ++m) {
        const int token = u.pm * 256 + ai * 128 + wr * 64 + m * 16 + fr; const float rk = RKV[token];
        int b, s, key; token_info(token, ctx, b, s, key);
#pragma unroll
        for (int bj = 0; bj < 2; ++bj) {
          const int nb = col0 + bj * 128 + wc * 32; const int h = nb >> 8, dd = nb & 255;
          const f32x4 v0 = acc[ai][bj][m][0] * rk, v1 = acc[ai][bj][m][1] * rk;
          bf16_t* dst = dd < 128 ? K1 + ((size_t)(b * 8 + h) * KVL + key) * 192 + dd : V1 + ((size_t)(b * 8 + h) * KVL + key) * 128 + (dd - 128);
          st8(dst + fq * 8, v0, v1);
        }
      }
  }
};

template <int SCID> struct ScaleOf { static constexpr float v = SCID == 0 ? 0.125f : 0.07216878364870322f; };
constexpr float THR = 8.f;
template <int KW> DEVI int kswz(int row, int colB) { return row * (KW * 2 + 16) + colB; }
DEVI int v_st(int k, int c) { const int kk = (k & ~0xC) | ((k & 4) << 1) | ((k & 8) >> 1); return ((kk >> 3) * 4 + (c >> 5)) * 512 + ((kk & 7) * 32 + (c & 31)) * 2; }
DEVI int v_rd_base(int lane) { return ((lane & 3) << 3) | (((lane >> 2) & 3) << 6) | (((lane >> 4) & 1) << 5) | (((lane >> 5) & 1) << 8); }
constexpr int v_rd_off(int d0, int ks, int half) { return d0 * 512 + ks * 4096 + half * 2048; }
template <int OFF> DEVI s16x4 tr_read(int vb) { s16x4 r; asm volatile("ds_read_b64_tr_b16 %0, %1 offset:%2" : "=&v"(r) : "v"(vb), "i"(OFF) : "memory"); return r; }

template <int SCID>
DEVI void partialSM(f32x16& p0, f32x16& p1, float& m_reg, float& mn, float& alpha) {
  constexpr float SC = ScaleOf<SCID>::v; constexpr float C = SC * 1.4426950408889634f;
  float pmax = p0[0];
#pragma unroll
  for (int r = 1; r < 16; ++r) pmax = fmaxf(pmax, p0[r]);
#pragma unroll
  for (int r = 0; r < 16; ++r) pmax = fmaxf(pmax, p1[r]);
  { auto rr = __builtin_amdgcn_permlane32_swap(__float_as_uint(pmax), __float_as_uint(pmax), false, false);
    pmax = fmaxf(__uint_as_float(rr[0]), __uint_as_float(rr[1])); }
  if (__builtin_expect(__all(pmax - m_reg <= THR / SC), 1)) { mn = m_reg; alpha = 1.f; }
  else { mn = fmaxf(m_reg, pmax); alpha = __builtin_amdgcn_exp2f((m_reg - mn) * C); m_reg = mn; }
  const float mnC = -mn * C;
#pragma unroll
  for (int r = 0; r < 16; ++r) p0[r] = fmaf(p0[r], C, mnC);
#pragma unroll
  for (int r = 0; r < 16; ++r) p1[r] = fmaf(p1[r], C, mnC);
#pragma unroll
  for (int r = 0; r < 16; ++r) p0[r] = __builtin_amdgcn_exp2f(p0[r]);
}
DEVI void finishSM(f32x16& p0, f32x16& p1, float alpha, float& l_reg, bf16x8& pa0, bf16x8& pa1, bf16x8& pa2, bf16x8& pa3) {
#pragma unroll
  for (int r = 0; r < 16; ++r) p1[r] = __builtin_amdgcn_exp2f(p1[r]);
  float ps = 0;
#pragma unroll
  for (int r = 0; r < 16; ++r) ps += p0[r];
#pragma unroll
  for (int r = 0; r < 16; ++r) ps += p1[r];
  { auto rr = __builtin_amdgcn_permlane32_swap(__float_as_uint(ps), __float_as_uint(ps), false, false);
    ps = __uint_as_float(rr[0]) + __uint_as_float(rr[1]); }
  l_reg = l_reg * alpha + ps;
#define PK4(P, BASE, OUT) do { unsigned a0 = cvtpk(P[BASE + 0], P[BASE + 1]), a1 = cvtpk(P[BASE + 2], P[BASE + 3]); \
    unsigned b0 = cvtpk(P[BASE + 4], P[BASE + 5]), b1 = cvtpk(P[BASE + 6], P[BASE + 7]); \
    auto r0 = __builtin_amdgcn_permlane32_swap(a0, b0, false, false); auto r1 = __builtin_amdgcn_permlane32_swap(a1, b1, false, false); \
    u32x4 w = {r0[0], r1[0], r0[1], r1[1]}; OUT = *reinterpret_cast<bf16x8*>(&w); } while (0)
  PK4(p0, 0, pa0); PK4(p0, 8, pa1); PK4(p1, 0, pa2); PK4(p1, 8, pa3);
#undef PK4
}
template <int OFF> DEVI bf16x8 lds_rd128(int a) { bf16x8 r; asm volatile("ds_read_b128 %0, %1 offset:%2" : "=&v"(r) : "v"(a), "i"(OFF) : "memory"); return r; }
template <int N> DEVI void wait_lgkm() { asm volatile("s_waitcnt lgkmcnt(%0)" :: "n"(N) : "memory"); }
template <int NQ, int QL> constexpr bool q_is_lds(int s) { return QL > 0 && s >= NQ - QL && s < NQ; }
template <int NQ, int QL, int PF> constexpr int q_after(int d) {
  int n = q_is_lds<NQ, QL>(d + 1) ? 1 : 0;
  if (q_is_lds<NQ, QL>(d)) n += (d + PF < NQ ? 2 : 0);
  else for (int i = 1; i <= PF; ++i) n += (d + i < NQ ? 2 : 0);
  return n;
}
template <int KW, int NQ, int QL, int PF, int D0>
DEVI void qkt_step(f32x16& p0, f32x16& p1, int ka, const bf16x8* qr, int qa, bf16x8 (&kf)[PF + 1][2], bf16x8 (&qf)[2]) {
  if constexpr (D0 < NQ) {
    constexpr int ROW32 = 32 * (KW * 2 + 16);
    if constexpr (D0 + PF < NQ) { kf[(D0 + PF) % (PF + 1)][0] = lds_rd128<(D0 + PF) * 32>(ka); kf[(D0 + PF) % (PF + 1)][1] = lds_rd128<ROW32 + (D0 + PF) * 32>(ka); }
    if constexpr (q_is_lds<NQ, QL>(D0 + 1)) qf[(D0 + 1) & 1] = lds_rd128<(D0 + 1 - (NQ - QL)) * 32>(qa);
    wait_lgkm<q_after<NQ, QL, PF>(D0)>(); SBAR();
    bf16x8 q;
    if constexpr (q_is_lds<NQ, QL>(D0)) q = qf[D0 & 1]; else q = qr[D0];
    p0 = __builtin_amdgcn_mfma_f32_32x32x16_bf16(kf[D0 % (PF + 1)][0], q, p0, 0, 0, 0);
    p1 = __builtin_amdgcn_mfma_f32_32x32x16_bf16(kf[D0 % (PF + 1)][1], q, p1, 0, 0, 0);
    qkt_step<KW, NQ, QL, PF, D0 + 1>(p0, p1, ka, qr, qa, kf, qf);
  }
}
template <int KW, int NQ, int QL = 0>
DEVI void qkt(f32x16& p0, f32x16& p1, const char* Ks, const bf16x8* qr, int kcol0, int r32, int hi, const char* ql = nullptr) {
  constexpr int PF = QL > 0 ? 2 : 3;
#pragma unroll
  for (int r = 0; r < 16; ++r) { p0[r] = 0.f; p1[r] = 0.f; }
  const int ka = (int)(uintptr_t)(Ks + kswz<KW>(r32, (kcol0 + hi * 8) * 2)), qa = (int)(uintptr_t)ql;
  constexpr int ROW32 = 32 * (KW * 2 + 16);
  static_assert(NQ >= PF && (QL == 0 || NQ - QL >= PF), "prologue issues steps 0..PF-1 from register-q steps");
  bf16x8 kf[PF + 1][2], qf[2];
  asm volatile("s_waitcnt lgkmcnt(0)" ::: "memory");
  kf[0][0] = lds_rd128<0>(ka); kf[0][1] = lds_rd128<ROW32>(ka);
  kf[1][0] = lds_rd128<32>(ka); kf[1][1] = lds_rd128<ROW32 + 32>(ka);
  if constexpr (PF >= 3) { kf[2][0] = lds_rd128<64>(ka); kf[2][1] = lds_rd128<ROW32 + 64>(ka); }
  qkt_step<KW, NQ, QL, PF, 0>(p0, p1, ka, qr, qa, kf, qf);
}
template <int D0> DEVI void pv_one(f32x16& od, int vb, bf16x8 pa0, bf16x8 pa1, bf16x8 pa2, bf16x8 pa3) {
  const s16x4 l0 = tr_read<v_rd_off(D0, 0, 0)>(vb), h0 = tr_read<v_rd_off(D0, 0, 1)>(vb), l1 = tr_read<v_rd_off(D0, 1, 0)>(vb), h1 = tr_read<v_rd_off(D0, 1, 1)>(vb);
  const s16x4 l2 = tr_read<v_rd_off(D0, 2, 0)>(vb), h2 = tr_read<v_rd_off(D0, 2, 1)>(vb), l3 = tr_read<v_rd_off(D0, 3, 0)>(vb), h3 = tr_read<v_rd_off(D0, 3, 1)>(vb);
  asm volatile("s_waitcnt lgkmcnt(0)" ::: "memory"); SBAR();
#define PK(L, H) (bf16x8){L[0], L[1], L[2], L[3], H[0], H[1], H[2], H[3]}
  od = __builtin_amdgcn_mfma_f32_32x32x16_bf16(pa0, PK(l0, h0), od, 0, 0, 0);
  od = __builtin_amdgcn_mfma_f32_32x32x16_bf16(pa1, PK(l1, h1), od, 0, 0, 0);
  od = __builtin_amdgcn_mfma_f32_32x32x16_bf16(pa2, PK(l2, h2), od, 0, 0, 0);
  od = __builtin_amdgcn_mfma_f32_32x32x16_bf16(pa3, PK(l3, h3), od, 0, 0, 0);
#undef PK
}
template <int D0> DEVI void v_load(int vb, s16x4 (&f)[8]) {
  f[0] = tr_read<v_rd_off(D0, 0, 0)>(vb); f[1] = tr_read<v_rd_off(D0, 0, 1)>(vb); f[2] = tr_read<v_rd_off(D0, 1, 0)>(vb); f[3] = tr_read<v_rd_off(D0, 1, 1)>(vb);
  f[4] = tr_read<v_rd_off(D0, 2, 0)>(vb); f[5] = tr_read<v_rd_off(D0, 2, 1)>(vb); f[6] = tr_read<v_rd_off(D0, 3, 0)>(vb); f[7] = tr_read<v_rd_off(D0, 3, 1)>(vb);
}
DEVI void pv_mma(f32x16& od, const s16x4 (&f)[8], bf16x8 pa0, bf16x8 pa1, bf16x8 pa2, bf16x8 pa3) {
#define PK(L, H) (bf16x8){L[0], L[1], L[2], L[3], H[0], H[1], H[2], H[3]}
  od = __builtin_amdgcn_mfma_f32_32x32x16_bf16(pa0, PK(f[0], f[1]), od, 0, 0, 0);
  od = __builtin_amdgcn_mfma_f32_32x32x16_bf16(pa1, PK(f[2], f[3]), od, 0, 0, 0);
  od = __builtin_amdgcn_mfma_f32_32x32x16_bf16(pa2, PK(f[4], f[5]), od, 0, 0, 0);
  od = __builtin_amdgcn_mfma_f32_32x32x16_bf16(pa3, PK(f[6], f[7]), od, 0, 0, 0);
#undef PK
}
DEVI void pv_d0(f32x16* o, int vb, bf16x8 pa0, bf16x8 pa1, bf16x8 pa2, bf16x8 pa3) {
  s16x4 fa[8], fb[8];
  v_load<0>(vb, fa);
  v_load<1>(vb, fb); asm volatile("s_waitcnt lgkmcnt(8)" ::: "memory"); SBAR(); pv_mma(o[0], fa, pa0, pa1, pa2, pa3); SBAR();
  v_load<2>(vb, fa); asm volatile("s_waitcnt lgkmcnt(8)" ::: "memory"); SBAR(); pv_mma(o[1], fb, pa0, pa1, pa2, pa3); SBAR();
  v_load<3>(vb, fb); asm volatile("s_waitcnt lgkmcnt(8)" ::: "memory"); SBAR(); pv_mma(o[2], fa, pa0, pa1, pa2, pa3); SBAR();
  asm volatile("s_waitcnt lgkmcnt(0)" ::: "memory"); SBAR(); pv_mma(o[3], fb, pa0, pa1, pa2, pa3);
}

template <int KW, int NQ, int SCID>
DEVI void attn_core(int wv, const bf16_t* __restrict__ Qw, const bf16_t* __restrict__ Kh, const bf16_t* __restrict__ Vh, int kcol0, int NT, char* lds,
                    f32x16 (&o)[4], float& l_out) {
  constexpr int SHM_V = 64 * 128 * 2, SHM_K = 64 * (KW * 2 + 16), KC = KW / 64;
  const int tid = tidx(wv), wid = tid >> 6, lane = tid & 63, r32 = lane & 31, hi = lane >> 5;
  char* V_lds = lds; char* K_lds = lds + 2 * SHM_V;
  float* al_l = (float*)(lds + 2 * SHM_V + 2 * SHM_K) + wid * 64 + 32;
  float m_reg = -1e30f, l_reg = 0;
#pragma unroll
  for (int d = 0; d < 4; ++d)
#pragma unroll
    for (int r = 0; r < 16; ++r) o[d][r] = 0.f;
  bf16x8 qr[NQ];
#pragma unroll
  for (int d0 = 0; d0 < NQ; ++d0) qr[d0] = *reinterpret_cast<const bf16x8*>(Qw + d0 * 16);
  const int sr = tid >> 4, sc = (tid & 15) * 8, vst0 = v_st(sr, sc), vst1 = v_st(32 + sr, sc);
  const int krow = tid >> 3, kch = tid & 7;
  const bf16_t* vg = Vh + sr * 128 + sc;
  const bf16_t* kg = Kh + krow * KW + kch * 8;
  const int vb0 = (int)(uintptr_t)V_lds + v_rd_base(lane);
  bf16x8 vs0, vs1, ks[KC];
#define SLOAD(k0) do { vs0 = *reinterpret_cast<const bf16x8*>(vg + (size_t)(k0) * 128); vs1 = *reinterpret_cast<const bf16x8*>(vg + (size_t)((k0) + 32) * 128); \
    _Pragma("unroll") for (int _c = 0; _c < KC; ++_c) ks[_c] = *reinterpret_cast<const bf16x8*>(kg + (size_t)(k0) * KW + _c * 64); } while (0)
#define SWRITE(b) do { *reinterpret_cast<bf16x8*>(V_lds + (b) * SHM_V + vst0) = vs0; *reinterpret_cast<bf16x8*>(V_lds + (b) * SHM_V + vst1) = vs1; \
    _Pragma("unroll") for (int _c = 0; _c < KC; ++_c) *reinterpret_cast<bf16x8*>(K_lds + (b) * SHM_K + kswz<KW>(krow, (kch + 8 * _c) * 16)) = ks[_c]; } while (0)
  SLOAD(0); SWRITE(0);
  if (NT > 1) SLOAD(64);
  __syncthreads();
  for (int j = 0; j < NT; ++j) {
    const int bsel = j & 1;
    f32x16 p0, p1; float mn, alpha; bf16x8 pa0, pa1, pa2, pa3;
    qkt<KW, NQ>(p0, p1, K_lds + bsel * SHM_K, qr, kcol0, r32, hi);
    partialSM<SCID>(p0, p1, m_reg, mn, alpha);
    if (__any(alpha < 1.f)) {
      if (hi == 0) al_l[r32] = alpha;
      asm volatile("s_waitcnt lgkmcnt(0)" ::: "memory");
#pragma unroll
      for (int d = 0; d < 4; ++d)
#pragma unroll
        for (int r = 0; r < 16; ++r) o[d][r] *= al_l[crow(r, hi)];
    }
    finishSM(p0, p1, alpha, l_reg, pa0, pa1, pa2, pa3);
    pv_d0(o, vb0 + bsel * SHM_V, pa0, pa1, pa2, pa3);
    if (j + 1 < NT) { SWRITE(bsel ^ 1); if (j + 2 < NT) SLOAD((j + 2) * 64); }
    __syncthreads();
  }
  l_out = l_reg;
#undef SLOAD
#undef SWRITE
}

template <int KW, int NQ, int SDEPTH, int SCID, int QL>
DEVI void attn_core_pipe(int wv, const bf16_t* __restrict__ Qw, const bf16_t* __restrict__ Kh, const bf16_t* __restrict__ Vh, int kcol0, int NT, char* lds,
                         f32x16 (&o)[4], float& l_out) {
  constexpr int SHM_V = 64 * 128 * 2, SHM_K = 64 * (KW * 2 + 16), KC = KW / 64;
  const int tid = tidx(wv), wid = tid >> 6, lane = tid & 63, r32 = lane & 31, hi = lane >> 5;
  char* V_lds = lds; char* K_lds = lds + 2 * SHM_V;
  float* al_l = (float*)(lds + 2 * SHM_V + 2 * SHM_K) + wid * 64 + 32;
  float m_reg = -1e30f, l_reg = 0;
#pragma unroll
  for (int d = 0; d < 4; ++d)
#pragma unroll
    for (int r = 0; r < 16; ++r) o[d][r] = 0.f;
  bf16x8 qr[NQ - QL + (QL ? 1 : 0)];
#pragma unroll
  for (int d0 = 0; d0 < NQ - QL; ++d0) qr[d0] = *reinterpret_cast<const bf16x8*>(Qw + d0 * 16);
  char* ql = lds + 2 * SHM_V + 2 * SHM_K + 2048 + (wid * 32 + r32) * 144 + hi * 16;
  if constexpr (QL > 0) {
#pragma unroll
    for (int d0 = NQ - QL; d0 < NQ; ++d0) *reinterpret_cast<bf16x8*>(ql + (d0 - (NQ - QL)) * 32) = *reinterpret_cast<const bf16x8*>(Qw + d0 * 16);
  }
  const int sr = tid >> 4, sc = (tid & 15) * 8, vst0 = v_st(sr, sc), vst1 = v_st(32 + sr, sc);
  const int krow = tid >> 3, kch = tid & 7;
  const bf16_t* vg = Vh + sr * 128 + sc;
  const bf16_t* kg = Kh + krow * KW + kch * 8;
  const int vb0 = (int)(uintptr_t)V_lds + v_rd_base(lane);
  struct { bf16x8 vs0, vs1, ks[KC]; } sr_[SDEPTH];
#define SLOAD(i, k0) do { sr_[i].vs0 = *reinterpret_cast<const bf16x8*>(vg + (size_t)(k0) * 128); sr_[i].vs1 = *reinterpret_cast<const bf16x8*>(vg + (size_t)((k0) + 32) * 128); \
    _Pragma("unroll") for (int _c = 0; _c < KC; ++_c) sr_[i].ks[_c] = *reinterpret_cast<const bf16x8*>(kg + (size_t)(k0) * KW + _c * 64); } while (0)
#define SWRITE(b, i) do { *reinterpret_cast<bf16x8*>(V_lds + (b) * SHM_V + vst0) = sr_[i].vs0; *reinterpret_cast<bf16x8*>(V_lds + (b) * SHM_V + vst1) = sr_[i].vs1; \
    _Pragma("unroll") for (int _c = 0; _c < KC; ++_c) *reinterpret_cast<bf16x8*>(K_lds + (b) * SHM_K + kswz<KW>(krow, (kch + 8 * _c) * 16)) = sr_[i].ks[_c]; } while (0)
#define SWAIT() do { if constexpr (SDEPTH == 2) asm volatile("s_waitcnt vmcnt(4)" ::: "memory"); else asm volatile("s_waitcnt vmcnt(0)" ::: "memory"); } while (0)
#define RESC(a) do { if (__any((a) < 1.f)) { if (hi == 0) al_l[r32] = (a); asm volatile("s_waitcnt lgkmcnt(0)" ::: "memory"); \
    _Pragma("unroll") for (int _d = 0; _d < 4; ++_d) _Pragma("unroll") for (int _r = 0; _r < 16; ++_r) o[_d][_r] *= al_l[crow(_r, hi)]; } } while (0)
  f32x16 pA0, pA1, pB0, pB1; float mnA, mnB, alA, alB; bf16x8 pa0, pa1, pa2, pa3;
  constexpr int SE = 0, SO = SDEPTH - 1;
  SLOAD(SE, 0); asm volatile("s_waitcnt vmcnt(0)" ::: "memory"); SWRITE(0, SE); __syncthreads();
  qkt<KW, NQ, QL>(pA0, pA1, K_lds, qr, kcol0, r32, hi, ql); partialSM<SCID>(pA0, pA1, m_reg, mnA, alA);
  SLOAD(SO, 64); if constexpr (SDEPTH == 2) { if (2 < NT) SLOAD(SE, 128); }
  SWAIT(); SWRITE(1, SO); __syncthreads();
  for (int j = 1; j + 1 < NT; j += 2) {
    SBAR(); qkt<KW, NQ, QL>(pB0, pB1, K_lds + SHM_K, qr, kcol0, r32, hi, ql);
    finishSM(pA0, pA1, alA, l_reg, pa0, pa1, pa2, pa3); SBAR();
    SLOAD(SO, (j + SDEPTH) * 64); SBAR();
    pv_d0(o, vb0, pa0, pa1, pa2, pa3); partialSM<SCID>(pB0, pB1, m_reg, mnB, alB);
    __syncthreads(); SWAIT(); SWRITE(0, SE);
    RESC(alB); __syncthreads();
    SBAR(); qkt<KW, NQ, QL>(pA0, pA1, K_lds, qr, kcol0, r32, hi, ql);
    finishSM(pB0, pB1, alB, l_reg, pa0, pa1, pa2, pa3); SBAR();
    if (SDEPTH == 1 || j + 3 < NT) SLOAD(SE, (j + 1 + SDEPTH) * 64);
    SBAR();
    pv_d0(o, vb0 + SHM_V, pa0, pa1, pa2, pa3); partialSM<SCID>(pA0, pA1, m_reg, mnA, alA);
    __syncthreads(); SWAIT(); SWRITE(1, SO);
    RESC(alA); __syncthreads();
  }
  SBAR(); qkt<KW, NQ, QL>(pB0, pB1, K_lds + SHM_K, qr, kcol0, r32, hi, ql);
  finishSM(pA0, pA1, alA, l_reg, pa0, pa1, pa2, pa3); SBAR();
  pv_d0(o, vb0, pa0, pa1, pa2, pa3); partialSM<SCID>(pB0, pB1, m_reg, mnB, alB);
  __syncthreads(); RESC(alB);
  finishSM(pB0, pB1, alB, l_reg, pa0, pa1, pa2, pa3); SBAR();
  pv_d0(o, vb0 + SHM_V, pa0, pa1, pa2, pa3);
  __syncthreads();
  l_out = l_reg;
#undef SLOAD
#undef SWRITE
#undef SWAIT
#undef RESC
}

template <int KW, int NQ, int SCID, int QL>
DEVI void attn_core_dma(int wv, const bf16_t* __restrict__ Qw, const bf16_t* __restrict__ Kh, const bf16_t* __restrict__ Vh, int kcol0, int NT, char* lds,
                        f32x16 (&o)[4], float& l_out) {
  constexpr int SHM_V = 64 * 128 * 2, KCH = KW / 8 + 1, SHM_K = 64 * KCH * 16, KR = (64 * KCH) / 512;
  static_assert(64 * KCH - KR * 512 == 64, "remainder must be one wave");
  const int tid = tidx(wv), wid = tid >> 6, lane = tid & 63, r32 = lane & 31, hi = lane >> 5;
  char* V_lds = lds; char* K_lds = lds + 2 * SHM_V;
  float* al_l = (float*)(lds + 2 * SHM_V + 2 * SHM_K) + wid * 64 + 32;
  float m_reg = -1e30f, l_reg = 0;
#pragma unroll
  for (int d = 0; d < 4; ++d)
#pragma unroll
    for (int r = 0; r < 16; ++r) o[d][r] = 0.f;
  bf16x8 qr[NQ - QL + (QL ? 1 : 0)];
#pragma unroll
  for (int d0 = 0; d0 < NQ - QL; ++d0) qr[d0] = *reinterpret_cast<const bf16x8*>(Qw + d0 * 16);
  char* ql = lds + 2 * SHM_V + 2 * SHM_K + 2048 + (wid * 32 + r32) * 144 + hi * 16;
  if constexpr (QL > 0) {
#pragma unroll
    for (int d0 = NQ - QL; d0 < NQ; ++d0) *reinterpret_cast<bf16x8*>(ql + (d0 - (NQ - QL)) * 32) = *reinterpret_cast<const bf16x8*>(Qw + d0 * 16);
  }
  const int sr = tid >> 4, sc = (tid & 15) * 8, vst0 = v_st(sr, sc), vst1 = v_st(32 + sr, sc);
  const bf16_t* vg = Vh + sr * 128 + sc;
  const int vb0 = (int)(uintptr_t)V_lds + v_rd_base(lane);
  unsigned koff[KR + 1];
#pragma unroll
  for (int i = 0; i <= KR; ++i) { const int c = tid + 512 * i; const int row = c / KCH; int ch = c - row * KCH; ch = ch == KCH - 1 ? KCH - 2 : ch; koff[i] = (unsigned)(row * KW + ch * 8) * 2u; }
  const unsigned kldsw = (unsigned)__builtin_amdgcn_readfirstlane(wid) * 1024u;
  bf16x8 vs0, vs1;
#define KDMA(k0, b) do { const char* _g = (const char*)(Kh + (size_t)(k0) * KW); PG8_LAS unsigned char* _l = (PG8_LAS unsigned char*)(K_lds + (b) * SHM_K) + kldsw; \
    _Pragma("unroll") for (int _i = 0; _i < KR; ++_i) __builtin_amdgcn_global_load_lds((const unsigned*)(_g + koff[_i]), (PG8_LAS unsigned*)(_l + _i * 8192), 16, 0, 0); \
    if (wid == 0) __builtin_amdgcn_global_load_lds((const unsigned*)(_g + koff[KR]), (PG8_LAS unsigned*)(_l + KR * 8192), 16, 0, 0); } while (0)
#define VLOAD(k0) do { vs0 = *reinterpret_cast<const bf16x8*>(vg + (size_t)(k0) * 128); vs1 = *reinterpret_cast<const bf16x8*>(vg + (size_t)((k0) + 32) * 128); } while (0)
#define VWRITE(b) do { *reinterpret_cast<bf16x8*>(V_lds + (b) * SHM_V + vst0) = vs0; *reinterpret_cast<bf16x8*>(V_lds + (b) * SHM_V + vst1) = vs1; } while (0)
#define VMW() asm volatile("s_waitcnt vmcnt(0)" ::: "memory")
#define RESC(a) do { if (__any((a) < 1.f)) { if (hi == 0) al_l[r32] = (a); asm volatile("s_waitcnt lgkmcnt(0)" ::: "memory"); \
    _Pragma("unroll") for (int _d = 0; _d < 4; ++_d) _Pragma("unroll") for (int _r = 0; _r < 16; ++_r) o[_d][_r] *= al_l[crow(_r, hi)]; } } while (0)
  f32x16 pA0, pA1, pB0, pB1; float mnA, mnB, alA, alB; bf16x8 pa0, pa1, pa2, pa3;
  KDMA(0, 0); VLOAD(0); VMW(); VWRITE(0); __syncthreads();
  KDMA(64, 1); VLOAD(64);
  qkt<KW, NQ, QL>(pA0, pA1, K_lds, qr, kcol0, r32, hi, ql); partialSM<SCID>(pA0, pA1, m_reg, mnA, alA);
  VMW(); __syncthreads(); VWRITE(1); __syncthreads();
  for (int j = 1; j + 1 < NT; j += 2) {
    SBAR(); KDMA((j + 1) * 64, 0); VLOAD((j + 1) * 64); SBAR();
    qkt<KW, NQ, QL>(pB0, pB1, K_lds + SHM_K, qr, kcol0, r32, hi, ql);
    finishSM(pA0, pA1, alA, l_reg, pa0, pa1, pa2, pa3); SBAR();
    pv_d0(o, vb0, pa0, pa1, pa2, pa3); partialSM<SCID>(pB0, pB1, m_reg, mnB, alB);
    VMW(); __syncthreads(); VWRITE(0);
    RESC(alB); __syncthreads();
    SBAR(); KDMA((j + 2) * 64, 1); VLOAD((j + 2) * 64); SBAR();
    qkt<KW, NQ, QL>(pA0, pA1, K_lds, qr, kcol0, r32, hi, ql);
    finishSM(pB0, pB1, alB, l_reg, pa0, pa1, pa2, pa3); SBAR();
    pv_d0(o, vb0 + SHM_V, pa0, pa1, pa2, pa3); partialSM<SCID>(pA0, pA1, m_reg, mnA, alA);
    VMW(); __syncthreads(); VWRITE(1);
    RESC(alA); __syncthreads();
  }
  SBAR(); qkt<KW, NQ, QL>(pB0, pB1, K_lds + SHM_K, qr, kcol0, r32, hi, ql);
  finishSM(pA0, pA1, alA, l_reg, pa0, pa1, pa2, pa3); SBAR();
  pv_d0(o, vb0, pa0, pa1, pa2, pa3); partialSM<SCID>(pB0, pB1, m_reg, mnB, alB);
  RESC(alB);
  finishSM(pB0, pB1, alB, l_reg, pa0, pa1, pa2, pa3); SBAR();
  pv_d0(o, vb0 + SHM_V, pa0, pa1, pa2, pa3);
  __syncthreads();
  l_out = l_reg;
#undef KDMA
#undef VLOAD
#undef VWRITE
#undef VMW
#undef RESC
}

template <int KW, int NQ, int SCID, int QL>
DEVI void attn_core_pp(int wv, const bf16_t* __restrict__ Qw, const bf16_t* __restrict__ Kh, const bf16_t* __restrict__ Vh, int kcol0, int NT, char* lds,
                       f32x16 (&o)[4], float& l_out) {
  constexpr int SHM_V = 64 * 128 * 2, KCH = KW / 8 + 1, SHM_K = 64 * KCH * 16, KR = (64 * KCH) / 512;
  static_assert(64 * KCH - KR * 512 == 64, "remainder must be one wave");
  const int tid = tidx(wv), wid = tid >> 6, lane = tid & 63, r32 = lane & 31, hi = lane >> 5;
  const int g = __builtin_amdgcn_readfirstlane(wid >> 2);
  char* V_lds = lds; char* K_lds = lds + 2 * SHM_V;
  float* al_l = (float*)(lds + 2 * SHM_V + 2 * SHM_K) + wid * 64 + 32;
  float m_reg = -1e30f, l_reg = 0;
#pragma unroll
  for (int d = 0; d < 4; ++d)
#pragma unroll
    for (int r = 0; r < 16; ++r) o[d][r] = 0.f;
  bf16x8 qr[NQ - QL + (QL ? 1 : 0)];
#pragma unroll
  for (int d0 = 0; d0 < NQ - QL; ++d0) qr[d0] = *reinterpret_cast<const bf16x8*>(Qw + d0 * 16);
  char* ql = lds + 2 * SHM_V + 2 * SHM_K + 2048 + (wid * 32 + r32) * 144 + hi * 16;
  if constexpr (QL > 0) {
#pragma unroll
    for (int d0 = NQ - QL; d0 < NQ; ++d0) *reinterpret_cast<bf16x8*>(ql + (d0 - (NQ - QL)) * 32) = *reinterpret_cast<const bf16x8*>(Qw + d0 * 16);
  }
  const int vb0 = (int)(uintptr_t)V_lds + v_rd_base(lane);
  unsigned koff[KR + 1], voff[2];
#pragma unroll
  for (int i = 0; i <= KR; ++i) { const int c = tid + 512 * i; const int row = c / KCH; int ch = c - row * KCH; ch = ch == KCH - 1 ? KCH - 2 : ch; koff[i] = (unsigned)(row * KW + ch * 8) * 2u; }
#pragma unroll
  for (int i = 0; i < 2; ++i) { const int q = tid + 512 * i; const int st = q >> 5, kk = (st >> 2) * 8 + ((q >> 2) & 7), c = (st & 3) * 32 + (q & 3) * 8;
    const int k = (kk & ~0xC) | ((kk & 4) << 1) | ((kk & 8) >> 1); voff[i] = (unsigned)(k * 128 + c) * 2u; }
  const unsigned ldsw = (unsigned)__builtin_amdgcn_readfirstlane(wid) * 1024u;
#define KDMA(k0, b) do { const char* _g = (const char*)(Kh + (size_t)(k0) * KW); PG8_LAS unsigned char* _l = (PG8_LAS unsigned char*)(K_lds + (b) * SHM_K) + ldsw; \
    _Pragma("unroll") for (int _i = 0; _i < KR; ++_i) __builtin_amdgcn_global_load_lds((const unsigned*)(_g + koff[_i]), (PG8_LAS unsigned*)(_l + _i * 8192), 16, 0, 0); \
    if (wid == 0) __builtin_amdgcn_global_load_lds((const unsigned*)(_g + koff[KR]), (PG8_LAS unsigned*)(_l + KR * 8192), 16, 0, 0); } while (0)
#define VDMA(k0, b) do { const char* _g = (const char*)(Vh + (size_t)(k0) * 128); PG8_LAS unsigned char* _l = (PG8_LAS unsigned char*)(V_lds + (b) * SHM_V) + ldsw; \
    _Pragma("unroll") for (int _i = 0; _i < 2; ++_i) __builtin_amdgcn_global_load_lds((const unsigned*)(_g + voff[_i]), (PG8_LAS unsigned*)(_l + _i * 8192), 16, 0, 0); } while (0)
#define VMW() asm volatile("s_waitcnt vmcnt(0)" ::: "memory")
#define PBAR() do { asm volatile("" ::: "memory"); __builtin_amdgcn_s_barrier(); asm volatile("" ::: "memory"); } while (0)
#define RESC(a) do { if (__any((a) < 1.f)) { if (hi == 0) al_l[r32] = (a); asm volatile("s_waitcnt lgkmcnt(0)" ::: "memory"); \
    _Pragma("unroll") for (int _d = 0; _d < 4; ++_d) _Pragma("unroll") for (int _r = 0; _r < 16; ++_r) o[_d][_r] *= al_l[crow(_r, hi)]; } } while (0)
  f32x16 pA0, pA1, pB0, pB1; float mn, al; bf16x8 pa0, pa1, pa2, pa3;
  KDMA(0, 0); KDMA(64, 1); VMW(); __syncthreads();
  qkt<KW, NQ, QL>(pA0, pA1, K_lds, qr, kcol0, r32, hi, ql);
  PBAR();
  if (g == 1) PBAR();
  for (int j = 0; j < NT; j += 2) {
    SBAR(); if (j + 2 < NT) KDMA((j + 2) * 64, 0); VDMA(j * 64, 0); SBAR();
    qkt<KW, NQ, QL>(pB0, pB1, K_lds + SHM_K, qr, kcol0, r32, hi, ql);
    if (j > 0) pv_d0(o, vb0 + SHM_V, pa0, pa1, pa2, pa3);
    if (g == 1) VMW();
    PBAR(); SBAR();
    partialSM<SCID>(pA0, pA1, m_reg, mn, al); RESC(al); finishSM(pA0, pA1, al, l_reg, pa0, pa1, pa2, pa3);
    if (g == 0) VMW();
    PBAR(); SBAR();
    if (j + 3 < NT) KDMA((j + 3) * 64, 1);
    VDMA((j + 1) * 64, 1); SBAR();
    if (j + 2 < NT) qkt<KW, NQ, QL>(pA0, pA1, K_lds, qr, kcol0, r32, hi, ql);
    pv_d0(o, vb0, pa0, pa1, pa2, pa3);
    if (g == 1) VMW();
    PBAR(); SBAR();
    partialSM<SCID>(pB0, pB1, m_reg, mn, al); RESC(al); finishSM(pB0, pB1, al, l_reg, pa0, pa1, pa2, pa3);
    if (g == 0) VMW();
    PBAR(); SBAR();
  }
  pv_d0(o, vb0 + SHM_V, pa0, pa1, pa2, pa3);
  if (g == 0) PBAR();
  __syncthreads();
  l_out = l_reg;
#undef KDMA
#undef VDMA
#undef VMW
#undef PBAR
#undef RESC
}

DEVI void gated_rows_out(const char* stg, int lane, const bf16_t* __restrict__ gate, int gld, bf16_t* __restrict__ out, int old) {
#pragma unroll
  for (int i = 0; i < 8; ++i) {
    const int c = lane + 64 * i, row = c >> 4, ch = c & 15;
    const u32x4 sv = *reinterpret_cast<const u32x4*>(stg + row * 272 + ch * 16);
    const u32x4 gv = *reinterpret_cast<const u32x4*>(gate + (size_t)row * gld + ch * 8);
    u32x4 ov;
#pragma unroll
    for (int e = 0; e < 4; ++e) ov[e] = cvtpk(bflo(sv[e]) * bflo(gv[e]), bfhi(sv[e]) * bfhi(gv[e]));
    *reinterpret_cast<u32x4*>(out + (size_t)row * old + ch * 8) = ov;
  }
}

DEVI void attn0_item(int wv, const Params& p, int token0, int b, int h, int nkeys, char* lds) {
  const int tid = tidx(wv), wid = tid >> 6, lane = tid & 63, r32 = lane & 31, hi = lane >> 5, m = wid >> 2, wl = wid & 3;
  const bf16_t* Q0 = (const bf16_t*)(p.ws + OFF_Q0); const bf16_t* K0 = (const bf16_t*)(p.ws + OFF_K0); const bf16_t* V0 = (const bf16_t*)(p.ws + OFF_V0);
  const bf16_t* ZB = (const bf16_t*)(p.ws + OFF_ZB); bf16_t* MIX = (bf16_t*)(p.ws + OFF_MIX);
  const bf16_t* Qw = Q0 + (size_t)(token0 + wl * 32 + r32) * 512 + h * 128 + m * 64 + hi * 8;
  const size_t kvo = (size_t)(b * 4 + h) * KVL * 128;
  f32x16 o[4]; float l;
  attn_core_pp<128, 4, 0, 0>(wv, Qw, K0 + kvo, V0 + kvo, m * 64, nkeys >> 6, lds, o, l);
  float* li_l = (float*)(lds + 32768 + 2 * 64 * 272) + wid * 64;
  if (hi == 0) li_l[r32] = l;
  asm volatile("s_waitcnt lgkmcnt(0)" ::: "memory");
  float rli[16];
#pragma unroll
  for (int r = 0; r < 16; ++r) rli[r] = __builtin_amdgcn_rcpf(li_l[crow(r, hi)]);
  float t1 = p.b_lq1[lane] * p.b_lk1[lane], t2 = p.b_lq2[lane] * p.b_lk2[lane];
  t1 = wave_sum(t1); t2 = wave_sum(t2);
  const float lam = __expf(t1) - __expf(t2) + 0.2f;
  __syncthreads();
  float* xch = (float*)lds;
  if (m == 1) {
#pragma unroll
    for (int r = 0; r < 16; ++r)
#pragma unroll
      for (int d0 = 0; d0 < 4; ++d0) xch[(wl * 32 + crow(r, hi)) * 128 + d0 * 32 + r32] = o[d0][r] * rli[r];
  }
  __syncthreads();
  if (m == 0) {
    char* stg = lds + 69632 + wl * 8704;
    float sw4[4];
#pragma unroll
    for (int d0 = 0; d0 < 4; ++d0) sw4[d0] = p.b_subln_w[d0 * 32 + r32];
#pragma unroll
    for (int r = 0; r < 16; ++r) {
      const int row = wl * 32 + crow(r, hi); const int token = token0 + row;
      float a[4], ss = 0.f;
#pragma unroll
      for (int d0 = 0; d0 < 4; ++d0) { a[d0] = o[d0][r] * rli[r] - lam * xch[row * 128 + d0 * 32 + r32]; ss += a[d0] * a[d0]; }
      ss = xsum<1>(ss); ss = xsum<2>(ss); ss = xsum<4>(ss); ss = xsum<8>(ss); ss = xsum<16>(ss);
      const float rstd = rsqrtf(ss * (1.f / 128.f) + 1e-5f) * 0.8f;
#pragma unroll
      for (int d0 = 0; d0 < 4; ++d0) *reinterpret_cast<bf16_t*>(stg + crow(r, hi) * 272 + (d0 * 32 + r32) * 2) = f2bf(a[d0] * rstd * sw4[d0]);
    }
    asm volatile("s_waitcnt lgkmcnt(0)" ::: "memory");
    const size_t t0 = (size_t)(token0 + wl * 32);
    gated_rows_out(stg, lane, ZB + t0 * 512 + h * 128, 512, MIX + t0 * 1024 + 512 + h * 128, 1024);
  }
  __syncthreads();
}

DEVI void attn1_item(int wv, const Params& p, int b, int h, int qb, char* lds) {
  const int tid = tidx(wv), wid = tid >> 6, lane = tid & 63, r32 = lane & 31, hi = lane >> 5;
  const bf16_t* Q1 = (const bf16_t*)(p.ws + OFF_Q1); const bf16_t* K1 = (const bf16_t*)(p.ws + OFF_K1); const bf16_t* V1 = (const bf16_t*)(p.ws + OFF_V1);
  const bf16_t* Z1 = (const bf16_t*)(p.ws + OFF_Z1); bf16_t* MIX = (bf16_t*)(p.ws + OFF_MIX);
  const int token0 = b * 2048 + qb * 256;
  const bf16_t* Qw = Q1 + (size_t)(token0 + wid * 32 + r32) * 1536 + h * 192 + hi * 8;
  f32x16 o[4]; float l;
  attn_core_pp<192, 12, 1, 4>(wv, Qw, K1 + (size_t)(b * 8 + h) * KVL * 192, V1 + (size_t)(b * 8 + h) * KVL * 128, 0, KVL / 64, lds, o, l);
  float* li_l = (float*)(lds + 32768 + 2 * 64 * 400) + wid * 64;
  if (hi == 0) li_l[r32] = l;
  asm volatile("s_waitcnt lgkmcnt(0)" ::: "memory");
  char* stg = lds + wid * 8704;
#pragma unroll
  for (int r = 0; r < 16; ++r) {
    const int cr = crow(r, hi); const float rl = __builtin_amdgcn_rcpf(li_l[cr]);
#pragma unroll
    for (int d0 = 0; d0 < 4; ++d0) *reinterpret_cast<bf16_t*>(stg + cr * 272 + (d0 * 32 + r32) * 2) = f2bf(o[d0][r] * rl);
  }
  asm volatile("s_waitcnt lgkmcnt(0)" ::: "memory");
  const size_t t0 = (size_t)(token0 + wid * 32);
  gated_rows_out(stg, lane, Z1 + t0 * 1024 + h * 128, 1024, MIX + t0 * 1024 + h * 128, 1024);
  __syncthreads();
}

DEVI void abranch_item(int wv, const Params& p, int ci, char* lds) {
  const int tid = tidx(wv), wid = tid >> 6, lane = tid & 63, r32 = lane & 31, hi = lane >> 5;
  const bf16_t* GV = (const bf16_t*)(p.ws + OFF_GV); const bf16_t* U = (const bf16_t*)(p.ws + OFF_U); const bf16_t* ZA = (const bf16_t*)(p.ws + OFF_ZA);
  const bf16_t* WSB = (const bf16_t*)(p.ws + OFF_WSB); bf16_t* MIX = (bf16_t*)(p.ws + OFF_MIX);
  const int t0 = ci * 128;
  bf16_t* vnT = (bf16_t*)lds;
  {
    const int pos = tid >> 2, cp = tid & 3;
    const bf16_t* g = GV + (size_t)(t0 + pos) * 512;
    bf16x8 raw[16];
#pragma unroll
    for (int i = 0; i < 16; ++i) raw[i] = *reinterpret_cast<const bf16x8*>(g + (i * 4 + cp) * 8);
    float s = 0.f, q = 0.f;
#pragma unroll
    for (int i = 0; i < 16; ++i)
#pragma unroll
      for (int e = 0; e < 8; ++e) { const float xv = bf2f((bf16_t)raw[i][e]); s += xv; q += xv * xv; }
    s = xsum<1>(s); s = xsum<2>(s); q = xsum<1>(q); q = xsum<2>(q);
    const float mu = s * (1.f / 512.f);
    const float rstd = rsqrtf(fmaxf(q * (1.f / 512.f) - mu * mu, 0.f) + 1e-5f);
#pragma unroll
    for (int i = 0; i < 16; ++i) {
      const int c0 = (i * 4 + cp) * 8;
      const f32x4 w0 = *reinterpret_cast<const f32x4*>(p.a_ln_w + c0), w1 = *reinterpret_cast<const f32x4*>(p.a_ln_w + c0 + 4);
      const f32x4 b0 = *reinterpret_cast<const f32x4*>(p.a_ln_b + c0), b1 = *reinterpret_cast<const f32x4*>(p.a_ln_b + c0 + 4);
#pragma unroll
      for (int e = 0; e < 8; ++e) {
        const float wv = e < 4 ? w0[e & 3] : w1[e & 3], bv = e < 4 ? b0[e & 3] : b1[e & 3];
        vnT[(c0 + e) * 136 + pos] = f2bf((bf2f((bf16_t)raw[i][e]) - mu) * rstd * wv + bv);
      }
    }
  }
  __syncthreads();
  const int g8 = wid;
  const bf16_t* Wg = WSB + g8 * 128 * 128;
  f32x16 acc[4][2];
#pragma unroll
  for (int pb = 0; pb < 4; ++pb) {
#pragma unroll
    for (int r = 0; r < 16; ++r) { acc[pb][0][r] = 0.f; acc[pb][1][r] = 0.f; }
#pragma unroll
    for (int ks = 0; ks < 8; ++ks) {
      const bf16x8 bw = *reinterpret_cast<const bf16x8*>(Wg + (pb * 32 + r32) * 128 + ks * 16 + hi * 8);
#pragma unroll
      for (int db = 0; db < 2; ++db) {
        const bf16x8 a = *reinterpret_cast<const bf16x8*>(vnT + (g8 * 64 + db * 32 + r32) * 136 + ks * 16 + hi * 8);
        acc[pb][db] = __builtin_amdgcn_mfma_f32_32x32x16_bf16(a, bw, acc[pb][db], 0, 0, 0);
      }
    }
  }
  asm volatile("s_waitcnt lgkmcnt(0)" ::: "memory");
  char* stg = (char*)vnT + (size_t)g8 * 64 * 272;
#pragma unroll
  for (int pb = 0; pb < 4; ++pb) {
    const float bias = p.a_bs[g8 * 128 + pb * 32 + r32];
#pragma unroll
    for (int db = 0; db < 2; ++db)
#pragma unroll
      for (int rg = 0; rg < 4; ++rg) {
        u32x2 pk = {cvtpk(acc[pb][db][rg * 4 + 0] + bias, acc[pb][db][rg * 4 + 1] + bias), cvtpk(acc[pb][db][rg * 4 + 2] + bias, acc[pb][db][rg * 4 + 3] + bias)};
        *reinterpret_cast<u32x2*>(stg + (pb * 32 + r32) * 136 + (db * 32 + rg * 8 + hi * 4) * 2) = pk;
      }
  }
  asm volatile("s_waitcnt lgkmcnt(0)" ::: "memory");
#pragma unroll 4
  for (int i = 0; i < 16; ++i) {
    const int c = lane + 64 * i, row = c >> 3, ch = c & 7;
    const u32x2 s0 = *reinterpret_cast<const u32x2*>(stg + row * 136 + ch * 16), s1 = *reinterpret_cast<const u32x2*>(stg + row * 136 + ch * 16 + 8);
    const size_t gi = (size_t)(t0 + row) * 512 + g8 * 64 + ch * 8;
    const u32x4 uv = *reinterpret_cast<const u32x4*>(U + gi), zv = *reinterpret_cast<const u32x4*>(ZA + gi);
    const unsigned sv[4] = {s0[0], s0[1], s1[0], s1[1]};
    u32x4 ov;
#pragma unroll
    for (int e = 0; e < 4; ++e) ov[e] = cvtpk(bflo(uv[e]) * bflo(sv[e]) * bflo(zv[e]), bfhi(uv[e]) * bfhi(sv[e]) * bfhi(zv[e]));
    *reinterpret_cast<u32x4*>(MIX + (size_t)(t0 + row) * 1024 + g8 * 64 + ch * 8) = ov;
  }
  __syncthreads();
}

DEVI void tr_tile(int wv, const float* __restrict__ src, bf16_t* __restrict__ dst, int K, int N, int tilesN4, const float* __restrict__ scale, int t, char* lds) {
  const int tid = tidx(wv);
  const int k0 = (t / tilesN4) * 64, n0 = (t % tilesN4) * 256;
  const int kr = tid >> 3, ng = (tid & 7) * 8;
  f32x4 v0[4], v1[4];
#pragma unroll
  for (int u = 0; u < 4; ++u) {
    v0[u] = (f32x4){0.f, 0.f, 0.f, 0.f}; v1[u] = v0[u];
    if (n0 + u * 64 + ng < N) { const float* s = src + (size_t)(k0 + kr) * N + n0 + u * 64 + ng; v0[u] = *reinterpret_cast<const f32x4*>(s); v1[u] = *reinterpret_cast<const f32x4*>(s + 4); }
  }
  const float scv = scale ? scale[k0 + kr] : 1.f;
  bf16_t* tl = (bf16_t*)lds;
#pragma unroll
  for (int u = 0; u < 4; ++u)
#pragma unroll
    for (int e = 0; e < 4; ++e) { tl[u * 4608 + (ng + e) * 72 + kr] = f2bf(v0[u][e] * scv); tl[u * 4608 + (ng + 4 + e) * 72 + kr] = f2bf(v1[u][e] * scv); }
  __syncthreads();
  const int n = tid >> 3, kc = (tid & 7) * 8;
#pragma unroll
  for (int u = 0; u < 4; ++u)
    *reinterpret_cast<bf16x8*>(dst + (size_t)(n0 + u * 64 + n) * K + k0 + kc) = *reinterpret_cast<const bf16x8*>(tl + u * 4608 + n * 72 + kc);
}

DEVI void tr_item(int wv, const Params& p, int t, char* lds) {
  if (t < 224) tr_tile(wv, p.even_w_in, (bf16_t*)(p.ws + OFF_W0IN), 1024, 3584, 14, nullptr, t, lds);
  else if (t < 288) tr_tile(wv, p.even_w_out, (bf16_t*)(p.ws + OFF_W0OUT), 1024, 1024, 4, nullptr, t - 224, lds);
  else if (t < 384) tr_tile(wv, p.odd_w_in, (bf16_t*)(p.ws + OFF_W1IN), 1024, 1472, 6, nullptr, t - 288, lds);
  else if (t < 408) tr_tile(wv, p.c_wq_b, (bf16_t*)(p.ws + OFF_WQ), 256, 1536, 6, p.c_q_norm_w, t - 384, lds);
  else if (t < 424) tr_tile(wv, p.c_wkv_b, (bf16_t*)(p.ws + OFF_WKV), 128, 2048, 8, p.c_kv_norm_w, t - 408, lds);
  else tr_tile(wv, p.odd_w_out, (bf16_t*)(p.ws + OFF_W1OUT), 1024, 1024, 4, nullptr, t - 424, lds);
  __syncthreads();
}

DEVI void phase0(int wv, const Params& p, char* lds) {
  const int tid = tidx(wv);
  constexpr int N_ADA = 192, N_TR = 224, N_WS = 16;
  for (int it = blockIdx.x; it < N_ADA + N_TR + N_WS + 1; it += gridDim.x) {
    if (it < N_ADA) {
      const int li = it / 96, chunk = it % 96;
      float* sc = (float*)lds;
      for (int idx = tid; idx < 17 * 1024; idx += 512) { const int r = idx >> 10, k = idx & 1023; const float xv = r < 16 ? p.c[r * 1024 + k] : p.c_ctx[k]; sc[idx] = xv / (1.f + expf(-xv)); }
      __syncthreads();
      const int col = tid & 31, kp = tid >> 5;
      const float* w = p.ada_w + (size_t)li * 1024 * 3072 + chunk * 32 + col;
      float acc[17];
#pragma unroll
      for (int r = 0; r < 17; ++r) acc[r] = 0.f;
#pragma unroll 2
      for (int k = kp * 64; k < kp * 64 + 64; k += 4) {
        const float w0 = w[(size_t)k * 3072], w1 = w[(size_t)(k + 1) * 3072], w2 = w[(size_t)(k + 2) * 3072], w3 = w[(size_t)(k + 3) * 3072];
#pragma unroll
        for (int r = 0; r < 17; ++r) { const f32x4 s4 = *reinterpret_cast<const f32x4*>(sc + r * 1024 + k); acc[r] += s4[0] * w0 + s4[1] * w1 + s4[2] * w2 + s4[3] * w3; }
      }
      float* red = (float*)(lds + 17 * 1024 * 4);
#pragma unroll
      for (int r = 0; r < 17; ++r) red[(kp * 17 + r) * 32 + col] = acc[r];
      __syncthreads();
      float* ada = (float*)(p.ws + OFF_ADA);
      for (int idx = tid; idx < 544; idx += 512) {
        const int r = idx >> 5, cc = idx & 31; float s = 0.f;
        for (int k2 = 0; k2 < 16; ++k2) s += red[(k2 * 17 + r) * 32 + cc];
        ada[(size_t)(li * 17 + r) * 3072 + chunk * 32 + cc] = s + p.ada_b[li * 3072 + chunk * 32 + cc];
      }
    } else if (it < N_ADA + N_TR) {
      tr_tile(wv, p.even_w_in, (bf16_t*)(p.ws + OFF_W0IN), 1024, 3584, 14, nullptr, it - N_ADA, lds);
    } else if (it < N_ADA + N_TR + N_WS) {
      const int base = (it - N_ADA - N_TR) * 8192 + tid * 16;
      bf16_t* dst = (bf16_t*)(p.ws + OFF_WSB) + base; const float* s = p.a_ws + base;
#pragma unroll
      for (int q = 0; q < 2; ++q) {
        const f32x4 a = *reinterpret_cast<const f32x4*>(s + q * 8), b = *reinterpret_cast<const f32x4*>(s + q * 8 + 4);
        u32x4 w = {cvtpk(a[0], a[1]), cvtpk(a[2], a[3]), cvtpk(b[0], b[1]), cvtpk(b[2], b[3])};
        *reinterpret_cast<u32x4*>(dst + q * 8) = w;
      }
    } else {
      float2* tab = (float2*)(p.ws + OFF_ROPE);
      for (int e = tid; e < 1024; e += 512) {
        const int pos = e >> 4, j = e & 15;
        const float inv = exp2f(-(float)j * (13.287712379549449f / 16.f));
        const float ang = (float)pos * inv;
        const float nrev = rintf(ang * 0.15915494309189535f);
        float rr = fmaf(-nrev, 6.2831855f, ang); rr = fmaf(-nrev, -1.7484555e-7f, rr);
        tab[e] = make_float2(__cosf(rr), __sinf(rr));
      }
    }
    __syncthreads();
  }
}

template <bool RES>
DEVI void norm_mod(int wv, const float* src_lat, const float* src_ctx, const float* __restrict__ nw, const float* __restrict__ ada, bf16_t* X,
                   int row_lo, int row_hi, int vb, int nvb, const float* __restrict__ ada_prev = nullptr, float* hdst_lat = nullptr, float* hdst_ctx = nullptr) {
  const int tid_ = tidx(wv); const int wid = tid_ >> 6, lane = tid_ & 63;
  for (int row0 = row_lo + (vb * 8 + wid) * 2; row0 < row_hi; row0 += nvb * 16) {
    f32x4 v[2][4]; u32x2 ov[2][4]; float ss[2];
#pragma unroll
    for (int q = 0; q < 2; ++q) {
      const int row = row0 + q;
      const float* src = row < NLAT ? src_lat + (size_t)row * 1024 : src_ctx + (size_t)(row - NLAT) * 1024;
      ss[q] = 0.f;
#pragma unroll
      for (int i = 0; i < 4; ++i) {
        v[q][i] = __builtin_nontemporal_load(reinterpret_cast<const f32x4*>(src + i * 256 + lane * 4));
        if constexpr (RES) ov[q][i] = *reinterpret_cast<const u32x2*>(X + (size_t)row * 1024 + i * 256 + lane * 4);
      }
    }
    if constexpr (RES) {
#pragma unroll
      for (int q = 0; q < 2; ++q) {
        const int row = row0 + q;
        const float* gp = ada_prev + (row < NLAT ? (row >> 11) : 16) * 3072 + 2048;
        float* hd = row < NLAT ? hdst_lat + (size_t)row * 1024 : hdst_ctx + (size_t)(row - NLAT) * 1024;
#pragma unroll
        for (int i = 0; i < 4; ++i) {
          const int c = i * 256 + lane * 4;
          const f32x4 g = *reinterpret_cast<const f32x4*>(gp + c);
          v[q][i][0] += g[0] * bflo(ov[q][i][0]); v[q][i][1] += g[1] * bfhi(ov[q][i][0]); v[q][i][2] += g[2] * bflo(ov[q][i][1]); v[q][i][3] += g[3] * bfhi(ov[q][i][1]);
          __builtin_nontemporal_store(v[q][i], reinterpret_cast<f32x4*>(hd + c));
        }
      }
    }
#pragma unroll
    for (int q = 0; q < 2; ++q) {
#pragma unroll
      for (int i = 0; i < 4; ++i) ss[q] += v[q][i][0] * v[q][i][0] + v[q][i][1] * v[q][i][1] + v[q][i][2] * v[q][i][2] + v[q][i][3] * v[q][i][3];
      ss[q] = wave_sum(ss[q]);
    }
#pragma unroll
    for (int q = 0; q < 2; ++q) {
      const int row = row0 + q;
      const float* ad = ada + (row < NLAT ? (row >> 11) : 16) * 3072;
      const float r = rsqrtf(ss[q] * (1.f / 1024.f) + 1e-6f);
#pragma unroll
      for (int i = 0; i < 4; ++i) {
        const int c = i * 256 + lane * 4;
        const f32x4 w = *reinterpret_cast<const f32x4*>(nw + c), sh = *reinterpret_cast<const f32x4*>(ad + c), scl = *reinterpret_cast<const f32x4*>(ad + 1024 + c);
        float o[4];
#pragma unroll
        for (int e = 0; e < 4; ++e) o[e] = v[q][i][e] * r * w[e] * (1.f + scl[e]) + sh[e];
        u32x2 pk = {cvtpk(o[0], o[1]), cvtpk(o[2], o[3])};
        *reinterpret_cast<u32x2*>(X + (size_t)row * 1024 + c) = pk;
      }
    }
  }
}

DEVI void final_norm(int wv, float* out, const float* __restrict__ fw, const bf16_t* __restrict__ O1, const float* __restrict__ ada1) {
  const int tid_ = tidx(wv); const int wid = tid_ >> 6, lane = tid_ & 63;
  for (int row0 = (blockIdx.x * 8 + wid) * 2; row0 < NLAT; row0 += gridDim.x * 16) {
    f32x4 v[2][4]; u32x2 ov[2][4]; float ss[2];
#pragma unroll
    for (int q = 0; q < 2; ++q) {
      ss[q] = 0.f;
#pragma unroll
      for (int i = 0; i < 4; ++i) {
        v[q][i] = __builtin_nontemporal_load(reinterpret_cast<const f32x4*>(out + (size_t)(row0 + q) * 1024 + i * 256 + lane * 4));
        ov[q][i] = *reinterpret_cast<const u32x2*>(O1 + (size_t)(row0 + q) * 1024 + i * 256 + lane * 4);
      }
    }
#pragma unroll
    for (int q = 0; q < 2; ++q) {
      const float* gp = ada1 + ((row0 + q) >> 11) * 3072 + 2048;
#pragma unroll
      for (int i = 0; i < 4; ++i) {
        const f32x4 g = *reinterpret_cast<const f32x4*>(gp + i * 256 + lane * 4);
        v[q][i][0] += g[0] * bflo(ov[q][i][0]); v[q][i][1] += g[1] * bfhi(ov[q][i][0]); v[q][i][2] += g[2] * bflo(ov[q][i][1]); v[q][i][3] += g[3] * bfhi(ov[q][i][1]);
        ss[q] += v[q][i][0] * v[q][i][0] + v[q][i][1] * v[q][i][1] + v[q][i][2] * v[q][i][2] + v[q][i][3] * v[q][i][3];
      }
      ss[q] = wave_sum(ss[q]);
    }
#pragma unroll
    for (int q = 0; q < 2; ++q) {
      const float r = rsqrtf(ss[q] * (1.f / 1024.f) + 1e-6f);
#pragma unroll
      for (int i = 0; i < 4; ++i) {
        const int c = i * 256 + lane * 4;
        const f32x4 w = *reinterpret_cast<const f32x4*>(fw + c);
        __builtin_nontemporal_store(v[q][i] * r * w, reinterpret_cast<f32x4*>(out + (size_t)(row0 + q) * 1024 + c));
      }
    }
  }
}

typedef const __attribute__((address_space(4))) Params* KArgP;
DEVI void run_phase(int wv, KArgP pp, int ph, char* lds) {
#if defined(__HIP_DEVICE_COMPILE__)
  asm volatile("" : "+s"(pp));
  char* ws = pp->ws;
  const float2* rope = (const float2*)(ws + OFF_ROPE);
  const float* ada0 = (const float*)(ws + OFF_ADA); const float* ada1 = ada0 + 17 * 3072;
  bf16_t* X = (bf16_t*)(ws + OFF_X); bf16_t* MIX = (bf16_t*)(ws + OFF_MIX);
  const int G = gridDim.x, B = blockIdx.x;
  PG8_LAS unsigned char* ldsp = (PG8_LAS unsigned char*)lds;
  switch (ph) {
    case 0: { const Params p = *pp; phase0(wv, p, lds); } break;
    case 1: norm_mod<false>(wv, pp->x, pp->ctx, pp->norm_w, ada0, X, 0, NTOK, B, G); break;
    case 2: {
      EpiL0In epi{(bf16_t*)(ws + OFF_U), (bf16_t*)(ws + OFF_GV), (bf16_t*)(ws + OFF_ZA), (bf16_t*)(ws + OFF_ZB), (bf16_t*)(ws + OFF_Q0), (bf16_t*)(ws + OFF_K0), (bf16_t*)(ws + OFF_V0), rope};
      gemm_phase(wv, ldsp, X, (const bf16_t*)(ws + OFF_W0IN), 1024, Sched{14, 144 * 14, 144 * 14, 0, 0}, epi);
    } break;
    case 3: { const Params p = *pp;
      for (int it = B; it < 1024 + 288 + 128; it += G) {
        if (it < 1024) {
          const int xcd = it & 7, slot = (it >> 3) & 31, rd = it >> 8;
          const int bh = rd * 16 + xcd * 2 + (slot >> 4), qb = slot & 15, b = bh >> 2, h = bh & 3;
          attn0_item(wv, p, b * 2048 + qb * 128, b, h, KVL, lds);
        } else if (it < 1024 + 288) abranch_item(wv, p, it - 1024, lds);
        else { const int i2 = it - 1312; const int b = i2 >> 3, h = (i2 >> 1) & 3, qb = i2 & 1; attn0_item(wv, p, NLAT + b * 256 + qb * 128, b, h, 256, lds); }
      }
      {
        const int nb = G >= 192 ? 96 : G, base = G - nb;
        if (B >= base) for (int t = 224 + (B - base); t < 288; t += nb) tr_item(wv, p, t, lds);
      }
    } break;
    case 4: {
      EpiPlain epi{X};
      gemm_phase(wv, ldsp, MIX, (const bf16_t*)(ws + OFF_W0OUT), 1024, Sched{4, 144 * 4, 144 * 4, 0, 0}, epi);
      {
        const Params p = *pp; const int nb = G > 64 ? G - 64 : G, base = G - nb;
        if (B >= base) for (int t = 288 + (B - base); t < 488; t += nb) tr_item(wv, p, t, lds);
      }
    } break;
    case 5: {
      if (B >= G - 16) {
        const int cp = B - (G - 16);
        norm_mod<true>(wv, pp->x, pp->ctx, pp->norm_w + 1024, ada1, X, NLAT + cp * 256, NLAT + cp * 256 + 256, 0, 1, ada0, pp->out, (float*)(ws + OFF_H1C));
        asm volatile("s_waitcnt vmcnt(0)" ::: "memory"); __syncthreads();
        EpiL1In epi{(bf16_t*)(ws + OFF_CQ), (bf16_t*)(ws + OFF_CKV), (bf16_t*)(ws + OFF_K1), (bf16_t*)(ws + OFF_Z1), (float*)(ws + OFF_RQ), (float*)(ws + OFF_RKV), rope, (float*)(lds + LDS_SS)};
        gemm_phase(wv, ldsp, X, (const bf16_t*)(ws + OFF_W1IN), 1024, Sched{6, 0, 16, 128, 1, G - 16}, epi);
      } else norm_mod<true>(wv, pp->x, pp->ctx, pp->norm_w + 1024, ada1, X, 0, NLAT, B, G - 16, ada0, pp->out, (float*)(ws + OFF_H1C));
    } break;
    case 6: {
      EpiL1In epi{(bf16_t*)(ws + OFF_CQ), (bf16_t*)(ws + OFF_CKV), (bf16_t*)(ws + OFF_K1), (bf16_t*)(ws + OFF_Z1), (float*)(ws + OFF_RQ), (float*)(ws + OFF_RKV), rope, (float*)(lds + LDS_SS)};
      gemm_phase(wv, ldsp, X, (const bf16_t*)(ws + OFF_W1IN), 1024, Sched{6, 768, 768, 128, 1}, epi);
    } break;
    case 7: {
      EpiQ eq{(bf16_t*)(ws + OFF_Q1), (const float*)(ws + OFF_RQ), rope};
      EpiKV ek{(bf16_t*)(ws + OFF_K1), (bf16_t*)(ws + OFF_V1), (const float*)(ws + OFF_RKV)};
      gemm_phase(wv, ldsp, (const bf16_t*)(ws + OFF_CQ), (const bf16_t*)(ws + OFF_WQ), 256, Sched{6, 768, 768, 0, 0}, eq);
      gemm_phase(wv, ldsp, (const bf16_t*)(ws + OFF_CKV), (const bf16_t*)(ws + OFF_WKV), 128, Sched{8, 1152, 1152, 0, 0}, ek);
    } break;
    case 8: { const Params p = *pp;
      for (int it = B; it < 1024; it += G) {
        const int xcd = it & 7, slot = (it >> 3) & 31, rd = it >> 8;
        const int bh = rd * 32 + xcd * 4 + (slot >> 3), qb = slot & 7;
        attn1_item(wv, p, bh >> 3, bh & 7, qb, lds);
      }
    } break;
    case 9: {
      EpiPlain epi{X};
      gemm_phase(wv, ldsp, MIX, (const bf16_t*)(ws + OFF_W1OUT), 1024, Sched{4, 128 * 4, 128 * 4, 0, 0}, epi);
    } break;
    case 10: final_norm(wv, pp->out, pp->final_w, X, ada1); break;
  }
#endif
}


#define XB_TMO      128
#define XB_XCNT(j)  (256  + 64 * (j))
#define XB_XSUB(j)  (1280 + 64 * (j))
#define XB_XGEN(j)  (2304 + 64 * (j))
#define XB_TOP      3328
#define XB_TOPGEN   3392
#define XCD_BAR_WORDS 3456
#define XB_SPIN_CAP (1u << 18)
#define LAS __attribute__((address_space(3)))
DEVI unsigned xb_ld(unsigned* p) { return __hip_atomic_load(p, __ATOMIC_RELAXED, __HIP_MEMORY_SCOPE_AGENT); }
DEVI unsigned xb_add(unsigned* p, unsigned v) { return __hip_atomic_fetch_add(p, v, __ATOMIC_RELAXED, __HIP_MEMORY_SCOPE_AGENT); }
DEVI unsigned xb_xcc_id() { return (unsigned)__builtin_amdgcn_s_getreg((3 << 11) | 20) & 0xFu; }
#define XB_SPIN(cond, bar) do { unsigned _sp = 0; while (cond) { __builtin_amdgcn_s_sleep(1); \
    if ((++_sp & 255u) == 0u) { if (xb_ld(&(bar)[XB_TMO])) break; if (_sp > XB_SPIN_CAP) { atomicAdd(&(bar)[XB_TMO], 1u); break; } } } } while (0)
struct XcdBarrier { unsigned* bar; unsigned x; volatile LAS unsigned* st; };
DEVI XcdBarrier xcd_barrier_post(int wv, unsigned* bar, volatile LAS unsigned* st) {
  XcdBarrier b; b.bar = bar; b.x = xb_xcc_id(); b.st = st;
  if (tidx(wv) == 0) (void)xb_add(&bar[XB_XCNT(b.x)], 1u);
  return b;
}
DEVI void xcd_barrier_complete(unsigned* bar, unsigned x, unsigned& nloc, unsigned& nx) {
  const unsigned G = gridDim.x * gridDim.y * gridDim.z;
  unsigned sum, cnt, mine, sp = 0u;
  for (;;) {
    sum = 0u; cnt = 0u; mine = 0u;
#pragma unroll
    for (unsigned j = 0; j < 16; ++j) { const unsigned c = xb_ld(&bar[XB_XCNT(j)]); sum += c; cnt += (c > 0u) ? 1u : 0u; mine = (j == x) ? c : mine; }
    if (sum == G) break;
    __builtin_amdgcn_s_sleep(1);
    if ((++sp & 255u) == 0u) { if (xb_ld(&bar[XB_TMO])) break; if (sp > XB_SPIN_CAP) { atomicAdd(&bar[XB_TMO], 1u); break; } }
  }
  nloc = mine > 0u ? mine : 1u; nx = cnt > 0u ? cnt : 1u;
}
DEVI void xcd_barrier(int wv, const XcdBarrier& b) {
  asm volatile("s_waitcnt vmcnt(0)" ::: "memory");
  __syncthreads();
  if (tidx(wv) == 0) {
    unsigned* bar = b.bar;
    __builtin_amdgcn_s_waitcnt(0);
    unsigned nloc = b.st[0], nx = b.st[1];
    if (nloc == 0u) { xcd_barrier_complete(bar, b.x, nloc, nx); b.st[0] = nloc; b.st[1] = nx; }
    const unsigned old = xb_add(&bar[XB_XSUB(b.x)], 1u);
    const unsigned gen = old / nloc;
    if (old + 1u == (gen + 1u) * nloc) {
      __builtin_amdgcn_fence(__ATOMIC_RELEASE, "agent");
      asm volatile("s_waitcnt vmcnt(0)" ::: "memory");
      const unsigned og = xb_add(&bar[XB_TOP], 1u);
      const unsigned tg = og / nx;
      if (og + 1u == (tg + 1u) * nx) xb_add(&bar[XB_TOPGEN], 1u);
      else XB_SPIN(xb_ld(&bar[XB_TOPGEN]) == tg, bar);
      __builtin_amdgcn_fence(__ATOMIC_ACQUIRE, "agent");
      xb_add(&bar[XB_XGEN(b.x)], 1u);
      asm volatile("s_waitcnt vmcnt(0)" ::: "memory");
    } else {
      XB_SPIN(xb_ld(&bar[XB_XGEN(b.x)]) == gen, bar);
      __builtin_amdgcn_fence(__ATOMIC_ACQUIRE, "agent");
      asm volatile("s_waitcnt vmcnt(0)" ::: "memory");
    }
  }
  __syncthreads();
}

extern __shared__ __attribute__((aligned(16))) char g_lds[];

constexpr int LDS_XB = 143360;
__global__ void __launch_bounds__(512) mega(Params p) {
  cg::grid_group grid = cg::this_grid();
  if (p.ph_hi > 64) grid.sync();
  const int wv = __builtin_amdgcn_readfirstlane((int)threadIdx.x >> 6);
  volatile LAS unsigned* xst = (volatile LAS unsigned*)(g_lds + LDS_XB);
  if (tidx(wv) == 0) { xst[0] = 0u; xst[1] = 0u; }
  __syncthreads();
  (void)xcd_barrier_post(wv, (unsigned*)(p.ws + OFF_BAR), xst);
#define GRID_BARRIER() do { KArgP _pp = (KArgP)__builtin_amdgcn_kernarg_segment_ptr(); asm volatile("" : "+s"(_pp)); \
    XcdBarrier _xb; _xb.bar = (unsigned*)(_pp->ws + OFF_BAR); _xb.x = xb_xcc_id(); _xb.st = (volatile LAS unsigned*)(g_lds + LDS_XB); xcd_barrier(wv, _xb); } while (0)
  for (int ph = p.ph_lo; ph < p.ph_hi; ++ph) {
    run_phase(wv, (KArgP)__builtin_amdgcn_kernarg_segment_ptr(), ph, g_lds);
#ifdef PROBE_PH
    if (ph == PROBE_PH) { GRID_BARRIER(); run_phase(wv, (KArgP)__builtin_amdgcn_kernarg_segment_ptr(), ph, g_lds); }
#endif
    if (ph + 1 < p.ph_hi) GRID_BARRIER();
  }
}

extern "C" void kernel_launch(void* const* d_in, const int* in_sizes, int n_in, void* d_out, int out_size, void* d_ws, size_t ws_size, hipStream_t stream) {
  static int ok = 0;
  static int grid_blocks = 0;
  if (!ok) {
    if (n_in != 25 || ws_size < WS_NEED) { fprintf(stderr, "kernel_launch: bad args n_in %d ws %zu need %zu\n", n_in, ws_size, (size_t)WS_NEED); return; }
    if (hipFuncSetAttribute((const void*)mega, hipFuncAttributeMaxDynamicSharedMemorySize, LDS_BYTES) != hipSuccess) { fprintf(stderr, "kernel_launch: LDS attr failed\n"); return; }
    int dev = 0, cus = 0, per_cu = 0;
    hipGetDevice(&dev);
    hipDeviceGetAttribute(&cus, hipDeviceAttributeMultiprocessorCount, dev);
    hipOccupancyMaxActiveBlocksPerMultiprocessor(&per_cu, mega, 512, LDS_BYTES);
    if (per_cu < 1) per_cu = 1;
    grid_blocks = cus * per_cu;
    ok = 1;
  }
  Params p{};
  const float** pp = (const float**)&p;
  for (int i = 0; i < 25; ++i) pp[i] = (const float*)d_in[i];
  p.out = (float*)d_out; p.ws = (char*)d_ws;
#if ONE_LAUNCH
  p.ph_lo = 0; p.ph_hi = 11;
  hipMemsetAsync((char*)d_ws + OFF_BAR, 0, XCD_BAR_WORDS * 4, stream);
  void* args[] = {&p};
  hipError_t e = hipLaunchCooperativeKernel((const void*)mega, dim3(grid_blocks), dim3(512), args, LDS_BYTES, stream);
  if (e != hipSuccess) fprintf(stderr, "cooperative launch failed: %s (grid %d)\n", hipGetErrorString(e), grid_blocks);
#else
  for (int ph = 0; ph < 11; ++ph) {
    p.ph_lo = ph; p.ph_hi = ph + 1;
    hipLaunchKernelGGL(mega, dim3(grid_blocks), dim3(512), LDS_BYTES, stream, p);
  }
#endif
}
```

```cpp
#include <hip/hip_runtime.h>
#include <hip/hip_cooperative_groups.h>
#include <cstdio>
namespace cg = cooperative_groups;

#ifndef ATT_SD0
#define ATT_SD0 2
#endif
#ifndef ONE_LAUNCH
#define ONE_LAUNCH 1
#endif

typedef unsigned short bf16_t;
typedef short bf16x8 __attribute__((ext_vector_type(8)));
typedef short s16x4 __attribute__((ext_vector_type(4)));
typedef float f32x16 __attribute__((ext_vector_type(16)));
typedef float f32x4 __attribute__((ext_vector_type(4)));
typedef unsigned u32x4 __attribute__((ext_vector_type(4)));
typedef unsigned u32x2 __attribute__((ext_vector_type(2)));
#define DEVI __device__ __forceinline__
#define SBAR() __builtin_amdgcn_sched_barrier(0)
DEVI int tidx(int wv) { int l; asm volatile("v_mbcnt_lo_u32_b32 %0, -1, 0\n\tv_mbcnt_hi_u32_b32 %0, -1, %0" : "=v"(l)); return (wv << 6) | l; }

constexpr int NLAT = 32768, NCTX = 4096, NTOK = 36864, KVL = 2304;
constexpr int LDS_BYTES = 147456, LDS_SS = 139264;

constexpr size_t OFF_W0IN = 0;
constexpr size_t OFF_W0OUT = OFF_W0IN + 3584ull * 1024 * 2;
constexpr size_t OFF_W1IN = OFF_W0OUT + 1024ull * 1024 * 2;
constexpr size_t OFF_WQ = OFF_W1IN + 1536ull * 1024 * 2;
constexpr size_t OFF_WKV = OFF_WQ + 1536ull * 256 * 2;
constexpr size_t OFF_W1OUT = OFF_WKV + 2048ull * 128 * 2;
constexpr size_t OFF_WSB = OFF_W1OUT + 1024ull * 1024 * 2;
constexpr size_t OFF_ADA = OFF_WSB + 8ull * 128 * 128 * 2;
constexpr size_t OFF_ROPE = OFF_ADA + 2ull * 17 * 3072 * 4;
constexpr size_t OFF_BAR = OFF_ROPE + 64ull * 16 * 8;
constexpr size_t OFF_H1C = OFF_BAR + 16384;
constexpr size_t OFF_RQ = OFF_H1C + 4096ull * 1024 * 4;
constexpr size_t OFF_RKV = OFF_RQ + 32768ull * 4;
constexpr size_t OFF_X = OFF_RKV + 36864ull * 4;
constexpr size_t OFF_MIX = OFF_X + 36864ull * 1024 * 2;
constexpr size_t OFF_T = OFF_MIX + 36864ull * 1024 * 2;
constexpr size_t SZ_HALF = 36864ull * 512 * 2;
constexpr size_t OFF_U = OFF_T, OFF_GV = OFF_U + SZ_HALF, OFF_ZA = OFF_GV + SZ_HALF, OFF_ZB = OFF_ZA + SZ_HALF, OFF_Q0 = OFF_ZB + SZ_HALF;
constexpr size_t OFF_K0 = OFF_Q0 + SZ_HALF, OFF_V0 = OFF_K0 + 16ull * 4 * KVL * 128 * 2, END_L0 = OFF_V0 + 16ull * 4 * KVL * 128 * 2;
constexpr size_t OFF_CQ = OFF_T, OFF_CKV = OFF_CQ + 32768ull * 256 * 2, OFF_Z1 = OFF_CKV + 36864ull * 128 * 2;
constexpr size_t OFF_Q1 = OFF_Z1 + 32768ull * 1024 * 2, OFF_K1 = OFF_Q1 + 32768ull * 1536 * 2, END_L1 = OFF_K1 + 16ull * 8 * KVL * 192 * 2;
constexpr size_t OFF_V1 = OFF_X;
constexpr size_t WS_NEED = END_L1 > END_L0 ? END_L1 : END_L0;

struct Params {
  const float *x, *c, *ctx, *c_ctx, *norm_w, *ada_w, *ada_b, *even_w_in, *a_ws, *a_bs, *a_ln_w, *a_ln_b,
      *b_lq1, *b_lk1, *b_lq2, *b_lk2, *b_subln_w, *even_w_out, *odd_w_in, *c_q_norm_w, *c_wq_b,
      *c_kv_norm_w, *c_wkv_b, *odd_w_out, *final_w;
  float* out; char* ws; int ph_lo, ph_hi;
};

DEVI unsigned cvtpk(float lo, float hi) { unsigned r; asm("v_cvt_pk_bf16_f32 %0, %1, %2" : "=v"(r) : "v"(lo), "v"(hi)); return r; }
DEVI bf16_t f2bf(float v) { return (bf16_t)(cvtpk(v, 0.f) & 0xffffu); }
DEVI float bf2f(bf16_t v) { return __uint_as_float(((unsigned)v) << 16); }
DEVI float bflo(unsigned w) { return __uint_as_float(w << 16); }
DEVI float bfhi(unsigned w) { return __uint_as_float(w & 0xffff0000u); }
DEVI int crow(int r, int hi) { return (r & 3) + 8 * (r >> 2) + 4 * hi; }
DEVI float silu_f(float x) { return x * __builtin_amdgcn_rcpf(1.f + __builtin_amdgcn_exp2f(x * -1.4426950408889634f)); }
DEVI float gelu_f(float v) {
  const float t = __builtin_amdgcn_rcpf(fmaf(fabsf(v), 0.2316418882f, 1.0f));
  float q = fmaf(t, 0.5307027145f, -0.7265760135f); q = fmaf(q, t, 0.7107068705f); q = fmaf(q, t, -0.142248368f); q = fmaf(q, t, 0.127414796f); q *= t;
  const float m = v * (q * __builtin_amdgcn_exp2f(v * v * -0.72134752044f));
  return v < 0.f ? m : v - m;
}

template <int M> DEVI float xsum(float v) {
  if constexpr (M == 32) { auto rr = __builtin_amdgcn_permlane32_swap(__float_as_uint(v), __float_as_uint(v), false, false); return __uint_as_float(rr[0]) + __uint_as_float(rr[1]); }
  else return v + __int_as_float(__builtin_amdgcn_ds_swizzle(__float_as_int(v), (M << 10) | 0x1f));
}
DEVI float wave_sum(float v) { v = xsum<1>(v); v = xsum<2>(v); v = xsum<4>(v); v = xsum<8>(v); v = xsum<16>(v); return xsum<32>(v); }

DEVI void rope_tile(f32x16& v, const float2* __restrict__ tab, int pos, int hi) {
#pragma unroll
  for (int r = 0; r < 8; ++r) {
    const int jf = (r & 3) + 8 * (r >> 2) + 4 * hi;
    const float2 cs = tab[pos * 16 + jf];
    const float a = v[r], b = v[r + 8];
    v[r] = a * cs.x - b * cs.y; v[r + 8] = b * cs.x + a * cs.y;
  }
}
DEVI void store4(bf16_t* dst, const f32x16& v, int rg) {
  u32x2 pk = {cvtpk(v[rg * 4 + 0], v[rg * 4 + 1]), cvtpk(v[rg * 4 + 2], v[rg * 4 + 3])};
  *reinterpret_cast<u32x2*>(dst) = pk;
}

#define PG8_LAS __attribute__((address_space(3)))
constexpr int HTB = 128 * 64 * 2;
DEVI int lds_byte(int r, int c) { const int st = (r >> 4) * 2 + (c >> 5), rr = r & 15, cc = c & 31, ob = rr * 64 + cc * 2; return st * 1024 + (ob ^ (((ob >> 9) & 1) << 5)); }
DEVI void stage_rc(int b, int& R, int& C) { const int st = b / 1024, sb = b % 1024, swz = sb ^ (((sb >> 9) & 1) << 5); R = (st >> 1) * 16 + swz / 64; C = (st & 1) * 32 + (swz % 64) / 2; }
DEVI int perm32(int rho) { const int n = rho >> 4, i = rho & 15; return 8 * (i >> 2) + 4 * n + (i & 3); }
struct Unit { int pm, pn; };
struct Sched {
  int nN, nmain, ntotal, xpm0, xpn, boff = 0;
  DEVI bool next(int i, Unit& u) const {
    const int it = (int)blockIdx.x - boff + i * (int)gridDim.x; if (it < 0 || it >= ntotal) return false;
    if (it < nmain) {
      const int xcd = it & 7, jx = it >> 3, nMl = nmain / nN / 8, nig = 8 * nN, gid = jx / nig, fm = gid * 8, gsz = (nMl - fm) < 8 ? (nMl - fm) : 8, r = jx % nig;
      u.pm = (fm + r % gsz) * 8 + xcd; u.pn = r / gsz;
    } else { u.pm = xpm0 + (it - nmain); u.pn = xpn; }
    return true;
  }
};
template <class Epi>
DEVI void gemm_phase(int wv, PG8_LAS unsigned char* lds, const bf16_t* gA, const bf16_t* gBt, const int K, const Sched& S, const Epi& E) {
  const int tid = tidx(wv), wid = __builtin_amdgcn_readfirstlane(tid >> 6), lane = tid & 63, wr = wid >> 2, wc = wid & 3, fr = lane & 15, fq = lane >> 4;
  const int nt = K / 64;
  unsigned voffA[2], voffB[2];
#pragma unroll
  for (int i = 0; i < 2; ++i) { int R, C; stage_rc(tid * 16 + i * 8192, R, C); const int Rb = (R & ~31) + perm32(R & 31); voffA[i] = (unsigned)(R * K + C) * 2u; voffB[i] = (unsigned)(Rb * K + C) * 2u; }
  const size_t kstep = (size_t)(64 * 2);
  const size_t hstep = (size_t)128 * K * 2;
  const size_t tstep = 2 * hstep;
  const unsigned ldsw = (unsigned)wid * 1024u;
  const int aoff = lds_byte(wr * 64 + fr, fq * 8), boff = lds_byte(wc * 32 + fr, fq * 8);
#define PG8_SA(b, h) (((b) * 2 + (h)) * HTB)
#define PG8_SB(b, h) ((4 + (b) * 2 + (h)) * HTB)
#define PG8_STAGE(bufoff, gbase, voff) do { _Pragma("unroll") for (int _i = 0; _i < 2; ++_i) \
    __builtin_amdgcn_global_load_lds((const unsigned*)((const char*)(gbase) + (voff)[_i]), (PG8_LAS unsigned*)(lds + (bufoff) + ldsw + _i * 8192), 16, 0, 0); } while (0)
#define PG8_LDA(dst, b, h) do { _Pragma("unroll") for (int m = 0; m < 4; ++m) _Pragma("unroll") for (int k = 0; k < 2; ++k) dst[m][k] = *(const PG8_LAS bf16x8*)(lds + PG8_SA(b, h) + aoff + m * 2048 + k * 1024); } while (0)
#define PG8_LDB(dst, b, h) do { _Pragma("unroll") for (int n = 0; n < 2; ++n) _Pragma("unroll") for (int k = 0; k < 2; ++k) dst[n][k] = *(const PG8_LAS bf16x8*)(lds + PG8_SB(b, h) + boff + n * 2048 + k * 1024); } while (0)
#define PG8_MMA(ai, bj, At, Bt) do { __builtin_amdgcn_s_setprio(1); _Pragma("unroll") for (int m = 0; m < 4; ++m) _Pragma("unroll") for (int n = 0; n < 2; ++n) _Pragma("unroll") for (int k = 0; k < 2; ++k) \
    acc[ai][bj][m][n] = __builtin_amdgcn_mfma_f32_16x16x32_bf16(Bt[n][k], At[m][k], acc[ai][bj][m][n], 0, 0, 0); __builtin_amdgcn_s_setprio(0); } while (0)
#define PG8_WAIT_V(n) asm volatile("s_waitcnt vmcnt(" #n ")" ::: "memory")
#define PG8_WAIT_L(n) asm volatile("s_waitcnt lgkmcnt(" #n ")" ::: "memory")
#define PG8_BAR __builtin_amdgcn_s_barrier()
#define PG8_SCHED __builtin_amdgcn_sched_barrier(0)
  Unit cur, nxt; int ui = 0;
  if (!S.next(0, cur)) return;
  f32x4 acc[2][2][4][2];
#pragma unroll
  for (int a = 0; a < 2; ++a)
#pragma unroll
    for (int b = 0; b < 2; ++b)
#pragma unroll
      for (int m = 0; m < 4; ++m)
#pragma unroll
        for (int n = 0; n < 2; ++n) acc[a][b][m][n] = (f32x4){0.f, 0.f, 0.f, 0.f};
  bf16x8 At[4][2], B0[2][2], B1[2][2];
  const char* cA = (const char*)gA + (size_t)cur.pm * tstep; const char* cB = (const char*)gBt + (size_t)cur.pn * tstep;
  PG8_STAGE(PG8_SB(0, 0), cB, voffB); PG8_STAGE(PG8_SA(0, 0), cA, voffA); PG8_STAGE(PG8_SB(0, 1), cB + hstep, voffB); PG8_STAGE(PG8_SA(0, 1), cA + hstep, voffA);
  if (wr == 1) PG8_BAR;
  PG8_WAIT_V(4); PG8_BAR;
  PG8_STAGE(PG8_SB(1, 0), cB + kstep, voffB); PG8_STAGE(PG8_SA(1, 0), cA + kstep, voffA); PG8_STAGE(PG8_SB(1, 1), cB + hstep + kstep, voffB);
  PG8_WAIT_V(6); PG8_BAR;
  for (;;) {
    const bool has_next = S.next(ui + 1, nxt);
    const char* nA = has_next ? (const char*)gA + (size_t)nxt.pm * tstep : cA; const char* nB = has_next ? (const char*)gBt + (size_t)nxt.pn * tstep : cB;
#pragma unroll 1
    for (int t = 0; t < nt; t += 2) {
      const bool last = (t == nt - 2);
      const char* a1 = cA + (size_t)(t + 1) * kstep;
      const char* a2 = last ? nA : cA + (size_t)(t + 2) * kstep; const char* b2 = last ? nB : cB + (size_t)(t + 2) * kstep;
      const char* a3 = a2 + kstep; const char* b3 = b2 + kstep;
      PG8_LDB(B0, 0, 0); PG8_SCHED; PG8_LDA(At, 0, 0); PG8_STAGE(PG8_SA(1, 1), a1 + hstep, voffA);
      PG8_WAIT_L(8); PG8_BAR; PG8_WAIT_L(0); PG8_MMA(0, 0, At, B0); PG8_BAR; PG8_SCHED;
      PG8_LDB(B1, 0, 1); PG8_STAGE(PG8_SB(0, 0), b2, voffB);
      PG8_BAR; PG8_WAIT_L(0); PG8_MMA(0, 1, At, B1); PG8_BAR;
      PG8_LDA(At, 0, 1); PG8_STAGE(PG8_SA(0, 0), a2, voffA);
      PG8_BAR; PG8_WAIT_L(0); PG8_MMA(1, 0, At, B0); PG8_BAR; PG8_SCHED;
      PG8_STAGE(PG8_SB(0, 1), b2 + hstep, voffB);
      PG8_WAIT_V(6); PG8_BAR; PG8_MMA(1, 1, At, B1); PG8_BAR;
      PG8_LDB(B0, 1, 0); PG8_SCHED; PG8_LDA(At, 1, 0); PG8_STAGE(PG8_SA(0, 1), a2 + hstep, voffA);
      PG8_WAIT_L(8); PG8_BAR; PG8_WAIT_L(0); PG8_MMA(0, 0, At, B0); PG8_BAR; PG8_SCHED;
      PG8_LDB(B1, 1, 1); PG8_STAGE(PG8_SB(1, 0), b3, voffB);
      PG8_BAR; PG8_WAIT_L(0); PG8_MMA(0, 1, At, B1); PG8_BAR;
      PG8_LDA(At, 1, 1); PG8_STAGE(PG8_SA(1, 0), a3, voffA);
      PG8_BAR; PG8_WAIT_L(0); PG8_MMA(1, 0, At, B0); PG8_BAR; PG8_SCHED;
      PG8_STAGE(PG8_SB(1, 1), b3 + hstep, voffB);
      PG8_WAIT_V(6); PG8_BAR; PG8_MMA(1, 1, At, B1); PG8_BAR;
    }
    E(acc, cur, wr, wc, fr, fq);
    if (!has_next) break;
#pragma unroll
    for (int a = 0; a < 2; ++a)
#pragma unroll
      for (int b = 0; b < 2; ++b)
#pragma unroll
        for (int m = 0; m < 4; ++m)
#pragma unroll
          for (int n = 0; n < 2; ++n) acc[a][b][m][n] = (f32x4){0.f, 0.f, 0.f, 0.f};
    cur = nxt; cA = nA; cB = nB; ++ui;
  }
  PG8_WAIT_V(0);
  if (wr == 0) PG8_BAR;
  PG8_BAR;
#undef PG8_SA
#undef PG8_SB
#undef PG8_STAGE
#undef PG8_LDA
#undef PG8_LDB
#undef PG8_MMA
#undef PG8_WAIT_V
#undef PG8_WAIT_L
#undef PG8_BAR
#undef PG8_SCHED
}

typedef f32x4 acc_t[2][2][4][2];
DEVI void token_info(int token, bool ctx, int& b, int& s, int& key) {
  if (!ctx) { b = token >> 11; s = token & 2047; key = 256 + s; } else { const int tc = token - NLAT; b = tc >> 8; s = 0; key = tc & 255; }
}
DEVI float swap32_partner(float v, bool upper) {
  auto rr = __builtin_amdgcn_permlane32_swap(__float_as_uint(v), __float_as_uint(v), false, false);
  return __uint_as_float(upper ? rr[0] : rr[1]);
}
DEVI void rope_pair(f32x4& v0, f32x4& v1, const float2* __restrict__ tab, int pos, int fq) {
  const bool upper = fq >= 2;
  const float2* t = tab + pos * 16 + (fq & 1) * 8;
  const f32x4 t0 = *reinterpret_cast<const f32x4*>(t), t1 = *reinterpret_cast<const f32x4*>(t + 2), t2 = *reinterpret_cast<const f32x4*>(t + 4), t3 = *reinterpret_cast<const f32x4*>(t + 6);
  const float cs[8] = {t0[0], t0[2], t1[0], t1[2], t2[0], t2[2], t3[0], t3[2]}, sn[8] = {t0[1], t0[3], t1[1], t1[3], t2[1], t2[3], t3[1], t3[3]};
#pragma unroll
  for (int e = 0; e < 4; ++e) {
    const float p0 = swap32_partner(v0[e], upper), p1 = swap32_partner(v1[e], upper);
    const float s0 = upper ? sn[e] : -sn[e], s1 = upper ? sn[4 + e] : -sn[4 + e];
    v0[e] = v0[e] * cs[e] + p0 * s0; v1[e] = v1[e] * cs[4 + e] + p1 * s1;
  }
}
DEVI void st8(bf16_t* dst, const f32x4& v0, const f32x4& v1) { u32x4 pk = {cvtpk(v0[0], v0[1]), cvtpk(v0[2], v0[3]), cvtpk(v1[0], v1[1]), cvtpk(v1[2], v1[3])}; *reinterpret_cast<u32x4*>(dst) = pk; }

struct EpiL0In {
  bf16_t *U, *GV, *ZA, *ZB, *Q0, *K0, *V0; const float2* rope;
  DEVI void operator()(acc_t& acc, const Unit& u, int wr, int wc, int fr, int fq) const {
    const int col0 = u.pn * 256, type = col0 >> 9; const bool ctx = u.pm >= 128;
#pragma unroll
    for (int ai = 0; ai < 2; ++ai)
#pragma unroll
      for (int m = 0; m < 4; ++m) {
        const int token = u.pm * 256 + ai * 128 + wr * 64 + m * 16 + fr;
        int b, s, key; token_info(token, ctx, b, s, key);
#pragma unroll
        for (int bj = 0; bj < 2; ++bj) {
          const int nl = (col0 & 511) + bj * 128 + wc * 32;
          f32x4 v0 = acc[ai][bj][m][0], v1 = acc[ai][bj][m][1];
          bf16_t* dst;
          if (type <= 1) {
#pragma unroll
            for (int e = 0; e < 4; ++e) { v0[e] = gelu_f(v0[e]); v1[e] = gelu_f(v1[e]); }
            dst = (type == 0 ? U : GV) + (size_t)token * 512 + nl;
          } else if (type == 2 || type == 6) {
#pragma unroll
            for (int e = 0; e < 4; ++e) { v0[e] = silu_f(v0[e]); v1[e] = silu_f(v1[e]); }
            dst = (type == 2 ? ZA : ZB) + (size_t)token * 512 + nl;
          } else if (type == 3) {
            if (!ctx) rope_pair(v0, v1, rope, (wc & 1) ? (s & 63) : (s >> 6), fq);
            dst = Q0 + (size_t)token * 512 + nl;
          } else if (type == 4) {
            if (!ctx) rope_pair(v0, v1, rope, (wc & 1) ? (s & 63) : (s >> 6), fq);
            dst = K0 + ((size_t)(b * 4 + (nl >> 7)) * KVL + key) * 128 + (nl & 127);
          } else {
            dst = V0 + ((size_t)(b * 4 + (nl >> 7)) * KVL + key) * 128 + (nl & 127);
          }
          st8(dst + fq * 8, v0, v1);
        }
      }
  }
};

template <bool HASCTX> struct EpiOut {
  const float* src_lat; const float* src_ctx; float* dst_lat; float* dst_ctx; const float* ada;
  DEVI void operator()(acc_t& acc, const Unit& u, int wr, int wc, int fr, int fq) const {
    const int col0 = u.pn * 256;
#pragma unroll
    for (int ai = 0; ai < 2; ++ai)
#pragma unroll
      for (int m = 0; m < 4; ++m) {
        const int token = u.pm * 256 + ai * 128 + wr * 64 + m * 16 + fr;
        const float* src; float* dst; const float* gate;
        if (!HASCTX || token < NLAT) { src = src_lat + (size_t)token * 1024; dst = dst_lat + (size_t)token * 1024; gate = ada + (token >> 11) * 3072 + 2048; }
        else { const int tc = token - NLAT; src = src_ctx + (size_t)tc * 1024; dst = dst_ctx + (size_t)tc * 1024; gate = ada + 16 * 3072 + 2048; }
#pragma unroll
        for (int bj = 0; bj < 2; ++bj)
#pragma unroll
          for (int n = 0; n < 2; ++n) {
            const int c = col0 + bj * 128 + wc * 32 + fq * 8 + n * 4;
            const f32x4 xv = *reinterpret_cast<const f32x4*>(src + c), g = *reinterpret_cast<const f32x4*>(gate + c);
            *reinterpret_cast<f32x4*>(dst + c) = xv + g * acc[ai][bj][m][n];
          }
      }
  }
};

struct EpiPlain {
  bf16_t* O;
  DEVI void operator()(acc_t& acc, const Unit& u, int wr, int wc, int fr, int fq) const {
    const int col0 = u.pn * 256;
#pragma unroll
    for (int ai = 0; ai < 2; ++ai)
#pragma unroll
      for (int m = 0; m < 4; ++m) {
        const int token = u.pm * 256 + ai * 128 + wr * 64 + m * 16 + fr;
#pragma unroll
        for (int bj = 0; bj < 2; ++bj) st8(O + (size_t)token * 1024 + col0 + bj * 128 + wc * 32 + fq * 8, acc[ai][bj][m][0], acc[ai][bj][m][1]);
      }
  }
};

struct EpiL1In {
  bf16_t *CQ, *CKV, *K1, *Z1; float *RQ, *RKV; const float2* rope; float* ssb;
  DEVI void operator()(acc_t& acc, const Unit& u, int wr, int wc, int fr, int fq) const {
    const int col0 = u.pn * 256; const bool ctx = u.pm >= 128;
    float ss[2][4];
#pragma unroll
    for (int ai = 0; ai < 2; ++ai)
#pragma unroll
      for (int m = 0; m < 4; ++m) {
        ss[ai][m] = 0.f;
        const int token = u.pm * 256 + ai * 128 + wr * 64 + m * 16 + fr;
        int b, s, key; token_info(token, ctx, b, s, key);
#pragma unroll
        for (int bj = 0; bj < 2; ++bj) {
          const int nb = col0 + bj * 128 + wc * 32;
          f32x4 v0 = acc[ai][bj][m][0], v1 = acc[ai][bj][m][1];
          if (nb < 384) {
#pragma unroll
            for (int e = 0; e < 4; ++e) ss[ai][m] += v0[e] * v0[e] + v1[e] * v1[e];
            bf16_t* dst = nb < 256 ? CQ + (size_t)token * 256 + nb : CKV + (size_t)token * 128 + (nb - 256);
            st8(dst + fq * 8, v0, v1);
          } else if (nb < 448) {
            if (!ctx) rope_pair(v0, v1, rope, (nb >= 416) ? (s & 63) : (s >> 6), fq);
#pragma unroll
            for (int h = 0; h < 8; ++h) {
              bf16_t* dst = K1 + ((size_t)(b * 8 + h) * KVL + key) * 192 + 128 + (nb - 384);
              st8(dst + fq * 8, v0, v1);
            }
          } else if (nb < 1472) {
            if (!ctx) {
#pragma unroll
              for (int e = 0; e < 4; ++e) { v0[e] = silu_f(v0[e]); v1[e] = silu_f(v1[e]); }
              bf16_t* dst = Z1 + (size_t)token * 1024 + (nb - 448);
              st8(dst + fq * 8, v0, v1);
            }
          }
        }
      }
    if (u.pn <= 1) {
#pragma unroll
      for (int ai = 0; ai < 2; ++ai)
#pragma unroll
        for (int m = 0; m < 4; ++m) {
          float sv = ss[ai][m]; sv = xsum<16>(sv); sv = xsum<32>(sv);
          if (fq == 0) ssb[wc * 256 + ai * 128 + wr * 64 + m * 16 + fr] = sv;
        }
      asm volatile("s_waitcnt lgkmcnt(0)" ::: "memory"); __builtin_amdgcn_s_barrier(); asm volatile("" ::: "memory");
      const int lt = wc * 64 + fq * 16 + fr;
      if (lt < 128) {
        const int row = (lt >> 6) * 128 + wr * 64 + (lt & 63);
        if (u.pn == 0) { const float tot = (ssb[row] + ssb[256 + row]) + (ssb[512 + row] + ssb[768 + row]); RQ[u.pm * 256 + row] = rsqrtf(tot * (1.f / 256.f) + 1e-6f); }
        else { const float tot = (ssb[row] + ssb[256 + row]) + (ssb[512 + row] + ssb[768 + row]); RKV[u.pm * 256 + row] = rsqrtf(tot * (1.f / 128.f) + 1e-6f); }
      }
    }
  }
};

struct EpiQ {
  bf16_t* Q1; const float* RQ; const float2* rope;
  DEVI void operator()(acc_t& acc, const Unit& u, int wr, int wc, int fr, int fq) const {
    const int col0 = u.pn * 256;
#pragma unroll
    for (int ai = 0; ai < 2; ++ai)
#pragma unroll
      for (int m = 0; m < 4; ++m) {
        const int token = u.pm * 256 + ai * 128 + wr * 64 + m * 16 + fr; const int s = token & 2047; const float rq = RQ[token];
#pragma unroll
        for (int bj = 0; bj < 2; ++bj) {
          const int n0 = col0 + bj * 128 + wc * 32; const int dd0 = n0 % 192;
          f32x4 v0 = acc[ai][bj][m][0] * rq, v1 = acc[ai][bj][m][1] * rq;
          if (dd0 >= 128) rope_pair(v0, v1, rope, (dd0 >= 160) ? (s & 63) : (s >> 6), fq);
          bf16_t* dst = Q1 + (size_t)token * 1536 + n0;
          st8(dst + fq * 8, v0, v1);
        }
      }
  }
};

struct EpiKV {
  bf16_t *K1, *V1; const float* RKV;
  DEVI void operator()(acc_t& acc, const Unit& u, int wr, int wc, int fr, int fq) const {
    const int col0 = u.pn * 256; const bool ctx = u.pm >= 128;
#pragma unroll
    for (int ai = 0; ai < 2; ++ai)
#pragma unroll
      for (int m = 0; m < 4; ++m) {
        const int token = u.pm * 256 + ai * 128 + wr * 64 + m * 16 + fr; const float rk = RKV[token];
        int b, s, key; token_info(token, ctx, b, s, key);
#pragma unroll
        for (int bj = 0; bj < 2; ++bj) {
          const int nb = col0 + bj * 128 + wc * 32; const int h = nb >> 8, dd = nb & 255;
          const f32x4 v0 = acc[ai][bj][m][0] * rk, v1 = acc[ai][bj][m][1] * rk;
          bf16_t* dst = dd < 128 ? K1 + ((size_t)(b * 8 + h) * KVL + key) * 192 + dd : V1 + ((size_t)(b * 8 + h) * KVL + key) * 128 + (dd - 128);
          st8(dst + fq * 8, v0, v1);
        }
      }
  }
};

template <int SCID> struct ScaleOf { static constexpr float v = SCID == 0 ? 0.125f : 0.07216878364870322f; };
constexpr float THR = 8.f;
template <int KW> DEVI int kswz(int row, int colB) { return row * (KW * 2 + 16) + colB; }
DEVI int v_st(int k, int c) { const int kk = (k & ~0xC) | ((k & 4) << 1) | ((k & 8) >> 1); return ((kk >> 3) * 4 + (c >> 5)) * 512 + ((kk & 7) * 32 + (c & 31)) * 2; }
DEVI int v_rd_base(int lane) { return ((lane & 3) << 3) | (((lane >> 2) & 3) << 6) | (((lane >> 4) & 1) << 5) | (((lane >> 5) & 1) << 8); }
constexpr int v_rd_off(int d0, int ks, int half) { return d0 * 512 + ks * 4096 + half * 2048; }
template <int OFF> DEVI s16x4 tr_read(int vb) { s16x4 r; asm volatile("ds_read_b64_tr_b16 %0, %1 offset:%2" : "=&v"(r) : "v"(vb), "i"(OFF) : "memory"); return r; }

template <int SCID>
DEVI void partialSM(f32x16& p0, f32x16& p1, float& m_reg, float& mn, float& alpha) {
  constexpr float SC = ScaleOf<SCID>::v; constexpr float C = SC * 1.4426950408889634f;
  float pmax = p0[0];
#pragma unroll
  for (int r = 1; r < 16; ++r) pmax = fmaxf(pmax, p0[r]);
#pragma unroll
  for (int r = 0; r < 16; ++r) pmax = fmaxf(pmax, p1[r]);
  { auto rr = __builtin_amdgcn_permlane32_swap(__float_as_uint(pmax), __float_as_uint(pmax), false, false);
    pmax = fmaxf(__uint_as_float(rr[0]), __uint_as_float(rr[1])); }
  if (__builtin_expect(__all(pmax - m_reg <= THR / SC), 1)) { mn = m_reg; alpha = 1.f; }
  else { mn = fmaxf(m_reg, pmax); alpha = __builtin_amdgcn_exp2f((m_reg - mn) * C); m_reg = mn; }
  const float mnC = -mn * C;
#pragma unroll
  for (int r = 0; r < 16; ++r) p0[r] = fmaf(p0[r], C, mnC);
#pragma unroll
  for (int r = 0; r < 16; ++r) p1[r] = fmaf(p1[r], C, mnC);
#pragma unroll
  for (int r = 0; r < 16; ++r) p0[r] = __builtin_amdgcn_exp2f(p0[r]);
}
DEVI void finishSM(f32x16& p0, f32x16& p1, float alpha, float& l_reg, bf16x8& pa0, bf16x8& pa1, bf16x8& pa2, bf16x8& pa3) {
#pragma unroll
  for (int r = 0; r < 16; ++r) p1[r] = __builtin_amdgcn_exp2f(p1[r]);
  float ps = 0;
#pragma unroll
  for (int r = 0; r < 16; ++r) ps += p0[r];
#pragma unroll
  for (int r = 0; r < 16; ++r) ps += p1[r];
  { auto rr = __builtin_amdgcn_permlane32_swap(__float_as_uint(ps), __float_as_uint(ps), false, false);
    ps = __uint_as_float(rr[0]) + __uint_as_float(rr[1]); }
  l_reg = l_reg * alpha + ps;
#define PK4(P, BASE, OUT) do { unsigned a0 = cvtpk(P[BASE + 0], P[BASE + 1]), a1 = cvtpk(P[BASE + 2], P[BASE + 3]); \
    unsigned b0 = cvtpk(P[BASE + 4], P[BASE + 5]), b1 = cvtpk(P[BASE + 6], P[BASE + 7]); \
    auto r0 = __builtin_amdgcn_permlane32_swap(a0, b0, false, false); auto r1 = __builtin_amdgcn_permlane32_swap(a1, b1, false, false); \
    u32x4 w = {r0[0], r1[0], r0[1], r1[1]}; OUT = *reinterpret_cast<bf16x8*>(&w); } while (0)
  PK4(p0, 0, pa0); PK4(p0, 8, pa1); PK4(p1, 0, pa2); PK4(p1, 8, pa3);
#undef PK4
}
template <int OFF> DEVI bf16x8 lds_rd128(int a) { bf16x8 r; asm volatile("ds_read_b128 %0, %1 offset:%2" : "=&v"(r) : "v"(a), "i"(OFF) : "memory"); return r; }
template <int N> DEVI void wait_lgkm() { asm volatile("s_waitcnt lgkmcnt(%0)" :: "n"(N) : "memory"); }
template <int NQ, int QL> constexpr bool q_is_lds(int s) { return QL > 0 && s >= NQ - QL && s < NQ; }
template <int NQ, int QL, int PF> constexpr int q_after(int d) {
  int n = q_is_lds<NQ, QL>(d + 1) ? 1 : 0;
  if (q_is_lds<NQ, QL>(d)) n += (d + PF < NQ ? 2 : 0);
  else for (int i = 1; i <= PF; ++i) n += (d + i < NQ ? 2 : 0);
  return n;
}
template <int KW, int NQ, int QL, int PF, int D0>
DEVI void qkt_step(f32x16& p0, f32x16& p1, int ka, const bf16x8* qr, int qa, bf16x8 (&kf)[PF + 1][2], bf16x8 (&qf)[2]) {
  if constexpr (D0 < NQ) {
    constexpr int ROW32 = 32 * (KW * 2 + 16);
    if constexpr (D0 + PF < NQ) { kf[(D0 + PF) % (PF + 1)][0] = lds_rd128<(D0 + PF) * 32>(ka); kf[(D0 + PF) % (PF + 1)][1] = lds_rd128<ROW32 + (D0 + PF) * 32>(ka); }
    if constexpr (q_is_lds<NQ, QL>(D0 + 1)) qf[(D0 + 1) & 1] = lds_rd128<(D0 + 1 - (NQ - QL)) * 32>(qa);
    wait_lgkm<q_after<NQ, QL, PF>(D0)>(); SBAR();
    bf16x8 q;
    if constexpr (q_is_lds<NQ, QL>(D0)) q = qf[D0 & 1]; else q = qr[D0];
    p0 = __builtin_amdgcn_mfma_f32_32x32x16_bf16(kf[D0 % (PF + 1)][0], q, p0, 0, 0, 0);
    p1 = __builtin_amdgcn_mfma_f32_32x32x16_bf16(kf[D0 % (PF + 1)][1], q, p1, 0, 0, 0);
    qkt_step<KW, NQ, QL, PF, D0 + 1>(p0, p1, ka, qr, qa, kf, qf);
  }
}
template <int KW, int NQ, int QL = 0>
DEVI void qkt(f32x16& p0, f32x16& p1, const char* Ks, const bf16x8* qr, int kcol0, int r32, int hi, const char* ql = nullptr) {
  constexpr int PF = QL > 0 ? 2 : 3;
#pragma unroll
  for (int r = 0; r < 16; ++r) { p0[r] = 0.f; p1[r] = 0.f; }
  const int ka = (int)(uintptr_t)(Ks + kswz<KW>(r32, (kcol0 + hi * 8) * 2)), qa = (int)(uintptr_t)ql;
  constexpr int ROW32 = 32 * (KW * 2 + 16);
  static_assert(NQ >= PF && (QL == 0 || NQ - QL >= PF), "prologue issues steps 0..PF-1 from register-q steps");
  bf16x8 kf[PF + 1][2], qf[2];
  asm volatile("s_waitcnt lgkmcnt(0)" ::: "memory");
  kf[0][0] = lds_rd128<0>(ka); kf[0][1] = lds_rd128<ROW32>(ka);
  kf[1][0] = lds_rd128<32>(ka); kf[1][1] = lds_rd128<ROW32 + 32>(ka);
  if constexpr (PF >= 3) { kf[2][0] = lds_rd128<64>(ka); kf[2][1] = lds_rd128<ROW32 + 64>(ka); }
  qkt_step<KW, NQ, QL, PF, 0>(p0, p1, ka, qr, qa, kf, qf);
}
template <int D0> DEVI void pv_one(f32x16& od, int vb, bf16x8 pa0, bf16x8 pa1, bf16x8 pa2, bf16x8 pa3) {
  const s16x4 l0 = tr_read<v_rd_off(D0, 0, 0)>(vb), h0 = tr_read<v_rd_off(D0, 0, 1)>(vb), l1 = tr_read<v_rd_off(D0, 1, 0)>(vb), h1 = tr_read<v_rd_off(D0, 1, 1)>(vb);
  const s16x4 l2 = tr_read<v_rd_off(D0, 2, 0)>(vb), h2 = tr_read<v_rd_off(D0, 2, 1)>(vb), l3 = tr_read<v_rd_off(D0, 3, 0)>(vb), h3 = tr_read<v_rd_off(D0, 3, 1)>(vb);
  asm volatile("s_waitcnt lgkmcnt(0)" ::: "memory"); SBAR();
#define PK(L, H) (bf16x8){L[0], L[1], L[2], L[3], H[0], H[1], H[2], H[3]}
  od = __builtin_amdgcn_mfma_f32_32x32x16_bf16(pa0, PK(l0, h0), od, 0, 0, 0);
  od = __builtin_amdgcn_mfma_f32_32x32x16_bf16(pa1, PK(l1, h1), od, 0, 0, 0);
  od = __builtin_amdgcn_mfma_f32_32x32x16_bf16(pa2, PK(l2, h2), od, 0, 0, 0);
  od = __builtin_amdgcn_mfma_f32_32x32x16_bf16(pa3, PK(l3, h3), od, 0, 0, 0);
#undef PK
}
template <int D0> DEVI void v_load(int vb, s16x4 (&f)[8]) {
  f[0] = tr_read<v_rd_off(D0, 0, 0)>(vb); f[1] = tr_read<v_rd_off(D0, 0, 1)>(vb); f[2] = tr_read<v_rd_off(D0, 1, 0)>(vb); f[3] = tr_read<v_rd_off(D0, 1, 1)>(vb);
  f[4] = tr_read<v_rd_off(D0, 2, 0)>(vb); f[5] = tr_read<v_rd_off(D0, 2, 1)>(vb); f[6] = tr_read<v_rd_off(D0, 3, 0)>(vb); f[7] = tr_read<v_rd_off(D0, 3, 1)>(vb);
}
DEVI void pv_mma(f32x16& od, const s16x4 (&f)[8], bf16x8 pa0, bf16x8 pa1, bf16x8 pa2, bf16x8 pa3) {
#define PK(L, H) (bf16x8){L[0], L[1], L[2], L[3], H[0], H[1], H[2], H[3]}
  od = __builtin_amdgcn_mfma_f32_32x32x16_bf16(pa0, PK(f[0], f[1]), od, 0, 0, 0);
  od = __builtin_amdgcn_mfma_f32_32x32x16_bf16(pa1, PK(f[2], f[3]), od, 0, 0, 0);
  od = __builtin_amdgcn_mfma_f32_32x32x16_bf16(pa2, PK(f[4], f[5]), od, 0, 0, 0);
  od = __builtin_amdgcn_mfma_f32_32x32x16_bf16(pa3, PK(f[6], f[7]), od, 0, 0, 0);
#undef PK
}
DEVI void pv_d0(f32x16* o, int vb, bf16x8 pa0, bf16x8 pa1, bf16x8 pa2, bf16x8 pa3) {
  s16x4 fa[8], fb[8];
  v_load<0>(vb, fa);
  v_load<1>(vb, fb); asm volatile("s_waitcnt lgkmcnt(8)" ::: "memory"); SBAR(); pv_mma(o[0], fa, pa0, pa1, pa2, pa3); SBAR();
  v_load<2>(vb, fa); asm volatile("s_waitcnt lgkmcnt(8)" ::: "memory"); SBAR(); pv_mma(o[1], fb, pa0, pa1, pa2, pa3); SBAR();
  v_load<3>(vb, fb); asm volatile("s_waitcnt lgkmcnt(8)" ::: "memory"); SBAR(); pv_mma(o[2], fa, pa0, pa1, pa2, pa3); SBAR();
  asm volatile("s_waitcnt lgkmcnt(0)" ::: "memory"); SBAR(); pv_mma(o[3], fb, pa0, pa1, pa2, pa3);
}

template <int KW, int NQ, int SCID>
DEVI void attn_core(int wv, const bf16_t* __restrict__ Qw, const bf16_t* __restrict__ Kh, const bf16_t* __restrict__ Vh, int kcol0, int NT, char* lds,
                    f32x16 (&o)[4], float& l_out) {
  constexpr int SHM_V = 64 * 128 * 2, SHM_K = 64 * (KW * 2 + 16), KC = KW / 64;
  const int tid = tidx(wv), wid = tid >> 6, lane = tid & 63, r32 = lane & 31, hi = lane >> 5;
  char* V_lds = lds; char* K_lds = lds + 2 * SHM_V;
  float* al_l = (float*)(lds + 2 * SHM_V + 2 * SHM_K) + wid * 64 + 32;
  float m_reg = -1e30f, l_reg = 0;
#pragma unroll
  for (int d = 0; d < 4; ++d)
#pragma unroll
    for (int r = 0; r < 16; ++r) o[d][r] = 0.f;
  bf16x8 qr[NQ];
#pragma unroll
  for (int d0 = 0; d0 < NQ; ++d0) qr[d0] = *reinterpret_cast<const bf16x8*>(Qw + d0 * 16);
  const int sr = tid >> 4, sc = (tid & 15) * 8, vst0 = v_st(sr, sc), vst1 = v_st(32 + sr, sc);
  const int krow = tid >> 3, kch = tid & 7;
  const bf16_t* vg = Vh + sr * 128 + sc;
  const bf16_t* kg = Kh + krow * KW + kch * 8;
  const int vb0 = (int)(uintptr_t)V_lds + v_rd_base(lane);
  bf16x8 vs0, vs1, ks[KC];
#define SLOAD(k0) do { vs0 = *reinterpret_cast<const bf16x8*>(vg + (size_t)(k0) * 128); vs1 = *reinterpret_cast<const bf16x8*>(vg + (size_t)((k0) + 32) * 128); \
    _Pragma("unroll") for (int _c = 0; _c < KC; ++_c) ks[_c] = *reinterpret_cast<const bf16x8*>(kg + (size_t)(k0) * KW + _c * 64); } while (0)
#define SWRITE(b) do { *reinterpret_cast<bf16x8*>(V_lds + (b) * SHM_V + vst0) = vs0; *reinterpret_cast<bf16x8*>(V_lds + (b) * SHM_V + vst1) = vs1; \
    _Pragma("unroll") for (int _c = 0; _c < KC; ++_c) *reinterpret_cast<bf16x8*>(K_lds + (b) * SHM_K + kswz<KW>(krow, (kch + 8 * _c) * 16)) = ks[_c]; } while (0)
  SLOAD(0); SWRITE(0);
  if (NT > 1) SLOAD(64);
  __syncthreads();
  for (int j = 0; j < NT; ++j) {
    const int bsel = j & 1;
    f32x16 p0, p1; float mn, alpha; bf16x8 pa0, pa1, pa2, pa3;
    qkt<KW, NQ>(p0, p1, K_lds + bsel * SHM_K, qr, kcol0, r32, hi);
    partialSM<SCID>(p0, p1, m_reg, mn, alpha);
    if (__any(alpha < 1.f)) {
      if (hi == 0) al_l[r32] = alpha;
      asm volatile("s_waitcnt lgkmcnt(0)" ::: "memory");
#pragma unroll
      for (int d = 0; d < 4; ++d)
#pragma unroll
        for (int r = 0; r < 16; ++r) o[d][r] *= al_l[crow(r, hi)];
    }
    finishSM(p0, p1, alpha, l_reg, pa0, pa1, pa2, pa3);
    pv_d0(o, vb0 + bsel * SHM_V, pa0, pa1, pa2, pa3);
    if (j + 1 < NT) { SWRITE(bsel ^ 1); if (j + 2 < NT) SLOAD((j + 2) * 64); }
    __syncthreads();
  }
  l_out = l_reg;
#undef SLOAD
#undef SWRITE
}

template <int KW, int NQ, int SDEPTH, int SCID, int QL>
DEVI void attn_core_pipe(int wv, const bf16_t* __restrict__ Qw, const bf16_t* __restrict__ Kh, const bf16_t* __restrict__ Vh, int kcol0, int NT, char* lds,
                         f32x16 (&o)[4], float& l_out) {
  constexpr int SHM_V = 64 * 128 * 2, SHM_K = 64 * (KW * 2 + 16), KC = KW / 64;
  const int tid = tidx(wv), wid = tid >> 6, lane = tid & 63, r32 = lane & 31, hi = lane >> 5;
  char* V_lds = lds; char* K_lds = lds + 2 * SHM_V;
  float* al_l = (float*)(lds + 2 * SHM_V + 2 * SHM_K) + wid * 64 + 32;
  float m_reg = -1e30f, l_reg = 0;
#pragma unroll
  for (int d = 0; d < 4; ++d)
#pragma unroll
    for (int r = 0; r < 16; ++r) o[d][r] = 0.f;
  bf16x8 qr[NQ - QL + (QL ? 1 : 0)];
#pragma unroll
  for (int d0 = 0; d0 < NQ - QL; ++d0) qr[d0] = *reinterpret_cast<const bf16x8*>(Qw + d0 * 16);
  char* ql = lds + 2 * SHM_V + 2 * SHM_K + 2048 + (wid * 32 + r32) * 144 + hi * 16;
  if constexpr (QL > 0) {
#pragma unroll
    for (int d0 = NQ - QL; d0 < NQ; ++d0) *reinterpret_cast<bf16x8*>(ql + (d0 - (NQ - QL)) * 32) = *reinterpret_cast<const bf16x8*>(Qw + d0 * 16);
  }
  const int sr = tid >> 4, sc = (tid & 15) * 8, vst0 = v_st(sr, sc), vst1 = v_st(32 + sr, sc);
  const int krow = tid >> 3, kch = tid & 7;
  const bf16_t* vg = Vh + sr * 128 + sc;
  const bf16_t* kg = Kh + krow * KW + kch * 8;
  const int vb0 = (int)(uintptr_t)V_lds + v_rd_base(lane);
  struct { bf16x8 vs0, vs1, ks[KC]; } sr_[SDEPTH];
#define SLOAD(i, k0) do { sr_[i].vs0 = *reinterpret_cast<const bf16x8*>(vg + (size_t)(k0) * 128); sr_[i].vs1 = *reinterpret_cast<const bf16x8*>(vg + (size_t)((k0) + 32) * 128); \
    _Pragma("unroll") for (int _c = 0; _c < KC; ++_c) sr_[i].ks[_c] = *reinterpret_cast<const bf16x8*>(kg + (size_t)(k0) * KW + _c * 64); } while (0)
#define SWRITE(b, i) do { *reinterpret_cast<bf16x8*>(V_lds + (b) * SHM_V + vst0) = sr_[i].vs0; *reinterpret_cast<bf16x8*>(V_lds + (b) * SHM_V + vst1) = sr_[i].vs1; \
    _Pragma("unroll") for (int _c = 0; _c < KC; ++_c) *reinterpret_cast<bf16x8*>(K_lds + (b) * SHM_K + kswz<KW>(krow, (kch + 8 * _c) * 16)) = sr_[i].ks[_c]; } while (0)
#define SWAIT() do { if constexpr (SDEPTH == 2) asm volatile("s_waitcnt vmcnt(4)" ::: "memory"); else asm volatile("s_waitcnt vmcnt(0)" ::: "memory"); } while (0)
#define RESC(a) do { if (__any((a) < 1.f)) { if (hi == 0) al_l[r32] = (a); asm volatile("s_waitcnt lgkmcnt(0)" ::: "memory"); \
    _Pragma("unroll") for (int _d = 0; _d < 4; ++_d) _Pragma("unroll") for (int _r = 0; _r < 16; ++_r) o[_d][_r] *= al_l[crow(_r, hi)]; } } while (0)
  f32x16 pA0, pA1, pB0, pB1; float mnA, mnB, alA, alB; bf16x8 pa0, pa1, pa2, pa3;
  constexpr int SE = 0, SO = SDEPTH - 1;
  SLOAD(SE, 0); asm volatile("s_waitcnt vmcnt(0)" ::: "memory"); SWRITE(0, SE); __syncthreads();
  qkt<KW, NQ, QL>(pA0, pA1, K_lds, qr, kcol0, r32, hi, ql); partialSM<SCID>(pA0, pA1, m_reg, mnA, alA);
  SLOAD(SO, 64); if constexpr (SDEPTH == 2) { if (2 < NT) SLOAD(SE, 128); }
  SWAIT(); SWRITE(1, SO); __syncthreads();
  for (int j = 1; j + 1 < NT; j += 2) {
    SBAR(); qkt<KW, NQ, QL>(pB0, pB1, K_lds + SHM_K, qr, kcol0, r32, hi, ql);
    finishSM(pA0, pA1, alA, l_reg, pa0, pa1, pa2, pa3); SBAR();
    SLOAD(SO, (j + SDEPTH) * 64); SBAR();
    pv_d0(o, vb0, pa0, pa1, pa2, pa3); partialSM<SCID>(pB0, pB1, m_reg, mnB, alB);
    __syncthreads(); SWAIT(); SWRITE(0, SE);
    RESC(alB); __syncthreads();
    SBAR(); qkt<KW, NQ, QL>(pA0, pA1, K_lds, qr, kcol0, r32, hi, ql);
    finishSM(pB0, pB1, alB, l_reg, pa0, pa1, pa2, pa3); SBAR();
    if (SDEPTH == 1 || j + 3 < NT) SLOAD(SE, (j + 1 + SDEPTH) * 64);
    SBAR();
    pv_d0(o, vb0 + SHM_V, pa0, pa1, pa2, pa3); partialSM<SCID>(pA0, pA1, m_reg, mnA, alA);
    __syncthreads(); SWAIT(); SWRITE(1, SO);
    RESC(alA); __syncthreads();
  }
  SBAR(); qkt<KW, NQ, QL>(pB0, pB1, K_lds + SHM_K, qr, kcol0, r32, hi, ql);
  finishSM(pA0, pA1, alA, l_reg, pa0, pa1, pa2, pa3); SBAR();
  pv_d0(o, vb0, pa0, pa1, pa2, pa3); partialSM<SCID>(pB0, pB1, m_reg, mnB, alB);
  __syncthreads(); RESC(alB);
  finishSM(pB0, pB1, alB, l_reg, pa0, pa1, pa2, pa3); SBAR();
  pv_d0(o, vb0 + SHM_V, pa0, pa1, pa2, pa3);
  __syncthreads();
  l_out = l_reg;
#undef SLOAD
#undef SWRITE
#undef SWAIT
#undef RESC
}

template <int KW, int NQ, int SCID, int QL>
DEVI void attn_core_dma(int wv, const bf16_t* __restrict__ Qw, const bf16_t* __restrict__ Kh, const bf16_t* __restrict__ Vh, int kcol0, int NT, char* lds,
                        f32x16 (&o)[4], float& l_out) {
  constexpr int SHM_V = 64 * 128 * 2, KCH = KW / 8 + 1, SHM_K = 64 * KCH * 16, KR = (64 * KCH) / 512;
  static_assert(64 * KCH - KR * 512 == 64, "remainder must be one wave");
  const int tid = tidx(wv), wid = tid >> 6, lane = tid & 63, r32 = lane & 31, hi = lane >> 5;
  char* V_lds = lds; char* K_lds = lds + 2 * SHM_V;
  float* al_l = (float*)(lds + 2 * SHM_V + 2 * SHM_K) + wid * 64 + 32;
  float m_reg = -1e30f, l_reg = 0;
#pragma unroll
  for (int d = 0; d < 4; ++d)
#pragma unroll
    for (int r = 0; r < 16; ++r) o[d][r] = 0.f;
  bf16x8 qr[NQ - QL + (QL ? 1 : 0)];
#pragma unroll
  for (int d0 = 0; d0 < NQ - QL; ++d0) qr[d0] = *reinterpret_cast<const bf16x8*>(Qw + d0 * 16);
  char* ql = lds + 2 * SHM_V + 2 * SHM_K + 2048 + (wid * 32 + r32) * 144 + hi * 16;
  if constexpr (QL > 0) {
#pragma unroll
    for (int d0 = NQ - QL; d0 < NQ; ++d0) *reinterpret_cast<bf16x8*>(ql + (d0 - (NQ - QL)) * 32) = *reinterpret_cast<const bf16x8*>(Qw + d0 * 16);
  }
  const int sr = tid >> 4, sc = (tid & 15) * 8, vst0 = v_st(sr, sc), vst1 = v_st(32 + sr, sc);
  const bf16_t* vg = Vh + sr * 128 + sc;
  const int vb0 = (int)(uintptr_t)V_lds + v_rd_base(lane);
  unsigned koff[KR + 1];
#pragma unroll
  for (int i = 0; i <= KR; ++i) { const int c = tid + 512 * i; const int row = c / KCH; int ch = c - row * KCH; ch = ch == KCH - 1 ? KCH - 2 : ch; koff[i] = (unsigned)(row * KW + ch * 8) * 2u; }
  const unsigned kldsw = (unsigned)__builtin_amdgcn_readfirstlane(wid) * 1024u;
  bf16x8 vs0, vs1;
#define KDMA(k0, b) do { const char* _g = (const char*)(Kh + (size_t)(k0) * KW); PG8_LAS unsigned char* _l = (PG8_LAS unsigned char*)(K_lds + (b) * SHM_K) + kldsw; \
    _Pragma("unroll") for (int _i = 0; _i < KR; ++_i) __builtin_amdgcn_global_load_lds((const unsigned*)(_g + koff[_i]), (PG8_LAS unsigned*)(_l + _i * 8192), 16, 0, 0); \
    if (wid == 0) __builtin_amdgcn_global_load_lds((const unsigned*)(_g + koff[KR]), (PG8_LAS unsigned*)(_l + KR * 8192), 16, 0, 0); } while (0)
#define VLOAD(k0) do { vs0 = *reinterpret_cast<const bf16x8*>(vg + (size_t)(k0) * 128); vs1 = *reinterpret_cast<const bf16x8*>(vg + (size_t)((k0) + 32) * 128); } while (0)
#define VWRITE(b) do { *reinterpret_cast<bf16x8*>(V_lds + (b) * SHM_V + vst0) = vs0; *reinterpret_cast<bf16x8*>(V_lds + (b) * SHM_V + vst1) = vs1; } while (0)
#define VMW() asm volatile("s_waitcnt vmcnt(0)" ::: "memory")
#define RESC(a) do { if (__any((a) < 1.f)) { if (hi == 0) al_l[r32] = (a); asm volatile("s_waitcnt lgkmcnt(0)" ::: "memory"); \
    _Pragma("unroll") for (int _d = 0; _d < 4; ++_d) _Pragma("unroll") for (int _r = 0; _r < 16; ++_r) o[_d][_r] *= al_l[crow(_r, hi)]; } } while (0)
  f32x16 pA0, pA1, pB0, pB1; float mnA, mnB, alA, alB; bf16x8 pa0, pa1, pa2, pa3;
  KDMA(0, 0); VLOAD(0); VMW(); VWRITE(0); __syncthreads();
  KDMA(64, 1); VLOAD(64);
  qkt<KW, NQ, QL>(pA0, pA1, K_lds, qr, kcol0, r32, hi, ql); partialSM<SCID>(pA0, pA1, m_reg, mnA, alA);
  VMW(); __syncthreads(); VWRITE(1); __syncthreads();
  for (int j = 1; j + 1 < NT; j += 2) {
    SBAR(); KDMA((j + 1) * 64, 0); VLOAD((j + 1) * 64); SBAR();
    qkt<KW, NQ, QL>(pB0, pB1, K_lds + SHM_K, qr, kcol0, r32, hi, ql);
    finishSM(pA0, pA1, alA, l_reg, pa0, pa1, pa2, pa3); SBAR();
    pv_d0(o, vb0, pa0, pa1, pa2, pa3); partialSM<SCID>(pB0, pB1, m_reg, mnB, alB);
    VMW(); __syncthreads(); VWRITE(0);
    RESC(alB); __syncthreads();
    SBAR(); KDMA((j + 2) * 64, 1); VLOAD((j + 2) * 64); SBAR();
    qkt<KW, NQ, QL>(pA0, pA1, K_lds, qr, kcol0, r32, hi, ql);
    finishSM(pB0, pB1, alB, l_reg, pa0, pa1, pa2, pa3); SBAR();
    pv_d0(o, vb0 + SHM_V, pa0, pa1, pa2, pa3); partialSM<SCID>(pA0, pA1, m_reg, mnA, alA);
    VMW(); __syncthreads(); VWRITE(1);
    RESC(alA); __syncthreads();
  }
  SBAR(); qkt<KW, NQ, QL>(pB0, pB1, K_lds + SHM_K, qr, kcol0, r32, hi, ql);
  finishSM(pA0, pA1, alA, l_reg, pa0, pa1, pa2, pa3); SBAR();
  pv_d0(o, vb0, pa0, pa1, pa2, pa3); partialSM<SCID>(pB0, pB1, m_reg, mnB, alB);
  RESC(alB);
  finishSM(pB0, pB1, alB, l_reg, pa0, pa1, pa2, pa3); SBAR();
  pv_d0(o, vb0 + SHM_V, pa0, pa1, pa2, pa3);
  __syncthreads();
  l_out = l_reg;
#undef KDMA
#undef VLOAD
#undef VWRITE
#undef VMW
#undef RESC
}

template <int KW, int NQ, int SCID, int QL>
DEVI void attn_core_pp(int wv, const bf16_t* __restrict__ Qw, const bf16_t* __restrict__ Kh, const bf16_t* __restrict__ Vh, int kcol0, int NT, char* lds,
                       f32x16 (&o)[4], float& l_out) {
  constexpr int SHM_V = 64 * 128 * 2, KCH = KW / 8 + 1, SHM_K = 64 * KCH * 16, KR = (64 * KCH) / 512;
  static_assert(64 * KCH - KR * 512 == 64, "remainder must be one wave");
  const int tid = tidx(wv), wid = tid >> 6, lane = tid & 63, r32 = lane & 31, hi = lane >> 5;
  const int g = __builtin_amdgcn_readfirstlane(wid >> 2);
  char* V_lds = lds; char* K_lds = lds + 2 * SHM_V;
  float* al_l = (float*)(lds + 2 * SHM_V + 2 * SHM_K) + wid * 64 + 32;
  float m_reg = -1e30f, l_reg = 0;
#pragma unroll
  for (int d = 0; d < 4; ++d)
#pragma unroll
    for (int r = 0; r < 16; ++r) o[d][r] = 0.f;
  bf16x8 qr[NQ - QL + (QL ? 1 : 0)];
#pragma unroll
  for (int d0 = 0; d0 < NQ - QL; ++d0) qr[d0] = *reinterpret_cast<const bf16x8*>(Qw + d0 * 16);
  char* ql = lds + 2 * SHM_V + 2 * SHM_K + 2048 + (wid * 32 + r32) * 144 + hi * 16;
  if constexpr (QL > 0) {
#pragma unroll
    for (int d0 = NQ - QL; d0 < NQ; ++d0) *reinterpret_cast<bf16x8*>(ql + (d0 - (NQ - QL)) * 32) = *reinterpret_cast<const bf16x8*>(Qw + d0 * 16);
  }
  const int vb0 = (int)(uintptr_t)V_lds + v_rd_base(lane);
  unsigned koff[KR + 1], voff[2];
#pragma unroll
  for (int i = 0; i <= KR; ++i) { const int c = tid + 512 * i; const int row = c / KCH; int ch = c - row * KCH; ch = ch == KCH - 1 ? KCH - 2 : ch; koff[i] = (unsigned)(row * KW + ch * 8) * 2u; }
#pragma unroll
  for (int i = 0; i < 2; ++i) { const int q = tid + 512 * i; const int st = q >> 5, kk = (st >> 2) * 8 + ((q >> 2) & 7), c = (st & 3) * 32 + (q & 3) * 8;
    const int k = (kk & ~0xC) | ((kk & 4) << 1) | ((kk & 8) >> 1); voff[i] = (unsigned)(k * 128 + c) * 2u; }
  const unsigned ldsw = (unsigned)__builtin_amdgcn_readfirstlane(wid) * 1024u;
#define KDMA(k0, b) do { const char* _g = (const char*)(Kh + (size_t)(k0) * KW); PG8_LAS unsigned char* _l = (PG8_LAS unsigned char*)(K_lds + (b) * SHM_K) + ldsw; \
    _Pragma("unroll") for (int _i = 0; _i < KR; ++_i) __builtin_amdgcn_global_load_lds((const unsigned*)(_g + koff[_i]), (PG8_LAS unsigned*)(_l + _i * 8192), 16, 0, 0); \
    if (wid == 0) __builtin_amdgcn_global_load_lds((const unsigned*)(_g + koff[KR]), (PG8_LAS unsigned*)(_l + KR * 8192), 16, 0, 0); } while (0)
#define VDMA(k0, b) do { const char* _g = (const char*)(Vh + (size_t)(k0) * 128); PG8_LAS unsigned char* _l = (PG8_LAS unsigned char*)(V_lds + (b) * SHM_V) + ldsw; \
    _Pragma("unroll") for (int _i = 0; _i < 2; ++_i) __builtin_amdgcn_global_load_lds((const unsigned*)(_g + voff[_i]), (PG8_LAS unsigned*)(_l + _i * 8192), 16, 0, 0); } while (0)
#define VMW() asm volatile("s_waitcnt vmcnt(0)" ::: "memory")
#define PBAR() do { asm volatile("" ::: "memory"); __builtin_amdgcn_s_barrier(); asm volatile("" ::: "memory"); } while (0)
#define RESC(a) do { if (__any((a) < 1.f)) { if (hi == 0) al_l[r32] = (a); asm volatile("s_waitcnt lgkmcnt(0)" ::: "memory"); \
    _Pragma("unroll") for (int _d = 0; _d < 4; ++_d) _Pragma("unroll") for (int _r = 0; _r < 16; ++_r) o[_d][_r] *= al_l[crow(_r, hi)]; } } while (0)
  f32x16 pA0, pA1, pB0, pB1; float mn, al; bf16x8 pa0, pa1, pa2, pa3;
  KDMA(0, 0); KDMA(64, 1); VMW(); __syncthreads();
  qkt<KW, NQ, QL>(pA0, pA1, K_lds, qr, kcol0, r32, hi, ql);
  PBAR();
  if (g == 1) PBAR();
  for (int j = 0; j < NT; j += 2) {
    SBAR(); if (j + 2 < NT) KDMA((j + 2) * 64, 0); VDMA(j * 64, 0); SBAR();
    qkt<KW, NQ, QL>(pB0, pB1, K_lds + SHM_K, qr, kcol0, r32, hi, ql);
    if (j > 0) pv_d0(o, vb0 + SHM_V, pa0, pa1, pa2, pa3);
    if (g == 1) VMW();
    PBAR(); SBAR();
    partialSM<SCID>(pA0, pA1, m_reg, mn, al); RESC(al); finishSM(pA0, pA1, al, l_reg, pa0, pa1, pa2, pa3);
    if (g == 0) VMW();
    PBAR(); SBAR();
    if (j + 3 < NT) KDMA((j + 3) * 64, 1);
    VDMA((j + 1) * 64, 1); SBAR();
    if (j + 2 < NT) qkt<KW, NQ, QL>(pA0, pA1, K_lds, qr, kcol0, r32, hi, ql);
    pv_d0(o, vb0, pa0, pa1, pa2, pa3);
    if (g == 1) VMW();
    PBAR(); SBAR();
    partialSM<SCID>(pB0, pB1, m_reg, mn, al); RESC(al); finishSM(pB0, pB1, al, l_reg, pa0, pa1, pa2, pa3);
    if (g == 0) VMW();
    PBAR(); SBAR();
  }
  pv_d0(o, vb0 + SHM_V, pa0, pa1, pa2, pa3);
  if (g == 0) PBAR();
  __syncthreads();
  l_out = l_reg;
#undef KDMA
#undef VDMA
#undef VMW
#undef PBAR
#undef RESC
}

DEVI void gated_rows_out(const char* stg, int lane, const bf16_t* __restrict__ gate, int gld, bf16_t* __restrict__ out, int old) {
#pragma unroll
  for (int i = 0; i < 8; ++i) {
    const int c = lane + 64 * i, row = c >> 4, ch = c & 15;
    const u32x4 sv = *reinterpret_cast<const u32x4*>(stg + row * 272 + ch * 16);
    const u32x4 gv = *reinterpret_cast<const u32x4*>(gate + (size_t)row * gld + ch * 8);
    u32x4 ov;
#pragma unroll
    for (int e = 0; e < 4; ++e) ov[e] = cvtpk(bflo(sv[e]) * bflo(gv[e]), bfhi(sv[e]) * bfhi(gv[e]));
    *reinterpret_cast<u32x4*>(out + (size_t)row * old + ch * 8) = ov;
  }
}

DEVI void attn0_item(int wv, const Params& p, int token0, int b, int h, int nkeys, char* lds) {
  const int tid = tidx(wv), wid = tid >> 6, lane = tid & 63, r32 = lane & 31, hi = lane >> 5, m = wid >> 2, wl = wid & 3;
  const bf16_t* Q0 = (const bf16_t*)(p.ws + OFF_Q0); const bf16_t* K0 = (const bf16_t*)(p.ws + OFF_K0); const bf16_t* V0 = (const bf16_t*)(p.ws + OFF_V0);
  const bf16_t* ZB = (const bf16_t*)(p.ws + OFF_ZB); bf16_t* MIX = (bf16_t*)(p.ws + OFF_MIX);
  const bf16_t* Qw = Q0 + (size_t)(token0 + wl * 32 + r32) * 512 + h * 128 + m * 64 + hi * 8;
  const size_t kvo = (size_t)(b * 4 + h) * KVL * 128;
  f32x16 o[4]; float l;
  attn_core_pp<128, 4, 0, 0>(wv, Qw, K0 + kvo, V0 + kvo, m * 64, nkeys >> 6, lds, o, l);
  float* li_l = (float*)(lds + 32768 + 2 * 64 * 272) + wid * 64;
  if (hi == 0) li_l[r32] = l;
  asm volatile("s_waitcnt lgkmcnt(0)" ::: "memory");
  float rli[16];
#pragma unroll
  for (int r = 0; r < 16; ++r) rli[r] = __builtin_amdgcn_rcpf(li_l[crow(r, hi)]);
  float t1 = p.b_lq1[lane] * p.b_lk1[lane], t2 = p.b_lq2[lane] * p.b_lk2[lane];
  t1 = wave_sum(t1); t2 = wave_sum(t2);
  const float lam = __expf(t1) - __expf(t2) + 0.2f;
  __syncthreads();
  float* xch = (float*)lds;
  if (m == 1) {
#pragma unroll
    for (int r = 0; r < 16; ++r)
#pragma unroll
      for (int d0 = 0; d0 < 4; ++d0) xch[(wl * 32 + crow(r, hi)) * 128 + d0 * 32 + r32] = o[d0][r] * rli[r];
  }
  __syncthreads();
  if (m == 0) {
    char* stg = lds + 69632 + wl * 8704;
    float sw4[4];
#pragma unroll
    for (int d0 = 0; d0 < 4; ++d0) sw4[d0] = p.b_subln_w[d0 * 32 + r32];
#pragma unroll
    for (int r = 0; r < 16; ++r) {
      const int row = wl * 32 + crow(r, hi); const int token = token0 + row;
      float a[4], ss = 0.f;
#pragma unroll
      for (int d0 = 0; d0 < 4; ++d0) { a[d0] = o[d0][r] * rli[r] - lam * xch[row * 128 + d0 * 32 + r32]; ss += a[d0] * a[d0]; }
      ss = xsum<1>(ss); ss = xsum<2>(ss); ss = xsum<4>(ss); ss = xsum<8>(ss); ss = xsum<16>(ss);
      const float rstd = rsqrtf(ss * (1.f / 128.f) + 1e-5f) * 0.8f;
#pragma unroll
      for (int d0 = 0; d0 < 4; ++d0) *reinterpret_cast<bf16_t*>(stg + crow(r, hi) * 272 + (d0 * 32 + r32) * 2) = f2bf(a[d0] * rstd * sw4[d0]);
    }
    asm volatile("s_waitcnt lgkmcnt(0)" ::: "memory");
    const size_t t0 = (size_t)(token0 + wl * 32);
    gated_rows_out(stg, lane, ZB + t0 * 512 + h * 128, 512, MIX + t0 * 1024 + 512 + h * 128, 1024);
  }
  __syncthreads();
}

DEVI void attn1_item(int wv, const Params& p, int b, int h, int qb, char* lds) {
  const int tid = tidx(wv), wid = tid >> 6, lane = tid & 63, r32 = lane & 31, hi = lane >> 5;
  const bf16_t* Q1 = (const bf16_t*)(p.ws + OFF_Q1); const bf16_t* K1 = (const bf16_t*)(p.ws + OFF_K1); const bf16_t* V1 = (const bf16_t*)(p.ws + OFF_V1);
  const bf16_t* Z1 = (const bf16_t*)(p.ws + OFF_Z1); bf16_t* MIX = (bf16_t*)(p.ws + OFF_MIX);
  const int token0 = b * 2048 + qb * 256;
  const bf16_t* Qw = Q1 + (size_t)(token0 + wid * 32 + r32) * 1536 + h * 192 + hi * 8;
  f32x16 o[4]; float l;
  attn_core_pp<192, 12, 1, 4>(wv, Qw, K1 + (size_t)(b * 8 + h) * KVL * 192, V1 + (size_t)(b * 8 + h) * KVL * 128, 0, KVL / 64, lds, o, l);
  float* li_l = (float*)(lds + 32768 + 2 * 64 * 400) + wid * 64;
  if (hi == 0) li_l[r32] = l;
  asm volatile("s_waitcnt lgkmcnt(0)" ::: "memory");
  char* stg = lds + wid * 8704;
#pragma unroll
  for (int r = 0; r < 16; ++r) {
    const int cr = crow(r, hi); const float rl = __builtin_amdgcn_rcpf(li_l[cr]);
#pragma unroll
    for (int d0 = 0; d0 < 4; ++d0) *reinterpret_cast<bf16_t*>(stg + cr * 272 + (d0 * 32 + r32) * 2) = f2bf(o[d0][r] * rl);
  }
  asm volatile("s_waitcnt lgkmcnt(0)" ::: "memory");
  const size_t t0 = (size_t)(token0 + wid * 32);
  gated_rows_out(stg, lane, Z1 + t0 * 1024 + h * 128, 1024, MIX + t0 * 1024 + h * 128, 1024);
  __syncthreads();
}

DEVI void abranch_item(int wv, const Params& p, int ci, char* lds) {
  const int tid = tidx(wv), wid = tid >> 6, lane = tid & 63, r32 = lane & 31, hi = lane >> 5;
  const bf16_t* GV = (const bf16_t*)(p.ws + OFF_GV); const bf16_t* U = (const bf16_t*)(p.ws + OFF_U); const bf16_t* ZA = (const bf16_t*)(p.ws + OFF_ZA);
  const bf16_t* WSB = (const bf16_t*)(p.ws + OFF_WSB); bf16_t* MIX = (bf16_t*)(p.ws + OFF_MIX);
  const int t0 = ci * 128;
  bf16_t* vnT = (bf16_t*)lds;
  {
    const int pos = tid >> 2, cp = tid & 3;
    const bf16_t* g = GV + (size_t)(t0 + pos) * 512;
    bf16x8 raw[16];
#pragma unroll
    for (int i = 0; i < 16; ++i) raw[i] = *reinterpret_cast<const bf16x8*>(g + (i * 4 + cp) * 8);
    float s = 0.f, q = 0.f;
#pragma unroll
    for (int i = 0; i < 16; ++i)
#pragma unroll
      for (int e = 0; e < 8; ++e) { const float xv = bf2f((bf16_t)raw[i][e]); s += xv; q += xv * xv; }
    s = xsum<1>(s); s = xsum<2>(s); q = xsum<1>(q); q = xsum<2>(q);
    const float mu = s * (1.f / 512.f);
    const float rstd = rsqrtf(fmaxf(q * (1.f / 512.f) - mu * mu, 0.f) + 1e-5f);
#pragma unroll
    for (int i = 0; i < 16; ++i) {
      const int c0 = (i * 4 + cp) * 8;
      const f32x4 w0 = *reinterpret_cast<const f32x4*>(p.a_ln_w + c0), w1 = *reinterpret_cast<const f32x4*>(p.a_ln_w + c0 + 4);
      const f32x4 b0 = *reinterpret_cast<const f32x4*>(p.a_ln_b + c0), b1 = *reinterpret_cast<const f32x4*>(p.a_ln_b + c0 + 4);
#pragma unroll
      for (int e = 0; e < 8; ++e) {
        const float wv = e < 4 ? w0[e & 3] : w1[e & 3], bv = e < 4 ? b0[e & 3] : b1[e & 3];
        vnT[(c0 + e) * 136 + pos] = f2bf((bf2f((bf16_t)raw[i][e]) - mu) * rstd * wv + bv);
      }
    }
  }
  __syncthreads();
  const int g8 = wid;
  const bf16_t* Wg = WSB + g8 * 128 * 128;
  f32x16 acc[4][2];
#pragma unroll
  for (int pb = 0; pb < 4; ++pb) {
#pragma unroll
    for (int r = 0; r < 16; ++r) { acc[pb][0][r] = 0.f; acc[pb][1][r] = 0.f; }
#pragma unroll
    for (int ks = 0; ks < 8; ++ks) {
      const bf16x8 bw = *reinterpret_cast<const bf16x8*>(Wg + (pb * 32 + r32) * 128 + ks * 16 + hi * 8);
#pragma unroll
      for (int db = 0; db < 2; ++db) {
        const bf16x8 a = *reinterpret_cast<const bf16x8*>(vnT + (g8 * 64 + db * 32 + r32) * 136 + ks * 16 + hi * 8);
        acc[pb][db] = __builtin_amdgcn_mfma_f32_32x32x16_bf16(a, bw, acc[pb][db], 0, 0, 0);
      }
    }
  }
  asm volatile("s_waitcnt lgkmcnt(0)" ::: "memory");
  char* stg = (char*)vnT + (size_t)g8 * 64 * 272;
#pragma unroll
  for (int pb = 0; pb < 4; ++pb) {
    const float bias = p.a_bs[g8 * 128 + pb * 32 + r32];
#pragma unroll
    for (int db = 0; db < 2; ++db)
#pragma unroll
      for (int rg = 0; rg < 4; ++rg) {
        u32x2 pk = {cvtpk(acc[pb][db][rg * 4 + 0] + bias, acc[pb][db][rg * 4 + 1] + bias), cvtpk(acc[pb][db][rg * 4 + 2] + bias, acc[pb][db][rg * 4 + 3] + bias)};
        *reinterpret_cast<u32x2*>(stg + (pb * 32 + r32) * 136 + (db * 32 + rg * 8 + hi * 4) * 2) = pk;
      }
  }
  asm volatile("s_waitcnt lgkmcnt(0)" ::: "memory");
#pragma unroll 4
  for (int i = 0; i < 16; ++i) {
    const int c = lane + 64 * i, row = c >> 3, ch = c & 7;
    const u32x2 s0 = *reinterpret_cast<const u32x2*>(stg + row * 136 + ch * 16), s1 = *reinterpret_cast<const u32x2*>(stg + row * 136 + ch * 16 + 8);
    const size_t gi = (size_t)(t0 + row) * 512 + g8 * 64 + ch * 8;
    const u32x4 uv = *reinterpret_cast<const u32x4*>(U + gi), zv = *reinterpret_cast<const u32x4*>(ZA + gi);
    const unsigned sv[4] = {s0[0], s0[1], s1[0], s1[1]};
    u32x4 ov;
#pragma unroll
    for (int e = 0; e < 4; ++e) ov[e] = cvtpk(bflo(uv[e]) * bflo(sv[e]) * bflo(zv[e]), bfhi(uv[e]) * bfhi(sv[e]) * bfhi(zv[e]));
    *reinterpret_cast<u32x4*>(MIX + (size_t)(t0 + row) * 1024 + g8 * 64 + ch * 8) = ov;
  }
  __syncthreads();
}

DEVI void tr_tile(int wv, const float* __restrict__ src, bf16_t* __restrict__ dst, int K, int N, int tilesN4, const float* __restrict__ scale, int t, char* lds) {
  const int tid = tidx(wv);
  const int k0 = (t / tilesN4) * 64, n0 = (t % tilesN4) * 256;
  const int kr = tid >> 3, ng = (tid & 7) * 8;
  f32x4 v0[4], v1[4];
#pragma unroll
  for (int u = 0; u < 4; ++u) {
    v0[u] = (f32x4){0.f, 0.f, 0.f, 0.f}; v1[u] = v0[u];
    if (n0 + u * 64 + ng < N) { const float* s = src + (size_t)(k0 + kr) * N + n0 + u * 64 + ng; v0[u] = *reinterpret_cast<const f32x4*>(s); v1[u] = *reinterpret_cast<const f32x4*>(s + 4); }
  }
  const float scv = scale ? scale[k0 + kr] : 1.f;
  bf16_t* tl = (bf16_t*)lds;
#pragma unroll
  for (int u = 0; u < 4; ++u)
#pragma unroll
    for (int e = 0; e < 4; ++e) { tl[u * 4608 + (ng + e) * 72 + kr] = f2bf(v0[u][e] * scv); tl[u * 4608 + (ng + 4 + e) * 72 + kr] = f2bf(v1[u][e] * scv); }
  __syncthreads();
  const int n = tid >> 3, kc = (tid & 7) * 8;
#pragma unroll
  for (int u = 0; u < 4; ++u)
    *reinterpret_cast<bf16x8*>(dst + (size_t)(n0 + u * 64 + n) * K + k0 + kc) = *reinterpret_cast<const bf16x8*>(tl + u * 4608 + n * 72 + kc);
}

DEVI void tr_item(int wv, const Params& p, int t, char* lds) {
  if (t < 224) tr_tile(wv, p.even_w_in, (bf16_t*)(p.ws + OFF_W0IN), 1024, 3584, 14, nullptr, t, lds);
  else if (t < 288) tr_tile(wv, p.even_w_out, (bf16_t*)(p.ws + OFF_W0OUT), 1024, 1024, 4, nullptr, t - 224, lds);
  else if (t < 384) tr_tile(wv, p.odd_w_in, (bf16_t*)(p.ws + OFF_W1IN), 1024, 1472, 6, nullptr, t - 288, lds);
  else if (t < 408) tr_tile(wv, p.c_wq_b, (bf16_t*)(p.ws + OFF_WQ), 256, 1536, 6, p.c_q_norm_w, t - 384, lds);
  else if (t < 424) tr_tile(wv, p.c_wkv_b, (bf16_t*)(p.ws + OFF_WKV), 128, 2048, 8, p.c_kv_norm_w, t - 408, lds);
  else tr_tile(wv, p.odd_w_out, (bf16_t*)(p.ws + OFF_W1OUT), 1024, 1024, 4, nullptr, t - 424, lds);
  __syncthreads();
}

DEVI void phase0(int wv, const Params& p, char* lds) {
  const int tid = tidx(wv);
  constexpr int N_ADA = 192, N_TR = 224, N_WS = 16;
  for (int it = blockIdx.x; it < N_ADA + N_TR + N_WS + 1; it += gridDim.x) {
    if (it < N_ADA) {
      const int li = it / 96, chunk = it % 96;
      float* sc = (float*)lds;
      for (int idx = tid; idx < 17 * 1024; idx += 512) { const int r = idx >> 10, k = idx & 1023; const float xv = r < 16 ? p.c[r * 1024 + k] : p.c_ctx[k]; sc[idx] = xv / (1.f + expf(-xv)); }
      __syncthreads();
      const int col = tid & 31, kp = tid >> 5;
      const float* w = p.ada_w + (size_t)li * 1024 * 3072 + chunk * 32 + col;
      float acc[17];
#pragma unroll
      for (int r = 0; r < 17; ++r) acc[r] = 0.f;
#pragma unroll 2
      for (int k = kp * 64; k < kp * 64 + 64; k += 4) {
        const float w0 = w[(size_t)k * 3072], w1 = w[(size_t)(k + 1) * 3072], w2 = w[(size_t)(k + 2) * 3072], w3 = w[(size_t)(k + 3) * 3072];
#pragma unroll
        for (int r = 0; r < 17; ++r) { const f32x4 s4 = *reinterpret_cast<const f32x4*>(sc + r * 1024 + k); acc[r] += s4[0] * w0 + s4[1] * w1 + s4[2] * w2 + s4[3] * w3; }
      }
      float* red = (float*)(lds + 17 * 1024 * 4);
#pragma unroll
      for (int r = 0; r < 17; ++r) red[(kp * 17 + r) * 32 + col] = acc[r];
      __syncthreads();
      float* ada = (float*)(p.ws + OFF_ADA);
      for (int idx = tid; idx < 544; idx += 512) {
        const int r = idx >> 5, cc = idx & 31; float s = 0.f;
        for (int k2 = 0; k2 < 16; ++k2) s += red[(k2 * 17 + r) * 32 + cc];
        ada[(size_t)(li * 17 + r) * 3072 + chunk * 32 + cc] = s + p.ada_b[li * 3072 + chunk * 32 + cc];
      }
    } else if (it < N_ADA + N_TR) {
      tr_tile(wv, p.even_w_in, (bf16_t*)(p.ws + OFF_W0IN), 1024, 3584, 14, nullptr, it - N_ADA, lds);
    } else if (it < N_ADA + N_TR + N_WS) {
      const int base = (it - N_ADA - N_TR) * 8192 + tid * 16;
      bf16_t* dst = (bf16_t*)(p.ws + OFF_WSB) + base; const float* s = p.a_ws + base;
#pragma unroll
      for (int q = 0; q < 2; ++q) {
        const f32x4 a = *reinterpret_cast<const f32x4*>(s + q * 8), b = *reinterpret_cast<const f32x4*>(s + q * 8 + 4);
        u32x4 w = {cvtpk(a[0], a[1]), cvtpk(a[2], a[3]), cvtpk(b[0], b[1]), cvtpk(b[2], b[3])};
        *reinterpret_cast<u32x4*>(dst + q * 8) = w;
      }
    } else {
      float2* tab = (float2*)(p.ws + OFF_ROPE);
      for (int e = tid; e < 1024; e += 512) {
        const int pos = e >> 4, j = e & 15;
        const float inv = exp2f(-(float)j * (13.287712379549449f / 16.f));
        const float ang = (float)pos * inv;
        const float nrev = rintf(ang * 0.15915494309189535f);
        float rr = fmaf(-nrev, 6.2831855f, ang); rr = fmaf(-nrev, -1.7484555e-7f, rr);
        tab[e] = make_float2(__cosf(rr), __sinf(rr));
      }
    }
    __syncthreads();
  }
}

template <bool RES>
DEVI void norm_mod(int wv, const float* src_lat, const float* src_ctx, const float* __restrict__ nw, const float* __restrict__ ada, bf16_t* X,
                   int row_lo, int row_hi, int vb, int nvb, const float* __restrict__ ada_prev = nullptr, float* hdst_lat = nullptr, float* hdst_ctx = nullptr) {
  const int tid_ = tidx(wv); const int wid = tid_ >> 6, lane = tid_ & 63;
  for (int row0 = row_lo + (vb * 8 + wid) * 2; row0 < row_hi; row0 += nvb * 16) {
    f32x4 v[2][4]; u32x2 ov[2][4]; float ss[2];
#pragma unroll
    for (int q = 0; q < 2; ++q) {
      const int row = row0 + q;
      const float* src = row < NLAT ? src_lat + (size_t)row * 1024 : src_ctx + (size_t)(row - NLAT) * 1024;
      ss[q] = 0.f;
#pragma unroll
      for (int i = 0; i < 4; ++i) {
        v[q][i] = __builtin_nontemporal_load(reinterpret_cast<const f32x4*>(src + i * 256 + lane * 4));
        if constexpr (RES) ov[q][i] = *reinterpret_cast<const u32x2*>(X + (size_t)row * 1024 + i * 256 + lane * 4);
      }
    }
    if constexpr (RES) {
#pragma unroll
      for (int q = 0; q < 2; ++q) {
        const int row = row0 + q;
        const float* gp = ada_prev + (row < NLAT ? (row >> 11) : 16) * 3072 + 2048;
        float* hd = row < NLAT ? hdst_lat + (size_t)row * 1024 : hdst_ctx + (size_t)(row - NLAT) * 1024;
#pragma unroll
        for (int i = 0; i < 4; ++i) {
          const int c = i * 256 + lane * 4;
          const f32x4 g = *reinterpret_cast<const f32x4*>(gp + c);
          v[q][i][0] += g[0] * bflo(ov[q][i][0]); v[q][i][1] += g[1] * bfhi(ov[q][i][0]); v[q][i][2] += g[2] * bflo(ov[q][i][1]); v[q][i][3] += g[3] * bfhi(ov[q][i][1]);
          __builtin_nontemporal_store(v[q][i], reinterpret_cast<f32x4*>(hd + c));
        }
      }
    }
#pragma unroll
    for (int q = 0; q < 2; ++q) {
#pragma unroll
      for (int i = 0; i < 4; ++i) ss[q] += v[q][i][0] * v[q][i][0] + v[q][i][1] * v[q][i][1] + v[q][i][2] * v[q][i][2] + v[q][i][3] * v[q][i][3];
      ss[q] = wave_sum(ss[q]);
    }
#pragma unroll
    for (int q = 0; q < 2; ++q) {
      const int row = row0 + q;
      const float* ad = ada + (row < NLAT ? (row >> 11) : 16) * 3072;
      const float r = rsqrtf(ss[q] * (1.f / 1024.f) + 1e-6f);
#pragma unroll
      for (int i = 0; i < 4; ++i) {
        const int c = i * 256 + lane * 4;
        const f32x4 w = *reinterpret_cast<const f32x4*>(nw + c), sh = *reinterpret_cast<const f32x4*>(ad + c), scl = *reinterpret_cast<const f32x4*>(ad + 1024 + c);
        float o[4];
#pragma unroll
        for (int e = 0; e < 4; ++e) o[e] = v[q][i][e] * r * w[e] * (1.f + scl[e]) + sh[e];
        u32x2 pk = {cvtpk(o[0], o[1]), cvtpk(o[2], o[3])};
        *reinterpret_cast<u32x2*>(X + (size_t)row * 1024 + c) = pk;
      }
    }
  }
}

DEVI void final_norm(int wv, float* out, const float* __restrict__ fw, const bf16_t* __restrict__ O1, const float* __restrict__ ada1) {
  const int tid_ = tidx(wv); const int wid = tid_ >> 6, lane = tid_ & 63;
  for (int row0 = (blockIdx.x * 8 + wid) * 2; row0 < NLAT; row0 += gridDim.x * 16) {
    f32x4 v[2][4]; u32x2 ov[2][4]; float ss[2];
#pragma unroll
    for (int q = 0; q < 2; ++q) {
      ss[q] = 0.f;
#pragma unroll
      for (int i = 0; i < 4; ++i) {
        v[q][i] = __builtin_nontemporal_load(reinterpret_cast<const f32x4*>(out + (size_t)(row0 + q) * 1024 + i * 256 + lane * 4));
        ov[q][i] = *reinterpret_cast<const u32x2*>(O1 + (size_t)(row0 + q) * 1024 + i * 256 + lane * 4);
      }
    }
#pragma unroll
    for (int q = 0; q < 2; ++q) {
      const float* gp = ada1 + ((row0 + q) >> 11) * 3072 + 2048;
#pragma unroll
      for (int i = 0; i < 4; ++i) {
        const f32x4 g = *reinterpret_cast<const f32x4*>(gp + i * 256 + lane * 4);
        v[q][i][0] += g[0] * bflo(ov[q][i][0]); v[q][i][1] += g[1] * bfhi(ov[q][i][0]); v[q][i][2] += g[2] * bflo(ov[q][i][1]); v[q][i][3] += g[3] * bfhi(ov[q][i][1]);
        ss[q] += v[q][i][0] * v[q][i][0] + v[q][i][1] * v[q][i][1] + v[q][i][2] * v[q][i][2] + v[q][i][3] * v[q][i][3];
      }
      ss[q] = wave_sum(ss[q]);
    }
#pragma unroll
    for (int q = 0; q < 2; ++q) {
      const float r = rsqrtf(ss[q] * (1.f / 1024.f) + 1e-6f);
#pragma unroll
      for (int i = 0; i < 4; ++i) {
        const int c = i * 256 + lane * 4;
        const f32x4 w = *reinterpret_cast<const f32x4*>(fw + c);
        __builtin_nontemporal_store(v[q][i] * r * w, reinterpret_cast<f32x4*>(out + (size_t)(row0 + q) * 1024 + c));
      }
    }
  }
}

typedef const __attribute__((address_space(4))) Params* KArgP;
DEVI void run_phase(int wv, KArgP pp, int ph, char* lds) {
#if defined(__HIP_DEVICE_COMPILE__)
  asm volatile("" : "+s"(pp));
  char* ws = pp->ws;
  const float2* rope = (const float2*)(ws + OFF_ROPE);
  const float* ada0 = (const float*)(ws + OFF_ADA); const float* ada1 = ada0 + 17 * 3072;
  bf16_t* X = (bf16_t*)(ws + OFF_X); bf16_t* MIX = (bf16_t*)(ws + OFF_MIX);
  const int G = gridDim.x, B = blockIdx.x;
  PG8_LAS unsigned char* ldsp = (PG8_LAS unsigned char*)lds;
  switch (ph) {
    case 0: { const Params p = *pp; phase0(wv, p, lds); } break;
    case 1: norm_mod<false>(wv, pp->x, pp->ctx, pp->norm_w, ada0, X, 0, NTOK, B, G); break;
    case 2: {
      EpiL0In epi{(bf16_t*)(ws + OFF_U), (bf16_t*)(ws + OFF_GV), (bf16_t*)(ws + OFF_ZA), (bf16_t*)(ws + OFF_ZB), (bf16_t*)(ws + OFF_Q0), (bf16_t*)(ws + OFF_K0), (bf16_t*)(ws + OFF_V0), rope};
      gemm_phase(wv, ldsp, X, (const bf16_t*)(ws + OFF_W0IN), 1024, Sched{14, 144 * 14, 144 * 14, 0, 0}, epi);
    } break;
    case 3: { const Params p = *pp;
      for (int it = B; it < 1024 + 288 + 128; it += G) {
        if (it < 1024) {
          const int xcd = it & 7, slot = (it >> 3) & 31, rd = it >> 8;
          const int bh = rd * 16 + xcd * 2 + (slot >> 4), qb = slot & 15, b = bh >> 2, h = bh & 3;
          attn0_item(wv, p, b * 2048 + qb * 128, b, h, KVL, lds);
        } else if (it < 1024 + 288) abranch_item(wv, p, it - 1024, lds);
        else { const int i2 = it - 1312; const int b = i2 >> 3, h = (i2 >> 1) & 3, qb = i2 & 1; attn0_item(wv, p, NLAT + b * 256 + qb * 128, b, h, 256, lds); }
      }
      {
        const int nb = G >= 192 ? 96 : G, base = G - nb;
        if (B >= base) for (int t = 224 + (B - base); t < 288; t += nb) tr_item(wv, p, t, lds);
      }
    } break;
    case 4: {
      EpiPlain epi{X};
      gemm_phase(wv, ldsp, MIX, (const bf16_t*)(ws + OFF_W0OUT), 1024, Sched{4, 144 * 4, 144 * 4, 0, 0}, epi);
      {
        const Params p = *pp; const int nb = G > 64 ? G - 64 : G, base = G - nb;
        if (B >= base) for (int t = 288 + (B - base); t < 488; t += nb) tr_item(wv, p, t, lds);
      }
    } break;
    case 5: {
      if (B >= G - 16) {
        const int cp = B - (G - 16);
        norm_mod<true>(wv, pp->x, pp->ctx, pp->norm_w + 1024, ada1, X, NLAT + cp * 256, NLAT + cp * 256 + 256, 0, 1, ada0, pp->out, (float*)(ws + OFF_H1C));
        asm volatile("s_waitcnt vmcnt(0)" ::: "memory"); __syncthreads();
        EpiL1In epi{(bf16_t*)(ws + OFF_CQ), (bf16_t*)(ws + OFF_CKV), (bf16_t*)(ws + OFF_K1), (bf16_t*)(ws + OFF_Z1), (float*)(ws + OFF_RQ), (float*)(ws + OFF_RKV), rope, (float*)(lds + LDS_SS)};
        gemm_phase(wv, ldsp, X, (const bf16_t*)(ws + OFF_W1IN), 1024, Sched{6, 0, 16, 128, 1, G - 16}, epi);
      } else norm_mod<true>(wv, pp->x, pp->ctx, pp->norm_w + 1024, ada1, X, 0, NLAT, B, G - 16, ada0, pp->out, (float*)(ws + OFF_H1C));
    } break;
    case 6: {
      EpiL1In epi{(bf16_t*)(ws + OFF_CQ), (bf16_t*)(ws + OFF_CKV), (bf16_t*)(ws + OFF_K1), (bf16_t*)(ws + OFF_Z1), (float*)(ws + OFF_RQ), (float*)(ws + OFF_RKV), rope, (float*)(lds + LDS_SS)};
      gemm_phase(wv, ldsp, X, (const bf16_t*)(ws + OFF_W1IN), 1024, Sched{6, 768, 768, 128, 1}, epi);
    } break;
    case 7: {
      EpiQ eq{(bf16_t*)(ws + OFF_Q1), (const float*)(ws + OFF_RQ), rope};
      EpiKV ek{(bf16_t*)(ws + OFF_K1), (bf16_t*)(ws + OFF_V1), (const float*)(ws + OFF_RKV)};
      gemm_phase(wv, ldsp, (const bf16_t*)(ws + OFF_CQ), (const bf16_t*)(ws + OFF_WQ), 256, Sched{6, 768, 768, 0, 0}, eq);
      gemm_phase(wv, ldsp, (const bf16_t*)(ws + OFF_CKV), (const bf16_t*)(ws + OFF_WKV), 128, Sched{8, 1152, 1152, 0, 0}, ek);
    } break;
    case 8: { const Params p = *pp;
      for (int it = B; it < 1024; it += G) {
        const int xcd = it & 7, slot = (it >> 3) & 31, rd = it >> 8;
        const int bh = rd * 32 + xcd * 4 + (slot >> 3), qb = slot & 7;
        attn1_item(wv, p, bh >> 3, bh & 7, qb, lds);
      }
    } break;
    case 9: {
      EpiPlain epi{X};
      gemm_phase(wv, ldsp, MIX, (const bf16_t*)(ws + OFF_W1OUT), 1024, Sched{4, 128 * 4, 128 * 4, 0, 0}, epi);
    } break;
    case 10: final_norm(wv, pp->out, pp->final_w, X, ada1); break;
  }
#endif
}


#define XB_TMO      128
#define XB_XCNT(j)  (256  + 64 * (j))
#define XB_XSUB(j)  (1280 + 64 * (j))
#define XB_XGEN(j)  (2304 + 64 * (j))
#define XB_TOP      3328
#define XB_TOPGEN   3392
#define XCD_BAR_WORDS 3456
#define XB_SPIN_CAP (1u << 18)
#define LAS __attribute__((address_space(3)))
DEVI unsigned xb_ld(unsigned* p) { return __hip_atomic_load(p, __ATOMIC_RELAXED, __HIP_MEMORY_SCOPE_AGENT); }
DEVI unsigned xb_add(unsigned* p, unsigned v) { return __hip_atomic_fetch_add(p, v, __ATOMIC_RELAXED, __HIP_MEMORY_SCOPE_AGENT); }
DEVI unsigned xb_xcc_id() { return (unsigned)__builtin_amdgcn_s_getreg((3 << 11) | 20) & 0xFu; }
#define XB_SPIN(cond, bar) do { unsigned _sp = 0; while (cond) { __builtin_amdgcn_s_sleep(1); \
    if ((++_sp & 255u) == 0u) { if (xb_ld(&(bar)[XB_TMO])) break; if (_sp > XB_SPIN_CAP) { atomicAdd(&(bar)[XB_TMO], 1u); break; } } } } while (0)
struct XcdBarrier { unsigned* bar; unsigned x; volatile LAS unsigned* st; };
DEVI XcdBarrier xcd_barrier_post(int wv, unsigned* bar, volatile LAS unsigned* st) {
  XcdBarrier b; b.bar = bar; b.x = xb_xcc_id(); b.st = st;
  if (tidx(wv) == 0) (void)xb_add(&bar[XB_XCNT(b.x)], 1u);
  return b;
}
DEVI void xcd_barrier_complete(unsigned* bar, unsigned x, unsigned& nloc, unsigned& nx) {
  const unsigned G = gridDim.x * gridDim.y * gridDim.z;
  unsigned sum, cnt, mine, sp = 0u;
  for (;;) {
    sum = 0u; cnt = 0u; mine = 0u;
#pragma unroll
    for (unsigned j = 0; j < 16; ++j) { const unsigned c = xb_ld(&bar[XB_XCNT(j)]); sum += c; cnt += (c > 0u) ? 1u : 0u; mine = (j == x) ? c : mine; }
    if (sum == G) break;
    __builtin_amdgcn_s_sleep(1);
    if ((++sp & 255u) == 0u) { if (xb_ld(&bar[XB_TMO])) break; if (sp > XB_SPIN_CAP) { atomicAdd(&bar[XB_TMO], 1u); break; } }
  }
  nloc = mine > 0u ? mine : 1u; nx = cnt > 0u ? cnt : 1u;
}
DEVI void xcd_barrier(int wv, const XcdBarrier& b) {
  asm volatile("s_waitcnt vmcnt(0)" ::: "memory");
  __syncthreads();
  if (tidx(wv) == 0) {
    unsigned* bar = b.bar;
    __builtin_amdgcn_s_waitcnt(0);
    unsigned nloc = b.st[0], nx = b.st[1];
    if (nloc == 0u) { xcd_barrier_complete(bar, b.x, nloc, nx); b.st[0] = nloc; b.st[1] = nx; }
    const unsigned old = xb_add(&bar[XB_XSUB(b.x)], 1u);
    const unsigned gen = old / nloc;
    if (old + 1u == (gen + 1u) * nloc) {
      __builtin_amdgcn_fence(__ATOMIC_RELEASE, "agent");
      asm volatile("s_waitcnt vmcnt(0)" ::: "memory");
      const unsigned og = xb_add(&bar[XB_TOP], 1u);
      const unsigned tg = og / nx;
      if (og + 1u == (tg + 1u) * nx) xb_add(&bar[XB_TOPGEN], 1u);
      else XB_SPIN(xb_ld(&bar[XB_TOPGEN]) == tg, bar);
      __builtin_amdgcn_fence(__ATOMIC_ACQUIRE, "agent");
      xb_add(&bar[XB_XGEN(b.x)], 1u);
      asm volatile("s_waitcnt vmcnt(0)" ::: "memory");
    } else {
      XB_SPIN(xb_ld(&bar[XB_XGEN(b.x)]) == gen, bar);
      __builtin_amdgcn_fence(__ATOMIC_ACQUIRE, "agent");
      asm volatile("s_waitcnt vmcnt(0)" ::: "memory");
    }
  }
  __syncthreads();
}

extern __shared__ __attribute__((aligned(16))) char g_lds[];

constexpr int LDS_XB = 143360;
__global__ void __launch_bounds__(512) mega(Params p) {
  cg::grid_group grid = cg::this_grid();
  if (p.ph_hi > 64) grid.sync();
  const int wv = __builtin_amdgcn_readfirstlane((int)threadIdx.x >> 6);
  volatile LAS unsigned* xst = (volatile LAS unsigned*)(g_lds + LDS_XB);
  if (tidx(wv) == 0) { xst[0] = 0u; xst[1] = 0u; }
  __syncthreads();
  (void)xcd_barrier_post(wv, (unsigned*)(p.ws + OFF_BAR), xst);
#define GRID_BARRIER() do { KArgP _pp = (KArgP)__builtin_amdgcn_kernarg_segment_ptr(); asm volatile("" : "+s"(_pp)); \
    XcdBarrier _xb; _xb.bar = (unsigned*)(_pp->ws + OFF_BAR); _xb.x = xb_xcc_id(); _xb.st = (volatile LAS unsigned*)(g_lds + LDS_XB); xcd_barrier(wv, _xb); } while (0)
  for (int ph = p.ph_lo; ph < p.ph_hi; ++ph) {
    run_phase(wv, (KArgP)__builtin_amdgcn_kernarg_segment_ptr(), ph, g_lds);
#ifdef PROBE_PH
    if (ph == PROBE_PH) { GRID_BARRIER(); run_phase(wv, (KArgP)__builtin_amdgcn_kernarg_segment_ptr(), ph, g_lds); }
#endif
    if (ph + 1 < p.ph_hi) GRID_BARRIER();
  }
}

extern "C" void kernel_launch(void* const* d_in, const int* in_sizes, int n_in, void* d_out, int out_size, void* d_ws, size_t ws_size, hipStream_t stream) {
  static int ok = 0;
  static int grid_blocks = 0;
  if (!ok) {
    if (n_in != 25 || ws_size < WS_NEED) { fprintf(stderr, "kernel_launch: bad args n_in %d ws %zu need %zu\n", n_in, ws_size, (size_t)WS_NEED); return; }
    if (hipFuncSetAttribute((const void*)mega, hipFuncAttributeMaxDynamicSharedMemorySize, LDS_BYTES) != hipSuccess) { fprintf(stderr, "kernel_launch: LDS attr failed\n"); return; }
    int dev = 0, cus = 0, per_cu = 0;
    hipGetDevice(&dev);
    hipDeviceGetAttribute(&cus, hipDeviceAttributeMultiprocessorCount, dev);
    hipOccupancyMaxActiveBlocksPerMultiprocessor(&per_cu, mega, 512, LDS_BYTES);
    if (per_cu < 1) per_cu = 1;
    grid_blocks = cus * per_cu;
    ok = 1;
  }
  Params p{};
  const float** pp = (const float**)&p;
  for (int i = 0; i < 25; ++i) pp[i] = (const float*)d_in[i];
  p.out = (float*)d_out; p.ws = (char*)d_ws;
#if ONE_LAUNCH
  p.ph_lo = 0; p.ph_hi = 11;
  hipMemsetAsync((char*)d_ws + OFF_BAR, 0, XCD_BAR_WORDS * 4, stream);
  void* args[] = {&p};
  hipError_t e = hipLaunchCooperativeKernel((const void*)mega, dim3(grid_blocks), dim3(512), args, LDS_BYTES, stream);
  if (e != hipSuccess) fprintf(stderr, "cooperative launch failed: %s (grid %d)\n", hipGetErrorString(e), grid_blocks);
#else
  for (int ph = 0; ph < 11; ++ph) {
    p.ph_lo = ph; p.ph_hi = ph + 1;
    hipLaunchKernelGGL(mega, dim3(grid_blocks), dim3(512), LDS_BYTES, stream, p);
  }
#endif
}
```

```cpp
#include <hip/hip_runtime.h>
#include <hip/hip_cooperative_groups.h>
#include <cstdio>
namespace cg = cooperative_groups;

#ifndef ATT_SD0
#define ATT_SD0 2
#endif
#ifndef ONE_LAUNCH
#define ONE_LAUNCH 1
#endif

typedef unsigned short bf16_t;
typedef short bf16x8 __attribute__((ext_vector_type(8)));
typedef short s16x4 __attribute__((ext_vector_type(4)));
typedef float f32x16 __attribute__((ext_vector_type(16)));
typedef float f32x4 __attribute__((ext_vector_type(4)));
typedef unsigned u32x4 __attribute__((ext_vector_type(4)));
typedef unsigned u32x2 __attribute__((ext_vector_type(2)));
#define DEVI __device__ __forceinline__
#define SBAR() __builtin_amdgcn_sched_barrier(0)
DEVI int tidx(int wv) { int l; asm volatile("v_mbcnt_lo_u32_b32 %0, -1, 0\n\tv_mbcnt_hi_u32_b32 %0, -1, %0" : "=v"(l)); return (wv << 6) | l; }

constexpr int NLAT = 32768, NCTX = 4096, NTOK = 36864, KVL = 2304;
constexpr int LDS_BYTES = 147456, LDS_SS = 139264;

constexpr size_t OFF_W0IN = 0;
constexpr size_t OFF_W0OUT = OFF_W0IN + 3584ull * 1024 * 2;
constexpr size_t OFF_W1IN = OFF_W0OUT + 1024ull * 1024 * 2;
constexpr size_t OFF_WQ = OFF_W1IN + 1536ull * 1024 * 2;
constexpr size_t OFF_WKV = OFF_WQ + 1536ull * 256 * 2;
constexpr size_t OFF_W1OUT = OFF_WKV + 2048ull * 128 * 2;
constexpr size_t OFF_WSB = OFF_W1OUT + 1024ull * 1024 * 2;
constexpr size_t OFF_ADA = OFF_WSB + 8ull * 128 * 128 * 2;
constexpr size_t OFF_ROPE = OFF_ADA + 2ull * 17 * 3072 * 4;
constexpr size_t OFF_BAR = OFF_ROPE + 64ull * 16 * 8;
constexpr size_t OFF_H1C = OFF_BAR + 16384;
constexpr size_t OFF_RQ = OFF_H1C + 4096ull * 1024 * 4;
constexpr size_t OFF_RKV = OFF_RQ + 32768ull * 4;
constexpr size_t OFF_X = OFF_RKV + 36864ull * 4;
constexpr size_t OFF_MIX = OFF_X + 36864ull * 1024 * 2;
constexpr size_t OFF_T = OFF_MIX + 36864ull * 1024 * 2;
constexpr size_t SZ_HALF = 36864ull * 512 * 2;
constexpr size_t OFF_U = OFF_T, OFF_GV = OFF_U + SZ_HALF, OFF_ZA = OFF_GV + SZ_HALF, OFF_ZB = OFF_ZA + SZ_HALF, OFF_Q0 = OFF_ZB + SZ_HALF;
constexpr size_t OFF_K0 = OFF_Q0 + SZ_HALF, OFF_V0 = OFF_K0 + 16ull * 4 * KVL * 128 * 2, END_L0 = OFF_V0 + 16ull * 4 * KVL * 128 * 2;
constexpr size_t OFF_CQ = OFF_T, OFF_CKV = OFF_CQ + 32768ull * 256 * 2, OFF_Z1 = OFF_CKV + 36864ull * 128 * 2;
constexpr size_t OFF_Q1 = OFF_Z1 + 32768ull * 1024 * 2, OFF_K1 = OFF_Q1 + 32768ull * 1536 * 2, OFF_KR = OFF_K1 + 16ull * 8 * KVL * 192 * 2, END_L1 = OFF_KR + 16ull * KVL * 192 * 2;
constexpr size_t OFF_V1 = OFF_X;
constexpr size_t WS_NEED = END_L1 > END_L0 ? END_L1 : END_L0;

struct Params {
  const float *x, *c, *ctx, *c_ctx, *norm_w, *ada_w, *ada_b, *even_w_in, *a_ws, *a_bs, *a_ln_w, *a_ln_b,
      *b_lq1, *b_lk1, *b_lq2, *b_lk2, *b_subln_w, *even_w_out, *odd_w_in, *c_q_norm_w, *c_wq_b,
      *c_kv_norm_w, *c_wkv_b, *odd_w_out, *final_w;
  float* out; char* ws; int ph_lo, ph_hi;
};

DEVI unsigned cvtpk(float lo, float hi) { unsigned r; asm("v_cvt_pk_bf16_f32 %0, %1, %2" : "=v"(r) : "v"(lo), "v"(hi)); return r; }
DEVI bf16_t f2bf(float v) { return (bf16_t)(cvtpk(v, 0.f) & 0xffffu); }
DEVI float bf2f(bf16_t v) { return __uint_as_float(((unsigned)v) << 16); }
DEVI float bflo(unsigned w) { return __uint_as_float(w << 16); }
DEVI float bfhi(unsigned w) { return __uint_as_float(w & 0xffff0000u); }
DEVI int crow(int r, int hi) { return (r & 3) + 8 * (r >> 2) + 4 * hi; }
DEVI float silu_f(float x) { return x * __builtin_amdgcn_rcpf(1.f + __builtin_amdgcn_exp2f(x * -1.4426950408889634f)); }
DEVI float gelu_f(float v) {
  const float t = __builtin_amdgcn_rcpf(fmaf(fabsf(v), 0.2316418882f, 1.0f));
  float q = fmaf(t, 0.5307027145f, -0.7265760135f); q = fmaf(q, t, 0.7107068705f); q = fmaf(q, t, -0.142248368f); q = fmaf(q, t, 0.127414796f); q *= t;
  const float m = v * (q * __builtin_amdgcn_exp2f(v * v * -0.72134752044f));
  return v < 0.f ? m : v - m;
}

template <int M> DEVI float xsum(float v) {
  if constexpr (M == 32) { auto rr = __builtin_amdgcn_permlane32_swap(__float_as_uint(v), __float_as_uint(v), false, false); return __uint_as_float(rr[0]) + __uint_as_float(rr[1]); }
  else return v + __int_as_float(__builtin_amdgcn_ds_swizzle(__float_as_int(v), (M << 10) | 0x1f));
}
DEVI float wave_sum(float v) { v = xsum<1>(v); v = xsum<2>(v); v = xsum<4>(v); v = xsum<8>(v); v = xsum<16>(v); return xsum<32>(v); }

DEVI void rope_tile(f32x16& v, const float2* __restrict__ tab, int pos, int hi) {
#pragma unroll
  for (int r = 0; r < 8; ++r) {
    const int jf = (r & 3) + 8 * (r >> 2) + 4 * hi;
    const float2 cs = tab[pos * 16 + jf];
    const float a = v[r], b = v[r + 8];
    v[r] = a * cs.x - b * cs.y; v[r + 8] = b * cs.x + a * cs.y;
  }
}
DEVI void store4(bf16_t* dst, const f32x16& v, int rg) {
  u32x2 pk = {cvtpk(v[rg * 4 + 0], v[rg * 4 + 1]), cvtpk(v[rg * 4 + 2], v[rg * 4 + 3])};
  *reinterpret_cast<u32x2*>(dst) = pk;
}

#define PG8_LAS __attribute__((address_space(3)))
constexpr int HTB = 128 * 64 * 2;
DEVI int lds_byte(int r, int c) { const int st = (r >> 4) * 2 + (c >> 5), rr = r & 15, cc = c & 31, ob = rr * 64 + cc * 2; return st * 1024 + (ob ^ (((ob >> 9) & 1) << 5)); }
DEVI void stage_rc(int b, int& R, int& C) { const int st = b / 1024, sb = b % 1024, swz = sb ^ (((sb >> 9) & 1) << 5); R = (st >> 1) * 16 + swz / 64; C = (st & 1) * 32 + (swz % 64) / 2; }
DEVI int perm32(int rho) { const int n = rho >> 4, i = rho & 15; return 8 * (i >> 2) + 4 * n + (i & 3); }
struct Unit { int pm, pn; };
struct Sched {
  int nN, nmain, ntotal, xpm0, xpn, boff = 0;
  DEVI bool next(int i, Unit& u) const {
    const int it = (int)blockIdx.x - boff + i * (int)gridDim.x; if (it < 0 || it >= ntotal) return false;
    if (it < nmain) {
      const int xcd = it & 7, jx = it >> 3, nMl = nmain / nN / 8, nig = 8 * nN, gid = jx / nig, fm = gid * 8, gsz = (nMl - fm) < 8 ? (nMl - fm) : 8, r = jx % nig;
      u.pm = (fm + r % gsz) * 8 + xcd; u.pn = r / gsz;
    } else { u.pm = xpm0 + (it - nmain); u.pn = xpn; }
    return true;
  }
};
template <class Epi>
DEVI void gemm_phase(int wv, PG8_LAS unsigned char* lds, const bf16_t* gA, const bf16_t* gBt, const int K, const Sched& S, const Epi& E) {
  const int tid = tidx(wv), wid = __builtin_amdgcn_readfirstlane(tid >> 6), lane = tid & 63, wr = wid >> 2, wc = wid & 3, fr = lane & 15, fq = lane >> 4;
  const int nt = K / 64;
  unsigned voffA[2], voffB[2];
#pragma unroll
  for (int i = 0; i < 2; ++i) { int R, C; stage_rc(tid * 16 + i * 8192, R, C); const int Rb = (R & ~31) + perm32(R & 31); voffA[i] = (unsigned)(R * K + C) * 2u; voffB[i] = (unsigned)(Rb * K + C) * 2u; }
  const size_t kstep = (size_t)(64 * 2);
  const size_t hstep = (size_t)128 * K * 2;
  const size_t tstep = 2 * hstep;
  const unsigned ldsw = (unsigned)wid * 1024u;
  const int aoff = lds_byte(wr * 64 + fr, fq * 8), boff = lds_byte(wc * 32 + fr, fq * 8);
#define PG8_SA(b, h) (((b) * 2 + (h)) * HTB)
#define PG8_SB(b, h) ((4 + (b) * 2 + (h)) * HTB)
#define PG8_STAGE(bufoff, gbase, voff) do { _Pragma("unroll") for (int _i = 0; _i < 2; ++_i) \
    __builtin_amdgcn_global_load_lds((const unsigned*)((const char*)(gbase) + (voff)[_i]), (PG8_LAS unsigned*)(lds + (bufoff) + ldsw + _i * 8192), 16, 0, 0); } while (0)
#define PG8_LDA(dst, b, h) do { _Pragma("unroll") for (int m = 0; m < 4; ++m) _Pragma("unroll") for (int k = 0; k < 2; ++k) dst[m][k] = *(const PG8_LAS bf16x8*)(lds + PG8_SA(b, h) + aoff + m * 2048 + k * 1024); } while (0)
#define PG8_LDB(dst, b, h) do { _Pragma("unroll") for (int n = 0; n < 2; ++n) _Pragma("unroll") for (int k = 0; k < 2; ++k) dst[n][k] = *(const PG8_LAS bf16x8*)(lds + PG8_SB(b, h) + boff + n * 2048 + k * 1024); } while (0)
#define PG8_MMA(ai, bj, At, Bt) do { __builtin_amdgcn_s_setprio(1); _Pragma("unroll") for (int m = 0; m < 4; ++m) _Pragma("unroll") for (int n = 0; n < 2; ++n) _Pragma("unroll") for (int k = 0; k < 2; ++k) \
    acc[ai][bj][m][n] = __builtin_amdgcn_mfma_f32_16x16x32_bf16(Bt[n][k], At[m][k], acc[ai][bj][m][n], 0, 0, 0); __builtin_amdgcn_s_setprio(0); } while (0)
#define PG8_WAIT_V(n) asm volatile("s_waitcnt vmcnt(" #n ")" ::: "memory")
#define PG8_WAIT_L(n) asm volatile("s_waitcnt lgkmcnt(" #n ")" ::: "memory")
#define PG8_BAR __builtin_amdgcn_s_barrier()
#define PG8_SCHED __builtin_amdgcn_sched_barrier(0)
  Unit cur, nxt; int ui = 0;
  if (!S.next(0, cur)) return;
  f32x4 acc[2][2][4][2];
#pragma unroll
  for (int a = 0; a < 2; ++a)
#pragma unroll
    for (int b = 0; b < 2; ++b)
#pragma unroll
      for (int m = 0; m < 4; ++m)
#pragma unroll
        for (int n = 0; n < 2; ++n) acc[a][b][m][n] = (f32x4){0.f, 0.f, 0.f, 0.f};
  bf16x8 At[4][2], B0[2][2], B1[2][2];
  const char* cA = (const char*)gA + (size_t)cur.pm * tstep; const char* cB = (const char*)gBt + (size_t)cur.pn * tstep;
  PG8_STAGE(PG8_SB(0, 0), cB, voffB); PG8_STAGE(PG8_SA(0, 0), cA, voffA); PG8_STAGE(PG8_SB(0, 1), cB + hstep, voffB); PG8_STAGE(PG8_SA(0, 1), cA + hstep, voffA);
  if (wr == 1) PG8_BAR;
  PG8_WAIT_V(4); PG8_BAR;
  PG8_STAGE(PG8_SB(1, 0), cB + kstep, voffB); PG8_STAGE(PG8_SA(1, 0), cA + kstep, voffA); PG8_STAGE(PG8_SB(1, 1), cB + hstep + kstep, voffB);
  PG8_WAIT_V(6); PG8_BAR;
  for (;;) {
    const bool has_next = S.next(ui + 1, nxt);
    const char* nA = has_next ? (const char*)gA + (size_t)nxt.pm * tstep : cA; const char* nB = has_next ? (const char*)gBt + (size_t)nxt.pn * tstep : cB;
#pragma unroll 1
    for (int t = 0; t < nt; t += 2) {
      const bool last = (t == nt - 2);
      const char* a1 = cA + (size_t)(t + 1) * kstep;
      const char* a2 = last ? nA : cA + (size_t)(t + 2) * kstep; const char* b2 = last ? nB : cB + (size_t)(t + 2) * kstep;
      const char* a3 = a2 + kstep; const char* b3 = b2 + kstep;
      PG8_LDB(B0, 0, 0); PG8_SCHED; PG8_LDA(At, 0, 0); PG8_STAGE(PG8_SA(1, 1), a1 + hstep, voffA);
      PG8_WAIT_L(8); PG8_BAR; PG8_WAIT_L(0); PG8_MMA(0, 0, At, B0); PG8_BAR; PG8_SCHED;
      PG8_LDB(B1, 0, 1); PG8_STAGE(PG8_SB(0, 0), b2, voffB);
      PG8_BAR; PG8_WAIT_L(0); PG8_MMA(0, 1, At, B1); PG8_BAR;
      PG8_LDA(At, 0, 1); PG8_STAGE(PG8_SA(0, 0), a2, voffA);
      PG8_BAR; PG8_WAIT_L(0); PG8_MMA(1, 0, At, B0); PG8_BAR; PG8_SCHED;
      PG8_STAGE(PG8_SB(0, 1), b2 + hstep, voffB);
      PG8_WAIT_V(6); PG8_BAR; PG8_MMA(1, 1, At, B1); PG8_BAR;
      PG8_LDB(B0, 1, 0); PG8_SCHED; PG8_LDA(At, 1, 0); PG8_STAGE(PG8_SA(0, 1), a2 + hstep, voffA);
      PG8_WAIT_L(8); PG8_BAR; PG8_WAIT_L(0); PG8_MMA(0, 0, At, B0); PG8_BAR; PG8_SCHED;
      PG8_LDB(B1, 1, 1); PG8_STAGE(PG8_SB(1, 0), b3, voffB);
      PG8_BAR; PG8_WAIT_L(0); PG8_MMA(0, 1, At, B1); PG8_BAR;
      PG8_LDA(At, 1, 1); PG8_STAGE(PG8_SA(1, 0), a3, voffA);
      PG8_BAR; PG8_WAIT_L(0); PG8_MMA(1, 0, At, B0); PG8_BAR; PG8_SCHED;
      PG8_STAGE(PG8_SB(1, 1), b3 + hstep, voffB);
      PG8_WAIT_V(6); PG8_BAR; PG8_MMA(1, 1, At, B1); PG8_BAR;
    }
    E(acc, cur, wr, wc, fr, fq);
    if (!has_next) break;
#pragma unroll
    for (int a = 0; a < 2; ++a)
#pragma unroll
      for (int b = 0; b < 2; ++b)
#pragma unroll
        for (int m = 0; m < 4; ++m)
#pragma unroll
          for (int n = 0; n < 2; ++n) acc[a][b][m][n] = (f32x4){0.f, 0.f, 0.f, 0.f};
    cur = nxt; cA = nA; cB = nB; ++ui;
  }
  PG8_WAIT_V(0);
  if (wr == 0) PG8_BAR;
  PG8_BAR;
#undef PG8_SA
#undef PG8_SB
#undef PG8_STAGE
#undef PG8_LDA
#undef PG8_LDB
#undef PG8_MMA
#undef PG8_WAIT_V
#undef PG8_WAIT_L
#undef PG8_BAR
#undef PG8_SCHED
}

typedef f32x4 acc_t[2][2][4][2];
DEVI void token_info(int token, bool ctx, int& b, int& s, int& key) {
  if (!ctx) { b = token >> 11; s = token & 2047; key = 256 + s; } else { const int tc = token - NLAT; b = tc >> 8; s = 0; key = tc & 255; }
}
DEVI float swap32_partner(float v, bool upper) {
  auto rr = __builtin_amdgcn_permlane32_swap(__float_as_uint(v), __float_as_uint(v), false, false);
  return __uint_as_float(upper ? rr[0] : rr[1]);
}
DEVI void rope_pair(f32x4& v0, f32x4& v1, const float2* __restrict__ tab, int pos, int fq) {
  const bool upper = fq >= 2;
  const float2* t = tab + pos * 16 + (fq & 1) * 8;
  const f32x4 t0 = *reinterpret_cast<const f32x4*>(t), t1 = *reinterpret_cast<const f32x4*>(t + 2), t2 = *reinterpret_cast<const f32x4*>(t + 4), t3 = *reinterpret_cast<const f32x4*>(t + 6);
  const float cs[8] = {t0[0], t0[2], t1[0], t1[2], t2[0], t2[2], t3[0], t3[2]}, sn[8] = {t0[1], t0[3], t1[1], t1[3], t2[1], t2[3], t3[1], t3[3]};
#pragma unroll
  for (int e = 0; e < 4; ++e) {
    const float p0 = swap32_partner(v0[e], upper), p1 = swap32_partner(v1[e], upper);
    const float s0 = upper ? sn[e] : -sn[e], s1 = upper ? sn[4 + e] : -sn[4 + e];
    v0[e] = v0[e] * cs[e] + p0 * s0; v1[e] = v1[e] * cs[4 + e] + p1 * s1;
  }
}
DEVI void st8(bf16_t* dst, const f32x4& v0, const f32x4& v1) { u32x4 pk = {cvtpk(v0[0], v0[1]), cvtpk(v0[2], v0[3]), cvtpk(v1[0], v1[1]), cvtpk(v1[2], v1[3])}; *reinterpret_cast<u32x4*>(dst) = pk; }

struct EpiL0In {
  bf16_t *U, *GV, *ZA, *ZB, *Q0, *K0, *V0; const float2* rope;
  DEVI void operator()(acc_t& acc, const Unit& u, int wr, int wc, int fr, int fq) const {
    const int col0 = u.pn * 256, type = col0 >> 9; const bool ctx = u.pm >= 128;
#pragma unroll
    for (int ai = 0; ai < 2; ++ai)
#pragma unroll
      for (int m = 0; m < 4; ++m) {
        const int token = u.pm * 256 + ai * 128 + wr * 64 + m * 16 + fr;
        int b, s, key; token_info(token, ctx, b, s, key);
#pragma unroll
        for (int bj = 0; bj < 2; ++bj) {
          const int nl = (col0 & 511) + bj * 128 + wc * 32;
          f32x4 v0 = acc[ai][bj][m][0], v1 = acc[ai][bj][m][1];
          bf16_t* dst;
          if (type <= 1) {
#pragma unroll
            for (int e = 0; e < 4; ++e) { v0[e] = gelu_f(v0[e]); v1[e] = gelu_f(v1[e]); }
            dst = (type == 0 ? U : GV) + (size_t)token * 512 + nl;
          } else if (type == 2 || type == 6) {
#pragma unroll
            for (int e = 0; e < 4; ++e) { v0[e] = silu_f(v0[e]); v1[e] = silu_f(v1[e]); }
            dst = (type == 2 ? ZA : ZB) + (size_t)token * 512 + nl;
          } else if (type == 3) {
            if (!ctx) rope_pair(v0, v1, rope, (wc & 1) ? (s & 63) : (s >> 6), fq);
            dst = Q0 + (size_t)token * 512 + nl;
          } else if (type == 4) {
            if (!ctx) rope_pair(v0, v1, rope, (wc & 1) ? (s & 63) : (s >> 6), fq);
            dst = K0 + ((size_t)(b * 4 + (nl >> 7)) * KVL + key) * 128 + (nl & 127);
          } else {
            dst = V0 + ((size_t)(b * 4 + (nl >> 7)) * KVL + key) * 128 + (nl & 127);
          }
          st8(dst + fq * 8, v0, v1);
        }
      }
  }
};

template <bool HASCTX> struct EpiOut {
  const float* src_lat; const float* src_ctx; float* dst_lat; float* dst_ctx; const float* ada;
  DEVI void operator()(acc_t& acc, const Unit& u, int wr, int wc, int fr, int fq) const {
    const int col0 = u.pn * 256;
#pragma unroll
    for (int ai = 0; ai < 2; ++ai)
#pragma unroll
      for (int m = 0; m < 4; ++m) {
        const int token = u.pm * 256 + ai * 128 + wr * 64 + m * 16 + fr;
        const float* src; float* dst; const float* gate;
        if (!HASCTX || token < NLAT) { src = src_lat + (size_t)token * 1024; dst = dst_lat + (size_t)token * 1024; gate = ada + (token >> 11) * 3072 + 2048; }
        else { const int tc = token - NLAT; src = src_ctx + (size_t)tc * 1024; dst = dst_ctx + (size_t)tc * 1024; gate = ada + 16 * 3072 + 2048; }
#pragma unroll
        for (int bj = 0; bj < 2; ++bj)
#pragma unroll
          for (int n = 0; n < 2; ++n) {
            const int c = col0 + bj * 128 + wc * 32 + fq * 8 + n * 4;
            const f32x4 xv = *reinterpret_cast<const f32x4*>(src + c), g = *reinterpret_cast<const f32x4*>(gate + c);
            *reinterpret_cast<f32x4*>(dst + c) = xv + g * acc[ai][bj][m][n];
          }
      }
  }
};

struct EpiPlain {
  bf16_t* O;
  DEVI void operator()(acc_t& acc, const Unit& u, int wr, int wc, int fr, int fq) const {
    const int col0 = u.pn * 256;
#pragma unroll
    for (int ai = 0; ai < 2; ++ai)
#pragma unroll
      for (int m = 0; m < 4; ++m) {
        const int token = u.pm * 256 + ai * 128 + wr * 64 + m * 16 + fr;
#pragma unroll
        for (int bj = 0; bj < 2; ++bj) st8(O + (size_t)token * 1024 + col0 + bj * 128 + wc * 32 + fq * 8, acc[ai][bj][m][0], acc[ai][bj][m][1]);
      }
  }
};

struct EpiL1In {
  bf16_t *CQ, *CKV, *K1, *Z1; float *RQ, *RKV; const float2* rope; float* ssb;
  DEVI void operator()(acc_t& acc, const Unit& u, int wr, int wc, int fr, int fq) const {
    const int col0 = u.pn * 256; const bool ctx = u.pm >= 128;
    float ss[2][4];
#pragma unroll
    for (int ai = 0; ai < 2; ++ai)
#pragma unroll
      for (int m = 0; m < 4; ++m) {
        ss[ai][m] = 0.f;
        const int token = u.pm * 256 + ai * 128 + wr * 64 + m * 16 + fr;
        int b, s, key; token_info(token, ctx, b, s, key);
#pragma unroll
        for (int bj = 0; bj < 2; ++bj) {
          const int nb = col0 + bj * 128 + wc * 32;
          f32x4 v0 = acc[ai][bj][m][0], v1 = acc[ai][bj][m][1];
          if (nb < 384) {
#pragma unroll
            for (int e = 0; e < 4; ++e) ss[ai][m] += v0[e] * v0[e] + v1[e] * v1[e];
            bf16_t* dst = nb < 256 ? CQ + (size_t)token * 256 + nb : CKV + (size_t)token * 128 + (nb - 256);
            st8(dst + fq * 8, v0, v1);
          } else if (nb < 448) {
            if (!ctx) rope_pair(v0, v1, rope, (nb >= 416) ? (s & 63) : (s >> 6), fq);
            { bf16_t* dst = K1   + ((size_t)b * KVL + key) * 192 + 128 + (nb - 384);
              st8(dst + fq * 8, v0, v1); }
          } else if (nb < 1472) {
            if (!ctx) {
#pragma unroll
              for (int e = 0; e < 4; ++e) { v0[e] = silu_f(v0[e]); v1[e] = silu_f(v1[e]); }
              bf16_t* dst = Z1 + (size_t)token * 1024 + (nb - 448);
              st8(dst + fq * 8, v0, v1);
            }
          }
        }
      }
    if (u.pn <= 1) {
#pragma unroll
      for (int ai = 0; ai < 2; ++ai)
#pragma unroll
        for (int m = 0; m < 4; ++m) {
          float sv = ss[ai][m]; sv = xsum<16>(sv); sv = xsum<32>(sv);
          if (fq == 0) ssb[wc * 256 + ai * 128 + wr * 64 + m * 16 + fr] = sv;
        }
      asm volatile("s_waitcnt lgkmcnt(0)" ::: "memory"); __builtin_amdgcn_s_barrier(); asm volatile("" ::: "memory");
      const int lt = wc * 64 + fq * 16 + fr;
      if (lt < 128) {
        const int row = (lt >> 6) * 128 + wr * 64 + (lt & 63);
        if (u.pn == 0) { const float tot = (ssb[row] + ssb[256 + row]) + (ssb[512 + row] + ssb[768 + row]); RQ[u.pm * 256 + row] = rsqrtf(tot * (1.f / 256.f) + 1e-6f); }
        else { const float tot = (ssb[row] + ssb[256 + row]) + (ssb[512 + row] + ssb[768 + row]); RKV[u.pm * 256 + row] = rsqrtf(tot * (1.f / 128.f) + 1e-6f); }
      }
    }
  }
};

struct EpiQ {
  bf16_t* Q1; const float* RQ; const float2* rope;
  DEVI void operator()(acc_t& acc, const Unit& u, int wr, int wc, int fr, int fq) const {
    const int col0 = u.pn * 256;
#pragma unroll
    for (int ai = 0; ai < 2; ++ai)
#pragma unroll
      for (int m = 0; m < 4; ++m) {
        const int token = u.pm * 256 + ai * 128 + wr * 64 + m * 16 + fr; const int s = token & 2047; const float rq = RQ[token];
#pragma unroll
        for (int bj = 0; bj < 2; ++bj) {
          const int n0 = col0 + bj * 128 + wc * 32; const int dd0 = n0 % 192;
          f32x4 v0 = acc[ai][bj][m][0] * rq, v1 = acc[ai][bj][m][1] * rq;
          if (dd0 >= 128) rope_pair(v0, v1, rope, (dd0 >= 160) ? (s & 63) : (s >> 6), fq);
          bf16_t* dst = Q1 + (size_t)token * 1536 + n0;
          st8(dst + fq * 8, v0, v1);
        }
      }
  }
};

struct EpiKV {
  bf16_t *K1, *V1; const float* RKV;
  DEVI void operator()(acc_t& acc, const Unit& u, int wr, int wc, int fr, int fq) const {
    const int col0 = u.pn * 256; const bool ctx = u.pm >= 128;
#pragma unroll
    for (int ai = 0; ai < 2; ++ai)
#pragma unroll
      for (int m = 0; m < 4; ++m) {
        const int token = u.pm * 256 + ai * 128 + wr * 64 + m * 16 + fr; const float rk = RKV[token];
        int b, s, key; token_info(token, ctx, b, s, key);
#pragma unroll
        for (int bj = 0; bj < 2; ++bj) {
          const int nb = col0 + bj * 128 + wc * 32; const int h = nb >> 8, dd = nb & 255;
          const f32x4 v0 = acc[ai][bj][m][0] * rk, v1 = acc[ai][bj][m][1] * rk;
          bf16_t* dst = dd < 128 ? K1 + ((size_t)(b * 8 + h) * KVL + key) * 192 + dd : V1 + ((size_t)(b * 8 + h) * KVL + key) * 128 + (dd - 128);
          st8(dst + fq * 8, v0, v1);
        }
      }
  }
};

template <int SCID> struct ScaleOf { static constexpr float v = SCID == 0 ? 0.125f : 0.07216878364870322f; };
constexpr float THR = 8.f;
template <int KW> DEVI int kswz(int row, int colB) { return row * (KW * 2 + 16) + colB; }
DEVI int v_st(int k, int c) { const int kk = (k & ~0xC) | ((k & 4) << 1) | ((k & 8) >> 1); return ((kk >> 3) * 4 + (c >> 5)) * 512 + ((kk & 7) * 32 + (c & 31)) * 2; }
DEVI int v_rd_base(int lane) { return ((lane & 3) << 3) | (((lane >> 2) & 3) << 6) | (((lane >> 4) & 1) << 5) | (((lane >> 5) & 1) << 8); }
constexpr int v_rd_off(int d0, int ks, int half) { return d0 * 512 + ks * 4096 + half * 2048; }
template <int OFF> DEVI s16x4 tr_read(int vb) { s16x4 r; asm volatile("ds_read_b64_tr_b16 %0, %1 offset:%2" : "=&v"(r) : "v"(vb), "i"(OFF) : "memory"); return r; }

template <int SCID>
DEVI void partialSM(f32x16& p0, f32x16& p1, float& m_reg, float& mn, float& alpha) {
  constexpr float SC = ScaleOf<SCID>::v; constexpr float C = SC * 1.4426950408889634f;
  float pmax = p0[0];
#pragma unroll
  for (int r = 1; r < 16; ++r) pmax = fmaxf(pmax, p0[r]);
#pragma unroll
  for (int r = 0; r < 16; ++r) pmax = fmaxf(pmax, p1[r]);
  { auto rr = __builtin_amdgcn_permlane32_swap(__float_as_uint(pmax), __float_as_uint(pmax), false, false);
    pmax = fmaxf(__uint_as_float(rr[0]), __uint_as_float(rr[1])); }
  if (__builtin_expect(__all(pmax - m_reg <= THR / SC), 1)) { mn = m_reg; alpha = 1.f; }
  else { mn = fmaxf(m_reg, pmax); alpha = __builtin_amdgcn_exp2f((m_reg - mn) * C); m_reg = mn; }
  const float mnC = -mn * C;
#pragma unroll
  for (int r = 0; r < 16; ++r) p0[r] = fmaf(p0[r], C, mnC);
#pragma unroll
  for (int r = 0; r < 16; ++r) p1[r] = fmaf(p1[r], C, mnC);
#pragma unroll
  for (int r = 0; r < 16; ++r) p0[r] = __builtin_amdgcn_exp2f(p0[r]);
}
DEVI void finishSM(f32x16& p0, f32x16& p1, float alpha, float& l_reg, bf16x8& pa0, bf16x8& pa1, bf16x8& pa2, bf16x8& pa3) {
#pragma unroll
  for (int r = 0; r < 16; ++r) p1[r] = __builtin_amdgcn_exp2f(p1[r]);
  float ps = 0;
#pragma unroll
  for (int r = 0; r < 16; ++r) ps += p0[r];
#pragma unroll
  for (int r = 0; r < 16; ++r) ps += p1[r];
  { auto rr = __builtin_amdgcn_permlane32_swap(__float_as_uint(ps), __float_as_uint(ps), false, false);
    ps = __uint_as_float(rr[0]) + __uint_as_float(rr[1]); }
  l_reg = l_reg * alpha + ps;
#define PK4(P, BASE, OUT) do { unsigned a0 = cvtpk(P[BASE + 0], P[BASE + 1]), a1 = cvtpk(P[BASE + 2], P[BASE + 3]); \
    unsigned b0 = cvtpk(P[BASE + 4], P[BASE + 5]), b1 = cvtpk(P[BASE + 6], P[BASE + 7]); \
    auto r0 = __builtin_amdgcn_permlane32_swap(a0, b0, false, false); auto r1 = __builtin_amdgcn_permlane32_swap(a1, b1, false, false); \
    u32x4 w = {r0[0], r1[0], r0[1], r1[1]}; OUT = *reinterpret_cast<bf16x8*>(&w); } while (0)
  PK4(p0, 0, pa0); PK4(p0, 8, pa1); PK4(p1, 0, pa2); PK4(p1, 8, pa3);
#undef PK4
}
template <int OFF> DEVI bf16x8 lds_rd128(int a) { bf16x8 r; asm volatile("ds_read_b128 %0, %1 offset:%2" : "=&v"(r) : "v"(a), "i"(OFF) : "memory"); return r; }
template <int N> DEVI void wait_lgkm() { asm volatile("s_waitcnt lgkmcnt(%0)" :: "n"(N) : "memory"); }
template <int NQ, int QL> constexpr bool q_is_lds(int s) { return QL > 0 && s >= NQ - QL && s < NQ; }
template <int NQ, int QL, int PF> constexpr int q_after(int d) {
  int n = q_is_lds<NQ, QL>(d + 1) ? 1 : 0;
  if (q_is_lds<NQ, QL>(d)) n += (d + PF < NQ ? 2 : 0);
  else for (int i = 1; i <= PF; ++i) n += (d + i < NQ ? 2 : 0);
  return n;
}
template <int KW, int NQ, int QL, int PF, int D0>
DEVI void qkt_step(f32x16& p0, f32x16& p1, int ka, const bf16x8* qr, int qa, bf16x8 (&kf)[PF + 1][2], bf16x8 (&qf)[2]) {
  if constexpr (D0 < NQ) {
    constexpr int ROW32 = 32 * (KW * 2 + 16);
    if constexpr (D0 + PF < NQ) { kf[(D0 + PF) % (PF + 1)][0] = lds_rd128<(D0 + PF) * 32>(ka); kf[(D0 + PF) % (PF + 1)][1] = lds_rd128<ROW32 + (D0 + PF) * 32>(ka); }
    if constexpr (q_is_lds<NQ, QL>(D0 + 1)) qf[(D0 + 1) & 1] = lds_rd128<(D0 + 1 - (NQ - QL)) * 32>(qa);
    wait_lgkm<q_after<NQ, QL, PF>(D0)>(); SBAR();
    bf16x8 q;
    if constexpr (q_is_lds<NQ, QL>(D0)) q = qf[D0 & 1]; else q = qr[D0];
    p0 = __builtin_amdgcn_mfma_f32_32x32x16_bf16(kf[D0 % (PF + 1)][0], q, p0, 0, 0, 0);
    p1 = __builtin_amdgcn_mfma_f32_32x32x16_bf16(kf[D0 % (PF + 1)][1], q, p1, 0, 0, 0);
    qkt_step<KW, NQ, QL, PF, D0 + 1>(p0, p1, ka, qr, qa, kf, qf);
  }
}
template <int KW, int NQ, int QL = 0>
DEVI void qkt(f32x16& p0, f32x16& p1, const char* Ks, const bf16x8* qr, int kcol0, int r32, int hi, const char* ql = nullptr) {
  constexpr int PF = QL > 0 ? 2 : 3;
#pragma unroll
  for (int r = 0; r < 16; ++r) { p0[r] = 0.f; p1[r] = 0.f; }
  const int ka = (int)(uintptr_t)(Ks + kswz<KW>(r32, (kcol0 + hi * 8) * 2)), qa = (int)(uintptr_t)ql;
  constexpr int ROW32 = 32 * (KW * 2 + 16);
  static_assert(NQ >= PF && (QL == 0 || NQ - QL >= PF), "prologue issues steps 0..PF-1 from register-q steps");
  bf16x8 kf[PF + 1][2], qf[2];
  asm volatile("s_waitcnt lgkmcnt(0)" ::: "memory");
  kf[0][0] = lds_rd128<0>(ka); kf[0][1] = lds_rd128<ROW32>(ka);
  kf[1][0] = lds_rd128<32>(ka); kf[1][1] = lds_rd128<ROW32 + 32>(ka);
  if constexpr (PF >= 3) { kf[2][0] = lds_rd128<64>(ka); kf[2][1] = lds_rd128<ROW32 + 64>(ka); }
  qkt_step<KW, NQ, QL, PF, 0>(p0, p1, ka, qr, qa, kf, qf);
}
template <int D0> DEVI void pv_one(f32x16& od, int vb, bf16x8 pa0, bf16x8 pa1, bf16x8 pa2, bf16x8 pa3) {
  const s16x4 l0 = tr_read<v_rd_off(D0, 0, 0)>(vb), h0 = tr_read<v_rd_off(D0, 0, 1)>(vb), l1 = tr_read<v_rd_off(D0, 1, 0)>(vb), h1 = tr_read<v_rd_off(D0, 1, 1)>(vb);
  const s16x4 l2 = tr_read<v_rd_off(D0, 2, 0)>(vb), h2 = tr_read<v_rd_off(D0, 2, 1)>(vb), l3 = tr_read<v_rd_off(D0, 3, 0)>(vb), h3 = tr_read<v_rd_off(D0, 3, 1)>(vb);
  asm volatile("s_waitcnt lgkmcnt(0)" ::: "memory"); SBAR();
#define PK(L, H) (bf16x8){L[0], L[1], L[2], L[3], H[0], H[1], H[2], H[3]}
  od = __builtin_amdgcn_mfma_f32_32x32x16_bf16(pa0, PK(l0, h0), od, 0, 0, 0);
  od = __builtin_amdgcn_mfma_f32_32x32x16_bf16(pa1, PK(l1, h1), od, 0, 0, 0);
  od = __builtin_amdgcn_mfma_f32_32x32x16_bf16(pa2, PK(l2, h2), od, 0, 0, 0);
  od = __builtin_amdgcn_mfma_f32_32x32x16_bf16(pa3, PK(l3, h3), od, 0, 0, 0);
#undef PK
}
template <int D0> DEVI void v_load(int vb, s16x4 (&f)[8]) {
  f[0] = tr_read<v_rd_off(D0, 0, 0)>(vb); f[1] = tr_read<v_rd_off(D0, 0, 1)>(vb); f[2] = tr_read<v_rd_off(D0, 1, 0)>(vb); f[3] = tr_read<v_rd_off(D0, 1, 1)>(vb);
  f[4] = tr_read<v_rd_off(D0, 2, 0)>(vb); f[5] = tr_read<v_rd_off(D0, 2, 1)>(vb); f[6] = tr_read<v_rd_off(D0, 3, 0)>(vb); f[7] = tr_read<v_rd_off(D0, 3, 1)>(vb);
}
DEVI void pv_mma(f32x16& od, const s16x4 (&f)[8], bf16x8 pa0, bf16x8 pa1, bf16x8 pa2, bf16x8 pa3) {
#define PK(L, H) (bf16x8){L[0], L[1], L[2], L[3], H[0], H[1], H[2], H[3]}
  od = __builtin_amdgcn_mfma_f32_32x32x16_bf16(pa0, PK(f[0], f[1]), od, 0, 0, 0);
  od = __builtin_amdgcn_mfma_f32_32x32x16_bf16(pa1, PK(f[2], f[3]), od, 0, 0, 0);
  od = __builtin_amdgcn_mfma_f32_32x32x16_bf16(pa2, PK(f[4], f[5]), od, 0, 0, 0);
  od = __builtin_amdgcn_mfma_f32_32x32x16_bf16(pa3, PK(f[6], f[7]), od, 0, 0, 0);
#undef PK
}
DEVI void pv_d0(f32x16* o, int vb, bf16x8 pa0, bf16x8 pa1, bf16x8 pa2, bf16x8 pa3) {
  s16x4 fa[8], fb[8];
  v_load<0>(vb, fa);
  v_load<1>(vb, fb); asm volatile("s_waitcnt lgkmcnt(8)" ::: "memory"); SBAR(); pv_mma(o[0], fa, pa0, pa1, pa2, pa3); SBAR();
  v_load<2>(vb, fa); asm volatile("s_waitcnt lgkmcnt(8)" ::: "memory"); SBAR(); pv_mma(o[1], fb, pa0, pa1, pa2, pa3); SBAR();
  v_load<3>(vb, fb); asm volatile("s_waitcnt lgkmcnt(8)" ::: "memory"); SBAR(); pv_mma(o[2], fa, pa0, pa1, pa2, pa3); SBAR();
  asm volatile("s_waitcnt lgkmcnt(0)" ::: "memory"); SBAR(); pv_mma(o[3], fb, pa0, pa1, pa2, pa3);
}

template <int KW, int NQ, int SCID>
DEVI void attn_core(int wv, const bf16_t* __restrict__ Qw, const bf16_t* __restrict__ Kh, const bf16_t* __restrict__ Vh, int kcol0, int NT, char* lds,
                    f32x16 (&o)[4], float& l_out) {
  constexpr int SHM_V = 64 * 128 * 2, SHM_K = 64 * (KW * 2 + 16), KC = KW / 64;
  const int tid = tidx(wv), wid = tid >> 6, lane = tid & 63, r32 = lane & 31, hi = lane >> 5;
  char* V_lds = lds; char* K_lds = lds + 2 * SHM_V;
  float* al_l = (float*)(lds + 2 * SHM_V + 2 * SHM_K) + wid * 64 + 32;
  float m_reg = -1e30f, l_reg = 0;
#pragma unroll
  for (int d = 0; d < 4; ++d)
#pragma unroll
    for (int r = 0; r < 16; ++r) o[d][r] = 0.f;
  bf16x8 qr[NQ];
#pragma unroll
  for (int d0 = 0; d0 < NQ; ++d0) qr[d0] = *reinterpret_cast<const bf16x8*>(Qw + d0 * 16);
  const int sr = tid >> 4, sc = (tid & 15) * 8, vst0 = v_st(sr, sc), vst1 = v_st(32 + sr, sc);
  const int krow = tid >> 3, kch = tid & 7;
  const bf16_t* vg = Vh + sr * 128 + sc;
  const bf16_t* kg = Kh + krow * KW + kch * 8;
  const int vb0 = (int)(uintptr_t)V_lds + v_rd_base(lane);
  bf16x8 vs0, vs1, ks[KC];
#define SLOAD(k0) do { vs0 = *reinterpret_cast<const bf16x8*>(vg + (size_t)(k0) * 128); vs1 = *reinterpret_cast<const bf16x8*>(vg + (size_t)((k0) + 32) * 128); \
    _Pragma("unroll") for (int _c = 0; _c < KC; ++_c) ks[_c] = *reinterpret_cast<const bf16x8*>(kg + (size_t)(k0) * KW + _c * 64); } while (0)
#define SWRITE(b) do { *reinterpret_cast<bf16x8*>(V_lds + (b) * SHM_V + vst0) = vs0; *reinterpret_cast<bf16x8*>(V_lds + (b) * SHM_V + vst1) = vs1; \
    _Pragma("unroll") for (int _c = 0; _c < KC; ++_c) *reinterpret_cast<bf16x8*>(K_lds + (b) * SHM_K + kswz<KW>(krow, (kch + 8 * _c) * 16)) = ks[_c]; } while (0)
  SLOAD(0); SWRITE(0);
  if (NT > 1) SLOAD(64);
  __syncthreads();
  for (int j = 0; j < NT; ++j) {
    const int bsel = j & 1;
    f32x16 p0, p1; float mn, alpha; bf16x8 pa0, pa1, pa2, pa3;
    qkt<KW, NQ>(p0, p1, K_lds + bsel * SHM_K, qr, kcol0, r32, hi);
    partialSM<SCID>(p0, p1, m_reg, mn, alpha);
    if (__any(alpha < 1.f)) {
      if (hi == 0) al_l[r32] = alpha;
      asm volatile("s_waitcnt lgkmcnt(0)" ::: "memory");
#pragma unroll
      for (int d = 0; d < 4; ++d)
#pragma unroll
        for (int r = 0; r < 16; ++r) o[d][r] *= al_l[crow(r, hi)];
    }
    finishSM(p0, p1, alpha, l_reg, pa0, pa1, pa2, pa3);
    pv_d0(o, vb0 + bsel * SHM_V, pa0, pa1, pa2, pa3);
    if (j + 1 < NT) { SWRITE(bsel ^ 1); if (j + 2 < NT) SLOAD((j + 2) * 64); }
    __syncthreads();
  }
  l_out = l_reg;
#undef SLOAD
#undef SWRITE
}

template <int KW, int NQ, int SDEPTH, int SCID, int QL>
DEVI void attn_core_pipe(int wv, const bf16_t* __restrict__ Qw, const bf16_t* __restrict__ Kh, const bf16_t* __restrict__ Vh, int kcol0, int NT, char* lds,
                         f32x16 (&o)[4], float& l_out) {
  constexpr int SHM_V = 64 * 128 * 2, SHM_K = 64 * (KW * 2 + 16), KC = KW / 64;
  const int tid = tidx(wv), wid = tid >> 6, lane = tid & 63, r32 = lane & 31, hi = lane >> 5;
  char* V_lds = lds; char* K_lds = lds + 2 * SHM_V;
  float* al_l = (float*)(lds + 2 * SHM_V + 2 * SHM_K) + wid * 64 + 32;
  float m_reg = -1e30f, l_reg = 0;
#pragma unroll
  for (int d = 0; d < 4; ++d)
#pragma unroll
    for (int r = 0; r < 16; ++r) o[d][r] = 0.f;
  bf16x8 qr[NQ - QL + (QL ? 1 : 0)];
#pragma unroll
  for (int d0 = 0; d0 < NQ - QL; ++d0) qr[d0] = *reinterpret_cast<const bf16x8*>(Qw + d0 * 16);
  char* ql = lds + 2 * SHM_V + 2 * SHM_K + 2048 + (wid * 32 + r32) * 144 + hi * 16;
  if constexpr (QL > 0) {
#pragma unroll
    for (int d0 = NQ - QL; d0 < NQ; ++d0) *reinterpret_cast<bf16x8*>(ql + (d0 - (NQ - QL)) * 32) = *reinterpret_cast<const bf16x8*>(Qw + d0 * 16);
  }
  const int sr = tid >> 4, sc = (tid & 15) * 8, vst0 = v_st(sr, sc), vst1 = v_st(32 + sr, sc);
  const int krow = tid >> 3, kch = tid & 7;
  const bf16_t* vg = Vh + sr * 128 + sc;
  const bf16_t* kg = Kh + krow * KW + kch * 8;
  const int vb0 = (int)(uintptr_t)V_lds + v_rd_base(lane);
  struct { bf16x8 vs0, vs1, ks[KC]; } sr_[SDEPTH];
#define SLOAD(i, k0) do { sr_[i].vs0 = *reinterpret_cast<const bf16x8*>(vg + (size_t)(k0) * 128); sr_[i].vs1 = *reinterpret_cast<const bf16x8*>(vg + (size_t)((k0) + 32) * 128); \
    _Pragma("unroll") for (int _c = 0; _c < KC; ++_c) sr_[i].ks[_c] = *reinterpret_cast<const bf16x8*>(kg + (size_t)(k0) * KW + _c * 64); } while (0)
#define SWRITE(b, i) do { *reinterpret_cast<bf16x8*>(V_lds + (b) * SHM_V + vst0) = sr_[i].vs0; *reinterpret_cast<bf16x8*>(V_lds + (b) * SHM_V + vst1) = sr_[i].vs1; \
    _Pragma("unroll") for (int _c = 0; _c < KC; ++_c) *reinterpret_cast<bf16x8*>(K_lds + (b) * SHM_K + kswz<KW>(krow, (kch + 8 * _c) * 16)) = sr_[i].ks[_c]; } while (0)
#define SWAIT() do { if constexpr (SDEPTH == 2) asm volatile("s_waitcnt vmcnt(4)" ::: "memory"); else asm volatile("s_waitcnt vmcnt(0)" ::: "memory"); } while (0)
#define RESC(a) do { if (__any((a) < 1.f)) { if (hi == 0) al_l[r32] = (a); asm volatile("s_waitcnt lgkmcnt(0)" ::: "memory"); \
    _Pragma("unroll") for (int _d = 0; _d < 4; ++_d) _Pragma("unroll") for (int _r = 0; _r < 16; ++_r) o[_d][_r] *= al_l[crow(_r, hi)]; } } while (0)
  f32x16 pA0, pA1, pB0, pB1; float mnA, mnB, alA, alB; bf16x8 pa0, pa1, pa2, pa3;
  constexpr int SE = 0, SO = SDEPTH - 1;
  SLOAD(SE, 0); asm volatile("s_waitcnt vmcnt(0)" ::: "memory"); SWRITE(0, SE); __syncthreads();
  qkt<KW, NQ, QL>(pA0, pA1, K_lds, qr, kcol0, r32, hi, ql); partialSM<SCID>(pA0, pA1, m_reg, mnA, alA);
  SLOAD(SO, 64); if constexpr (SDEPTH == 2) { if (2 < NT) SLOAD(SE, 128); }
  SWAIT(); SWRITE(1, SO); __syncthreads();
  for (int j = 1; j + 1 < NT; j += 2) {
    SBAR(); qkt<KW, NQ, QL>(pB0, pB1, K_lds + SHM_K, qr, kcol0, r32, hi, ql);
    finishSM(pA0, pA1, alA, l_reg, pa0, pa1, pa2, pa3); SBAR();
    SLOAD(SO, (j + SDEPTH) * 64); SBAR();
    pv_d0(o, vb0, pa0, pa1, pa2, pa3); partialSM<SCID>(pB0, pB1, m_reg, mnB, alB);
    __syncthreads(); SWAIT(); SWRITE(0, SE);
    RESC(alB); __syncthreads();
    SBAR(); qkt<KW, NQ, QL>(pA0, pA1, K_lds, qr, kcol0, r32, hi, ql);
    finishSM(pB0, pB1, alB, l_reg, pa0, pa1, pa2, pa3); SBAR();
    if (SDEPTH == 1 || j + 3 < NT) SLOAD(SE, (j + 1 + SDEPTH) * 64);
    SBAR();
    pv_d0(o, vb0 + SHM_V, pa0, pa1, pa2, pa3); partialSM<SCID>(pA0, pA1, m_reg, mnA, alA);
    __syncthreads(); SWAIT(); SWRITE(1, SO);
    RESC(alA); __syncthreads();
  }
  SBAR(); qkt<KW, NQ, QL>(pB0, pB1, K_lds + SHM_K, qr, kcol0, r32, hi, ql);
  finishSM(pA0, pA1, alA, l_reg, pa0, pa1, pa2, pa3); SBAR();
  pv_d0(o, vb0, pa0, pa1, pa2, pa3); partialSM<SCID>(pB0, pB1, m_reg, mnB, alB);
  __syncthreads(); RESC(alB);
  finishSM(pB0, pB1, alB, l_reg, pa0, pa1, pa2, pa3); SBAR();
  pv_d0(o, vb0 + SHM_V, pa0, pa1, pa2, pa3);
  __syncthreads();
  l_out = l_reg;
#undef SLOAD
#undef SWRITE
#undef SWAIT
#undef RESC
}

template <int KW, int NQ, int SCID, int QL>
DEVI void attn_core_dma(int wv, const bf16_t* __restrict__ Qw, const bf16_t* __restrict__ Kh, const bf16_t* __restrict__ Vh, int kcol0, int NT, char* lds,
                        f32x16 (&o)[4], float& l_out) {
  constexpr int SHM_V = 64 * 128 * 2, KCH = KW / 8 + 1, SHM_K = 64 * KCH * 16, KR = (64 * KCH) / 512;
  static_assert(64 * KCH - KR * 512 == 64, "remainder must be one wave");
  const int tid = tidx(wv), wid = tid >> 6, lane = tid & 63, r32 = lane & 31, hi = lane >> 5;
  char* V_lds = lds; char* K_lds = lds + 2 * SHM_V;
  float* al_l = (float*)(lds + 2 * SHM_V + 2 * SHM_K) + wid * 64 + 32;
  float m_reg = -1e30f, l_reg = 0;
#pragma unroll
  for (int d = 0; d < 4; ++d)
#pragma unroll
    for (int r = 0; r < 16; ++r) o[d][r] = 0.f;
  bf16x8 qr[NQ - QL + (QL ? 1 : 0)];
#pragma unroll
  for (int d0 = 0; d0 < NQ - QL; ++d0) qr[d0] = *reinterpret_cast<const bf16x8*>(Qw + d0 * 16);
  char* ql = lds + 2 * SHM_V + 2 * SHM_K + 2048 + (wid * 32 + r32) * 144 + hi * 16;
  if constexpr (QL > 0) {
#pragma unroll
    for (int d0 = NQ - QL; d0 < NQ; ++d0) *reinterpret_cast<bf16x8*>(ql + (d0 - (NQ - QL)) * 32) = *reinterpret_cast<const bf16x8*>(Qw + d0 * 16);
  }
  const int sr = tid >> 4, sc = (tid & 15) * 8, vst0 = v_st(sr, sc), vst1 = v_st(32 + sr, sc);
  const bf16_t* vg = Vh + sr * 128 + sc;
  const int vb0 = (int)(uintptr_t)V_lds + v_rd_base(lane);
  unsigned koff[KR + 1];
#pragma unroll
  for (int i = 0; i <= KR; ++i) { const int c = tid + 512 * i; const int row = c / KCH; int ch = c - row * KCH; ch = ch == KCH - 1 ? KCH - 2 : ch; koff[i] = (unsigned)(row * KW + ch * 8) * 2u; }
  const unsigned kldsw = (unsigned)__builtin_amdgcn_readfirstlane(wid) * 1024u;
  bf16x8 vs0, vs1;
#define KDMA(k0, b) do { const char* _g = (const char*)(Kh + (size_t)(k0) * KW); PG8_LAS unsigned char* _l = (PG8_LAS unsigned char*)(K_lds + (b) * SHM_K) + kldsw; \
    _Pragma("unroll") for (int _i = 0; _i < KR; ++_i) __builtin_amdgcn_global_load_lds((const unsigned*)(_g + koff[_i]), (PG8_LAS unsigned*)(_l + _i * 8192), 16, 0, 0); \
    if (wid == 0) __builtin_amdgcn_global_load_lds((const unsigned*)(_g + koff[KR]), (PG8_LAS unsigned*)(_l + KR * 8192), 16, 0, 0); } while (0)
#define VLOAD(k0) do { vs0 = *reinterpret_cast<const bf16x8*>(vg + (size_t)(k0) * 128); vs1 = *reinterpret_cast<const bf16x8*>(vg + (size_t)((k0) + 32) * 128); } while (0)
#define VWRITE(b) do { *reinterpret_cast<bf16x8*>(V_lds + (b) * SHM_V + vst0) = vs0; *reinterpret_cast<bf16x8*>(V_lds + (b) * SHM_V + vst1) = vs1; } while (0)
#define VMW() asm volatile("s_waitcnt vmcnt(0)" ::: "memory")
#define RESC(a) do { if (__any((a) < 1.f)) { if (hi == 0) al_l[r32] = (a); asm volatile("s_waitcnt lgkmcnt(0)" ::: "memory"); \
    _Pragma("unroll") for (int _d = 0; _d < 4; ++_d) _Pragma("unroll") for (int _r = 0; _r < 16; ++_r) o[_d][_r] *= al_l[crow(_r, hi)]; } } while (0)
  f32x16 pA0, pA1, pB0, pB1; float mnA, mnB, alA, alB; bf16x8 pa0, pa1, pa2, pa3;
  KDMA(0, 0); VLOAD(0); VMW(); VWRITE(0); __syncthreads();
  KDMA(64, 1); VLOAD(64);
  qkt<KW, NQ, QL>(pA0, pA1, K_lds, qr, kcol0, r32, hi, ql); partialSM<SCID>(pA0, pA1, m_reg, mnA, alA);
  VMW(); __syncthreads(); VWRITE(1); __syncthreads();
  for (int j = 1; j + 1 < NT; j += 2) {
    SBAR(); KDMA((j + 1) * 64, 0); VLOAD((j + 1) * 64); SBAR();
    qkt<KW, NQ, QL>(pB0, pB1, K_lds + SHM_K, qr, kcol0, r32, hi, ql);
    finishSM(pA0, pA1, alA, l_reg, pa0, pa1, pa2, pa3); SBAR();
    pv_d0(o, vb0, pa0, pa1, pa2, pa3); partialSM<SCID>(pB0, pB1, m_reg, mnB, alB);
    VMW(); __syncthreads(); VWRITE(0);
    RESC(alB); __syncthreads();
    SBAR(); KDMA((j + 2) * 64, 1); VLOAD((j + 2) * 64); SBAR();
    qkt<KW, NQ, QL>(pA0, pA1, K_lds, qr, kcol0, r32, hi, ql);
    finishSM(pB0, pB1, alB, l_reg, pa0, pa1, pa2, pa3); SBAR();
    pv_d0(o, vb0 + SHM_V, pa0, pa1, pa2, pa3); partialSM<SCID>(pA0, pA1, m_reg, mnA, alA);
    VMW(); __syncthreads(); VWRITE(1);
    RESC(alA); __syncthreads();
  }
  SBAR(); qkt<KW, NQ, QL>(pB0, pB1, K_lds + SHM_K, qr, kcol0, r32, hi, ql);
  finishSM(pA0, pA1, alA, l_reg, pa0, pa1, pa2, pa3); SBAR();
  pv_d0(o, vb0, pa0, pa1, pa2, pa3); partialSM<SCID>(pB0, pB1, m_reg, mnB, alB);
  RESC(alB);
  finishSM(pB0, pB1, alB, l_reg, pa0, pa1, pa2, pa3); SBAR();
  pv_d0(o, vb0 + SHM_V, pa0, pa1, pa2, pa3);
  __syncthreads();
  l_out = l_reg;
#undef KDMA
#undef VLOAD
#undef VWRITE
#undef VMW
#undef RESC
}

template <int KW, int NQ, int SCID, int QL>
DEVI void attn_core_pp(int wv, const bf16_t* __restrict__ Qw, const bf16_t* __restrict__ Kh, const bf16_t* __restrict__ Vh, int kcol0, unsigned krd, int NT, char* lds,
                       f32x16 (&o)[4], float& l_out) {
  constexpr int SHM_V = 64 * 128 * 2, KCH = KW / 8 + 1, SHM_K = 64 * KCH * 16, KR = (64 * KCH) / 512;
  static_assert(64 * KCH - KR * 512 == 64, "remainder must be one wave");
  const int tid = tidx(wv), wid = tid >> 6, lane = tid & 63, r32 = lane & 31, hi = lane >> 5;
  const int g = __builtin_amdgcn_readfirstlane(wid >> 2);
  char* V_lds = lds; char* K_lds = lds + 2 * SHM_V;
  float* al_l = (float*)(lds + 2 * SHM_V + 2 * SHM_K) + wid * 64 + 32;
  float m_reg = -1e30f, l_reg = 0;
#pragma unroll
  for (int d = 0; d < 4; ++d)
#pragma unroll
    for (int r = 0; r < 16; ++r) o[d][r] = 0.f;
  bf16x8 qr[NQ - QL + (QL ? 1 : 0)];
#pragma unroll
  for (int d0 = 0; d0 < NQ - QL; ++d0) qr[d0] = *reinterpret_cast<const bf16x8*>(Qw + d0 * 16);
  char* ql = lds + 2 * SHM_V + 2 * SHM_K + 2048 + (wid * 32 + r32) * 144 + hi * 16;
  if constexpr (QL > 0) {
#pragma unroll
    for (int d0 = NQ - QL; d0 < NQ; ++d0) *reinterpret_cast<bf16x8*>(ql + (d0 - (NQ - QL)) * 32) = *reinterpret_cast<const bf16x8*>(Qw + d0 * 16);
  }
  const int vb0 = (int)(uintptr_t)V_lds + v_rd_base(lane);
  unsigned koff[KR + 1], voff[2];
#pragma unroll
  for (int i = 0; i <= KR; ++i) { const int c = tid + 512 * i; const int row = c / KCH; int ch = c - row * KCH; ch = ch == KCH - 1 ? KCH - 2 : ch; koff[i] = (unsigned)(row * KW + ch * 8) * 2u + (ch >= 16 ? krd : 0u); }
#pragma unroll
  for (int i = 0; i < 2; ++i) { const int q = tid + 512 * i; const int st = q >> 5, kk = (st >> 2) * 8 + ((q >> 2) & 7), c = (st & 3) * 32 + (q & 3) * 8;
    const int k = (kk & ~0xC) | ((kk & 4) << 1) | ((kk & 8) >> 1); voff[i] = (unsigned)(k * 128 + c) * 2u; }
  const unsigned ldsw = (unsigned)__builtin_amdgcn_readfirstlane(wid) * 1024u;
#define KDMA(k0, b) do { const char* _g = (const char*)(Kh + (size_t)(k0) * KW); PG8_LAS unsigned char* _l = (PG8_LAS unsigned char*)(K_lds + (b) * SHM_K) + ldsw; \
    _Pragma("unroll") for (int _i = 0; _i < KR; ++_i) __builtin_amdgcn_global_load_lds((const unsigned*)(_g + koff[_i]), (PG8_LAS unsigned*)(_l + _i * 8192), 16, 0, 0); \
    if (wid == 0) __builtin_amdgcn_global_load_lds((const unsigned*)(_g + koff[KR]), (PG8_LAS unsigned*)(_l + KR * 8192), 16, 0, 0); } while (0)
#define VDMA(k0, b) do { const char* _g = (const char*)(Vh + (size_t)(k0) * 128); PG8_LAS unsigned char* _l = (PG8_LAS unsigned char*)(V_lds + (b) * SHM_V) + ldsw; \
    _Pragma("unroll") for (int _i = 0; _i < 2; ++_i) __builtin_amdgcn_global_load_lds((const unsigned*)(_g + voff[_i]), (PG8_LAS unsigned*)(_l + _i * 8192), 16, 0, 0); } while (0)
#define VMW() asm volatile("s_waitcnt vmcnt(0)" ::: "memory")
#define PBAR() do { asm volatile("" ::: "memory"); __builtin_amdgcn_s_barrier(); asm volatile("" ::: "memory"); } while (0)
#define RESC(a) do { if (__any((a) < 1.f)) { if (hi == 0) al_l[r32] = (a); asm volatile("s_waitcnt lgkmcnt(0)" ::: "memory"); \
    _Pragma("unroll") for (int _d = 0; _d < 4; ++_d) _Pragma("unroll") for (int _r = 0; _r < 16; ++_r) o[_d][_r] *= al_l[crow(_r, hi)]; } } while (0)
  f32x16 pA0, pA1, pB0, pB1; float mn, al; bf16x8 pa0, pa1, pa2, pa3;
  KDMA(0, 0); KDMA(64, 1); VMW(); __syncthreads();
  qkt<KW, NQ, QL>(pA0, pA1, K_lds, qr, kcol0, r32, hi, ql);
  PBAR();
  if (g == 1) PBAR();
  for (int j = 0; j < NT; j += 2) {
    SBAR(); if (j + 2 < NT) KDMA((j + 2) * 64, 0); VDMA(j * 64, 0); SBAR();
    qkt<KW, NQ, QL>(pB0, pB1, K_lds + SHM_K, qr, kcol0, r32, hi, ql);
    if (j > 0) pv_d0(o, vb0 + SHM_V, pa0, pa1, pa2, pa3);
    if (g == 1) VMW();
    PBAR(); SBAR();
    partialSM<SCID>(pA0, pA1, m_reg, mn, al); RESC(al); finishSM(pA0, pA1, al, l_reg, pa0, pa1, pa2, pa3);
    if (g == 0) VMW();
    PBAR(); SBAR();
    if (j + 3 < NT) KDMA((j + 3) * 64, 1);
    VDMA((j + 1) * 64, 1); SBAR();
    if (j + 2 < NT) qkt<KW, NQ, QL>(pA0, pA1, K_lds, qr, kcol0, r32, hi, ql);
    pv_d0(o, vb0, pa0, pa1, pa2, pa3);
    if (g == 1) VMW();
    PBAR(); SBAR();
    partialSM<SCID>(pB0, pB1, m_reg, mn, al); RESC(al); finishSM(pB0, pB1, al, l_reg, pa0, pa1, pa2, pa3);
    if (g == 0) VMW();
    PBAR(); SBAR();
  }
  pv_d0(o, vb0 + SHM_V, pa0, pa1, pa2, pa3);
  if (g == 0) PBAR();
  __syncthreads();
  l_out = l_reg;
#undef KDMA
#undef VDMA
#undef VMW
#undef PBAR
#undef RESC
}

DEVI void gated_rows_out(const char* stg, int lane, const bf16_t* __restrict__ gate, int gld, bf16_t* __restrict__ out, int old) {
#pragma unroll
  for (int i = 0; i < 8; ++i) {
    const int c = lane + 64 * i, row = c >> 4, ch = c & 15;
    const u32x4 sv = *reinterpret_cast<const u32x4*>(stg + row * 272 + ch * 16);
    const u32x4 gv = *reinterpret_cast<const u32x4*>(gate + (size_t)row * gld + ch * 8);
    u32x4 ov;
#pragma unroll
    for (int e = 0; e < 4; ++e) ov[e] = cvtpk(bflo(sv[e]) * bflo(gv[e]), bfhi(sv[e]) * bfhi(gv[e]));
    *reinterpret_cast<u32x4*>(out + (size_t)row * old + ch * 8) = ov;
  }
}

DEVI void attn0_item(int wv, const Params& p, int token0, int b, int h, int nkeys, char* lds) {
  const int tid = tidx(wv), wid = tid >> 6, lane = tid & 63, r32 = lane & 31, hi = lane >> 5, m = wid >> 2, wl = wid & 3;
  const bf16_t* Q0 = (const bf16_t*)(p.ws + OFF_Q0); const bf16_t* K0 = (const bf16_t*)(p.ws + OFF_K0); const bf16_t* V0 = (const bf16_t*)(p.ws + OFF_V0);
  const bf16_t* ZB = (const bf16_t*)(p.ws + OFF_ZB); bf16_t* MIX = (bf16_t*)(p.ws + OFF_MIX);
  const bf16_t* Qw = Q0 + (size_t)(token0 + wl * 32 + r32) * 512 + h * 128 + m * 64 + hi * 8;
  const size_t kvo = (size_t)(b * 4 + h) * KVL * 128;
  f32x16 o[4]; float l;
  attn_core_pp<128, 4, 0, 0>(wv, Qw, K0 + kvo, V0 + kvo, m * 64, 0u, nkeys >> 6, lds, o, l);
  float* li_l = (float*)(lds + 32768 + 2 * 64 * 272) + wid * 64;
  if (hi == 0) li_l[r32] = l;
  asm volatile("s_waitcnt lgkmcnt(0)" ::: "memory");
  float rli[16];
#pragma unroll
  for (int r = 0; r < 16; ++r) rli[r] = __builtin_amdgcn_rcpf(li_l[crow(r, hi)]);
  float t1 = p.b_lq1[lane] * p.b_lk1[lane], t2 = p.b_lq2[lane] * p.b_lk2[lane];
  t1 = wave_sum(t1); t2 = wave_sum(t2);
  const float lam = __expf(t1) - __expf(t2) + 0.2f;
  __syncthreads();
  float* xch = (float*)lds;
  if (m == 1) {
#pragma unroll
    for (int r = 0; r < 16; ++r)
#pragma unroll
      for (int d0 = 0; d0 < 4; ++d0) xch[(wl * 32 + crow(r, hi)) * 128 + d0 * 32 + r32] = o[d0][r] * rli[r];
  }
  __syncthreads();
  if (m == 0) {
    char* stg = lds + 69632 + wl * 8704;
    float sw4[4];
#pragma unroll
    for (int d0 = 0; d0 < 4; ++d0) sw4[d0] = p.b_subln_w[d0 * 32 + r32];
#pragma unroll
    for (int r = 0; r < 16; ++r) {
      const int row = wl * 32 + crow(r, hi); const int token = token0 + row;
      float a[4], ss = 0.f;
#pragma unroll
      for (int d0 = 0; d0 < 4; ++d0) { a[d0] = o[d0][r] * rli[r] - lam * xch[row * 128 + d0 * 32 + r32]; ss += a[d0] * a[d0]; }
      ss = xsum<1>(ss); ss = xsum<2>(ss); ss = xsum<4>(ss); ss = xsum<8>(ss); ss = xsum<16>(ss);
      const float rstd = rsqrtf(ss * (1.f / 128.f) + 1e-5f) * 0.8f;
#pragma unroll
      for (int d0 = 0; d0 < 4; ++d0) *reinterpret_cast<bf16_t*>(stg + crow(r, hi) * 272 + (d0 * 32 + r32) * 2) = f2bf(a[d0] * rstd * sw4[d0]);
    }
    asm volatile("s_waitcnt lgkmcnt(0)" ::: "memory");
    const size_t t0 = (size_t)(token0 + wl * 32);
    gated_rows_out(stg, lane, ZB + t0 * 512 + h * 128, 512, MIX + t0 * 1024 + 512 + h * 128, 1024);
  }
  __syncthreads();
}

DEVI void attn1_item(int wv, const Params& p, int b, int h, int qb, char* lds) {
  const int tid = tidx(wv), wid = tid >> 6, lane = tid & 63, r32 = lane & 31, hi = lane >> 5;
  const bf16_t* Q1 = (const bf16_t*)(p.ws + OFF_Q1); const bf16_t* K1 = (const bf16_t*)(p.ws + OFF_K1); const bf16_t* V1 = (const bf16_t*)(p.ws + OFF_V1);
  const bf16_t* Z1 = (const bf16_t*)(p.ws + OFF_Z1); bf16_t* MIX = (bf16_t*)(p.ws + OFF_MIX);
  const int token0 = b * 2048 + qb * 256;
  const bf16_t* Qw = Q1 + (size_t)(token0 + wid * 32 + r32) * 1536 + h * 192 + hi * 8;
  f32x16 o[4]; float l;
  const bf16_t* Kh1 = K1 + (size_t)(b * 8 + h) * KVL * 192; const bf16_t* KRb = (const bf16_t*)(p.ws + OFF_KR) + (size_t)b * KVL * 192;
  attn_core_pp<192, 12, 1, 4>(wv, Qw, Kh1, V1 + (size_t)(b * 8 + h) * KVL * 128, 0, (unsigned)((const char*)KRb - (const char*)Kh1), KVL / 64, lds, o, l);
  float* li_l = (float*)(lds + 32768 + 2 * 64 * 400) + wid * 64;
  if (hi == 0) li_l[r32] = l;
  asm volatile("s_waitcnt lgkmcnt(0)" ::: "memory");
  char* stg = lds + wid * 8704;
#pragma unroll
  for (int r = 0; r < 16; ++r) {
    const int cr = crow(r, hi); const float rl = __builtin_amdgcn_rcpf(li_l[cr]);
#pragma unroll
    for (int d0 = 0; d0 < 4; ++d0) *reinterpret_cast<bf16_t*>(stg + cr * 272 + (d0 * 32 + r32) * 2) = f2bf(o[d0][r] * rl);
  }
  asm volatile("s_waitcnt lgkmcnt(0)" ::: "memory");
  const size_t t0 = (size_t)(token0 + wid * 32);
  gated_rows_out(stg, lane, Z1 + t0 * 1024 + h * 128, 1024, MIX + t0 * 1024 + h * 128, 1024);
  __syncthreads();
}

DEVI void abranch_item(int wv, const Params& p, int ci, char* lds) {
  const int tid = tidx(wv), wid = tid >> 6, lane = tid & 63, r32 = lane & 31, hi = lane >> 5;
  const bf16_t* GV = (const bf16_t*)(p.ws + OFF_GV); const bf16_t* U = (const bf16_t*)(p.ws + OFF_U); const bf16_t* ZA = (const bf16_t*)(p.ws + OFF_ZA);
  const bf16_t* WSB = (const bf16_t*)(p.ws + OFF_WSB); bf16_t* MIX = (bf16_t*)(p.ws + OFF_MIX);
  const int t0 = ci * 128;
  bf16_t* vnT = (bf16_t*)lds;
  {
    const int pos = tid >> 2, cp = tid & 3;
    const bf16_t* g = GV + (size_t)(t0 + pos) * 512;
    bf16x8 raw[16];
#pragma unroll
    for (int i = 0; i < 16; ++i) raw[i] = *reinterpret_cast<const bf16x8*>(g + (i * 4 + cp) * 8);
    float s = 0.f, q = 0.f;
#pragma unroll
    for (int i = 0; i < 16; ++i)
#pragma unroll
      for (int e = 0; e < 8; ++e) { const float xv = bf2f((bf16_t)raw[i][e]); s += xv; q += xv * xv; }
    s = xsum<1>(s); s = xsum<2>(s); q = xsum<1>(q); q = xsum<2>(q);
    const float mu = s * (1.f / 512.f);
    const float rstd = rsqrtf(fmaxf(q * (1.f / 512.f) - mu * mu, 0.f) + 1e-5f);
#pragma unroll
    for (int i = 0; i < 16; ++i) {
      const int c0 = (i * 4 + cp) * 8;
      const f32x4 w0 = *reinterpret_cast<const f32x4*>(p.a_ln_w + c0), w1 = *reinterpret_cast<const f32x4*>(p.a_ln_w + c0 + 4);
      const f32x4 b0 = *reinterpret_cast<const f32x4*>(p.a_ln_b + c0), b1 = *reinterpret_cast<const f32x4*>(p.a_ln_b + c0 + 4);
#pragma unroll
      for (int e = 0; e < 8; ++e) {
        const float wv = e < 4 ? w0[e & 3] : w1[e & 3], bv = e < 4 ? b0[e & 3] : b1[e & 3];
        vnT[(c0 + e) * 136 + pos] = f2bf((bf2f((bf16_t)raw[i][e]) - mu) * rstd * wv + bv);
      }
    }
  }
  __syncthreads();
  const int g8 = wid;
  const bf16_t* Wg = WSB + g8 * 128 * 128;
  f32x16 acc[4][2];
#pragma unroll
  for (int pb = 0; pb < 4; ++pb) {
#pragma unroll
    for (int r = 0; r < 16; ++r) { acc[pb][0][r] = 0.f; acc[pb][1][r] = 0.f; }
#pragma unroll
    for (int ks = 0; ks < 8; ++ks) {
      const bf16x8 bw = *reinterpret_cast<const bf16x8*>(Wg + (pb * 32 + r32) * 128 + ks * 16 + hi * 8);
#pragma unroll
      for (int db = 0; db < 2; ++db) {
        const bf16x8 a = *reinterpret_cast<const bf16x8*>(vnT + (g8 * 64 + db * 32 + r32) * 136 + ks * 16 + hi * 8);
        acc[pb][db] = __builtin_amdgcn_mfma_f32_32x32x16_bf16(a, bw, acc[pb][db], 0, 0, 0);
      }
    }
  }
  asm volatile("s_waitcnt lgkmcnt(0)" ::: "memory");
  char* stg = (char*)vnT + (size_t)g8 * 64 * 272;
#pragma unroll
  for (int pb = 0; pb < 4; ++pb) {
    const float bias = p.a_bs[g8 * 128 + pb * 32 + r32];
#pragma unroll
    for (int db = 0; db < 2; ++db)
#pragma unroll
      for (int rg = 0; rg < 4; ++rg) {
        u32x2 pk = {cvtpk(acc[pb][db][rg * 4 + 0] + bias, acc[pb][db][rg * 4 + 1] + bias), cvtpk(acc[pb][db][rg * 4 + 2] + bias, acc[pb][db][rg * 4 + 3] + bias)};
        *reinterpret_cast<u32x2*>(stg + (pb * 32 + r32) * 136 + (db * 32 + rg * 8 + hi * 4) * 2) = pk;
      }
  }
  asm volatile("s_waitcnt lgkmcnt(0)" ::: "memory");
#pragma unroll 4
  for (int i = 0; i < 16; ++i) {
    const int c = lane + 64 * i, row = c >> 3, ch = c & 7;
    const u32x2 s0 = *reinterpret_cast<const u32x2*>(stg + row * 136 + ch * 16), s1 = *reinterpret_cast<const u32x2*>(stg + row * 136 + ch * 16 + 8);
    const size_t gi = (size_t)(t0 + row) * 512 + g8 * 64 + ch * 8;
    const u32x4 uv = *reinterpret_cast<const u32x4*>(U + gi), zv = *reinterpret_cast<const u32x4*>(ZA + gi);
    const unsigned sv[4] = {s0[0], s0[1], s1[0], s1[1]};
    u32x4 ov;
#pragma unroll
    for (int e = 0; e < 4; ++e) ov[e] = cvtpk(bflo(uv[e]) * bflo(sv[e]) * bflo(zv[e]), bfhi(uv[e]) * bfhi(sv[e]) * bfhi(zv[e]));
    *reinterpret_cast<u32x4*>(MIX + (size_t)(t0 + row) * 1024 + g8 * 64 + ch * 8) = ov;
  }
  __syncthreads();
}

DEVI void tr_tile(int wv, const float* __restrict__ src, bf16_t* __restrict__ dst, int K, int N, int tilesN4, const float* __restrict__ scale, int t, char* lds) {
  const int tid = tidx(wv);
  const int k0 = (t / tilesN4) * 64, n0 = (t % tilesN4) * 256;
  const int kr = tid >> 3, ng = (tid & 7) * 8;
  f32x4 v0[4], v1[4];
#pragma unroll
  for (int u = 0; u < 4; ++u) {
    v0[u] = (f32x4){0.f, 0.f, 0.f, 0.f}; v1[u] = v0[u];
    if (n0 + u * 64 + ng < N) { const float* s = src + (size_t)(k0 + kr) * N + n0 + u * 64 + ng; v0[u] = *reinterpret_cast<const f32x4*>(s); v1[u] = *reinterpret_cast<const f32x4*>(s + 4); }
  }
  const float scv = scale ? scale[k0 + kr] : 1.f;
  bf16_t* tl = (bf16_t*)lds;
#pragma unroll
  for (int u = 0; u < 4; ++u)
#pragma unroll
    for (int e = 0; e < 4; ++e) { tl[u * 4608 + (ng + e) * 72 + kr] = f2bf(v0[u][e] * scv); tl[u * 4608 + (ng + 4 + e) * 72 + kr] = f2bf(v1[u][e] * scv); }
  __syncthreads();
  const int n = tid >> 3, kc = (tid & 7) * 8;
#pragma unroll
  for (int u = 0; u < 4; ++u)
    *reinterpret_cast<bf16x8*>(dst + (size_t)(n0 + u * 64 + n) * K + k0 + kc) = *reinterpret_cast<const bf16x8*>(tl + u * 4608 + n * 72 + kc);
}

DEVI void tr_item(int wv, const Params& p, int t, char* lds) {
  if (t < 224) tr_tile(wv, p.even_w_in, (bf16_t*)(p.ws + OFF_W0IN), 1024, 3584, 14, nullptr, t, lds);
  else if (t < 288) tr_tile(wv, p.even_w_out, (bf16_t*)(p.ws + OFF_W0OUT), 1024, 1024, 4, nullptr, t - 224, lds);
  else if (t < 384) tr_tile(wv, p.odd_w_in, (bf16_t*)(p.ws + OFF_W1IN), 1024, 1472, 6, nullptr, t - 288, lds);
  else if (t < 408) tr_tile(wv, p.c_wq_b, (bf16_t*)(p.ws + OFF_WQ), 256, 1536, 6, p.c_q_norm_w, t - 384, lds);
  else if (t < 424) tr_tile(wv, p.c_wkv_b, (bf16_t*)(p.ws + OFF_WKV), 128, 2048, 8, p.c_kv_norm_w, t - 408, lds);
  else tr_tile(wv, p.odd_w_out, (bf16_t*)(p.ws + OFF_W1OUT), 1024, 1024, 4, nullptr, t - 424, lds);
  __syncthreads();
}

DEVI void phase0(int wv, const Params& p, char* lds) {
  const int tid = tidx(wv);
  constexpr int N_ADA = 192, N_TR = 224, N_WS = 16;
  for (int it = blockIdx.x; it < N_ADA + N_TR + N_WS + 1; it += gridDim.x) {
    if (it < N_ADA) {
      const int li = it / 96, chunk = it % 96;
      float* sc = (float*)lds;
      for (int idx = tid; idx < 17 * 1024; idx += 512) { const int r = idx >> 10, k = idx & 1023; const float xv = r < 16 ? p.c[r * 1024 + k] : p.c_ctx[k]; sc[idx] = xv / (1.f + expf(-xv)); }
      __syncthreads();
      const int col = tid & 31, kp = tid >> 5;
      const float* w = p.ada_w + (size_t)li * 1024 * 3072 + chunk * 32 + col;
      float acc[17];
#pragma unroll
      for (int r = 0; r < 17; ++r) acc[r] = 0.f;
#pragma unroll 2
      for (int k = kp * 64; k < kp * 64 + 64; k += 4) {
        const float w0 = w[(size_t)k * 3072], w1 = w[(size_t)(k + 1) * 3072], w2 = w[(size_t)(k + 2) * 3072], w3 = w[(size_t)(k + 3) * 3072];
#pragma unroll
        for (int r = 0; r < 17; ++r) { const f32x4 s4 = *reinterpret_cast<const f32x4*>(sc + r * 1024 + k); acc[r] += s4[0] * w0 + s4[1] * w1 + s4[2] * w2 + s4[3] * w3; }
      }
      float* red = (float*)(lds + 17 * 1024 * 4);
#pragma unroll
      for (int r = 0; r < 17; ++r) red[(kp * 17 + r) * 32 + col] = acc[r];
      __syncthreads();
      float* ada = (float*)(p.ws + OFF_ADA);
      for (int idx = tid; idx < 544; idx += 512) {
        const int r = idx >> 5, cc = idx & 31; float s = 0.f;
        for (int k2 = 0; k2 < 16; ++k2) s += red[(k2 * 17 + r) * 32 + cc];
        ada[(size_t)(li * 17 + r) * 3072 + chunk * 32 + cc] = s + p.ada_b[li * 3072 + chunk * 32 + cc];
      }
    } else if (it < N_ADA + N_TR) {
      tr_tile(wv, p.even_w_in, (bf16_t*)(p.ws + OFF_W0IN), 1024, 3584, 14, nullptr, it - N_ADA, lds);
    } else if (it < N_ADA + N_TR + N_WS) {
      const int base = (it - N_ADA - N_TR) * 8192 + tid * 16;
      bf16_t* dst = (bf16_t*)(p.ws + OFF_WSB) + base; const float* s = p.a_ws + base;
#pragma unroll
      for (int q = 0; q < 2; ++q) {
        const f32x4 a = *reinterpret_cast<const f32x4*>(s + q * 8), b = *reinterpret_cast<const f32x4*>(s + q * 8 + 4);
        u32x4 w = {cvtpk(a[0], a[1]), cvtpk(a[2], a[3]), cvtpk(b[0], b[1]), cvtpk(b[2], b[3])};
        *reinterpret_cast<u32x4*>(dst + q * 8) = w;
      }
    } else {
      float2* tab = (float2*)(p.ws + OFF_ROPE);
      for (int e = tid; e < 1024; e += 512) {
        const int pos = e >> 4, j = e & 15;
        const float inv = exp2f(-(float)j * (13.287712379549449f / 16.f));
        const float ang = (float)pos * inv;
        const float nrev = rintf(ang * 0.15915494309189535f);
        float rr = fmaf(-nrev, 6.2831855f, ang); rr = fmaf(-nrev, -1.7484555e-7f, rr);
        tab[e] = make_float2(__cosf(rr), __sinf(rr));
      }
    }
    __syncthreads();
  }
}

template <bool RES>
DEVI void norm_mod(int wv, const float* src_lat, const float* src_ctx, const float* __restrict__ nw, const float* __restrict__ ada, bf16_t* X,
                   int row_lo, int row_hi, int vb, int nvb, const float* __restrict__ ada_prev = nullptr, float* hdst_lat = nullptr, float* hdst_ctx = nullptr) {
  const int tid_ = tidx(wv); const int wid = tid_ >> 6, lane = tid_ & 63;
  for (int row0 = row_lo + (vb * 8 + wid) * 2; row0 < row_hi; row0 += nvb * 16) {
    f32x4 v[2][4]; u32x2 ov[2][4]; float ss[2];
#pragma unroll
    for (int q = 0; q < 2; ++q) {
      const int row = row0 + q;
      const float* src = row < NLAT ? src_lat + (size_t)row * 1024 : src_ctx + (size_t)(row - NLAT) * 1024;
      ss[q] = 0.f;
#pragma unroll
      for (int i = 0; i < 4; ++i) {
        v[q][i] = __builtin_nontemporal_load(reinterpret_cast<const f32x4*>(src + i * 256 + lane * 4));
        if constexpr (RES) ov[q][i] = *reinterpret_cast<const u32x2*>(X + (size_t)row * 1024 + i * 256 + lane * 4);
      }
    }
    if constexpr (RES) {
#pragma unroll
      for (int q = 0; q < 2; ++q) {
        const int row = row0 + q;
        const float* gp = ada_prev + (row < NLAT ? (row >> 11) : 16) * 3072 + 2048;
        float* hd = row < NLAT ? hdst_lat + (size_t)row * 1024 : hdst_ctx + (size_t)(row - NLAT) * 1024;
#pragma unroll
        for (int i = 0; i < 4; ++i) {
          const int c = i * 256 + lane * 4;
          const f32x4 g = *reinterpret_cast<const f32x4*>(gp + c);
          v[q][i][0] += g[0] * bflo(ov[q][i][0]); v[q][i][1] += g[1] * bfhi(ov[q][i][0]); v[q][i][2] += g[2] * bflo(ov[q][i][1]); v[q][i][3] += g[3] * bfhi(ov[q][i][1]);
          __builtin_nontemporal_store(v[q][i], reinterpret_cast<f32x4*>(hd + c));
        }
      }
    }
#pragma unroll
    for (int q = 0; q < 2; ++q) {
#pragma unroll
      for (int i = 0; i < 4; ++i) ss[q] += v[q][i][0] * v[q][i][0] + v[q][i][1] * v[q][i][1] + v[q][i][2] * v[q][i][2] + v[q][i][3] * v[q][i][3];
      ss[q] = wave_sum(ss[q]);
    }
#pragma unroll
    for (int q = 0; q < 2; ++q) {
      const int row = row0 + q;
      const float* ad = ada + (row < NLAT ? (row >> 11) : 16) * 3072;
      const float r = rsqrtf(ss[q] * (1.f / 1024.f) + 1e-6f);
#pragma unroll
      for (int i = 0; i < 4; ++i) {
        const int c = i * 256 + lane * 4;
        const f32x4 w = *reinterpret_cast<const f32x4*>(nw + c), sh = *reinterpret_cast<const f32x4*>(ad + c), scl = *reinterpret_cast<const f32x4*>(ad + 1024 + c);
        float o[4];
#pragma unroll
        for (int e = 0; e < 4; ++e) o[e] = v[q][i][e] * r * w[e] * (1.f + scl[e]) + sh[e];
        u32x2 pk = {cvtpk(o[0], o[1]), cvtpk(o[2], o[3])};
        *reinterpret_cast<u32x2*>(X + (size_t)row * 1024 + c) = pk;
      }
    }
  }
}

DEVI void final_norm(int wv, float* out, const float* __restrict__ fw, const bf16_t* __restrict__ O1, const float* __restrict__ ada1) {
  const int tid_ = tidx(wv); const int wid = tid_ >> 6, lane = tid_ & 63;
  for (int row0 = (blockIdx.x * 8 + wid) * 2; row0 < NLAT; row0 += gridDim.x * 16) {
    f32x4 v[2][4]; u32x2 ov[2][4]; float ss[2];
#pragma unroll
    for (int q = 0; q < 2; ++q) {
      ss[q] = 0.f;
#pragma unroll
      for (int i = 0; i < 4; ++i) {
        v[q][i] = __builtin_nontemporal_load(reinterpret_cast<const f32x4*>(out + (size_t)(row0 + q) * 1024 + i * 256 + lane * 4));
        ov[q][i] = *reinterpret_cast<const u32x2*>(O1 + (size_t)(row0 + q) * 1024 + i * 256 + lane * 4);
      }
    }
#pragma unroll
    for (int q = 0; q < 2; ++q) {
      const float* gp = ada1 + ((row0 + q) >> 11) * 3072 + 2048;
#pragma unroll
      for (int i = 0; i < 4; ++i) {
        const f32x4 g = *reinterpret_cast<const f32x4*>(gp + i * 256 + lane * 4);
        v[q][i][0] += g[0] * bflo(ov[q][i][0]); v[q][i][1] += g[1] * bfhi(ov[q][i][0]); v[q][i][2] += g[2] * bflo(ov[q][i][1]); v[q][i][3] += g[3] * bfhi(ov[q][i][1]);
        ss[q] += v[q][i][0] * v[q][i][0] + v[q][i][1] * v[q][i][1] + v[q][i][2] * v[q][i][2] + v[q][i][3] * v[q][i][3];
      }
      ss[q] = wave_sum(ss[q]);
    }
#pragma unroll
    for (int q = 0; q < 2; ++q) {
      const float r = rsqrtf(ss[q] * (1.f / 1024.f) + 1e-6f);
#pragma unroll
      for (int i = 0; i < 4; ++i) {
        const int c = i * 256 + lane * 4;
        const f32x4 w = *reinterpret_cast<const f32x4*>(fw + c);
        __builtin_nontemporal_store(v[q][i] * r * w, reinterpret_cast<f32x4*>(out + (size_t)(row0 + q) * 1024 + c));
      }
    }
  }
}

typedef const __attribute__((address_space(4))) Params* KArgP;
DEVI void run_phase(int wv, KArgP pp, int ph, char* lds) {
#if defined(__HIP_DEVICE_COMPILE__)
  asm volatile("" : "+s"(pp));
  char* ws = pp->ws;
  const float2* rope = (const float2*)(ws + OFF_ROPE);
  const float* ada0 = (const float*)(ws + OFF_ADA); const float* ada1 = ada0 + 17 * 3072;
  bf16_t* X = (bf16_t*)(ws + OFF_X); bf16_t* MIX = (bf16_t*)(ws + OFF_MIX);
  const int G = gridDim.x, B = blockIdx.x;
  PG8_LAS unsigned char* ldsp = (PG8_LAS unsigned char*)lds;
  switch (ph) {
    case 0: { const Params p = *pp; phase0(wv, p, lds); } break;
    case 1: norm_mod<false>(wv, pp->x, pp->ctx, pp->norm_w, ada0, X, 0, NTOK, B, G); break;
    case 2: {
      EpiL0In epi{(bf16_t*)(ws + OFF_U), (bf16_t*)(ws + OFF_GV), (bf16_t*)(ws + OFF_ZA), (bf16_t*)(ws + OFF_ZB), (bf16_t*)(ws + OFF_Q0), (bf16_t*)(ws + OFF_K0), (bf16_t*)(ws + OFF_V0), rope};
      gemm_phase(wv, ldsp, X, (const bf16_t*)(ws + OFF_W0IN), 1024, Sched{14, 144 * 14, 144 * 14, 0, 0}, epi);
    } break;
    case 3: { const Params p = *pp;
      for (int it = B; it < 1024 + 288 + 128; it += G) {
        if (it < 1024) {
          const int xcd = it & 7, slot = (it >> 3) & 31, rd = it >> 8;
          const int bh = rd * 16 + xcd * 2 + (slot >> 4), qb = slot & 15, b = bh >> 2, h = bh & 3;
          attn0_item(wv, p, b * 2048 + qb * 128, b, h, KVL, lds);
        } else if (it < 1024 + 288) abranch_item(wv, p, it - 1024, lds);
        else { const int i2 = it - 1312; const int b = i2 >> 3, h = (i2 >> 1) & 3, qb = i2 & 1; attn0_item(wv, p, NLAT + b * 256 + qb * 128, b, h, 256, lds); }
      }
      {
        const int nb = G >= 192 ? 96 : G, base = G - nb;
        if (B >= base) for (int t = 224 + (B - base); t < 288; t += nb) tr_item(wv, p, t, lds);
      }
    } break;
    case 4: {
      EpiPlain epi{X};
      gemm_phase(wv, ldsp, MIX, (const bf16_t*)(ws + OFF_W0OUT), 1024, Sched{4, 144 * 4, 144 * 4, 0, 0}, epi);
      {
        const Params p = *pp; const int nb = G > 64 ? G - 64 : G, base = G - nb;
        if (B >= base) for (int t = 288 + (B - base); t < 488; t += nb) tr_item(wv, p, t, lds);
      }
    } break;
    case 5: {
      if (B >= G - 16) {
        const int cp = B - (G - 16);
        norm_mod<true>(wv, pp->x, pp->ctx, pp->norm_w + 1024, ada1, X, NLAT + cp * 256, NLAT + cp * 256 + 256, 0, 1, ada0, pp->out, (float*)(ws + OFF_H1C));
        asm volatile("s_waitcnt vmcnt(0)" ::: "memory"); __syncthreads();
        EpiL1In epi{(bf16_t*)(ws + OFF_CQ), (bf16_t*)(ws + OFF_CKV), (bf16_t*)(ws + OFF_KR), (bf16_t*)(ws + OFF_Z1), (float*)(ws + OFF_RQ), (float*)(ws + OFF_RKV), rope, (float*)(lds + LDS_SS)};
        gemm_phase(wv, ldsp, X, (const bf16_t*)(ws + OFF_W1IN), 1024, Sched{6, 0, 16, 128, 1, G - 16}, epi);
      } else norm_mod<true>(wv, pp->x, pp->ctx, pp->norm_w + 1024, ada1, X, 0, NLAT, B, G - 16, ada0, pp->out, (float*)(ws + OFF_H1C));
    } break;
    case 6: {
      EpiL1In epi{(bf16_t*)(ws + OFF_CQ), (bf16_t*)(ws + OFF_CKV), (bf16_t*)(ws + OFF_KR), (bf16_t*)(ws + OFF_Z1), (float*)(ws + OFF_RQ), (float*)(ws + OFF_RKV), rope, (float*)(lds + LDS_SS)};
      gemm_phase(wv, ldsp, X, (const bf16_t*)(ws + OFF_W1IN), 1024, Sched{6, 768, 768, 128, 1}, epi);
    } break;
    case 7: {
      EpiQ eq{(bf16_t*)(ws + OFF_Q1), (const float*)(ws + OFF_RQ), rope};
      EpiKV ek{(bf16_t*)(ws + OFF_K1), (bf16_t*)(ws + OFF_V1), (const float*)(ws + OFF_RKV)};
      gemm_phase(wv, ldsp, (const bf16_t*)(ws + OFF_CQ), (const bf16_t*)(ws + OFF_WQ), 256, Sched{6, 768, 768, 0, 0}, eq);
      gemm_phase(wv, ldsp, (const bf16_t*)(ws + OFF_CKV), (const bf16_t*)(ws + OFF_WKV), 128, Sched{8, 1152, 1152, 0, 0}, ek);
    } break;
    case 8: { const Params p = *pp;
      for (int it = B; it < 1024; it += G) {
        const int xcd = it & 7, slot = (it >> 3) & 31, rd = it >> 8;
        const int bh = rd * 32 + xcd * 4 + (slot >> 3), qb = slot & 7;
        attn1_item(wv, p, bh >> 3, bh & 7, qb, lds);
      }
    } break;
    case 9: {
      EpiPlain epi{X};
      gemm_phase(wv, ldsp, MIX, (const bf16_t*)(ws + OFF_W1OUT), 1024, Sched{4, 128 * 4, 128 * 4, 0, 0}, epi);
    } break;
    case 10: final_norm(wv, pp->out, pp->final_w, X, ada1); break;
  }
#endif
}


#define XB_TMO      128
#define XB_XCNT(j)  (256  + 64 * (j))
#define XB_XSUB(j)  (1280 + 64 * (j))
#define XB_XGEN(j)  (2304 + 64 * (j))
#define XB_TOP      3328
#define XB_TOPGEN   3392
#define XCD_BAR_WORDS 3456
#define XB_SPIN_CAP (1u << 18)
#define LAS __attribute__((address_space(3)))
DEVI unsigned xb_ld(unsigned* p) { return __hip_atomic_load(p, __ATOMIC_RELAXED, __HIP_MEMORY_SCOPE_AGENT); }
DEVI unsigned xb_add(unsigned* p, unsigned v) { return __hip_atomic_fetch_add(p, v, __ATOMIC_RELAXED, __HIP_MEMORY_SCOPE_AGENT); }
DEVI unsigned xb_xcc_id() { return (unsigned)__builtin_amdgcn_s_getreg((3 << 11) | 20) & 0xFu; }
#define XB_SPIN(cond, bar) do { unsigned _sp = 0; while (cond) { __builtin_amdgcn_s_sleep(1); \
    if ((++_sp & 255u) == 0u) { if (xb_ld(&(bar)[XB_TMO])) break; if (_sp > XB_SPIN_CAP) { atomicAdd(&(bar)[XB_TMO], 1u); break; } } } } while (0)
struct XcdBarrier { unsigned* bar; unsigned x; volatile LAS unsigned* st; };
DEVI XcdBarrier xcd_barrier_post(int wv, unsigned* bar, volatile LAS unsigned* st) {
  XcdBarrier b; b.bar = bar; b.x = xb_xcc_id(); b.st = st;
  if (tidx(wv) == 0) (void)xb_add(&bar[XB_XCNT(b.x)], 1u);
  return b;
}
DEVI void xcd_barrier_complete(unsigned* bar, unsigned x, unsigned& nloc, unsigned& nx) {
  const unsigned G = gridDim.x * gridDim.y * gridDim.z;
  unsigned sum, cnt, mine, sp = 0u;
  for (;;) {
    sum = 0u; cnt = 0u; mine = 0u;
#pragma unroll
    for (unsigned j = 0; j < 16; ++j) { const unsigned c = xb_ld(&bar[XB_XCNT(j)]); sum += c; cnt += (c > 0u) ? 1u : 0u; mine = (j == x) ? c : mine; }
    if (sum == G) break;
    __builtin_amdgcn_s_sleep(1);
    if ((++sp & 255u) == 0u) { if (xb_ld(&bar[XB_TMO])) break; if (sp > XB_SPIN_CAP) { atomicAdd(&bar[XB_TMO], 1u); break; } }
  }
  nloc = mine > 0u ? mine : 1u; nx = cnt > 0u ? cnt : 1u;
}
DEVI void xcd_barrier(int wv, const XcdBarrier& b) {
  asm volatile("s_waitcnt vmcnt(0)" ::: "memory");
  __syncthreads();
  if (tidx(wv) == 0) {
    unsigned* bar = b.bar;
    __builtin_amdgcn_s_waitcnt(0);
    unsigned nloc = b.st[0], nx = b.st[1];
    if (nloc == 0u) { xcd_barrier_complete(bar, b.x, nloc, nx); b.st[0] = nloc; b.st[1] = nx; }
    const unsigned old = xb_add(&bar[XB_XSUB(b.x)], 1u);
    const unsigned gen = old / nloc;
    if (old + 1u == (gen + 1u) * nloc) {
      __builtin_amdgcn_fence(__ATOMIC_RELEASE, "agent");
      asm volatile("s_waitcnt vmcnt(0)" ::: "memory");
      const unsigned og = xb_add(&bar[XB_TOP], 1u);
      const unsigned tg = og / nx;
      if (og + 1u == (tg + 1u) * nx) xb_add(&bar[XB_TOPGEN], 1u);
      else XB_SPIN(xb_ld(&bar[XB_TOPGEN]) == tg, bar);
      __builtin_amdgcn_fence(__ATOMIC_ACQUIRE, "agent");
      xb_add(&bar[XB_XGEN(b.x)], 1u);
      asm volatile("s_waitcnt vmcnt(0)" ::: "memory");
    } else {
      XB_SPIN(xb_ld(&bar[XB_XGEN(b.x)]) == gen, bar);
      __builtin_amdgcn_fence(__ATOMIC_ACQUIRE, "agent");
      asm volatile("s_waitcnt vmcnt(0)" ::: "memory");
    }
  }
  __syncthreads();
}

extern __shared__ __attribute__((aligned(16))) char g_lds[];

constexpr int LDS_XB = 143360;
__global__ void __launch_bounds__(512) mega(Params p) {
  cg::grid_group grid = cg::this_grid();
  if (p.ph_hi > 64) grid.sync();
  const int wv = __builtin_amdgcn_readfirstlane((int)threadIdx.x >> 6);
  volatile LAS unsigned* xst = (volatile LAS unsigned*)(g_lds + LDS_XB);
  if (tidx(wv) == 0) { xst[0] = 0u; xst[1] = 0u; }
  __syncthreads();
  (void)xcd_barrier_post(wv, (unsigned*)(p.ws + OFF_BAR), xst);
#define GRID_BARRIER() do { KArgP _pp = (KArgP)__builtin_amdgcn_kernarg_segment_ptr(); asm volatile("" : "+s"(_pp)); \
    XcdBarrier _xb; _xb.bar = (unsigned*)(_pp->ws + OFF_BAR); _xb.x = xb_xcc_id(); _xb.st = (volatile LAS unsigned*)(g_lds + LDS_XB); xcd_barrier(wv, _xb); } while (0)
  for (int ph = p.ph_lo; ph < p.ph_hi; ++ph) {
    run_phase(wv, (KArgP)__builtin_amdgcn_kernarg_segment_ptr(), ph, g_lds);
#ifdef PROBE_PH
    if (ph == PROBE_PH) { GRID_BARRIER(); run_phase(wv, (KArgP)__builtin_amdgcn_kernarg_segment_ptr(), ph, g_lds); }
#endif
    if (ph + 1 < p.ph_hi) GRID_BARRIER();
  }
}

extern "C" void kernel_launch(void* const* d_in, const int* in_sizes, int n_in, void* d_out, int out_size, void* d_ws, size_t ws_size, hipStream_t stream) {
  static int ok = 0;
  static int grid_blocks = 0;
  if (!ok) {
    if (n_in != 25 || ws_size < WS_NEED) { fprintf(stderr, "kernel_launch: bad args n_in %d ws %zu need %zu\n", n_in, ws_size, (size_t)WS_NEED); return; }
    if (hipFuncSetAttribute((const void*)mega, hipFuncAttributeMaxDynamicSharedMemorySize, LDS_BYTES) != hipSuccess) { fprintf(stderr, "kernel_launch: LDS attr failed\n"); return; }
    int dev = 0, cus = 0, per_cu = 0;
    hipGetDevice(&dev);
    hipDeviceGetAttribute(&cus, hipDeviceAttributeMultiprocessorCount, dev);
    hipOccupancyMaxActiveBlocksPerMultiprocessor(&per_cu, mega, 512, LDS_BYTES);
    if (per_cu < 1) per_cu = 1;
    grid_blocks = cus * per_cu;
    ok = 1;
  }
  Params p{};
  const float** pp = (const float**)&p;
  for (int i = 0; i < 25; ++i) pp[i] = (const float*)d_in[i];
  p.out = (float*)d_out; p.ws = (char*)d_ws;
#if ONE_LAUNCH
  p.ph_lo = 0; p.ph_hi = 11;
  hipMemsetAsync((char*)d_ws + OFF_BAR, 0, XCD_BAR_WORDS * 4, stream);
  void* args[] = {&p};
  hipError_t e = hipLaunchCooperativeKernel((const void*)mega, dim3(grid_blocks), dim3(512), args, LDS_BYTES, stream);
  if (e != hipSuccess) fprintf(stderr, "cooperative launch failed: %s (grid %d)\n", hipGetErrorString(e), grid_blocks);
#else
  for (int ph = 0; ph < 11; ++ph) {
    p.ph_lo = ph; p.ph_hi = ph + 1;
    hipLaunchKernelGGL(mega, dim3(grid_blocks), dim3(512), LDS_BYTES, stream, p);
  }
#endif
}
```

```cpp
#include <hip/hip_runtime.h>
#include <hip/hip_cooperative_groups.h>
#include <cstdio>
namespace cg = cooperative_groups;

#ifndef ATT_SD0
#define ATT_SD0 2
#endif
#ifndef ONE_LAUNCH
#define ONE_LAUNCH 1
#endif

typedef unsigned short bf16_t;
typedef short bf16x8 __attribute__((ext_vector_type(8)));
typedef short s16x4 __attribute__((ext_vector_type(4)));
typedef float f32x16 __attribute__((ext_vector_type(16)));
typedef float f32x4 __attribute__((ext_vector_type(4)));
typedef unsigned u32x4 __attribute__((ext_vector_type(4)));
typedef unsigned u32x2 __attribute__((ext_vector_type(2)));
#define DEVI __device__ __forceinline__
#define SBAR() __builtin_amdgcn_sched_barrier(0)
DEVI int tidx(int wv) { int l; asm volatile("v_mbcnt_lo_u32_b32 %0, -1, 0\n\tv_mbcnt_hi_u32_b32 %0, -1, %0" : "=v"(l)); return (wv << 6) | l; }

constexpr int NLAT = 32768, NCTX = 4096, NTOK = 36864, KVL = 2304;
constexpr int LDS_BYTES = 147456, LDS_SS = 139264;

constexpr size_t OFF_W0IN = 0;
constexpr size_t OFF_W0OUT = OFF_W0IN + 3584ull * 1024 * 2;
constexpr size_t OFF_W1IN = OFF_W0OUT + 1024ull * 1024 * 2;
constexpr size_t OFF_WQ = OFF_W1IN + 1536ull * 1024 * 2;
constexpr size_t OFF_WKV = OFF_WQ + 1536ull * 256 * 2;
constexpr size_t OFF_W1OUT = OFF_WKV + 2048ull * 128 * 2;
constexpr size_t OFF_WSB = OFF_W1OUT + 1024ull * 1024 * 2;
constexpr size_t OFF_ADA = OFF_WSB + 8ull * 128 * 128 * 2;
constexpr size_t OFF_ROPE = OFF_ADA + 2ull * 17 * 3072 * 4;
constexpr size_t OFF_BAR = OFF_ROPE + 64ull * 16 * 8;
constexpr size_t OFF_H1C = OFF_BAR + 16384;
constexpr size_t OFF_RQ = OFF_H1C + 4096ull * 1024 * 4;
constexpr size_t OFF_RKV = OFF_RQ + 32768ull * 4;
constexpr size_t OFF_X = OFF_RKV + 36864ull * 4;
constexpr size_t OFF_MIX = OFF_X + 36864ull * 1024 * 2;
constexpr size_t OFF_T = OFF_MIX + 36864ull * 1024 * 2;
constexpr size_t SZ_HALF = 36864ull * 512 * 2;
constexpr size_t OFF_U = OFF_T, OFF_GV = OFF_U + SZ_HALF, OFF_ZA = OFF_GV + SZ_HALF, OFF_ZB = OFF_ZA + SZ_HALF, OFF_Q0 = OFF_ZB + SZ_HALF;
constexpr size_t OFF_K0 = OFF_Q0 + SZ_HALF, OFF_V0 = OFF_K0 + 16ull * 4 * KVL * 128 * 2, END_L0 = OFF_V0 + 16ull * 4 * KVL * 128 * 2;
constexpr size_t OFF_CQ = OFF_T, OFF_CKV = OFF_CQ + 32768ull * 256 * 2, OFF_Z1 = OFF_CKV + 36864ull * 128 * 2;
constexpr size_t OFF_Q1 = OFF_Z1 + 32768ull * 1024 * 2, OFF_K1 = OFF_Q1 + 32768ull * 1536 * 2, OFF_KR = OFF_K1 + 16ull * 8 * KVL * 192 * 2, END_L1 = OFF_KR + 16ull * KVL * 192 * 2;
constexpr size_t OFF_V1 = OFF_X;
constexpr size_t WS_NEED = END_L1 > END_L0 ? END_L1 : END_L0;

struct Params {
  const float *x, *c, *ctx, *c_ctx, *norm_w, *ada_w, *ada_b, *even_w_in, *a_ws, *a_bs, *a_ln_w, *a_ln_b,
      *b_lq1, *b_lk1, *b_lq2, *b_lk2, *b_subln_w, *even_w_out, *odd_w_in, *c_q_norm_w, *c_wq_b,
      *c_kv_norm_w, *c_wkv_b, *odd_w_out, *final_w;
  float* out; char* ws; int ph_lo, ph_hi;
};

DEVI unsigned cvtpk(float lo, float hi) { unsigned r; asm("v_cvt_pk_bf16_f32 %0, %1, %2" : "=v"(r) : "v"(lo), "v"(hi)); return r; }
DEVI bf16_t f2bf(float v) { return (bf16_t)(cvtpk(v, 0.f) & 0xffffu); }
DEVI float bf2f(bf16_t v) { return __uint_as_float(((unsigned)v) << 16); }
DEVI float bflo(unsigned w) { return __uint_as_float(w << 16); }
DEVI float bfhi(unsigned w) { return __uint_as_float(w & 0xffff0000u); }
DEVI int crow(int r, int hi) { return (r & 3) + 8 * (r >> 2) + 4 * hi; }
DEVI float silu_f(float x) { return x * __builtin_amdgcn_rcpf(1.f + __builtin_amdgcn_exp2f(x * -1.4426950408889634f)); }
DEVI float gelu_f(float v) {
  const float t = __builtin_amdgcn_rcpf(fmaf(fabsf(v), 0.2316418882f, 1.0f));
  float q = fmaf(t, 0.5307027145f, -0.7265760135f); q = fmaf(q, t, 0.7107068705f); q = fmaf(q, t, -0.142248368f); q = fmaf(q, t, 0.127414796f); q *= t;
  const float m = v * (q * __builtin_amdgcn_exp2f(v * v * -0.72134752044f));
  return v < 0.f ? m : v - m;
}

template <int M> DEVI float xsum(float v) {
  if constexpr (M == 32) { auto rr = __builtin_amdgcn_permlane32_swap(__float_as_uint(v), __float_as_uint(v), false, false); return __uint_as_float(rr[0]) + __uint_as_float(rr[1]); }
  else return v + __int_as_float(__builtin_amdgcn_ds_swizzle(__float_as_int(v), (M << 10) | 0x1f));
}
DEVI float wave_sum(float v) { v = xsum<1>(v); v = xsum<2>(v); v = xsum<4>(v); v = xsum<8>(v); v = xsum<16>(v); return xsum<32>(v); }

DEVI void rope_tile(f32x16& v, const float2* __restrict__ tab, int pos, int hi) {
#pragma unroll
  for (int r = 0; r < 8; ++r) {
    const int jf = (r & 3) + 8 * (r >> 2) + 4 * hi;
    const float2 cs = tab[pos * 16 + jf];
    const float a = v[r], b = v[r + 8];
    v[r] = a * cs.x - b * cs.y; v[r + 8] = b * cs.x + a * cs.y;
  }
}
DEVI void store4(bf16_t* dst, const f32x16& v, int rg) {
  u32x2 pk = {cvtpk(v[rg * 4 + 0], v[rg * 4 + 1]), cvtpk(v[rg * 4 + 2], v[rg * 4 + 3])};
  *reinterpret_cast<u32x2*>(dst) = pk;
}

#define PG8_LAS __attribute__((address_space(3)))
constexpr int HTB = 128 * 64 * 2;
DEVI int lds_byte(int r, int c) { const int st = (r >> 4) * 2 + (c >> 5), rr = r & 15, cc = c & 31, ob = rr * 64 + cc * 2; return st * 1024 + (ob ^ (((ob >> 9) & 1) << 5)); }
DEVI void stage_rc(int b, int& R, int& C) { const int st = b / 1024, sb = b % 1024, swz = sb ^ (((sb >> 9) & 1) << 5); R = (st >> 1) * 16 + swz / 64; C = (st & 1) * 32 + (swz % 64) / 2; }
DEVI int perm32(int rho) { const int n = rho >> 4, i = rho & 15; return 8 * (i >> 2) + 4 * n + (i & 3); }
struct Unit { int pm, pn; };
struct Sched {
  int nN, nmain, ntotal, xpm0, xpn, boff = 0;
  DEVI bool next(int i, Unit& u) const {
    const int it = (int)blockIdx.x - boff + i * (int)gridDim.x; if (it < 0 || it >= ntotal) return false;
    if (it < nmain) {
      const int xcd = it & 7, jx = it >> 3, nMl = nmain / nN / 8, nig = 8 * nN, gid = jx / nig, fm = gid * 8, gsz = (nMl - fm) < 8 ? (nMl - fm) : 8, r = jx % nig;
      u.pm = (fm + r % gsz) * 8 + xcd; u.pn = r / gsz;
    } else { u.pm = xpm0 + (it - nmain); u.pn = xpn; }
    return true;
  }
};
template <class Epi>
DEVI void gemm_phase(int wv, PG8_LAS unsigned char* lds, const bf16_t* gA, const bf16_t* gBt, const int K, const Sched& S, const Epi& E) {
  const int tid = tidx(wv), wid = __builtin_amdgcn_readfirstlane(tid >> 6), lane = tid & 63, wr = wid >> 2, wc = wid & 3, fr = lane & 15, fq = lane >> 4;
  const int nt = K / 64;
  unsigned voffA[2], voffB[2];
#pragma unroll
  for (int i = 0; i < 2; ++i) { int R, C; stage_rc(tid * 16 + i * 8192, R, C); const int Rb = (R & ~31) + perm32(R & 31); voffA[i] = (unsigned)(R * K + C) * 2u; voffB[i] = (unsigned)(Rb * K + C) * 2u; }
  const size_t kstep = (size_t)(64 * 2);
  const size_t hstep = (size_t)128 * K * 2;
  const size_t tstep = 2 * hstep;
  const unsigned ldsw = (unsigned)wid * 1024u;
  const int aoff = lds_byte(wr * 64 + fr, fq * 8), boff = lds_byte(wc * 32 + fr, fq * 8);
#define PG8_SA(b, h) (((b) * 2 + (h)) * HTB)
#define PG8_SB(b, h) ((4 + (b) * 2 + (h)) * HTB)
#define PG8_STAGE(bufoff, gbase, voff) do { _Pragma("unroll") for (int _i = 0; _i < 2; ++_i) \
    __builtin_amdgcn_global_load_lds((const unsigned*)((const char*)(gbase) + (voff)[_i]), (PG8_LAS unsigned*)(lds + (bufoff) + ldsw + _i * 8192), 16, 0, 0); } while (0)
#define PG8_LDA(dst, b, h) do { _Pragma("unroll") for (int m = 0; m < 4; ++m) _Pragma("unroll") for (int k = 0; k < 2; ++k) dst[m][k] = *(const PG8_LAS bf16x8*)(lds + PG8_SA(b, h) + aoff + m * 2048 + k * 1024); } while (0)
#define PG8_LDB(dst, b, h) do { _Pragma("unroll") for (int n = 0; n < 2; ++n) _Pragma("unroll") for (int k = 0; k < 2; ++k) dst[n][k] = *(const PG8_LAS bf16x8*)(lds + PG8_SB(b, h) + boff + n * 2048 + k * 1024); } while (0)
#define PG8_MMA(ai, bj, At, Bt) do { __builtin_amdgcn_s_setprio(1); _Pragma("unroll") for (int m = 0; m < 4; ++m) _Pragma("unroll") for (int n = 0; n < 2; ++n) _Pragma("unroll") for (int k = 0; k < 2; ++k) \
    acc[ai][bj][m][n] = __builtin_amdgcn_mfma_f32_16x16x32_bf16(Bt[n][k], At[m][k], acc[ai][bj][m][n], 0, 0, 0); __builtin_amdgcn_s_setprio(0); } while (0)
#define PG8_WAIT_V(n) asm volatile("s_waitcnt vmcnt(" #n ")" ::: "memory")
#define PG8_WAIT_L(n) asm volatile("s_waitcnt lgkmcnt(" #n ")" ::: "memory")
#define PG8_BAR __builtin_amdgcn_s_barrier()
#define PG8_SCHED __builtin_amdgcn_sched_barrier(0)
  Unit cur, nxt; int ui = 0;
  if (!S.next(0, cur)) return;
  f32x4 acc[2][2][4][2];
#pragma unroll
  for (int a = 0; a < 2; ++a)
#pragma unroll
    for (int b = 0; b < 2; ++b)
#pragma unroll
      for (int m = 0; m < 4; ++m)
#pragma unroll
        for (int n = 0; n < 2; ++n) acc[a][b][m][n] = (f32x4){0.f, 0.f, 0.f, 0.f};
  bf16x8 At[4][2], B0[2][2], B1[2][2];
  const char* cA = (const char*)gA + (size_t)cur.pm * tstep; const char* cB = (const char*)gBt + (size_t)cur.pn * tstep;
  PG8_STAGE(PG8_SB(0, 0), cB, voffB); PG8_STAGE(PG8_SA(0, 0), cA, voffA); PG8_STAGE(PG8_SB(0, 1), cB + hstep, voffB); PG8_STAGE(PG8_SA(0, 1), cA + hstep, voffA);
  if (wr == 1) PG8_BAR;
  PG8_WAIT_V(4); PG8_BAR;
  PG8_STAGE(PG8_SB(1, 0), cB + kstep, voffB); PG8_STAGE(PG8_SA(1, 0), cA + kstep, voffA); PG8_STAGE(PG8_SB(1, 1), cB + hstep + kstep, voffB);
  PG8_WAIT_V(6); PG8_BAR;
  for (;;) {
    const bool has_next = S.next(ui + 1, nxt);
    const char* nA = has_next ? (const char*)gA + (size_t)nxt.pm * tstep : cA; const char* nB = has_next ? (const char*)gBt + (size_t)nxt.pn * tstep : cB;
#pragma unroll 1
    for (int t = 0; t < nt; t += 2) {
      const bool last = (t == nt - 2);
      const char* a1 = cA + (size_t)(t + 1) * kstep;
      const char* a2 = last ? nA : cA + (size_t)(t + 2) * kstep; const char* b2 = last ? nB : cB + (size_t)(t + 2) * kstep;
      const char* a3 = a2 + kstep; const char* b3 = b2 + kstep;
      PG8_LDB(B0, 0, 0); PG8_SCHED; PG8_LDA(At, 0, 0); PG8_STAGE(PG8_SA(1, 1), a1 + hstep, voffA);
      PG8_WAIT_L(8); PG8_BAR; PG8_WAIT_L(0); PG8_MMA(0, 0, At, B0); PG8_BAR; PG8_SCHED;
      PG8_LDB(B1, 0, 1); PG8_STAGE(PG8_SB(0, 0), b2, voffB);
      PG8_BAR; PG8_WAIT_L(0); PG8_MMA(0, 1, At, B1); PG8_BAR;
      PG8_LDA(At, 0, 1); PG8_STAGE(PG8_SA(0, 0), a2, voffA);
      PG8_BAR; PG8_WAIT_L(0); PG8_MMA(1, 0, At, B0); PG8_BAR; PG8_SCHED;
      PG8_STAGE(PG8_SB(0, 1), b2 + hstep, voffB);
      PG8_WAIT_V(6); PG8_BAR; PG8_MMA(1, 1, At, B1); PG8_BAR;
      PG8_LDB(B0, 1, 0); PG8_SCHED; PG8_LDA(At, 1, 0); PG8_STAGE(PG8_SA(0, 1), a2 + hstep, voffA);
      PG8_WAIT_L(8); PG8_BAR; PG8_WAIT_L(0); PG8_MMA(0, 0, At, B0); PG8_BAR; PG8_SCHED;
      PG8_LDB(B1, 1, 1); PG8_STAGE(PG8_SB(1, 0), b3, voffB);
      PG8_BAR; PG8_WAIT_L(0); PG8_MMA(0, 1, At, B1); PG8_BAR;
      PG8_LDA(At, 1, 1); PG8_STAGE(PG8_SA(1, 0), a3, voffA);
      PG8_BAR; PG8_WAIT_L(0); PG8_MMA(1, 0, At, B0); PG8_BAR; PG8_SCHED;
      PG8_STAGE(PG8_SB(1, 1), b3 + hstep, voffB);
      PG8_WAIT_V(6); PG8_BAR; PG8_MMA(1, 1, At, B1); PG8_BAR;
    }
    E(acc, cur, wr, wc, fr, fq);
    if (!has_next) break;
#pragma unroll
    for (int a = 0; a < 2; ++a)
#pragma unroll
      for (int b = 0; b < 2; ++b)
#pragma unroll
        for (int m = 0; m < 4; ++m)
#pragma unroll
          for (int n = 0; n < 2; ++n) acc[a][b][m][n] = (f32x4){0.f, 0.f, 0.f, 0.f};
    cur = nxt; cA = nA; cB = nB; ++ui;
  }
  PG8_WAIT_V(0);
  if (wr == 0) PG8_BAR;
  PG8_BAR;
#undef PG8_SA
#undef PG8_SB
#undef PG8_STAGE
#undef PG8_LDA
#undef PG8_LDB
#undef PG8_MMA
#undef PG8_WAIT_V
#undef PG8_WAIT_L
#undef PG8_BAR
#undef PG8_SCHED
}

typedef f32x4 acc_t[2][2][4][2];
DEVI void token_info(int token, bool ctx, int& b, int& s, int& key) {
  if (!ctx) { b = token >> 11; s = token & 2047; key = 256 + s; } else { const int tc = token - NLAT; b = tc >> 8; s = 0; key = tc & 255; }
}
DEVI float swap32_partner(float v, bool upper) {
  auto rr = __builtin_amdgcn_permlane32_swap(__float_as_uint(v), __float_as_uint(v), false, false);
  return __uint_as_float(upper ? rr[0] : rr[1]);
}
DEVI void rope_pair(f32x4& v0, f32x4& v1, const float2* __restrict__ tab, int pos, int fq) {
  const bool upper = fq >= 2;
  const float2* t = tab + pos * 16 + (fq & 1) * 8;
  const f32x4 t0 = *reinterpret_cast<const f32x4*>(t), t1 = *reinterpret_cast<const f32x4*>(t + 2), t2 = *reinterpret_cast<const f32x4*>(t + 4), t3 = *reinterpret_cast<const f32x4*>(t + 6);
  const float cs[8] = {t0[0], t0[2], t1[0], t1[2], t2[0], t2[2], t3[0], t3[2]}, sn[8] = {t0[1], t0[3], t1[1], t1[3], t2[1], t2[3], t3[1], t3[3]};
#pragma unroll
  for (int e = 0; e < 4; ++e) {
    const float p0 = swap32_partner(v0[e], upper), p1 = swap32_partner(v1[e], upper);
    const float s0 = upper ? sn[e] : -sn[e], s1 = upper ? sn[4 + e] : -sn[4 + e];
    v0[e] = v0[e] * cs[e] + p0 * s0; v1[e] = v1[e] * cs[4 + e] + p1 * s1;
  }
}
DEVI void st8(bf16_t* dst, const f32x4& v0, const f32x4& v1) { u32x4 pk = {cvtpk(v0[0], v0[1]), cvtpk(v0[2], v0[3]), cvtpk(v1[0], v1[1]), cvtpk(v1[2], v1[3])}; *reinterpret_cast<u32x4*>(dst) = pk; }

struct EpiL0In {
  bf16_t *U, *GV, *ZA, *ZB, *Q0, *K0, *V0; const float2* rope;
  DEVI void operator()(acc_t& acc, const Unit& u, int wr, int wc, int fr, int fq) const {
    const int col0 = u.pn * 256, type = col0 >> 9; const bool ctx = u.pm >= 128;
#pragma unroll
    for (int ai = 0; ai < 2; ++ai)
#pragma unroll
      for (int m = 0; m < 4; ++m) {
        const int token = u.pm * 256 + ai * 128 + wr * 64 + m * 16 + fr;
        int b, s, key; token_info(token, ctx, b, s, key);
#pragma unroll
        for (int bj = 0; bj < 2; ++bj) {
          const int nl = (col0 & 511) + bj * 128 + wc * 32;
          f32x4 v0 = acc[ai][bj][m][0], v1 = acc[ai][bj][m][1];
          bf16_t* dst;
          if (type <= 1) {
#pragma unroll
            for (int e = 0; e < 4; ++e) { v0[e] = gelu_f(v0[e]); v1[e] = gelu_f(v1[e]); }
            dst = (type == 0 ? U : GV) + (size_t)token * 512 + nl;
          } else if (type == 2 || type == 6) {
#pragma unroll
            for (int e = 0; e < 4; ++e) { v0[e] = silu_f(v0[e]); v1[e] = silu_f(v1[e]); }
            dst = (type == 2 ? ZA : ZB) + (size_t)token * 512 + nl;
          } else if (type == 3) {
            if (!ctx) rope_pair(v0, v1, rope, (wc & 1) ? (s & 63) : (s >> 6), fq);
            dst = Q0 + (size_t)token * 512 + nl;
          } else if (type == 4) {
            if (!ctx) rope_pair(v0, v1, rope, (wc & 1) ? (s & 63) : (s >> 6), fq);
            dst = K0 + ((size_t)(b * 4 + (nl >> 7)) * KVL + key) * 128 + (nl & 127);
          } else {
            dst = V0 + ((size_t)(b * 4 + (nl >> 7)) * KVL + key) * 128 + (nl & 127);
          }
          st8(dst + fq * 8, v0, v1);
        }
      }
  }
};

template <bool HASCTX> struct EpiOut {
  const float* src_lat; const float* src_ctx; float* dst_lat; float* dst_ctx; const float* ada;
  DEVI void operator()(acc_t& acc, const Unit& u, int wr, int wc, int fr, int fq) const {
    const int col0 = u.pn * 256;
#pragma unroll
    for (int ai = 0; ai < 2; ++ai)
#pragma unroll
      for (int m = 0; m < 4; ++m) {
        const int token = u.pm * 256 + ai * 128 + wr * 64 + m * 16 + fr;
        const float* src; float* dst; const float* gate;
        if (!HASCTX || token < NLAT) { src = src_lat + (size_t)token * 1024; dst = dst_lat + (size_t)token * 1024; gate = ada + (token >> 11) * 3072 + 2048; }
        else { const int tc = token - NLAT; src = src_ctx + (size_t)tc * 1024; dst = dst_ctx + (size_t)tc * 1024; gate = ada + 16 * 3072 + 2048; }
#pragma unroll
        for (int bj = 0; bj < 2; ++bj)
#pragma unroll
          for (int n = 0; n < 2; ++n) {
            const int c = col0 + bj * 128 + wc * 32 + fq * 8 + n * 4;
            const f32x4 xv = *reinterpret_cast<const f32x4*>(src + c), g = *reinterpret_cast<const f32x4*>(gate + c);
            *reinterpret_cast<f32x4*>(dst + c) = xv + g * acc[ai][bj][m][n];
          }
      }
  }
};

struct EpiPlain {
  bf16_t* O;
  DEVI void operator()(acc_t& acc, const Unit& u, int wr, int wc, int fr, int fq) const {
    const int col0 = u.pn * 256;
#pragma unroll
    for (int ai = 0; ai < 2; ++ai)
#pragma unroll
      for (int m = 0; m < 4; ++m) {
        const int token = u.pm * 256 + ai * 128 + wr * 64 + m * 16 + fr;
#pragma unroll
        for (int bj = 0; bj < 2; ++bj) st8(O + (size_t)token * 1024 + col0 + bj * 128 + wc * 32 + fq * 8, acc[ai][bj][m][0], acc[ai][bj][m][1]);
      }
  }
};

struct EpiL1In {
  bf16_t *CQ, *CKV, *K1, *Z1; float *RQ, *RKV; const float2* rope; float* ssb;
  DEVI void operator()(acc_t& acc, const Unit& u, int wr, int wc, int fr, int fq) const {
    const int col0 = u.pn * 256; const bool ctx = u.pm >= 128;
    float ss[2][4];
#pragma unroll
    for (int ai = 0; ai < 2; ++ai)
#pragma unroll
      for (int m = 0; m < 4; ++m) {
        ss[ai][m] = 0.f;
        const int token = u.pm * 256 + ai * 128 + wr * 64 + m * 16 + fr;
        int b, s, key; token_info(token, ctx, b, s, key);
#pragma unroll
        for (int bj = 0; bj < 2; ++bj) {
          const int nb = col0 + bj * 128 + wc * 32;
          f32x4 v0 = acc[ai][bj][m][0], v1 = acc[ai][bj][m][1];
          if (nb < 384) {
#pragma unroll
            for (int e = 0; e < 4; ++e) ss[ai][m] += v0[e] * v0[e] + v1[e] * v1[e];
            bf16_t* dst = nb < 256 ? CQ + (size_t)token * 256 + nb : CKV + (size_t)token * 128 + (nb - 256);
            st8(dst + fq * 8, v0, v1);
          } else if (nb < 448) {
            if (!ctx) rope_pair(v0, v1, rope, (nb >= 416) ? (s & 63) : (s >> 6), fq);
            { bf16_t* dst = K1   + ((size_t)b * KVL + key) * 192 + 128 + (nb - 384);
              st8(dst + fq * 8, v0, v1); }
          } else if (nb < 1472) {
            if (!ctx) {
#pragma unroll
              for (int e = 0; e < 4; ++e) { v0[e] = silu_f(v0[e]); v1[e] = silu_f(v1[e]); }
              bf16_t* dst = Z1 + (size_t)token * 1024 + (nb - 448);
              st8(dst + fq * 8, v0, v1);
            }
          }
        }
      }
    if (u.pn <= 1) {
#pragma unroll
      for (int ai = 0; ai < 2; ++ai)
#pragma unroll
        for (int m = 0; m < 4; ++m) {
          float sv = ss[ai][m]; sv = xsum<16>(sv); sv = xsum<32>(sv);
          if (fq == 0) ssb[wc * 256 + ai * 128 + wr * 64 + m * 16 + fr] = sv;
        }
      asm volatile("s_waitcnt lgkmcnt(0)" ::: "memory"); __builtin_amdgcn_s_barrier(); asm volatile("" ::: "memory");
      const int lt = wc * 64 + fq * 16 + fr;
      if (lt < 128) {
        const int row = (lt >> 6) * 128 + wr * 64 + (lt & 63);
        if (u.pn == 0) { const float tot = (ssb[row] + ssb[256 + row]) + (ssb[512 + row] + ssb[768 + row]); RQ[u.pm * 256 + row] = rsqrtf(tot * (1.f / 256.f) + 1e-6f); }
        else { const float tot = (ssb[row] + ssb[256 + row]) + (ssb[512 + row] + ssb[768 + row]); RKV[u.pm * 256 + row] = rsqrtf(tot * (1.f / 128.f) + 1e-6f); }
      }
    }
  }
};

struct EpiQ {
  bf16_t* Q1; const float* RQ; const float2* rope;
  DEVI void operator()(acc_t& acc, const Unit& u, int wr, int wc, int fr, int fq) const {
    const int col0 = u.pn * 256;
#pragma unroll
    for (int ai = 0; ai < 2; ++ai)
#pragma unroll
      for (int m = 0; m < 4; ++m) {
        const int token = u.pm * 256 + ai * 128 + wr * 64 + m * 16 + fr; const int s = token & 2047; const float rq = RQ[token];
#pragma unroll
        for (int bj = 0; bj < 2; ++bj) {
          const int n0 = col0 + bj * 128 + wc * 32; const int dd0 = n0 % 192;
          f32x4 v0 = acc[ai][bj][m][0] * rq, v1 = acc[ai][bj][m][1] * rq;
          if (dd0 >= 128) rope_pair(v0, v1, rope, (dd0 >= 160) ? (s & 63) : (s >> 6), fq);
          bf16_t* dst = Q1 + (size_t)token * 1536 + n0;
          st8(dst + fq * 8, v0, v1);
        }
      }
  }
};

struct EpiKV {
  bf16_t *K1, *V1; const float* RKV;
  DEVI void operator()(acc_t& acc, const Unit& u, int wr, int wc, int fr, int fq) const {
    const int col0 = u.pn * 256; const bool ctx = u.pm >= 128;
#pragma unroll
    for (int ai = 0; ai < 2; ++ai)
#pragma unroll
      for (int m = 0; m < 4; ++m) {
        const int token = u.pm * 256 + ai * 128 + wr * 64 + m * 16 + fr; const float rk = RKV[token];
        int b, s, key; token_info(token, ctx, b, s, key);
#pragma unroll
        for (int bj = 0; bj < 2; ++bj) {
          const int nb = col0 + bj * 128 + wc * 32; const int h = nb >> 8, dd = nb & 255;
          const f32x4 v0 = acc[ai][bj][m][0] * rk, v1 = acc[ai][bj][m][1] * rk;
          bf16_t* dst = dd < 128 ? K1 + ((size_t)(b * 8 + h) * KVL + key) * 192 + dd : V1 + ((size_t)(b * 8 + h) * KVL + key) * 128 + (dd - 128);
          st8(dst + fq * 8, v0, v1);
        }
      }
  }
};

template <int SCID> struct ScaleOf { static constexpr float v = SCID == 0 ? 0.125f : 0.07216878364870322f; };
constexpr float THR = 8.f;
template <int KW> DEVI int kswz(int row, int colB) { return row * (KW * 2 + 16) + colB; }
DEVI int v_st(int k, int c) { const int kk = (k & ~0xC) | ((k & 4) << 1) | ((k & 8) >> 1); return ((kk >> 3) * 4 + (c >> 5)) * 512 + ((kk & 7) * 32 + (c & 31)) * 2; }
DEVI int v_rd_base(int lane) { return ((lane & 3) << 3) | (((lane >> 2) & 3) << 6) | (((lane >> 4) & 1) << 5) | (((lane >> 5) & 1) << 8); }
constexpr int v_rd_off(int d0, int ks, int half) { return d0 * 512 + ks * 4096 + half * 2048; }
template <int OFF> DEVI s16x4 tr_read(int vb) { s16x4 r; asm volatile("ds_read_b64_tr_b16 %0, %1 offset:%2" : "=&v"(r) : "v"(vb), "i"(OFF) : "memory"); return r; }

template <int SCID>
DEVI void partialSM(f32x16& p0, f32x16& p1, float& m_reg, float& mn, float& alpha) {
  constexpr float SC = ScaleOf<SCID>::v; constexpr float C = SC * 1.4426950408889634f;
  float pmax = p0[0];
#pragma unroll
  for (int r = 1; r < 16; ++r) pmax = fmaxf(pmax, p0[r]);
#pragma unroll
  for (int r = 0; r < 16; ++r) pmax = fmaxf(pmax, p1[r]);
  { auto rr = __builtin_amdgcn_permlane32_swap(__float_as_uint(pmax), __float_as_uint(pmax), false, false);
    pmax = fmaxf(__uint_as_float(rr[0]), __uint_as_float(rr[1])); }
  if (__builtin_expect(__all(pmax - m_reg <= THR / SC), 1)) { mn = m_reg; alpha = 1.f; }
  else { mn = fmaxf(m_reg, pmax); alpha = __builtin_amdgcn_exp2f((m_reg - mn) * C); m_reg = mn; }
  const float mnC = -mn * C;
#pragma unroll
  for (int r = 0; r < 16; ++r) p0[r] = fmaf(p0[r], C, mnC);
#pragma unroll
  for (int r = 0; r < 16; ++r) p1[r] = fmaf(p1[r], C, mnC);
#pragma unroll
  for (int r = 0; r < 16; ++r) p0[r] = __builtin_amdgcn_exp2f(p0[r]);
}
DEVI void finishSM(f32x16& p0, f32x16& p1, float alpha, float& l_reg, bf16x8& pa0, bf16x8& pa1, bf16x8& pa2, bf16x8& pa3) {
#pragma unroll
  for (int r = 0; r < 16; ++r) p1[r] = __builtin_amdgcn_exp2f(p1[r]);
  float ps = 0;
#pragma unroll
  for (int r = 0; r < 16; ++r) ps += p0[r];
#pragma unroll
  for (int r = 0; r < 16; ++r) ps += p1[r];
  { auto rr = __builtin_amdgcn_permlane32_swap(__float_as_uint(ps), __float_as_uint(ps), false, false);
    ps = __uint_as_float(rr[0]) + __uint_as_float(rr[1]); }
  l_reg = l_reg * alpha + ps;
#define PK4(P, BASE, OUT) do { unsigned a0 = cvtpk(P[BASE + 0], P[BASE + 1]), a1 = cvtpk(P[BASE + 2], P[BASE + 3]); \
    unsigned b0 = cvtpk(P[BASE + 4], P[BASE + 5]), b1 = cvtpk(P[BASE + 6], P[BASE + 7]); \
    auto r0 = __builtin_amdgcn_permlane32_swap(a0, b0, false, false); auto r1 = __builtin_amdgcn_permlane32_swap(a1, b1, false, false); \
    u32x4 w = {r0[0], r1[0], r0[1], r1[1]}; OUT = *reinterpret_cast<bf16x8*>(&w); } while (0)
  PK4(p0, 0, pa0); PK4(p0, 8, pa1); PK4(p1, 0, pa2); PK4(p1, 8, pa3);
#undef PK4
}
template <int OFF> DEVI bf16x8 lds_rd128(int a) { bf16x8 r; asm volatile("ds_read_b128 %0, %1 offset:%2" : "=&v"(r) : "v"(a), "i"(OFF) : "memory"); return r; }
template <int N> DEVI void wait_lgkm() { asm volatile("s_waitcnt lgkmcnt(%0)" :: "n"(N) : "memory"); }
template <int NQ, int QL> constexpr bool q_is_lds(int s) { return QL > 0 && s >= NQ - QL && s < NQ; }
template <int NQ, int QL, int PF> constexpr int q_after(int d) {
  int n = q_is_lds<NQ, QL>(d + 1) ? 1 : 0;
  if (q_is_lds<NQ, QL>(d)) n += (d + PF < NQ ? 2 : 0);
  else for (int i = 1; i <= PF; ++i) n += (d + i < NQ ? 2 : 0);
  return n;
}
template <int KW, int NQ, int QL, int PF, int D0>
DEVI void qkt_step(f32x16& p0, f32x16& p1, int ka, const bf16x8* qr, int qa, bf16x8 (&kf)[PF + 1][2], bf16x8 (&qf)[2]) {
  if constexpr (D0 < NQ) {
    constexpr int ROW32 = 32 * (KW * 2 + 16);
    if constexpr (D0 + PF < NQ) { kf[(D0 + PF) % (PF + 1)][0] = lds_rd128<(D0 + PF) * 32>(ka); kf[(D0 + PF) % (PF + 1)][1] = lds_rd128<ROW32 + (D0 + PF) * 32>(ka); }
    if constexpr (q_is_lds<NQ, QL>(D0 + 1)) qf[(D0 + 1) & 1] = lds_rd128<(D0 + 1 - (NQ - QL)) * 32>(qa);
    wait_lgkm<q_after<NQ, QL, PF>(D0)>(); SBAR();
    bf16x8 q;
    if constexpr (q_is_lds<NQ, QL>(D0)) q = qf[D0 & 1]; else q = qr[D0];
    p0 = __builtin_amdgcn_mfma_f32_32x32x16_bf16(kf[D0 % (PF + 1)][0], q, p0, 0, 0, 0);
    p1 = __builtin_amdgcn_mfma_f32_32x32x16_bf16(kf[D0 % (PF + 1)][1], q, p1, 0, 0, 0);
    qkt_step<KW, NQ, QL, PF, D0 + 1>(p0, p1, ka, qr, qa, kf, qf);
  }
}
template <int KW, int NQ, int QL = 0>
DEVI void qkt(f32x16& p0, f32x16& p1, const char* Ks, const bf16x8* qr, int kcol0, int r32, int hi, const char* ql = nullptr) {
  constexpr int PF = QL > 0 ? 2 : 3;
#pragma unroll
  for (int r = 0; r < 16; ++r) { p0[r] = 0.f; p1[r] = 0.f; }
  const int ka = (int)(uintptr_t)(Ks + kswz<KW>(r32, (kcol0 + hi * 8) * 2)), qa = (int)(uintptr_t)ql;
  constexpr int ROW32 = 32 * (KW * 2 + 16);
  static_assert(NQ >= PF && (QL == 0 || NQ - QL >= PF), "prologue issues steps 0..PF-1 from register-q steps");
  bf16x8 kf[PF + 1][2], qf[2];
  asm volatile("s_waitcnt lgkmcnt(0)" ::: "memory");
  kf[0][0] = lds_rd128<0>(ka); kf[0][1] = lds_rd128<ROW32>(ka);
  kf[1][0] = lds_rd128<32>(ka); kf[1][1] = lds_rd128<ROW32 + 32>(ka);
  if constexpr (PF >= 3) { kf[2][0] = lds_rd128<64>(ka); kf[2][1] = lds_rd128<ROW32 + 64>(ka); }
  qkt_step<KW, NQ, QL, PF, 0>(p0, p1, ka, qr, qa, kf, qf);
}
template <int D0> DEVI void pv_one(f32x16& od, int vb, bf16x8 pa0, bf16x8 pa1, bf16x8 pa2, bf16x8 pa3) {
  const s16x4 l0 = tr_read<v_rd_off(D0, 0, 0)>(vb), h0 = tr_read<v_rd_off(D0, 0, 1)>(vb), l1 = tr_read<v_rd_off(D0, 1, 0)>(vb), h1 = tr_read<v_rd_off(D0, 1, 1)>(vb);
  const s16x4 l2 = tr_read<v_rd_off(D0, 2, 0)>(vb), h2 = tr_read<v_rd_off(D0, 2, 1)>(vb), l3 = tr_read<v_rd_off(D0, 3, 0)>(vb), h3 = tr_read<v_rd_off(D0, 3, 1)>(vb);
  asm volatile("s_waitcnt lgkmcnt(0)" ::: "memory"); SBAR();
#define PK(L, H) (bf16x8){L[0], L[1], L[2], L[3], H[0], H[1], H[2], H[3]}
  od = __builtin_amdgcn_mfma_f32_32x32x16_bf16(pa0, PK(l0, h0), od, 0, 0, 0);
  od = __builtin_amdgcn_mfma_f32_32x32x16_bf16(pa1, PK(l1, h1), od, 0, 0, 0);
  od = __builtin_amdgcn_mfma_f32_32x32x16_bf16(pa2, PK(l2, h2), od, 0, 0, 0);
  od = __builtin_amdgcn_mfma_f32_32x32x16_bf16(pa3, PK(l3, h3), od, 0, 0, 0);
#undef PK
}
template <int D0> DEVI void v_load(int vb, s16x4 (&f)[8]) {
  f[0] = tr_read<v_rd_off(D0, 0, 0)>(vb); f[1] = tr_read<v_rd_off(D0, 0, 1)>(vb); f[2] = tr_read<v_rd_off(D0, 1, 0)>(vb); f[3] = tr_read<v_rd_off(D0, 1, 1)>(vb);
  f[4] = tr_read<v_rd_off(D0, 2, 0)>(vb); f[5] = tr_read<v_rd_off(D0, 2, 1)>(vb); f[6] = tr_read<v_rd_off(D0, 3, 0)>(vb); f[7] = tr_read<v_rd_off(D0, 3, 1)>(vb);
}
DEVI void pv_mma(f32x16& od, const s16x4 (&f)[8], bf16x8 pa0, bf16x8 pa1, bf16x8 pa2, bf16x8 pa3) {
#define PK(L, H) (bf16x8){L[0], L[1], L[2], L[3], H[0], H[1], H[2], H[3]}
  od = __builtin_amdgcn_mfma_f32_32x32x16_bf16(pa0, PK(f[0], f[1]), od, 0, 0, 0);
  od = __builtin_amdgcn_mfma_f32_32x32x16_bf16(pa1, PK(f[2], f[3]), od, 0, 0, 0);
  od = __builtin_amdgcn_mfma_f32_32x32x16_bf16(pa2, PK(f[4], f[5]), od, 0, 0, 0);
  od = __builtin_amdgcn_mfma_f32_32x32x16_bf16(pa3, PK(f[6], f[7]), od, 0, 0, 0);
#undef PK
}
DEVI void pv_d0(f32x16* o, int vb, bf16x8 pa0, bf16x8 pa1, bf16x8 pa2, bf16x8 pa3) {
  s16x4 fa[8], fb[8];
  v_load<0>(vb, fa);
  v_load<1>(vb, fb); asm volatile("s_waitcnt lgkmcnt(8)" ::: "memory"); SBAR(); pv_mma(o[0], fa, pa0, pa1, pa2, pa3); SBAR();
  v_load<2>(vb, fa); asm volatile("s_waitcnt lgkmcnt(8)" ::: "memory"); SBAR(); pv_mma(o[1], fb, pa0, pa1, pa2, pa3); SBAR();
  v_load<3>(vb, fb); asm volatile("s_waitcnt lgkmcnt(8)" ::: "memory"); SBAR(); pv_mma(o[2], fa, pa0, pa1, pa2, pa3); SBAR();
  asm volatile("s_waitcnt lgkmcnt(0)" ::: "memory"); SBAR(); pv_mma(o[3], fb, pa0, pa1, pa2, pa3);
}

template <int KW, int NQ, int SCID>
DEVI void attn_core(int wv, const bf16_t* __restrict__ Qw, const bf16_t* __restrict__ Kh, const bf16_t* __restrict__ Vh, int kcol0, int NT, char* lds,
                    f32x16 (&o)[4], float& l_out) {
  constexpr int SHM_V = 64 * 128 * 2, SHM_K = 64 * (KW * 2 + 16), KC = KW / 64;
  const int tid = tidx(wv), wid = tid >> 6, lane = tid & 63, r32 = lane & 31, hi = lane >> 5;
  char* V_lds = lds; char* K_lds = lds + 2 * SHM_V;
  float* al_l = (float*)(lds + 2 * SHM_V + 2 * SHM_K) + wid * 64 + 32;
  float m_reg = -1e30f, l_reg = 0;
#pragma unroll
  for (int d = 0; d < 4; ++d)
#pragma unroll
    for (int r = 0; r < 16; ++r) o[d][r] = 0.f;
  bf16x8 qr[NQ];
#pragma unroll
  for (int d0 = 0; d0 < NQ; ++d0) qr[d0] = *reinterpret_cast<const bf16x8*>(Qw + d0 * 16);
  const int sr = tid >> 4, sc = (tid & 15) * 8, vst0 = v_st(sr, sc), vst1 = v_st(32 + sr, sc);
  const int krow = tid >> 3, kch = tid & 7;
  const bf16_t* vg = Vh + sr * 128 + sc;
  const bf16_t* kg = Kh + krow * KW + kch * 8;
  const int vb0 = (int)(uintptr_t)V_lds + v_rd_base(lane);
  bf16x8 vs0, vs1, ks[KC];
#define SLOAD(k0) do { vs0 = *reinterpret_cast<const bf16x8*>(vg + (size_t)(k0) * 128); vs1 = *reinterpret_cast<const bf16x8*>(vg + (size_t)((k0) + 32) * 128); \
    _Pragma("unroll") for (int _c = 0; _c < KC; ++_c) ks[_c] = *reinterpret_cast<const bf16x8*>(kg + (size_t)(k0) * KW + _c * 64); } while (0)
#define SWRITE(b) do { *reinterpret_cast<bf16x8*>(V_lds + (b) * SHM_V + vst0) = vs0; *reinterpret_cast<bf16x8*>(V_lds + (b) * SHM_V + vst1) = vs1; \
    _Pragma("unroll") for (int _c = 0; _c < KC; ++_c) *reinterpret_cast<bf16x8*>(K_lds + (b) * SHM_K + kswz<KW>(krow, (kch + 8 * _c) * 16)) = ks[_c]; } while (0)
  SLOAD(0); SWRITE(0);
  if (NT > 1) SLOAD(64);
  __syncthreads();
  for (int j = 0; j < NT; ++j) {
    const int bsel = j & 1;
    f32x16 p0, p1; float mn, alpha; bf16x8 pa0, pa1, pa2, pa3;
    qkt<KW, NQ>(p0, p1, K_lds + bsel * SHM_K, qr, kcol0, r32, hi);
    partialSM<SCID>(p0, p1, m_reg, mn, alpha);
    if (__any(alpha < 1.f)) {
      if (hi == 0) al_l[r32] = alpha;
      asm volatile("s_waitcnt lgkmcnt(0)" ::: "memory");
#pragma unroll
      for (int d = 0; d < 4; ++d)
#pragma unroll
        for (int r = 0; r < 16; ++r) o[d][r] *= al_l[crow(r, hi)];
    }
    finishSM(p0, p1, alpha, l_reg, pa0, pa1, pa2, pa3);
    pv_d0(o, vb0 + bsel * SHM_V, pa0, pa1, pa2, pa3);
    if (j + 1 < NT) { SWRITE(bsel ^ 1); if (j + 2 < NT) SLOAD((j + 2) * 64); }
    __syncthreads();
  }
  l_out = l_reg;
#undef SLOAD
#undef SWRITE
}

template <int KW, int NQ, int SDEPTH, int SCID, int QL>
DEVI void attn_core_pipe(int wv, const bf16_t* __restrict__ Qw, const bf16_t* __restrict__ Kh, const bf16_t* __restrict__ Vh, int kcol0, int NT, char* lds,
                         f32x16 (&o)[4], float& l_out) {
  constexpr int SHM_V = 64 * 128 * 2, SHM_K = 64 * (KW * 2 + 16), KC = KW / 64;
  const int tid = tidx(wv), wid = tid >> 6, lane = tid & 63, r32 = lane & 31, hi = lane >> 5;
  char* V_lds = lds; char* K_lds = lds + 2 * SHM_V;
  float* al_l = (float*)(lds + 2 * SHM_V + 2 * SHM_K) + wid * 64 + 32;
  float m_reg = -1e30f, l_reg = 0;
#pragma unroll
  for (int d = 0; d < 4; ++d)
#pragma unroll
    for (int r = 0; r < 16; ++r) o[d][r] = 0.f;
  bf16x8 qr[NQ - QL + (QL ? 1 : 0)];
#pragma unroll
  for (int d0 = 0; d0 < NQ - QL; ++d0) qr[d0] = *reinterpret_cast<const bf16x8*>(Qw + d0 * 16);
  char* ql = lds + 2 * SHM_V + 2 * SHM_K + 2048 + (wid * 32 + r32) * 144 + hi * 16;
  if constexpr (QL > 0) {
#pragma unroll
    for (int d0 = NQ - QL; d0 < NQ; ++d0) *reinterpret_cast<bf16x8*>(ql + (d0 - (NQ - QL)) * 32) = *reinterpret_cast<const bf16x8*>(Qw + d0 * 16);
  }
  const int sr = tid >> 4, sc = (tid & 15) * 8, vst0 = v_st(sr, sc), vst1 = v_st(32 + sr, sc);
  const int krow = tid >> 3, kch = tid & 7;
  const bf16_t* vg = Vh + sr * 128 + sc;
  const bf16_t* kg = Kh + krow * KW + kch * 8;
  const int vb0 = (int)(uintptr_t)V_lds + v_rd_base(lane);
  struct { bf16x8 vs0, vs1, ks[KC]; } sr_[SDEPTH];
#define SLOAD(i, k0) do { sr_[i].vs0 = *reinterpret_cast<const bf16x8*>(vg + (size_t)(k0) * 128); sr_[i].vs1 = *reinterpret_cast<const bf16x8*>(vg + (size_t)((k0) + 32) * 128); \
    _Pragma("unroll") for (int _c = 0; _c < KC; ++_c) sr_[i].ks[_c] = *reinterpret_cast<const bf16x8*>(kg + (size_t)(k0) * KW + _c * 64); } while (0)
#define SWRITE(b, i) do { *reinterpret_cast<bf16x8*>(V_lds + (b) * SHM_V + vst0) = sr_[i].vs0; *reinterpret_cast<bf16x8*>(V_lds + (b) * SHM_V + vst1) = sr_[i].vs1; \
    _Pragma("unroll") for (int _c = 0; _c < KC; ++_c) *reinterpret_cast<bf16x8*>(K_lds + (b) * SHM_K + kswz<KW>(krow, (kch + 8 * _c) * 16)) = sr_[i].ks[_c]; } while (0)
#define SWAIT() do { if constexpr (SDEPTH == 2) asm volatile("s_waitcnt vmcnt(4)" ::: "memory"); else asm volatile("s_waitcnt vmcnt(0)" ::: "memory"); } while (0)
#define RESC(a) do { if (__any((a) < 1.f)) { if (hi == 0) al_l[r32] = (a); asm volatile("s_waitcnt lgkmcnt(0)" ::: "memory"); \
    _Pragma("unroll") for (int _d = 0; _d < 4; ++_d) _Pragma("unroll") for (int _r = 0; _r < 16; ++_r) o[_d][_r] *= al_l[crow(_r, hi)]; } } while (0)
  f32x16 pA0, pA1, pB0, pB1; float mnA, mnB, alA, alB; bf16x8 pa0, pa1, pa2, pa3;
  constexpr int SE = 0, SO = SDEPTH - 1;
  SLOAD(SE, 0); asm volatile("s_waitcnt vmcnt(0)" ::: "memory"); SWRITE(0, SE); __syncthreads();
  qkt<KW, NQ, QL>(pA0, pA1, K_lds, qr, kcol0, r32, hi, ql); partialSM<SCID>(pA0, pA1, m_reg, mnA, alA);
  SLOAD(SO, 64); if constexpr (SDEPTH == 2) { if (2 < NT) SLOAD(SE, 128); }
  SWAIT(); SWRITE(1, SO); __syncthreads();
  for (int j = 1; j + 1 < NT; j += 2) {
    SBAR(); qkt<KW, NQ, QL>(pB0, pB1, K_lds + SHM_K, qr, kcol0, r32, hi, ql);
    finishSM(pA0, pA1, alA, l_reg, pa0, pa1, pa2, pa3); SBAR();
    SLOAD(SO, (j + SDEPTH) * 64); SBAR();
    pv_d0(o, vb0, pa0, pa1, pa2, pa3); partialSM<SCID>(pB0, pB1, m_reg, mnB, alB);
    __syncthreads(); SWAIT(); SWRITE(0, SE);
    RESC(alB); __syncthreads();
    SBAR(); qkt<KW, NQ, QL>(pA0, pA1, K_lds, qr, kcol0, r32, hi, ql);
    finishSM(pB0, pB1, alB, l_reg, pa0, pa1, pa2, pa3); SBAR();
    if (SDEPTH == 1 || j + 3 < NT) SLOAD(SE, (j + 1 + SDEPTH) * 64);
    SBAR();
    pv_d0(o, vb0 + SHM_V, pa0, pa1, pa2, pa3); partialSM<SCID>(pA0, pA1, m_reg, mnA, alA);
    __syncthreads(); SWAIT(); SWRITE(1, SO);
    RESC(alA); __syncthreads();
  }
  SBAR(); qkt<KW, NQ, QL>(pB0, pB1, K_lds + SHM_K, qr, kcol0, r32, hi, ql);
  finishSM(pA0, pA1, alA, l_reg, pa0, pa1, pa2, pa3); SBAR();
  pv_d0(o, vb0, pa0, pa1, pa2, pa3); partialSM<SCID>(pB0, pB1, m_reg, mnB, alB);
  __syncthreads(); RESC(alB);
  finishSM(pB0, pB1, alB, l_reg, pa0, pa1, pa2, pa3); SBAR();
  pv_d0(o, vb0 + SHM_V, pa0, pa1, pa2, pa3);
  __syncthreads();
  l_out = l_reg;
#undef SLOAD
#undef SWRITE
#undef SWAIT
#undef RESC
}

template <int KW, int NQ, int SCID, int QL>
DEVI void attn_core_dma(int wv, const bf16_t* __restrict__ Qw, const bf16_t* __restrict__ Kh, const bf16_t* __restrict__ Vh, int kcol0, int NT, char* lds,
                        f32x16 (&o)[4], float& l_out) {
  constexpr int SHM_V = 64 * 128 * 2, KCH = KW / 8 + 1, SHM_K = 64 * KCH * 16, KR = (64 * KCH) / 512;
  static_assert(64 * KCH - KR * 512 == 64, "remainder must be one wave");
  const int tid = tidx(wv), wid = tid >> 6, lane = tid & 63, r32 = lane & 31, hi = lane >> 5;
  char* V_lds = lds; char* K_lds = lds + 2 * SHM_V;
  float* al_l = (float*)(lds + 2 * SHM_V + 2 * SHM_K) + wid * 64 + 32;
  float m_reg = -1e30f, l_reg = 0;
#pragma unroll
  for (int d = 0; d < 4; ++d)
#pragma unroll
    for (int r = 0; r < 16; ++r) o[d][r] = 0.f;
  bf16x8 qr[NQ - QL + (QL ? 1 : 0)];
#pragma unroll
  for (int d0 = 0; d0 < NQ - QL; ++d0) qr[d0] = *reinterpret_cast<const bf16x8*>(Qw + d0 * 16);
  char* ql = lds + 2 * SHM_V + 2 * SHM_K + 2048 + (wid * 32 + r32) * 144 + hi * 16;
  if constexpr (QL > 0) {
#pragma unroll
    for (int d0 = NQ - QL; d0 < NQ; ++d0) *reinterpret_cast<bf16x8*>(ql + (d0 - (NQ - QL)) * 32) = *reinterpret_cast<const bf16x8*>(Qw + d0 * 16);
  }
  const int sr = tid >> 4, sc = (tid & 15) * 8, vst0 = v_st(sr, sc), vst1 = v_st(32 + sr, sc);
  const bf16_t* vg = Vh + sr * 128 + sc;
  const int vb0 = (int)(uintptr_t)V_lds + v_rd_base(lane);
  unsigned koff[KR + 1];
#pragma unroll
  for (int i = 0; i <= KR; ++i) { const int c = tid + 512 * i; const int row = c / KCH; int ch = c - row * KCH; ch = ch == KCH - 1 ? KCH - 2 : ch; koff[i] = (unsigned)(row * KW + ch * 8) * 2u; }
  const unsigned kldsw = (unsigned)__builtin_amdgcn_readfirstlane(wid) * 1024u;
  bf16x8 vs0, vs1;
#define KDMA(k0, b) do { const char* _g = (const char*)(Kh + (size_t)(k0) * KW); PG8_LAS unsigned char* _l = (PG8_LAS unsigned char*)(K_lds + (b) * SHM_K) + kldsw; \
    _Pragma("unroll") for (int _i = 0; _i < KR; ++_i) __builtin_amdgcn_global_load_lds((const unsigned*)(_g + koff[_i]), (PG8_LAS unsigned*)(_l + _i * 8192), 16, 0, 0); \
    if (wid == 0) __builtin_amdgcn_global_load_lds((const unsigned*)(_g + koff[KR]), (PG8_LAS unsigned*)(_l + KR * 8192), 16, 0, 0); } while (0)
#define VLOAD(k0) do { vs0 = *reinterpret_cast<const bf16x8*>(vg + (size_t)(k0) * 128); vs1 = *reinterpret_cast<const bf16x8*>(vg + (size_t)((k0) + 32) * 128); } while (0)
#define VWRITE(b) do { *reinterpret_cast<bf16x8*>(V_lds + (b) * SHM_V + vst0) = vs0; *reinterpret_cast<bf16x8*>(V_lds + (b) * SHM_V + vst1) = vs1; } while (0)
#define VMW() asm volatile("s_waitcnt vmcnt(0)" ::: "memory")
#define RESC(a) do { if (__any((a) < 1.f)) { if (hi == 0) al_l[r32] = (a); asm volatile("s_waitcnt lgkmcnt(0)" ::: "memory"); \
    _Pragma("unroll") for (int _d = 0; _d < 4; ++_d) _Pragma("unroll") for (int _r = 0; _r < 16; ++_r) o[_d][_r] *= al_l[crow(_r, hi)]; } } while (0)
  f32x16 pA0, pA1, pB0, pB1; float mnA, mnB, alA, alB; bf16x8 pa0, pa1, pa2, pa3;
  KDMA(0, 0); VLOAD(0); VMW(); VWRITE(0); __syncthreads();
  KDMA(64, 1); VLOAD(64);
  qkt<KW, NQ, QL>(pA0, pA1, K_lds, qr, kcol0, r32, hi, ql); partialSM<SCID>(pA0, pA1, m_reg, mnA, alA);
  VMW(); __syncthreads(); VWRITE(1); __syncthreads();
  for (int j = 1; j + 1 < NT; j += 2) {
    SBAR(); KDMA((j + 1) * 64, 0); VLOAD((j + 1) * 64); SBAR();
    qkt<KW, NQ, QL>(pB0, pB1, K_lds + SHM_K, qr, kcol0, r32, hi, ql);
    finishSM(pA0, pA1, alA, l_reg, pa0, pa1, pa2, pa3); SBAR();
    pv_d0(o, vb0, pa0, pa1, pa2, pa3); partialSM<SCID>(pB0, pB1, m_reg, mnB, alB);
    VMW(); __syncthreads(); VWRITE(0);
    RESC(alB); __syncthreads();
    SBAR(); KDMA((j + 2) * 64, 1); VLOAD((j + 2) * 64); SBAR();
    qkt<KW, NQ, QL>(pA0, pA1, K_lds, qr, kcol0, r32, hi, ql);
    finishSM(pB0, pB1, alB, l_reg, pa0, pa1, pa2, pa3); SBAR();
    pv_d0(o, vb0 + SHM_V, pa0, pa1, pa2, pa3); partialSM<SCID>(pA0, pA1, m_reg, mnA, alA);
    VMW(); __syncthreads(); VWRITE(1);
    RESC(alA); __syncthreads();
  }
  SBAR(); qkt<KW, NQ, QL>(pB0, pB1, K_lds + SHM_K, qr, kcol0, r32, hi, ql);
  finishSM(pA0, pA1, alA, l_reg, pa0, pa1, pa2, pa3); SBAR();
  pv_d0(o, vb0, pa0, pa1, pa2, pa3); partialSM<SCID>(pB0, pB1, m_reg, mnB, alB);
  RESC(alB);
  finishSM(pB0, pB1, alB, l_reg, pa0, pa1, pa2, pa3); SBAR();
  pv_d0(o, vb0 + SHM_V, pa0, pa1, pa2, pa3);
  __syncthreads();
  l_out = l_reg;
#undef KDMA
#undef VLOAD
#undef VWRITE
#undef VMW
#undef RESC
}

template <int KW, int NQ, int SCID, int QL>
DEVI void attn_core_pp(int wv, const bf16_t* __restrict__ Qw, const bf16_t* __restrict__ Kh, const bf16_t* __restrict__ Vh, int kcol0, unsigned krd, int NT, char* lds,
                       f32x16 (&o)[4], float& l_out) {
  constexpr int SHM_V = 64 * 128 * 2, KCH = KW / 8 + 1, SHM_K = 64 * KCH * 16, KR = (64 * KCH) / 512;
  static_assert(64 * KCH - KR * 512 == 64, "remainder must be one wave");
  const int tid = tidx(wv), wid = tid >> 6, lane = tid & 63, r32 = lane & 31, hi = lane >> 5;
  const int g = __builtin_amdgcn_readfirstlane(wid >> 2);
  char* V_lds = lds; char* K_lds = lds + 2 * SHM_V;
  float* al_l = (float*)(lds + 2 * SHM_V + 2 * SHM_K) + wid * 64 + 32;
  float m_reg = -1e30f, l_reg = 0;
#pragma unroll
  for (int d = 0; d < 4; ++d)
#pragma unroll
    for (int r = 0; r < 16; ++r) o[d][r] = 0.f;
  bf16x8 qr[NQ - QL + (QL ? 1 : 0)];
#pragma unroll
  for (int d0 = 0; d0 < NQ - QL; ++d0) qr[d0] = *reinterpret_cast<const bf16x8*>(Qw + d0 * 16);
  char* ql = lds + 2 * SHM_V + 2 * SHM_K + 2048 + (wid * 32 + r32) * 144 + hi * 16;
  if constexpr (QL > 0) {
#pragma unroll
    for (int d0 = NQ - QL; d0 < NQ; ++d0) *reinterpret_cast<bf16x8*>(ql + (d0 - (NQ - QL)) * 32) = *reinterpret_cast<const bf16x8*>(Qw + d0 * 16);
  }
  const int vb0 = (int)(uintptr_t)V_lds + v_rd_base(lane);
  unsigned koff[KR + 1], voff[2];
#pragma unroll
  for (int i = 0; i <= KR; ++i) { const int c = tid + 512 * i; const int row = c / KCH; int ch = c - row * KCH; ch = ch == KCH - 1 ? KCH - 2 : ch; koff[i] = (unsigned)(row * KW + ch * 8) * 2u + (ch >= 16 ? krd : 0u); }
#pragma unroll
  for (int i = 0; i < 2; ++i) { const int q = tid + 512 * i; const int st = q >> 5, kk = (st >> 2) * 8 + ((q >> 2) & 7), c = (st & 3) * 32 + (q & 3) * 8;
    const int k = (kk & ~0xC) | ((kk & 4) << 1) | ((kk & 8) >> 1); voff[i] = (unsigned)(k * 128 + c) * 2u; }
  const unsigned ldsw = (unsigned)__builtin_amdgcn_readfirstlane(wid) * 1024u;
#define KDMA(k0, b) do { const char* _g = (const char*)(Kh + (size_t)(k0) * KW); PG8_LAS unsigned char* _l = (PG8_LAS unsigned char*)(K_lds + (b) * SHM_K) + ldsw; \
    _Pragma("unroll") for (int _i = 0; _i < KR; ++_i) __builtin_amdgcn_global_load_lds((const unsigned*)(_g + koff[_i]), (PG8_LAS unsigned*)(_l + _i * 8192), 16, 0, 0); \
    if (wid == 0) __builtin_amdgcn_global_load_lds((const unsigned*)(_g + koff[KR]), (PG8_LAS unsigned*)(_l + KR * 8192), 16, 0, 0); } while (0)
#define VDMA(k0, b) do { const char* _g = (const char*)(Vh + (size_t)(k0) * 128); PG8_LAS unsigned char* _l = (PG8_LAS unsigned char*)(V_lds + (b) * SHM_V) + ldsw; \
    _Pragma("unroll") for (int _i = 0; _i < 2; ++_i) __builtin_amdgcn_global_load_lds((const unsigned*)(_g + voff[_i]), (PG8_LAS unsigned*)(_l + _i * 8192), 16, 0, 0); } while (0)
#define VMW() asm volatile("s_waitcnt vmcnt(0)" ::: "memory")
#define PBAR() do { asm volatile("" ::: "memory"); __builtin_amdgcn_s_barrier(); asm volatile("" ::: "memory"); } while (0)
#define RESC(a) do { if (__any((a) < 1.f)) { if (hi == 0) al_l[r32] = (a); asm volatile("s_waitcnt lgkmcnt(0)" ::: "memory"); \
    _Pragma("unroll") for (int _d = 0; _d < 4; ++_d) _Pragma("unroll") for (int _r = 0; _r < 16; ++_r) o[_d][_r] *= al_l[crow(_r, hi)]; } } while (0)
  f32x16 pA0, pA1, pB0, pB1; float mn, al; bf16x8 pa0, pa1, pa2, pa3;
  KDMA(0, 0); KDMA(64, 1); VMW(); __syncthreads();
  qkt<KW, NQ, QL>(pA0, pA1, K_lds, qr, kcol0, r32, hi, ql);
  PBAR();
  if (g == 1) PBAR();
  for (int j = 0; j < NT; j += 2) {
    SBAR(); if (j + 2 < NT) KDMA((j + 2) * 64, 0); VDMA(j * 64, 0); SBAR();
    qkt<KW, NQ, QL>(pB0, pB1, K_lds + SHM_K, qr, kcol0, r32, hi, ql);
    if (j > 0) pv_d0(o, vb0 + SHM_V, pa0, pa1, pa2, pa3);
    if (g == 1) VMW();
    PBAR(); SBAR();
    partialSM<SCID>(pA0, pA1, m_reg, mn, al); RESC(al); finishSM(pA0, pA1, al, l_reg, pa0, pa1, pa2, pa3);
    if (g == 0) VMW();
    PBAR(); SBAR();
    if (j + 3 < NT) KDMA((j + 3) * 64, 1);
    VDMA((j + 1) * 64, 1); SBAR();
    if (j + 2 < NT) qkt<KW, NQ, QL>(pA0, pA1, K_lds, qr, kcol0, r32, hi, ql);
    pv_d0(o, vb0, pa0, pa1, pa2, pa3);
    if (g == 1) VMW();
    PBAR(); SBAR();
    partialSM<SCID>(pB0, pB1, m_reg, mn, al); RESC(al); finishSM(pB0, pB1, al, l_reg, pa0, pa1, pa2, pa3);
    if (g == 0) VMW();
    PBAR(); SBAR();
  }
  pv_d0(o, vb0 + SHM_V, pa0, pa1, pa2, pa3);
  if (g == 0) PBAR();
  __syncthreads();
  l_out = l_reg;
#undef KDMA
#undef VDMA
#undef VMW
#undef PBAR
#undef RESC
}

DEVI void gated_rows_out(const char* stg, int lane, const bf16_t* __restrict__ gate, int gld, bf16_t* __restrict__ out, int old) {
#pragma unroll
  for (int i = 0; i < 8; ++i) {
    const int c = lane + 64 * i, row = c >> 4, ch = c & 15;
    const u32x4 sv = *reinterpret_cast<const u32x4*>(stg + row * 272 + ch * 16);
    const u32x4 gv = *reinterpret_cast<const u32x4*>(gate + (size_t)row * gld + ch * 8);
    u32x4 ov;
#pragma unroll
    for (int e = 0; e < 4; ++e) ov[e] = cvtpk(bflo(sv[e]) * bflo(gv[e]), bfhi(sv[e]) * bfhi(gv[e]));
    *reinterpret_cast<u32x4*>(out + (size_t)row * old + ch * 8) = ov;
  }
}

DEVI void attn0_item(int wv, const Params& p, int token0, int b, int h, int nkeys, char* lds) {
  const int tid = tidx(wv), wid = tid >> 6, lane = tid & 63, r32 = lane & 31, hi = lane >> 5, m = wid >> 2, wl = wid & 3;
  const bf16_t* Q0 = (const bf16_t*)(p.ws + OFF_Q0); const bf16_t* K0 = (const bf16_t*)(p.ws + OFF_K0); const bf16_t* V0 = (const bf16_t*)(p.ws + OFF_V0);
  const bf16_t* ZB = (const bf16_t*)(p.ws + OFF_ZB); bf16_t* MIX = (bf16_t*)(p.ws + OFF_MIX);
  const bf16_t* Qw = Q0 + (size_t)(token0 + wl * 32 + r32) * 512 + h * 128 + m * 64 + hi * 8;
  const size_t kvo = (size_t)(b * 4 + h) * KVL * 128;
  f32x16 o[4]; float l;
  attn_core_pp<128, 4, 0, 0>(wv, Qw, K0 + kvo, V0 + kvo, m * 64, 0u, nkeys >> 6, lds, o, l);
  float* li_l = (float*)(lds + 32768 + 2 * 64 * 272) + wid * 64;
  if (hi == 0) li_l[r32] = l;
  asm volatile("s_waitcnt lgkmcnt(0)" ::: "memory");
  float rli[16];
#pragma unroll
  for (int r = 0; r < 16; ++r) rli[r] = __builtin_amdgcn_rcpf(li_l[crow(r, hi)]);
  float t1 = p.b_lq1[lane] * p.b_lk1[lane], t2 = p.b_lq2[lane] * p.b_lk2[lane];
  t1 = wave_sum(t1); t2 = wave_sum(t2);
  const float lam = __expf(t1) - __expf(t2) + 0.2f;
  __syncthreads();
  float* xch = (float*)lds;
  if (m == 1) {
#pragma unroll
    for (int r = 0; r < 16; ++r)
#pragma unroll
      for (int d0 = 0; d0 < 4; ++d0) xch[(wl * 32 + crow(r, hi)) * 128 + d0 * 32 + r32] = o[d0][r] * rli[r];
  }
  __syncthreads();
  if (m == 0) {
    char* stg = lds + 69632 + wl * 8704;
    float sw4[4];
#pragma unroll
    for (int d0 = 0; d0 < 4; ++d0) sw4[d0] = p.b_subln_w[d0 * 32 + r32];
#pragma unroll
    for (int r = 0; r < 16; ++r) {
      const int row = wl * 32 + crow(r, hi); const int token = token0 + row;
      float a[4], ss = 0.f;
#pragma unroll
      for (int d0 = 0; d0 < 4; ++d0) { a[d0] = o[d0][r] * rli[r] - lam * xch[row * 128 + d0 * 32 + r32]; ss += a[d0] * a[d0]; }
      ss = xsum<1>(ss); ss = xsum<2>(ss); ss = xsum<4>(ss); ss = xsum<8>(ss); ss = xsum<16>(ss);
      const float rstd = rsqrtf(ss * (1.f / 128.f) + 1e-5f) * 0.8f;
#pragma unroll
      for (int d0 = 0; d0 < 4; ++d0) *reinterpret_cast<bf16_t*>(stg + crow(r, hi) * 272 + (d0 * 32 + r32) * 2) = f2bf(a[d0] * rstd * sw4[d0]);
    }
    asm volatile("s_waitcnt lgkmcnt(0)" ::: "memory");
    const size_t t0 = (size_t)(token0 + wl * 32);
    gated_rows_out(stg, lane, ZB + t0 * 512 + h * 128, 512, MIX + t0 * 1024 + 512 + h * 128, 1024);
  }
  __syncthreads();
}

DEVI void attn1_item(int wv, const Params& p, int b, int h, int qb, char* lds) {
  const int tid = tidx(wv), wid = tid >> 6, lane = tid & 63, r32 = lane & 31, hi = lane >> 5;
  const bf16_t* Q1 = (const bf16_t*)(p.ws + OFF_Q1); const bf16_t* K1 = (const bf16_t*)(p.ws + OFF_K1); const bf16_t* V1 = (const bf16_t*)(p.ws + OFF_V1);
  const bf16_t* Z1 = (const bf16_t*)(p.ws + OFF_Z1); bf16_t* MIX = (bf16_t*)(p.ws + OFF_MIX);
  const int token0 = b * 2048 + qb * 256;
  const bf16_t* Qw = Q1 + (size_t)(token0 + wid * 32 + r32) * 1536 + h * 192 + hi * 8;
  f32x16 o[4]; float l;
  const bf16_t* Kh1 = K1 + (size_t)(b * 8 + h) * KVL * 192; const bf16_t* KRb = (const bf16_t*)(p.ws + OFF_KR) + (size_t)b * KVL * 192;
  attn_core_pp<192, 12, 1, 4>(wv, Qw, Kh1, V1 + (size_t)(b * 8 + h) * KVL * 128, 0, (unsigned)((const char*)KRb - (const char*)Kh1), KVL / 64, lds, o, l);
  float* li_l = (float*)(lds + 32768 + 2 * 64 * 400) + wid * 64;
  if (hi == 0) li_l[r32] = l;
  asm volatile("s_waitcnt lgkmcnt(0)" ::: "memory");
  char* stg = lds + wid * 8704;
#pragma unroll
  for (int r = 0; r < 16; ++r) {
    const int cr = crow(r, hi); const float rl = __builtin_amdgcn_rcpf(li_l[cr]);
#pragma unroll
    for (int d0 = 0; d0 < 4; ++d0) *reinterpret_cast<bf16_t*>(stg + cr * 272 + (d0 * 32 + r32) * 2) = f2bf(o[d0][r] * rl);
  }
  asm volatile("s_waitcnt lgkmcnt(0)" ::: "memory");
  const size_t t0 = (size_t)(token0 + wid * 32);
  gated_rows_out(stg, lane, Z1 + t0 * 1024 + h * 128, 1024, MIX + t0 * 1024 + h * 128, 1024);
  __syncthreads();
}

DEVI void abranch_item(int wv, const Params& p, int ci, char* lds) {
  const int tid = tidx(wv), wid = tid >> 6, lane = tid & 63, r32 = lane & 31, hi = lane >> 5;
  const bf16_t* GV = (const bf16_t*)(p.ws + OFF_GV); const bf16_t* U = (const bf16_t*)(p.ws + OFF_U); const bf16_t* ZA = (const bf16_t*)(p.ws + OFF_ZA);
  const bf16_t* WSB = (const bf16_t*)(p.ws + OFF_WSB); bf16_t* MIX = (bf16_t*)(p.ws + OFF_MIX);
  const int t0 = ci * 128;
  bf16_t* vnT = (bf16_t*)lds;
  {
    const int pos = tid >> 2, cp = tid & 3;
    const bf16_t* g = GV + (size_t)(t0 + pos) * 512;
    bf16x8 raw[16];
#pragma unroll
    for (int i = 0; i < 16; ++i) raw[i] = *reinterpret_cast<const bf16x8*>(g + (i * 4 + cp) * 8);
    float s = 0.f, q = 0.f;
#pragma unroll
    for (int i = 0; i < 16; ++i)
#pragma unroll
      for (int e = 0; e < 8; ++e) { const float xv = bf2f((bf16_t)raw[i][e]); s += xv; q += xv * xv; }
    s = xsum<1>(s); s = xsum<2>(s); q = xsum<1>(q); q = xsum<2>(q);
    const float mu = s * (1.f / 512.f);
    const float rstd = rsqrtf(fmaxf(q * (1.f / 512.f) - mu * mu, 0.f) + 1e-5f);
#pragma unroll
    for (int i = 0; i < 16; ++i) {
      const int c0 = (i * 4 + cp) * 8;
      const f32x4 w0 = *reinterpret_cast<const f32x4*>(p.a_ln_w + c0), w1 = *reinterpret_cast<const f32x4*>(p.a_ln_w + c0 + 4);
      const f32x4 b0 = *reinterpret_cast<const f32x4*>(p.a_ln_b + c0), b1 = *reinterpret_cast<const f32x4*>(p.a_ln_b + c0 + 4);
#pragma unroll
      for (int e = 0; e < 8; ++e) {
        const float wv = e < 4 ? w0[e & 3] : w1[e & 3], bv = e < 4 ? b0[e & 3] : b1[e & 3];
        vnT[(c0 + e) * 136 + pos] = f2bf((bf2f((bf16_t)raw[i][e]) - mu) * rstd * wv + bv);
      }
    }
  }
  __syncthreads();
  const int g8 = wid;
  const bf16_t* Wg = WSB + g8 * 128 * 128;
  f32x16 acc[4][2];
#pragma unroll
  for (int pb = 0; pb < 4; ++pb) {
#pragma unroll
    for (int r = 0; r < 16; ++r) { acc[pb][0][r] = 0.f; acc[pb][1][r] = 0.f; }
#pragma unroll
    for (int ks = 0; ks < 8; ++ks) {
      const bf16x8 bw = *reinterpret_cast<const bf16x8*>(Wg + (pb * 32 + r32) * 128 + ks * 16 + hi * 8);
#pragma unroll
      for (int db = 0; db < 2; ++db) {
        const bf16x8 a = *reinterpret_cast<const bf16x8*>(vnT + (g8 * 64 + db * 32 + r32) * 136 + ks * 16 + hi * 8);
        acc[pb][db] = __builtin_amdgcn_mfma_f32_32x32x16_bf16(a, bw, acc[pb][db], 0, 0, 0);
      }
    }
  }
  asm volatile("s_waitcnt lgkmcnt(0)" ::: "memory");
  char* stg = (char*)vnT + (size_t)g8 * 64 * 272;
#pragma unroll
  for (int pb = 0; pb < 4; ++pb) {
    const float bias = p.a_bs[g8 * 128 + pb * 32 + r32];
#pragma unroll
    for (int db = 0; db < 2; ++db)
#pragma unroll
      for (int rg = 0; rg < 4; ++rg) {
        u32x2 pk = {cvtpk(acc[pb][db][rg * 4 + 0] + bias, acc[pb][db][rg * 4 + 1] + bias), cvtpk(acc[pb][db][rg * 4 + 2] + bias, acc[pb][db][rg * 4 + 3] + bias)};
        *reinterpret_cast<u32x2*>(stg + (pb * 32 + r32) * 136 + (db * 32 + rg * 8 + hi * 4) * 2) = pk;
      }
  }
  asm volatile("s_waitcnt lgkmcnt(0)" ::: "memory");
#pragma unroll 4
  for (int i = 0; i < 16; ++i) {
    const int c = lane + 64 * i, row = c >> 3, ch = c & 7;
    const u32x2 s0 = *reinterpret_cast<const u32x2*>(stg + row * 136 + ch * 16), s1 = *reinterpret_cast<const u32x2*>(stg + row * 136 + ch * 16 + 8);
    const size_t gi = (size_t)(t0 + row) * 512 + g8 * 64 + ch * 8;
    const u32x4 uv = *reinterpret_cast<const u32x4*>(U + gi), zv = *reinterpret_cast<const u32x4*>(ZA + gi);
    const unsigned sv[4] = {s0[0], s0[1], s1[0], s1[1]};
    u32x4 ov;
#pragma unroll
    for (int e = 0; e < 4; ++e) ov[e] = cvtpk(bflo(uv[e]) * bflo(sv[e]) * bflo(zv[e]), bfhi(uv[e]) * bfhi(sv[e]) * bfhi(zv[e]));
    *reinterpret_cast<u32x4*>(MIX + (size_t)(t0 + row) * 1024 + g8 * 64 + ch * 8) = ov;
  }
  __syncthreads();
}

DEVI void tr_tile(int wv, const float* __restrict__ src, bf16_t* __restrict__ dst, int K, int N, int tilesN4, const float* __restrict__ scale, int t, char* lds) {
  const int tid = tidx(wv);
  const int k0 = (t / tilesN4) * 64, n0 = (t % tilesN4) * 256;
  const int kr = tid >> 3, ng = (tid & 7) * 8;
  f32x4 v0[4], v1[4];
#pragma unroll
  for (int u = 0; u < 4; ++u) {
    v0[u] = (f32x4){0.f, 0.f, 0.f, 0.f}; v1[u] = v0[u];
    if (n0 + u * 64 + ng < N) { const float* s = src + (size_t)(k0 + kr) * N + n0 + u * 64 + ng; v0[u] = *reinterpret_cast<const f32x4*>(s); v1[u] = *reinterpret_cast<const f32x4*>(s + 4); }
  }
  const float scv = scale ? scale[k0 + kr] : 1.f;
  bf16_t* tl = (bf16_t*)lds;
#pragma unroll
  for (int u = 0; u < 4; ++u)
#pragma unroll
    for (int e = 0; e < 4; ++e) { tl[u * 4608 + (ng + e) * 72 + kr] = f2bf(v0[u][e] * scv); tl[u * 4608 + (ng + 4 + e) * 72 + kr] = f2bf(v1[u][e] * scv); }
  __syncthreads();
  const int n = tid >> 3, kc = (tid & 7) * 8;
#pragma unroll
  for (int u = 0; u < 4; ++u)
    *reinterpret_cast<bf16x8*>(dst + (size_t)(n0 + u * 64 + n) * K + k0 + kc) = *reinterpret_cast<const bf16x8*>(tl + u * 4608 + n * 72 + kc);
}

DEVI void tr_item(int wv, const Params& p, int t, char* lds) {
  if (t < 224) tr_tile(wv, p.even_w_in, (bf16_t*)(p.ws + OFF_W0IN), 1024, 3584, 14, nullptr, t, lds);
  else if (t < 288) tr_tile(wv, p.even_w_out, (bf16_t*)(p.ws + OFF_W0OUT), 1024, 1024, 4, nullptr, t - 224, lds);
  else if (t < 384) tr_tile(wv, p.odd_w_in, (bf16_t*)(p.ws + OFF_W1IN), 1024, 1472, 6, nullptr, t - 288, lds);
  else if (t < 408) tr_tile(wv, p.c_wq_b, (bf16_t*)(p.ws + OFF_WQ), 256, 1536, 6, p.c_q_norm_w, t - 384, lds);
  else if (t < 424) tr_tile(wv, p.c_wkv_b, (bf16_t*)(p.ws + OFF_WKV), 128, 2048, 8, p.c_kv_norm_w, t - 408, lds);
  else tr_tile(wv, p.odd_w_out, (bf16_t*)(p.ws + OFF_W1OUT), 1024, 1024, 4, nullptr, t - 424, lds);
  __syncthreads();
}

DEVI void phase0(int wv, const Params& p, char* lds) {
  const int tid = tidx(wv);
  constexpr int N_ADA = 192, N_TR = 224, N_WS = 16;
  for (int it = blockIdx.x; it < N_ADA + N_TR + N_WS + 1; it += gridDim.x) {
    if (it < N_ADA) {
      const int li = it / 96, chunk = it % 96;
      float* sc = (float*)lds;
      for (int idx = tid; idx < 17 * 1024; idx += 512) { const int r = idx >> 10, k = idx & 1023; const float xv = r < 16 ? p.c[r * 1024 + k] : p.c_ctx[k]; sc[idx] = xv / (1.f + expf(-xv)); }
      __syncthreads();
      const int col = tid & 31, kp = tid >> 5;
      const float* w = p.ada_w + (size_t)li * 1024 * 3072 + chunk * 32 + col;
      float acc[17];
#pragma unroll
      for (int r = 0; r < 17; ++r) acc[r] = 0.f;
#pragma unroll 2
      for (int k = kp * 64; k < kp * 64 + 64; k += 4) {
        const float w0 = w[(size_t)k * 3072], w1 = w[(size_t)(k + 1) * 3072], w2 = w[(size_t)(k + 2) * 3072], w3 = w[(size_t)(k + 3) * 3072];
#pragma unroll
        for (int r = 0; r < 17; ++r) { const f32x4 s4 = *reinterpret_cast<const f32x4*>(sc + r * 1024 + k); acc[r] += s4[0] * w0 + s4[1] * w1 + s4[2] * w2 + s4[3] * w3; }
      }
      float* red = (float*)(lds + 17 * 1024 * 4);
#pragma unroll
      for (int r = 0; r < 17; ++r) red[(kp * 17 + r) * 32 + col] = acc[r];
      __syncthreads();
      float* ada = (float*)(p.ws + OFF_ADA);
      for (int idx = tid; idx < 544; idx += 512) {
        const int r = idx >> 5, cc = idx & 31; float s = 0.f;
        for (int k2 = 0; k2 < 16; ++k2) s += red[(k2 * 17 + r) * 32 + cc];
        ada[(size_t)(li * 17 + r) * 3072 + chunk * 32 + cc] = s + p.ada_b[li * 3072 + chunk * 32 + cc];
      }
    } else if (it < N_ADA + N_TR) {
      tr_tile(wv, p.even_w_in, (bf16_t*)(p.ws + OFF_W0IN), 1024, 3584, 14, nullptr, it - N_ADA, lds);
    } else if (it < N_ADA + N_TR + N_WS) {
      const int base = (it - N_ADA - N_TR) * 8192 + tid * 16;
      bf16_t* dst = (bf16_t*)(p.ws + OFF_WSB) + base; const float* s = p.a_ws + base;
#pragma unroll
      for (int q = 0; q < 2; ++q) {
        const f32x4 a = *reinterpret_cast<const f32x4*>(s + q * 8), b = *reinterpret_cast<const f32x4*>(s + q * 8 + 4);
        u32x4 w = {cvtpk(a[0], a[1]), cvtpk(a[2], a[3]), cvtpk(b[0], b[1]), cvtpk(b[2], b[3])};
        *reinterpret_cast<u32x4*>(dst + q * 8) = w;
      }
    } else {
      float2* tab = (float2*)(p.ws + OFF_ROPE);
      for (int e = tid; e < 1024; e += 512) {
        const int pos = e >> 4, j = e & 15;
        const float inv = exp2f(-(float)j * (13.287712379549449f / 16.f));
        const float ang = (float)pos * inv;
        const float nrev = rintf(ang * 0.15915494309189535f);
        float rr = fmaf(-nrev, 6.2831855f, ang); rr = fmaf(-nrev, -1.7484555e-7f, rr);
        tab[e] = make_float2(__cosf(rr), __sinf(rr));
      }
    }
    __syncthreads();
  }
}

template <bool RES>
DEVI void norm_mod(int wv, const float* src_lat, const float* src_ctx, const float* __restrict__ nw, const float* __restrict__ ada, bf16_t* X,
                   int row_lo, int row_hi, int vb, int nvb, const float* __restrict__ ada_prev = nullptr, float* hdst_lat = nullptr, float* hdst_ctx = nullptr) {
  const int tid_ = tidx(wv); const int wid = tid_ >> 6, lane = tid_ & 63;
  for (int row0 = row_lo + (vb * 8 + wid) * 2; row0 < row_hi; row0 += nvb * 16) {
    f32x4 v[2][4]; u32x2 ov[2][4]; float ss[2];
#pragma unroll
    for (int q = 0; q < 2; ++q) {
      const int row = row0 + q;
      const float* src = row < NLAT ? src_lat + (size_t)row * 1024 : src_ctx + (size_t)(row - NLAT) * 1024;
      ss[q] = 0.f;
#pragma unroll
      for (int i = 0; i < 4; ++i) {
        v[q][i] = __builtin_nontemporal_load(reinterpret_cast<const f32x4*>(src + i * 256 + lane * 4));
        if constexpr (RES) ov[q][i] = *reinterpret_cast<const u32x2*>(X + (size_t)row * 1024 + i * 256 + lane * 4);
      }
    }
    if constexpr (RES) {
#pragma unroll
      for (int q = 0; q < 2; ++q) {
        const int row = row0 + q;
        const float* gp = ada_prev + (row < NLAT ? (row >> 11) : 16) * 3072 + 2048;
        float* hd = row < NLAT ? hdst_lat + (size_t)row * 1024 : hdst_ctx + (size_t)(row - NLAT) * 1024;
#pragma unroll
        for (int i = 0; i < 4; ++i) {
          const int c = i * 256 + lane * 4;
          const f32x4 g = *reinterpret_cast<const f32x4*>(gp + c);
          v[q][i][0] += g[0] * bflo(ov[q][i][0]); v[q][i][1] += g[1] * bfhi(ov[q][i][0]); v[q][i][2] += g[2] * bflo(ov[q][i][1]); v[q][i][3] += g[3] * bfhi(ov[q][i][1]);
          __builtin_nontemporal_store(v[q][i], reinterpret_cast<f32x4*>(hd + c));
        }
      }
    }
#pragma unroll
    for (int q = 0; q < 2; ++q) {
#pragma unroll
      for (int i = 0; i < 4; ++i) ss[q] += v[q][i][0] * v[q][i][0] + v[q][i][1] * v[q][i][1] + v[q][i][2] * v[q][i][2] + v[q][i][3] * v[q][i][3];
      ss[q] = wave_sum(ss[q]);
    }
#pragma unroll
    for (int q = 0; q < 2; ++q) {
      const int row = row0 + q;
      const float* ad = ada + (row < NLAT ? (row >> 11) : 16) * 3072;
      const float r = rsqrtf(ss[q] * (1.f / 1024.f) + 1e-6f);
#pragma unroll
      for (int i = 0; i < 4; ++i) {
        const int c = i * 256 + lane * 4;
        const f32x4 w = *reinterpret_cast<const f32x4*>(nw + c), sh = *reinterpret_cast<const f32x4*>(ad + c), scl = *reinterpret_cast<const f32x4*>(ad + 1024 + c);
        float o[4];
#pragma unroll
        for (int e = 0; e < 4; ++e) o[e] = v[q][i][e] * r * w[e] * (1.f + scl[e]) + sh[e];
        u32x2 pk = {cvtpk(o[0], o[1]), cvtpk(o[2], o[3])};
        *reinterpret_cast<u32x2*>(X + (size_t)row * 1024 + c) = pk;
      }
    }
  }
}

DEVI void final_norm(int wv, float* out, const float* __restrict__ fw, const bf16_t* __restrict__ O1, const float* __restrict__ ada1) {
  const int tid_ = tidx(wv); const int wid = tid_ >> 6, lane = tid_ & 63;
  for (int row0 = (blockIdx.x * 8 + wid) * 2; row0 < NLAT; row0 += gridDim.x * 16) {
    f32x4 v[2][4]; u32x2 ov[2][4]; float ss[2];
#pragma unroll
    for (int q = 0; q < 2; ++q) {
      ss[q] = 0.f;
#pragma unroll
      for (int i = 0; i < 4; ++i) {
        v[q][i] = __builtin_nontemporal_load(reinterpret_cast<const f32x4*>(out + (size_t)(row0 + q) * 1024 + i * 256 + lane * 4));
        ov[q][i] = *reinterpret_cast<const u32x2*>(O1 + (size_t)(row0 + q) * 1024 + i * 256 + lane * 4);
      }
    }
#pragma unroll
    for (int q = 0; q < 2; ++q) {
      const float* gp = ada1 + ((row0 + q) >> 11) * 3072 + 2048;
#pragma unroll
      for (int i = 0; i < 4; ++i) {
        const f32x4 g = *reinterpret_cast<const f32x4*>(gp + i * 256 + lane * 4);
        v[q][i][0] += g[0] * bflo(ov[q][i][0]); v[q][i][1] += g[1] * bfhi(ov[q][i][0]); v[q][i][2] += g[2] * bflo(ov[q][i][1]); v[q][i][3] += g[3] * bfhi(ov[q][i][1]);
        ss[q] += v[q][i][0] * v[q][i][0] + v[q][i][1] * v[q][i][1] + v[q][i][2] * v[q][i][2] + v[q][i][3] * v[q][i][3];
      }
      ss[q] = wave_sum(ss[q]);
    }
#pragma unroll
    for (int q = 0; q < 2; ++q) {
      const float r = rsqrtf(ss[q] * (1.f / 1024.f) + 1e-6f);
#pragma unroll
      for (int i = 0; i < 4; ++i) {
        const int c = i * 256 + lane * 4;
        const f32x4 w = *reinterpret_cast<const f32x4*>(fw + c);
        __builtin_nontemporal_store(v[q][i] * r * w, reinterpret_cast<f32x4*>(out + (size_t)(row0 + q) * 1024 + c));
      }
    }
  }
}

typedef const __attribute__((address_space(4))) Params* KArgP;
DEVI void run_phase(int wv, KArgP pp, int ph, char* lds) {
#if defined(__HIP_DEVICE_COMPILE__)
  asm volatile("" : "+s"(pp));
  char* ws = pp->ws;
  const float2* rope = (const float2*)(ws + OFF_ROPE);
  const float* ada0 = (const float*)(ws + OFF_ADA); const float* ada1 = ada0 + 17 * 3072;
  bf16_t* X = (bf16_t*)(ws + OFF_X); bf16_t* MIX = (bf16_t*)(ws + OFF_MIX);
  const int G = gridDim.x, B = blockIdx.x;
  PG8_LAS unsigned char* ldsp = (PG8_LAS unsigned char*)lds;
  switch (ph) {
    case 0: { const Params p = *pp; phase0(wv, p, lds); } break;
    case 1: norm_mod<false>(wv, pp->x, pp->ctx, pp->norm_w, ada0, X, 0, NTOK, B, G); break;
    case 2: {
      EpiL0In epi{(bf16_t*)(ws + OFF_U), (bf16_t*)(ws + OFF_GV), (bf16_t*)(ws + OFF_ZA), (bf16_t*)(ws + OFF_ZB), (bf16_t*)(ws + OFF_Q0), (bf16_t*)(ws + OFF_K0), (bf16_t*)(ws + OFF_V0), rope};
      gemm_phase(wv, ldsp, X, (const bf16_t*)(ws + OFF_W0IN), 1024, Sched{14, 144 * 14, 144 * 14, 0, 0}, epi);
    } break;
    case 3: { const Params p = *pp;
      for (int it = B; it < 1024 + 288 + 128; it += G) {
        if (it < 1024) {
          const int xcd = it & 7, slot = (it >> 3) & 31, rd = it >> 8;
          const int bh = rd * 16 + xcd * 2 + (slot >> 4), qb = slot & 15, b = bh >> 2, h = bh & 3;
          attn0_item(wv, p, b * 2048 + qb * 128, b, h, KVL, lds);
        } else if (it < 1024 + 288) abranch_item(wv, p, it - 1024, lds);
        else { const int i2 = it - 1312; const int b = i2 >> 3, h = (i2 >> 1) & 3, qb = i2 & 1; attn0_item(wv, p, NLAT + b * 256 + qb * 128, b, h, 256, lds); }
      }
      {
        const int nb = G >= 192 ? 96 : G, base = G - nb;
        if (B >= base) for (int t = 224 + (B - base); t < 288; t += nb) tr_item(wv, p, t, lds);
      }
    } break;
    case 4: {
      EpiPlain epi{X};
      gemm_phase(wv, ldsp, MIX, (const bf16_t*)(ws + OFF_W0OUT), 1024, Sched{4, 144 * 4, 144 * 4, 0, 0}, epi);
      {
        const Params p = *pp; const int nb = G > 64 ? G - 64 : G, base = G - nb;
        if (B >= base) for (int t = 288 + (B - base); t < 488; t += nb) tr_item(wv, p, t, lds);
      }
    } break;
    case 5: {
      if (B >= G - 16) {
        const int cp = B - (G - 16);
        norm_mod<true>(wv, pp->x, pp->ctx, pp->norm_w + 1024, ada1, X, NLAT + cp * 256, NLAT + cp * 256 + 256, 0, 1, ada0, pp->out, (float*)(ws + OFF_H1C));
        asm volatile("s_waitcnt vmcnt(0)" ::: "memory"); __syncthreads();
        EpiL1In epi{(bf16_t*)(ws + OFF_CQ), (bf16_t*)(ws + OFF_CKV), (bf16_t*)(ws + OFF_KR), (bf16_t*)(ws + OFF_Z1), (float*)(ws + OFF_RQ), (float*)(ws + OFF_RKV), rope, (float*)(lds + LDS_SS)};
        gemm_phase(wv, ldsp, X, (const bf16_t*)(ws + OFF_W1IN), 1024, Sched{6, 0, 16, 128, 1, G - 16}, epi);
      } else norm_mod<true>(wv, pp->x, pp->ctx, pp->norm_w + 1024, ada1, X, 0, NLAT, B, G - 16, ada0, pp->out, (float*)(ws + OFF_H1C));
    } break;
    case 6: {
      EpiL1In epi{(bf16_t*)(ws + OFF_CQ), (bf16_t*)(ws + OFF_CKV), (bf16_t*)(ws + OFF_KR), (bf16_t*)(ws + OFF_Z1), (float*)(ws + OFF_RQ), (float*)(ws + OFF_RKV), rope, (float*)(lds + LDS_SS)};
      gemm_phase(wv, ldsp, X, (const bf16_t*)(ws + OFF_W1IN), 1024, Sched{6, 768, 768, 128, 1}, epi);
    } break;
    case 7: {
      EpiQ eq{(bf16_t*)(ws + OFF_Q1), (const float*)(ws + OFF_RQ), rope};
      EpiKV ek{(bf16_t*)(ws + OFF_K1), (bf16_t*)(ws + OFF_V1), (const float*)(ws + OFF_RKV)};
      gemm_phase(wv, ldsp, (const bf16_t*)(ws + OFF_CKV), (const bf16_t*)(ws + OFF_WKV), 128, Sched{8, 1152, 1152, 0, 0}, ek);
      gemm_phase(wv, ldsp, (const bf16_t*)(ws + OFF_CQ), (const bf16_t*)(ws + OFF_WQ), 256, Sched{6, 768, 768, 0, 0}, eq);
    } break;
    case 8: { const Params p = *pp;
      for (int it = B; it < 1024; it += G) {
        const int xcd = it & 7, slot = (it >> 3) & 31, rd = it >> 8;
        const int bh = rd * 32 + xcd * 4 + (slot >> 3), qb = slot & 7;
        attn1_item(wv, p, bh >> 3, bh & 7, qb, lds);
      }
    } break;
    case 9: {
      EpiPlain epi{X};
      gemm_phase(wv, ldsp, MIX, (const bf16_t*)(ws + OFF_W1OUT), 1024, Sched{4, 128 * 4, 128 * 4, 0, 0}, epi);
    } break;
    case 10: final_norm(wv, pp->out, pp->final_w, X, ada1); break;
  }
#endif
}


#define XB_TMO      128
#define XB_XCNT(j)  (256  + 64 * (j))
#define XB_XSUB(j)  (1280 + 64 * (j))
#define XB_XGEN(j)  (2304 + 64 * (j))
#define XB_TOP      3328
#define XB_TOPGEN   3392
#define XCD_BAR_WORDS 3456
#define XB_SPIN_CAP (1u << 18)
#define LAS __attribute__((address_space(3)))
DEVI unsigned xb_ld(unsigned* p) { return __hip_atomic_load(p, __ATOMIC_RELAXED, __HIP_MEMORY_SCOPE_AGENT); }
DEVI unsigned xb_add(unsigned* p, unsigned v) { return __hip_atomic_fetch_add(p, v, __ATOMIC_RELAXED, __HIP_MEMORY_SCOPE_AGENT); }
DEVI unsigned xb_xcc_id() { return (unsigned)__builtin_amdgcn_s_getreg((3 << 11) | 20) & 0xFu; }
#define XB_SPIN(cond, bar) do { unsigned _sp = 0; while (cond) { __builtin_amdgcn_s_sleep(1); \
    if ((++_sp & 255u) == 0u) { if (xb_ld(&(bar)[XB_TMO])) break; if (_sp > XB_SPIN_CAP) { atomicAdd(&(bar)[XB_TMO], 1u); break; } } } } while (0)
struct XcdBarrier { unsigned* bar; unsigned x; volatile LAS unsigned* st; };
DEVI XcdBarrier xcd_barrier_post(int wv, unsigned* bar, volatile LAS unsigned* st) {
  XcdBarrier b; b.bar = bar; b.x = xb_xcc_id(); b.st = st;
  if (tidx(wv) == 0) (void)xb_add(&bar[XB_XCNT(b.x)], 1u);
  return b;
}
DEVI void xcd_barrier_complete(unsigned* bar, unsigned x, unsigned& nloc, unsigned& nx) {
  const unsigned G = gridDim.x * gridDim.y * gridDim.z;
  unsigned sum, cnt, mine, sp = 0u;
  for (;;) {
    sum = 0u; cnt = 0u; mine = 0u;
#pragma unroll
    for (unsigned j = 0; j < 16; ++j) { const unsigned c = xb_ld(&bar[XB_XCNT(j)]); sum += c; cnt += (c > 0u) ? 1u : 0u; mine = (j == x) ? c : mine; }
    if (sum == G) break;
    __builtin_amdgcn_s_sleep(1);
    if ((++sp & 255u) == 0u) { if (xb_ld(&bar[XB_TMO])) break; if (sp > XB_SPIN_CAP) { atomicAdd(&bar[XB_TMO], 1u); break; } }
  }
  nloc = mine > 0u ? mine : 1u; nx = cnt > 0u ? cnt : 1u;
}
DEVI void xcd_barrier(int wv, const XcdBarrier& b) {
  asm volatile("s_waitcnt vmcnt(0)" ::: "memory");
  __syncthreads();
  if (tidx(wv) == 0) {
    unsigned* bar = b.bar;
    __builtin_amdgcn_s_waitcnt(0);
    unsigned nloc = b.st[0], nx = b.st[1];
    if (nloc == 0u) { xcd_barrier_complete(bar, b.x, nloc, nx); b.st[0] = nloc; b.st[1] = nx; }
    const unsigned old = xb_add(&bar[XB_XSUB(b.x)], 1u);
    const unsigned gen = old / nloc;
    if (old + 1u == (gen + 1u) * nloc) {
      __builtin_amdgcn_fence(__ATOMIC_RELEASE, "agent");
      asm volatile("s_waitcnt vmcnt(0)" ::: "memory");
      const unsigned og = xb_add(&bar[XB_TOP], 1u);
      const unsigned tg = og / nx;
      if (og + 1u == (tg + 1u) * nx) xb_add(&bar[XB_TOPGEN], 1u);
      else XB_SPIN(xb_ld(&bar[XB_TOPGEN]) == tg, bar);
      __builtin_amdgcn_fence(__ATOMIC_ACQUIRE, "agent");
      xb_add(&bar[XB_XGEN(b.x)], 1u);
      asm volatile("s_waitcnt vmcnt(0)" ::: "memory");
    } else {
      XB_SPIN(xb_ld(&bar[XB_XGEN(b.x)]) == gen, bar);
      __builtin_amdgcn_fence(__ATOMIC_ACQUIRE, "agent");
      asm volatile("s_waitcnt vmcnt(0)" ::: "memory");
    }
  }
  __syncthreads();
}

extern __shared__ __attribute__((aligned(16))) char g_lds[];

constexpr int LDS_XB = 143360;
__global__ void __launch_bounds__(512) mega(Params p) {
  cg::grid_group grid = cg::this_grid();
  if (p.ph_hi > 64) grid.sync();
  const int wv = __builtin_amdgcn_readfirstlane((int)threadIdx.x >> 6);
  volatile LAS unsigned* xst = (volatile LAS unsigned*)(g_lds + LDS_XB);
  if (tidx(wv) == 0) { xst[0] = 0u; xst[1] = 0u; }
  __syncthreads();
  (void)xcd_barrier_post(wv, (unsigned*)(p.ws + OFF_BAR), xst);
#define GRID_BARRIER() do { KArgP _pp = (KArgP)__builtin_amdgcn_kernarg_segment_ptr(); asm volatile("" : "+s"(_pp)); \
    XcdBarrier _xb; _xb.bar = (unsigned*)(_pp->ws + OFF_BAR); _xb.x = xb_xcc_id(); _xb.st = (volatile LAS unsigned*)(g_lds + LDS_XB); xcd_barrier(wv, _xb); } while (0)
  for (int ph = p.ph_lo; ph < p.ph_hi; ++ph) {
    run_phase(wv, (KArgP)__builtin_amdgcn_kernarg_segment_ptr(), ph, g_lds);
#ifdef PROBE_PH
    if (ph == PROBE_PH) { GRID_BARRIER(); run_phase(wv, (KArgP)__builtin_amdgcn_kernarg_segment_ptr(), ph, g_lds); }
#endif
    if (ph + 1 < p.ph_hi) GRID_BARRIER();
  }
}

extern "C" void kernel_launch(void* const* d_in, const int* in_sizes, int n_in, void* d_out, int out_size, void* d_ws, size_t ws_size, hipStream_t stream) {
  static int ok = 0;
  static int grid_blocks = 0;
  if (!ok) {
    if (n_in != 25 || ws_size < WS_NEED) { fprintf(stderr, "kernel_launch: bad args n_in %d ws %zu need %zu\n", n_in, ws_size, (size_t)WS_NEED); return; }
    if (hipFuncSetAttribute((const void*)mega, hipFuncAttributeMaxDynamicSharedMemorySize, LDS_BYTES) != hipSuccess) { fprintf(stderr, "kernel_launch: LDS attr failed\n"); return; }
    int dev = 0, cus = 0, per_cu = 0;
    hipGetDevice(&dev);
    hipDeviceGetAttribute(&cus, hipDeviceAttributeMultiprocessorCount, dev);
    hipOccupancyMaxActiveBlocksPerMultiprocessor(&per_cu, mega, 512, LDS_BYTES);
    if (per_cu < 1) per_cu = 1;
    grid_blocks = cus * per_cu;
    ok = 1;
  }
  Params p{};
  const float** pp = (const float**)&p;
  for (int i = 0; i < 25; ++i) pp[i] = (const float*)d_in[i];
  p.out = (float*)d_out; p.ws = (char*)d_ws;
#if ONE_LAUNCH
  p.ph_lo = 0; p.ph_hi = 11;
  hipMemsetAsync((char*)d_ws + OFF_BAR, 0, XCD_BAR_WORDS * 4, stream);
  void* args[] = {&p};
  hipError_t e = hipLaunchCooperativeKernel((const void*)mega, dim3(grid_blocks), dim3(512), args, LDS_BYTES, stream);
  if (e != hipSuccess) fprintf(stderr, "cooperative launch failed: %s (grid %d)\n", hipGetErrorString(e), grid_blocks);
#else
  for (int ph = 0; ph < 11; ++ph) {
    p.ph_lo = ph; p.ph_hi = ph + 1;
    hipLaunchKernelGGL(mega, dim3(grid_blocks), dim3(512), LDS_BYTES, stream, p);
  }
#endif
}
```
